# Optimizing an MI355X kernel written in HIP

```python
import math
import jax, jax.numpy as jnp
from jax import lax
import numpy as np

D_MODEL = 1024
BATCH = 8
SEQ = 2048
DEPTH = 2

CHUNK = 64
D_MIX = D_MODEL
GROUP_W = D_MIX // 4
EPS = 1e-6

SB_HEADS = 4
SB_HEAD_DIM = GROUP_W // SB_HEADS
SB_BLOCK = 128
RG_WIDTH = GROUP_W
RG_BLOCKS = 4
RG_BLOCK_DIM = RG_WIDTH // RG_BLOCKS
RG_CONV = 4
RG_C = 8.0
HG_HEADS = 4
HG_DK = GROUP_W // HG_HEADS
HG_DV = GROUP_W // HG_HEADS
M2_HEADS = 4
M2_HEAD_DIM = GROUP_W // M2_HEADS
M2_GROUPS = 2
M2_STATE = 128
M2_CONV = 4
M2_CONV_DIM = GROUP_W + 2 * M2_GROUPS * M2_STATE
N_EXPERTS = 32
TOP_K = 4
D_FF = D_MODEL
SWIGLU_LIMIT = 7.0
SWIGLU_ALPHA = 1.702
MOE_BLOCK = 128

IN_WIDTHS = ([GROUP_W] * 3
             + [GROUP_W] * 2
             + [GROUP_W] * 4
             + [GROUP_W, M2_CONV_DIM, M2_HEADS])
D_IN = sum(IN_WIDTHS)

kernel_name = "hybrid_sb_rglru_hgrn2_ssd_moe"


def rms_norm(x, g):
    xf = x.astype(jnp.float32)
    y = xf * lax.rsqrt(jnp.mean(xf * xf, axis=-1, keepdims=True) + EPS)
    return (y * g.astype(jnp.float32)).astype(x.dtype)


def group_rms(x, n_groups):
    shp = x.shape
    xg = x.reshape(shp[:-1] + (n_groups, shp[-1] // n_groups))
    xg = xg * lax.rsqrt(jnp.mean(xg * xg, axis=-1, keepdims=True) + EPS)
    return xg.reshape(shp)


def causal_depthwise_conv(x, w, b):
    k = w.shape[0]
    y = lax.conv_general_dilated(x, w[:, None, :], window_strides=(1,), padding=[(k - 1, 0)],
                                 dimension_numbers=("NWC", "WIO", "NWC"),
                                 feature_group_count=x.shape[-1])
    return y + b


def stick_breaking_attention(q, k, v):
    L = q.shape[2]
    scale = q.shape[-1] ** -0.5
    outs = []
    for blk in range(L // SB_BLOCK):
        q0 = blk * SB_BLOCK
        lk = q0 + SB_BLOCK
        z = jnp.einsum("bhtd,bhsd->bhts", q[:, :, q0:lk], k[:, :, :lk]).astype(jnp.float32) * scale
        t_idx = q0 + jnp.arange(SB_BLOCK)[:, None]
        s_idx = jnp.arange(lk)[None, :]
        mask = s_idx < t_idx
        log_keep = jnp.where(mask, jax.nn.log_sigmoid(-z), 0.0)
        log_remain = lax.cumsum(log_keep, axis=3, reverse=True) - log_keep
        log_a = jnp.where(mask, jax.nn.log_sigmoid(z) + log_remain, -jnp.inf)
        a = jnp.exp(log_a)
        outs.append(jnp.einsum("bhts,bhsd->bhtd", a.astype(v.dtype), v[:, :, :lk]))
    return jnp.concatenate(outs, axis=2)


def rg_lru_branch(x_in, gate_in, conv_w, conv_b, wa, ba, wx, bx, lam):
    B_, L, W = x_in.shape
    xc = causal_depthwise_conv(x_in, conv_w, conv_b)
    xb = xc.reshape(B_, L, RG_BLOCKS, RG_BLOCK_DIM)
    r = jax.nn.sigmoid((jnp.einsum("blni,nij->blnj", xb, wa).reshape(B_, L, W) + ba).astype(jnp.float32))
    ig = jax.nn.sigmoid((jnp.einsum("blni,nij->blnj", xb, wx).reshape(B_, L, W) + bx).astype(jnp.float32))
    log_a = -RG_C * r * jax.nn.softplus(-lam.astype(jnp.float32))
    a = jnp.exp(log_a)
    mult = jnp.sqrt(-jnp.expm1(2.0 * log_a))
    mult = jnp.where((jnp.arange(L) == 0)[None, :, None], 1.0, mult)
    u = mult * ig * xc.astype(jnp.float32)

    def combine(c1, c2):
        a1, b1 = c1
        a2, b2 = c2
        return a1 * a2, a2 * b1 + b2

    _, hs = lax.associative_scan(combine, (a, u), axis=1)
    return (hs * jax.nn.gelu(gate_in.astype(jnp.float32))).astype(x_in.dtype)


def hgrn2_branch(q_in, f_in, i_in, g_in, lb, norm_g):
    B_, L, W = q_in.shape
    nc = L // CHUNK
    forget = lb + (1.0 - lb) * jax.nn.sigmoid(f_in.astype(jnp.float32))
    log_f = jnp.log(forget)
    key = 1.0 - forget
    q = jax.nn.silu(q_in.astype(jnp.float32))
    v = i_in.astype(jnp.float32)

    def to_chunks(t, d):
        return t.reshape(B_, nc, CHUNK, HG_HEADS, d).transpose(1, 0, 3, 2, 4)

    qc, kc, lfc = to_chunks(q, HG_DK), to_chunks(key, HG_DK), to_chunks(log_f, HG_DK)
    vc = to_chunks(v, HG_DV)
    causal = jnp.tril(jnp.ones((CHUNK, CHUNK), bool))

    def step(state, inp):
        qb, kb, vb, lfb = inp
        bcum = jnp.cumsum(lfb, axis=2)
        diff = bcum[:, :, :, None, :] - bcum[:, :, None, :, :]
        decay = jnp.exp(jnp.where(causal[:, :, None], diff, -jnp.inf))
        scores = jnp.einsum("bhtc,bhsc,bhtsc->bhts", qb, kb, decay)
        o = jnp.einsum("bhts,bhsv->bhtv", scores, vb) + jnp.einsum("bhtc,bhcv->bhtv", qb * jnp.exp(bcum), state)
        b_last = bcum[:, :, -1:, :]
        new_state = (jnp.exp(b_last[:, :, 0, :, None]) * state
                     + jnp.einsum("bhsc,bhsv->bhcv", kb * jnp.exp(b_last - bcum), vb))
        return new_state, o

    s0 = jnp.zeros((B_, HG_HEADS, HG_DK, HG_DV), jnp.float32)
    _, o = lax.scan(step, s0, (qc, kc, vc, lfc))
    o = o.transpose(1, 0, 3, 2, 4).reshape(B_, L, W)
    o = group_rms(o, HG_HEADS) * norm_g.astype(jnp.float32) * jax.nn.silu(g_in.astype(jnp.float32))
    return o.astype(q_in.dtype)


def segsum(x):
    q = x.shape[-1]
    cs = jnp.cumsum(x, axis=-1)
    diff = cs[..., :, None] - cs[..., None, :]
    return jnp.where(jnp.tril(jnp.ones((q, q), bool)), diff, -jnp.inf)


def mamba2_branch(z, xbc, dt_raw, conv_w, conv_b, dt_bias, a_log, d_skip, norm_g):
    B_, L, _ = z.shape
    nc = L // CHUNK
    H, P, G, N = M2_HEADS, M2_HEAD_DIM, M2_GROUPS, M2_STATE
    xbc = jax.nn.silu(causal_depthwise_conv(xbc, conv_w, conv_b))
    xs = xbc[..., :GROUP_W].reshape(B_, L, H, P).astype(jnp.float32)
    bm = jnp.repeat(xbc[..., GROUP_W:GROUP_W + G * N].reshape(B_, L, G, N), H // G, axis=2).astype(jnp.float32)
    cm = jnp.repeat(xbc[..., GROUP_W + G * N:].reshape(B_, L, G, N), H // G, axis=2).astype(jnp.float32)
    dt = jax.nn.softplus(dt_raw.astype(jnp.float32) + dt_bias.astype(jnp.float32))
    da = dt * (-jnp.exp(a_log.astype(jnp.float32)))
    xd = xs * dt[..., None]
    xd_c = xd.reshape(B_, nc, CHUNK, H, P)
    b_c = bm.reshape(B_, nc, CHUNK, H, N)
    c_c = cm.reshape(B_, nc, CHUNK, H, N)
    da_c = da.reshape(B_, nc, CHUNK, H).transpose(0, 3, 1, 2)
    a_cs = jnp.cumsum(da_c, axis=-1)
    lmat = jnp.exp(segsum(da_c))
    y_diag = jnp.einsum("bclhn,bcshn,bhcls,bcshp->bclhp", c_c, b_c, lmat, xd_c)
    decay_states = jnp.exp(a_cs[..., -1:] - a_cs)
    states = jnp.einsum("bcshn,bhcs,bcshp->bchpn", b_c, decay_states, xd_c)
    chunk_decay = jnp.exp(a_cs[..., -1])

    def step(hstate, inp):
        st, dec = inp
        return dec[..., None, None] * hstate + st, hstate

    h0 = jnp.zeros((B_, H, P, N), jnp.float32)
    _, prev = lax.scan(step, h0, (states.transpose(1, 0, 2, 3, 4), chunk_decay.transpose(2, 0, 1)))
    prev = prev.transpose(1, 0, 2, 3, 4)
    y_off = jnp.einsum("bclhn,bchpn,bhcl->bclhp", c_c, prev, jnp.exp(a_cs))
    y = (y_diag + y_off).reshape(B_, L, H, P) + xs * d_skip.astype(jnp.float32)[:, None]
    y = y.reshape(B_, L, GROUP_W) * jax.nn.silu(z.astype(jnp.float32))
    y = group_rms(y, M2_GROUPS) * norm_g.astype(jnp.float32)
    return y.astype(z.dtype)


def moe_ffn(x, router_w, router_b, w_gu, b_gu, w_down, b_down):
    B_, L, D = x.shape
    n_tok = B_ * L
    xt = x.reshape(n_tok, D)
    logits = (xt @ router_w + router_b).astype(jnp.float32)
    top_logits, top_idx = lax.top_k(logits, TOP_K)
    gates = jax.nn.softmax(top_logits, axis=-1)
    n_assign = n_tok * TOP_K
    flat_e = top_idx.reshape(-1)
    order = jnp.argsort(flat_e)
    sorted_e = flat_e[order]
    sorted_tok = (order // TOP_K).astype(jnp.int32)
    counts = jnp.bincount(flat_e, length=N_EXPERTS)
    padded = (counts + MOE_BLOCK - 1) // MOE_BLOCK * MOE_BLOCK
    pad_end = jnp.cumsum(padded)
    pad_start = pad_end - padded
    start = jnp.cumsum(counts) - counts
    dest = (pad_start[sorted_e] + jnp.arange(n_assign) - start[sorted_e]).astype(jnp.int32)
    n_blocks = -(-n_assign // MOE_BLOCK) + N_EXPERTS
    slot_tok = jnp.zeros((n_blocks * MOE_BLOCK,), jnp.int32).at[dest].set(sorted_tok)
    block_expert = jnp.minimum(jnp.searchsorted(pad_end, jnp.arange(n_blocks) * MOE_BLOCK, side="right"),
                               N_EXPERTS - 1)

    def run_block(args):
        tok, e = args
        hmid = xt[tok] @ w_gu[e] + b_gu[e]
        glu = jnp.minimum(hmid[:, 0::2], SWIGLU_LIMIT)
        lin = jnp.clip(hmid[:, 1::2], -SWIGLU_LIMIT, SWIGLU_LIMIT)
        act = glu * jax.nn.sigmoid(SWIGLU_ALPHA * glu) * (lin + 1.0)
        return act @ w_down[e] + b_down[e]

    y_slots = lax.map(run_block, (slot_tok.reshape(n_blocks, MOE_BLOCK), block_expert)).reshape(-1, D)
    slot_of = jnp.zeros((n_assign,), jnp.int32).at[order].set(dest)
    y = jnp.einsum("tk,tkd->td", gates.astype(x.dtype), y_slots[slot_of].reshape(n_tok, TOP_K, D))
    return y.reshape(B_, L, D)


def setup_inputs(seed: int = 0) -> dict:
    key = jax.random.key(seed)
    ks = jax.random.split(key, 32)

    def nrm(k, shape, scale):
        return jax.random.normal(k, shape, jnp.float32) * scale

    def gain(k, shape):
        return 1.0 + 0.02 * jax.random.normal(k, shape, jnp.float32)

    x = nrm(ks[0], (BATCH, SEQ, D_MODEL), 1.0)
    norm_mix_g = gain(ks[1], (DEPTH, D_MODEL))
    w_in = nrm(ks[2], (DEPTH, D_MODEL, D_IN), D_MODEL ** -0.5)
    sb_norm_g = gain(ks[3], (DEPTH, GROUP_W))
    rg_conv_w = nrm(ks[4], (DEPTH, RG_CONV, RG_WIDTH), RG_CONV ** -0.5)
    rg_conv_b = nrm(ks[5], (DEPTH, RG_WIDTH), 0.01)
    rg_wa = nrm(ks[6], (DEPTH, RG_BLOCKS, RG_BLOCK_DIM, RG_BLOCK_DIM), RG_BLOCK_DIM ** -0.5)
    rg_ba = nrm(ks[7], (DEPTH, RG_WIDTH), 0.01)
    rg_wx = nrm(ks[8], (DEPTH, RG_BLOCKS, RG_BLOCK_DIM, RG_BLOCK_DIM), RG_BLOCK_DIM ** -0.5)
    rg_bx = nrm(ks[9], (DEPTH, RG_WIDTH), 0.01)
    a_pow = jax.random.uniform(ks[10], (DEPTH, RG_WIDTH), jnp.float32, 0.9, 0.999)
    s = a_pow ** (1.0 / RG_C)
    rg_lambda = jnp.log(s) - jnp.log1p(-s)
    rg_norm_g = gain(ks[11], (DEPTH, GROUP_W))
    hg_lower_bounds = nrm(ks[12], (DEPTH, GROUP_W), 0.1)
    hg_norm_g = gain(ks[13], (DEPTH, GROUP_W))
    m2_conv_w = nrm(ks[14], (DEPTH, M2_CONV, M2_CONV_DIM), M2_CONV ** -0.5)
    m2_conv_b = nrm(ks[15], (DEPTH, M2_CONV_DIM), 0.01)
    dt0 = jnp.exp(jax.random.uniform(ks[16], (DEPTH, M2_HEADS), jnp.float32, math.log(1e-3), math.log(1e-1)))
    m2_dt_bias = dt0 + jnp.log(-jnp.expm1(-dt0))
    m2_a_log = jnp.log(jax.random.uniform(ks[17], (DEPTH, M2_HEADS), jnp.float32, 1.0, 16.0))
    m2_d = gain(ks[18], (DEPTH, M2_HEADS))
    m2_norm_g = gain(ks[19], (DEPTH, GROUP_W))
    w_out = nrm(ks[20], (DEPTH, D_MIX, D_MODEL), 0.5 * D_MIX ** -0.5)
    norm_ffn_g = gain(ks[21], (DEPTH, D_MODEL))
    router_w = nrm(ks[22], (DEPTH, D_MODEL, N_EXPERTS), D_MODEL ** -0.5)
    router_b = nrm(ks[23], (DEPTH, N_EXPERTS), 0.01)
    moe_w_gu = nrm(ks[24], (DEPTH, N_EXPERTS, D_MODEL, 2 * D_FF), D_MODEL ** -0.5)
    moe_b_gu = nrm(ks[25], (DEPTH, N_EXPERTS, 2 * D_FF), 0.01)
    moe_w_down = nrm(ks[26], (DEPTH, N_EXPERTS, D_FF, D_MODEL), 0.5 * D_FF ** -0.5)
    moe_b_down = nrm(ks[27], (DEPTH, N_EXPERTS, D_MODEL), 0.01)
    final_norm_g = gain(ks[28], (D_MODEL,))
    return {"x": x, "norm_mix_g": norm_mix_g, "w_in": w_in, "sb_norm_g": sb_norm_g,
            "rg_conv_w": rg_conv_w, "rg_conv_b": rg_conv_b, "rg_wa": rg_wa, "rg_ba": rg_ba,
            "rg_wx": rg_wx, "rg_bx": rg_bx, "rg_lambda": rg_lambda, "rg_norm_g": rg_norm_g,
            "hg_lower_bounds": hg_lower_bounds, "hg_norm_g": hg_norm_g,
            "m2_conv_w": m2_conv_w, "m2_conv_b": m2_conv_b, "m2_dt_bias": m2_dt_bias,
            "m2_a_log": m2_a_log, "m2_d": m2_d, "m2_norm_g": m2_norm_g, "w_out": w_out,
            "norm_ffn_g": norm_ffn_g, "router_w": router_w, "router_b": router_b,
            "moe_w_gu": moe_w_gu, "moe_b_gu": moe_b_gu, "moe_w_down": moe_w_down,
            "moe_b_down": moe_b_down, "final_norm_g": final_norm_g}


def reference(x, norm_mix_g, w_in, sb_norm_g, rg_conv_w, rg_conv_b, rg_wa, rg_ba, rg_wx, rg_bx,
              rg_lambda, rg_norm_g, hg_lower_bounds, hg_norm_g, m2_conv_w, m2_conv_b, m2_dt_bias,
              m2_a_log, m2_d, m2_norm_g, w_out, norm_ffn_g, router_w, router_b, moe_w_gu, moe_b_gu,
              moe_w_down, moe_b_down, final_norm_g):
    B_, L, _ = x.shape
    lbs = jnp.cumsum(jax.nn.softmax(hg_lower_bounds.astype(jnp.float32), axis=0), axis=0)
    lbs = lbs - lbs[0]
    split_at = np.cumsum(IN_WIDTHS)[:-1].tolist()

    def to_heads(t, n):
        return t.reshape(B_, L, n, -1).transpose(0, 2, 1, 3)

    h = x
    for l in range(DEPTH):
        u = rms_norm(h, norm_mix_g[l])
        proj = u @ w_in[l]
        (sb_q, sb_k, sb_v, rg_x, rg_g, hg_q, hg_f, hg_i, hg_g,
         m2_z, m2_xbc, m2_dt) = jnp.split(proj, split_at, axis=-1)
        o_a = stick_breaking_attention(to_heads(sb_q, SB_HEADS), to_heads(sb_k, SB_HEADS), to_heads(sb_v, SB_HEADS))
        o_a = rms_norm(o_a.transpose(0, 2, 1, 3).reshape(B_, L, GROUP_W), sb_norm_g[l])
        o_b = rms_norm(rg_lru_branch(rg_x, rg_g, rg_conv_w[l], rg_conv_b[l], rg_wa[l], rg_ba[l],
                                     rg_wx[l], rg_bx[l], rg_lambda[l]), rg_norm_g[l])
        o_c = hgrn2_branch(hg_q, hg_f, hg_i, hg_g, lbs[l], hg_norm_g[l])
        o_d = mamba2_branch(m2_z, m2_xbc, m2_dt, m2_conv_w[l], m2_conv_b[l], m2_dt_bias[l],
                            m2_a_log[l], m2_d[l], m2_norm_g[l])
        mix = jnp.concatenate([o_a, o_b, o_c, o_d], axis=-1)
        h = h + mix @ w_out[l]
        h = h + moe_ffn(rms_norm(h, norm_ffn_g[l]), router_w[l], router_b[l], moe_w_gu[l],
                        moe_b_gu[l], moe_w_down[l], moe_b_down[l])
    return rms_norm(h, final_norm_g)
```

```cpp
#include <hip/hip_runtime.h>
#include <cstdio>
#include <cstdint>

#ifndef MK_N_LAUNCHES
#define MK_N_LAUNCHES 0
#endif

constexpr int NB = 8, SEQ = 2048, DM = 1024, T = NB * SEQ, DEPTH = 2;
constexpr int DIN = 3332, DING = 3328;
constexpr int NE = 32, TOPK = 4, DFF = 1024;
constexpr int NASG = T * TOPK;
constexpr int MAXSLOT = NASG + NE * 256;
constexpr float EPS = 1e-6f;
constexpr int C_SBQ = 0, C_SBK = 256, C_SBV = 512, C_RGX = 768, C_RGG = 1024, C_HGQ = 1280, C_HGF = 1536, C_HGI = 1792, C_HGG = 2048,
              C_M2Z = 2304, C_M2X = 2560, C_DT = 3328;
constexpr int NWAVES = 8, NTHR = 512;

constexpr size_t MiB = 1u << 20;
constexpr size_t WS_CTL = 0, CTL_ZERO_BYTES = 1 * MiB;
constexpr size_t WS_WIN = 2 * MiB;
constexpr size_t WS_WOUT = 16 * MiB;
constexpr size_t WS_WGU = 32 * MiB;
constexpr size_t WS_WDN = 288 * MiB;
constexpr size_t WS_XN = 416 * MiB;
constexpr size_t WS_PROJ = 448 * MiB;
constexpr size_t WS_ORAW = 552 * MiB;
constexpr size_t WS_MIX = 616 * MiB;
constexpr size_t WS_H1 = 648 * MiB;
constexpr size_t WS_HB = 712 * MiB;
constexpr size_t WS_XS = 776 * MiB;
constexpr size_t WS_ACT = 920 * MiB;
constexpr size_t WS_Y = 1064 * MiB;
constexpr size_t WS_DT = 1208 * MiB;
constexpr size_t WS_ASGE = 1209 * MiB;
constexpr size_t WS_ASGP = 1210 * MiB;
constexpr size_t WS_GATE = 1211 * MiB;
constexpr size_t WS_SLOT = 1212 * MiB;
constexpr size_t WS_END = 1216 * MiB;
constexpr int CW_TMO = 0, CW_CODE = 1;
constexpr int CW_CNT = 256;
constexpr int CW_BAR = 4096;

constexpr int LDS_BYTES = 147456;
constexpr int LDSCTL_OFF = LDS_BYTES - 1024;
constexpr int MISC_OFF = LDSCTL_OFF;
constexpr int TB_OFF = LDSCTL_OFF + 256;

namespace pg8 {
#define PG8_LAS __attribute__((address_space(3)))
typedef unsigned short bf16_t;
typedef short bf16x8 __attribute__((ext_vector_type(8)));
typedef float f32x4 __attribute__((ext_vector_type(4)));
typedef unsigned u32x4 __attribute__((ext_vector_type(4)));
constexpr int BM = 256, BK = 64, HALF = 128, HTB = HALF * BK * 2  , STAGE_BYTES = 8 * HTB, NXCD = 8, WGM = 8;

__host__ __device__ __forceinline__ int lds_byte(int r, int c) { const int st = (r >> 4) * 2 + (c >> 5), rr = r & 15, cc = c & 31, ob = rr * 64 + cc * 2; return st * 1024 + (ob ^ (((ob >> 9) & 1) << 5)); }
__host__ __device__ __forceinline__ void stage_rc(int b, int& R, int& C) { const int st = b / 1024, sb = b % 1024, swz = sb ^ (((sb >> 9) & 1) << 5); R = (st >> 1) * 16 + swz / 64; C = (st & 1) * 32 + (swz % 64) / 2; }
__host__ __device__ __forceinline__ int perm32(int rho) { const int n = rho >> 4, i = rho & 15; return 8 * (i >> 2) + 4 * n + (i & 3); }

struct Unit { int pm, pn, pb, e; };
struct Gemm { const bf16_t* A; const bf16_t* Bt; int M, N, K; };

__host__ __device__ __forceinline__ int xcd_remap(int wgid, int nwg) { const int q = nwg / NXCD, r = nwg % NXCD, xcd = wgid % NXCD, off = wgid / NXCD; return (xcd < r ? xcd * (q + 1) : r * (q + 1) + (xcd - r) * q) + off; }

struct StaticOrder {
    int nM, nN, nwg, G, c;
    __host__ __device__ void init(int M, int N, int G_, int c_) { nM = M / BM; nN = N / BM; nwg = nM * nN; G = G_; c = c_; }
    __host__ __device__ bool next(int i, Unit& u) const {
        const long L = (long)i * G + c; if (L >= nwg) return false;
        const int wgid = xcd_remap((int)L, nwg);
        const int nig = WGM * nN, gid = wgid / nig, fm = gid * WGM, gsz = (nM - fm) < WGM ? (nM - fm) : WGM;
        u.pm = fm + ((wgid % nig) % gsz); u.pn = (wgid % nig) / gsz; u.pb = u.pn; u.e = 0; return true;
    }
    __device__ __forceinline__ void a_ready(const Unit&) const {}
    __device__ __forceinline__ void done(const Unit&) const {}
};
struct MoeOrder {
    const PG8_LAS int* tb; int NP, G, c;
    __device__ __forceinline__ bool next(int i, Unit& u) const {
        const int ntot = tb[32], nunits = ntot * NP;
        const long L = (long)i * G + c; if (L >= nunits) return false;
        const int id = xcd_remap((int)L, nunits);
        int e = 0;
        for (int j = 1; j < 32; ++j) if (id >= tb[j] * NP) e = j;
        e = __builtin_amdgcn_readfirstlane(e);
        const int t0 = tb[e], nt = tb[e + 1] - t0, rem = id - t0 * NP;
        u.pm = __builtin_amdgcn_readfirstlane(t0 + rem % nt); u.pn = __builtin_amdgcn_readfirstlane(rem / nt); u.pb = e * NP + u.pn; u.e = e; return true;
    }
    __device__ __forceinline__ void a_ready(const Unit&) const {}
    __device__ __forceinline__ void done(const Unit&) const {}
};

__device__ __forceinline__ unsigned cvt_pk_bf16(float lo, float hi) { unsigned r; asm volatile("v_cvt_pk_bf16_f32 %0, %1, %2" : "=v"(r) : "v"(lo), "v"(hi)); return r; }

struct EpiBf16 {
    static constexpr bool PERM = true, AFTER_DRAIN = false;
    bf16_t* O; int ldc; const float* bias; int bias_estride;
    __device__ __forceinline__ void operator()(const f32x4 (&acc)[2][2][4][2], const Unit& u, int wr, int wc, int fr, int fq) const {
        const int row0 = u.pm * BM + wr * 64 + fr; const int col0 = u.pn * BM + wc * 32 + 8 * fq;
        f32x4 bv[2][2];
#pragma unroll
        for (int bj = 0; bj < 2; ++bj)
#pragma unroll
            for (int n = 0; n < 2; ++n) bv[bj][n] = bias ? *(const f32x4*)(bias + (size_t)u.e * bias_estride + col0 + bj * HALF + 4 * n) : (f32x4){0.f, 0.f, 0.f, 0.f};
#pragma unroll
        for (int ai = 0; ai < 2; ++ai)
#pragma unroll
            for (int m = 0; m < 4; ++m) { bf16_t* rowp = O + (size_t)(row0 + ai * HALF + m * 16) * ldc + col0;
#pragma unroll
                for (int bj = 0; bj < 2; ++bj) { const f32x4 v0 = acc[ai][bj][m][0] + bv[bj][0], v1 = acc[ai][bj][m][1] + bv[bj][1];
                    u32x4 w; w.x = cvt_pk_bf16(v0[0], v0[1]); w.y = cvt_pk_bf16(v0[2], v0[3]); w.z = cvt_pk_bf16(v1[0], v1[1]); w.w = cvt_pk_bf16(v1[2], v1[3]);
                    *(u32x4*)(rowp + bj * HALF) = w; } }
    }
};
struct EpiResF32 {
    static constexpr bool PERM = false, AFTER_DRAIN = false;
    const float* base; float* out; int ldc;
    __device__ __forceinline__ void operator()(const f32x4 (&acc)[2][2][4][2], const Unit& u, int wr, int wc, int fr, int fq) const {
        const int row0 = u.pm * BM + wr * 64 + fr, col0 = u.pn * BM + wc * 32 + 4 * fq;
#pragma unroll
        for (int ai = 0; ai < 2; ++ai)
#pragma unroll
            for (int m = 0; m < 4; ++m) { const size_t off = (size_t)(row0 + ai * HALF + m * 16) * ldc + col0;
#pragma unroll
                for (int bj = 0; bj < 2; ++bj)
#pragma unroll
                    for (int n = 0; n < 2; ++n) { const f32x4 b = *(const f32x4*)(base + off + bj * HALF + n * 16); *(f32x4*)(out + off + bj * HALF + n * 16) = b + acc[ai][bj][m][n]; } }
    }
};
struct EpiSwiglu {
    static constexpr bool PERM = true, AFTER_DRAIN = false;
    bf16_t* O; const float* bias;
    __device__ __forceinline__ void operator()(const f32x4 (&acc)[2][2][4][2], const Unit& u, int wr, int wc, int fr, int fq) const {
        const int row0 = u.pm * BM + wr * 64 + fr; const int a0 = u.pn * HALF + wc * 32 + 8 * fq;
        const float* bp = bias + (size_t)u.e * 2048 + 2 * a0;
        f32x4 b4[4];
#pragma unroll
        for (int j = 0; j < 4; ++j) b4[j] = *(const f32x4*)(bp + 4 * j);
#pragma unroll
        for (int ai = 0; ai < 2; ++ai)
#pragma unroll
            for (int m = 0; m < 4; ++m) { bf16_t* rowp = O + (size_t)(row0 + ai * HALF + m * 16) * 1024 + a0;
                float a[8];
#pragma unroll
                for (int n = 0; n < 2; ++n)
#pragma unroll
                    for (int i = 0; i < 4; ++i) { const int k = 4 * n + i;
                        float g = acc[ai][0][m][n][i] + b4[k >> 1][2 * (k & 1)], l = acc[ai][1][m][n][i] + b4[k >> 1][2 * (k & 1) + 1];
                        g = fminf(g, 7.0f); l = fminf(fmaxf(l, -7.0f), 7.0f);
                        const float sg = __builtin_amdgcn_rcpf(1.0f + __builtin_amdgcn_exp2f(-1.702f * 1.4426950408889634f * g));
                        a[k] = g * sg * (l + 1.0f); }
                u32x4 w; w.x = cvt_pk_bf16(a[0], a[1]); w.y = cvt_pk_bf16(a[2], a[3]); w.z = cvt_pk_bf16(a[4], a[5]); w.w = cvt_pk_bf16(a[6], a[7]);
                *(u32x4*)rowp = w; }
    }
};

template <class Epi, class Sched, bool ALIGN_EPI = false, bool SP2 = false>
__device__ __forceinline__ void gemm_phase(PG8_LAS unsigned char* lds, const Gemm g, const Sched& S, const Epi& E) {
    int tid = threadIdx.x; asm volatile("" : "+v"(tid));
    const int wid = __builtin_amdgcn_readfirstlane(tid >> 6), lane = tid & 63, wr = wid >> 2, wc = wid & 3, fr = lane & 15, fq = lane >> 4;
    const int K = g.K, nt = K / BK;
    unsigned voffA[2], voffB[2];
#pragma unroll
    for (int i = 0; i < 2; ++i) { int R, C; stage_rc(tid * 16 + i * 8192, R, C); const int Rb = Epi::PERM ? ((R & ~31) + perm32(R & 31)) : R;
        voffA[i] = (unsigned)(R * K + C) * 2u; voffB[i] = (unsigned)(Rb * K + C) * 2u; }
    const size_t kstep = (size_t)(BK * 2);
    const size_t hstep = (size_t)HALF * K * 2;
    const size_t tstep = 2 * hstep;
    const unsigned ldsw = (unsigned)wid * 1024u;
    const int aoff = lds_byte(wr * 64 + fr, fq * 8), boff = lds_byte(wc * 32 + fr, fq * 8);
#define PG8_SA(b, h) (((b) * 2 + (h)) * HTB)
#define PG8_SB(b, h) ((4 + (b) * 2 + (h)) * HTB)
#define PG8_STAGE(bufoff, gbase, voff) do { _Pragma("unroll") for (int _i = 0; _i < 2; ++_i) \
        __builtin_amdgcn_global_load_lds((const unsigned*)((const char*)(gbase) + (voff)[_i]), (PG8_LAS unsigned*)(lds + (bufoff) + ldsw + _i * 8192), 16, 0, 0); } while (0)
#define PG8_LDA(dst, b, h) do { _Pragma("unroll") for (int m = 0; m < 4; ++m) _Pragma("unroll") for (int k = 0; k < 2; ++k) dst[m][k] = *(const PG8_LAS bf16x8*)(lds + PG8_SA(b, h) + aoff + m * 2048 + k * 1024); } while (0)
#define PG8_LDB(dst, b, h) do { _Pragma("unroll") for (int n = 0; n < 2; ++n) _Pragma("unroll") for (int k = 0; k < 2; ++k) dst[n][k] = *(const PG8_LAS bf16x8*)(lds + PG8_SB(b, h) + boff + n * 2048 + k * 1024); } while (0)
#define PG8_MMA(ai, bj, At, Bt) do { __builtin_amdgcn_s_setprio(1); _Pragma("unroll") for (int m = 0; m < 4; ++m) _Pragma("unroll") for (int n = 0; n < 2; ++n) _Pragma("unroll") for (int k = 0; k < 2; ++k) \
        acc[ai][bj][m][n] = __builtin_amdgcn_mfma_f32_16x16x32_bf16(Bt[n][k], At[m][k], acc[ai][bj][m][n], 0, 0, 0); __builtin_amdgcn_s_setprio(0); } while (0)
#define PG8_WAIT_V(n) asm volatile("s_waitcnt vmcnt(" #n ")" ::: "memory")
#define PG8_WAIT_L(n) asm volatile("s_waitcnt lgkmcnt(" #n ")" ::: "memory")
#define PG8_BAR __builtin_amdgcn_s_barrier()
#define PG8_SCHED __builtin_amdgcn_sched_barrier(0)
    Unit cur, nxt; int ui = 0;
    if (!S.next(0, cur)) return;
    f32x4 acc[2][2][4][2];
#pragma unroll
    for (int a = 0; a < 2; ++a)
#pragma unroll
        for (int b = 0; b < 2; ++b)
#pragma unroll
            for (int m = 0; m < 4; ++m)
#pragma unroll
                for (int n = 0; n < 2; ++n) acc[a][b][m][n] = (f32x4){0.f, 0.f, 0.f, 0.f};
    bf16x8 At[4][2], B0[2][2], B1[2][2];
    const char* cA = (const char*)g.A + (size_t)cur.pm * tstep; const char* cB = (const char*)g.Bt + (size_t)cur.pb * tstep;
    S.a_ready(cur);
    if constexpr (SP2) {
        PG8_STAGE(PG8_SB(0, 0), cB, voffB); PG8_STAGE(PG8_SB(0, 1), cB + hstep, voffB); PG8_STAGE(PG8_SA(0, 0), cA, voffA); PG8_STAGE(PG8_SA(0, 1), cA + hstep, voffA);
        if (wr == 1) PG8_BAR;
        PG8_WAIT_V(2); PG8_BAR;
        PG8_STAGE(PG8_SB(1, 0), cB + kstep, voffB); PG8_STAGE(PG8_SA(1, 0), cA + kstep, voffA); PG8_STAGE(PG8_SB(1, 1), cB + hstep + kstep, voffB);
        PG8_WAIT_V(6); PG8_BAR;
    } else {
        PG8_STAGE(PG8_SB(0, 0), cB, voffB); PG8_STAGE(PG8_SA(0, 0), cA, voffA); PG8_STAGE(PG8_SB(0, 1), cB + hstep, voffB); PG8_STAGE(PG8_SA(0, 1), cA + hstep, voffA);
        if (wr == 1) PG8_BAR;
        PG8_WAIT_V(4); PG8_BAR;
        PG8_STAGE(PG8_SB(1, 0), cB + kstep, voffB); PG8_STAGE(PG8_SA(1, 0), cA + kstep, voffA); PG8_STAGE(PG8_SB(1, 1), cB + hstep + kstep, voffB);
        PG8_WAIT_V(6); PG8_BAR;
    }
    for (;;) {
        const bool has_next = S.next(ui + 1, nxt);
        const char* nA = has_next ? (const char*)g.A + (size_t)nxt.pm * tstep : cA; const char* nB = has_next ? (const char*)g.Bt + (size_t)nxt.pb * tstep : cB;
        for (int t = 0; t < nt; t += 2) {
            const bool last = (t == nt - 2);
            const char* a1 = cA + (size_t)(t + 1) * kstep;
            const char* a2 = last ? nA : cA + (size_t)(t + 2) * kstep; const char* b2 = last ? nB : cB + (size_t)(t + 2) * kstep;
            const char* a3 = a2 + kstep; const char* b3 = b2 + kstep;
            if (last && has_next) S.a_ready(nxt);
            if constexpr (SP2) {
            PG8_LDB(B0, 0, 0); PG8_LDB(B1, 0, 1); PG8_SCHED; PG8_LDA(At, 0, 0); PG8_STAGE(PG8_SA(1, 1), a1 + hstep, voffA);
            PG8_WAIT_V(8); PG8_WAIT_L(0); PG8_BAR; PG8_MMA(0, 0, At, B0); PG8_MMA(0, 1, At, B1); PG8_BAR; PG8_SCHED;
            PG8_LDA(At, 0, 1); PG8_STAGE(PG8_SB(0, 0), b2, voffB); PG8_STAGE(PG8_SB(0, 1), b2 + hstep, voffB); PG8_STAGE(PG8_SA(0, 0), a2, voffA);
            PG8_WAIT_V(8); PG8_WAIT_L(0); PG8_BAR; PG8_MMA(1, 0, At, B0); PG8_MMA(1, 1, At, B1); PG8_BAR; PG8_SCHED;
            PG8_LDB(B0, 1, 0); PG8_LDB(B1, 1, 1); PG8_SCHED; PG8_LDA(At, 1, 0); PG8_STAGE(PG8_SA(0, 1), a2 + hstep, voffA);
            PG8_WAIT_V(8); PG8_WAIT_L(0); PG8_BAR; PG8_MMA(0, 0, At, B0); PG8_MMA(0, 1, At, B1); PG8_BAR; PG8_SCHED;
            PG8_LDA(At, 1, 1); PG8_STAGE(PG8_SB(1, 0), b3, voffB); PG8_STAGE(PG8_SB(1, 1), b3 + hstep, voffB); PG8_STAGE(PG8_SA(1, 0), a3, voffA);
            PG8_WAIT_V(8); PG8_WAIT_L(0); PG8_BAR; PG8_MMA(1, 0, At, B0); PG8_MMA(1, 1, At, B1); PG8_BAR; PG8_SCHED;
            } else {
            PG8_LDB(B0, 0, 0); PG8_SCHED; PG8_LDA(At, 0, 0); PG8_STAGE(PG8_SA(1, 1), a1 + hstep, voffA);
            PG8_WAIT_L(8); PG8_BAR; PG8_WAIT_L(0); PG8_MMA(0, 0, At, B0); PG8_BAR; PG8_SCHED;
            PG8_LDB(B1, 0, 1); PG8_STAGE(PG8_SB(0, 0), b2, voffB);
            PG8_BAR; PG8_WAIT_L(0); PG8_MMA(0, 1, At, B1); PG8_BAR;
            PG8_LDA(At, 0, 1); PG8_STAGE(PG8_SA(0, 0), a2, voffA);
            PG8_BAR; PG8_WAIT_L(0); PG8_MMA(1, 0, At, B0); PG8_BAR; PG8_SCHED;
            PG8_STAGE(PG8_SB(0, 1), b2 + hstep, voffB);
            PG8_WAIT_V(6); PG8_BAR; PG8_MMA(1, 1, At, B1); PG8_BAR;
            PG8_LDB(B0, 1, 0); PG8_SCHED; PG8_LDA(At, 1, 0); PG8_STAGE(PG8_SA(0, 1), a2 + hstep, voffA);
            PG8_WAIT_L(8); PG8_BAR; PG8_WAIT_L(0); PG8_MMA(0, 0, At, B0); PG8_BAR; PG8_SCHED;
            PG8_LDB(B1, 1, 1); PG8_STAGE(PG8_SB(1, 0), b3, voffB);
            PG8_BAR; PG8_WAIT_L(0); PG8_MMA(0, 1, At, B1); PG8_BAR;
            PG8_LDA(At, 1, 1); PG8_STAGE(PG8_SA(1, 0), a3, voffA);
            PG8_BAR; PG8_WAIT_L(0); PG8_MMA(1, 0, At, B0); PG8_BAR; PG8_SCHED;
            PG8_STAGE(PG8_SB(1, 1), b3 + hstep, voffB);
            PG8_WAIT_V(6); PG8_BAR; PG8_MMA(1, 1, At, B1); PG8_BAR;
            }
        }
        if constexpr (ALIGN_EPI) { if (wr == 0) PG8_BAR; }
        if constexpr (!Epi::AFTER_DRAIN) { E(acc, cur, wr, wc, fr, fq); S.done(cur); }
        if (!has_next) break;
#pragma unroll
        for (int a = 0; a < 2; ++a)
#pragma unroll
            for (int b = 0; b < 2; ++b)
#pragma unroll
                for (int m = 0; m < 4; ++m)
#pragma unroll
                    for (int n = 0; n < 2; ++n) acc[a][b][m][n] = (f32x4){0.f, 0.f, 0.f, 0.f};
        cur = nxt; cA = nA; cB = nB; ++ui;
        if constexpr (ALIGN_EPI) { if (wr == 1) PG8_BAR; }
    }
    PG8_WAIT_V(0);
    if constexpr (!ALIGN_EPI) { if (wr == 0) PG8_BAR; }
    PG8_BAR;
    if constexpr (Epi::AFTER_DRAIN) { E.fused(acc, cur, wr, wc, fr, fq, lds, wid, lane); S.done(cur); }
#undef PG8_SA
#undef PG8_SB
#undef PG8_STAGE
#undef PG8_LDA
#undef PG8_LDB
#undef PG8_MMA
#undef PG8_WAIT_V
#undef PG8_WAIT_L
#undef PG8_BAR
#undef PG8_SCHED
}
}
#define GAS __attribute__((address_space(1)))
#define LAS __attribute__((address_space(3)))
typedef unsigned short bf16;
typedef unsigned v4u __attribute__((ext_vector_type(4)));
typedef float f32x4 __attribute__((ext_vector_type(4)));
typedef short bf16x8 __attribute__((ext_vector_type(8)));
typedef GAS unsigned gu32;
typedef GAS unsigned long long gu64;
#define RLX_AGENT __ATOMIC_RELAXED, __HIP_MEMORY_SCOPE_AGENT
#define LDS_WAIT() asm volatile("s_waitcnt lgkmcnt(0)" ::: "memory")
#define VM_WAIT() asm volatile("s_waitcnt vmcnt(0)" ::: "memory")
__device__ __forceinline__ unsigned long long rt() { return __builtin_amdgcn_s_memrealtime(); }
__device__ __forceinline__ unsigned f2bf(float f) { unsigned u = __builtin_bit_cast(unsigned, f); return (u + 0x7fffu + ((u >> 16) & 1u)) >> 16; }
__device__ __forceinline__ unsigned pk2(float lo, float hi) { return f2bf(lo) | (f2bf(hi) << 16); }

#define XB_TMO      128
#define XB_XCNT(j)  (256  + 64 * (j))
#define XB_XSUB(j)  (1280 + 64 * (j))
#define XB_XGEN(j)  (2304 + 64 * (j))
#define XB_TOP      3328
#define XB_TOPGEN   3392
#define XCD_BAR_WORDS 3456
#define XB_SPIN_CAP (1u << 18)

__device__ __forceinline__ unsigned xb_ld(unsigned* p)              { return __hip_atomic_load(p, __ATOMIC_RELAXED, __HIP_MEMORY_SCOPE_AGENT); }
__device__ __forceinline__ unsigned xb_add(unsigned* p, unsigned v) { return __hip_atomic_fetch_add(p, v, __ATOMIC_RELAXED, __HIP_MEMORY_SCOPE_AGENT); }
__device__ __forceinline__ unsigned xb_xcc_id() { return (unsigned)__builtin_amdgcn_s_getreg((3 << 11) | 20) & 0xFu; }
#define XB_SPIN(cond, bar) do { unsigned _sp = 0; while (cond) { __builtin_amdgcn_s_sleep(1); \
    if ((++_sp & 255u) == 0u) { if (xb_ld(&(bar)[XB_TMO])) break; if (_sp > XB_SPIN_CAP) { atomicAdd(&(bar)[XB_TMO], 1u); break; } } } } while (0)

struct XcdBarrier {
    unsigned* bar; unsigned x;
    volatile LAS unsigned* st;
};

__device__ __forceinline__ XcdBarrier xcd_barrier_post(unsigned* bar, volatile LAS unsigned* st) {
    XcdBarrier b; b.bar = bar; b.x = xb_xcc_id(); b.st = st;
    if (threadIdx.x == 0) (void)xb_add(&bar[XB_XCNT(b.x)], 1u);
    return b;
}
__device__ __forceinline__ void xcd_barrier_complete(unsigned* bar, unsigned x, unsigned& nloc, unsigned& nx) {
    const unsigned G = gridDim.x * gridDim.y * gridDim.z;
    unsigned sum, cnt, mine, sp = 0u;
    for (;;) {
        sum = 0u; cnt = 0u; mine = 0u;
#pragma unroll
        for (unsigned j = 0; j < 16; ++j) { const unsigned c = xb_ld(&bar[XB_XCNT(j)]); sum += c; cnt += (c > 0u) ? 1u : 0u; mine = (j == x) ? c : mine; }
        if (sum == G) break;
        __builtin_amdgcn_s_sleep(1);
        if ((++sp & 255u) == 0u) { if (xb_ld(&bar[XB_TMO])) break; if (sp > XB_SPIN_CAP) { atomicAdd(&bar[XB_TMO], 1u); break; } }
    }
    nloc = mine > 0u ? mine : 1u; nx = cnt > 0u ? cnt : 1u;
}

__device__ __forceinline__ void xcd_barrier(const XcdBarrier& b) {
    asm volatile("s_waitcnt vmcnt(0)" ::: "memory");
    __syncthreads();
    if (threadIdx.x == 0) {
        unsigned* bar = b.bar;
        __builtin_amdgcn_s_waitcnt(0);
        unsigned nloc = b.st[0], nx = b.st[1];
        if (nloc == 0u) { xcd_barrier_complete(bar, b.x, nloc, nx); b.st[0] = nloc; b.st[1] = nx; }
        const unsigned old = xb_add(&bar[XB_XSUB(b.x)], 1u);
        const unsigned gen = old / nloc;
        if (old + 1u == (gen + 1u) * nloc) {
            __builtin_amdgcn_fence(__ATOMIC_RELEASE, "agent");
            asm volatile("s_waitcnt vmcnt(0)" ::: "memory");
            const unsigned og = xb_add(&bar[XB_TOP], 1u);
            const unsigned tg = og / nx;
            if (og + 1u == (tg + 1u) * nx) xb_add(&bar[XB_TOPGEN], 1u);
            else XB_SPIN(xb_ld(&bar[XB_TOPGEN]) == tg, bar);
            __builtin_amdgcn_fence(__ATOMIC_ACQUIRE, "agent");
            xb_add(&bar[XB_XGEN(b.x)], 1u);
            asm volatile("s_waitcnt vmcnt(0)" ::: "memory");
        } else {
            XB_SPIN(xb_ld(&bar[XB_XGEN(b.x)]) == gen, bar);
            __builtin_amdgcn_fence(__ATOMIC_ACQUIRE, "agent");
            asm volatile("s_waitcnt vmcnt(0)" ::: "memory");
        }
    }
    __syncthreads();
}

using pg8::bf16_t;
typedef unsigned u32x2 __attribute__((ext_vector_type(2)));
__device__ __forceinline__ float bf2f(unsigned v) { return __uint_as_float(v << 16); }
__device__ __forceinline__ float bflo(unsigned w) { return __uint_as_float(w << 16); }
__device__ __forceinline__ float bfhi(unsigned w) { return __uint_as_float(w & 0xffff0000u); }
__device__ __forceinline__ float wave_sum(float v) {
#pragma unroll
    for (int o = 1; o < 64; o <<= 1) v += __shfl_xor(v, o);
    return v;
}
__device__ __forceinline__ float sigm(float x) { return 1.0f / (1.0f + expf(-x)); }
__device__ __forceinline__ float softplusf_(float x) { return fmaxf(x, 0.f) + log1pf(expf(-fabsf(x))); }
__device__ __forceinline__ float gelu_tanh(float x) { return 0.5f * x * (1.0f + tanhf(0.7978845608028654f * (x + 0.044715f * x * x * x))); }

__device__ __forceinline__ int gu_rowmap(int n) { const int a = n >> 1; return ((a >> 7) << 8) + (a & 127) + ((n & 1) << 7); }
template <bool GU>
__device__ __forceinline__ void transpose_item(const float* W, int ldw, bf16* WT, int K, int k0, int n0, LAS float* scr, int lane) {
#pragma unroll
    for (int i = 0; i < 16; ++i) { const int k = 4 * i + (lane >> 4); const f32x4 v = *(const f32x4*)(W + (size_t)(k0 + k) * ldw + n0 + 4 * (lane & 15));
        LAS float* d = scr + k * 65 + 4 * (lane & 15); d[0] = v[0]; d[1] = v[1]; d[2] = v[2]; d[3] = v[3]; }
    LDS_WAIT(); asm volatile("" ::: "memory");
    const int c = lane & 7;
#pragma unroll
    for (int j = 0; j < 8; ++j) { const int n = 8 * j + (lane >> 3); const LAS float* s = scr + (8 * c) * 65 + n;
        v4u o; o.x = pk2(s[0], s[65]); o.y = pk2(s[130], s[195]); o.z = pk2(s[260], s[325]); o.w = pk2(s[390], s[455]);
        const int nr = GU ? gu_rowmap(n0 + n) : (n0 + n);
        *(v4u*)(WT + (size_t)nr * K + k0 + 8 * c) = o; }
    LDS_WAIT(); asm volatile("" ::: "memory");
}
constexpr int IT_WIN = 16 * 52, IT_WOUT = 256, IT_GU = 512, IT_DN = 256;
constexpr int NIT_WIN = DEPTH * IT_WIN, NIT_WOUT = DEPTH * IT_WOUT, NIT_GU = DEPTH * NE * IT_GU, NIT_DN = DEPTH * NE * IT_DN, NITEMS = NIT_WIN + NIT_WOUT + NIT_GU + NIT_DN;

__device__ __forceinline__ void emit_xn_dt(const f32x4 (&v)[4], const float* g, const float* win_l, bf16* xn_row, float* dt_row, int lane) {
    float ss = 0.f;
#pragma unroll
    for (int j = 0; j < 4; ++j) ss += (v[j][0] * v[j][0] + v[j][1] * v[j][1]) + (v[j][2] * v[j][2] + v[j][3] * v[j][3]);
    ss = wave_sum(ss);
    const float rstd = 1.0f / sqrtf(ss * (1.0f / DM) + EPS);
    float d0 = 0.f, d1 = 0.f, d2 = 0.f, d3 = 0.f;
#pragma unroll
    for (int j = 0; j < 4; ++j) { const int col = 256 * j + 4 * lane; const f32x4 gg = *(const f32x4*)(g + col); const f32x4 u = v[j] * rstd * gg;
        u32x2 w; w.x = pk2(u[0], u[1]); w.y = pk2(u[2], u[3]); *(u32x2*)(xn_row + col) = w;
#pragma unroll
        for (int i = 0; i < 4; ++i) { const f32x4 ww = *(const f32x4*)(win_l + (size_t)(col + i) * DIN + C_DT); d0 += u[i] * ww[0]; d1 += u[i] * ww[1]; d2 += u[i] * ww[2]; d3 += u[i] * ww[3]; } }
    d0 = wave_sum(d0); d1 = wave_sum(d1); d2 = wave_sum(d2); d3 = wave_sum(d3);
    if (lane == 0) *(f32x4*)dt_row = (f32x4){d0, d1, d2, d3};
}

__device__ __forceinline__ void attn_naive(const bf16* proj, float* oraw, int b, int h, int qb, int lane) {
    const int t = qb * 64 + lane; const size_t row = (size_t)b * SEQ + t;
    int zero; asm volatile("v_mov_b32 %0, 0" : "=v"(zero));
    float q[64], acc[64];
    const bf16* qp = proj + row * DING + C_SBQ + h * 64;
#pragma unroll
    for (int c = 0; c < 8; ++c) { const v4u w = *(const v4u*)(qp + 8 * c);
#pragma unroll
        for (int i = 0; i < 4; ++i) { q[8 * c + 2 * i] = bflo(w[i]) * 0.125f; q[8 * c + 2 * i + 1] = bfhi(w[i]) * 0.125f; } }
#pragma unroll
    for (int d = 0; d < 64; ++d) acc[d] = 0.f;
    float R = 0.f;
    for (int s = qb * 64 + 62; s >= 0; --s) {
        const bf16* kp = proj + ((size_t)b * SEQ + s) * DING + C_SBK + h * 64 + zero;
        float z = 0.f;
#pragma unroll
        for (int c = 0; c < 8; ++c) { const v4u w = *(const v4u*)(kp + 8 * c);
#pragma unroll
            for (int i = 0; i < 4; ++i) { z += q[8 * c + 2 * i] * bflo(w[i]); z += q[8 * c + 2 * i + 1] * bfhi(w[i]); } }
        if (s < t) {
            const float sp = softplusf_(z);
            const float a = expf(z - sp + R);
            R -= sp;
            const bf16* vp = kp + 256;
#pragma unroll
            for (int c = 0; c < 8; ++c) { const v4u w = *(const v4u*)(vp + 8 * c);
#pragma unroll
                for (int i = 0; i < 4; ++i) { acc[8 * c + 2 * i] += a * bflo(w[i]); acc[8 * c + 2 * i + 1] += a * bfhi(w[i]); } }
        }
    }
    float* op = oraw + row * DM + h * 64;
#pragma unroll
    for (int c = 0; c < 16; ++c) *(f32x4*)(op + 4 * c) = (f32x4){acc[4 * c], acc[4 * c + 1], acc[4 * c + 2], acc[4 * c + 3]};
}

__device__ __forceinline__ void rg_chain(const bf16* proj, float* oraw, int b, int n, const float* conv_w, const float* conv_b, const float* wa, const float* ba,
                                         const float* wx, const float* bx, const float* lam, LAS float* L, int tid) {
    LAS float* wa_s = L; LAS float* wx_s = L + 4096; LAS float* xc_s = L + 8192; LAS float* a_s = L + 12288; LAS float* u_s = L + 16384;
    const int j = tid & 63, tr = tid >> 6, c = n * 64 + j;
    for (int idx = tid; idx < 4096; idx += NTHR) { wa_s[idx] = wa[n * 4096 + idx]; wx_s[idx] = wx[n * 4096 + idx]; }
    float cw[4];
#pragma unroll
    for (int k = 0; k < 4; ++k) cw[k] = conv_w[k * 256 + c];
    const float cb = conv_b[c], bav = ba[c], bxv = bx[c], spl = softplusf_(-lam[c]);
    float hstate = 0.f;
    __syncthreads();
    for (int ch = 0; ch < SEQ / 64; ++ch) {
        const int t0 = ch * 64;
#pragma unroll 1
        for (int i = 0; i < 8; ++i) { const int t = tr + 8 * i, tg = t0 + t; float a = cb;
#pragma unroll
            for (int k = 0; k < 4; ++k) { const int ts = tg - 3 + k; if (ts >= 0) a += cw[k] * bf2f(proj[((size_t)b * SEQ + ts) * DING + C_RGX + c]); }
            xc_s[t * 64 + j] = a; }
        __syncthreads();
#pragma unroll 1
        for (int i = 0; i < 8; ++i) { const int t = tr + 8 * i; float ra = bav, ga = bxv;
            _Pragma("unroll 4") for (int ii = 0; ii < 64; ++ii) { const float x = xc_s[t * 64 + ii]; ra += x * wa_s[ii * 64 + j]; ga += x * wx_s[ii * 64 + j]; }
            const float r = sigm(ra), ig = sigm(ga), log_a = -8.0f * r * spl;
            float mult = sqrtf(-expm1f(2.0f * log_a)); if (t0 + t == 0) mult = 1.0f;
            a_s[t * 64 + j] = expf(log_a); u_s[t * 64 + j] = mult * ig * xc_s[t * 64 + j]; }
        __syncthreads();
        if (tid < 64) {
            for (int t = 0; t < 64; ++t) { hstate = a_s[t * 64 + j] * hstate + u_s[t * 64 + j];
                const size_t row = (size_t)b * SEQ + t0 + t; const float gate = bf2f(proj[row * DING + C_RGG + c]);
                oraw[row * DM + 256 + c] = hstate * gelu_tanh(gate); }
        }
        __syncthreads();
    }
}

__device__ __forceinline__ void hg_chain(const bf16* proj, float* oraw, int b, int h, const float* lbp, int layer, LAS float* L, int tid) {
    constexpr int S = 65, A = 64 * S;
    LAS float* q_s = L; LAS float* k_s = L + A; LAS float* v_s = L + 2 * A; LAS float* bc_s = L + 3 * A; LAS float* sc_s = L + 4 * A; LAS float* st_s = L + 5 * A; LAS float* qe_s = L + 6 * A;
    const int j = tid & 63, tr = tid >> 6;
    float lb = 0.f;
    if (layer == 1) { const float x0 = lbp[h * 64 + j], x1 = lbp[256 + h * 64 + j], mx = fmaxf(x0, x1), e0 = expf(x0 - mx), e1 = expf(x1 - mx); lb = e1 / (e0 + e1); }
#pragma unroll
    for (int i = 0; i < 8; ++i) st_s[(tr + 8 * i) * S + j] = 0.f;
    __syncthreads();
    for (int ch = 0; ch < SEQ / 64; ++ch) {
        const int t0 = ch * 64;
#pragma unroll 1
        for (int i = 0; i < 8; ++i) { const int t = tr + 8 * i; const size_t row = (size_t)b * SEQ + t0 + t; const bf16* pp = proj + row * DING + h * 64 + j;
            const float qv = bf2f(pp[C_HGQ]), fv = bf2f(pp[C_HGF]), iv = bf2f(pp[C_HGI]);
            const float forget = lb + (1.0f - lb) * sigm(fv);
            q_s[t * S + j] = qv * sigm(qv); k_s[t * S + j] = 1.0f - forget; v_s[t * S + j] = iv; bc_s[t * S + j] = logf(forget); }
        __syncthreads();
        if (tid < 64) { float run = 0.f; for (int t = 0; t < 64; ++t) { run += bc_s[t * S + j]; bc_s[t * S + j] = run; } }
        __syncthreads();
#pragma unroll 1
        for (int i = 0; i < 8; ++i) { const int t = tr + 8 * i; qe_s[t * S + j] = q_s[t * S + j] * expf(bc_s[t * S + j]); }
#pragma unroll 1
        for (int i = 0; i < 8; ++i) { const int t = tr + 8 * i, s = j; float a = 0.f;
            if (s <= t) _Pragma("unroll 4") for (int c = 0; c < 64; ++c) a += q_s[t * S + c] * k_s[s * S + c] * expf(bc_s[t * S + c] - bc_s[s * S + c]);
            sc_s[t * S + s] = a; }
        __syncthreads();
#pragma unroll 1
        for (int i = 0; i < 8; ++i) { const int t = tr + 8 * i, v = j; float o = 0.f;
            _Pragma("unroll 4") for (int s = 0; s < 64; ++s) o += sc_s[t * S + s] * v_s[s * S + v];
            _Pragma("unroll 4") for (int c = 0; c < 64; ++c) o += qe_s[t * S + c] * st_s[c * S + v];
            oraw[((size_t)b * SEQ + t0 + t) * DM + 512 + h * 64 + v] = o; }
        __syncthreads();
#pragma unroll 1
        for (int i = 0; i < 8; ++i) { const int s = tr + 8 * i, c = j; sc_s[s * S + c] = k_s[s * S + c] * expf(bc_s[63 * S + c] - bc_s[s * S + c]); }
        __syncthreads();
#pragma unroll 1
        for (int i = 0; i < 8; ++i) { const int c = tr + 8 * i, v = j; float a = expf(bc_s[63 * S + c]) * st_s[c * S + v];
            _Pragma("unroll 4") for (int s = 0; s < 64; ++s) a += sc_s[s * S + c] * v_s[s * S + v];
            st_s[c * S + v] = a; }
        __syncthreads();
    }
}

__device__ __forceinline__ void m2_chain(const bf16* proj, const float* dtraw, float* oraw, int b, int h, const float* conv_w, const float* conv_b, const float* dt_bias,
                                         const float* a_log, const float* dskip, LAS float* L, int tid) {
    constexpr int SB = 129;
    LAS float* xs_s = L; LAS float* B_s = L + 4096; LAS float* C_s = B_s + 64 * SB; LAS float* W_s = C_s + 64 * SB; LAS float* st_s = W_s + 64 * 65;
    LAS float* dt_s = st_s + 64 * SB; LAS float* acs_s = dt_s + 64; LAS float* w_s = acs_s + 64;
    const int j = tid & 63, tr = tid >> 6, g = h >> 1;
    const float dtb = dt_bias[h], negA = -expf(a_log[h]), Dh = dskip[h];
    for (int idx = tid; idx < 64 * SB; idx += NTHR) st_s[idx] = 0.f;
    __syncthreads();
    for (int ch = 0; ch < SEQ / 64; ++ch) {
        const int t0 = ch * 64;
        for (int idx = tid; idx < 64 * 320; idx += NTHR) { const int cch = idx % 320, t = idx / 320;
            int col, cc; LAS float* dst;
            if (cch < 64) { cc = h * 64 + cch; dst = xs_s + t * 64 + cch; }
            else if (cch < 192) { cc = 256 + g * 128 + (cch - 64); dst = B_s + t * SB + (cch - 64); }
            else { cc = 512 + g * 128 + (cch - 192); dst = C_s + t * SB + (cch - 192); }
            col = C_M2X + cc;
            float a = conv_b[cc];
#pragma unroll
            for (int k = 0; k < 4; ++k) { const int ts = t0 + t - 3 + k; if (ts >= 0) a += conv_w[k * 768 + cc] * bf2f(proj[((size_t)b * SEQ + ts) * DING + col]); }
            *dst = a * sigm(a); }
        if (tid < 64) { const float dtv = softplusf_(dtraw[((size_t)b * SEQ + t0 + tid) * 4 + h] + dtb); dt_s[tid] = dtv;
            float v = dtv * negA;
#pragma unroll
            for (int o = 1; o < 64; o <<= 1) { const float nb = __shfl_up(v, o); if (tid >= o) v += nb; }
            acs_s[tid] = v; const float last = __shfl(v, 63); w_s[tid] = expf(last - v) * dtv; }
        __syncthreads();
#pragma unroll 1
        for (int i = 0; i < 8; ++i) { const int l = tr + 8 * i, s = j; float a = 0.f;
            if (s <= l) { _Pragma("unroll 4") for (int n = 0; n < 128; ++n) a += C_s[l * SB + n] * B_s[s * SB + n]; a *= expf(acs_s[l] - acs_s[s]); }
            W_s[l * 65 + s] = a; }
        __syncthreads();
#pragma unroll 1
        for (int i = 0; i < 8; ++i) { const int l = tr + 8 * i, p = j; float yd = 0.f, yo = 0.f;
            _Pragma("unroll 4") for (int s = 0; s < 64; ++s) yd += W_s[l * 65 + s] * (xs_s[s * 64 + p] * dt_s[s]);
            _Pragma("unroll 4") for (int n = 0; n < 128; ++n) yo += C_s[l * SB + n] * st_s[p * SB + n];
            const size_t row = (size_t)b * SEQ + t0 + l; const float zv = bf2f(proj[row * DING + C_M2Z + h * 64 + p]);
            const float y = yd + expf(acs_s[l]) * yo + xs_s[l * 64 + p] * Dh;
            oraw[row * DM + 768 + h * 64 + p] = y * (zv * sigm(zv)); }
        __syncthreads();
        { const int n = tid & 127, pq = tid >> 7; const float dec = expf(acs_s[63]);
#pragma unroll 1
            for (int i = 0; i < 16; ++i) { const int p = pq + 4 * i; float a = dec * st_s[p * SB + n];
                _Pragma("unroll 4") for (int s = 0; s < 64; ++s) a += B_s[s * SB + n] * (w_s[s] * xs_s[s * 64 + p]);
                st_s[p * SB + n] = a; } }
        __syncthreads();
    }
}

__device__ __forceinline__ void norm_row(const float* orow, const bf16* prow, bf16* mrow, const float* gA, const float* gB, const float* gC, const float* gD, int lane) {
    f32x4 v[4];
#pragma unroll
    for (int j = 0; j < 4; ++j) v[j] = *(const f32x4*)(orow + 256 * j + 4 * lane);
    float s[4];
#pragma unroll
    for (int j = 0; j < 4; ++j) s[j] = (v[j][0] * v[j][0] + v[j][1] * v[j][1]) + (v[j][2] * v[j][2] + v[j][3] * v[j][3]);
#pragma unroll
    for (int o = 1; o < 64; o <<= 1) { s[0] += __shfl_xor(s[0], o); s[1] += __shfl_xor(s[1], o); if (o < 16) s[2] += __shfl_xor(s[2], o); if (o < 32) s[3] += __shfl_xor(s[3], o); }
    const float r0 = 1.0f / sqrtf(s[0] * (1.0f / 256) + EPS), r1 = 1.0f / sqrtf(s[1] * (1.0f / 256) + EPS), r2 = 1.0f / sqrtf(s[2] * (1.0f / 64) + EPS), r3 = 1.0f / sqrtf(s[3] * (1.0f / 128) + EPS);
    const int c = 4 * lane;
    const f32x4 g0 = *(const f32x4*)(gA + c), g1 = *(const f32x4*)(gB + c), g2 = *(const f32x4*)(gC + c), g3 = *(const f32x4*)(gD + c);
    const u32x2 gw = *(const u32x2*)(prow + C_HGG + c);
    const float gi[4] = {bflo(gw.x), bfhi(gw.x), bflo(gw.y), bfhi(gw.y)};
    f32x4 o0 = v[0] * r0 * g0, o1 = v[1] * r1 * g1, o2 = v[2] * r2 * g2, o3 = v[3] * r3 * g3;
#pragma unroll
    for (int i = 0; i < 4; ++i) o2[i] *= gi[i] * sigm(gi[i]);
    u32x2 w;
    w.x = pk2(o0[0], o0[1]); w.y = pk2(o0[2], o0[3]); *(u32x2*)(mrow + c) = w;
    w.x = pk2(o1[0], o1[1]); w.y = pk2(o1[2], o1[3]); *(u32x2*)(mrow + 256 + c) = w;
    w.x = pk2(o2[0], o2[1]); w.y = pk2(o2[2], o2[3]); *(u32x2*)(mrow + 512 + c) = w;
    w.x = pk2(o3[0], o3[1]); w.y = pk2(o3[2], o3[3]); *(u32x2*)(mrow + 768 + c) = w;
}

__device__ __forceinline__ void router_row(const float* hrow, const float* g, const LAS float* rw_t, const float* rb, bf16* xn_row, gu32* cnt, int* asg_e, int* asg_p, float* gate, int lane) {
    f32x4 v[4]; float ss = 0.f;
#pragma unroll
    for (int j = 0; j < 4; ++j) { v[j] = *(const f32x4*)(hrow + 256 * j + 4 * lane); ss += (v[j][0] * v[j][0] + v[j][1] * v[j][1]) + (v[j][2] * v[j][2] + v[j][3] * v[j][3]); }
    ss = wave_sum(ss);
    const float rstd = 1.0f / sqrtf(ss * (1.0f / DM) + EPS);
#pragma unroll
    for (int j = 0; j < 4; ++j) { const int col = 256 * j + 4 * lane; v[j] = v[j] * rstd * *(const f32x4*)(g + col);
        u32x2 w; w.x = pk2(v[j][0], v[j][1]); w.y = pk2(v[j][2], v[j][3]); *(u32x2*)(xn_row + col) = w; }
    float lg[32];
#pragma unroll
    for (int e = 0; e < 32; ++e) { float p = 0.f;
#pragma unroll
        for (int j = 0; j < 4; ++j) { const f32x4 w = *(const LAS f32x4*)(rw_t + e * 1024 + 256 * j + 4 * lane); p += (v[j][0] * w[0] + v[j][1] * w[1]) + (v[j][2] * w[2] + v[j][3] * w[3]); }
        lg[e] = wave_sum(p) + rb[e]; }
    int be[4]; float bl[4];
#pragma unroll
    for (int r = 0; r < 4; ++r) { float best = -INFINITY; int bi = 0;
#pragma unroll
        for (int e = 0; e < 32; ++e) if (lg[e] > best) { best = lg[e]; bi = e; }
#pragma unroll
        for (int e = 0; e < 32; ++e) if (e == bi) lg[e] = -INFINITY;
        be[r] = bi; bl[r] = best; }
    const float e1 = expf(bl[1] - bl[0]), e2 = expf(bl[2] - bl[0]), e3 = expf(bl[3] - bl[0]), inv = 1.0f / (1.0f + e1 + e2 + e3);
    if (lane < 4) { const int e = lane == 0 ? be[0] : lane == 1 ? be[1] : lane == 2 ? be[2] : be[3];
        const float gg = (lane == 0 ? 1.0f : lane == 1 ? e1 : lane == 2 ? e2 : e3) * inv;
        const unsigned pos = __hip_atomic_fetch_add(cnt + e, 1u, __ATOMIC_RELAXED, __HIP_MEMORY_SCOPE_AGENT);
        asg_e[lane] = e; asg_p[lane] = (int)pos; gate[lane] = gg; }
}

__device__ __forceinline__ void build_tb(gu32* cnt, LAS int* tb, int tid) {
    if (tid == 0) { int run = 0; for (int e = 0; e < 32; ++e) { tb[e] = run; run += ((int)__hip_atomic_load(cnt + e, RLX_AGENT) + 255) >> 8; } tb[32] = run; }
    __syncthreads();
}

constexpr int NPHASE = 1 + 9 * DEPTH;
struct Args { const float* in[29]; float* out; unsigned char* ws; int ph_lo, ph_hi, use_bar, pad; };

typedef const __attribute__((address_space(4))) Args* KArgP;
__device__ __forceinline__ KArgP kargs() { KArgP p = (KArgP)__builtin_amdgcn_kernarg_segment_ptr(); asm volatile("" : "+s"(p)); return p; }
#define WSP(type, off) ((type*)(kargs()->ws + (off)))

__global__ void __launch_bounds__(NTHR, 2) fwd_kernel(Args args_unused) {
    extern __shared__ __attribute__((aligned(16))) unsigned char lds_raw[];
    LAS unsigned char* lds = (LAS unsigned char*)lds_raw;
    LAS float* ldsf = (LAS float*)lds_raw;
    volatile LAS unsigned* MISC = (volatile LAS unsigned*)(lds + MISC_OFF);
    LAS int* tb = (LAS int*)(lds + TB_OFF);
    const int tid0 = threadIdx.x;
#define PH_IDS int tid = threadIdx.x; asm volatile("" : "+v"(tid)); const int lane = tid & 63, wave = __builtin_amdgcn_readfirstlane(tid >> 6); const int gw = vcu * NWAVES + wave; (void)lane; (void)gw;
    const int G = gridDim.x, bx = blockIdx.x;
    const int vcu = (G % 8 == 0) ? (bx % 8) * (G / 8) + bx / 8 : bx;
    const int NGW = G * NWAVES;
    gu32* ctl = (gu32*)WSP(unsigned char, WS_CTL);

    for (int u = tid0; u < (LDS_BYTES - LDSCTL_OFF) / 4; u += NTHR) ((LAS unsigned*)(lds + LDSCTL_OFF))[u] = 0u;
    __syncthreads();
    XcdBarrier bar; bar.bar = (unsigned*)(ctl + CW_BAR); bar.x = 0; bar.st = nullptr;
    if (kargs()->use_bar) bar = xcd_barrier_post((unsigned*)(ctl + CW_BAR), MISC + 8);
    const int lo = kargs()->ph_lo, hi = kargs()->ph_hi;
#ifndef PH_MASK
#define PH_MASK 0x3ff
#endif
#define IN(k) (lo <= (k) && (k) < hi)
#define EN(ty) ((PH_MASK >> (ty)) & 1)
#define SEAM(k) do { if (IN(k) && IN((k) + 1)) xcd_barrier(bar); } while (0)

    if (EN(9) && IN(0)) { PH_IDS
        LAS float* scr = ldsf + wave * (64 * 65);
        for (int it = gw; it < NITEMS; it += NGW) {
            int r = it;
            if (r < NIT_WIN) { const int l = r / IT_WIN, q = r % IT_WIN; transpose_item<false>(kargs()->in[2] + (size_t)l * DM * DIN, DIN, WSP(bf16, WS_WIN) + (size_t)l * DING * DM, DM, 64 * (q / 52), 64 * (q % 52), scr, lane); continue; }
            r -= NIT_WIN;
            if (r < NIT_WOUT) { const int l = r / IT_WOUT, q = r % IT_WOUT; transpose_item<false>(kargs()->in[20] + (size_t)l * DM * DM, DM, WSP(bf16, WS_WOUT) + (size_t)l * DM * DM, DM, 64 * (q / 16), 64 * (q % 16), scr, lane); continue; }
            r -= NIT_WOUT;
            if (r < NIT_GU) { const int le = r / IT_GU, q = r % IT_GU; transpose_item<true>(kargs()->in[24] + (size_t)le * DM * 2048, 2048, WSP(bf16, WS_WGU) + (size_t)le * 2048 * DM, DM, 64 * (q / 32), 64 * (q % 32), scr, lane); continue; }
            r -= NIT_GU;
            { const int le = r / IT_DN, q = r % IT_DN; transpose_item<false>(kargs()->in[26] + (size_t)le * DFF * DM, DM, WSP(bf16, WS_WDN) + (size_t)le * DM * DFF, DFF, 64 * (q / 16), 64 * (q % 16), scr, lane); }
        }
        for (int m = gw; m < T; m += NGW) { f32x4 v[4];
#pragma unroll
            for (int j = 0; j < 4; ++j) v[j] = *(const f32x4*)(kargs()->in[0] + (size_t)m * DM + 256 * j + 4 * lane);
            emit_xn_dt(v, kargs()->in[1], kargs()->in[2], WSP(bf16, WS_XN) + (size_t)m * DM, WSP(float, WS_DT) + (size_t)m * 4, lane); }
    }
    SEAM(0);

#pragma unroll 1
    for (int l = 0; l < DEPTH; ++l) {
        const int P = 1 + 9 * l;
        if (EN(0) && IN(P)) { PH_IDS
            pg8::Gemm g{WSP(bf16, WS_XN), WSP(bf16, WS_WIN) + (size_t)l * DING * DM, T, DING, DM}; pg8::StaticOrder S; S.init(T, DING, G, bx);
            pg8::EpiBf16 E{WSP(bf16, WS_PROJ), DING, nullptr, 0};
            pg8::gemm_phase<pg8::EpiBf16, pg8::StaticOrder, true, true>(lds, g, S, E);
        }
        SEAM(P);
        if (EN(1) && IN(P + 1)) { PH_IDS
            if (vcu < 32) rg_chain(WSP(bf16, WS_PROJ), WSP(float, WS_ORAW), vcu >> 2, vcu & 3, kargs()->in[4] + l * 1024, kargs()->in[5] + l * 256, kargs()->in[6] + l * 16384, kargs()->in[7] + l * 256, kargs()->in[8] + l * 16384, kargs()->in[9] + l * 256, kargs()->in[10] + l * 256, ldsf, tid);
            else if (vcu < 64) hg_chain(WSP(bf16, WS_PROJ), WSP(float, WS_ORAW), (vcu - 32) >> 2, (vcu - 32) & 3, kargs()->in[12], l, ldsf, tid);
            else if (vcu < 96) m2_chain(WSP(bf16, WS_PROJ), WSP(float, WS_DT), WSP(float, WS_ORAW), (vcu - 64) >> 2, (vcu - 64) & 3, kargs()->in[14] + l * 3072, kargs()->in[15] + l * 768, kargs()->in[16] + l * 4, kargs()->in[17] + l * 4, kargs()->in[18] + l * 4, ldsf, tid);
            else { const int aw = (vcu - 96) * NWAVES + wave, naw = (G - 96) * NWAVES;
                for (int u = aw; u < 1024; u += naw) { const int qb = 31 - (u >> 5), bh = u & 31; attn_naive(WSP(bf16, WS_PROJ), WSP(float, WS_ORAW), bh >> 2, bh & 3, qb, lane); } }
        }
        SEAM(P + 1);
        if (EN(2) && IN(P + 2)) { PH_IDS
            _Pragma("unroll 1") for (int m = gw; m < T; m += NGW) norm_row(WSP(float, WS_ORAW) + (size_t)m * DM, WSP(bf16, WS_PROJ) + (size_t)m * DING, WSP(bf16, WS_MIX) + (size_t)m * DM, kargs()->in[3] + l * 256, kargs()->in[11] + l * 256, kargs()->in[13] + l * 256, kargs()->in[19] + l * 256, lane);
        }
        SEAM(P + 2);
        if (EN(3) && IN(P + 3)) { PH_IDS
            pg8::Gemm g{WSP(bf16, WS_MIX), WSP(bf16, WS_WOUT) + (size_t)l * DM * DM, T, DM, DM}; pg8::StaticOrder S; S.init(T, DM, G, bx);
            pg8::EpiResF32 E{l == 0 ? kargs()->in[0] : WSP(float, WS_HB), WSP(float, WS_H1), DM};
            pg8::gemm_phase<pg8::EpiResF32, pg8::StaticOrder, true, true>(lds, g, S, E);
        }
        SEAM(P + 3);
        if (EN(4) && IN(P + 4)) { PH_IDS
            const float* rw = kargs()->in[22] + (size_t)l * DM * NE;
            for (int idx = tid; idx < NE * DM; idx += NTHR) { const int e = idx >> 10, k = idx & 1023; ldsf[idx] = rw[k * NE + e]; }
            __syncthreads();
            _Pragma("unroll 1") for (int m = gw; m < T; m += NGW) { asm volatile("" ::: "memory"); router_row(WSP(float, WS_H1) + (size_t)m * DM, kargs()->in[21] + l * DM, ldsf, kargs()->in[23] + l * NE, WSP(bf16, WS_XN) + (size_t)m * DM, ctl + CW_CNT + l * 32, WSP(int, WS_ASGE) + m * 4, WSP(int, WS_ASGP) + m * 4, WSP(float, WS_GATE) + m * 4, lane); }
        }
        SEAM(P + 4);
        if (EN(5) && IN(P + 5)) { PH_IDS
            build_tb(ctl + CW_CNT + l * 32, tb, tid);
            for (int a = gw; a < NASG; a += NGW) { const int e = WSP(int, WS_ASGE)[a], p = WSP(int, WS_ASGP)[a], slot = tb[e] * 256 + p, t = a >> 2;
                const v4u* src = (const v4u*)(WSP(bf16, WS_XN) + (size_t)t * DM); v4u* dst = (v4u*)(WSP(bf16, WS_XS) + (size_t)slot * DM);
                const v4u a0 = src[lane], a1 = src[lane + 64]; dst[lane] = a0; dst[lane + 64] = a1;
                if (lane == 0) WSP(int, WS_SLOT)[a] = slot; }
        }
        SEAM(P + 5);
        if (EN(6) && IN(P + 6)) { PH_IDS
            build_tb(ctl + CW_CNT + l * 32, tb, tid);
            pg8::Gemm g{WSP(bf16, WS_XS), WSP(bf16, WS_WGU) + (size_t)l * NE * 2048 * DM, MAXSLOT, 2048, DM}; pg8::MoeOrder S{(const LAS int*)tb, 8, G, bx};
            pg8::EpiSwiglu E{WSP(bf16, WS_ACT), kargs()->in[25] + (size_t)l * NE * 2048};
            pg8::gemm_phase<pg8::EpiSwiglu, pg8::MoeOrder, true, true>(lds, g, S, E);
        }
        SEAM(P + 6);
        if (EN(7) && IN(P + 7)) { PH_IDS
            build_tb(ctl + CW_CNT + l * 32, tb, tid);
            pg8::Gemm g{WSP(bf16, WS_ACT), WSP(bf16, WS_WDN) + (size_t)l * NE * DM * DFF, MAXSLOT, DM, DFF}; pg8::MoeOrder S{(const LAS int*)tb, 4, G, bx};
            pg8::EpiBf16 E{WSP(bf16, WS_Y), DM, kargs()->in[27] + (size_t)l * NE * DM, DM};
            pg8::gemm_phase<pg8::EpiBf16, pg8::MoeOrder, true, true>(lds, g, S, E);
        }
        SEAM(P + 7);
        if (EN(8) && IN(P + 8)) { PH_IDS
            for (int m = gw; m < T; m += NGW) { f32x4 v[4];
#pragma unroll
                for (int j = 0; j < 4; ++j) v[j] = *(const f32x4*)(WSP(float, WS_H1) + (size_t)m * DM + 256 * j + 4 * lane);
#pragma unroll
                for (int r = 0; r < 4; ++r) { const int slot = WSP(int, WS_SLOT)[m * 4 + r]; const float gg = WSP(float, WS_GATE)[m * 4 + r]; const bf16* yr = WSP(bf16, WS_Y) + (size_t)slot * DM;
#pragma unroll
                    for (int j = 0; j < 4; ++j) { const u32x2 w = *(const u32x2*)(yr + 256 * j + 4 * lane); v[j][0] += gg * bflo(w.x); v[j][1] += gg * bfhi(w.x); v[j][2] += gg * bflo(w.y); v[j][3] += gg * bfhi(w.y); } }
                if (l + 1 < DEPTH) {
#pragma unroll
                    for (int j = 0; j < 4; ++j) *(f32x4*)(WSP(float, WS_HB) + (size_t)m * DM + 256 * j + 4 * lane) = v[j];
                    emit_xn_dt(v, kargs()->in[1] + (l + 1) * DM, kargs()->in[2] + (size_t)(l + 1) * DM * DIN, WSP(bf16, WS_XN) + (size_t)m * DM, WSP(float, WS_DT) + (size_t)m * 4, lane);
                } else { float ss = 0.f;
#pragma unroll
                    for (int j = 0; j < 4; ++j) ss += (v[j][0] * v[j][0] + v[j][1] * v[j][1]) + (v[j][2] * v[j][2] + v[j][3] * v[j][3]);
                    ss = wave_sum(ss); const float rstd = 1.0f / sqrtf(ss * (1.0f / DM) + EPS);
#pragma unroll
                    for (int j = 0; j < 4; ++j) *(f32x4*)(kargs()->out + (size_t)m * DM + 256 * j + 4 * lane) = v[j] * rstd * *(const f32x4*)(kargs()->in[28] + 256 * j + 4 * lane); }
            }
        }
        if (l + 1 < DEPTH) SEAM(P + 8);
    }
#undef IN
#undef SEAM
}

extern "C" void kernel_launch(void* const* d_in, const int* in_sizes, int n_in, void* d_out, int out_size, void* d_ws, size_t ws_size, hipStream_t stream) {
    static int grid = 0;
    if (grid == 0) {
        if (n_in != 29 || in_sizes[0] != T * DM || out_size != T * DM || ws_size < WS_END) { fprintf(stderr, "kernel_launch: unexpected shapes (n_in %d, in0 %d, out %d, ws %zu); nothing launched\n", n_in, n_in > 0 ? in_sizes[0] : -1, out_size, ws_size); grid = -1; return; }
        int dev = 0, cus = 0, per_cu = 0;
        if (hipGetDevice(&dev) != hipSuccess || hipDeviceGetAttribute(&cus, hipDeviceAttributeMultiprocessorCount, dev) != hipSuccess) { grid = -1; return; }
        if (hipFuncSetAttribute((const void*)fwd_kernel, hipFuncAttributeMaxDynamicSharedMemorySize, LDS_BYTES) != hipSuccess) { fprintf(stderr, "kernel_launch: hipFuncSetAttribute failed\n"); grid = -1; return; }
        if (hipOccupancyMaxActiveBlocksPerMultiprocessor(&per_cu, (const void*)fwd_kernel, NTHR, LDS_BYTES) != hipSuccess || per_cu < 1) fprintf(stderr, "kernel_launch: occupancy query reports %d\n", per_cu);
        (void)hipGetLastError();
        grid = cus;
    }
    if (grid < 0) return;
    if (hipMemsetAsync((char*)d_ws + WS_CTL, 0, CTL_ZERO_BYTES, stream) != hipSuccess) { fprintf(stderr, "kernel_launch: memset failed\n"); return; }
    Args a{};
    for (int i = 0; i < 29; ++i) a.in[i] = (const float*)d_in[i];
    a.out = (float*)d_out; a.ws = (unsigned char*)d_ws;
#if MK_N_LAUNCHES == 1
    a.ph_lo = 0; a.ph_hi = NPHASE; a.use_bar = 1;
    hipLaunchKernelGGL(fwd_kernel, dim3(grid), dim3(NTHR), LDS_BYTES, stream, a);
#else
    for (int p = 0; p < NPHASE; ++p) { a.ph_lo = p; a.ph_hi = p + 1; a.use_bar = 0; hipLaunchKernelGGL(fwd_kernel, dim3(grid), dim3(NTHR), LDS_BYTES, stream, a); }
#endif
}
```

```cpp
#include <hip/hip_runtime.h>
#include <cstdio>
#include <cstdint>

#ifndef MK_N_LAUNCHES
#define MK_N_LAUNCHES 1
#endif

constexpr int NB = 8, SEQ = 2048, DM = 1024, T = NB * SEQ, DEPTH = 2;
constexpr int DIN = 3332, DING = 3328;
constexpr int NE = 32, TOPK = 4, DFF = 1024;
constexpr int NASG = T * TOPK;
constexpr int MAXSLOT = NASG + NE * 256;
constexpr float EPS = 1e-6f;
constexpr int C_SBQ = 0, C_SBK = 256, C_SBV = 512, C_RGX = 768, C_RGG = 1024, C_HGQ = 1280, C_HGF = 1536, C_HGI = 1792, C_HGG = 2048,
              C_M2Z = 2304, C_M2X = 2560, C_DT = 3328;
constexpr int NWAVES = 8, NTHR = 512;

constexpr size_t MiB = 1u << 20;
constexpr size_t WS_CTL = 0, CTL_ZERO_BYTES = 1 * MiB;
constexpr size_t WS_WIN = 2 * MiB;
constexpr size_t WS_WOUT = 16 * MiB;
constexpr size_t WS_WGU = 32 * MiB;
constexpr size_t WS_WDN = 288 * MiB;
constexpr size_t WS_XN = 416 * MiB;
constexpr size_t WS_PROJ = 448 * MiB;
constexpr size_t WS_ORAW = 552 * MiB;
constexpr size_t WS_MIX = 616 * MiB;
constexpr size_t WS_H1 = 648 * MiB;
constexpr size_t WS_HB = 712 * MiB;
constexpr size_t WS_XS = 776 * MiB;
constexpr size_t WS_ACT = 920 * MiB;
constexpr size_t WS_Y = 1064 * MiB;
constexpr size_t WS_DT = 1208 * MiB;
constexpr size_t WS_ASGE = 1209 * MiB;
constexpr size_t WS_ASGP = 1210 * MiB;
constexpr size_t WS_GATE = 1211 * MiB;
constexpr size_t WS_SLOT = 1212 * MiB;
constexpr size_t WS_SLOC = 1216 * MiB;
constexpr size_t WS_DEC = 1248 * MiB;
constexpr size_t WS_SLT = 1250 * MiB;
constexpr size_t WS_DECC = 1266 * MiB;
constexpr size_t WS_HLOC = 1268 * MiB;
constexpr size_t WS_PCUM = 1284 * MiB;
constexpr size_t WS_RGS = 1300 * MiB;
constexpr size_t WS_CARRY = 1301 * MiB;
constexpr size_t WS_WAT = 1302 * MiB;
constexpr size_t WS_HIST = 1303 * MiB;
constexpr size_t WS_TOT = WS_HIST + 512 * 1024;
constexpr size_t WS_END = 1304 * MiB;
constexpr int CW_TMO = 0, CW_CODE = 1;
constexpr int CW_CNT = 256;
constexpr int CW_BAR = 4096;

constexpr int LDS_BYTES = 147456;
constexpr int LDSCTL_OFF = LDS_BYTES - 1024;
constexpr int MISC_OFF = LDSCTL_OFF;
constexpr int TB_OFF = LDSCTL_OFF + 256;

namespace pg8 {
#define PG8_LAS __attribute__((address_space(3)))
typedef unsigned short bf16_t;
typedef short bf16x8 __attribute__((ext_vector_type(8)));
typedef float f32x4 __attribute__((ext_vector_type(4)));
typedef unsigned u32x4 __attribute__((ext_vector_type(4)));
constexpr int BM = 256, BK = 64, HALF = 128, HTB = HALF * BK * 2  , STAGE_BYTES = 8 * HTB, NXCD = 8, WGM = 8;

__host__ __device__ __forceinline__ int lds_byte(int r, int c) { const int st = (r >> 4) * 2 + (c >> 5), rr = r & 15, cc = c & 31, ob = rr * 64 + cc * 2; return st * 1024 + (ob ^ (((ob >> 9) & 1) << 5)); }
__host__ __device__ __forceinline__ void stage_rc(int b, int& R, int& C) { const int st = b / 1024, sb = b % 1024, swz = sb ^ (((sb >> 9) & 1) << 5); R = (st >> 1) * 16 + swz / 64; C = (st & 1) * 32 + (swz % 64) / 2; }
__host__ __device__ __forceinline__ int perm32(int rho) { const int n = rho >> 4, i = rho & 15; return 8 * (i >> 2) + 4 * n + (i & 3); }

struct Unit { int pm, pn, pb, e; };
struct Gemm { const bf16_t* A; const bf16_t* Bt; int M, N, K; };

__host__ __device__ __forceinline__ int xcd_remap(int wgid, int nwg) { const int q = nwg / NXCD, r = nwg % NXCD, xcd = wgid % NXCD, off = wgid / NXCD; return (xcd < r ? xcd * (q + 1) : r * (q + 1) + (xcd - r) * q) + off; }

struct StaticOrder {
    int nM, nN, nwg, G, c;
    __host__ __device__ void init(int M, int N, int G_, int c_) { nM = M / BM; nN = N / BM; nwg = nM * nN; G = G_; c = c_; }
    __host__ __device__ bool next(int i, Unit& u) const {
        const long L = (long)i * G + c; if (L >= nwg) return false;
        const int wgid = xcd_remap((int)L, nwg);
        const int nig = WGM * nN, gid = wgid / nig, fm = gid * WGM, gsz = (nM - fm) < WGM ? (nM - fm) : WGM;
        u.pm = fm + ((wgid % nig) % gsz); u.pn = (wgid % nig) / gsz; u.pb = u.pn; u.e = 0; return true;
    }
    __device__ __forceinline__ void a_ready(const Unit&) const {}
    __device__ __forceinline__ void done(const Unit&) const {}
};
struct MoeOrder {
    const PG8_LAS int* tb; int NP, G, c;
    __device__ __forceinline__ bool next(int i, Unit& u) const {
        const int ntot = tb[32], nunits = ntot * NP;
        const long L = (long)i * G + c; if (L >= nunits) return false;
        const int id = xcd_remap((int)L, nunits);
        int e = 0;
        for (int j = 1; j < 32; ++j) if (id >= tb[j] * NP) e = j;
        e = __builtin_amdgcn_readfirstlane(e);
        const int t0 = tb[e], nt = tb[e + 1] - t0, rem = id - t0 * NP;
        u.pm = __builtin_amdgcn_readfirstlane(t0 + rem % nt); u.pn = __builtin_amdgcn_readfirstlane(rem / nt); u.pb = e * NP + u.pn; u.e = e; return true;
    }
    __device__ __forceinline__ void a_ready(const Unit&) const {}
    __device__ __forceinline__ void done(const Unit&) const {}
};

__device__ __forceinline__ unsigned cvt_pk_bf16(float lo, float hi) { unsigned r; asm volatile("v_cvt_pk_bf16_f32 %0, %1, %2" : "=v"(r) : "v"(lo), "v"(hi)); return r; }

struct EpiBf16 {
    static constexpr bool PERM = true, AFTER_DRAIN = false;
    bf16_t* O; int ldc; const float* bias; int bias_estride;
    __device__ __forceinline__ void operator()(const f32x4 (&acc)[2][2][4][2], const Unit& u, int wr, int wc, int fr, int fq) const {
        const int row0 = u.pm * BM + wr * 64 + fr; const int col0 = u.pn * BM + wc * 32 + 8 * fq;
        f32x4 bv[2][2];
#pragma unroll
        for (int bj = 0; bj < 2; ++bj)
#pragma unroll
            for (int n = 0; n < 2; ++n) bv[bj][n] = bias ? *(const f32x4*)(bias + (size_t)u.e * bias_estride + col0 + bj * HALF + 4 * n) : (f32x4){0.f, 0.f, 0.f, 0.f};
#pragma unroll
        for (int ai = 0; ai < 2; ++ai)
#pragma unroll
            for (int m = 0; m < 4; ++m) { bf16_t* rowp = O + (size_t)(row0 + ai * HALF + m * 16) * ldc + col0;
#pragma unroll
                for (int bj = 0; bj < 2; ++bj) { const f32x4 v0 = acc[ai][bj][m][0] + bv[bj][0], v1 = acc[ai][bj][m][1] + bv[bj][1];
                    u32x4 w; w.x = cvt_pk_bf16(v0[0], v0[1]); w.y = cvt_pk_bf16(v0[2], v0[3]); w.z = cvt_pk_bf16(v1[0], v1[1]); w.w = cvt_pk_bf16(v1[2], v1[3]);
                    *(u32x4*)(rowp + bj * HALF) = w; } }
    }
};
struct EpiResF32 {
    static constexpr bool PERM = false, AFTER_DRAIN = false;
    const float* base; float* out; int ldc;
    __device__ __forceinline__ void operator()(const f32x4 (&acc)[2][2][4][2], const Unit& u, int wr, int wc, int fr, int fq) const {
        const int row0 = u.pm * BM + wr * 64 + fr, col0 = u.pn * BM + wc * 32 + 4 * fq;
#pragma unroll
        for (int ai = 0; ai < 2; ++ai)
#pragma unroll
            for (int m = 0; m < 4; ++m) { const size_t off = (size_t)(row0 + ai * HALF + m * 16) * ldc + col0;
#pragma unroll
                for (int bj = 0; bj < 2; ++bj)
#pragma unroll
                    for (int n = 0; n < 2; ++n) { const f32x4 b = *(const f32x4*)(base + off + bj * HALF + n * 16); *(f32x4*)(out + off + bj * HALF + n * 16) = b + acc[ai][bj][m][n]; } }
    }
};
struct EpiSwiglu {
    static constexpr bool PERM = true, AFTER_DRAIN = false;
    bf16_t* O; const float* bias;
    __device__ __forceinline__ void operator()(const f32x4 (&acc)[2][2][4][2], const Unit& u, int wr, int wc, int fr, int fq) const {
        const int row0 = u.pm * BM + wr * 64 + fr; const int a0 = u.pn * HALF + wc * 32 + 8 * fq;
        const float* bp = bias + (size_t)u.e * 2048 + 2 * a0;
        f32x4 b4[4];
#pragma unroll
        for (int j = 0; j < 4; ++j) b4[j] = *(const f32x4*)(bp + 4 * j);
#pragma unroll
        for (int ai = 0; ai < 2; ++ai)
#pragma unroll
            for (int m = 0; m < 4; ++m) { bf16_t* rowp = O + (size_t)(row0 + ai * HALF + m * 16) * 1024 + a0;
                float a[8];
#pragma unroll
                for (int n = 0; n < 2; ++n)
#pragma unroll
                    for (int i = 0; i < 4; ++i) { const int k = 4 * n + i;
                        float g = acc[ai][0][m][n][i] + b4[k >> 1][2 * (k & 1)], l = acc[ai][1][m][n][i] + b4[k >> 1][2 * (k & 1) + 1];
                        g = fminf(g, 7.0f); l = fminf(fmaxf(l, -7.0f), 7.0f);
                        const float sg = __builtin_amdgcn_rcpf(1.0f + __builtin_amdgcn_exp2f(-1.702f * 1.4426950408889634f * g));
                        a[k] = g * sg * (l + 1.0f); }
                u32x4 w; w.x = cvt_pk_bf16(a[0], a[1]); w.y = cvt_pk_bf16(a[2], a[3]); w.z = cvt_pk_bf16(a[4], a[5]); w.w = cvt_pk_bf16(a[6], a[7]);
                *(u32x4*)rowp = w; }
    }
};

template <class Epi, class Sched, bool ALIGN_EPI = false, bool SP2 = false>
__device__ __forceinline__ void gemm_phase(PG8_LAS unsigned char* lds, const Gemm g, const Sched& S, const Epi& E) {
    int tid = threadIdx.x; asm volatile("" : "+v"(tid));
    const int wid = __builtin_amdgcn_readfirstlane(tid >> 6), lane = tid & 63, wr = wid >> 2, wc = wid & 3, fr = lane & 15, fq = lane >> 4;
    const int K = g.K, nt = K / BK;
    unsigned voffA[2], voffB[2];
#pragma unroll
    for (int i = 0; i < 2; ++i) { int R, C; stage_rc(tid * 16 + i * 8192, R, C); const int Rb = Epi::PERM ? ((R & ~31) + perm32(R & 31)) : R;
        voffA[i] = (unsigned)(R * K + C) * 2u; voffB[i] = (unsigned)(Rb * K + C) * 2u; }
    const size_t kstep = (size_t)(BK * 2);
    const size_t hstep = (size_t)HALF * K * 2;
    const size_t tstep = 2 * hstep;
    const unsigned ldsw = (unsigned)wid * 1024u;
    const int aoff = lds_byte(wr * 64 + fr, fq * 8), boff = lds_byte(wc * 32 + fr, fq * 8);
#define PG8_SA(b, h) (((b) * 2 + (h)) * HTB)
#define PG8_SB(b, h) ((4 + (b) * 2 + (h)) * HTB)
#define PG8_STAGE(bufoff, gbase, voff) do { _Pragma("unroll") for (int _i = 0; _i < 2; ++_i) \
        __builtin_amdgcn_global_load_lds((const unsigned*)((const char*)(gbase) + (voff)[_i]), (PG8_LAS unsigned*)(lds + (bufoff) + ldsw + _i * 8192), 16, 0, 0); } while (0)
#define PG8_LDA(dst, b, h) do { _Pragma("unroll") for (int m = 0; m < 4; ++m) _Pragma("unroll") for (int k = 0; k < 2; ++k) dst[m][k] = *(const PG8_LAS bf16x8*)(lds + PG8_SA(b, h) + aoff + m * 2048 + k * 1024); } while (0)
#define PG8_LDB(dst, b, h) do { _Pragma("unroll") for (int n = 0; n < 2; ++n) _Pragma("unroll") for (int k = 0; k < 2; ++k) dst[n][k] = *(const PG8_LAS bf16x8*)(lds + PG8_SB(b, h) + boff + n * 2048 + k * 1024); } while (0)
#define PG8_MMA(ai, bj, At, Bt) do { __builtin_amdgcn_s_setprio(1); _Pragma("unroll") for (int m = 0; m < 4; ++m) _Pragma("unroll") for (int n = 0; n < 2; ++n) _Pragma("unroll") for (int k = 0; k < 2; ++k) \
        acc[ai][bj][m][n] = __builtin_amdgcn_mfma_f32_16x16x32_bf16(Bt[n][k], At[m][k], acc[ai][bj][m][n], 0, 0, 0); __builtin_amdgcn_s_setprio(0); } while (0)
#define PG8_WAIT_V(n) asm volatile("s_waitcnt vmcnt(" #n ")" ::: "memory")
#define PG8_WAIT_L(n) asm volatile("s_waitcnt lgkmcnt(" #n ")" ::: "memory")
#define PG8_BAR __builtin_amdgcn_s_barrier()
#define PG8_SCHED __builtin_amdgcn_sched_barrier(0)
    Unit cur, nxt; int ui = 0;
    if (!S.next(0, cur)) return;
    f32x4 acc[2][2][4][2];
#pragma unroll
    for (int a = 0; a < 2; ++a)
#pragma unroll
        for (int b = 0; b < 2; ++b)
#pragma unroll
            for (int m = 0; m < 4; ++m)
#pragma unroll
                for (int n = 0; n < 2; ++n) acc[a][b][m][n] = (f32x4){0.f, 0.f, 0.f, 0.f};
    bf16x8 At[4][2], B0[2][2], B1[2][2];
    const char* cA = (const char*)g.A + (size_t)cur.pm * tstep; const char* cB = (const char*)g.Bt + (size_t)cur.pb * tstep;
    S.a_ready(cur);
    if constexpr (SP2) {
        PG8_STAGE(PG8_SB(0, 0), cB, voffB); PG8_STAGE(PG8_SB(0, 1), cB + hstep, voffB); PG8_STAGE(PG8_SA(0, 0), cA, voffA); PG8_STAGE(PG8_SA(0, 1), cA + hstep, voffA);
        if (wr == 1) PG8_BAR;
        PG8_WAIT_V(2); PG8_BAR;
        PG8_STAGE(PG8_SB(1, 0), cB + kstep, voffB); PG8_STAGE(PG8_SA(1, 0), cA + kstep, voffA); PG8_STAGE(PG8_SB(1, 1), cB + hstep + kstep, voffB);
        PG8_WAIT_V(6); PG8_BAR;
    } else {
        PG8_STAGE(PG8_SB(0, 0), cB, voffB); PG8_STAGE(PG8_SA(0, 0), cA, voffA); PG8_STAGE(PG8_SB(0, 1), cB + hstep, voffB); PG8_STAGE(PG8_SA(0, 1), cA + hstep, voffA);
        if (wr == 1) PG8_BAR;
        PG8_WAIT_V(4); PG8_BAR;
        PG8_STAGE(PG8_SB(1, 0), cB + kstep, voffB); PG8_STAGE(PG8_SA(1, 0), cA + kstep, voffA); PG8_STAGE(PG8_SB(1, 1), cB + hstep + kstep, voffB);
        PG8_WAIT_V(6); PG8_BAR;
    }
    for (;;) {
        const bool has_next = S.next(ui + 1, nxt);
        const char* nA = has_next ? (const char*)g.A + (size_t)nxt.pm * tstep : cA; const char* nB = has_next ? (const char*)g.Bt + (size_t)nxt.pb * tstep : cB;
        for (int t = 0; t < nt; t += 2) {
            const bool last = (t == nt - 2);
            const char* a1 = cA + (size_t)(t + 1) * kstep;
            const char* a2 = last ? nA : cA + (size_t)(t + 2) * kstep; const char* b2 = last ? nB : cB + (size_t)(t + 2) * kstep;
            const char* a3 = a2 + kstep; const char* b3 = b2 + kstep;
            if (last && has_next) S.a_ready(nxt);
            if constexpr (SP2) {
            PG8_LDB(B0, 0, 0); PG8_LDB(B1, 0, 1); PG8_SCHED; PG8_LDA(At, 0, 0); PG8_STAGE(PG8_SA(1, 1), a1 + hstep, voffA);
            PG8_WAIT_V(8); PG8_WAIT_L(0); PG8_BAR; PG8_MMA(0, 0, At, B0); PG8_MMA(0, 1, At, B1); PG8_BAR; PG8_SCHED;
            PG8_LDA(At, 0, 1); PG8_STAGE(PG8_SB(0, 0), b2, voffB); PG8_STAGE(PG8_SB(0, 1), b2 + hstep, voffB); PG8_STAGE(PG8_SA(0, 0), a2, voffA);
            PG8_WAIT_V(8); PG8_WAIT_L(0); PG8_BAR; PG8_MMA(1, 0, At, B0); PG8_MMA(1, 1, At, B1); PG8_BAR; PG8_SCHED;
            PG8_LDB(B0, 1, 0); PG8_LDB(B1, 1, 1); PG8_SCHED; PG8_LDA(At, 1, 0); PG8_STAGE(PG8_SA(0, 1), a2 + hstep, voffA);
            PG8_WAIT_V(8); PG8_WAIT_L(0); PG8_BAR; PG8_MMA(0, 0, At, B0); PG8_MMA(0, 1, At, B1); PG8_BAR; PG8_SCHED;
            PG8_LDA(At, 1, 1); PG8_STAGE(PG8_SB(1, 0), b3, voffB); PG8_STAGE(PG8_SB(1, 1), b3 + hstep, voffB); PG8_STAGE(PG8_SA(1, 0), a3, voffA);
            PG8_WAIT_V(8); PG8_WAIT_L(0); PG8_BAR; PG8_MMA(1, 0, At, B0); PG8_MMA(1, 1, At, B1); PG8_BAR; PG8_SCHED;
            } else {
            PG8_LDB(B0, 0, 0); PG8_SCHED; PG8_LDA(At, 0, 0); PG8_STAGE(PG8_SA(1, 1), a1 + hstep, voffA);
            PG8_WAIT_L(8); PG8_BAR; PG8_WAIT_L(0); PG8_MMA(0, 0, At, B0); PG8_BAR; PG8_SCHED;
            PG8_LDB(B1, 0, 1); PG8_STAGE(PG8_SB(0, 0), b2, voffB);
            PG8_BAR; PG8_WAIT_L(0); PG8_MMA(0, 1, At, B1); PG8_BAR;
            PG8_LDA(At, 0, 1); PG8_STAGE(PG8_SA(0, 0), a2, voffA);
            PG8_BAR; PG8_WAIT_L(0); PG8_MMA(1, 0, At, B0); PG8_BAR; PG8_SCHED;
            PG8_STAGE(PG8_SB(0, 1), b2 + hstep, voffB);
            PG8_WAIT_V(6); PG8_BAR; PG8_MMA(1, 1, At, B1); PG8_BAR;
            PG8_LDB(B0, 1, 0); PG8_SCHED; PG8_LDA(At, 1, 0); PG8_STAGE(PG8_SA(0, 1), a2 + hstep, voffA);
            PG8_WAIT_L(8); PG8_BAR; PG8_WAIT_L(0); PG8_MMA(0, 0, At, B0); PG8_BAR; PG8_SCHED;
            PG8_LDB(B1, 1, 1); PG8_STAGE(PG8_SB(1, 0), b3, voffB);
            PG8_BAR; PG8_WAIT_L(0); PG8_MMA(0, 1, At, B1); PG8_BAR;
            PG8_LDA(At, 1, 1); PG8_STAGE(PG8_SA(1, 0), a3, voffA);
            PG8_BAR; PG8_WAIT_L(0); PG8_MMA(1, 0, At, B0); PG8_BAR; PG8_SCHED;
            PG8_STAGE(PG8_SB(1, 1), b3 + hstep, voffB);
            PG8_WAIT_V(6); PG8_BAR; PG8_MMA(1, 1, At, B1); PG8_BAR;
            }
        }
        if constexpr (ALIGN_EPI) { if (wr == 0) PG8_BAR; }
        if constexpr (!Epi::AFTER_DRAIN) { E(acc, cur, wr, wc, fr, fq); S.done(cur); }
        if (!has_next) break;
#pragma unroll
        for (int a = 0; a < 2; ++a)
#pragma unroll
            for (int b = 0; b < 2; ++b)
#pragma unroll
                for (int m = 0; m < 4; ++m)
#pragma unroll
                    for (int n = 0; n < 2; ++n) acc[a][b][m][n] = (f32x4){0.f, 0.f, 0.f, 0.f};
        cur = nxt; cA = nA; cB = nB; ++ui;
        if constexpr (ALIGN_EPI) { if (wr == 1) PG8_BAR; }
    }
    PG8_WAIT_V(0);
    if constexpr (!ALIGN_EPI) { if (wr == 0) PG8_BAR; }
    PG8_BAR;
    if constexpr (Epi::AFTER_DRAIN) { E.fused(acc, cur, wr, wc, fr, fq, lds, wid, lane); S.done(cur); }
#undef PG8_SA
#undef PG8_SB
#undef PG8_STAGE
#undef PG8_LDA
#undef PG8_LDB
#undef PG8_MMA
#undef PG8_WAIT_V
#undef PG8_WAIT_L
#undef PG8_BAR
#undef PG8_SCHED
}
}
#define GAS __attribute__((address_space(1)))
#define LAS __attribute__((address_space(3)))
typedef unsigned short bf16;
typedef unsigned v4u __attribute__((ext_vector_type(4)));
typedef float f32x4 __attribute__((ext_vector_type(4)));
typedef short bf16x8 __attribute__((ext_vector_type(8)));
typedef GAS unsigned gu32;
typedef GAS unsigned long long gu64;
#define RLX_AGENT __ATOMIC_RELAXED, __HIP_MEMORY_SCOPE_AGENT
#define LDS_WAIT() asm volatile("s_waitcnt lgkmcnt(0)" ::: "memory")
#define VM_WAIT() asm volatile("s_waitcnt vmcnt(0)" ::: "memory")
__device__ __forceinline__ unsigned long long rt() { return __builtin_amdgcn_s_memrealtime(); }
__device__ __forceinline__ unsigned f2bf(float f) { unsigned u = __builtin_bit_cast(unsigned, f); return (u + 0x7fffu + ((u >> 16) & 1u)) >> 16; }
__device__ __forceinline__ unsigned pk2(float lo, float hi) { return f2bf(lo) | (f2bf(hi) << 16); }

#define XB_TMO      128
#define XB_XCNT(j)  (256  + 64 * (j))
#define XB_XSUB(j)  (1280 + 64 * (j))
#define XB_XGEN(j)  (2304 + 64 * (j))
#define XB_TOP      3328
#define XB_TOPGEN   3392
#define XCD_BAR_WORDS 3456
#define XB_SPIN_CAP (1u << 18)

__device__ __forceinline__ unsigned xb_ld(unsigned* p)              { return __hip_atomic_load(p, __ATOMIC_RELAXED, __HIP_MEMORY_SCOPE_AGENT); }
__device__ __forceinline__ unsigned xb_add(unsigned* p, unsigned v) { return __hip_atomic_fetch_add(p, v, __ATOMIC_RELAXED, __HIP_MEMORY_SCOPE_AGENT); }
__device__ __forceinline__ unsigned xb_xcc_id() { return (unsigned)__builtin_amdgcn_s_getreg((3 << 11) | 20) & 0xFu; }
#define XB_SPIN(cond, bar) do { unsigned _sp = 0; while (cond) { __builtin_amdgcn_s_sleep(1); \
    if ((++_sp & 255u) == 0u) { if (xb_ld(&(bar)[XB_TMO])) break; if (_sp > XB_SPIN_CAP) { atomicAdd(&(bar)[XB_TMO], 1u); break; } } } } while (0)

struct XcdBarrier {
    unsigned* bar; unsigned x;
    volatile LAS unsigned* st;
};

__device__ __forceinline__ XcdBarrier xcd_barrier_post(unsigned* bar, volatile LAS unsigned* st) {
    XcdBarrier b; b.bar = bar; b.x = xb_xcc_id(); b.st = st;
    if (threadIdx.x == 0) (void)xb_add(&bar[XB_XCNT(b.x)], 1u);
    return b;
}
__device__ __forceinline__ void xcd_barrier_complete(unsigned* bar, unsigned x, unsigned& nloc, unsigned& nx) {
    const unsigned G = gridDim.x * gridDim.y * gridDim.z;
    unsigned sum, cnt, mine, sp = 0u;
    for (;;) {
        sum = 0u; cnt = 0u; mine = 0u;
#pragma unroll
        for (unsigned j = 0; j < 16; ++j) { const unsigned c = xb_ld(&bar[XB_XCNT(j)]); sum += c; cnt += (c > 0u) ? 1u : 0u; mine = (j == x) ? c : mine; }
        if (sum == G) break;
        __builtin_amdgcn_s_sleep(1);
        if ((++sp & 255u) == 0u) { if (xb_ld(&bar[XB_TMO])) break; if (sp > XB_SPIN_CAP) { atomicAdd(&bar[XB_TMO], 1u); break; } }
    }
    nloc = mine > 0u ? mine : 1u; nx = cnt > 0u ? cnt : 1u;
}

__device__ __forceinline__ void xcd_barrier(const XcdBarrier& b) {
    asm volatile("s_waitcnt vmcnt(0)" ::: "memory");
    __syncthreads();
    if (threadIdx.x == 0) {
        unsigned* bar = b.bar;
        __builtin_amdgcn_s_waitcnt(0);
        unsigned nloc = b.st[0], nx = b.st[1];
        if (nloc == 0u) { xcd_barrier_complete(bar, b.x, nloc, nx); b.st[0] = nloc; b.st[1] = nx; }
        const unsigned old = xb_add(&bar[XB_XSUB(b.x)], 1u);
        const unsigned gen = old / nloc;
        if (old + 1u == (gen + 1u) * nloc) {
            __builtin_amdgcn_fence(__ATOMIC_RELEASE, "agent");
            asm volatile("s_waitcnt vmcnt(0)" ::: "memory");
            const unsigned og = xb_add(&bar[XB_TOP], 1u);
            const unsigned tg = og / nx;
            if (og + 1u == (tg + 1u) * nx) xb_add(&bar[XB_TOPGEN], 1u);
            else XB_SPIN(xb_ld(&bar[XB_TOPGEN]) == tg, bar);
            __builtin_amdgcn_fence(__ATOMIC_ACQUIRE, "agent");
            xb_add(&bar[XB_XGEN(b.x)], 1u);
            asm volatile("s_waitcnt vmcnt(0)" ::: "memory");
        } else {
            XB_SPIN(xb_ld(&bar[XB_XGEN(b.x)]) == gen, bar);
            __builtin_amdgcn_fence(__ATOMIC_ACQUIRE, "agent");
            asm volatile("s_waitcnt vmcnt(0)" ::: "memory");
        }
    }
    __syncthreads();
}

using pg8::bf16_t;
typedef unsigned u32x2 __attribute__((ext_vector_type(2)));
__device__ __forceinline__ float bf2f(unsigned v) { return __uint_as_float(v << 16); }
__device__ __forceinline__ float bflo(unsigned w) { return __uint_as_float(w << 16); }
__device__ __forceinline__ float bfhi(unsigned w) { return __uint_as_float(w & 0xffff0000u); }
__device__ __forceinline__ float wave_sum(float v) {
#pragma unroll
    for (int o = 1; o < 64; o <<= 1) v += __shfl_xor(v, o);
    return v;
}
__device__ __forceinline__ float sigm(float x) { return 1.0f / (1.0f + expf(-x)); }
__device__ __forceinline__ float softplusf_(float x) { return fmaxf(x, 0.f) + log1pf(expf(-fabsf(x))); }
__device__ __forceinline__ float gelu_tanh(float x) { return 0.5f * x * (1.0f + tanhf(0.7978845608028654f * (x + 0.044715f * x * x * x))); }

__device__ __forceinline__ int gu_rowmap(int n) { const int a = n >> 1; return ((a >> 7) << 8) + (a & 127) + ((n & 1) << 7); }
template <bool GU>
__device__ __forceinline__ void transpose_item(const float* W, int ldw, bf16* WT, int K, int k0, int n0, LAS float* scr, int lane) {
#pragma unroll
    for (int i = 0; i < 16; ++i) { const int k = 4 * i + (lane >> 4); const f32x4 v = *(const f32x4*)(W + (size_t)(k0 + k) * ldw + n0 + 4 * (lane & 15));
        LAS float* d = scr + k * 65 + 4 * (lane & 15); d[0] = v[0]; d[1] = v[1]; d[2] = v[2]; d[3] = v[3]; }
    LDS_WAIT(); asm volatile("" ::: "memory");
    const int c = lane & 7;
#pragma unroll
    for (int j = 0; j < 8; ++j) { const int n = 8 * j + (lane >> 3); const LAS float* s = scr + (8 * c) * 65 + n;
        v4u o; o.x = pk2(s[0], s[65]); o.y = pk2(s[130], s[195]); o.z = pk2(s[260], s[325]); o.w = pk2(s[390], s[455]);
        const int nr = GU ? gu_rowmap(n0 + n) : (n0 + n);
        *(v4u*)(WT + (size_t)nr * K + k0 + 8 * c) = o; }
    LDS_WAIT(); asm volatile("" ::: "memory");
}
constexpr int IT_WIN = 16 * 52, IT_WOUT = 256, IT_GU = 512, IT_DN = 256;
constexpr int NIT_WIN = DEPTH * IT_WIN, NIT_WOUT = DEPTH * IT_WOUT, NIT_GU = DEPTH * NE * IT_GU, NIT_DN = DEPTH * NE * IT_DN, NITEMS = NIT_WIN + NIT_WOUT + NIT_GU + NIT_DN;

__device__ __forceinline__ void emit_xn_dt(const f32x4 (&v)[4], const float* g, const float* win_l, bf16* xn_row, float* dt_row, int lane) {
    float ss = 0.f;
#pragma unroll
    for (int j = 0; j < 4; ++j) ss += (v[j][0] * v[j][0] + v[j][1] * v[j][1]) + (v[j][2] * v[j][2] + v[j][3] * v[j][3]);
    ss = wave_sum(ss);
    const float rstd = 1.0f / sqrtf(ss * (1.0f / DM) + EPS);
    float d0 = 0.f, d1 = 0.f, d2 = 0.f, d3 = 0.f;
#pragma unroll
    for (int j = 0; j < 4; ++j) { const int col = 256 * j + 4 * lane; const f32x4 gg = *(const f32x4*)(g + col); const f32x4 u = v[j] * rstd * gg;
        u32x2 w; w.x = pk2(u[0], u[1]); w.y = pk2(u[2], u[3]); *(u32x2*)(xn_row + col) = w;
#pragma unroll
        for (int i = 0; i < 4; ++i) { const f32x4 ww = *(const f32x4*)(win_l + (size_t)(col + i) * DIN + C_DT); d0 += u[i] * ww[0]; d1 += u[i] * ww[1]; d2 += u[i] * ww[2]; d3 += u[i] * ww[3]; } }
    d0 = wave_sum(d0); d1 = wave_sum(d1); d2 = wave_sum(d2); d3 = wave_sum(d3);
    if (lane == 0) *(f32x4*)dt_row = (f32x4){d0, d1, d2, d3};
}

__device__ __forceinline__ void attn_naive(const bf16* proj, float* oraw, int b, int h, int qb, int lane) {
    const int t = qb * 64 + lane; const size_t row = (size_t)b * SEQ + t;
    int zero; asm volatile("v_mov_b32 %0, 0" : "=v"(zero));
    float q[64], acc[64];
    const bf16* qp = proj + row * DING + C_SBQ + h * 64;
#pragma unroll
    for (int c = 0; c < 8; ++c) { const v4u w = *(const v4u*)(qp + 8 * c);
#pragma unroll
        for (int i = 0; i < 4; ++i) { q[8 * c + 2 * i] = bflo(w[i]) * 0.125f; q[8 * c + 2 * i + 1] = bfhi(w[i]) * 0.125f; } }
#pragma unroll
    for (int d = 0; d < 64; ++d) acc[d] = 0.f;
    float R = 0.f;
    for (int s = qb * 64 + 62; s >= 0; --s) {
        const bf16* kp = proj + ((size_t)b * SEQ + s) * DING + C_SBK + h * 64 + zero;
        float z = 0.f;
#pragma unroll
        for (int c = 0; c < 8; ++c) { const v4u w = *(const v4u*)(kp + 8 * c);
#pragma unroll
            for (int i = 0; i < 4; ++i) { z += q[8 * c + 2 * i] * bflo(w[i]); z += q[8 * c + 2 * i + 1] * bfhi(w[i]); } }
        if (s < t) {
            const float sp = softplusf_(z);
            const float a = expf(z - sp + R);
            R -= sp;
            const bf16* vp = kp + 256;
#pragma unroll
            for (int c = 0; c < 8; ++c) { const v4u w = *(const v4u*)(vp + 8 * c);
#pragma unroll
                for (int i = 0; i < 4; ++i) { acc[8 * c + 2 * i] += a * bflo(w[i]); acc[8 * c + 2 * i + 1] += a * bfhi(w[i]); } }
        }
        if (__all(R < -88.0f)) break;
    }
    float* op = oraw + row * DM + h * 64;
#pragma unroll
    for (int c = 0; c < 16; ++c) *(f32x4*)(op + 4 * c) = (f32x4){acc[4 * c], acc[4 * c + 1], acc[4 * c + 2], acc[4 * c + 3]};
}

__device__ __forceinline__ void rg_chain(const bf16* proj, float* oraw, int b, int n, const float* conv_w, const float* conv_b, const float* wa, const float* ba,
                                         const float* wx, const float* bx, const float* lam, LAS float* L, int tid) {
    LAS float* wa_s = L; LAS float* wx_s = L + 4096; LAS float* xc_s = L + 8192; LAS float* a_s = L + 12288; LAS float* u_s = L + 16384;
    const int j = tid & 63, tr = tid >> 6, c = n * 64 + j;
    for (int idx = tid; idx < 4096; idx += NTHR) { wa_s[idx] = wa[n * 4096 + idx]; wx_s[idx] = wx[n * 4096 + idx]; }
    float cw[4];
#pragma unroll
    for (int k = 0; k < 4; ++k) cw[k] = conv_w[k * 256 + c];
    const float cb = conv_b[c], bav = ba[c], bxv = bx[c], spl = softplusf_(-lam[c]);
    float hstate = 0.f;
    __syncthreads();
    for (int ch = 0; ch < SEQ / 64; ++ch) {
        const int t0 = ch * 64;
#pragma unroll 1
        for (int i = 0; i < 8; ++i) { const int t = tr + 8 * i, tg = t0 + t; float a = cb;
#pragma unroll
            for (int k = 0; k < 4; ++k) { const int ts = tg - 3 + k; if (ts >= 0) a += cw[k] * bf2f(proj[((size_t)b * SEQ + ts) * DING + C_RGX + c]); }
            xc_s[t * 64 + j] = a; }
        __syncthreads();
#pragma unroll 1
        for (int i = 0; i < 8; ++i) { const int t = tr + 8 * i; float ra = bav, ga = bxv;
            _Pragma("unroll 4") for (int ii = 0; ii < 64; ++ii) { const float x = xc_s[t * 64 + ii]; ra += x * wa_s[ii * 64 + j]; ga += x * wx_s[ii * 64 + j]; }
            const float r = sigm(ra), ig = sigm(ga), log_a = -8.0f * r * spl;
            float mult = sqrtf(-expm1f(2.0f * log_a)); if (t0 + t == 0) mult = 1.0f;
            a_s[t * 64 + j] = expf(log_a); u_s[t * 64 + j] = mult * ig * xc_s[t * 64 + j]; }
        __syncthreads();
        if (tid < 64) {
            for (int t = 0; t < 64; ++t) { hstate = a_s[t * 64 + j] * hstate + u_s[t * 64 + j];
                const size_t row = (size_t)b * SEQ + t0 + t; const float gate = bf2f(proj[row * DING + C_RGG + c]);
                oraw[row * DM + 256 + c] = hstate * gelu_tanh(gate); }
        }
        __syncthreads();
    }
}

__device__ __forceinline__ void hg_chain(const bf16* proj, float* oraw, int b, int h, const float* lbp, int layer, LAS float* L, int tid) {
    constexpr int S = 65, A = 64 * S;
    LAS float* q_s = L; LAS float* k_s = L + A; LAS float* v_s = L + 2 * A; LAS float* bc_s = L + 3 * A; LAS float* sc_s = L + 4 * A; LAS float* st_s = L + 5 * A; LAS float* qe_s = L + 6 * A;
    const int j = tid & 63, tr = tid >> 6;
    float lb = 0.f;
    if (layer == 1) { const float x0 = lbp[h * 64 + j], x1 = lbp[256 + h * 64 + j], mx = fmaxf(x0, x1), e0 = expf(x0 - mx), e1 = expf(x1 - mx); lb = e1 / (e0 + e1); }
#pragma unroll
    for (int i = 0; i < 8; ++i) st_s[(tr + 8 * i) * S + j] = 0.f;
    __syncthreads();
    for (int ch = 0; ch < SEQ / 64; ++ch) {
        const int t0 = ch * 64;
#pragma unroll 1
        for (int i = 0; i < 8; ++i) { const int t = tr + 8 * i; const size_t row = (size_t)b * SEQ + t0 + t; const bf16* pp = proj + row * DING + h * 64 + j;
            const float qv = bf2f(pp[C_HGQ]), fv = bf2f(pp[C_HGF]), iv = bf2f(pp[C_HGI]);
            const float forget = lb + (1.0f - lb) * sigm(fv);
            q_s[t * S + j] = qv * sigm(qv); k_s[t * S + j] = 1.0f - forget; v_s[t * S + j] = iv; bc_s[t * S + j] = logf(forget); }
        __syncthreads();
        if (tid < 64) { float run = 0.f; for (int t = 0; t < 64; ++t) { run += bc_s[t * S + j]; bc_s[t * S + j] = run; } }
        __syncthreads();
#pragma unroll 1
        for (int i = 0; i < 8; ++i) { const int t = tr + 8 * i; qe_s[t * S + j] = q_s[t * S + j] * expf(bc_s[t * S + j]); }
#pragma unroll 1
        for (int i = 0; i < 8; ++i) { const int t = tr + 8 * i, s = j; float a = 0.f;
            if (s <= t) _Pragma("unroll 4") for (int c = 0; c < 64; ++c) a += q_s[t * S + c] * k_s[s * S + c] * expf(bc_s[t * S + c] - bc_s[s * S + c]);
            sc_s[t * S + s] = a; }
        __syncthreads();
#pragma unroll 1
        for (int i = 0; i < 8; ++i) { const int t = tr + 8 * i, v = j; float o = 0.f;
            _Pragma("unroll 4") for (int s = 0; s < 64; ++s) o += sc_s[t * S + s] * v_s[s * S + v];
            _Pragma("unroll 4") for (int c = 0; c < 64; ++c) o += qe_s[t * S + c] * st_s[c * S + v];
            oraw[((size_t)b * SEQ + t0 + t) * DM + 512 + h * 64 + v] = o; }
        __syncthreads();
#pragma unroll 1
        for (int i = 0; i < 8; ++i) { const int s = tr + 8 * i, c = j; sc_s[s * S + c] = k_s[s * S + c] * expf(bc_s[63 * S + c] - bc_s[s * S + c]); }
        __syncthreads();
#pragma unroll 1
        for (int i = 0; i < 8; ++i) { const int c = tr + 8 * i, v = j; float a = expf(bc_s[63 * S + c]) * st_s[c * S + v];
            _Pragma("unroll 4") for (int s = 0; s < 64; ++s) a += sc_s[s * S + c] * v_s[s * S + v];
            st_s[c * S + v] = a; }
        __syncthreads();
    }
}

__device__ __forceinline__ void m2_chain(const bf16* proj, const float* dtraw, float* oraw, int b, int h, const float* conv_w, const float* conv_b, const float* dt_bias,
                                         const float* a_log, const float* dskip, LAS float* L, int tid) {
    constexpr int SB = 129;
    LAS float* xs_s = L; LAS float* B_s = L + 4096; LAS float* C_s = B_s + 64 * SB; LAS float* W_s = C_s + 64 * SB; LAS float* st_s = W_s + 64 * 65;
    LAS float* dt_s = st_s + 64 * SB; LAS float* acs_s = dt_s + 64; LAS float* w_s = acs_s + 64;
    const int j = tid & 63, tr = tid >> 6, g = h >> 1;
    const float dtb = dt_bias[h], negA = -expf(a_log[h]), Dh = dskip[h];
    for (int idx = tid; idx < 64 * SB; idx += NTHR) st_s[idx] = 0.f;
    __syncthreads();
    for (int ch = 0; ch < SEQ / 64; ++ch) {
        const int t0 = ch * 64;
        for (int idx = tid; idx < 64 * 320; idx += NTHR) { const int cch = idx % 320, t = idx / 320;
            int col, cc; LAS float* dst;
            if (cch < 64) { cc = h * 64 + cch; dst = xs_s + t * 64 + cch; }
            else if (cch < 192) { cc = 256 + g * 128 + (cch - 64); dst = B_s + t * SB + (cch - 64); }
            else { cc = 512 + g * 128 + (cch - 192); dst = C_s + t * SB + (cch - 192); }
            col = C_M2X + cc;
            float a = conv_b[cc];
#pragma unroll
            for (int k = 0; k < 4; ++k) { const int ts = t0 + t - 3 + k; if (ts >= 0) a += conv_w[k * 768 + cc] * bf2f(proj[((size_t)b * SEQ + ts) * DING + col]); }
            *dst = a * sigm(a); }
        if (tid < 64) { const float dtv = softplusf_(dtraw[((size_t)b * SEQ + t0 + tid) * 4 + h] + dtb); dt_s[tid] = dtv;
            float v = dtv * negA;
#pragma unroll
            for (int o = 1; o < 64; o <<= 1) { const float nb = __shfl_up(v, o); if (tid >= o) v += nb; }
            acs_s[tid] = v; const float last = __shfl(v, 63); w_s[tid] = expf(last - v) * dtv; }
        __syncthreads();
#pragma unroll 1
        for (int i = 0; i < 8; ++i) { const int l = tr + 8 * i, s = j; float a = 0.f;
            if (s <= l) { _Pragma("unroll 4") for (int n = 0; n < 128; ++n) a += C_s[l * SB + n] * B_s[s * SB + n]; a *= expf(acs_s[l] - acs_s[s]); }
            W_s[l * 65 + s] = a; }
        __syncthreads();
#pragma unroll 1
        for (int i = 0; i < 8; ++i) { const int l = tr + 8 * i, p = j; float yd = 0.f, yo = 0.f;
            _Pragma("unroll 4") for (int s = 0; s < 64; ++s) yd += W_s[l * 65 + s] * (xs_s[s * 64 + p] * dt_s[s]);
            _Pragma("unroll 4") for (int n = 0; n < 128; ++n) yo += C_s[l * SB + n] * st_s[p * SB + n];
            const size_t row = (size_t)b * SEQ + t0 + l; const float zv = bf2f(proj[row * DING + C_M2Z + h * 64 + p]);
            const float y = yd + expf(acs_s[l]) * yo + xs_s[l * 64 + p] * Dh;
            oraw[row * DM + 768 + h * 64 + p] = y * (zv * sigm(zv)); }
        __syncthreads();
        { const int n = tid & 127, pq = tid >> 7; const float dec = expf(acs_s[63]);
#pragma unroll 1
            for (int i = 0; i < 16; ++i) { const int p = pq + 4 * i; float a = dec * st_s[p * SB + n];
                _Pragma("unroll 4") for (int s = 0; s < 64; ++s) a += B_s[s * SB + n] * (w_s[s] * xs_s[s * 64 + p]);
                st_s[p * SB + n] = a; } }
        __syncthreads();
    }
}

__device__ __forceinline__ void norm_row(const float* orow, const bf16* prow, bf16* mrow, const float* gA, const float* gB, const float* gC, const float* gD, int lane) {
    f32x4 v[4];
#pragma unroll
    for (int j = 0; j < 4; ++j) v[j] = *(const f32x4*)(orow + 256 * j + 4 * lane);
    float s[4];
#pragma unroll
    for (int j = 0; j < 4; ++j) s[j] = (v[j][0] * v[j][0] + v[j][1] * v[j][1]) + (v[j][2] * v[j][2] + v[j][3] * v[j][3]);
#pragma unroll
    for (int o = 1; o < 64; o <<= 1) { s[0] += __shfl_xor(s[0], o); s[1] += __shfl_xor(s[1], o); if (o < 16) s[2] += __shfl_xor(s[2], o); if (o < 32) s[3] += __shfl_xor(s[3], o); }
    const float r0 = 1.0f / sqrtf(s[0] * (1.0f / 256) + EPS), r1 = 1.0f / sqrtf(s[1] * (1.0f / 256) + EPS), r2 = 1.0f / sqrtf(s[2] * (1.0f / 64) + EPS), r3 = 1.0f / sqrtf(s[3] * (1.0f / 128) + EPS);
    const int c = 4 * lane;
    const f32x4 g0 = *(const f32x4*)(gA + c), g1 = *(const f32x4*)(gB + c), g2 = *(const f32x4*)(gC + c), g3 = *(const f32x4*)(gD + c);
    const u32x2 gw = *(const u32x2*)(prow + C_HGG + c);
    const float gi[4] = {bflo(gw.x), bfhi(gw.x), bflo(gw.y), bfhi(gw.y)};
    f32x4 o0 = v[0] * r0 * g0, o1 = v[1] * r1 * g1, o2 = v[2] * r2 * g2, o3 = v[3] * r3 * g3;
#pragma unroll
    for (int i = 0; i < 4; ++i) o2[i] *= gi[i] * sigm(gi[i]);
    u32x2 w;
    w.x = pk2(o0[0], o0[1]); w.y = pk2(o0[2], o0[3]); *(u32x2*)(mrow + c) = w;
    w.x = pk2(o1[0], o1[1]); w.y = pk2(o1[2], o1[3]); *(u32x2*)(mrow + 256 + c) = w;
    w.x = pk2(o2[0], o2[1]); w.y = pk2(o2[2], o2[3]); *(u32x2*)(mrow + 512 + c) = w;
    w.x = pk2(o3[0], o3[1]); w.y = pk2(o3[2], o3[3]); *(u32x2*)(mrow + 768 + c) = w;
}

__device__ __forceinline__ void router_row(const float* hrow, const float* g, const LAS float* rw_t, const float* rb, bf16* xn_row, int& cntl, int& oe, int& orank, float& ogate, int lane) {
    f32x4 v[4]; float ss = 0.f;
#pragma unroll
    for (int j = 0; j < 4; ++j) { v[j] = *(const f32x4*)(hrow + 256 * j + 4 * lane); ss += (v[j][0] * v[j][0] + v[j][1] * v[j][1]) + (v[j][2] * v[j][2] + v[j][3] * v[j][3]); }
    ss = wave_sum(ss);
    const float rstd = 1.0f / sqrtf(ss * (1.0f / DM) + EPS);
#pragma unroll
    for (int j = 0; j < 4; ++j) { const int col = 256 * j + 4 * lane; v[j] = v[j] * rstd * *(const f32x4*)(g + col);
        u32x2 w; w.x = pk2(v[j][0], v[j][1]); w.y = pk2(v[j][2], v[j][3]); *(u32x2*)(xn_row + col) = w; }
    float p[32];
#pragma unroll
    for (int e = 0; e < 32; ++e) { float a = 0.f;
#pragma unroll
        for (int j = 0; j < 4; ++j) { const f32x4 w = *(const LAS f32x4*)(rw_t + e * 1024 + 256 * j + 4 * lane); a += (v[j][0] * w[0] + v[j][1] * w[1]) + (v[j][2] * w[2] + v[j][3] * w[3]); }
        p[e] = a; }
    float q16[16], q8[8], q4[4], q2[2];
    { const bool hi = (lane & 32) != 0;
#pragma unroll
        for (int i = 0; i < 16; ++i) { const float keep = hi ? p[16 + i] : p[i], send = hi ? p[i] : p[16 + i]; q16[i] = keep + __shfl_xor(send, 32); } }
    { const bool hi = (lane & 16) != 0;
#pragma unroll
        for (int i = 0; i < 8; ++i) { const float keep = hi ? q16[8 + i] : q16[i], send = hi ? q16[i] : q16[8 + i]; q8[i] = keep + __shfl_xor(send, 16); } }
    { const bool hi = (lane & 8) != 0;
#pragma unroll
        for (int i = 0; i < 4; ++i) { const float keep = hi ? q8[4 + i] : q8[i], send = hi ? q8[i] : q8[4 + i]; q4[i] = keep + __shfl_xor(send, 8); } }
    { const bool hi = (lane & 4) != 0;
#pragma unroll
        for (int i = 0; i < 2; ++i) { const float keep = hi ? q4[2 + i] : q4[i], send = hi ? q4[i] : q4[2 + i]; q2[i] = keep + __shfl_xor(send, 4); } }
    float mine;
    { const bool hi = (lane & 2) != 0; const float keep = hi ? q2[1] : q2[0], send = hi ? q2[0] : q2[1]; mine = keep + __shfl_xor(send, 2); }
    mine += __shfl_xor(mine, 1);
    mine += rb[lane >> 1];
    float lg[32];
#pragma unroll
    for (int e = 0; e < 32; ++e) lg[e] = __uint_as_float(__builtin_amdgcn_readlane(__float_as_uint(mine), 2 * e));
    int be[4]; float bl[4];
#pragma unroll
    for (int r = 0; r < 4; ++r) { float best = -INFINITY; int bi = 0;
#pragma unroll
        for (int e = 0; e < 32; ++e) if (lg[e] > best) { best = lg[e]; bi = e; }
#pragma unroll
        for (int e = 0; e < 32; ++e) if (e == bi) lg[e] = -INFINITY;
        be[r] = bi; bl[r] = best; }
    const float e1 = expf(bl[1] - bl[0]), e2 = expf(bl[2] - bl[0]), e3 = expf(bl[3] - bl[0]), inv = 1.0f / (1.0f + e1 + e2 + e3);
    int rk[4];
#pragma unroll
    for (int r = 0; r < 4; ++r) { rk[r] = __shfl(cntl, be[r]); if (lane == be[r]) cntl += 1; }
    { const int k = lane & 3;
        oe = k == 0 ? be[0] : k == 1 ? be[1] : k == 2 ? be[2] : be[3]; orank = k == 0 ? rk[0] : k == 1 ? rk[1] : k == 2 ? rk[2] : rk[3];
        ogate = (k == 0 ? 1.0f : k == 1 ? e1 : k == 2 ? e2 : e3) * inv; }
}

__device__ __forceinline__ void build_tb(const int* tot, LAS int* tb, int tid) {
    if (tid == 0) { int run = 0; for (int e = 0; e < 32; ++e) { tb[e] = run; run += (tot[e] + 255) >> 8; } tb[32] = run; }
    __syncthreads();
}

typedef short s16x4 __attribute__((ext_vector_type(4)));
typedef short v4i16_t __attribute__((ext_vector_type(4)));
#define MFMA16(a, b, c) __builtin_amdgcn_mfma_f32_16x16x32_bf16((a), (b), (c), 0, 0, 0)
__device__ __forceinline__ bf16x8 frag_kc(const LAS bf16* M, int ld, int idx0, int k0, int lane) { return *(const LAS bf16x8*)(M + (idx0 + (lane & 15)) * ld + k0 + 8 * (lane >> 4)); }
__device__ __forceinline__ bf16x8 frag_ks(const LAS bf16* M, int ld, int idx0, int k0, int lane) {
    const LAS bf16* p = M + (k0 + 8 * (lane >> 4) + ((lane & 15) >> 2)) * ld + idx0 + 4 * (lane & 3);
    const s16x4 lo = __builtin_bit_cast(s16x4, __builtin_amdgcn_ds_read_tr16_b64_v4i16((LAS v4i16_t*)p));
    const s16x4 hi = __builtin_bit_cast(s16x4, __builtin_amdgcn_ds_read_tr16_b64_v4i16((LAS v4i16_t*)(p + 4 * ld)));
    return (bf16x8){lo[0], lo[1], lo[2], lo[3], hi[0], hi[1], hi[2], hi[3]};
}
__device__ __forceinline__ bf16x8 frag_g32(const float* M, int ld, int idx0, int k0, int lane) {
    const float* p = M + (size_t)(idx0 + (lane & 15)) * ld + k0 + 8 * (lane >> 4);
    const f32x4 a = *(const f32x4*)p, b = *(const f32x4*)(p + 4);
    v4u w; w.x = pk2(a[0], a[1]); w.y = pk2(a[2], a[3]); w.z = pk2(b[0], b[1]); w.w = pk2(b[2], b[3]);
    return __builtin_bit_cast(bf16x8, w);
}
__device__ __forceinline__ float fsigm(float x) { return __builtin_amdgcn_rcpf(1.0f + __builtin_amdgcn_exp2f(-1.4426950408889634f * x)); }
__device__ __forceinline__ float fexp(float x) { return __builtin_amdgcn_exp2f(1.4426950408889634f * x); }

constexpr int M2LD = 136, M2WLD = 72;
__device__ __forceinline__ void m2_conv8(const bf16* proj, const float* cw, const float* cb, int b, int tg, int cc0, float (&o)[8]) {
    const f32x4 b0 = *(const f32x4*)(cb + cc0), b1 = *(const f32x4*)(cb + cc0 + 4);
    o[0] = b0[0]; o[1] = b0[1]; o[2] = b0[2]; o[3] = b0[3]; o[4] = b1[0]; o[5] = b1[1]; o[6] = b1[2]; o[7] = b1[3];
#pragma unroll
    for (int k = 0; k < 4; ++k) { const int ts = tg - 3 + k;
        if (ts >= 0) { const v4u w = *(const v4u*)(proj + ((size_t)b * SEQ + ts) * DING + C_M2X + cc0);
            const f32x4 w0 = *(const f32x4*)(cw + k * 768 + cc0), w1 = *(const f32x4*)(cw + k * 768 + cc0 + 4);
            o[0] += w0[0] * bflo(w[0]); o[1] += w0[1] * bfhi(w[0]); o[2] += w0[2] * bflo(w[1]); o[3] += w0[3] * bfhi(w[1]);
            o[4] += w1[0] * bflo(w[2]); o[5] += w1[1] * bfhi(w[2]); o[6] += w1[2] * bflo(w[3]); o[7] += w1[3] * bfhi(w[3]); } }
#pragma unroll
    for (int i = 0; i < 8; ++i) o[i] = o[i] * fsigm(o[i]);
}
__device__ __forceinline__ void m2_dt_scan(const float* dtraw, const float* dt_bias, const float* a_log, int b, int t0, int g, LAS float* dt_s, LAS float* acs_s, LAS float* w_s, float* dec_out, int tid) {
    if (tid < 128) { const int hh = tid >> 6, t = tid & 63, h = 2 * g + hh;
        const float dtv = softplusf_(dtraw[((size_t)b * SEQ + t0 + t) * 4 + h] + dt_bias[h]);
        float v = dtv * (-expf(a_log[h]));
#pragma unroll
        for (int o = 1; o < 64; o <<= 1) { const float nb = __shfl_up(v, o); if (t >= o) v += nb; }
        const float last = __shfl(v, 63);
        dt_s[hh * 64 + t] = dtv; acs_s[hh * 64 + t] = v; w_s[hh * 64 + t] = expf(last - v) * dtv;
        if (dec_out && t == 63) dec_out[h] = expf(last); }
}
__device__ __forceinline__ void m2_state_unit(const bf16* proj, const float* dtraw, float* sloc, float* dec, int b, int ch, int g, const float* cw, const float* cb, const float* dt_bias, const float* a_log, LAS unsigned char* lds, int tid) {
    LAS bf16* XS = (LAS bf16*)lds; LAS bf16* BS = XS + 64 * M2LD; LAS float* dt_s = (LAS float*)(BS + 64 * M2LD); LAS float* acs_s = dt_s + 128; LAS float* w_s = acs_s + 128;
    const int lane = tid & 63, w = tid >> 6, t0 = ch * 64;
    m2_dt_scan(dtraw, dt_bias, a_log, b, t0, g, dt_s, acs_s, w_s, dec + (size_t)(b * 32 + ch) * 4, tid);
    __syncthreads();
#pragma unroll 1
    for (int it = tid; it < 64 * 32; it += NTHR) { const int t = it >> 5, cg = it & 31; float o[8];
        if (cg < 16) { m2_conv8(proj, cw, cb, b, t0 + t, g * 128 + 8 * cg, o); const float sc = w_s[(cg >> 3) * 64 + t];
            v4u q; q.x = pk2(o[0] * sc, o[1] * sc); q.y = pk2(o[2] * sc, o[3] * sc); q.z = pk2(o[4] * sc, o[5] * sc); q.w = pk2(o[6] * sc, o[7] * sc); *(LAS v4u*)(XS + t * M2LD + 8 * cg) = q; }
        else { m2_conv8(proj, cw, cb, b, t0 + t, 256 + g * 128 + 8 * (cg - 16), o);
            v4u q; q.x = pk2(o[0], o[1]); q.y = pk2(o[2], o[3]); q.z = pk2(o[4], o[5]); q.w = pk2(o[6], o[7]); *(LAS v4u*)(BS + t * M2LD + 8 * (cg - 16)) = q; } }
    __syncthreads();
    { const int hh = w >> 2, mi = w & 3;
        const bf16x8 a0 = frag_ks(XS, M2LD, hh * 64 + mi * 16, 0, lane), a1 = frag_ks(XS, M2LD, hh * 64 + mi * 16, 32, lane);
        float* outp = sloc + ((size_t)((b * 32 + ch) * 4 + 2 * g + hh) * 64 + mi * 16 + 4 * (lane >> 4)) * 128 + (lane & 15);
#pragma unroll
        for (int ni = 0; ni < 8; ++ni) { const bf16x8 b0 = frag_ks(BS, M2LD, ni * 16, 0, lane), b1 = frag_ks(BS, M2LD, ni * 16, 32, lane);
            f32x4 acc = {0.f, 0.f, 0.f, 0.f}; acc = MFMA16(a0, b0, acc); acc = MFMA16(a1, b1, acc);
#pragma unroll
            for (int i = 0; i < 4; ++i) outp[i * 128 + ni * 16] = acc[i]; } }
    __syncthreads();
}
__device__ __forceinline__ void m2_out_unit(const bf16* proj, const float* dtraw, const float* prev, float* oraw, int b, int ch, int g, const float* cw, const float* cb, const float* dt_bias, const float* a_log, const float* dskip, LAS unsigned char* lds, int tid) {
    LAS bf16* XS = (LAS bf16*)lds; LAS bf16* BS = XS + 64 * M2LD; LAS bf16* CS = BS + 64 * M2LD; LAS bf16* WS = CS + 64 * M2LD;
    LAS float* dt_s = (LAS float*)(WS + 2 * 64 * M2WLD); LAS float* acs_s = dt_s + 128; LAS float* w_s = acs_s + 128;
    const int lane = tid & 63, w = tid >> 6, t0 = ch * 64;
    m2_dt_scan(dtraw, dt_bias, a_log, b, t0, g, dt_s, acs_s, w_s, nullptr, tid);
#pragma unroll 1
    for (int it = tid; it < 64 * 48; it += NTHR) { const int t = it / 48, cg = it % 48; float o[8];
        const int cc0 = cg < 16 ? g * 128 + 8 * cg : cg < 32 ? 256 + g * 128 + 8 * (cg - 16) : 512 + g * 128 + 8 * (cg - 32);
        m2_conv8(proj, cw, cb, b, t0 + t, cc0, o);
        LAS bf16* dst = cg < 16 ? XS + t * M2LD + 8 * cg : cg < 32 ? BS + t * M2LD + 8 * (cg - 16) : CS + t * M2LD + 8 * (cg - 32);
        v4u q; q.x = pk2(o[0], o[1]); q.y = pk2(o[2], o[3]); q.z = pk2(o[4], o[5]); q.w = pk2(o[6], o[7]); *(LAS v4u*)dst = q; }
    __syncthreads();
    { const int mi = w >> 1, ni0 = (w & 1) * 2;
        f32x4 acc[2] = {{0.f, 0.f, 0.f, 0.f}, {0.f, 0.f, 0.f, 0.f}};
#pragma unroll
        for (int kk = 0; kk < 4; ++kk) { const bf16x8 a = frag_kc(CS, M2LD, mi * 16, 32 * kk, lane);
#pragma unroll
            for (int q = 0; q < 2; ++q) { const bf16x8 bb = frag_kc(BS, M2LD, (ni0 + q) * 16, 32 * kk, lane); acc[q] = MFMA16(a, bb, acc[q]); } }
#pragma unroll
        for (int q = 0; q < 2; ++q) { const int s = (ni0 + q) * 16 + (lane & 15);
#pragma unroll
            for (int hh = 0; hh < 2; ++hh) { const float as = acs_s[hh * 64 + s], ds = dt_s[hh * 64 + s];
#pragma unroll
                for (int i = 0; i < 4; ++i) { const int l = mi * 16 + 4 * (lane >> 4) + i;
                    const float v = (s <= l) ? acc[q][i] * fexp(acs_s[hh * 64 + l] - as) * ds : 0.f;
                    WS[(hh * 64 + l) * M2WLD + s] = (bf16)f2bf(v); } } } }
    __syncthreads();
    { const int hh = w >> 2, mi = w & 3, h = 2 * g + hh;
        f32x4 yd[4], yo[4];
#pragma unroll
        for (int ni = 0; ni < 4; ++ni) { yd[ni] = (f32x4){0.f, 0.f, 0.f, 0.f}; yo[ni] = (f32x4){0.f, 0.f, 0.f, 0.f}; }
#pragma unroll
        for (int kk = 0; kk < 2; ++kk) { const bf16x8 a = frag_kc(WS + hh * 64 * M2WLD, M2WLD, mi * 16, 32 * kk, lane);
#pragma unroll
            for (int ni = 0; ni < 4; ++ni) { const bf16x8 bb = frag_ks(XS, M2LD, hh * 64 + ni * 16, 32 * kk, lane); yd[ni] = MFMA16(a, bb, yd[ni]); } }
        const float* pv = prev + (size_t)((b * 32 + ch) * 4 + h) * 64 * 128;
#pragma unroll
        for (int kk = 0; kk < 4; ++kk) { const bf16x8 a = frag_kc(CS, M2LD, mi * 16, 32 * kk, lane);
#pragma unroll
            for (int ni = 0; ni < 4; ++ni) { const bf16x8 bb = frag_g32(pv, 128, ni * 16, 32 * kk, lane); yo[ni] = MFMA16(a, bb, yo[ni]); } }
        const float Dh = dskip[h];
#pragma unroll
        for (int i = 0; i < 4; ++i) { const int l = mi * 16 + 4 * (lane >> 4) + i; const float ea = fexp(acs_s[hh * 64 + l]); const size_t row = (size_t)b * SEQ + t0 + l;
#pragma unroll
            for (int ni = 0; ni < 4; ++ni) { const int p = ni * 16 + (lane & 15);
                const float xv = bf2f(XS[l * M2LD + hh * 64 + p]), zv = bf2f(proj[row * DING + C_M2Z + h * 64 + p]);
                const float y = yd[ni][i] + ea * yo[ni][i] + xv * Dh;
                oraw[row * DM + 768 + h * 64 + p] = y * (zv * fsigm(zv)); } } }
    __syncthreads();
}

constexpr int HGLD = 136, HGWLD = 72;
template <bool WITH_Q>
__device__ __forceinline__ void hg_prep(const bf16* proj, int b, int t0, int hp, const float* lbp, int layer, LAS float* bc_s, LAS bf16* QS, LAS bf16* KS, LAS bf16* VS, int tid) {
#pragma unroll 1
    for (int it = tid; it < 64 * 16; it += NTHR) { const int t = it >> 4, c0 = (it & 15) * 8; const size_t row = (size_t)b * SEQ + t0 + t;
        const v4u fw = *(const v4u*)(proj + row * DING + C_HGF + hp * 128 + c0);
        float f[8] = {bflo(fw[0]), bfhi(fw[0]), bflo(fw[1]), bfhi(fw[1]), bflo(fw[2]), bfhi(fw[2]), bflo(fw[3]), bfhi(fw[3])};
#pragma unroll
        for (int i = 0; i < 8; ++i) { float lb = 0.f;
            if (layer == 1) { const float x0 = lbp[hp * 128 + c0 + i], x1 = lbp[256 + hp * 128 + c0 + i], mx = fmaxf(x0, x1), e0 = expf(x0 - mx), e1 = expf(x1 - mx); lb = e1 / (e0 + e1); }
            bc_s[t * 128 + c0 + i] = logf(lb + (1.0f - lb) * fsigm(f[i])); } }
    __syncthreads();
    if (tid < 128) { float run = 0.f;
#pragma unroll 8
        for (int t = 0; t < 64; ++t) { run += bc_s[t * 128 + tid]; bc_s[t * 128 + tid] = run; } }
    __syncthreads();
#pragma unroll 1
    for (int it = tid; it < 64 * 16; it += NTHR) { const int t = it >> 4, c0 = (it & 15) * 8; const size_t row = (size_t)b * SEQ + t0 + t;
        const v4u fw = *(const v4u*)(proj + row * DING + C_HGF + hp * 128 + c0);
        const v4u iw = *(const v4u*)(proj + row * DING + C_HGI + hp * 128 + c0);
        *(LAS v4u*)(VS + t * HGLD + c0) = iw;
        float f[8] = {bflo(fw[0]), bfhi(fw[0]), bflo(fw[1]), bfhi(fw[1]), bflo(fw[2]), bfhi(fw[2]), bflo(fw[3]), bfhi(fw[3])};
        float kk[8], qq[8];
        v4u qw; if (WITH_Q) qw = *(const v4u*)(proj + row * DING + C_HGQ + hp * 128 + c0);
#pragma unroll
        for (int i = 0; i < 8; ++i) { float lb = 0.f;
            if (layer == 1) { const float x0 = lbp[hp * 128 + c0 + i], x1 = lbp[256 + hp * 128 + c0 + i], mx = fmaxf(x0, x1), e0 = expf(x0 - mx), e1 = expf(x1 - mx); lb = e1 / (e0 + e1); }
            const float key = (1.0f - lb) * (1.0f - fsigm(f[i]));
            const float d = bc_s[31 * 128 + c0 + i] - bc_s[t * 128 + c0 + i];
            kk[i] = key * fexp(fminf(d, 60.0f));
            if (WITH_Q) { const float qv = (i & 1) ? bfhi(qw[i >> 1]) : bflo(qw[i >> 1]); qq[i] = qv * fsigm(qv) * fexp(fminf(-d, 60.0f)); } }
        v4u o; o.x = pk2(kk[0], kk[1]); o.y = pk2(kk[2], kk[3]); o.z = pk2(kk[4], kk[5]); o.w = pk2(kk[6], kk[7]); *(LAS v4u*)(KS + t * HGLD + c0) = o;
        if (WITH_Q) { o.x = pk2(qq[0], qq[1]); o.y = pk2(qq[2], qq[3]); o.z = pk2(qq[4], qq[5]); o.w = pk2(qq[6], qq[7]); *(LAS v4u*)(QS + t * HGLD + c0) = o; } }
    __syncthreads();
}
__device__ __forceinline__ void hg_state_unit(const bf16* proj, float* slt, float* decc, int b, int ch, int hp, const float* lbp, int layer, LAS unsigned char* lds, int tid) {
    LAS float* bc_s = (LAS float*)lds; LAS bf16* KS = (LAS bf16*)(lds + 32768); LAS bf16* VS = KS + 64 * HGLD;
    const int lane = tid & 63, w = tid >> 6;
    hg_prep<false>(proj, b, ch * 64, hp, lbp, layer, bc_s, nullptr, KS, VS, tid);
    if (tid < 128) decc[(size_t)((b * 32 + ch) * 4 + 2 * hp) * 64 + tid] = fexp(bc_s[63 * 128 + tid]);
    { const int hh = w >> 2, mi = w & 3, h = 2 * hp + hh;
        const bf16x8 a0 = frag_ks(VS, HGLD, hh * 64 + mi * 16, 0, lane), a1 = frag_ks(VS, HGLD, hh * 64 + mi * 16, 32, lane);
        float* outp = slt + ((size_t)((b * 32 + ch) * 4 + h) * 64 + mi * 16 + 4 * (lane >> 4)) * 64 + (lane & 15);
#pragma unroll
        for (int ni = 0; ni < 4; ++ni) { const bf16x8 b0 = frag_ks(KS, HGLD, hh * 64 + ni * 16, 0, lane), b1 = frag_ks(KS, HGLD, hh * 64 + ni * 16, 32, lane);
            f32x4 acc = {0.f, 0.f, 0.f, 0.f}; acc = MFMA16(a0, b0, acc); acc = MFMA16(a1, b1, acc);
            const int c = hh * 64 + ni * 16 + (lane & 15); const float sc = fexp(bc_s[63 * 128 + c] - bc_s[31 * 128 + c]);
#pragma unroll
            for (int i = 0; i < 4; ++i) outp[i * 64 + ni * 16] = acc[i] * sc; } }
    __syncthreads();
}
__device__ __forceinline__ void hg_out_unit(const bf16* proj, const float* stin, float* oraw, int b, int ch, int hp, const float* lbp, int layer, LAS unsigned char* lds, int tid) {
    LAS float* bc_s = (LAS float*)lds; LAS bf16* KS = (LAS bf16*)(lds + 32768); LAS bf16* VS = KS + 64 * HGLD; LAS bf16* QS = VS + 64 * HGLD; LAS bf16* WS = QS + 64 * HGLD;
    const int lane = tid & 63, w = tid >> 6, t0 = ch * 64;
    hg_prep<true>(proj, b, t0, hp, lbp, layer, bc_s, QS, KS, VS, tid);
    const int hh = w >> 2, mi = w & 3, h = 2 * hp + hh;
    { f32x4 sc[4];
#pragma unroll
        for (int ni = 0; ni < 4; ++ni) sc[ni] = (f32x4){0.f, 0.f, 0.f, 0.f};
#pragma unroll
        for (int kk = 0; kk < 2; ++kk) { const bf16x8 a = frag_kc(QS, HGLD, mi * 16, hh * 64 + 32 * kk, lane);
#pragma unroll
            for (int ni = 0; ni < 4; ++ni) { const bf16x8 bb = frag_kc(KS, HGLD, ni * 16, hh * 64 + 32 * kk, lane); sc[ni] = MFMA16(a, bb, sc[ni]); } }
#pragma unroll
        for (int ni = 0; ni < 4; ++ni) { const int s = ni * 16 + (lane & 15);
#pragma unroll
            for (int i = 0; i < 4; ++i) { const int t = mi * 16 + 4 * (lane >> 4) + i; WS[(hh * 64 + t) * HGWLD + s] = (bf16)f2bf(s <= t ? sc[ni][i] : 0.f); } } }
    __syncthreads();
    { f32x4 o[4];
#pragma unroll
        for (int ni = 0; ni < 4; ++ni) o[ni] = (f32x4){0.f, 0.f, 0.f, 0.f};
#pragma unroll
        for (int kk = 0; kk < 2; ++kk) { const bf16x8 a = frag_kc(WS + hh * 64 * HGWLD, HGWLD, mi * 16, 32 * kk, lane);
#pragma unroll
            for (int ni = 0; ni < 4; ++ni) { const bf16x8 bb = frag_ks(VS, HGLD, hh * 64 + ni * 16, 32 * kk, lane); o[ni] = MFMA16(a, bb, o[ni]); } }
        const float* st = stin + (size_t)((b * 32 + ch) * 4 + h) * 64 * 64;
#pragma unroll
        for (int kk = 0; kk < 2; ++kk) { const bf16x8 a = frag_kc(QS, HGLD, mi * 16, hh * 64 + 32 * kk, lane);
            float e31[8];
#pragma unroll
            for (int j = 0; j < 8; ++j) e31[j] = fexp(bc_s[31 * 128 + hh * 64 + 32 * kk + 8 * (lane >> 4) + j]);
#pragma unroll
            for (int ni = 0; ni < 4; ++ni) { const float* p = st + (size_t)(ni * 16 + (lane & 15)) * 64 + 32 * kk + 8 * (lane >> 4);
                const f32x4 x0 = *(const f32x4*)p, x1 = *(const f32x4*)(p + 4);
                v4u q; q.x = pk2(x0[0] * e31[0], x0[1] * e31[1]); q.y = pk2(x0[2] * e31[2], x0[3] * e31[3]); q.z = pk2(x1[0] * e31[4], x1[1] * e31[5]); q.w = pk2(x1[2] * e31[6], x1[3] * e31[7]);
                o[ni] = MFMA16(a, __builtin_bit_cast(bf16x8, q), o[ni]); } }
#pragma unroll
        for (int i = 0; i < 4; ++i) { const size_t row = (size_t)b * SEQ + t0 + mi * 16 + 4 * (lane >> 4) + i;
#pragma unroll
            for (int ni = 0; ni < 4; ++ni) oraw[row * DM + 512 + h * 64 + ni * 16 + (lane & 15)] = o[ni][i]; } }
    __syncthreads();
}

constexpr int RGLD = 136;
__device__ __forceinline__ void rg_local_unit(const bf16* proj, float* hloc, float* pcum, float* rgs, int b, int ch, int half, const float* conv_w, const float* conv_b, const bf16* waT, const bf16* wxT,
                                              const float* ba, const float* bx, const float* lam, LAS unsigned char* lds, int tid) {
    LAS float* xc32 = (LAS float*)lds; LAS float* a_s = xc32 + 64 * 128; LAS bf16* xcb = (LAS bf16*)(a_s + 64 * 128); LAS float* par = (LAS float*)(xcb + 64 * RGLD);
    const int lane = tid & 63, w = tid >> 6, t0 = ch * 64, cg0 = half * 128;
    if (tid < 128) { par[tid] = ba[cg0 + tid]; par[128 + tid] = bx[cg0 + tid]; par[256 + tid] = softplusf_(-lam[cg0 + tid]); }
#pragma unroll 1
    for (int it = tid; it < 64 * 16; it += NTHR) { const int t = it >> 4, c0 = (it & 15) * 8, cg = cg0 + c0; float o[8];
        const f32x4 b0 = *(const f32x4*)(conv_b + cg), b1 = *(const f32x4*)(conv_b + cg + 4);
        o[0] = b0[0]; o[1] = b0[1]; o[2] = b0[2]; o[3] = b0[3]; o[4] = b1[0]; o[5] = b1[1]; o[6] = b1[2]; o[7] = b1[3];
#pragma unroll
        for (int k = 0; k < 4; ++k) { const int ts = t0 + t - 3 + k;
            if (ts >= 0) { const v4u x = *(const v4u*)(proj + ((size_t)b * SEQ + ts) * DING + C_RGX + cg);
                const f32x4 w0 = *(const f32x4*)(conv_w + k * 256 + cg), w1 = *(const f32x4*)(conv_w + k * 256 + cg + 4);
                o[0] += w0[0] * bflo(x[0]); o[1] += w0[1] * bfhi(x[0]); o[2] += w0[2] * bflo(x[1]); o[3] += w0[3] * bfhi(x[1]);
                o[4] += w1[0] * bflo(x[2]); o[5] += w1[1] * bfhi(x[2]); o[6] += w1[2] * bflo(x[3]); o[7] += w1[3] * bfhi(x[3]); } }
        *(LAS f32x4*)(xc32 + t * 128 + c0) = (f32x4){o[0], o[1], o[2], o[3]}; *(LAS f32x4*)(xc32 + t * 128 + c0 + 4) = (f32x4){o[4], o[5], o[6], o[7]};
        v4u q; q.x = pk2(o[0], o[1]); q.y = pk2(o[2], o[3]); q.z = pk2(o[4], o[5]); q.w = pk2(o[6], o[7]); *(LAS v4u*)(xcb + t * RGLD + c0) = q; }
    __syncthreads();
    { const int nb = w >> 2, mi = w & 3, n = 2 * half + nb;
        f32x4 ra[4], ga[4];
#pragma unroll
        for (int ni = 0; ni < 4; ++ni) { ra[ni] = (f32x4){0.f, 0.f, 0.f, 0.f}; ga[ni] = (f32x4){0.f, 0.f, 0.f, 0.f}; }
#pragma unroll
        for (int kk = 0; kk < 2; ++kk) { const bf16x8 a = frag_kc(xcb, RGLD, mi * 16, nb * 64 + 32 * kk, lane);
#pragma unroll
            for (int ni = 0; ni < 4; ++ni) { const size_t off = (size_t)(n * 64 + ni * 16 + (lane & 15)) * 64 + 32 * kk + 8 * (lane >> 4);
                ra[ni] = MFMA16(a, *(const bf16x8*)(waT + off), ra[ni]); ga[ni] = MFMA16(a, *(const bf16x8*)(wxT + off), ga[ni]); } }
#pragma unroll
        for (int ni = 0; ni < 4; ++ni) { const int c = nb * 64 + ni * 16 + (lane & 15); const float bav = par[c], bxv = par[128 + c], spl = par[256 + c];
#pragma unroll
            for (int i = 0; i < 4; ++i) { const int t = mi * 16 + 4 * (lane >> 4) + i;
                const float r = fsigm(ra[ni][i] + bav), ig = fsigm(ga[ni][i] + bxv), log_a = -8.0f * r * spl;
                float mult = sqrtf(-expm1f(2.0f * log_a)); if (t0 + t == 0) mult = 1.0f;
                a_s[t * 128 + c] = expf(log_a); xc32[t * 128 + c] = mult * ig * xc32[t * 128 + c]; } } }
    __syncthreads();
    if (tid < 128) { float h = 0.f, P = 1.f; const size_t base = ((size_t)b * SEQ + t0) * 256 + cg0 + tid;
#pragma unroll 8
        for (int t = 0; t < 64; ++t) { const float a = a_s[t * 128 + tid]; h = a * h + xc32[t * 128 + tid]; P *= a; hloc[base + (size_t)t * 256] = h; pcum[base + (size_t)t * 256] = P; }
        rgs[((size_t)(b * 32 + ch) * 256 + cg0 + tid) * 2] = P; rgs[((size_t)(b * 32 + ch) * 256 + cg0 + tid) * 2 + 1] = h; }
    __syncthreads();
}

typedef float f32x16 __attribute__((ext_vector_type(16)));
#define MFMA32(a, b, c) __builtin_amdgcn_mfma_f32_32x32x16_bf16((a), (b), (c), 0, 0, 0)
constexpr int AVLD = 72;
__device__ __forceinline__ bf16x8 pack8(const f32x16& x, int o) {
    v4u w; w.x = pg8::cvt_pk_bf16(x[o], x[o + 1]); w.y = pg8::cvt_pk_bf16(x[o + 2], x[o + 3]); w.z = pg8::cvt_pk_bf16(x[o + 4], x[o + 5]); w.w = pg8::cvt_pk_bf16(x[o + 6], x[o + 7]);
    return __builtin_bit_cast(bf16x8, w);
}
__device__ __forceinline__ float lk2(float z) { return -(fmaxf(z, 0.f) + __builtin_amdgcn_logf(1.0f + __builtin_amdgcn_exp2f(-fabsf(z)))); }
__device__ __forceinline__ void attn_unit(const bf16* proj, float* oraw, int b, int h, int qb, LAS bf16* VL, int lane) {
    const int q = lane & 31, h2 = lane >> 5, qw = qb * 32; const size_t rowb = (size_t)b * SEQ;
    bf16x8 qf[4];
    { const bf16* qp = proj + (rowb + qw + q) * DING + C_SBQ + h * 64 + 8 * h2; const float C2 = 0.125f * 1.4426950408889634f;
#pragma unroll
        for (int kk = 0; kk < 4; ++kk) { const v4u w = *(const v4u*)(qp + 16 * kk); v4u o;
            o.x = pg8::cvt_pk_bf16(bflo(w.x) * C2, bfhi(w.x) * C2); o.y = pg8::cvt_pk_bf16(bflo(w.y) * C2, bfhi(w.y) * C2); o.z = pg8::cvt_pk_bf16(bflo(w.z) * C2, bfhi(w.z) * C2); o.w = pg8::cvt_pk_bf16(bflo(w.w) * C2, bfhi(w.w) * C2);
            qf[kk] = __builtin_bit_cast(bf16x8, o); } }
    bf16x8 m0[2], ones;
#pragma unroll
    for (int s = 0; s < 2; ++s) {
#pragma unroll
        for (int jj = 0; jj < 8; ++jj) { const int j = 16 * s + 8 * (jj >> 2) + 4 * h2 + (jj & 3); m0[s][jj] = (short)(j >= q ? 0x3F80 : 0); } }
#pragma unroll
    for (int jj = 0; jj < 8; ++jj) ones[jj] = (short)0x3F80;
    f32x16 o0, o1;
#pragma unroll
    for (int r = 0; r < 16; ++r) { o0[r] = 0.f; o1[r] = 0.f; }
    float R = 0.f;
    const int sd = (qw >> 6) << 6;
    for (int s0 = sd; s0 >= 0; s0 -= 64) {
        bf16x8 kf[2][4];
        { const bf16* kp = proj + (rowb + s0 + q) * DING + C_SBK + h * 64 + 8 * h2;
#pragma unroll
            for (int hf = 0; hf < 2; ++hf)
#pragma unroll
                for (int kk = 0; kk < 4; ++kk) kf[hf][kk] = *(const bf16x8*)(kp + (size_t)hf * 32 * DING + 16 * kk); }
#pragma unroll
        for (int i = 0; i < 8; ++i) { const int row = (lane >> 3) + 8 * i; const v4u w = *(const v4u*)(proj + (rowb + s0 + row) * DING + C_SBV + h * 64 + 8 * (lane & 7)); *(LAS v4u*)(VL + row * AVLD + 8 * (lane & 7)) = w; }
        f32x16 z0, z1;
#pragma unroll
        for (int r = 0; r < 16; ++r) { z0[r] = 0.f; z1[r] = 0.f; }
#pragma unroll
        for (int kk = 0; kk < 4; ++kk) { z0 = MFMA32(kf[0][kk], qf[kk], z0); z1 = MFMA32(kf[1][kk], qf[kk], z1); }
        const int lim = (s0 == sd) ? (qw - sd) + q : 64;
        f32x16 l0, l1;
#pragma unroll
        for (int r = 0; r < 16; ++r) { const int key = (r & 3) + 8 * (r >> 2) + 4 * h2; l0[r] = key < lim ? lk2(z0[r]) : 0.f; l1[r] = key + 32 < lim ? lk2(z1[r]) : 0.f; }
        const bf16x8 bl0 = pack8(l0, 0), bl1 = pack8(l0, 8), bh0 = pack8(l1, 0), bh1 = pack8(l1, 8);
        f32x16 i0 = z0, i1 = z1;
        i0 = MFMA32(m0[0], bl0, i0); i0 = MFMA32(m0[1], bl1, i0); i0 = MFMA32(ones, bh0, i0); i0 = MFMA32(ones, bh1, i0);
        i1 = MFMA32(m0[0], bh0, i1); i1 = MFMA32(m0[1], bh1, i1);
        float tot = h2 == 0 ? i0[0] - z0[0] : 0.f; tot += __shfl_xor(tot, 32);
#pragma unroll
        for (int r = 0; r < 16; ++r) { const int key = (r & 3) + 8 * (r >> 2) + 4 * h2; l0[r] = key < lim ? __builtin_amdgcn_exp2f(i0[r] + R) : 0.f; l1[r] = key + 32 < lim ? __builtin_amdgcn_exp2f(i1[r] + R) : 0.f; }
        R += tot;
        const bf16x8 pa0 = pack8(l0, 0), pa1 = pack8(l0, 8), pa2 = pack8(l1, 0), pa3 = pack8(l1, 8);
        const LAS bf16* vb = VL + (4 * h2 + ((lane & 15) >> 2)) * AVLD + 16 * ((lane >> 4) & 1) + 4 * (lane & 3);
#define VFRAG(kb, db) ({ const s16x4 lo_ = __builtin_bit_cast(s16x4, __builtin_amdgcn_ds_read_tr16_b64_v4i16((LAS v4i16_t*)(vb + (kb) * AVLD + (db) * 32))); \
                         const s16x4 hi_ = __builtin_bit_cast(s16x4, __builtin_amdgcn_ds_read_tr16_b64_v4i16((LAS v4i16_t*)(vb + ((kb) + 8) * AVLD + (db) * 32))); \
                         (bf16x8){lo_[0], lo_[1], lo_[2], lo_[3], hi_[0], hi_[1], hi_[2], hi_[3]}; })
        o0 = MFMA32(pa0, VFRAG(0, 0), o0); o1 = MFMA32(pa0, VFRAG(0, 1), o1);
        o0 = MFMA32(pa1, VFRAG(16, 0), o0); o1 = MFMA32(pa1, VFRAG(16, 1), o1);
        o0 = MFMA32(pa2, VFRAG(32, 0), o0); o1 = MFMA32(pa2, VFRAG(32, 1), o1);
        o0 = MFMA32(pa3, VFRAG(48, 0), o0); o1 = MFMA32(pa3, VFRAG(48, 1), o1);
#undef VFRAG
        if (__all(R < -127.0f)) break;
    }
    float* op = oraw + (rowb + qw) * DM + h * 64 + q;
#pragma unroll
    for (int r = 0; r < 16; ++r) { const int qq = (r & 3) + 8 * (r >> 2) + 4 * h2; op[(size_t)qq * DM] = o0[r]; op[(size_t)qq * DM + 32] = o1[r]; }
}

constexpr int NPL = 11, NPHASE = 1 + NPL * DEPTH;
struct Args { const float* in[29]; float* out; unsigned char* ws; int ph_lo, ph_hi, use_bar, pad; };

typedef const __attribute__((address_space(4))) Args* KArgP;
__device__ __forceinline__ KArgP kargs() { KArgP p = (KArgP)__builtin_amdgcn_kernarg_segment_ptr(); asm volatile("" : "+s"(p)); return p; }
#define WSP(type, off) ((type*)(kargs()->ws + (off)))
#define INP(i) (kargs()->in[i])

__global__ void __launch_bounds__(NTHR, 2) fwd_kernel(Args args_unused) {
    extern __shared__ __attribute__((aligned(16))) unsigned char lds_raw[];
    LAS unsigned char* lds = (LAS unsigned char*)lds_raw;
    LAS float* ldsf = (LAS float*)lds_raw;
    volatile LAS unsigned* MISC = (volatile LAS unsigned*)(lds + MISC_OFF);
    LAS int* tb = (LAS int*)(lds + TB_OFF);
    const int tid0 = threadIdx.x;
#define PH_IDS int tid = threadIdx.x; asm volatile("" : "+v"(tid)); const int lane = tid & 63, wave = __builtin_amdgcn_readfirstlane(tid >> 6); const int gw = vcu * NWAVES + wave; (void)lane; (void)gw;
    const int G = gridDim.x, bx = blockIdx.x;
    const int vcu = (G % 8 == 0) ? (bx % 8) * (G / 8) + bx / 8 : bx;
    const int NGW = G * NWAVES;
    gu32* ctl = (gu32*)WSP(unsigned char, WS_CTL);

    for (int u = tid0; u < (LDS_BYTES - LDSCTL_OFF) / 4; u += NTHR) ((LAS unsigned*)(lds + LDSCTL_OFF))[u] = 0u;
    __syncthreads();
    XcdBarrier bar; bar.bar = (unsigned*)(ctl + CW_BAR); bar.x = 0; bar.st = nullptr;
    if (kargs()->use_bar) bar = xcd_barrier_post((unsigned*)(ctl + CW_BAR), MISC + 8);
    const int lo = kargs()->ph_lo, hi = kargs()->ph_hi;
#ifndef PH_MASK
#define PH_MASK 0xfff
#endif
#ifndef REP_MASK
#define REP_MASK 0
#endif
#define IN(k) (lo <= (k) && (k) < hi)
#define EN(ty) ((PH_MASK >> (ty)) & 1)
#define REPS(ty) (1 + ((REP_MASK >> (ty)) & 1))
#define SEAM(k) do { if (IN(k) && IN((k) + 1)) xcd_barrier(bar); } while (0)
#define PHASE(ty, k) if (EN(ty) && IN(k)) _Pragma("unroll 1") for (int rep_ = 0; rep_ < REPS(ty); ++rep_)

    PHASE(11, 0) { PH_IDS
        LAS float* scr = ldsf + wave * (64 * 65);
        for (int it = gw; it < NITEMS; it += NGW) {
            int r = it;
            if (r < NIT_WIN) { const int l = r / IT_WIN, q = r % IT_WIN; transpose_item<false>(INP(2) + (size_t)l * DM * DIN, DIN, WSP(bf16, WS_WIN) + (size_t)l * DING * DM, DM, 64 * (q / 52), 64 * (q % 52), scr, lane); continue; }
            r -= NIT_WIN;
            if (r < NIT_WOUT) { const int l = r / IT_WOUT, q = r % IT_WOUT; transpose_item<false>(INP(20) + (size_t)l * DM * DM, DM, WSP(bf16, WS_WOUT) + (size_t)l * DM * DM, DM, 64 * (q / 16), 64 * (q % 16), scr, lane); continue; }
            r -= NIT_WOUT;
            if (r < NIT_GU) { const int le = r / IT_GU, q = r % IT_GU; transpose_item<true>(INP(24) + (size_t)le * DM * 2048, 2048, WSP(bf16, WS_WGU) + (size_t)le * 2048 * DM, DM, 64 * (q / 32), 64 * (q % 32), scr, lane); continue; }
            r -= NIT_GU;
            { const int le = r / IT_DN, q = r % IT_DN; transpose_item<false>(INP(26) + (size_t)le * DFF * DM, DM, WSP(bf16, WS_WDN) + (size_t)le * DM * DFF, DFF, 64 * (q / 16), 64 * (q % 16), scr, lane); }
        }
        for (int idx = gw * 64 + lane; idx < DEPTH * 4 * 4096; idx += NGW * 64) { const int i = idx & 63, j = (idx >> 6) & 63, ln = idx >> 12;
            WSP(bf16, WS_WAT)[idx] = (bf16)f2bf(INP(6)[(size_t)ln * 4096 + i * 64 + j]); WSP(bf16, WS_WAT + 512 * 1024)[idx] = (bf16)f2bf(INP(8)[(size_t)ln * 4096 + i * 64 + j]); }
        for (int m = gw; m < T; m += NGW) { f32x4 v[4];
#pragma unroll
            for (int j = 0; j < 4; ++j) v[j] = *(const f32x4*)(INP(0) + (size_t)m * DM + 256 * j + 4 * lane);
            emit_xn_dt(v, INP(1), INP(2), WSP(bf16, WS_XN) + (size_t)m * DM, WSP(float, WS_DT) + (size_t)m * 4, lane); }
    }
    SEAM(0);

#pragma unroll 1
    for (int l = 0; l < DEPTH; ++l) {
        const int P = 1 + NPL * l;
        PHASE(0, P) { PH_IDS
            pg8::Gemm g{WSP(bf16, WS_XN), WSP(bf16, WS_WIN) + (size_t)l * DING * DM, T, DING, DM}; pg8::StaticOrder S; S.init(T, DING, G, bx);
            pg8::EpiBf16 E{WSP(bf16, WS_PROJ), DING, nullptr, 0};
            pg8::gemm_phase<pg8::EpiBf16, pg8::StaticOrder, true, true>(lds, g, S, E);
        }
        SEAM(P);
        PHASE(1, P + 1) { PH_IDS
#pragma unroll 1
            for (int u = vcu; u < 512; u += G) m2_state_unit(WSP(bf16, WS_PROJ), WSP(float, WS_DT), WSP(float, WS_SLOC), WSP(float, WS_DEC), u >> 6, (u >> 1) & 31, u & 1, INP(14) + l * 3072, INP(15) + l * 768, INP(16) + l * 4, INP(17) + l * 4, lds, tid);
#pragma unroll 1
            for (int u = vcu; u < 512; u += G) hg_state_unit(WSP(bf16, WS_PROJ), WSP(float, WS_SLT), WSP(float, WS_DECC), u >> 6, (u >> 1) & 31, u & 1, INP(12), l, lds, tid);
#pragma unroll 1
            for (int u = vcu; u < 512; u += G) rg_local_unit(WSP(bf16, WS_PROJ), WSP(float, WS_HLOC), WSP(float, WS_PCUM), WSP(float, WS_RGS), u >> 6, (u >> 1) & 31, u & 1, INP(4) + l * 1024, INP(5) + l * 256,
                                                             WSP(bf16, WS_WAT) + l * 16384, WSP(bf16, WS_WAT + 512 * 1024) + l * 16384, INP(7) + l * 256, INP(9) + l * 256, INP(10) + l * 256, lds, tid);
            for (int u = gw; u < 2048; u += NGW) { const int qb = 63 - (u >> 5), bh = u & 31; attn_unit(WSP(bf16, WS_PROJ), WSP(float, WS_ORAW), bh >> 2, bh & 3, qb, (LAS bf16*)(lds + wave * (64 * AVLD * 2)), lane); }
        }
        SEAM(P + 1);
        PHASE(2, P + 2) { PH_IDS
            { float* sl = WSP(float, WS_SLOC); const float* dc = WSP(float, WS_DEC);
                const int e = (vcu * NTHR + tid) * 2, n = e & 127, p = (e >> 7) & 63, h = (e >> 13) & 3, b = e >> 15;
                if (b < NB) { float r0 = 0.f, r1 = 0.f;
#pragma unroll 8
                    for (int c = 0; c < 32; ++c) { float* a = sl + ((size_t)((b * 32 + c) * 4 + h) * 64 + p) * 128 + n; const float d = dc[(b * 32 + c) * 4 + h];
                        const float s0 = a[0], s1 = a[1]; a[0] = r0; a[1] = r1; r0 = d * r0 + s0; r1 = d * r1 + s1; } } }
            { float* sl = WSP(float, WS_SLT); const float* dc = WSP(float, WS_DECC);
                const int e = vcu * NTHR + tid, c = e & 63, v = (e >> 6) & 63, h = (e >> 12) & 3, b = e >> 14;
                if (b < NB) { float r = 0.f;
#pragma unroll 8
                    for (int k = 0; k < 32; ++k) { float* a = sl + ((size_t)((b * 32 + k) * 4 + h) * 64 + v) * 64 + c; const float d = dc[(size_t)((b * 32 + k) * 4 + h) * 64 + c];
                        const float s0 = a[0]; a[0] = r; r = d * r + s0; } } }
            { const int e = vcu * NTHR + tid;
                if (e < NB * 256) { const int b = e >> 8, c = e & 255; const float* rs = WSP(float, WS_RGS); float* cy = WSP(float, WS_CARRY); float r = 0.f;
#pragma unroll 8
                    for (int k = 0; k < 32; ++k) { const size_t o = (size_t)(b * 32 + k) * 256 + c; cy[o] = r; r = rs[2 * o] * r + rs[2 * o + 1]; } } }
        }
        SEAM(P + 2);
        PHASE(3, P + 3) { PH_IDS
#pragma unroll 1
            for (int u = vcu; u < 512; u += G) m2_out_unit(WSP(bf16, WS_PROJ), WSP(float, WS_DT), WSP(float, WS_SLOC), WSP(float, WS_ORAW), u >> 6, (u >> 1) & 31, u & 1, INP(14) + l * 3072, INP(15) + l * 768, INP(16) + l * 4, INP(17) + l * 4, INP(18) + l * 4, lds, tid);
#pragma unroll 1
            for (int u = vcu; u < 512; u += G) hg_out_unit(WSP(bf16, WS_PROJ), WSP(float, WS_SLT), WSP(float, WS_ORAW), u >> 6, (u >> 1) & 31, u & 1, INP(12), l, lds, tid);
            { const float* hl = WSP(float, WS_HLOC); const float* pc = WSP(float, WS_PCUM); const float* cy = WSP(float, WS_CARRY); const bf16* pj = WSP(bf16, WS_PROJ); float* orw = WSP(float, WS_ORAW);
                _Pragma("unroll 1") for (int m = gw; m < T; m += NGW) { const int c = 4 * lane; const size_t cb = (size_t)(m >> 6) * 256 + c;
                    const f32x4 hv = *(const f32x4*)(hl + (size_t)m * 256 + c), pv = *(const f32x4*)(pc + (size_t)m * 256 + c), cv = *(const f32x4*)(cy + cb);
                    const u32x2 gwd = *(const u32x2*)(pj + (size_t)m * DING + C_RGG + c);
                    f32x4 o = hv + pv * cv; o[0] *= gelu_tanh(bflo(gwd.x)); o[1] *= gelu_tanh(bfhi(gwd.x)); o[2] *= gelu_tanh(bflo(gwd.y)); o[3] *= gelu_tanh(bfhi(gwd.y));
                    *(f32x4*)(orw + (size_t)m * DM + 256 + c) = o; } }
        }
        SEAM(P + 3);
        PHASE(4, P + 4) { PH_IDS
            _Pragma("unroll 1") for (int m = gw; m < T; m += NGW) norm_row(WSP(float, WS_ORAW) + (size_t)m * DM, WSP(bf16, WS_PROJ) + (size_t)m * DING, WSP(bf16, WS_MIX) + (size_t)m * DM, INP(3) + l * 256, INP(11) + l * 256, INP(13) + l * 256, INP(19) + l * 256, lane);
        }
        SEAM(P + 4);
        PHASE(5, P + 5) { PH_IDS
            pg8::Gemm g{WSP(bf16, WS_MIX), WSP(bf16, WS_WOUT) + (size_t)l * DM * DM, T, DM, DM}; pg8::StaticOrder S; S.init(T, DM, G, bx);
            pg8::EpiResF32 E{l == 0 ? INP(0) : WSP(float, WS_HB), WSP(float, WS_H1), DM};
            pg8::gemm_phase<pg8::EpiResF32, pg8::StaticOrder, true, true>(lds, g, S, E);
        }
        SEAM(P + 5);
        PHASE(6, P + 6) { PH_IDS
            const float* rw = INP(22) + (size_t)l * DM * NE;
            for (int idx = tid; idx < NE * DM; idx += NTHR) { const int e = idx >> 10, k = idx & 1023; ldsf[idx] = rw[k * NE + e]; }
            __syncthreads();
            LAS int* lh = (LAS int*)(lds + 131072);
            int cntl = 0, myE = 0, myRank = 0; float myGate = 0.f;
            _Pragma("unroll 1") for (int r = 0; r < 8; ++r) { const int m = vcu * 64 + wave * 8 + r; asm volatile("" ::: "memory");
                int oe, orank; float og;
                router_row(WSP(float, WS_H1) + (size_t)m * DM, INP(21) + l * DM, ldsf, INP(23) + l * NE, WSP(bf16, WS_XN) + (size_t)m * DM, cntl, oe, orank, og, lane);
                if ((lane >> 2) == r) { myE = oe; myRank = orank; myGate = og; } }
            if (lane < 32) lh[wave * 32 + lane] = cntl;
            __syncthreads();
            if (tid < 32) { int s = 0; for (int w = 0; w < 8; ++w) s += lh[w * 32 + tid]; WSP(int, WS_HIST)[(size_t)vcu * 32 + tid] = s; }
            { int base = 0; if (lane < 32) for (int w = 0; w < wave; ++w) base += lh[w * 32 + lane];
                const int add = __shfl(base, myE);
                if (lane < 32) { const int a = (vcu * 64 + wave * 8) * 4 + lane; WSP(int, WS_ASGE)[a] = myE; WSP(int, WS_ASGP)[a] = myRank + add; WSP(float, WS_GATE)[a] = myGate; } }
        }
        SEAM(P + 6);
        PHASE(7, P + 7) { PH_IDS
            LAS int* bs = (LAS int*)(lds + 131072);
            if (tid < 32) { const int* hs = WSP(int, WS_HIST); int base = 0, tot = 0;
#pragma unroll 8
                for (int w = 0; w < G; ++w) { const int c = hs[w * 32 + tid]; tot += c; if (w < vcu) base += c; }
                bs[tid] = base; bs[32 + tid] = tot; if (vcu == 0) WSP(int, WS_TOT)[tid] = tot; }
            __syncthreads();
            if (tid == 0) { int run = 0; for (int e = 0; e < 32; ++e) { tb[e] = run; run += (bs[32 + e] + 255) >> 8; } tb[32] = run; }
            __syncthreads();
            const int* asge = WSP(int, WS_ASGE); const int* asgp = WSP(int, WS_ASGP); int* slotp = WSP(int, WS_SLOT); const bf16* xn = WSP(bf16, WS_XN); bf16* xs = WSP(bf16, WS_XS);
            for (int i = wave; i < 256; i += NWAVES) { const int a = vcu * 256 + i; const int e = asge[a], slot = tb[e] * 256 + bs[e] + asgp[a], t = a >> 2;
                const v4u* src = (const v4u*)(xn + (size_t)t * DM); v4u* dst = (v4u*)(xs + (size_t)slot * DM);
                const v4u a0 = src[lane], a1 = src[lane + 64]; dst[lane] = a0; dst[lane + 64] = a1;
                if (lane == 0) slotp[a] = slot; }
        }
        SEAM(P + 7);
        PHASE(8, P + 8) { PH_IDS
            build_tb(WSP(int, WS_TOT), tb, tid);
            pg8::Gemm g{WSP(bf16, WS_XS), WSP(bf16, WS_WGU) + (size_t)l * NE * 2048 * DM, MAXSLOT, 2048, DM}; pg8::MoeOrder S{(const LAS int*)tb, 8, G, bx};
            pg8::EpiSwiglu E{WSP(bf16, WS_ACT), INP(25) + (size_t)l * NE * 2048};
            pg8::gemm_phase<pg8::EpiSwiglu, pg8::MoeOrder, true, true>(lds, g, S, E);
        }
        SEAM(P + 8);
        PHASE(9, P + 9) { PH_IDS
            build_tb(WSP(int, WS_TOT), tb, tid);
            pg8::Gemm g{WSP(bf16, WS_ACT), WSP(bf16, WS_WDN) + (size_t)l * NE * DM * DFF, MAXSLOT, DM, DFF}; pg8::MoeOrder S{(const LAS int*)tb, 4, G, bx};
            pg8::EpiBf16 E{WSP(bf16, WS_Y), DM, INP(27) + (size_t)l * NE * DM, DM};
            pg8::gemm_phase<pg8::EpiBf16, pg8::MoeOrder, true, true>(lds, g, S, E);
        }
        SEAM(P + 9);
        PHASE(10, P + 10) { PH_IDS
            const float* h1 = WSP(float, WS_H1); const int* slotp = WSP(int, WS_SLOT); const float* gatep = WSP(float, WS_GATE); const bf16* yb = WSP(bf16, WS_Y);
            for (int m = gw; m < T; m += NGW) { f32x4 v[4];
#pragma unroll
                for (int j = 0; j < 4; ++j) v[j] = *(const f32x4*)(h1 + (size_t)m * DM + 256 * j + 4 * lane);
#pragma unroll
                for (int r = 0; r < 4; ++r) { const int slot = slotp[m * 4 + r]; const float gg = gatep[m * 4 + r]; const bf16* yr = yb + (size_t)slot * DM;
#pragma unroll
                    for (int j = 0; j < 4; ++j) { const u32x2 w = *(const u32x2*)(yr + 256 * j + 4 * lane); v[j][0] += gg * bflo(w.x); v[j][1] += gg * bfhi(w.x); v[j][2] += gg * bflo(w.y); v[j][3] += gg * bfhi(w.y); } }
                if (l + 1 < DEPTH) {
#pragma unroll
                    for (int j = 0; j < 4; ++j) *(f32x4*)(WSP(float, WS_HB) + (size_t)m * DM + 256 * j + 4 * lane) = v[j];
                    emit_xn_dt(v, INP(1) + (l + 1) * DM, INP(2) + (size_t)(l + 1) * DM * DIN, WSP(bf16, WS_XN) + (size_t)m * DM, WSP(float, WS_DT) + (size_t)m * 4, lane);
                } else { float ss = 0.f;
#pragma unroll
                    for (int j = 0; j < 4; ++j) ss += (v[j][0] * v[j][0] + v[j][1] * v[j][1]) + (v[j][2] * v[j][2] + v[j][3] * v[j][3]);
                    ss = wave_sum(ss); const float rstd = 1.0f / sqrtf(ss * (1.0f / DM) + EPS);
#pragma unroll
                    for (int j = 0; j < 4; ++j) *(f32x4*)(kargs()->out + (size_t)m * DM + 256 * j + 4 * lane) = v[j] * rstd * *(const f32x4*)(INP(28) + 256 * j + 4 * lane); }
            }
        }
        if (l + 1 < DEPTH) SEAM(P + 10);
    }
#undef IN
#undef SEAM
}

extern "C" void kernel_launch(void* const* d_in, const int* in_sizes, int n_in, void* d_out, int out_size, void* d_ws, size_t ws_size, hipStream_t stream) {
    static int grid = 0;
    if (grid == 0) {
        if (n_in != 29 || in_sizes[0] != T * DM || out_size != T * DM || ws_size < WS_END) { fprintf(stderr, "kernel_launch: unexpected shapes (n_in %d, in0 %d, out %d, ws %zu); nothing launched\n", n_in, n_in > 0 ? in_sizes[0] : -1, out_size, ws_size); grid = -1; return; }
        int dev = 0, cus = 0, per_cu = 0;
        if (hipGetDevice(&dev) != hipSuccess || hipDeviceGetAttribute(&cus, hipDeviceAttributeMultiprocessorCount, dev) != hipSuccess) { grid = -1; return; }
        if (hipFuncSetAttribute((const void*)fwd_kernel, hipFuncAttributeMaxDynamicSharedMemorySize, LDS_BYTES) != hipSuccess) { fprintf(stderr, "kernel_launch: hipFuncSetAttribute failed\n"); grid = -1; return; }
        if (hipOccupancyMaxActiveBlocksPerMultiprocessor(&per_cu, (const void*)fwd_kernel, NTHR, LDS_BYTES) != hipSuccess || per_cu < 1) fprintf(stderr, "kernel_launch: occupancy query reports %d\n", per_cu);
        (void)hipGetLastError();
        grid = cus;
    }
    if (grid < 0) return;
    if (hipMemsetAsync((char*)d_ws + WS_CTL, 0, CTL_ZERO_BYTES, stream) != hipSuccess) { fprintf(stderr, "kernel_launch: memset failed\n"); return; }
    Args a{};
    for (int i = 0; i < 29; ++i) a.in[i] = (const float*)d_in[i];
    a.out = (float*)d_out; a.ws = (unsigned char*)d_ws;
#if MK_N_LAUNCHES == 1
    a.ph_lo = 0; a.ph_hi = NPHASE; a.use_bar = 1;
    hipLaunchKernelGGL(fwd_kernel, dim3(grid), dim3(NTHR), LDS_BYTES, stream, a);
#else
    for (int p = 0; p < NPHASE; ++p) { a.ph_lo = p; a.ph_hi = p + 1; a.use_bar = 0; hipLaunchKernelGGL(fwd_kernel, dim3(grid), dim3(NTHR), LDS_BYTES, stream, a); }
#endif
}
```

```cpp
#include <hip/hip_runtime.h>
#include <cstdio>
#include <cstdint>

#ifndef MK_N_LAUNCHES
#define MK_N_LAUNCHES 1
#endif

constexpr int NB = 8, SEQ = 2048, DM = 1024, T = NB * SEQ, DEPTH = 2;
constexpr int DIN = 3332, DING = 3328;
constexpr int NE = 32, TOPK = 4, DFF = 1024;
constexpr int NASG = T * TOPK;
constexpr int MAXSLOT = NASG + NE * 256;
constexpr float EPS = 1e-6f;
constexpr int C_SBQ = 0, C_SBK = 256, C_SBV = 512, C_RGX = 768, C_RGG = 1024, C_HGQ = 1280, C_HGF = 1536, C_HGI = 1792, C_HGG = 2048,
              C_M2Z = 2304, C_M2X = 2560, C_DT = 3328;
constexpr int NWAVES = 8, NTHR = 512;

constexpr size_t MiB = 1u << 20;
constexpr size_t WS_CTL = 0, CTL_ZERO_BYTES = 1 * MiB;
constexpr size_t WS_WIN = 2 * MiB;
constexpr size_t WS_WOUT = 16 * MiB;
constexpr size_t WS_WGU = 32 * MiB;
constexpr size_t WS_WDN = 288 * MiB;
constexpr size_t WS_XN = 416 * MiB;
constexpr size_t WS_PROJ = 448 * MiB;
constexpr size_t WS_ORAW = 552 * MiB;
constexpr size_t WS_MIX = 616 * MiB;
constexpr size_t WS_H1 = 648 * MiB;
constexpr size_t WS_HB = 712 * MiB;
constexpr size_t WS_XS = 776 * MiB;
constexpr size_t WS_ACT = 920 * MiB;
constexpr size_t WS_Y = 1064 * MiB;
constexpr size_t WS_DT = 1208 * MiB;
constexpr size_t WS_ASGE = 1209 * MiB;
constexpr size_t WS_ASGP = 1210 * MiB;
constexpr size_t WS_GATE = 1211 * MiB;
constexpr size_t WS_SLOT = 1212 * MiB;
constexpr size_t WS_SLOC = 1216 * MiB;
constexpr size_t WS_DEC = 1248 * MiB;
constexpr size_t WS_SLT = 1250 * MiB;
constexpr size_t WS_DECC = 1266 * MiB;
constexpr size_t WS_HLOC = 1268 * MiB;
constexpr size_t WS_PCUM = 1284 * MiB;
constexpr size_t WS_RGS = 1300 * MiB;
constexpr size_t WS_CARRY = 1301 * MiB;
constexpr size_t WS_WAT = 1302 * MiB;
constexpr size_t WS_HIST = 1303 * MiB;
constexpr size_t WS_TOT = WS_HIST + 512 * 1024;
constexpr size_t WS_LB1 = WS_HIST + 768 * 1024;
constexpr size_t WS_PREVB = 1304 * MiB;
constexpr size_t WS_STB = 1320 * MiB;
constexpr size_t WS_END = 1328 * MiB;
constexpr int CW_TMO = 0, CW_CODE = 1;
constexpr int CW_CNT = 256;
constexpr int CW_BAR = 4096;
constexpr size_t CTL_TOKS = 256 * 1024;

constexpr int LDS_BYTES = 147456;
constexpr int LDSCTL_OFF = LDS_BYTES - 1024;
constexpr int MISC_OFF = LDSCTL_OFF;
constexpr int TB_OFF = LDSCTL_OFF + 256;

namespace pg8 {
#define PG8_LAS __attribute__((address_space(3)))
typedef unsigned short bf16_t;
typedef short bf16x8 __attribute__((ext_vector_type(8)));
typedef float f32x4 __attribute__((ext_vector_type(4)));
typedef unsigned u32x4 __attribute__((ext_vector_type(4)));
constexpr int BM = 256, BK = 64, HALF = 128, HTB = HALF * BK * 2  , STAGE_BYTES = 8 * HTB, NXCD = 8, WGM = 8;

__host__ __device__ __forceinline__ int lds_byte(int r, int c) { const int st = (r >> 4) * 2 + (c >> 5), rr = r & 15, cc = c & 31, ob = rr * 64 + cc * 2; return st * 1024 + (ob ^ (((ob >> 9) & 1) << 5)); }
__host__ __device__ __forceinline__ void stage_rc(int b, int& R, int& C) { const int st = b / 1024, sb = b % 1024, swz = sb ^ (((sb >> 9) & 1) << 5); R = (st >> 1) * 16 + swz / 64; C = (st & 1) * 32 + (swz % 64) / 2; }
__host__ __device__ __forceinline__ int perm32(int rho) { const int n = rho >> 4, i = rho & 15; return 8 * (i >> 2) + 4 * n + (i & 3); }

struct Unit { int pm, pn, pb, e, ui; };
struct Gemm { const bf16_t* A; const bf16_t* Bt; int M, N, K; };

__host__ __device__ __forceinline__ int xcd_remap(int wgid, int nwg) { const int q = nwg / NXCD, r = nwg % NXCD, xcd = wgid % NXCD, off = wgid / NXCD; return (xcd < r ? xcd * (q + 1) : r * (q + 1) + (xcd - r) * q) + off; }

struct StaticOrder {
    int nM, nN, nwg, G, c;
    __host__ __device__ void init(int M, int N, int G_, int c_) { nM = M / BM; nN = N / BM; nwg = nM * nN; G = G_; c = c_; }
    __host__ __device__ bool next(int i, Unit& u) const {
        const long L = (long)i * G + c; if (L >= nwg) return false;
        const int wgid = xcd_remap((int)L, nwg);
        const int nig = WGM * nN, gid = wgid / nig, fm = gid * WGM, gsz = (nM - fm) < WGM ? (nM - fm) : WGM;
        u.pm = fm + ((wgid % nig) % gsz); u.pn = (wgid % nig) / gsz; u.pb = u.pn; u.e = 0; u.ui = i; return true;
    }
    __device__ __forceinline__ void a_ready(const Unit&) const {}
    __device__ __forceinline__ void done(const Unit&) const {}
    __device__ __forceinline__ size_t a_base(const Unit& u, size_t tstep) const { return (size_t)u.pm * tstep; }
    __device__ __forceinline__ unsigned a_off(const Unit&, int r, int K) const { return (unsigned)(r * K) * 2u; }
};
struct MoeOrder {
    const PG8_LAS int* tb; int NP, G, c; const PG8_LAS int* tokl;
    __device__ __forceinline__ bool next(int i, Unit& u) const {
        const int ntot = tb[32], nunits = ntot * NP;
        const long L = (long)i * G + c; if (L >= nunits) return false;
        const int id = xcd_remap((int)L, nunits);
        int e = 0;
        for (int j = 1; j < 32; ++j) if (id >= tb[j] * NP) e = j;
        e = __builtin_amdgcn_readfirstlane(e);
        const int t0 = tb[e], nt = tb[e + 1] - t0, rem = id - t0 * NP;
        u.pm = __builtin_amdgcn_readfirstlane(t0 + rem % nt); u.pn = __builtin_amdgcn_readfirstlane(rem / nt); u.pb = e * NP + u.pn; u.e = e; u.ui = i; return true;
    }
    __device__ __forceinline__ void a_ready(const Unit&) const {}
    __device__ __forceinline__ void done(const Unit&) const {}
    __device__ __forceinline__ size_t a_base(const Unit& u, size_t tstep) const { return tokl ? (size_t)0 : (size_t)u.pm * tstep; }
    __device__ __forceinline__ unsigned a_off(const Unit& u, int r, int K) const { return tokl ? (unsigned)(tokl[u.ui * 256 + r] * K) * 2u : (unsigned)(r * K) * 2u; }
};

__device__ __forceinline__ unsigned cvt_pk_bf16(float lo, float hi) { unsigned r; asm volatile("v_cvt_pk_bf16_f32 %0, %1, %2" : "=v"(r) : "v"(lo), "v"(hi)); return r; }

struct EpiBf16 {
    static constexpr bool PERM = true, AFTER_DRAIN = false;
    bf16_t* O; int ldc; const float* bias; int bias_estride;
    __device__ __forceinline__ void operator()(const f32x4 (&acc)[2][2][4][2], const Unit& u, int wr, int wc, int fr, int fq) const {
        const int row0 = u.pm * BM + wr * 64 + fr; const int col0 = u.pn * BM + wc * 32 + 8 * fq;
        f32x4 bv[2][2];
#pragma unroll
        for (int bj = 0; bj < 2; ++bj)
#pragma unroll
            for (int n = 0; n < 2; ++n) bv[bj][n] = bias ? *(const f32x4*)(bias + (size_t)u.e * bias_estride + col0 + bj * HALF + 4 * n) : (f32x4){0.f, 0.f, 0.f, 0.f};
#pragma unroll
        for (int ai = 0; ai < 2; ++ai)
#pragma unroll
            for (int m = 0; m < 4; ++m) { bf16_t* rowp = O + (size_t)(row0 + ai * HALF + m * 16) * ldc + col0;
#pragma unroll
                for (int bj = 0; bj < 2; ++bj) { const f32x4 v0 = acc[ai][bj][m][0] + bv[bj][0], v1 = acc[ai][bj][m][1] + bv[bj][1];
                    u32x4 w; w.x = cvt_pk_bf16(v0[0], v0[1]); w.y = cvt_pk_bf16(v0[2], v0[3]); w.z = cvt_pk_bf16(v1[0], v1[1]); w.w = cvt_pk_bf16(v1[2], v1[3]);
                    *(u32x4*)(rowp + bj * HALF) = w; } }
    }
};
struct EpiResF32 {
    static constexpr bool PERM = false, AFTER_DRAIN = false;
    const float* base; float* out; int ldc;
    __device__ __forceinline__ void operator()(const f32x4 (&acc)[2][2][4][2], const Unit& u, int wr, int wc, int fr, int fq) const {
        const int row0 = u.pm * BM + wr * 64 + fr, col0 = u.pn * BM + wc * 32 + 4 * fq;
#pragma unroll
        for (int ai = 0; ai < 2; ++ai)
#pragma unroll
            for (int m = 0; m < 4; ++m) { const size_t off = (size_t)(row0 + ai * HALF + m * 16) * ldc + col0;
#pragma unroll
                for (int bj = 0; bj < 2; ++bj)
#pragma unroll
                    for (int n = 0; n < 2; ++n) { const f32x4 b = *(const f32x4*)(base + off + bj * HALF + n * 16); *(f32x4*)(out + off + bj * HALF + n * 16) = b + acc[ai][bj][m][n]; } }
    }
};
struct EpiSwiglu {
    static constexpr bool PERM = true, AFTER_DRAIN = false;
    bf16_t* O; const float* bias;
    __device__ __forceinline__ void operator()(const f32x4 (&acc)[2][2][4][2], const Unit& u, int wr, int wc, int fr, int fq) const {
        const int row0 = u.pm * BM + wr * 64 + fr; const int a0 = u.pn * HALF + wc * 32 + 8 * fq;
        const float* bp = bias + (size_t)u.e * 2048 + 2 * a0;
        f32x4 b4[4];
#pragma unroll
        for (int j = 0; j < 4; ++j) b4[j] = *(const f32x4*)(bp + 4 * j);
#pragma unroll
        for (int ai = 0; ai < 2; ++ai)
#pragma unroll
            for (int m = 0; m < 4; ++m) { bf16_t* rowp = O + (size_t)(row0 + ai * HALF + m * 16) * 1024 + a0;
                float a[8];
#pragma unroll
                for (int n = 0; n < 2; ++n)
#pragma unroll
                    for (int i = 0; i < 4; ++i) { const int k = 4 * n + i;
                        float g = acc[ai][0][m][n][i] + b4[k >> 1][2 * (k & 1)], l = acc[ai][1][m][n][i] + b4[k >> 1][2 * (k & 1) + 1];
                        g = fminf(g, 7.0f); l = fminf(fmaxf(l, -7.0f), 7.0f);
                        const float sg = __builtin_amdgcn_rcpf(1.0f + __builtin_amdgcn_exp2f(-1.702f * 1.4426950408889634f * g));
                        a[k] = g * sg * (l + 1.0f); }
                u32x4 w; w.x = cvt_pk_bf16(a[0], a[1]); w.y = cvt_pk_bf16(a[2], a[3]); w.z = cvt_pk_bf16(a[4], a[5]); w.w = cvt_pk_bf16(a[6], a[7]);
                *(u32x4*)rowp = w; }
    }
};

template <class Epi, class Sched, bool ALIGN_EPI = false, bool SP2 = false>
__device__ __forceinline__ void gemm_phase(PG8_LAS unsigned char* lds, const Gemm g, const Sched& S, const Epi& E) {
    int tid = threadIdx.x; asm volatile("" : "+v"(tid));
    const int wid = __builtin_amdgcn_readfirstlane(tid >> 6), lane = tid & 63, wr = wid >> 2, wc = wid & 3, fr = lane & 15, fq = lane >> 4;
    const int K = g.K, nt = K / BK;
    unsigned vAc[2][2], vAn[2][2], voffB[2];
    int sR[2], sC[2];
#pragma unroll
    for (int i = 0; i < 2; ++i) { int R, C; stage_rc(tid * 16 + i * 8192, R, C); const int Rb = Epi::PERM ? ((R & ~31) + perm32(R & 31)) : R;
        sR[i] = R; sC[i] = C; voffB[i] = (unsigned)(Rb * K + C) * 2u; }
    const size_t kstep = (size_t)(BK * 2);
    const size_t hstep = (size_t)HALF * K * 2;
    const size_t tstep = 2 * hstep;
    const unsigned ldsw = (unsigned)wid * 1024u;
    const int aoff = lds_byte(wr * 64 + fr, fq * 8), boff = lds_byte(wc * 32 + fr, fq * 8);
#define PG8_SA(b, h) (((b) * 2 + (h)) * HTB)
#define PG8_SB(b, h) ((4 + (b) * 2 + (h)) * HTB)
#define PG8_STAGE(bufoff, gbase, voff) do { _Pragma("unroll") for (int _i = 0; _i < 2; ++_i) \
        __builtin_amdgcn_global_load_lds((const unsigned*)((const char*)(gbase) + (voff)[_i]), (PG8_LAS unsigned*)(lds + (bufoff) + ldsw + _i * 8192), 16, 0, 0); } while (0)
#define PG8_LDA(dst, b, h) do { _Pragma("unroll") for (int m = 0; m < 4; ++m) _Pragma("unroll") for (int k = 0; k < 2; ++k) dst[m][k] = *(const PG8_LAS bf16x8*)(lds + PG8_SA(b, h) + aoff + m * 2048 + k * 1024); } while (0)
#define PG8_LDB(dst, b, h) do { _Pragma("unroll") for (int n = 0; n < 2; ++n) _Pragma("unroll") for (int k = 0; k < 2; ++k) dst[n][k] = *(const PG8_LAS bf16x8*)(lds + PG8_SB(b, h) + boff + n * 2048 + k * 1024); } while (0)
#define PG8_MMA(ai, bj, At, Bt) do { __builtin_amdgcn_s_setprio(1); _Pragma("unroll") for (int m = 0; m < 4; ++m) _Pragma("unroll") for (int n = 0; n < 2; ++n) _Pragma("unroll") for (int k = 0; k < 2; ++k) \
        acc[ai][bj][m][n] = __builtin_amdgcn_mfma_f32_16x16x32_bf16(Bt[n][k], At[m][k], acc[ai][bj][m][n], 0, 0, 0); __builtin_amdgcn_s_setprio(0); } while (0)
#define PG8_WAIT_V(n) asm volatile("s_waitcnt vmcnt(" #n ")" ::: "memory")
#define PG8_WAIT_L(n) asm volatile("s_waitcnt lgkmcnt(" #n ")" ::: "memory")
#define PG8_BAR __builtin_amdgcn_s_barrier()
#define PG8_SCHED __builtin_amdgcn_sched_barrier(0)
    Unit cur, nxt; int ui = 0;
    if (!S.next(0, cur)) return;
    f32x4 acc[2][2][4][2];
#pragma unroll
    for (int a = 0; a < 2; ++a)
#pragma unroll
        for (int b = 0; b < 2; ++b)
#pragma unroll
            for (int m = 0; m < 4; ++m)
#pragma unroll
                for (int n = 0; n < 2; ++n) acc[a][b][m][n] = (f32x4){0.f, 0.f, 0.f, 0.f};
    bf16x8 At[4][2], B0[2][2], B1[2][2];
    const char* cA = (const char*)g.A + S.a_base(cur, tstep); const char* cB = (const char*)g.Bt + (size_t)cur.pb * tstep;
#pragma unroll
    for (int h = 0; h < 2; ++h)
#pragma unroll
        for (int i = 0; i < 2; ++i) { vAc[h][i] = S.a_off(cur, h * HALF + sR[i], K) + (unsigned)sC[i] * 2u; vAn[h][i] = vAc[h][i]; }
    S.a_ready(cur);
    if constexpr (SP2) {
        PG8_STAGE(PG8_SB(0, 0), cB, voffB); PG8_STAGE(PG8_SB(0, 1), cB + hstep, voffB); PG8_STAGE(PG8_SA(0, 0), cA, vAc[0]); PG8_STAGE(PG8_SA(0, 1), cA, vAc[1]);
        if (wr == 1) PG8_BAR;
        PG8_WAIT_V(2); PG8_BAR;
        PG8_STAGE(PG8_SB(1, 0), cB + kstep, voffB); PG8_STAGE(PG8_SA(1, 0), cA + kstep, vAc[0]); PG8_STAGE(PG8_SB(1, 1), cB + hstep + kstep, voffB);
        PG8_WAIT_V(6); PG8_BAR;
    } else {
        PG8_STAGE(PG8_SB(0, 0), cB, voffB); PG8_STAGE(PG8_SA(0, 0), cA, vAc[0]); PG8_STAGE(PG8_SB(0, 1), cB + hstep, voffB); PG8_STAGE(PG8_SA(0, 1), cA, vAc[1]);
        if (wr == 1) PG8_BAR;
        PG8_WAIT_V(4); PG8_BAR;
        PG8_STAGE(PG8_SB(1, 0), cB + kstep, voffB); PG8_STAGE(PG8_SA(1, 0), cA + kstep, vAc[0]); PG8_STAGE(PG8_SB(1, 1), cB + hstep + kstep, voffB);
        PG8_WAIT_V(6); PG8_BAR;
    }
    for (;;) {
        const bool has_next = S.next(ui + 1, nxt);
        const char* nA = has_next ? (const char*)g.A + S.a_base(nxt, tstep) : cA;
        if (has_next) {
#pragma unroll
            for (int h = 0; h < 2; ++h)
#pragma unroll
                for (int i = 0; i < 2; ++i) vAn[h][i] = S.a_off(nxt, h * HALF + sR[i], K) + (unsigned)sC[i] * 2u; } const char* nB = has_next ? (const char*)g.Bt + (size_t)nxt.pb * tstep : cB;
        for (int t = 0; t < nt; t += 2) {
            const bool last = (t == nt - 2);
            const char* a1 = cA + (size_t)(t + 1) * kstep;
            const char* a2 = last ? nA : cA + (size_t)(t + 2) * kstep; const char* b2 = last ? nB : cB + (size_t)(t + 2) * kstep;
            const char* a3 = a2 + kstep; const char* b3 = b2 + kstep;
            unsigned v2[2][2];
#pragma unroll
            for (int h = 0; h < 2; ++h)
#pragma unroll
                for (int i = 0; i < 2; ++i) v2[h][i] = last ? vAn[h][i] : vAc[h][i];
            if (last && has_next) S.a_ready(nxt);
            if constexpr (SP2) {
            PG8_LDB(B0, 0, 0); PG8_LDB(B1, 0, 1); PG8_SCHED; PG8_LDA(At, 0, 0); PG8_STAGE(PG8_SA(1, 1), a1, vAc[1]);
            PG8_WAIT_V(8); PG8_WAIT_L(0); PG8_BAR; PG8_MMA(0, 0, At, B0); PG8_MMA(0, 1, At, B1); PG8_BAR; PG8_SCHED;
            PG8_LDA(At, 0, 1); PG8_STAGE(PG8_SB(0, 0), b2, voffB); PG8_STAGE(PG8_SB(0, 1), b2 + hstep, voffB); PG8_STAGE(PG8_SA(0, 0), a2, v2[0]);
            PG8_WAIT_V(8); PG8_WAIT_L(0); PG8_BAR; PG8_MMA(1, 0, At, B0); PG8_MMA(1, 1, At, B1); PG8_BAR; PG8_SCHED;
            PG8_LDB(B0, 1, 0); PG8_LDB(B1, 1, 1); PG8_SCHED; PG8_LDA(At, 1, 0); PG8_STAGE(PG8_SA(0, 1), a2, v2[1]);
            PG8_WAIT_V(8); PG8_WAIT_L(0); PG8_BAR; PG8_MMA(0, 0, At, B0); PG8_MMA(0, 1, At, B1); PG8_BAR; PG8_SCHED;
            PG8_LDA(At, 1, 1); PG8_STAGE(PG8_SB(1, 0), b3, voffB); PG8_STAGE(PG8_SB(1, 1), b3 + hstep, voffB); PG8_STAGE(PG8_SA(1, 0), a3, v2[0]);
            PG8_WAIT_V(8); PG8_WAIT_L(0); PG8_BAR; PG8_MMA(1, 0, At, B0); PG8_MMA(1, 1, At, B1); PG8_BAR; PG8_SCHED;
            } else {
            PG8_LDB(B0, 0, 0); PG8_SCHED; PG8_LDA(At, 0, 0); PG8_STAGE(PG8_SA(1, 1), a1, vAc[1]);
            PG8_WAIT_L(8); PG8_BAR; PG8_WAIT_L(0); PG8_MMA(0, 0, At, B0); PG8_BAR; PG8_SCHED;
            PG8_LDB(B1, 0, 1); PG8_STAGE(PG8_SB(0, 0), b2, voffB);
            PG8_BAR; PG8_WAIT_L(0); PG8_MMA(0, 1, At, B1); PG8_BAR;
            PG8_LDA(At, 0, 1); PG8_STAGE(PG8_SA(0, 0), a2, v2[0]);
            PG8_BAR; PG8_WAIT_L(0); PG8_MMA(1, 0, At, B0); PG8_BAR; PG8_SCHED;
            PG8_STAGE(PG8_SB(0, 1), b2 + hstep, voffB);
            PG8_WAIT_V(6); PG8_BAR; PG8_MMA(1, 1, At, B1); PG8_BAR;
            PG8_LDB(B0, 1, 0); PG8_SCHED; PG8_LDA(At, 1, 0); PG8_STAGE(PG8_SA(0, 1), a2, v2[1]);
            PG8_WAIT_L(8); PG8_BAR; PG8_WAIT_L(0); PG8_MMA(0, 0, At, B0); PG8_BAR; PG8_SCHED;
            PG8_LDB(B1, 1, 1); PG8_STAGE(PG8_SB(1, 0), b3, voffB);
            PG8_BAR; PG8_WAIT_L(0); PG8_MMA(0, 1, At, B1); PG8_BAR;
            PG8_LDA(At, 1, 1); PG8_STAGE(PG8_SA(1, 0), a3, v2[0]);
            PG8_BAR; PG8_WAIT_L(0); PG8_MMA(1, 0, At, B0); PG8_BAR; PG8_SCHED;
            PG8_STAGE(PG8_SB(1, 1), b3 + hstep, voffB);
            PG8_WAIT_V(6); PG8_BAR; PG8_MMA(1, 1, At, B1); PG8_BAR;
            }
        }
        if constexpr (ALIGN_EPI) { if (wr == 0) PG8_BAR; }
        if constexpr (!Epi::AFTER_DRAIN) { E(acc, cur, wr, wc, fr, fq); S.done(cur); }
        if (!has_next) break;
#pragma unroll
        for (int a = 0; a < 2; ++a)
#pragma unroll
            for (int b = 0; b < 2; ++b)
#pragma unroll
                for (int m = 0; m < 4; ++m)
#pragma unroll
                    for (int n = 0; n < 2; ++n) acc[a][b][m][n] = (f32x4){0.f, 0.f, 0.f, 0.f};
        cur = nxt; cA = nA; cB = nB; ++ui;
#pragma unroll
        for (int h = 0; h < 2; ++h)
#pragma unroll
            for (int i = 0; i < 2; ++i) vAc[h][i] = vAn[h][i];
        if constexpr (ALIGN_EPI) { if (wr == 1) PG8_BAR; }
    }
    PG8_WAIT_V(0);
    if constexpr (!ALIGN_EPI) { if (wr == 0) PG8_BAR; }
    PG8_BAR;
    if constexpr (Epi::AFTER_DRAIN) { E.fused(acc, cur, wr, wc, fr, fq, lds, wid, lane); S.done(cur); }
#undef PG8_SA
#undef PG8_SB
#undef PG8_STAGE
#undef PG8_LDA
#undef PG8_LDB
#undef PG8_MMA
#undef PG8_WAIT_V
#undef PG8_WAIT_L
#undef PG8_BAR
#undef PG8_SCHED
}
}
#define GAS __attribute__((address_space(1)))
#define LAS __attribute__((address_space(3)))
typedef unsigned short bf16;
typedef unsigned v4u __attribute__((ext_vector_type(4)));
typedef float f32x4 __attribute__((ext_vector_type(4)));
typedef short bf16x8 __attribute__((ext_vector_type(8)));
typedef GAS unsigned gu32;
typedef GAS unsigned long long gu64;
#define RLX_AGENT __ATOMIC_RELAXED, __HIP_MEMORY_SCOPE_AGENT
#define LDS_WAIT() asm volatile("s_waitcnt lgkmcnt(0)" ::: "memory")
#define VM_WAIT() asm volatile("s_waitcnt vmcnt(0)" ::: "memory")
__device__ __forceinline__ unsigned long long rt() { return __builtin_amdgcn_s_memrealtime(); }
__device__ __forceinline__ unsigned f2bf(float f) { unsigned u = __builtin_bit_cast(unsigned, f); return (u + 0x7fffu + ((u >> 16) & 1u)) >> 16; }
__device__ __forceinline__ unsigned pk2(float lo, float hi) { return f2bf(lo) | (f2bf(hi) << 16); }

#define XB_TMO      128
#define XB_XCNT(j)  (256  + 64 * (j))
#define XB_XSUB(j)  (1280 + 64 * (j))
#define XB_XGEN(j)  (2304 + 64 * (j))
#define XB_TOP      3328
#define XB_TOPGEN   3392
#define XCD_BAR_WORDS 3456
#define XB_SPIN_CAP (1u << 18)

__device__ __forceinline__ unsigned xb_ld(unsigned* p)              { return __hip_atomic_load(p, __ATOMIC_RELAXED, __HIP_MEMORY_SCOPE_AGENT); }
__device__ __forceinline__ unsigned xb_add(unsigned* p, unsigned v) { return __hip_atomic_fetch_add(p, v, __ATOMIC_RELAXED, __HIP_MEMORY_SCOPE_AGENT); }
__device__ __forceinline__ unsigned xb_xcc_id() { return (unsigned)__builtin_amdgcn_s_getreg((3 << 11) | 20) & 0xFu; }
#define XB_SPIN(cond, bar) do { unsigned _sp = 0; while (cond) { __builtin_amdgcn_s_sleep(1); \
    if ((++_sp & 255u) == 0u) { if (xb_ld(&(bar)[XB_TMO])) break; if (_sp > XB_SPIN_CAP) { atomicAdd(&(bar)[XB_TMO], 1u); break; } } } } while (0)

struct XcdBarrier {
    unsigned* bar; unsigned x;
    volatile LAS unsigned* st;
};

__device__ __forceinline__ XcdBarrier xcd_barrier_post(unsigned* bar, volatile LAS unsigned* st) {
    XcdBarrier b; b.bar = bar; b.x = xb_xcc_id(); b.st = st;
    if (threadIdx.x == 0) (void)xb_add(&bar[XB_XCNT(b.x)], 1u);
    return b;
}
__device__ __forceinline__ void xcd_barrier_complete(unsigned* bar, unsigned x, unsigned& nloc, unsigned& nx) {
    const unsigned G = gridDim.x * gridDim.y * gridDim.z;
    unsigned sum, cnt, mine, sp = 0u;
    for (;;) {
        sum = 0u; cnt = 0u; mine = 0u;
#pragma unroll
        for (unsigned j = 0; j < 16; ++j) { const unsigned c = xb_ld(&bar[XB_XCNT(j)]); sum += c; cnt += (c > 0u) ? 1u : 0u; mine = (j == x) ? c : mine; }
        if (sum == G) break;
        __builtin_amdgcn_s_sleep(1);
        if ((++sp & 255u) == 0u) { if (xb_ld(&bar[XB_TMO])) break; if (sp > XB_SPIN_CAP) { atomicAdd(&bar[XB_TMO], 1u); break; } }
    }
    nloc = mine > 0u ? mine : 1u; nx = cnt > 0u ? cnt : 1u;
}

__device__ __forceinline__ void xcd_barrier(const XcdBarrier& b) {
    asm volatile("s_waitcnt vmcnt(0)" ::: "memory");
    __syncthreads();
    if (threadIdx.x == 0) {
        unsigned* bar = b.bar;
        __builtin_amdgcn_s_waitcnt(0);
        unsigned nloc = b.st[0], nx = b.st[1];
        if (nloc == 0u) { xcd_barrier_complete(bar, b.x, nloc, nx); b.st[0] = nloc; b.st[1] = nx; }
        const unsigned old = xb_add(&bar[XB_XSUB(b.x)], 1u);
        const unsigned gen = old / nloc;
        if (old + 1u == (gen + 1u) * nloc) {
            __builtin_amdgcn_fence(__ATOMIC_RELEASE, "agent");
            asm volatile("s_waitcnt vmcnt(0)" ::: "memory");
            const unsigned og = xb_add(&bar[XB_TOP], 1u);
            const unsigned tg = og / nx;
            if (og + 1u == (tg + 1u) * nx) xb_add(&bar[XB_TOPGEN], 1u);
            else XB_SPIN(xb_ld(&bar[XB_TOPGEN]) == tg, bar);
            __builtin_amdgcn_fence(__ATOMIC_ACQUIRE, "agent");
            xb_add(&bar[XB_XGEN(b.x)], 1u);
            asm volatile("s_waitcnt vmcnt(0)" ::: "memory");
        } else {
            XB_SPIN(xb_ld(&bar[XB_XGEN(b.x)]) == gen, bar);
            __builtin_amdgcn_fence(__ATOMIC_ACQUIRE, "agent");
            asm volatile("s_waitcnt vmcnt(0)" ::: "memory");
        }
    }
    __syncthreads();
}

using pg8::bf16_t;
typedef unsigned u32x2 __attribute__((ext_vector_type(2)));
__device__ __forceinline__ float bf2f(unsigned v) { return __uint_as_float(v << 16); }
__device__ __forceinline__ float bflo(unsigned w) { return __uint_as_float(w << 16); }
__device__ __forceinline__ float bfhi(unsigned w) { return __uint_as_float(w & 0xffff0000u); }
__device__ __forceinline__ float wave_sum(float v) {
#pragma unroll
    for (int o = 1; o < 64; o <<= 1) v += __shfl_xor(v, o);
    return v;
}
__device__ __forceinline__ float sigm(float x) { return 1.0f / (1.0f + expf(-x)); }
__device__ __forceinline__ float softplusf_(float x) { return fmaxf(x, 0.f) + log1pf(expf(-fabsf(x))); }
__device__ __forceinline__ float gelu_tanh(float x) { return 0.5f * x * (1.0f + tanhf(0.7978845608028654f * (x + 0.044715f * x * x * x))); }

__device__ __forceinline__ int gu_rowmap(int n) { const int a = n >> 1; return ((a >> 7) << 8) + (a & 127) + ((n & 1) << 7); }
struct TDesc { const float* W; bf16* WT; int ldw, K, k0, n0, gu; };
__device__ __forceinline__ void tload(const TDesc& d, f32x4 (&v)[16], int lane) {
#pragma unroll
    for (int i = 0; i < 16; ++i) v[i] = __builtin_nontemporal_load((const f32x4*)(d.W + (size_t)(d.k0 + 4 * i + (lane >> 4)) * d.ldw + d.n0 + 4 * (lane & 15)));
}
__device__ __forceinline__ void tstore(const TDesc& d, const f32x4 (&v)[16], LAS float* scr, int lane) {
#pragma unroll
    for (int i = 0; i < 16; ++i) { LAS float* p = scr + (4 * i + (lane >> 4)) * 65 + 4 * (lane & 15); p[0] = v[i][0]; p[1] = v[i][1]; p[2] = v[i][2]; p[3] = v[i][3]; }
    LDS_WAIT(); asm volatile("" ::: "memory");
    const int c = lane & 7;
#pragma unroll
    for (int j = 0; j < 8; ++j) { const int n = 8 * j + (lane >> 3); const LAS float* s = scr + (8 * c) * 65 + n;
        v4u o; o.x = pg8::cvt_pk_bf16(s[0], s[65]); o.y = pg8::cvt_pk_bf16(s[130], s[195]); o.z = pg8::cvt_pk_bf16(s[260], s[325]); o.w = pg8::cvt_pk_bf16(s[390], s[455]);
        const int nr = d.gu ? gu_rowmap(d.n0 + n) : (d.n0 + n);
        *(v4u*)(d.WT + (size_t)nr * d.K + d.k0 + 8 * c) = o; }
    LDS_WAIT(); asm volatile("" ::: "memory");
}
constexpr int IT_WIN = 16 * 52, IT_WOUT = 256, IT_GU = 512, IT_DN = 256;
constexpr int NIT_WIN = DEPTH * IT_WIN, NIT_WOUT = DEPTH * IT_WOUT, NIT_GU = DEPTH * NE * IT_GU, NIT_DN = DEPTH * NE * IT_DN, NITEMS = NIT_WIN + NIT_WOUT + NIT_GU + NIT_DN;

__device__ __forceinline__ void emit_xn_dt(const f32x4 (&v)[4], const float* g, const float* win_l, bf16* xn_row, float* dt_row, int lane) {
    float ss = 0.f;
#pragma unroll
    for (int j = 0; j < 4; ++j) ss += (v[j][0] * v[j][0] + v[j][1] * v[j][1]) + (v[j][2] * v[j][2] + v[j][3] * v[j][3]);
    ss = wave_sum(ss);
    const float rstd = 1.0f / sqrtf(ss * (1.0f / DM) + EPS);
    float d0 = 0.f, d1 = 0.f, d2 = 0.f, d3 = 0.f;
#pragma unroll
    for (int j = 0; j < 4; ++j) { const int col = 256 * j + 4 * lane; const f32x4 gg = *(const f32x4*)(g + col); const f32x4 u = v[j] * rstd * gg;
        u32x2 w; w.x = pk2(u[0], u[1]); w.y = pk2(u[2], u[3]); *(u32x2*)(xn_row + col) = w;
#pragma unroll
        for (int i = 0; i < 4; ++i) { const f32x4 ww = *(const f32x4*)(win_l + (size_t)(col + i) * DIN + C_DT); d0 += u[i] * ww[0]; d1 += u[i] * ww[1]; d2 += u[i] * ww[2]; d3 += u[i] * ww[3]; } }
    d0 = wave_sum(d0); d1 = wave_sum(d1); d2 = wave_sum(d2); d3 = wave_sum(d3);
    if (lane == 0) *(f32x4*)dt_row = (f32x4){d0, d1, d2, d3};
}

__device__ __forceinline__ void attn_naive(const bf16* proj, float* oraw, int b, int h, int qb, int lane) {
    const int t = qb * 64 + lane; const size_t row = (size_t)b * SEQ + t;
    int zero; asm volatile("v_mov_b32 %0, 0" : "=v"(zero));
    float q[64], acc[64];
    const bf16* qp = proj + row * DING + C_SBQ + h * 64;
#pragma unroll
    for (int c = 0; c < 8; ++c) { const v4u w = *(const v4u*)(qp + 8 * c);
#pragma unroll
        for (int i = 0; i < 4; ++i) { q[8 * c + 2 * i] = bflo(w[i]) * 0.125f; q[8 * c + 2 * i + 1] = bfhi(w[i]) * 0.125f; } }
#pragma unroll
    for (int d = 0; d < 64; ++d) acc[d] = 0.f;
    float R = 0.f;
    for (int s = qb * 64 + 62; s >= 0; --s) {
        const bf16* kp = proj + ((size_t)b * SEQ + s) * DING + C_SBK + h * 64 + zero;
        float z = 0.f;
#pragma unroll
        for (int c = 0; c < 8; ++c) { const v4u w = *(const v4u*)(kp + 8 * c);
#pragma unroll
            for (int i = 0; i < 4; ++i) { z += q[8 * c + 2 * i] * bflo(w[i]); z += q[8 * c + 2 * i + 1] * bfhi(w[i]); } }
        if (s < t) {
            const float sp = softplusf_(z);
            const float a = expf(z - sp + R);
            R -= sp;
            const bf16* vp = kp + 256;
#pragma unroll
            for (int c = 0; c < 8; ++c) { const v4u w = *(const v4u*)(vp + 8 * c);
#pragma unroll
                for (int i = 0; i < 4; ++i) { acc[8 * c + 2 * i] += a * bflo(w[i]); acc[8 * c + 2 * i + 1] += a * bfhi(w[i]); } }
        }
        if (__all(R < -88.0f)) break;
    }
    float* op = oraw + row * DM + h * 64;
#pragma unroll
    for (int c = 0; c < 16; ++c) *(f32x4*)(op + 4 * c) = (f32x4){acc[4 * c], acc[4 * c + 1], acc[4 * c + 2], acc[4 * c + 3]};
}

__device__ __forceinline__ void rg_chain(const bf16* proj, float* oraw, int b, int n, const float* conv_w, const float* conv_b, const float* wa, const float* ba,
                                         const float* wx, const float* bx, const float* lam, LAS float* L, int tid) {
    LAS float* wa_s = L; LAS float* wx_s = L + 4096; LAS float* xc_s = L + 8192; LAS float* a_s = L + 12288; LAS float* u_s = L + 16384;
    const int j = tid & 63, tr = tid >> 6, c = n * 64 + j;
    for (int idx = tid; idx < 4096; idx += NTHR) { wa_s[idx] = wa[n * 4096 + idx]; wx_s[idx] = wx[n * 4096 + idx]; }
    float cw[4];
#pragma unroll
    for (int k = 0; k < 4; ++k) cw[k] = conv_w[k * 256 + c];
    const float cb = conv_b[c], bav = ba[c], bxv = bx[c], spl = softplusf_(-lam[c]);
    float hstate = 0.f;
    __syncthreads();
    for (int ch = 0; ch < SEQ / 64; ++ch) {
        const int t0 = ch * 64;
#pragma unroll 1
        for (int i = 0; i < 8; ++i) { const int t = tr + 8 * i, tg = t0 + t; float a = cb;
#pragma unroll
            for (int k = 0; k < 4; ++k) { const int ts = tg - 3 + k; if (ts >= 0) a += cw[k] * bf2f(proj[((size_t)b * SEQ + ts) * DING + C_RGX + c]); }
            xc_s[t * 64 + j] = a; }
        __syncthreads();
#pragma unroll 1
        for (int i = 0; i < 8; ++i) { const int t = tr + 8 * i; float ra = bav, ga = bxv;
            _Pragma("unroll 4") for (int ii = 0; ii < 64; ++ii) { const float x = xc_s[t * 64 + ii]; ra += x * wa_s[ii * 64 + j]; ga += x * wx_s[ii * 64 + j]; }
            const float r = sigm(ra), ig = sigm(ga), log_a = -8.0f * r * spl;
            float mult = sqrtf(-expm1f(2.0f * log_a)); if (t0 + t == 0) mult = 1.0f;
            a_s[t * 64 + j] = expf(log_a); u_s[t * 64 + j] = mult * ig * xc_s[t * 64 + j]; }
        __syncthreads();
        if (tid < 64) {
            for (int t = 0; t < 64; ++t) { hstate = a_s[t * 64 + j] * hstate + u_s[t * 64 + j];
                const size_t row = (size_t)b * SEQ + t0 + t; const float gate = bf2f(proj[row * DING + C_RGG + c]);
                oraw[row * DM + 256 + c] = hstate * gelu_tanh(gate); }
        }
        __syncthreads();
    }
}

__device__ __forceinline__ void hg_chain(const bf16* proj, float* oraw, int b, int h, const float* lbp, int layer, LAS float* L, int tid) {
    constexpr int S = 65, A = 64 * S;
    LAS float* q_s = L; LAS float* k_s = L + A; LAS float* v_s = L + 2 * A; LAS float* bc_s = L + 3 * A; LAS float* sc_s = L + 4 * A; LAS float* st_s = L + 5 * A; LAS float* qe_s = L + 6 * A;
    const int j = tid & 63, tr = tid >> 6;
    float lb = 0.f;
    if (layer == 1) { const float x0 = lbp[h * 64 + j], x1 = lbp[256 + h * 64 + j], mx = fmaxf(x0, x1), e0 = expf(x0 - mx), e1 = expf(x1 - mx); lb = e1 / (e0 + e1); }
#pragma unroll
    for (int i = 0; i < 8; ++i) st_s[(tr + 8 * i) * S + j] = 0.f;
    __syncthreads();
    for (int ch = 0; ch < SEQ / 64; ++ch) {
        const int t0 = ch * 64;
#pragma unroll 1
        for (int i = 0; i < 8; ++i) { const int t = tr + 8 * i; const size_t row = (size_t)b * SEQ + t0 + t; const bf16* pp = proj + row * DING + h * 64 + j;
            const float qv = bf2f(pp[C_HGQ]), fv = bf2f(pp[C_HGF]), iv = bf2f(pp[C_HGI]);
            const float forget = lb + (1.0f - lb) * sigm(fv);
            q_s[t * S + j] = qv * sigm(qv); k_s[t * S + j] = 1.0f - forget; v_s[t * S + j] = iv; bc_s[t * S + j] = logf(forget); }
        __syncthreads();
        if (tid < 64) { float run = 0.f; for (int t = 0; t < 64; ++t) { run += bc_s[t * S + j]; bc_s[t * S + j] = run; } }
        __syncthreads();
#pragma unroll 1
        for (int i = 0; i < 8; ++i) { const int t = tr + 8 * i; qe_s[t * S + j] = q_s[t * S + j] * expf(bc_s[t * S + j]); }
#pragma unroll 1
        for (int i = 0; i < 8; ++i) { const int t = tr + 8 * i, s = j; float a = 0.f;
            if (s <= t) _Pragma("unroll 4") for (int c = 0; c < 64; ++c) a += q_s[t * S + c] * k_s[s * S + c] * expf(bc_s[t * S + c] - bc_s[s * S + c]);
            sc_s[t * S + s] = a; }
        __syncthreads();
#pragma unroll 1
        for (int i = 0; i < 8; ++i) { const int t = tr + 8 * i, v = j; float o = 0.f;
            _Pragma("unroll 4") for (int s = 0; s < 64; ++s) o += sc_s[t * S + s] * v_s[s * S + v];
            _Pragma("unroll 4") for (int c = 0; c < 64; ++c) o += qe_s[t * S + c] * st_s[c * S + v];
            oraw[((size_t)b * SEQ + t0 + t) * DM + 512 + h * 64 + v] = o; }
        __syncthreads();
#pragma unroll 1
        for (int i = 0; i < 8; ++i) { const int s = tr + 8 * i, c = j; sc_s[s * S + c] = k_s[s * S + c] * expf(bc_s[63 * S + c] - bc_s[s * S + c]); }
        __syncthreads();
#pragma unroll 1
        for (int i = 0; i < 8; ++i) { const int c = tr + 8 * i, v = j; float a = expf(bc_s[63 * S + c]) * st_s[c * S + v];
            _Pragma("unroll 4") for (int s = 0; s < 64; ++s) a += sc_s[s * S + c] * v_s[s * S + v];
            st_s[c * S + v] = a; }
        __syncthreads();
    }
}

__device__ __forceinline__ void m2_chain(const bf16* proj, const float* dtraw, float* oraw, int b, int h, const float* conv_w, const float* conv_b, const float* dt_bias,
                                         const float* a_log, const float* dskip, LAS float* L, int tid) {
    constexpr int SB = 129;
    LAS float* xs_s = L; LAS float* B_s = L + 4096; LAS float* C_s = B_s + 64 * SB; LAS float* W_s = C_s + 64 * SB; LAS float* st_s = W_s + 64 * 65;
    LAS float* dt_s = st_s + 64 * SB; LAS float* acs_s = dt_s + 64; LAS float* w_s = acs_s + 64;
    const int j = tid & 63, tr = tid >> 6, g = h >> 1;
    const float dtb = dt_bias[h], negA = -expf(a_log[h]), Dh = dskip[h];
    for (int idx = tid; idx < 64 * SB; idx += NTHR) st_s[idx] = 0.f;
    __syncthreads();
    for (int ch = 0; ch < SEQ / 64; ++ch) {
        const int t0 = ch * 64;
        for (int idx = tid; idx < 64 * 320; idx += NTHR) { const int cch = idx % 320, t = idx / 320;
            int col, cc; LAS float* dst;
            if (cch < 64) { cc = h * 64 + cch; dst = xs_s + t * 64 + cch; }
            else if (cch < 192) { cc = 256 + g * 128 + (cch - 64); dst = B_s + t * SB + (cch - 64); }
            else { cc = 512 + g * 128 + (cch - 192); dst = C_s + t * SB + (cch - 192); }
            col = C_M2X + cc;
            float a = conv_b[cc];
#pragma unroll
            for (int k = 0; k < 4; ++k) { const int ts = t0 + t - 3 + k; if (ts >= 0) a += conv_w[k * 768 + cc] * bf2f(proj[((size_t)b * SEQ + ts) * DING + col]); }
            *dst = a * sigm(a); }
        if (tid < 64) { const float dtv = softplusf_(dtraw[((size_t)b * SEQ + t0 + tid) * 4 + h] + dtb); dt_s[tid] = dtv;
            float v = dtv * negA;
#pragma unroll
            for (int o = 1; o < 64; o <<= 1) { const float nb = __shfl_up(v, o); if (tid >= o) v += nb; }
            acs_s[tid] = v; const float last = __shfl(v, 63); w_s[tid] = expf(last - v) * dtv; }
        __syncthreads();
#pragma unroll 1
        for (int i = 0; i < 8; ++i) { const int l = tr + 8 * i, s = j; float a = 0.f;
            if (s <= l) { _Pragma("unroll 4") for (int n = 0; n < 128; ++n) a += C_s[l * SB + n] * B_s[s * SB + n]; a *= expf(acs_s[l] - acs_s[s]); }
            W_s[l * 65 + s] = a; }
        __syncthreads();
#pragma unroll 1
        for (int i = 0; i < 8; ++i) { const int l = tr + 8 * i, p = j; float yd = 0.f, yo = 0.f;
            _Pragma("unroll 4") for (int s = 0; s < 64; ++s) yd += W_s[l * 65 + s] * (xs_s[s * 64 + p] * dt_s[s]);
            _Pragma("unroll 4") for (int n = 0; n < 128; ++n) yo += C_s[l * SB + n] * st_s[p * SB + n];
            const size_t row = (size_t)b * SEQ + t0 + l; const float zv = bf2f(proj[row * DING + C_M2Z + h * 64 + p]);
            const float y = yd + expf(acs_s[l]) * yo + xs_s[l * 64 + p] * Dh;
            oraw[row * DM + 768 + h * 64 + p] = y * (zv * sigm(zv)); }
        __syncthreads();
        { const int n = tid & 127, pq = tid >> 7; const float dec = expf(acs_s[63]);
#pragma unroll 1
            for (int i = 0; i < 16; ++i) { const int p = pq + 4 * i; float a = dec * st_s[p * SB + n];
                _Pragma("unroll 4") for (int s = 0; s < 64; ++s) a += B_s[s * SB + n] * (w_s[s] * xs_s[s * 64 + p]);
                st_s[p * SB + n] = a; } }
        __syncthreads();
    }
}

__device__ __forceinline__ void norm_row(const float* orow, const bf16* prow, bf16* mrow, const float* gA, const float* gB, const float* gC, const float* gD, int lane) {
    f32x4 v[4];
#pragma unroll
    for (int j = 0; j < 4; ++j) v[j] = *(const f32x4*)(orow + 256 * j + 4 * lane);
    float s[4];
#pragma unroll
    for (int j = 0; j < 4; ++j) s[j] = (v[j][0] * v[j][0] + v[j][1] * v[j][1]) + (v[j][2] * v[j][2] + v[j][3] * v[j][3]);
#pragma unroll
    for (int o = 1; o < 64; o <<= 1) { s[0] += __shfl_xor(s[0], o); s[1] += __shfl_xor(s[1], o); if (o < 16) s[2] += __shfl_xor(s[2], o); if (o < 32) s[3] += __shfl_xor(s[3], o); }
    const float r0 = 1.0f / sqrtf(s[0] * (1.0f / 256) + EPS), r1 = 1.0f / sqrtf(s[1] * (1.0f / 256) + EPS), r2 = 1.0f / sqrtf(s[2] * (1.0f / 64) + EPS), r3 = 1.0f / sqrtf(s[3] * (1.0f / 128) + EPS);
    const int c = 4 * lane;
    const f32x4 g0 = *(const f32x4*)(gA + c), g1 = *(const f32x4*)(gB + c), g2 = *(const f32x4*)(gC + c), g3 = *(const f32x4*)(gD + c);
    const u32x2 gw = *(const u32x2*)(prow + C_HGG + c);
    const float gi[4] = {bflo(gw.x), bfhi(gw.x), bflo(gw.y), bfhi(gw.y)};
    f32x4 o0 = v[0] * r0 * g0, o1 = v[1] * r1 * g1, o2 = v[2] * r2 * g2, o3 = v[3] * r3 * g3;
#pragma unroll
    for (int i = 0; i < 4; ++i) o2[i] *= gi[i] * sigm(gi[i]);
    u32x2 w;
    w.x = pk2(o0[0], o0[1]); w.y = pk2(o0[2], o0[3]); *(u32x2*)(mrow + c) = w;
    w.x = pk2(o1[0], o1[1]); w.y = pk2(o1[2], o1[3]); *(u32x2*)(mrow + 256 + c) = w;
    w.x = pk2(o2[0], o2[1]); w.y = pk2(o2[2], o2[3]); *(u32x2*)(mrow + 512 + c) = w;
    w.x = pk2(o3[0], o3[1]); w.y = pk2(o3[2], o3[3]); *(u32x2*)(mrow + 768 + c) = w;
}

constexpr int RWS = 1028;
__device__ __forceinline__ void router_load(const float* hrow, f32x4 (&v)[4], int lane) {
#pragma unroll
    for (int j = 0; j < 4; ++j) v[j] = *(const f32x4*)(hrow + 256 * j + 4 * lane);
}
__device__ __forceinline__ void router_row(f32x4 (&v)[4], const float* g, const LAS float* rw_t, const float* rb, bf16* xn_row, int& cntl, int& oe, int& orank, float& ogate, int lane) {
    float ss = 0.f;
#pragma unroll
    for (int j = 0; j < 4; ++j) ss += (v[j][0] * v[j][0] + v[j][1] * v[j][1]) + (v[j][2] * v[j][2] + v[j][3] * v[j][3]);
    ss = wave_sum(ss);
    const float rstd = 1.0f / sqrtf(ss * (1.0f / DM) + EPS);
#pragma unroll
    for (int j = 0; j < 4; ++j) { const int col = 256 * j + 4 * lane; v[j] = v[j] * rstd * *(const f32x4*)(g + col);
        u32x2 w; w.x = pk2(v[j][0], v[j][1]); w.y = pk2(v[j][2], v[j][3]); *(u32x2*)(xn_row + col) = w; }
    float p[32];
#pragma unroll
    for (int e = 0; e < 32; ++e) { float a = 0.f;
#pragma unroll
        for (int j = 0; j < 4; ++j) { const f32x4 w = *(const LAS f32x4*)(rw_t + e * RWS + 256 * j + 4 * lane); a += (v[j][0] * w[0] + v[j][1] * w[1]) + (v[j][2] * w[2] + v[j][3] * w[3]); }
        p[e] = a; }
    float q16[16], q8[8], q4[4], q2[2];
    { const bool hi = (lane & 32) != 0;
#pragma unroll
        for (int i = 0; i < 16; ++i) { const float keep = hi ? p[16 + i] : p[i], send = hi ? p[i] : p[16 + i]; q16[i] = keep + __shfl_xor(send, 32); } }
    { const bool hi = (lane & 16) != 0;
#pragma unroll
        for (int i = 0; i < 8; ++i) { const float keep = hi ? q16[8 + i] : q16[i], send = hi ? q16[i] : q16[8 + i]; q8[i] = keep + __shfl_xor(send, 16); } }
    { const bool hi = (lane & 8) != 0;
#pragma unroll
        for (int i = 0; i < 4; ++i) { const float keep = hi ? q8[4 + i] : q8[i], send = hi ? q8[i] : q8[4 + i]; q4[i] = keep + __shfl_xor(send, 8); } }
    { const bool hi = (lane & 4) != 0;
#pragma unroll
        for (int i = 0; i < 2; ++i) { const float keep = hi ? q4[2 + i] : q4[i], send = hi ? q4[i] : q4[2 + i]; q2[i] = keep + __shfl_xor(send, 4); } }
    float mine;
    { const bool hi = (lane & 2) != 0; const float keep = hi ? q2[1] : q2[0], send = hi ? q2[0] : q2[1]; mine = keep + __shfl_xor(send, 2); }
    mine += __shfl_xor(mine, 1);
    const int myexp = lane >> 1;
    mine += rb[myexp];
    int rank = 0;
#pragma unroll
    for (int e = 0; e < 32; ++e) { const float o = __uint_as_float(__builtin_amdgcn_readlane(__float_as_uint(mine), 2 * e)); rank += (o > mine || (o == mine && e < myexp)) ? 1 : 0; }
    int be[4]; float bl[4];
#pragma unroll
    for (int r = 0; r < 4; ++r) { const unsigned long long m = __ballot(rank == r && (lane & 1) == 0); be[r] = (int)(__builtin_ctzll(m) >> 1);
        bl[r] = __uint_as_float(__builtin_amdgcn_readlane(__float_as_uint(mine), 2 * be[r])); }
    const float e1 = expf(bl[1] - bl[0]), e2 = expf(bl[2] - bl[0]), e3 = expf(bl[3] - bl[0]), inv = 1.0f / (1.0f + e1 + e2 + e3);
    int rk[4];
#pragma unroll
    for (int r = 0; r < 4; ++r) { rk[r] = __builtin_amdgcn_readlane(cntl, be[r]); if (lane == be[r]) cntl += 1; }
    { const int k = lane & 3;
        oe = k == 0 ? be[0] : k == 1 ? be[1] : k == 2 ? be[2] : be[3]; orank = k == 0 ? rk[0] : k == 1 ? rk[1] : k == 2 ? rk[2] : rk[3];
        ogate = (k == 0 ? 1.0f : k == 1 ? e1 : k == 2 ? e2 : e3) * inv; }
}

__device__ __forceinline__ void build_tb(const int* tot, LAS int* tb, int tid) {
    if (tid == 0) { int run = 0; for (int e = 0; e < 32; ++e) { tb[e] = run; run += (tot[e] + 255) >> 8; } tb[32] = run; }
    __syncthreads();
}

typedef short s16x4 __attribute__((ext_vector_type(4)));
typedef short v4i16_t __attribute__((ext_vector_type(4)));
#define MFMA16(a, b, c) __builtin_amdgcn_mfma_f32_16x16x32_bf16((a), (b), (c), 0, 0, 0)
__device__ __forceinline__ bf16x8 frag_kc(const LAS bf16* M, int ld, int idx0, int k0, int lane) { return *(const LAS bf16x8*)(M + (idx0 + (lane & 15)) * ld + k0 + 8 * (lane >> 4)); }
__device__ __forceinline__ bf16x8 frag_ks(const LAS bf16* M, int ld, int idx0, int k0, int lane) {
    const LAS bf16* p = M + (k0 + 8 * (lane >> 4) + ((lane & 15) >> 2)) * ld + idx0 + 4 * (lane & 3);
    const s16x4 lo = __builtin_bit_cast(s16x4, __builtin_amdgcn_ds_read_tr16_b64_v4i16((LAS v4i16_t*)p));
    const s16x4 hi = __builtin_bit_cast(s16x4, __builtin_amdgcn_ds_read_tr16_b64_v4i16((LAS v4i16_t*)(p + 4 * ld)));
    return (bf16x8){lo[0], lo[1], lo[2], lo[3], hi[0], hi[1], hi[2], hi[3]};
}
__device__ __forceinline__ bf16x8 frag_g32(const float* M, int ld, int idx0, int k0, int lane) {
    const float* p = M + (size_t)(idx0 + (lane & 15)) * ld + k0 + 8 * (lane >> 4);
    const f32x4 a = *(const f32x4*)p, b = *(const f32x4*)(p + 4);
    v4u w; w.x = pk2(a[0], a[1]); w.y = pk2(a[2], a[3]); w.z = pk2(b[0], b[1]); w.w = pk2(b[2], b[3]);
    return __builtin_bit_cast(bf16x8, w);
}
__device__ __forceinline__ float fsigm(float x) { return __builtin_amdgcn_rcpf(1.0f + __builtin_amdgcn_exp2f(-1.4426950408889634f * x)); }
__device__ __forceinline__ float fexp(float x) { return __builtin_amdgcn_exp2f(1.4426950408889634f * x); }

constexpr int M2LD = 136, M2WLD = 72;
__device__ __forceinline__ void m2_conv_block(const bf16* proj, const float* cw, const float* cb, int b, int t0, int tq, int cc0, float (&o)[8][8]) {
    v4u x[11]; f32x4 w[4][2];
    const int ts0 = t0 + 8 * tq - 3;
#pragma unroll
    for (int r = 0; r < 11; ++r) { const int ts = ts0 + r; x[r] = (v4u){0u, 0u, 0u, 0u}; if (ts >= 0) x[r] = *(const v4u*)(proj + ((size_t)b * SEQ + ts) * DING + C_M2X + cc0); }
#pragma unroll
    for (int k = 0; k < 4; ++k) { w[k][0] = *(const f32x4*)(cw + k * 768 + cc0); w[k][1] = *(const f32x4*)(cw + k * 768 + cc0 + 4); }
    const f32x4 b0 = *(const f32x4*)(cb + cc0), b1 = *(const f32x4*)(cb + cc0 + 4);
#pragma unroll
    for (int j = 0; j < 8; ++j) { float a[8] = {b0[0], b0[1], b0[2], b0[3], b1[0], b1[1], b1[2], b1[3]};
#pragma unroll
        for (int k = 0; k < 4; ++k) { const v4u xv = x[j + k];
            a[0] += w[k][0][0] * bflo(xv[0]); a[1] += w[k][0][1] * bfhi(xv[0]); a[2] += w[k][0][2] * bflo(xv[1]); a[3] += w[k][0][3] * bfhi(xv[1]);
            a[4] += w[k][1][0] * bflo(xv[2]); a[5] += w[k][1][1] * bfhi(xv[2]); a[6] += w[k][1][2] * bflo(xv[3]); a[7] += w[k][1][3] * bfhi(xv[3]); }
#pragma unroll
        for (int i = 0; i < 8; ++i) o[j][i] = a[i] * fsigm(a[i]); }
}
__device__ __forceinline__ void m2_dt_scan(const float* dtraw, const float* dt_bias, const float* a_log, int b, int t0, int g, LAS float* dt_s, LAS float* acs_s, LAS float* w_s, float* dec_out, int tid) {
    if (tid >= 384) { const int hh = (tid - 384) >> 6, t = tid & 63, h = 2 * g + hh;
        const float dtv = softplusf_(dtraw[((size_t)b * SEQ + t0 + t) * 4 + h] + dt_bias[h]);
        float v = dtv * (-expf(a_log[h]));
#pragma unroll
        for (int o = 1; o < 64; o <<= 1) { const float nb = __shfl_up(v, o); if (t >= o) v += nb; }
        const float last = __shfl(v, 63);
        dt_s[hh * 64 + t] = dtv; acs_s[hh * 64 + t] = v; w_s[hh * 64 + t] = expf(last - v) * dtv;
        if (dec_out && t == 63) dec_out[h] = expf(last); }
}
__device__ __forceinline__ void m2_state_unit(const bf16* proj, const float* dtraw, float* sloc, float* dec, int b, int ch, int g, const float* cw, const float* cb, const float* dt_bias, const float* a_log, LAS unsigned char* lds, int tid) {
    LAS bf16* XS = (LAS bf16*)lds; LAS bf16* BS = XS + 64 * M2LD; LAS float* dt_s = (LAS float*)(BS + 64 * M2LD); LAS float* acs_s = dt_s + 128; LAS float* w_s = acs_s + 128;
    const int lane = tid & 63, w = tid >> 6, t0 = ch * 64;
    m2_dt_scan(dtraw, dt_bias, a_log, b, t0, g, dt_s, acs_s, w_s, dec + (size_t)(b * 32 + ch) * 4, tid);
    float o[8][8]; const int cg = tid & 31, tq = tid >> 5;
    if (tid < 256) m2_conv_block(proj, cw, cb, b, t0, tq, cg < 16 ? g * 128 + 8 * cg : 256 + g * 128 + 8 * (cg - 16), o);
    __syncthreads();
    if (tid < 256) {
#pragma unroll
        for (int j = 0; j < 8; ++j) { const int t = 8 * tq + j; const float sc = cg < 16 ? w_s[(cg >> 3) * 64 + t] : 1.0f;
            v4u q; q.x = pk2(o[j][0] * sc, o[j][1] * sc); q.y = pk2(o[j][2] * sc, o[j][3] * sc); q.z = pk2(o[j][4] * sc, o[j][5] * sc); q.w = pk2(o[j][6] * sc, o[j][7] * sc);
            *(LAS v4u*)((cg < 16 ? XS + 8 * cg : BS + 8 * (cg - 16)) + t * M2LD) = q; } }
    __syncthreads();
    { const int hh = w >> 2, mi = w & 3;
        const bf16x8 a0 = frag_ks(XS, M2LD, hh * 64 + mi * 16, 0, lane), a1 = frag_ks(XS, M2LD, hh * 64 + mi * 16, 32, lane);
        float* outp = sloc + ((size_t)((b * 32 + ch) * 4 + 2 * g + hh) * 64 + mi * 16 + 4 * (lane >> 4)) * 128 + (lane & 15);
#pragma unroll
        for (int ni = 0; ni < 8; ++ni) { const bf16x8 b0 = frag_ks(BS, M2LD, ni * 16, 0, lane), b1 = frag_ks(BS, M2LD, ni * 16, 32, lane);
            f32x4 acc = {0.f, 0.f, 0.f, 0.f}; acc = MFMA16(a0, b0, acc); acc = MFMA16(a1, b1, acc);
#pragma unroll
            for (int i = 0; i < 4; ++i) outp[i * 128 + ni * 16] = acc[i]; } }
    __syncthreads();
}
__device__ __forceinline__ void m2_out_unit(const bf16* proj, const float* dtraw, const bf16* prevb, float* oraw, int b, int ch, int g, const float* cw, const float* cb, const float* dt_bias, const float* a_log, const float* dskip, LAS unsigned char* lds, int tid) {
    LAS bf16* XS = (LAS bf16*)lds; LAS bf16* BS = XS + 64 * M2LD; LAS bf16* CS = BS + 64 * M2LD; LAS bf16* WS = CS + 64 * M2LD;
    LAS float* dt_s = (LAS float*)(WS + 2 * 64 * M2WLD); LAS float* acs_s = dt_s + 128; LAS float* w_s = acs_s + 128;
    const int lane = tid & 63, w = tid >> 6, t0 = ch * 64;
    bf16x8 pf[4][4];
    { const bf16* pv = prevb + (size_t)((b * 32 + ch) * 4 + 2 * g + (w >> 2)) * 64 * 128;
#pragma unroll
        for (int kk = 0; kk < 4; ++kk)
#pragma unroll
            for (int ni = 0; ni < 4; ++ni) pf[kk][ni] = *(const bf16x8*)(pv + (size_t)(ni * 16 + (lane & 15)) * 128 + 32 * kk + 8 * (lane >> 4)); }
    m2_dt_scan(dtraw, dt_bias, a_log, b, t0, g, dt_s, acs_s, w_s, nullptr, tid);
    if (tid < 384) { float o[8][8]; const int cg = tid % 48, tq = tid / 48;
        const int cc0 = cg < 16 ? g * 128 + 8 * cg : cg < 32 ? 256 + g * 128 + 8 * (cg - 16) : 512 + g * 128 + 8 * (cg - 32);
        m2_conv_block(proj, cw, cb, b, t0, tq, cc0, o);
        LAS bf16* dst = cg < 16 ? XS + 8 * cg : cg < 32 ? BS + 8 * (cg - 16) : CS + 8 * (cg - 32);
#pragma unroll
        for (int j = 0; j < 8; ++j) { v4u q; q.x = pk2(o[j][0], o[j][1]); q.y = pk2(o[j][2], o[j][3]); q.z = pk2(o[j][4], o[j][5]); q.w = pk2(o[j][6], o[j][7]); *(LAS v4u*)(dst + (8 * tq + j) * M2LD) = q; } }
    __syncthreads();
    { const int mi = w >> 1, ni0 = (w & 1) * 2;
        f32x4 acc[2] = {{0.f, 0.f, 0.f, 0.f}, {0.f, 0.f, 0.f, 0.f}};
#pragma unroll
        for (int kk = 0; kk < 4; ++kk) { const bf16x8 a = frag_kc(CS, M2LD, mi * 16, 32 * kk, lane);
#pragma unroll
            for (int q = 0; q < 2; ++q) { const bf16x8 bb = frag_kc(BS, M2LD, (ni0 + q) * 16, 32 * kk, lane); acc[q] = MFMA16(a, bb, acc[q]); } }
#pragma unroll
        for (int q = 0; q < 2; ++q) { const int s = (ni0 + q) * 16 + (lane & 15);
#pragma unroll
            for (int hh = 0; hh < 2; ++hh) { const float as = acs_s[hh * 64 + s], ds = dt_s[hh * 64 + s];
#pragma unroll
                for (int i = 0; i < 4; ++i) { const int l = mi * 16 + 4 * (lane >> 4) + i;
                    const float v = (s <= l) ? acc[q][i] * fexp(acs_s[hh * 64 + l] - as) * ds : 0.f;
                    WS[(hh * 64 + l) * M2WLD + s] = (bf16)f2bf(v); } } } }
    __syncthreads();
    { const int hh = w >> 2, mi = w & 3, h = 2 * g + hh;
        f32x4 yd[4], yo[4];
#pragma unroll
        for (int ni = 0; ni < 4; ++ni) { yd[ni] = (f32x4){0.f, 0.f, 0.f, 0.f}; yo[ni] = (f32x4){0.f, 0.f, 0.f, 0.f}; }
#pragma unroll
        for (int kk = 0; kk < 2; ++kk) { const bf16x8 a = frag_kc(WS + hh * 64 * M2WLD, M2WLD, mi * 16, 32 * kk, lane);
#pragma unroll
            for (int ni = 0; ni < 4; ++ni) { const bf16x8 bb = frag_ks(XS, M2LD, hh * 64 + ni * 16, 32 * kk, lane); yd[ni] = MFMA16(a, bb, yd[ni]); } }
#pragma unroll
        for (int kk = 0; kk < 4; ++kk) { const bf16x8 a = frag_kc(CS, M2LD, mi * 16, 32 * kk, lane);
#pragma unroll
            for (int ni = 0; ni < 4; ++ni) yo[ni] = MFMA16(a, pf[kk][ni], yo[ni]); }
        const float Dh = dskip[h];
#pragma unroll
        for (int i = 0; i < 4; ++i) { const int l = mi * 16 + 4 * (lane >> 4) + i; const float ea = fexp(acs_s[hh * 64 + l]); const size_t row = (size_t)b * SEQ + t0 + l;
#pragma unroll
            for (int ni = 0; ni < 4; ++ni) { const int p = ni * 16 + (lane & 15);
                const float xv = bf2f(XS[l * M2LD + hh * 64 + p]), zv = bf2f(proj[row * DING + C_M2Z + h * 64 + p]);
                const float y = yd[ni][i] + ea * yo[ni][i] + xv * Dh;
                oraw[row * DM + 768 + h * 64 + p] = y * (zv * fsigm(zv)); } } }
    __syncthreads();
}

constexpr int HGLD = 136, HGWLD = 72;
template <bool WITH_Q>
__device__ __forceinline__ void hg_prep(const bf16* proj, int b, int t0, int hp, const float* lb1, int layer, LAS float* bc_s, LAS bf16* QS, LAS bf16* KS, LAS bf16* VS, LAS bf16* Q2, int tid) {
    const int c0 = (tid & 15) * 8, ta = tid >> 4;
    float lb[8];
#pragma unroll
    for (int i = 0; i < 8; ++i) lb[i] = 0.f;
    if (layer == 1) { const f32x4 l0 = *(const f32x4*)(lb1 + hp * 128 + c0), l1 = *(const f32x4*)(lb1 + hp * 128 + c0 + 4); lb[0] = l0[0]; lb[1] = l0[1]; lb[2] = l0[2]; lb[3] = l0[3]; lb[4] = l1[0]; lb[5] = l1[1]; lb[6] = l1[2]; lb[7] = l1[3]; }
    v4u fw[2], iw[2], qw[2];
#pragma unroll
    for (int u = 0; u < 2; ++u) { const size_t row = (size_t)b * SEQ + t0 + ta + 32 * u;
        fw[u] = *(const v4u*)(proj + row * DING + C_HGF + hp * 128 + c0); iw[u] = *(const v4u*)(proj + row * DING + C_HGI + hp * 128 + c0);
        if (WITH_Q) qw[u] = *(const v4u*)(proj + row * DING + C_HGQ + hp * 128 + c0); }
    float key[2][8];
#pragma unroll
    for (int u = 0; u < 2; ++u) { const int t = ta + 32 * u;
        const float f[8] = {bflo(fw[u][0]), bfhi(fw[u][0]), bflo(fw[u][1]), bfhi(fw[u][1]), bflo(fw[u][2]), bfhi(fw[u][2]), bflo(fw[u][3]), bfhi(fw[u][3])};
        float lf[8];
#pragma unroll
        for (int i = 0; i < 8; ++i) { const float sg = fsigm(f[i]); lf[i] = __builtin_amdgcn_logf(lb[i] + (1.0f - lb[i]) * sg) * 0.6931471805599453f; key[u][i] = (1.0f - lb[i]) * (1.0f - sg); }
        *(LAS f32x4*)(bc_s + t * 128 + c0) = (f32x4){lf[0], lf[1], lf[2], lf[3]}; *(LAS f32x4*)(bc_s + t * 128 + c0 + 4) = (f32x4){lf[4], lf[5], lf[6], lf[7]};
        *(LAS v4u*)(VS + t * HGLD + c0) = iw[u]; }
    __syncthreads();
    if (tid < 128) { float run = 0.f;
#pragma unroll 8
        for (int t = 0; t < 64; ++t) { run += bc_s[t * 128 + tid]; bc_s[t * 128 + tid] = run; } }
    __syncthreads();
    const f32x4 m0 = *(const LAS f32x4*)(bc_s + 31 * 128 + c0), m1 = *(const LAS f32x4*)(bc_s + 31 * 128 + c0 + 4);
    const float b31[8] = {m0[0], m0[1], m0[2], m0[3], m1[0], m1[1], m1[2], m1[3]};
#pragma unroll
    for (int u = 0; u < 2; ++u) { const int t = ta + 32 * u;
        const f32x4 x0 = *(const LAS f32x4*)(bc_s + t * 128 + c0), x1 = *(const LAS f32x4*)(bc_s + t * 128 + c0 + 4);
        const float bc[8] = {x0[0], x0[1], x0[2], x0[3], x1[0], x1[1], x1[2], x1[3]};
        float kk[8], qq[8], q2[8];
#pragma unroll
        for (int i = 0; i < 8; ++i) { const float d = b31[i] - bc[i]; kk[i] = key[u][i] * fexp(fminf(d, 60.0f));
            if (WITH_Q) { const float qv = (i & 1) ? bfhi(qw[u][i >> 1]) : bflo(qw[u][i >> 1]); const float qs = qv * fsigm(qv); qq[i] = qs * fexp(fminf(-d, 60.0f)); q2[i] = qs * fexp(bc[i]); } }
        v4u o; o.x = pk2(kk[0], kk[1]); o.y = pk2(kk[2], kk[3]); o.z = pk2(kk[4], kk[5]); o.w = pk2(kk[6], kk[7]); *(LAS v4u*)(KS + t * HGLD + c0) = o;
        if (WITH_Q) { o.x = pk2(qq[0], qq[1]); o.y = pk2(qq[2], qq[3]); o.z = pk2(qq[4], qq[5]); o.w = pk2(qq[6], qq[7]); *(LAS v4u*)(QS + t * HGLD + c0) = o;
            o.x = pk2(q2[0], q2[1]); o.y = pk2(q2[2], q2[3]); o.z = pk2(q2[4], q2[5]); o.w = pk2(q2[6], q2[7]); *(LAS v4u*)(Q2 + t * HGLD + c0) = o; } }
    __syncthreads();
}
__device__ __forceinline__ void hg_state_unit(const bf16* proj, float* slt, float* decc, int b, int ch, int hp, const float* lbp, int layer, LAS unsigned char* lds, int tid) {
    LAS float* bc_s = (LAS float*)lds; LAS bf16* KS = (LAS bf16*)(lds + 32768); LAS bf16* VS = KS + 64 * HGLD;
    const int lane = tid & 63, w = tid >> 6;
    hg_prep<false>(proj, b, ch * 64, hp, lbp, layer, bc_s, nullptr, KS, VS, nullptr, tid);
    if (tid < 128) decc[(size_t)((b * 32 + ch) * 4 + 2 * hp) * 64 + tid] = fexp(bc_s[63 * 128 + tid]);
    { const int hh = w >> 2, mi = w & 3, h = 2 * hp + hh;
        const bf16x8 a0 = frag_ks(VS, HGLD, hh * 64 + mi * 16, 0, lane), a1 = frag_ks(VS, HGLD, hh * 64 + mi * 16, 32, lane);
        float* outp = slt + ((size_t)((b * 32 + ch) * 4 + h) * 64 + mi * 16 + 4 * (lane >> 4)) * 64 + (lane & 15);
#pragma unroll
        for (int ni = 0; ni < 4; ++ni) { const bf16x8 b0 = frag_ks(KS, HGLD, hh * 64 + ni * 16, 0, lane), b1 = frag_ks(KS, HGLD, hh * 64 + ni * 16, 32, lane);
            f32x4 acc = {0.f, 0.f, 0.f, 0.f}; acc = MFMA16(a0, b0, acc); acc = MFMA16(a1, b1, acc);
            const int c = hh * 64 + ni * 16 + (lane & 15); const float sc = fexp(bc_s[63 * 128 + c] - bc_s[31 * 128 + c]);
#pragma unroll
            for (int i = 0; i < 4; ++i) outp[i * 64 + ni * 16] = acc[i] * sc; } }
    __syncthreads();
}
__device__ __forceinline__ void hg_out_unit(const bf16* proj, const bf16* stb, float* oraw, int b, int ch, int hp, const float* lbp, int layer, LAS unsigned char* lds, int tid) {
    LAS float* bc_s = (LAS float*)lds; LAS bf16* KS = (LAS bf16*)(lds + 32768); LAS bf16* VS = KS + 64 * HGLD; LAS bf16* QS = VS + 64 * HGLD; LAS bf16* WS = QS + 64 * HGLD; LAS bf16* Q2 = WS + 2 * 64 * HGWLD;
    const int lane = tid & 63, w = tid >> 6, t0 = ch * 64;
    const int hh = w >> 2, mi = w & 3, h = 2 * hp + hh;
    bf16x8 sf[2][4];
    { const bf16* st = stb + (size_t)((b * 32 + ch) * 4 + h) * 64 * 64;
#pragma unroll
        for (int kk = 0; kk < 2; ++kk)
#pragma unroll
            for (int ni = 0; ni < 4; ++ni) sf[kk][ni] = *(const bf16x8*)(st + (size_t)(ni * 16 + (lane & 15)) * 64 + 32 * kk + 8 * (lane >> 4)); }
    hg_prep<true>(proj, b, t0, hp, lbp, layer, bc_s, QS, KS, VS, Q2, tid);
    { f32x4 sc[4];
#pragma unroll
        for (int ni = 0; ni < 4; ++ni) sc[ni] = (f32x4){0.f, 0.f, 0.f, 0.f};
#pragma unroll
        for (int kk = 0; kk < 2; ++kk) { const bf16x8 a = frag_kc(QS, HGLD, mi * 16, hh * 64 + 32 * kk, lane);
#pragma unroll
            for (int ni = 0; ni < 4; ++ni) { const bf16x8 bb = frag_kc(KS, HGLD, ni * 16, hh * 64 + 32 * kk, lane); sc[ni] = MFMA16(a, bb, sc[ni]); } }
#pragma unroll
        for (int ni = 0; ni < 4; ++ni) { const int s = ni * 16 + (lane & 15);
#pragma unroll
            for (int i = 0; i < 4; ++i) { const int t = mi * 16 + 4 * (lane >> 4) + i; WS[(hh * 64 + t) * HGWLD + s] = (bf16)f2bf(s <= t ? sc[ni][i] : 0.f); } } }
    __syncthreads();
    { f32x4 o[4];
#pragma unroll
        for (int ni = 0; ni < 4; ++ni) o[ni] = (f32x4){0.f, 0.f, 0.f, 0.f};
#pragma unroll
        for (int kk = 0; kk < 2; ++kk) { const bf16x8 a = frag_kc(WS + hh * 64 * HGWLD, HGWLD, mi * 16, 32 * kk, lane);
#pragma unroll
            for (int ni = 0; ni < 4; ++ni) { const bf16x8 bb = frag_ks(VS, HGLD, hh * 64 + ni * 16, 32 * kk, lane); o[ni] = MFMA16(a, bb, o[ni]); } }
#pragma unroll
        for (int kk = 0; kk < 2; ++kk) { const bf16x8 a = frag_kc(Q2, HGLD, mi * 16, hh * 64 + 32 * kk, lane);
#pragma unroll
            for (int ni = 0; ni < 4; ++ni) o[ni] = MFMA16(a, sf[kk][ni], o[ni]); }
#pragma unroll
        for (int i = 0; i < 4; ++i) { const size_t row = (size_t)b * SEQ + t0 + mi * 16 + 4 * (lane >> 4) + i;
#pragma unroll
            for (int ni = 0; ni < 4; ++ni) oraw[row * DM + 512 + h * 64 + ni * 16 + (lane & 15)] = o[ni][i]; } }
    __syncthreads();
}

constexpr int RGLD = 136;
__device__ __forceinline__ void rg_local_unit(const bf16* proj, float* hloc, float* pcum, float* rgs, int b, int ch, int half, const float* conv_w, const float* conv_b, const bf16* waT, const bf16* wxT,
                                              const float* ba, const float* bx, const float* lam, LAS unsigned char* lds, int tid) {
    LAS float* xc32 = (LAS float*)lds; LAS float* a_s = xc32 + 64 * 128; LAS bf16* xcb = (LAS bf16*)(a_s + 64 * 128); LAS float* par = (LAS float*)(xcb + 64 * RGLD);
    const int lane = tid & 63, w = tid >> 6, t0 = ch * 64, cg0 = half * 128;
    if (tid < 128) { par[tid] = ba[cg0 + tid]; par[128 + tid] = bx[cg0 + tid]; par[256 + tid] = softplusf_(-lam[cg0 + tid]); }
    { const int c0 = (tid & 15) * 8, cg = cg0 + c0, tp = tid >> 4;
        v4u x[5]; f32x4 wk[4][2];
#pragma unroll
        for (int r = 0; r < 5; ++r) { const int ts = t0 + 2 * tp - 3 + r; x[r] = (v4u){0u, 0u, 0u, 0u}; if (ts >= 0) x[r] = *(const v4u*)(proj + ((size_t)b * SEQ + ts) * DING + C_RGX + cg); }
#pragma unroll
        for (int k = 0; k < 4; ++k) { wk[k][0] = *(const f32x4*)(conv_w + k * 256 + cg); wk[k][1] = *(const f32x4*)(conv_w + k * 256 + cg + 4); }
        const f32x4 b0 = *(const f32x4*)(conv_b + cg), b1 = *(const f32x4*)(conv_b + cg + 4);
#pragma unroll
        for (int j = 0; j < 2; ++j) { const int t = 2 * tp + j; float o[8] = {b0[0], b0[1], b0[2], b0[3], b1[0], b1[1], b1[2], b1[3]};
#pragma unroll
            for (int k = 0; k < 4; ++k) { const v4u xv = x[j + k];
                o[0] += wk[k][0][0] * bflo(xv[0]); o[1] += wk[k][0][1] * bfhi(xv[0]); o[2] += wk[k][0][2] * bflo(xv[1]); o[3] += wk[k][0][3] * bfhi(xv[1]);
                o[4] += wk[k][1][0] * bflo(xv[2]); o[5] += wk[k][1][1] * bfhi(xv[2]); o[6] += wk[k][1][2] * bflo(xv[3]); o[7] += wk[k][1][3] * bfhi(xv[3]); }
            *(LAS f32x4*)(xc32 + t * 128 + c0) = (f32x4){o[0], o[1], o[2], o[3]}; *(LAS f32x4*)(xc32 + t * 128 + c0 + 4) = (f32x4){o[4], o[5], o[6], o[7]};
            v4u q; q.x = pk2(o[0], o[1]); q.y = pk2(o[2], o[3]); q.z = pk2(o[4], o[5]); q.w = pk2(o[6], o[7]); *(LAS v4u*)(xcb + t * RGLD + c0) = q; } }
    __syncthreads();
    { const int nb = w >> 2, mi = w & 3, n = 2 * half + nb;
        f32x4 ra[4], ga[4];
#pragma unroll
        for (int ni = 0; ni < 4; ++ni) { ra[ni] = (f32x4){0.f, 0.f, 0.f, 0.f}; ga[ni] = (f32x4){0.f, 0.f, 0.f, 0.f}; }
#pragma unroll
        for (int kk = 0; kk < 2; ++kk) { const bf16x8 a = frag_kc(xcb, RGLD, mi * 16, nb * 64 + 32 * kk, lane);
#pragma unroll
            for (int ni = 0; ni < 4; ++ni) { const size_t off = (size_t)(n * 64 + ni * 16 + (lane & 15)) * 64 + 32 * kk + 8 * (lane >> 4);
                ra[ni] = MFMA16(a, *(const bf16x8*)(waT + off), ra[ni]); ga[ni] = MFMA16(a, *(const bf16x8*)(wxT + off), ga[ni]); } }
#pragma unroll
        for (int ni = 0; ni < 4; ++ni) { const int c = nb * 64 + ni * 16 + (lane & 15); const float bav = par[c], bxv = par[128 + c], spl = par[256 + c];
#pragma unroll
            for (int i = 0; i < 4; ++i) { const int t = mi * 16 + 4 * (lane >> 4) + i;
                const float r = fsigm(ra[ni][i] + bav), ig = fsigm(ga[ni][i] + bxv), log_a = -8.0f * r * spl;
                float mult = sqrtf(-expm1f(2.0f * log_a)); if (t0 + t == 0) mult = 1.0f;
                a_s[t * 128 + c] = expf(log_a); xc32[t * 128 + c] = mult * ig * xc32[t * 128 + c]; } } }
    __syncthreads();
    if (tid < 128) { float h = 0.f, P = 1.f; const size_t base = ((size_t)b * SEQ + t0) * 256 + cg0 + tid;
#pragma unroll 8
        for (int t = 0; t < 64; ++t) { const float a = a_s[t * 128 + tid]; h = a * h + xc32[t * 128 + tid]; P *= a; hloc[base + (size_t)t * 256] = h; pcum[base + (size_t)t * 256] = P; }
        rgs[((size_t)(b * 32 + ch) * 256 + cg0 + tid) * 2] = P; rgs[((size_t)(b * 32 + ch) * 256 + cg0 + tid) * 2 + 1] = h; }
    __syncthreads();
}

typedef float f32x16 __attribute__((ext_vector_type(16)));
#define MFMA32(a, b, c) __builtin_amdgcn_mfma_f32_32x32x16_bf16((a), (b), (c), 0, 0, 0)
constexpr int AVLD = 72;
__device__ __forceinline__ bf16x8 pack8(const f32x16& x, int o) {
    v4u w; w.x = pg8::cvt_pk_bf16(x[o], x[o + 1]); w.y = pg8::cvt_pk_bf16(x[o + 2], x[o + 3]); w.z = pg8::cvt_pk_bf16(x[o + 4], x[o + 5]); w.w = pg8::cvt_pk_bf16(x[o + 6], x[o + 7]);
    return __builtin_bit_cast(bf16x8, w);
}
__device__ __forceinline__ float lk2(float z) { return -(fmaxf(z, 0.f) + __builtin_amdgcn_logf(1.0f + __builtin_amdgcn_exp2f(-fabsf(z)))); }
__device__ __forceinline__ void attn_unit(const bf16* proj, float* oraw, int b, int h, int qb, LAS bf16* VL, int lane) {
    const int q = lane & 31, h2 = lane >> 5, qw = qb * 32; const size_t rowb = (size_t)b * SEQ;
    bf16x8 qf[4];
    { const bf16* qp = proj + (rowb + qw + q) * DING + C_SBQ + h * 64 + 8 * h2; const float C2 = 0.125f * 1.4426950408889634f;
#pragma unroll
        for (int kk = 0; kk < 4; ++kk) { const v4u w = *(const v4u*)(qp + 16 * kk); v4u o;
            o.x = pg8::cvt_pk_bf16(bflo(w.x) * C2, bfhi(w.x) * C2); o.y = pg8::cvt_pk_bf16(bflo(w.y) * C2, bfhi(w.y) * C2); o.z = pg8::cvt_pk_bf16(bflo(w.z) * C2, bfhi(w.z) * C2); o.w = pg8::cvt_pk_bf16(bflo(w.w) * C2, bfhi(w.w) * C2);
            qf[kk] = __builtin_bit_cast(bf16x8, o); } }
    bf16x8 m0[2], ones;
#pragma unroll
    for (int s = 0; s < 2; ++s) {
#pragma unroll
        for (int jj = 0; jj < 8; ++jj) { const int j = 16 * s + 8 * (jj >> 2) + 4 * h2 + (jj & 3); m0[s][jj] = (short)(j >= q ? 0x3F80 : 0); } }
#pragma unroll
    for (int jj = 0; jj < 8; ++jj) ones[jj] = (short)0x3F80;
    f32x16 o0, o1;
#pragma unroll
    for (int r = 0; r < 16; ++r) { o0[r] = 0.f; o1[r] = 0.f; }
    float R = 0.f;
    const int sd = (qw >> 6) << 6;
    bf16x8 kf[2][4];
    { const bf16* kp = proj + (rowb + sd + q) * DING + C_SBK + h * 64 + 8 * h2;
#pragma unroll
        for (int hf = 0; hf < 2; ++hf)
#pragma unroll
            for (int kk = 0; kk < 4; ++kk) kf[hf][kk] = *(const bf16x8*)(kp + (size_t)hf * 32 * DING + 16 * kk); }
    for (int s0 = sd; s0 >= 0; s0 -= 64) {
        v4u vr[8];
#pragma unroll
        for (int i = 0; i < 8; ++i) vr[i] = *(const v4u*)(proj + (rowb + s0 + (lane >> 3) + 8 * i) * DING + C_SBV + h * 64 + 8 * (lane & 7));
        bf16x8 kn[2][4];
        { const int sn = s0 >= 64 ? s0 - 64 : s0; const bf16* kp = proj + (rowb + sn + q) * DING + C_SBK + h * 64 + 8 * h2;
#pragma unroll
            for (int hf = 0; hf < 2; ++hf)
#pragma unroll
                for (int kk = 0; kk < 4; ++kk) kn[hf][kk] = *(const bf16x8*)(kp + (size_t)hf * 32 * DING + 16 * kk); }
        f32x16 z0, z1;
#pragma unroll
        for (int r = 0; r < 16; ++r) { z0[r] = 0.f; z1[r] = 0.f; }
#pragma unroll
        for (int kk = 0; kk < 4; ++kk) { z0 = MFMA32(kf[0][kk], qf[kk], z0); z1 = MFMA32(kf[1][kk], qf[kk], z1); }
        const int lim = (s0 == sd) ? (qw - sd) + q : 64;
        f32x16 l0, l1;
#pragma unroll
        for (int r = 0; r < 16; ++r) { const int key = (r & 3) + 8 * (r >> 2) + 4 * h2; l0[r] = key < lim ? lk2(z0[r]) : 0.f; l1[r] = key + 32 < lim ? lk2(z1[r]) : 0.f; }
        const bf16x8 bl0 = pack8(l0, 0), bl1 = pack8(l0, 8), bh0 = pack8(l1, 0), bh1 = pack8(l1, 8);
        f32x16 i0 = z0, i1 = z1;
        i0 = MFMA32(m0[0], bl0, i0); i0 = MFMA32(m0[1], bl1, i0); i0 = MFMA32(ones, bh0, i0); i0 = MFMA32(ones, bh1, i0);
        i1 = MFMA32(m0[0], bh0, i1); i1 = MFMA32(m0[1], bh1, i1);
        float tot = h2 == 0 ? i0[0] - z0[0] : 0.f; tot += __shfl_xor(tot, 32);
#pragma unroll
        for (int r = 0; r < 16; ++r) { const int key = (r & 3) + 8 * (r >> 2) + 4 * h2; l0[r] = key < lim ? __builtin_amdgcn_exp2f(i0[r] + R) : 0.f; l1[r] = key + 32 < lim ? __builtin_amdgcn_exp2f(i1[r] + R) : 0.f; }
        R += tot;
        const bf16x8 pa0 = pack8(l0, 0), pa1 = pack8(l0, 8), pa2 = pack8(l1, 0), pa3 = pack8(l1, 8);
#pragma unroll
        for (int i = 0; i < 8; ++i) *(LAS v4u*)(VL + ((lane >> 3) + 8 * i) * AVLD + 8 * (lane & 7)) = vr[i];
        const LAS bf16* vb = VL + (4 * h2 + ((lane & 15) >> 2)) * AVLD + 16 * ((lane >> 4) & 1) + 4 * (lane & 3);
#define VFRAG(kb, db) ({ const s16x4 lo_ = __builtin_bit_cast(s16x4, __builtin_amdgcn_ds_read_tr16_b64_v4i16((LAS v4i16_t*)(vb + (kb) * AVLD + (db) * 32))); \
                         const s16x4 hi_ = __builtin_bit_cast(s16x4, __builtin_amdgcn_ds_read_tr16_b64_v4i16((LAS v4i16_t*)(vb + ((kb) + 8) * AVLD + (db) * 32))); \
                         (bf16x8){lo_[0], lo_[1], lo_[2], lo_[3], hi_[0], hi_[1], hi_[2], hi_[3]}; })
        o0 = MFMA32(pa0, VFRAG(0, 0), o0); o1 = MFMA32(pa0, VFRAG(0, 1), o1);
        o0 = MFMA32(pa1, VFRAG(16, 0), o0); o1 = MFMA32(pa1, VFRAG(16, 1), o1);
        o0 = MFMA32(pa2, VFRAG(32, 0), o0); o1 = MFMA32(pa2, VFRAG(32, 1), o1);
        o0 = MFMA32(pa3, VFRAG(48, 0), o0); o1 = MFMA32(pa3, VFRAG(48, 1), o1);
#undef VFRAG
#pragma unroll
        for (int hf = 0; hf < 2; ++hf)
#pragma unroll
            for (int kk = 0; kk < 4; ++kk) kf[hf][kk] = kn[hf][kk];
        if (__all(R < -127.0f)) break;
    }
    float* op = oraw + (rowb + qw) * DM + h * 64 + q;
#pragma unroll
    for (int r = 0; r < 16; ++r) { const int qq = (r & 3) + 8 * (r >> 2) + 4 * h2; op[(size_t)qq * DM] = o0[r]; op[(size_t)qq * DM + 32] = o1[r]; }
}

constexpr int NPL = 11, NPHASE = 1 + NPL * DEPTH;
struct Args { const float* in[29]; float* out; unsigned char* ws; int ph_lo, ph_hi, use_bar, pad; };

typedef const __attribute__((address_space(4))) Args* KArgP;
__device__ __forceinline__ KArgP kargs() { KArgP p = (KArgP)__builtin_amdgcn_kernarg_segment_ptr(); asm volatile("" : "+s"(p)); return p; }
#define WSP(type, off) ((type*)(kargs()->ws + (off)))
#define INP(i) (kargs()->in[i])

__global__ void __launch_bounds__(NTHR, 2) fwd_kernel(Args args_unused) {
    extern __shared__ __attribute__((aligned(16))) unsigned char lds_raw[];
    LAS unsigned char* lds = (LAS unsigned char*)lds_raw;
    LAS float* ldsf = (LAS float*)lds_raw;
    volatile LAS unsigned* MISC = (volatile LAS unsigned*)(lds + MISC_OFF);
    LAS int* tb = (LAS int*)(lds + TB_OFF);
    const int tid0 = threadIdx.x;
#define PH_IDS int tid = threadIdx.x; asm volatile("" : "+v"(tid)); const int lane = tid & 63, wave = __builtin_amdgcn_readfirstlane(tid >> 6); const int gw = vcu * NWAVES + wave; (void)lane; (void)gw;
    const int G = gridDim.x, bx = blockIdx.x;
    const int vcu = (G % 8 == 0) ? (bx % 8) * (G / 8) + bx / 8 : bx;
    const int NGW = G * NWAVES;
    gu32* ctl = (gu32*)WSP(unsigned char, WS_CTL);

    for (int u = tid0; u < (LDS_BYTES - LDSCTL_OFF) / 4; u += NTHR) ((LAS unsigned*)(lds + LDSCTL_OFF))[u] = 0u;
    __syncthreads();
    XcdBarrier bar; bar.bar = (unsigned*)(ctl + CW_BAR); bar.x = 0; bar.st = nullptr;
    if (kargs()->use_bar) bar = xcd_barrier_post((unsigned*)(ctl + CW_BAR), MISC + 8);
    const int lo = kargs()->ph_lo, hi = kargs()->ph_hi;
#ifndef PH_MASK
#define PH_MASK 0xfff
#endif
#ifndef REP_MASK
#define REP_MASK 0
#endif
#define IN(k) (lo <= (k) && (k) < hi)
#define EN(ty) ((PH_MASK >> (ty)) & 1)
#define REPS(ty) (1 + ((REP_MASK >> (ty)) & 1))
#ifndef REP2_MASK
#define REP2_MASK 0
#endif
#define SUB(bit) _Pragma("unroll 1") for (int rep2_ = 0; rep2_ < 1 + ((REP2_MASK >> (bit)) & 1); ++rep2_)
#define SEAM(k) do { if (IN(k) && IN((k) + 1)) xcd_barrier(bar); } while (0)
#define PHASE(ty, k) if (EN(ty) && IN(k)) _Pragma("unroll 1") for (int rep_ = 0; rep_ < REPS(ty); ++rep_)

    PHASE(11, 0) { PH_IDS
        LAS float* scr = ldsf + wave * (64 * 65);
        auto tdecode = [&](int r) -> TDesc { TDesc d;
            if (r < NIT_WIN) { const int l = r / IT_WIN, q = r % IT_WIN; d.W = INP(2) + (size_t)l * DM * DIN; d.ldw = DIN; d.WT = WSP(bf16, WS_WIN) + (size_t)l * DING * DM; d.K = DM; d.k0 = 64 * (q / 52); d.n0 = 64 * (q % 52); d.gu = 0; return d; }
            r -= NIT_WIN;
            if (r < NIT_WOUT) { const int l = r / IT_WOUT, q = r % IT_WOUT; d.W = INP(20) + (size_t)l * DM * DM; d.ldw = DM; d.WT = WSP(bf16, WS_WOUT) + (size_t)l * DM * DM; d.K = DM; d.k0 = 64 * (q / 16); d.n0 = 64 * (q % 16); d.gu = 0; return d; }
            r -= NIT_WOUT;
            if (r < NIT_GU) { const int le = r / IT_GU, q = r % IT_GU; d.W = INP(24) + (size_t)le * DM * 2048; d.ldw = 2048; d.WT = WSP(bf16, WS_WGU) + (size_t)le * 2048 * DM; d.K = DM; d.k0 = 64 * (q / 32); d.n0 = 64 * (q % 32); d.gu = 1; return d; }
            r -= NIT_GU;
            { const int le = r / IT_DN, q = r % IT_DN; d.W = INP(26) + (size_t)le * DFF * DM; d.ldw = DM; d.WT = WSP(bf16, WS_WDN) + (size_t)le * DM * DFF; d.K = DFF; d.k0 = 64 * (q / 16); d.n0 = 64 * (q % 16); d.gu = 0; return d; } };
        { int it = gw; TDesc dc, dn; f32x4 va[16], vb[16];
            if (it < NITEMS) { dc = tdecode(it); tload(dc, va, lane); }
            while (it < NITEMS) { const int nx = it + NGW; const bool hn = nx < NITEMS;
                if (hn) { dn = tdecode(nx); tload(dn, vb, lane); }
                tstore(dc, va, scr, lane);
                if (hn) { dc = dn;
#pragma unroll
                    for (int i = 0; i < 16; ++i) va[i] = vb[i]; }
                it = nx; } }
        for (int idx = gw * 64 + lane; idx < DEPTH * 4 * 4096; idx += NGW * 64) { const int i = idx & 63, j = (idx >> 6) & 63, ln = idx >> 12;
            WSP(bf16, WS_WAT)[idx] = (bf16)f2bf(INP(6)[(size_t)ln * 4096 + i * 64 + j]); WSP(bf16, WS_WAT + 512 * 1024)[idx] = (bf16)f2bf(INP(8)[(size_t)ln * 4096 + i * 64 + j]); }
        if (gw == 0) for (int c = lane; c < 256; c += 64) { const float x0 = INP(12)[c], x1 = INP(12)[256 + c], mx = fmaxf(x0, x1), e0 = expf(x0 - mx), e1 = expf(x1 - mx); WSP(float, WS_LB1)[c] = e1 / (e0 + e1); }
        for (int m = gw; m < T; m += NGW) { f32x4 v[4];
#pragma unroll
            for (int j = 0; j < 4; ++j) v[j] = *(const f32x4*)(INP(0) + (size_t)m * DM + 256 * j + 4 * lane);
            emit_xn_dt(v, INP(1), INP(2), WSP(bf16, WS_XN) + (size_t)m * DM, WSP(float, WS_DT) + (size_t)m * 4, lane); }
    }
    SEAM(0);

#pragma unroll 1
    for (int l = 0; l < DEPTH; ++l) {
        const int P = 1 + NPL * l;
        PHASE(0, P) { PH_IDS
            pg8::Gemm g{WSP(bf16, WS_XN), WSP(bf16, WS_WIN) + (size_t)l * DING * DM, T, DING, DM}; pg8::StaticOrder S; S.init(T, DING, G, bx);
            pg8::EpiBf16 E{WSP(bf16, WS_PROJ), DING, nullptr, 0};
            pg8::gemm_phase<pg8::EpiBf16, pg8::StaticOrder, true, true>(lds, g, S, E);
        }
        SEAM(P);
        PHASE(1, P + 1) { PH_IDS
            SUB(0)
#pragma unroll 1
            for (int u = vcu; u < 512; u += G) m2_state_unit(WSP(bf16, WS_PROJ), WSP(float, WS_DT), WSP(float, WS_SLOC), WSP(float, WS_DEC), u >> 6, (u >> 1) & 31, u & 1, INP(14) + l * 3072, INP(15) + l * 768, INP(16) + l * 4, INP(17) + l * 4, lds, tid);
            SUB(1)
#pragma unroll 1
            for (int u = vcu; u < 512; u += G) hg_state_unit(WSP(bf16, WS_PROJ), WSP(float, WS_SLT), WSP(float, WS_DECC), u >> 6, (u >> 1) & 31, u & 1, WSP(float, WS_LB1), l, lds, tid);
            SUB(2)
#pragma unroll 1
            for (int u = vcu; u < 512; u += G) rg_local_unit(WSP(bf16, WS_PROJ), WSP(float, WS_HLOC), WSP(float, WS_PCUM), WSP(float, WS_RGS), u >> 6, (u >> 1) & 31, u & 1, INP(4) + l * 1024, INP(5) + l * 256,
                                                             WSP(bf16, WS_WAT) + l * 16384, WSP(bf16, WS_WAT + 512 * 1024) + l * 16384, INP(7) + l * 256, INP(9) + l * 256, INP(10) + l * 256, lds, tid);
            SUB(3) { __syncthreads();
            for (int u = gw; u < 2048; u += NGW) { const int qb = 63 - (u >> 5), bh = u & 31; attn_unit(WSP(bf16, WS_PROJ), WSP(float, WS_ORAW), bh >> 2, bh & 3, qb, (LAS bf16*)(lds + wave * (64 * AVLD * 2)), lane); }
            __syncthreads(); }
        }
        SEAM(P + 1);
        PHASE(2, P + 2) { PH_IDS
            { float* sl = WSP(float, WS_SLOC); const float* dc = WSP(float, WS_DEC); bf16* pb = WSP(bf16, WS_PREVB);
                const int e = (vcu * NTHR + tid) * 2, n = e & 127, p = (e >> 7) & 63, h = (e >> 13) & 3, b = e >> 15;
                if (b < NB) { float r0 = 0.f, r1 = 0.f;
#pragma unroll 8
                    for (int c = 0; c < 32; ++c) { float* a = sl + ((size_t)((b * 32 + c) * 4 + h) * 64 + p) * 128 + n; const float d = dc[(b * 32 + c) * 4 + h];
                        const float s0 = a[0], s1 = a[1]; *(unsigned*)(pb + (a - sl)) = pk2(r0, r1); r0 = d * r0 + s0; r1 = d * r1 + s1; } } }
            { float* sl = WSP(float, WS_SLT); const float* dc = WSP(float, WS_DECC); bf16* pb = WSP(bf16, WS_STB);
                const int e = vcu * NTHR + tid, c = e & 63, v = (e >> 6) & 63, h = (e >> 12) & 3, b = e >> 14;
                if (b < NB) { float r = 0.f;
#pragma unroll 8
                    for (int k = 0; k < 32; ++k) { float* a = sl + ((size_t)((b * 32 + k) * 4 + h) * 64 + v) * 64 + c; const float d = dc[(size_t)((b * 32 + k) * 4 + h) * 64 + c];
                        const float s0 = a[0]; pb[a - sl] = (bf16)f2bf(r); r = d * r + s0; } } }
            { const int e = vcu * NTHR + tid;
                if (e < NB * 256) { const int b = e >> 8, c = e & 255; const float* rs = WSP(float, WS_RGS); float* cy = WSP(float, WS_CARRY); float r = 0.f;
#pragma unroll 8
                    for (int k = 0; k < 32; ++k) { const size_t o = (size_t)(b * 32 + k) * 256 + c; cy[o] = r; r = rs[2 * o] * r + rs[2 * o + 1]; } } }
        }
        SEAM(P + 2);
        PHASE(3, P + 3) { PH_IDS
            SUB(4)
#pragma unroll 1
            for (int u = vcu; u < 512; u += G) m2_out_unit(WSP(bf16, WS_PROJ), WSP(float, WS_DT), WSP(bf16, WS_PREVB), WSP(float, WS_ORAW), u >> 6, (u >> 1) & 31, u & 1, INP(14) + l * 3072, INP(15) + l * 768, INP(16) + l * 4, INP(17) + l * 4, INP(18) + l * 4, lds, tid);
            SUB(5)
#pragma unroll 1
            for (int u = vcu; u < 512; u += G) hg_out_unit(WSP(bf16, WS_PROJ), WSP(bf16, WS_STB), WSP(float, WS_ORAW), u >> 6, (u >> 1) & 31, u & 1, WSP(float, WS_LB1), l, lds, tid);
            SUB(6)
            { const float* hl = WSP(float, WS_HLOC); const float* pc = WSP(float, WS_PCUM); const float* cy = WSP(float, WS_CARRY); const bf16* pj = WSP(bf16, WS_PROJ); float* orw = WSP(float, WS_ORAW);
                _Pragma("unroll 1") for (int m = gw; m < T; m += NGW) { const int c = 4 * lane; const size_t cb = (size_t)(m >> 6) * 256 + c;
                    const f32x4 hv = *(const f32x4*)(hl + (size_t)m * 256 + c), pv = *(const f32x4*)(pc + (size_t)m * 256 + c), cv = *(const f32x4*)(cy + cb);
                    const u32x2 gwd = *(const u32x2*)(pj + (size_t)m * DING + C_RGG + c);
                    f32x4 o = hv + pv * cv; o[0] *= gelu_tanh(bflo(gwd.x)); o[1] *= gelu_tanh(bfhi(gwd.x)); o[2] *= gelu_tanh(bflo(gwd.y)); o[3] *= gelu_tanh(bfhi(gwd.y));
                    *(f32x4*)(orw + (size_t)m * DM + 256 + c) = o; } }
        }
        SEAM(P + 3);
        PHASE(4, P + 4) { PH_IDS
            _Pragma("unroll 1") for (int m = gw; m < T; m += NGW) norm_row(WSP(float, WS_ORAW) + (size_t)m * DM, WSP(bf16, WS_PROJ) + (size_t)m * DING, WSP(bf16, WS_MIX) + (size_t)m * DM, INP(3) + l * 256, INP(11) + l * 256, INP(13) + l * 256, INP(19) + l * 256, lane);
        }
        SEAM(P + 4);
        PHASE(5, P + 5) { PH_IDS
            pg8::Gemm g{WSP(bf16, WS_MIX), WSP(bf16, WS_WOUT) + (size_t)l * DM * DM, T, DM, DM}; pg8::StaticOrder S; S.init(T, DM, G, bx);
            pg8::EpiResF32 E{l == 0 ? INP(0) : WSP(float, WS_HB), WSP(float, WS_H1), DM};
            pg8::gemm_phase<pg8::EpiResF32, pg8::StaticOrder, true, true>(lds, g, S, E);
        }
        SEAM(P + 5);
        PHASE(6, P + 6) { PH_IDS
            const float* rw = INP(22) + (size_t)l * DM * NE;
            { f32x4 wv[16];
#pragma unroll
                for (int i = 0; i < 16; ++i) { const int idx = tid + NTHR * i; wv[i] = *(const f32x4*)(rw + (size_t)(idx >> 3) * NE + 4 * (idx & 7)); }
#pragma unroll
                for (int i = 0; i < 16; ++i) { const int idx = tid + NTHR * i, k = idx >> 3, e0 = 4 * (idx & 7);
                    ldsf[(e0 + 0) * RWS + k] = wv[i][0]; ldsf[(e0 + 1) * RWS + k] = wv[i][1]; ldsf[(e0 + 2) * RWS + k] = wv[i][2]; ldsf[(e0 + 3) * RWS + k] = wv[i][3]; } }
            __syncthreads();
            LAS int* lh = (LAS int*)(lds + 32 * RWS * 4);
            int cntl = 0, myE = 0, myRank = 0; float myGate = 0.f;
            f32x4 vn[4]; router_load(WSP(float, WS_H1) + (size_t)(vcu * 64 + wave * 8) * DM, vn, lane);
            _Pragma("unroll 1") for (int r = 0; r < 8; ++r) { const int m = vcu * 64 + wave * 8 + r; asm volatile("" ::: "memory");
                f32x4 v[4];
#pragma unroll
                for (int j = 0; j < 4; ++j) v[j] = vn[j];
                if (r < 7) router_load(WSP(float, WS_H1) + (size_t)(m + 1) * DM, vn, lane);
                int oe, orank; float og;
                router_row(v, INP(21) + l * DM, ldsf, INP(23) + l * NE, WSP(bf16, WS_XN) + (size_t)m * DM, cntl, oe, orank, og, lane);
                if ((lane >> 2) == r) { myE = oe; myRank = orank; myGate = og; } }
            if (lane < 32) lh[wave * 32 + lane] = cntl;
            __syncthreads();
            if (tid < 32) { int s = 0; for (int w = 0; w < 8; ++w) s += lh[w * 32 + tid]; WSP(int, WS_HIST)[(size_t)vcu * 32 + tid] = s; }
            { int base = 0; if (lane < 32) for (int w = 0; w < wave; ++w) base += lh[w * 32 + lane];
                const int add = __shfl(base, myE);
                if (lane < 32) { const int a = (vcu * 64 + wave * 8) * 4 + lane; WSP(int, WS_ASGE)[a] = myE; WSP(int, WS_ASGP)[a] = myRank + add; WSP(float, WS_GATE)[a] = myGate; } }
        }
        SEAM(P + 6);
        PHASE(7, P + 7) { PH_IDS
            LAS int* bs = (LAS int*)(lds + 131072);
            if (tid < 32) { const int* hs = WSP(int, WS_HIST); int base = 0, tot = 0;
#pragma unroll 8
                for (int w = 0; w < G; ++w) { const int c = hs[w * 32 + tid]; tot += c; if (w < vcu) base += c; }
                bs[tid] = base; bs[32 + tid] = tot; if (vcu == 0) WSP(int, WS_TOT)[tid] = tot; }
            __syncthreads();
            if (tid == 0) { int run = 0; for (int e = 0; e < 32; ++e) { tb[e] = run; run += (bs[32 + e] + 255) >> 8; } tb[32] = run; }
            __syncthreads();
            const int* asge = WSP(int, WS_ASGE); const int* asgp = WSP(int, WS_ASGP); int* slotp = WSP(int, WS_SLOT); int* toks = (int*)(kargs()->ws + WS_CTL + CTL_TOKS) + (size_t)l * MAXSLOT;
            if (tid < 256) { const int a = vcu * 256 + tid; const int e = asge[a], slot = tb[e] * 256 + bs[e] + asgp[a]; slotp[a] = slot; toks[slot] = a >> 2; }
        }
        SEAM(P + 7);
        PHASE(8, P + 8) { PH_IDS
            build_tb(WSP(int, WS_TOT), tb, tid);
            LAS int* tokl = (LAS int*)(lds + 131072);
            pg8::MoeOrder S{(const LAS int*)tb, 8, G, bx, (const LAS int*)tokl};
            { const int* toks = (const int*)(kargs()->ws + WS_CTL + CTL_TOKS) + (size_t)l * MAXSLOT; pg8::Unit u;
                for (int i = 0; i < 15 && S.next(i, u); ++i) if (tid < 256) tokl[i * 256 + tid] = toks[u.pm * 256 + tid];
                __syncthreads(); }
            pg8::Gemm g{WSP(bf16, WS_XN), WSP(bf16, WS_WGU) + (size_t)l * NE * 2048 * DM, T, 2048, DM};
            pg8::EpiSwiglu E{WSP(bf16, WS_ACT), INP(25) + (size_t)l * NE * 2048};
            pg8::gemm_phase<pg8::EpiSwiglu, pg8::MoeOrder, true, true>(lds, g, S, E);
        }
        SEAM(P + 8);
        PHASE(9, P + 9) { PH_IDS
            build_tb(WSP(int, WS_TOT), tb, tid);
            pg8::Gemm g{WSP(bf16, WS_ACT), WSP(bf16, WS_WDN) + (size_t)l * NE * DM * DFF, MAXSLOT, DM, DFF}; pg8::MoeOrder S{(const LAS int*)tb, 4, G, bx};
            pg8::EpiBf16 E{WSP(bf16, WS_Y), DM, INP(27) + (size_t)l * NE * DM, DM};
            pg8::gemm_phase<pg8::EpiBf16, pg8::MoeOrder, true, true>(lds, g, S, E);
        }
        SEAM(P + 9);
        PHASE(10, P + 10) { PH_IDS
            const float* h1 = WSP(float, WS_H1); const int* slotp = WSP(int, WS_SLOT); const float* gatep = WSP(float, WS_GATE); const bf16* yb = WSP(bf16, WS_Y);
            for (int m = gw; m < T; m += NGW) { f32x4 v[4];
#pragma unroll
                for (int j = 0; j < 4; ++j) v[j] = *(const f32x4*)(h1 + (size_t)m * DM + 256 * j + 4 * lane);
#pragma unroll
                for (int r = 0; r < 4; ++r) { const int slot = slotp[m * 4 + r]; const float gg = gatep[m * 4 + r]; const bf16* yr = yb + (size_t)slot * DM;
#pragma unroll
                    for (int j = 0; j < 4; ++j) { const u32x2 w = *(const u32x2*)(yr + 256 * j + 4 * lane); v[j][0] += gg * bflo(w.x); v[j][1] += gg * bfhi(w.x); v[j][2] += gg * bflo(w.y); v[j][3] += gg * bfhi(w.y); } }
                if (l + 1 < DEPTH) {
#pragma unroll
                    for (int j = 0; j < 4; ++j) *(f32x4*)(WSP(float, WS_HB) + (size_t)m * DM + 256 * j + 4 * lane) = v[j];
                    emit_xn_dt(v, INP(1) + (l + 1) * DM, INP(2) + (size_t)(l + 1) * DM * DIN, WSP(bf16, WS_XN) + (size_t)m * DM, WSP(float, WS_DT) + (size_t)m * 4, lane);
                } else { float ss = 0.f;
#pragma unroll
                    for (int j = 0; j < 4; ++j) ss += (v[j][0] * v[j][0] + v[j][1] * v[j][1]) + (v[j][2] * v[j][2] + v[j][3] * v[j][3]);
                    ss = wave_sum(ss); const float rstd = 1.0f / sqrtf(ss * (1.0f / DM) + EPS);
#pragma unroll
                    for (int j = 0; j < 4; ++j) *(f32x4*)(kargs()->out + (size_t)m * DM + 256 * j + 4 * lane) = v[j] * rstd * *(const f32x4*)(INP(28) + 256 * j + 4 * lane); }
            }
        }
        if (l + 1 < DEPTH) SEAM(P + 10);
    }
#undef IN
#undef SEAM
}

extern "C" void kernel_launch(void* const* d_in, const int* in_sizes, int n_in, void* d_out, int out_size, void* d_ws, size_t ws_size, hipStream_t stream) {
    static int grid = 0;
    if (grid == 0) {
        if (n_in != 29 || in_sizes[0] != T * DM || out_size != T * DM || ws_size < WS_END) { fprintf(stderr, "kernel_launch: unexpected shapes (n_in %d, in0 %d, out %d, ws %zu); nothing launched\n", n_in, n_in > 0 ? in_sizes[0] : -1, out_size, ws_size); grid = -1; return; }
        int dev = 0, cus = 0, per_cu = 0;
        if (hipGetDevice(&dev) != hipSuccess || hipDeviceGetAttribute(&cus, hipDeviceAttributeMultiprocessorCount, dev) != hipSuccess) { grid = -1; return; }
        if (hipFuncSetAttribute((const void*)fwd_kernel, hipFuncAttributeMaxDynamicSharedMemorySize, LDS_BYTES) != hipSuccess) { fprintf(stderr, "kernel_launch: hipFuncSetAttribute failed\n"); grid = -1; return; }
        if (hipOccupancyMaxActiveBlocksPerMultiprocessor(&per_cu, (const void*)fwd_kernel, NTHR, LDS_BYTES) != hipSuccess || per_cu < 1) fprintf(stderr, "kernel_launch: occupancy query reports %d\n", per_cu);
        (void)hipGetLastError();
        grid = cus;
    }
    if (grid < 0) return;
    if (hipMemsetAsync((char*)d_ws + WS_CTL, 0, CTL_ZERO_BYTES, stream) != hipSuccess) { fprintf(stderr, "kernel_launch: memset failed\n"); return; }
    Args a{};
    for (int i = 0; i < 29; ++i) a.in[i] = (const float*)d_in[i];
    a.out = (float*)d_out; a.ws = (unsigned char*)d_ws;
#if MK_N_LAUNCHES == 1
    a.ph_lo = 0; a.ph_hi = NPHASE; a.use_bar = 1;
    hipLaunchKernelGGL(fwd_kernel, dim3(grid), dim3(NTHR), LDS_BYTES, stream, a);
#else
    for (int p = 0; p < NPHASE; ++p) { a.ph_lo = p; a.ph_hi = p + 1; a.use_bar = 0; hipLaunchKernelGGL(fwd_kernel, dim3(grid), dim3(NTHR), LDS_BYTES, stream, a); }
#endif
}
```

```cpp
#include <hip/hip_runtime.h>
#include <cstdio>
#include <cstdint>

#ifndef MK_N_LAUNCHES
#define MK_N_LAUNCHES 1
#endif

constexpr int NB = 8, SEQ = 2048, DM = 1024, T = NB * SEQ, DEPTH = 2;
constexpr int DIN = 3332, DING = 3328;
constexpr int NE = 32, TOPK = 4, DFF = 1024;
constexpr int NASG = T * TOPK;
constexpr int MAXSLOT = NASG + NE * 256;
constexpr float EPS = 1e-6f;
constexpr int C_SBQ = 0, C_SBK = 256, C_SBV = 512, C_RGX = 768, C_RGG = 1024, C_HGQ = 1280, C_HGF = 1536, C_HGI = 1792, C_HGG = 2048,
              C_M2Z = 2304, C_M2X = 2560, C_DT = 3328;
constexpr int NWAVES = 8, NTHR = 512;

constexpr size_t MiB = 1u << 20;
constexpr size_t WS_CTL = 0, CTL_ZERO_BYTES = 1 * MiB;
constexpr size_t WS_WIN = 2 * MiB;
constexpr size_t WS_WOUT = 16 * MiB;
constexpr size_t WS_WGU = 32 * MiB;
constexpr size_t WS_WDN = 288 * MiB;
constexpr size_t WS_XN = 416 * MiB;
constexpr size_t WS_PROJ = 448 * MiB;
constexpr size_t WS_ORAW = 552 * MiB;
constexpr size_t WS_MIX = 616 * MiB;
constexpr size_t WS_H1 = 648 * MiB;
constexpr size_t WS_HB = 712 * MiB;
constexpr size_t WS_XS = 776 * MiB;
constexpr size_t WS_ACT = 920 * MiB;
constexpr size_t WS_Y = 1064 * MiB;
constexpr size_t WS_DT = 1208 * MiB;
constexpr size_t WS_ASGE = 1209 * MiB;
constexpr size_t WS_ASGP = 1210 * MiB;
constexpr size_t WS_GATE = 1211 * MiB;
constexpr size_t WS_SLOT = 1212 * MiB;
constexpr size_t WS_SLOC = 1216 * MiB;
constexpr size_t WS_DEC = 1248 * MiB;
constexpr size_t WS_SLT = 1250 * MiB;
constexpr size_t WS_DECC = 1266 * MiB;
constexpr size_t WS_HLOC = 1268 * MiB;
constexpr size_t WS_PCUM = 1284 * MiB;
constexpr size_t WS_RGS = 1300 * MiB;
constexpr size_t WS_CARRY = 1301 * MiB;
constexpr size_t WS_WAT = 1302 * MiB;
constexpr size_t WS_HIST = 1303 * MiB;
constexpr size_t WS_TOT = WS_HIST + 512 * 1024;
constexpr size_t WS_LB1 = WS_HIST + 768 * 1024;
constexpr size_t WS_PREVB = 1304 * MiB;
constexpr size_t WS_STB = 1320 * MiB;
constexpr size_t WS_RWB = 1328 * MiB;
constexpr size_t WS_END = 1329 * MiB;
constexpr int CW_TMO = 0, CW_CODE = 1;
constexpr int CW_CNT = 256;
constexpr int CW_BAR = 4096;
constexpr size_t CTL_TOKS = 256 * 1024;

constexpr int LDS_BYTES = 147456;
constexpr int LDSCTL_OFF = LDS_BYTES - 1024;
constexpr int MISC_OFF = LDSCTL_OFF;
constexpr int TB_OFF = LDSCTL_OFF + 256;

namespace pg8 {
#define PG8_LAS __attribute__((address_space(3)))
typedef unsigned short bf16_t;
typedef short bf16x8 __attribute__((ext_vector_type(8)));
typedef float f32x4 __attribute__((ext_vector_type(4)));
typedef unsigned u32x4 __attribute__((ext_vector_type(4)));
constexpr int BM = 256, BK = 64, HALF = 128, HTB = HALF * BK * 2  , STAGE_BYTES = 8 * HTB, NXCD = 8, WGM = 8;

__host__ __device__ __forceinline__ int lds_byte(int r, int c) { const int st = (r >> 4) * 2 + (c >> 5), rr = r & 15, cc = c & 31, ob = rr * 64 + cc * 2; return st * 1024 + (ob ^ (((ob >> 9) & 1) << 5)); }
__host__ __device__ __forceinline__ void stage_rc(int b, int& R, int& C) { const int st = b / 1024, sb = b % 1024, swz = sb ^ (((sb >> 9) & 1) << 5); R = (st >> 1) * 16 + swz / 64; C = (st & 1) * 32 + (swz % 64) / 2; }
__host__ __device__ __forceinline__ int perm32(int rho) { const int n = rho >> 4, i = rho & 15; return 8 * (i >> 2) + 4 * n + (i & 3); }

struct Unit { int pm, pn, pb, e, ui; };
struct Gemm { const bf16_t* A; const bf16_t* Bt; int M, N, K; };

__host__ __device__ __forceinline__ int xcd_remap(int wgid, int nwg) { const int q = nwg / NXCD, r = nwg % NXCD, xcd = wgid % NXCD, off = wgid / NXCD; return (xcd < r ? xcd * (q + 1) : r * (q + 1) + (xcd - r) * q) + off; }

struct StaticOrder {
    int nM, nN, nwg, G, c;
    __host__ __device__ void init(int M, int N, int G_, int c_) { nM = M / BM; nN = N / BM; nwg = nM * nN; G = G_; c = c_; }
    __host__ __device__ bool next(int i, Unit& u) const {
        const long L = (long)i * G + c; if (L >= nwg) return false;
        const int wgid = xcd_remap((int)L, nwg);
        const int nig = WGM * nN, gid = wgid / nig, fm = gid * WGM, gsz = (nM - fm) < WGM ? (nM - fm) : WGM;
        u.pm = fm + ((wgid % nig) % gsz); u.pn = (wgid % nig) / gsz; u.pb = u.pn; u.e = 0; u.ui = i; return true;
    }
    __device__ __forceinline__ void a_ready(const Unit&) const {}
    __device__ __forceinline__ void done(const Unit&) const {}
    __device__ __forceinline__ size_t a_base(const Unit& u, size_t tstep) const { return (size_t)u.pm * tstep; }
    __device__ __forceinline__ unsigned a_off(const Unit&, int r, int K) const { return (unsigned)(r * K) * 2u; }
};
struct MoeOrder {
    const PG8_LAS int* tb; int NP, G, c; const PG8_LAS int* tokl;
    __device__ __forceinline__ bool next(int i, Unit& u) const {
        const int ntot = tb[32], nunits = ntot * NP;
        const long L = (long)i * G + c; if (L >= nunits) return false;
        const int id = xcd_remap((int)L, nunits);
        int e = 0;
        for (int j = 1; j < 32; ++j) if (id >= tb[j] * NP) e = j;
        e = __builtin_amdgcn_readfirstlane(e);
        const int t0 = tb[e], nt = tb[e + 1] - t0, rem = id - t0 * NP;
        u.pm = __builtin_amdgcn_readfirstlane(t0 + rem % nt); u.pn = __builtin_amdgcn_readfirstlane(rem / nt); u.pb = e * NP + u.pn; u.e = e; u.ui = i; return true;
    }
    __device__ __forceinline__ void a_ready(const Unit&) const {}
    __device__ __forceinline__ void done(const Unit&) const {}
    __device__ __forceinline__ size_t a_base(const Unit& u, size_t tstep) const { return tokl ? (size_t)0 : (size_t)u.pm * tstep; }
    __device__ __forceinline__ unsigned a_off(const Unit& u, int r, int K) const { return tokl ? (unsigned)(tokl[u.ui * 256 + r] * K) * 2u : (unsigned)(r * K) * 2u; }
};

__device__ __forceinline__ unsigned cvt_pk_bf16(float lo, float hi) { unsigned r; asm volatile("v_cvt_pk_bf16_f32 %0, %1, %2" : "=v"(r) : "v"(lo), "v"(hi)); return r; }

struct EpiBf16 {
    static constexpr bool PERM = true, AFTER_DRAIN = false;
    bf16_t* O; int ldc; const float* bias; int bias_estride;
    __device__ __forceinline__ void operator()(const f32x4 (&acc)[2][2][4][2], const Unit& u, int wr, int wc, int fr, int fq) const {
        const int row0 = u.pm * BM + wr * 64 + fr; const int col0 = u.pn * BM + wc * 32 + 8 * fq;
        f32x4 bv[2][2];
#pragma unroll
        for (int bj = 0; bj < 2; ++bj)
#pragma unroll
            for (int n = 0; n < 2; ++n) bv[bj][n] = bias ? *(const f32x4*)(bias + (size_t)u.e * bias_estride + col0 + bj * HALF + 4 * n) : (f32x4){0.f, 0.f, 0.f, 0.f};
#pragma unroll
        for (int ai = 0; ai < 2; ++ai)
#pragma unroll
            for (int m = 0; m < 4; ++m) { bf16_t* rowp = O + (size_t)(row0 + ai * HALF + m * 16) * ldc + col0;
#pragma unroll
                for (int bj = 0; bj < 2; ++bj) { const f32x4 v0 = acc[ai][bj][m][0] + bv[bj][0], v1 = acc[ai][bj][m][1] + bv[bj][1];
                    u32x4 w; w.x = cvt_pk_bf16(v0[0], v0[1]); w.y = cvt_pk_bf16(v0[2], v0[3]); w.z = cvt_pk_bf16(v1[0], v1[1]); w.w = cvt_pk_bf16(v1[2], v1[3]);
                    *(u32x4*)(rowp + bj * HALF) = w; } }
    }
};
template <bool BASE_F32> struct EpiResBf16 {
    static constexpr bool PERM = true, AFTER_DRAIN = false;
    const void* base; bf16_t* out; int ldc;
    __device__ __forceinline__ void operator()(const f32x4 (&acc)[2][2][4][2], const Unit& u, int wr, int wc, int fr, int fq) const {
        const int row0 = u.pm * BM + wr * 64 + fr, col0 = u.pn * BM + wc * 32 + 8 * fq;
#pragma unroll
        for (int ai = 0; ai < 2; ++ai)
#pragma unroll
            for (int m = 0; m < 4; ++m) { const size_t off = (size_t)(row0 + ai * HALF + m * 16) * ldc + col0;
#pragma unroll
                for (int bj = 0; bj < 2; ++bj) { f32x4 b0, b1;
                    if (BASE_F32) { const float* bp = (const float*)base + off + bj * HALF; b0 = *(const f32x4*)bp; b1 = *(const f32x4*)(bp + 4); }
                    else { const u32x4 w = *(const u32x4*)((const bf16_t*)base + off + bj * HALF);
                        b0 = (f32x4){__uint_as_float(w.x << 16), __uint_as_float(w.x & 0xffff0000u), __uint_as_float(w.y << 16), __uint_as_float(w.y & 0xffff0000u)};
                        b1 = (f32x4){__uint_as_float(w.z << 16), __uint_as_float(w.z & 0xffff0000u), __uint_as_float(w.w << 16), __uint_as_float(w.w & 0xffff0000u)}; }
                    const f32x4 v0 = b0 + acc[ai][bj][m][0], v1 = b1 + acc[ai][bj][m][1];
                    u32x4 o; o.x = cvt_pk_bf16(v0[0], v0[1]); o.y = cvt_pk_bf16(v0[2], v0[3]); o.z = cvt_pk_bf16(v1[0], v1[1]); o.w = cvt_pk_bf16(v1[2], v1[3]);
                    *(u32x4*)(out + off + bj * HALF) = o; } }
    }
};
struct EpiSwiglu {
    static constexpr bool PERM = true, AFTER_DRAIN = false;
    bf16_t* O; const float* bias;
    __device__ __forceinline__ void operator()(const f32x4 (&acc)[2][2][4][2], const Unit& u, int wr, int wc, int fr, int fq) const {
        const int row0 = u.pm * BM + wr * 64 + fr; const int a0 = u.pn * HALF + wc * 32 + 8 * fq;
        const float* bp = bias + (size_t)u.e * 2048 + 2 * a0;
        f32x4 b4[4];
#pragma unroll
        for (int j = 0; j < 4; ++j) b4[j] = *(const f32x4*)(bp + 4 * j);
#pragma unroll
        for (int ai = 0; ai < 2; ++ai)
#pragma unroll
            for (int m = 0; m < 4; ++m) { bf16_t* rowp = O + (size_t)(row0 + ai * HALF + m * 16) * 1024 + a0;
                float a[8];
#pragma unroll
                for (int n = 0; n < 2; ++n)
#pragma unroll
                    for (int i = 0; i < 4; ++i) { const int k = 4 * n + i;
                        float g = acc[ai][0][m][n][i] + b4[k >> 1][2 * (k & 1)], l = acc[ai][1][m][n][i] + b4[k >> 1][2 * (k & 1) + 1];
                        g = fminf(g, 7.0f); l = fminf(fmaxf(l, -7.0f), 7.0f);
                        const float sg = __builtin_amdgcn_rcpf(1.0f + __builtin_amdgcn_exp2f(-1.702f * 1.4426950408889634f * g));
                        a[k] = g * sg * (l + 1.0f); }
                u32x4 w; w.x = cvt_pk_bf16(a[0], a[1]); w.y = cvt_pk_bf16(a[2], a[3]); w.z = cvt_pk_bf16(a[4], a[5]); w.w = cvt_pk_bf16(a[6], a[7]);
                *(u32x4*)rowp = w; }
    }
};

template <class Epi, class Sched, bool ALIGN_EPI = false, bool SP2 = false>
__device__ __forceinline__ void gemm_phase(PG8_LAS unsigned char* lds, const Gemm g, const Sched& S, const Epi& E) {
    int tid = threadIdx.x; asm volatile("" : "+v"(tid));
    const int wid = __builtin_amdgcn_readfirstlane(tid >> 6), lane = tid & 63, wr = wid >> 2, wc = wid & 3, fr = lane & 15, fq = lane >> 4;
    const int K = g.K, nt = K / BK;
    unsigned vAc[2][2], vAn[2][2], voffB[2];
    int sR[2], sC[2];
#pragma unroll
    for (int i = 0; i < 2; ++i) { int R, C; stage_rc(tid * 16 + i * 8192, R, C); const int Rb = Epi::PERM ? ((R & ~31) + perm32(R & 31)) : R;
        sR[i] = R; sC[i] = C; voffB[i] = (unsigned)(Rb * K + C) * 2u; }
    const size_t kstep = (size_t)(BK * 2);
    const size_t hstep = (size_t)HALF * K * 2;
    const size_t tstep = 2 * hstep;
    const unsigned ldsw = (unsigned)wid * 1024u;
    const int aoff = lds_byte(wr * 64 + fr, fq * 8), boff = lds_byte(wc * 32 + fr, fq * 8);
#define PG8_SA(b, h) (((b) * 2 + (h)) * HTB)
#define PG8_SB(b, h) ((4 + (b) * 2 + (h)) * HTB)
#define PG8_STAGE(bufoff, gbase, voff) do { _Pragma("unroll") for (int _i = 0; _i < 2; ++_i) \
        __builtin_amdgcn_global_load_lds((const unsigned*)((const char*)(gbase) + (voff)[_i]), (PG8_LAS unsigned*)(lds + (bufoff) + ldsw + _i * 8192), 16, 0, 0); } while (0)
#define PG8_LDA(dst, b, h) do { _Pragma("unroll") for (int m = 0; m < 4; ++m) _Pragma("unroll") for (int k = 0; k < 2; ++k) dst[m][k] = *(const PG8_LAS bf16x8*)(lds + PG8_SA(b, h) + aoff + m * 2048 + k * 1024); } while (0)
#define PG8_LDB(dst, b, h) do { _Pragma("unroll") for (int n = 0; n < 2; ++n) _Pragma("unroll") for (int k = 0; k < 2; ++k) dst[n][k] = *(const PG8_LAS bf16x8*)(lds + PG8_SB(b, h) + boff + n * 2048 + k * 1024); } while (0)
#define PG8_MMA(ai, bj, At, Bt) do { __builtin_amdgcn_s_setprio(1); _Pragma("unroll") for (int m = 0; m < 4; ++m) _Pragma("unroll") for (int n = 0; n < 2; ++n) _Pragma("unroll") for (int k = 0; k < 2; ++k) \
        acc[ai][bj][m][n] = __builtin_amdgcn_mfma_f32_16x16x32_bf16(Bt[n][k], At[m][k], acc[ai][bj][m][n], 0, 0, 0); __builtin_amdgcn_s_setprio(0); } while (0)
#define PG8_WAIT_V(n) asm volatile("s_waitcnt vmcnt(" #n ")" ::: "memory")
#define PG8_WAIT_L(n) asm volatile("s_waitcnt lgkmcnt(" #n ")" ::: "memory")
#define PG8_BAR __builtin_amdgcn_s_barrier()
#define PG8_SCHED __builtin_amdgcn_sched_barrier(0)
    Unit cur, nxt; int ui = 0;
    if (!S.next(0, cur)) return;
    f32x4 acc[2][2][4][2];
#pragma unroll
    for (int a = 0; a < 2; ++a)
#pragma unroll
        for (int b = 0; b < 2; ++b)
#pragma unroll
            for (int m = 0; m < 4; ++m)
#pragma unroll
                for (int n = 0; n < 2; ++n) acc[a][b][m][n] = (f32x4){0.f, 0.f, 0.f, 0.f};
    bf16x8 At[4][2], B0[2][2], B1[2][2];
    const char* cA = (const char*)g.A + S.a_base(cur, tstep); const char* cB = (const char*)g.Bt + (size_t)cur.pb * tstep;
#pragma unroll
    for (int h = 0; h < 2; ++h)
#pragma unroll
        for (int i = 0; i < 2; ++i) { vAc[h][i] = S.a_off(cur, h * HALF + sR[i], K) + (unsigned)sC[i] * 2u; vAn[h][i] = vAc[h][i]; }
    S.a_ready(cur);
    if constexpr (SP2) {
        PG8_STAGE(PG8_SB(0, 0), cB, voffB); PG8_STAGE(PG8_SB(0, 1), cB + hstep, voffB); PG8_STAGE(PG8_SA(0, 0), cA, vAc[0]); PG8_STAGE(PG8_SA(0, 1), cA, vAc[1]);
        if (wr == 1) PG8_BAR;
        PG8_WAIT_V(2); PG8_BAR;
        PG8_STAGE(PG8_SB(1, 0), cB + kstep, voffB); PG8_STAGE(PG8_SA(1, 0), cA + kstep, vAc[0]); PG8_STAGE(PG8_SB(1, 1), cB + hstep + kstep, voffB);
        PG8_WAIT_V(6); PG8_BAR;
    } else {
        PG8_STAGE(PG8_SB(0, 0), cB, voffB); PG8_STAGE(PG8_SA(0, 0), cA, vAc[0]); PG8_STAGE(PG8_SB(0, 1), cB + hstep, voffB); PG8_STAGE(PG8_SA(0, 1), cA, vAc[1]);
        if (wr == 1) PG8_BAR;
        PG8_WAIT_V(4); PG8_BAR;
        PG8_STAGE(PG8_SB(1, 0), cB + kstep, voffB); PG8_STAGE(PG8_SA(1, 0), cA + kstep, vAc[0]); PG8_STAGE(PG8_SB(1, 1), cB + hstep + kstep, voffB);
        PG8_WAIT_V(6); PG8_BAR;
    }
    for (;;) {
        const bool has_next = S.next(ui + 1, nxt);
        const char* nA = has_next ? (const char*)g.A + S.a_base(nxt, tstep) : cA;
        if (has_next) {
#pragma unroll
            for (int h = 0; h < 2; ++h)
#pragma unroll
                for (int i = 0; i < 2; ++i) vAn[h][i] = S.a_off(nxt, h * HALF + sR[i], K) + (unsigned)sC[i] * 2u; } const char* nB = has_next ? (const char*)g.Bt + (size_t)nxt.pb * tstep : cB;
        for (int t = 0; t < nt; t += 2) {
            const bool last = (t == nt - 2);
            const char* a1 = cA + (size_t)(t + 1) * kstep;
            const char* a2 = last ? nA : cA + (size_t)(t + 2) * kstep; const char* b2 = last ? nB : cB + (size_t)(t + 2) * kstep;
            const char* a3 = a2 + kstep; const char* b3 = b2 + kstep;
            unsigned v2[2][2];
#pragma unroll
            for (int h = 0; h < 2; ++h)
#pragma unroll
                for (int i = 0; i < 2; ++i) v2[h][i] = last ? vAn[h][i] : vAc[h][i];
            if (last && has_next) S.a_ready(nxt);
            if constexpr (SP2) {
            PG8_LDB(B0, 0, 0); PG8_LDB(B1, 0, 1); PG8_SCHED; PG8_LDA(At, 0, 0); PG8_STAGE(PG8_SA(1, 1), a1, vAc[1]);
            PG8_WAIT_V(8); PG8_WAIT_L(0); PG8_BAR; PG8_MMA(0, 0, At, B0); PG8_MMA(0, 1, At, B1); PG8_BAR; PG8_SCHED;
            PG8_LDA(At, 0, 1); PG8_STAGE(PG8_SB(0, 0), b2, voffB); PG8_STAGE(PG8_SB(0, 1), b2 + hstep, voffB); PG8_STAGE(PG8_SA(0, 0), a2, v2[0]);
            PG8_WAIT_V(8); PG8_WAIT_L(0); PG8_BAR; PG8_MMA(1, 0, At, B0); PG8_MMA(1, 1, At, B1); PG8_BAR; PG8_SCHED;
            PG8_LDB(B0, 1, 0); PG8_LDB(B1, 1, 1); PG8_SCHED; PG8_LDA(At, 1, 0); PG8_STAGE(PG8_SA(0, 1), a2, v2[1]);
            PG8_WAIT_V(8); PG8_WAIT_L(0); PG8_BAR; PG8_MMA(0, 0, At, B0); PG8_MMA(0, 1, At, B1); PG8_BAR; PG8_SCHED;
            PG8_LDA(At, 1, 1); PG8_STAGE(PG8_SB(1, 0), b3, voffB); PG8_STAGE(PG8_SB(1, 1), b3 + hstep, voffB); PG8_STAGE(PG8_SA(1, 0), a3, v2[0]);
            PG8_WAIT_V(8); PG8_WAIT_L(0); PG8_BAR; PG8_MMA(1, 0, At, B0); PG8_MMA(1, 1, At, B1); PG8_BAR; PG8_SCHED;
            } else {
            PG8_LDB(B0, 0, 0); PG8_SCHED; PG8_LDA(At, 0, 0); PG8_STAGE(PG8_SA(1, 1), a1, vAc[1]);
            PG8_WAIT_L(8); PG8_BAR; PG8_WAIT_L(0); PG8_MMA(0, 0, At, B0); PG8_BAR; PG8_SCHED;
            PG8_LDB(B1, 0, 1); PG8_STAGE(PG8_SB(0, 0), b2, voffB);
            PG8_BAR; PG8_WAIT_L(0); PG8_MMA(0, 1, At, B1); PG8_BAR;
            PG8_LDA(At, 0, 1); PG8_STAGE(PG8_SA(0, 0), a2, v2[0]);
            PG8_BAR; PG8_WAIT_L(0); PG8_MMA(1, 0, At, B0); PG8_BAR; PG8_SCHED;
            PG8_STAGE(PG8_SB(0, 1), b2 + hstep, voffB);
            PG8_WAIT_V(6); PG8_BAR; PG8_MMA(1, 1, At, B1); PG8_BAR;
            PG8_LDB(B0, 1, 0); PG8_SCHED; PG8_LDA(At, 1, 0); PG8_STAGE(PG8_SA(0, 1), a2, v2[1]);
            PG8_WAIT_L(8); PG8_BAR; PG8_WAIT_L(0); PG8_MMA(0, 0, At, B0); PG8_BAR; PG8_SCHED;
            PG8_LDB(B1, 1, 1); PG8_STAGE(PG8_SB(1, 0), b3, voffB);
            PG8_BAR; PG8_WAIT_L(0); PG8_MMA(0, 1, At, B1); PG8_BAR;
            PG8_LDA(At, 1, 1); PG8_STAGE(PG8_SA(1, 0), a3, v2[0]);
            PG8_BAR; PG8_WAIT_L(0); PG8_MMA(1, 0, At, B0); PG8_BAR; PG8_SCHED;
            PG8_STAGE(PG8_SB(1, 1), b3 + hstep, voffB);
            PG8_WAIT_V(6); PG8_BAR; PG8_MMA(1, 1, At, B1); PG8_BAR;
            }
        }
        if constexpr (ALIGN_EPI) { if (wr == 0) PG8_BAR; }
        if constexpr (!Epi::AFTER_DRAIN) { E(acc, cur, wr, wc, fr, fq); S.done(cur); }
        if (!has_next) break;
#pragma unroll
        for (int a = 0; a < 2; ++a)
#pragma unroll
            for (int b = 0; b < 2; ++b)
#pragma unroll
                for (int m = 0; m < 4; ++m)
#pragma unroll
                    for (int n = 0; n < 2; ++n) acc[a][b][m][n] = (f32x4){0.f, 0.f, 0.f, 0.f};
        cur = nxt; cA = nA; cB = nB; ++ui;
#pragma unroll
        for (int h = 0; h < 2; ++h)
#pragma unroll
            for (int i = 0; i < 2; ++i) vAc[h][i] = vAn[h][i];
        if constexpr (ALIGN_EPI) { if (wr == 1) PG8_BAR; }
    }
    PG8_WAIT_V(0);
    if constexpr (!ALIGN_EPI) { if (wr == 0) PG8_BAR; }
    PG8_BAR;
    if constexpr (Epi::AFTER_DRAIN) { E.fused(acc, cur, wr, wc, fr, fq, lds, wid, lane); S.done(cur); }
#undef PG8_SA
#undef PG8_SB
#undef PG8_STAGE
#undef PG8_LDA
#undef PG8_LDB
#undef PG8_MMA
#undef PG8_WAIT_V
#undef PG8_WAIT_L
#undef PG8_BAR
#undef PG8_SCHED
}
}
#define GAS __attribute__((address_space(1)))
#define LAS __attribute__((address_space(3)))
typedef unsigned short bf16;
typedef unsigned v4u __attribute__((ext_vector_type(4)));
typedef float f32x4 __attribute__((ext_vector_type(4)));
typedef short bf16x8 __attribute__((ext_vector_type(8)));
typedef GAS unsigned gu32;
typedef GAS unsigned long long gu64;
#define RLX_AGENT __ATOMIC_RELAXED, __HIP_MEMORY_SCOPE_AGENT
#define LDS_WAIT() asm volatile("s_waitcnt lgkmcnt(0)" ::: "memory")
#define VM_WAIT() asm volatile("s_waitcnt vmcnt(0)" ::: "memory")
__device__ __forceinline__ unsigned long long rt() { return __builtin_amdgcn_s_memrealtime(); }
__device__ __forceinline__ unsigned f2bf(float f) { unsigned u = __builtin_bit_cast(unsigned, f); return (u + 0x7fffu + ((u >> 16) & 1u)) >> 16; }
__device__ __forceinline__ unsigned pk2(float lo, float hi) { return f2bf(lo) | (f2bf(hi) << 16); }

#define XB_TMO      128
#define XB_XCNT(j)  (256  + 64 * (j))
#define XB_XSUB(j)  (1280 + 64 * (j))
#define XB_XGEN(j)  (2304 + 64 * (j))
#define XB_TOP      3328
#define XB_TOPGEN   3392
#define XCD_BAR_WORDS 3456
#define XB_SPIN_CAP (1u << 18)

__device__ __forceinline__ unsigned xb_ld(unsigned* p)              { return __hip_atomic_load(p, __ATOMIC_RELAXED, __HIP_MEMORY_SCOPE_AGENT); }
__device__ __forceinline__ unsigned xb_add(unsigned* p, unsigned v) { return __hip_atomic_fetch_add(p, v, __ATOMIC_RELAXED, __HIP_MEMORY_SCOPE_AGENT); }
__device__ __forceinline__ unsigned xb_xcc_id() { return (unsigned)__builtin_amdgcn_s_getreg((3 << 11) | 20) & 0xFu; }
#define XB_SPIN(cond, bar) do { unsigned _sp = 0; while (cond) { __builtin_amdgcn_s_sleep(1); \
    if ((++_sp & 255u) == 0u) { if (xb_ld(&(bar)[XB_TMO])) break; if (_sp > XB_SPIN_CAP) { atomicAdd(&(bar)[XB_TMO], 1u); break; } } } } while (0)

struct XcdBarrier {
    unsigned* bar; unsigned x;
    volatile LAS unsigned* st;
};

__device__ __forceinline__ XcdBarrier xcd_barrier_post(unsigned* bar, volatile LAS unsigned* st) {
    XcdBarrier b; b.bar = bar; b.x = xb_xcc_id(); b.st = st;
    if (threadIdx.x == 0) (void)xb_add(&bar[XB_XCNT(b.x)], 1u);
    return b;
}
__device__ __forceinline__ void xcd_barrier_complete(unsigned* bar, unsigned x, unsigned& nloc, unsigned& nx) {
    const unsigned G = gridDim.x * gridDim.y * gridDim.z;
    unsigned sum, cnt, mine, sp = 0u;
    for (;;) {
        sum = 0u; cnt = 0u; mine = 0u;
#pragma unroll
        for (unsigned j = 0; j < 16; ++j) { const unsigned c = xb_ld(&bar[XB_XCNT(j)]); sum += c; cnt += (c > 0u) ? 1u : 0u; mine = (j == x) ? c : mine; }
        if (sum == G) break;
        __builtin_amdgcn_s_sleep(1);
        if ((++sp & 255u) == 0u) { if (xb_ld(&bar[XB_TMO])) break; if (sp > XB_SPIN_CAP) { atomicAdd(&bar[XB_TMO], 1u); break; } }
    }
    nloc = mine > 0u ? mine : 1u; nx = cnt > 0u ? cnt : 1u;
}

__device__ __forceinline__ void xcd_barrier(const XcdBarrier& b) {
    asm volatile("s_waitcnt vmcnt(0)" ::: "memory");
    __syncthreads();
    if (threadIdx.x == 0) {
        unsigned* bar = b.bar;
        __builtin_amdgcn_s_waitcnt(0);
        unsigned nloc = b.st[0], nx = b.st[1];
        if (nloc == 0u) { xcd_barrier_complete(bar, b.x, nloc, nx); b.st[0] = nloc; b.st[1] = nx; }
        const unsigned old = xb_add(&bar[XB_XSUB(b.x)], 1u);
        const unsigned gen = old / nloc;
        if (old + 1u == (gen + 1u) * nloc) {
            __builtin_amdgcn_fence(__ATOMIC_RELEASE, "agent");
            asm volatile("s_waitcnt vmcnt(0)" ::: "memory");
            const unsigned og = xb_add(&bar[XB_TOP], 1u);
            const unsigned tg = og / nx;
            if (og + 1u == (tg + 1u) * nx) xb_add(&bar[XB_TOPGEN], 1u);
            else XB_SPIN(xb_ld(&bar[XB_TOPGEN]) == tg, bar);
            __builtin_amdgcn_fence(__ATOMIC_ACQUIRE, "agent");
            xb_add(&bar[XB_XGEN(b.x)], 1u);
            asm volatile("s_waitcnt vmcnt(0)" ::: "memory");
        } else {
            XB_SPIN(xb_ld(&bar[XB_XGEN(b.x)]) == gen, bar);
            __builtin_amdgcn_fence(__ATOMIC_ACQUIRE, "agent");
            asm volatile("s_waitcnt vmcnt(0)" ::: "memory");
        }
    }
    __syncthreads();
}

using pg8::bf16_t;
typedef unsigned u32x2 __attribute__((ext_vector_type(2)));
__device__ __forceinline__ float bf2f(unsigned v) { return __uint_as_float(v << 16); }
__device__ __forceinline__ float bflo(unsigned w) { return __uint_as_float(w << 16); }
__device__ __forceinline__ float bfhi(unsigned w) { return __uint_as_float(w & 0xffff0000u); }
__device__ __forceinline__ float wave_sum(float v) {
#pragma unroll
    for (int o = 1; o < 64; o <<= 1) v += __shfl_xor(v, o);
    return v;
}
__device__ __forceinline__ float sigm(float x) { return 1.0f / (1.0f + expf(-x)); }
__device__ __forceinline__ float softplusf_(float x) { return fmaxf(x, 0.f) + log1pf(expf(-fabsf(x))); }
__device__ __forceinline__ float gelu_tanh(float x) { return 0.5f * x * (1.0f + tanhf(0.7978845608028654f * (x + 0.044715f * x * x * x))); }

__device__ __forceinline__ int gu_rowmap(int n) { const int a = n >> 1; return ((a >> 7) << 8) + (a & 127) + ((n & 1) << 7); }
struct TDesc { const float* W; bf16* WT; int ldw, K, k0, n0, gu; };
__device__ __forceinline__ void tload(const TDesc& d, f32x4 (&v)[16], int lane) {
#pragma unroll
    for (int i = 0; i < 16; ++i) v[i] = __builtin_nontemporal_load((const f32x4*)(d.W + (size_t)(d.k0 + 4 * i + (lane >> 4)) * d.ldw + d.n0 + 4 * (lane & 15)));
}
__device__ __forceinline__ void tstore(const TDesc& d, const f32x4 (&v)[16], LAS float* scr, int lane) {
#pragma unroll
    for (int i = 0; i < 16; ++i) { LAS float* p = scr + (4 * i + (lane >> 4)) * 65 + 4 * (lane & 15); p[0] = v[i][0]; p[1] = v[i][1]; p[2] = v[i][2]; p[3] = v[i][3]; }
    LDS_WAIT(); asm volatile("" ::: "memory");
    const int c = lane & 7;
#pragma unroll
    for (int j = 0; j < 8; ++j) { const int n = 8 * j + (lane >> 3); const LAS float* s = scr + (8 * c) * 65 + n;
        v4u o; o.x = pg8::cvt_pk_bf16(s[0], s[65]); o.y = pg8::cvt_pk_bf16(s[130], s[195]); o.z = pg8::cvt_pk_bf16(s[260], s[325]); o.w = pg8::cvt_pk_bf16(s[390], s[455]);
        const int nr = d.gu ? gu_rowmap(d.n0 + n) : (d.n0 + n);
        *(v4u*)(d.WT + (size_t)nr * d.K + d.k0 + 8 * c) = o; }
    LDS_WAIT(); asm volatile("" ::: "memory");
}
constexpr int IT_WIN = 16 * 52, IT_WOUT = 256, IT_GU = 512, IT_DN = 256;
constexpr int NIT_WIN = DEPTH * IT_WIN, NIT_WOUT = DEPTH * IT_WOUT, NIT_GU = DEPTH * NE * IT_GU, NIT_DN = DEPTH * NE * IT_DN, NITEMS = NIT_WIN + NIT_WOUT + NIT_GU + NIT_DN;

__device__ __forceinline__ void emit_xn_dt(const f32x4 (&v)[4], const float* g, const float* win_l, bf16* xn_row, float* dt_row, int lane) {
    float ss = 0.f;
#pragma unroll
    for (int j = 0; j < 4; ++j) ss += (v[j][0] * v[j][0] + v[j][1] * v[j][1]) + (v[j][2] * v[j][2] + v[j][3] * v[j][3]);
    ss = wave_sum(ss);
    const float rstd = 1.0f / sqrtf(ss * (1.0f / DM) + EPS);
    float d0 = 0.f, d1 = 0.f, d2 = 0.f, d3 = 0.f;
#pragma unroll
    for (int j = 0; j < 4; ++j) { const int col = 256 * j + 4 * lane; const f32x4 gg = *(const f32x4*)(g + col); const f32x4 u = v[j] * rstd * gg;
        u32x2 w; w.x = pk2(u[0], u[1]); w.y = pk2(u[2], u[3]); *(u32x2*)(xn_row + col) = w;
#pragma unroll
        for (int i = 0; i < 4; ++i) { const f32x4 ww = *(const f32x4*)(win_l + (size_t)(col + i) * DIN + C_DT); d0 += u[i] * ww[0]; d1 += u[i] * ww[1]; d2 += u[i] * ww[2]; d3 += u[i] * ww[3]; } }
    d0 = wave_sum(d0); d1 = wave_sum(d1); d2 = wave_sum(d2); d3 = wave_sum(d3);
    if (lane == 0) *(f32x4*)dt_row = (f32x4){d0, d1, d2, d3};
}

__device__ __forceinline__ void attn_naive(const bf16* proj, float* oraw, int b, int h, int qb, int lane) {
    const int t = qb * 64 + lane; const size_t row = (size_t)b * SEQ + t;
    int zero; asm volatile("v_mov_b32 %0, 0" : "=v"(zero));
    float q[64], acc[64];
    const bf16* qp = proj + row * DING + C_SBQ + h * 64;
#pragma unroll
    for (int c = 0; c < 8; ++c) { const v4u w = *(const v4u*)(qp + 8 * c);
#pragma unroll
        for (int i = 0; i < 4; ++i) { q[8 * c + 2 * i] = bflo(w[i]) * 0.125f; q[8 * c + 2 * i + 1] = bfhi(w[i]) * 0.125f; } }
#pragma unroll
    for (int d = 0; d < 64; ++d) acc[d] = 0.f;
    float R = 0.f;
    for (int s = qb * 64 + 62; s >= 0; --s) {
        const bf16* kp = proj + ((size_t)b * SEQ + s) * DING + C_SBK + h * 64 + zero;
        float z = 0.f;
#pragma unroll
        for (int c = 0; c < 8; ++c) { const v4u w = *(const v4u*)(kp + 8 * c);
#pragma unroll
            for (int i = 0; i < 4; ++i) { z += q[8 * c + 2 * i] * bflo(w[i]); z += q[8 * c + 2 * i + 1] * bfhi(w[i]); } }
        if (s < t) {
            const float sp = softplusf_(z);
            const float a = expf(z - sp + R);
            R -= sp;
            const bf16* vp = kp + 256;
#pragma unroll
            for (int c = 0; c < 8; ++c) { const v4u w = *(const v4u*)(vp + 8 * c);
#pragma unroll
                for (int i = 0; i < 4; ++i) { acc[8 * c + 2 * i] += a * bflo(w[i]); acc[8 * c + 2 * i + 1] += a * bfhi(w[i]); } }
        }
        if (__all(R < -88.0f)) break;
    }
    float* op = oraw + row * DM + h * 64;
#pragma unroll
    for (int c = 0; c < 16; ++c) *(f32x4*)(op + 4 * c) = (f32x4){acc[4 * c], acc[4 * c + 1], acc[4 * c + 2], acc[4 * c + 3]};
}

__device__ __forceinline__ void rg_chain(const bf16* proj, float* oraw, int b, int n, const float* conv_w, const float* conv_b, const float* wa, const float* ba,
                                         const float* wx, const float* bx, const float* lam, LAS float* L, int tid) {
    LAS float* wa_s = L; LAS float* wx_s = L + 4096; LAS float* xc_s = L + 8192; LAS float* a_s = L + 12288; LAS float* u_s = L + 16384;
    const int j = tid & 63, tr = tid >> 6, c = n * 64 + j;
    for (int idx = tid; idx < 4096; idx += NTHR) { wa_s[idx] = wa[n * 4096 + idx]; wx_s[idx] = wx[n * 4096 + idx]; }
    float cw[4];
#pragma unroll
    for (int k = 0; k < 4; ++k) cw[k] = conv_w[k * 256 + c];
    const float cb = conv_b[c], bav = ba[c], bxv = bx[c], spl = softplusf_(-lam[c]);
    float hstate = 0.f;
    __syncthreads();
    for (int ch = 0; ch < SEQ / 64; ++ch) {
        const int t0 = ch * 64;
#pragma unroll 1
        for (int i = 0; i < 8; ++i) { const int t = tr + 8 * i, tg = t0 + t; float a = cb;
#pragma unroll
            for (int k = 0; k < 4; ++k) { const int ts = tg - 3 + k; if (ts >= 0) a += cw[k] * bf2f(proj[((size_t)b * SEQ + ts) * DING + C_RGX + c]); }
            xc_s[t * 64 + j] = a; }
        __syncthreads();
#pragma unroll 1
        for (int i = 0; i < 8; ++i) { const int t = tr + 8 * i; float ra = bav, ga = bxv;
            _Pragma("unroll 4") for (int ii = 0; ii < 64; ++ii) { const float x = xc_s[t * 64 + ii]; ra += x * wa_s[ii * 64 + j]; ga += x * wx_s[ii * 64 + j]; }
            const float r = sigm(ra), ig = sigm(ga), log_a = -8.0f * r * spl;
            float mult = sqrtf(-expm1f(2.0f * log_a)); if (t0 + t == 0) mult = 1.0f;
            a_s[t * 64 + j] = expf(log_a); u_s[t * 64 + j] = mult * ig * xc_s[t * 64 + j]; }
        __syncthreads();
        if (tid < 64) {
            for (int t = 0; t < 64; ++t) { hstate = a_s[t * 64 + j] * hstate + u_s[t * 64 + j];
                const size_t row = (size_t)b * SEQ + t0 + t; const float gate = bf2f(proj[row * DING + C_RGG + c]);
                oraw[row * DM + 256 + c] = hstate * gelu_tanh(gate); }
        }
        __syncthreads();
    }
}

__device__ __forceinline__ void hg_chain(const bf16* proj, float* oraw, int b, int h, const float* lbp, int layer, LAS float* L, int tid) {
    constexpr int S = 65, A = 64 * S;
    LAS float* q_s = L; LAS float* k_s = L + A; LAS float* v_s = L + 2 * A; LAS float* bc_s = L + 3 * A; LAS float* sc_s = L + 4 * A; LAS float* st_s = L + 5 * A; LAS float* qe_s = L + 6 * A;
    const int j = tid & 63, tr = tid >> 6;
    float lb = 0.f;
    if (layer == 1) { const float x0 = lbp[h * 64 + j], x1 = lbp[256 + h * 64 + j], mx = fmaxf(x0, x1), e0 = expf(x0 - mx), e1 = expf(x1 - mx); lb = e1 / (e0 + e1); }
#pragma unroll
    for (int i = 0; i < 8; ++i) st_s[(tr + 8 * i) * S + j] = 0.f;
    __syncthreads();
    for (int ch = 0; ch < SEQ / 64; ++ch) {
        const int t0 = ch * 64;
#pragma unroll 1
        for (int i = 0; i < 8; ++i) { const int t = tr + 8 * i; const size_t row = (size_t)b * SEQ + t0 + t; const bf16* pp = proj + row * DING + h * 64 + j;
            const float qv = bf2f(pp[C_HGQ]), fv = bf2f(pp[C_HGF]), iv = bf2f(pp[C_HGI]);
            const float forget = lb + (1.0f - lb) * sigm(fv);
            q_s[t * S + j] = qv * sigm(qv); k_s[t * S + j] = 1.0f - forget; v_s[t * S + j] = iv; bc_s[t * S + j] = logf(forget); }
        __syncthreads();
        if (tid < 64) { float run = 0.f; for (int t = 0; t < 64; ++t) { run += bc_s[t * S + j]; bc_s[t * S + j] = run; } }
        __syncthreads();
#pragma unroll 1
        for (int i = 0; i < 8; ++i) { const int t = tr + 8 * i; qe_s[t * S + j] = q_s[t * S + j] * expf(bc_s[t * S + j]); }
#pragma unroll 1
        for (int i = 0; i < 8; ++i) { const int t = tr + 8 * i, s = j; float a = 0.f;
            if (s <= t) _Pragma("unroll 4") for (int c = 0; c < 64; ++c) a += q_s[t * S + c] * k_s[s * S + c] * expf(bc_s[t * S + c] - bc_s[s * S + c]);
            sc_s[t * S + s] = a; }
        __syncthreads();
#pragma unroll 1
        for (int i = 0; i < 8; ++i) { const int t = tr + 8 * i, v = j; float o = 0.f;
            _Pragma("unroll 4") for (int s = 0; s < 64; ++s) o += sc_s[t * S + s] * v_s[s * S + v];
            _Pragma("unroll 4") for (int c = 0; c < 64; ++c) o += qe_s[t * S + c] * st_s[c * S + v];
            oraw[((size_t)b * SEQ + t0 + t) * DM + 512 + h * 64 + v] = o; }
        __syncthreads();
#pragma unroll 1
        for (int i = 0; i < 8; ++i) { const int s = tr + 8 * i, c = j; sc_s[s * S + c] = k_s[s * S + c] * expf(bc_s[63 * S + c] - bc_s[s * S + c]); }
        __syncthreads();
#pragma unroll 1
        for (int i = 0; i < 8; ++i) { const int c = tr + 8 * i, v = j; float a = expf(bc_s[63 * S + c]) * st_s[c * S + v];
            _Pragma("unroll 4") for (int s = 0; s < 64; ++s) a += sc_s[s * S + c] * v_s[s * S + v];
            st_s[c * S + v] = a; }
        __syncthreads();
    }
}

__device__ __forceinline__ void m2_chain(const bf16* proj, const float* dtraw, float* oraw, int b, int h, const float* conv_w, const float* conv_b, const float* dt_bias,
                                         const float* a_log, const float* dskip, LAS float* L, int tid) {
    constexpr int SB = 129;
    LAS float* xs_s = L; LAS float* B_s = L + 4096; LAS float* C_s = B_s + 64 * SB; LAS float* W_s = C_s + 64 * SB; LAS float* st_s = W_s + 64 * 65;
    LAS float* dt_s = st_s + 64 * SB; LAS float* acs_s = dt_s + 64; LAS float* w_s = acs_s + 64;
    const int j = tid & 63, tr = tid >> 6, g = h >> 1;
    const float dtb = dt_bias[h], negA = -expf(a_log[h]), Dh = dskip[h];
    for (int idx = tid; idx < 64 * SB; idx += NTHR) st_s[idx] = 0.f;
    __syncthreads();
    for (int ch = 0; ch < SEQ / 64; ++ch) {
        const int t0 = ch * 64;
        for (int idx = tid; idx < 64 * 320; idx += NTHR) { const int cch = idx % 320, t = idx / 320;
            int col, cc; LAS float* dst;
            if (cch < 64) { cc = h * 64 + cch; dst = xs_s + t * 64 + cch; }
            else if (cch < 192) { cc = 256 + g * 128 + (cch - 64); dst = B_s + t * SB + (cch - 64); }
            else { cc = 512 + g * 128 + (cch - 192); dst = C_s + t * SB + (cch - 192); }
            col = C_M2X + cc;
            float a = conv_b[cc];
#pragma unroll
            for (int k = 0; k < 4; ++k) { const int ts = t0 + t - 3 + k; if (ts >= 0) a += conv_w[k * 768 + cc] * bf2f(proj[((size_t)b * SEQ + ts) * DING + col]); }
            *dst = a * sigm(a); }
        if (tid < 64) { const float dtv = softplusf_(dtraw[((size_t)b * SEQ + t0 + tid) * 4 + h] + dtb); dt_s[tid] = dtv;
            float v = dtv * negA;
#pragma unroll
            for (int o = 1; o < 64; o <<= 1) { const float nb = __shfl_up(v, o); if (tid >= o) v += nb; }
            acs_s[tid] = v; const float last = __shfl(v, 63); w_s[tid] = expf(last - v) * dtv; }
        __syncthreads();
#pragma unroll 1
        for (int i = 0; i < 8; ++i) { const int l = tr + 8 * i, s = j; float a = 0.f;
            if (s <= l) { _Pragma("unroll 4") for (int n = 0; n < 128; ++n) a += C_s[l * SB + n] * B_s[s * SB + n]; a *= expf(acs_s[l] - acs_s[s]); }
            W_s[l * 65 + s] = a; }
        __syncthreads();
#pragma unroll 1
        for (int i = 0; i < 8; ++i) { const int l = tr + 8 * i, p = j; float yd = 0.f, yo = 0.f;
            _Pragma("unroll 4") for (int s = 0; s < 64; ++s) yd += W_s[l * 65 + s] * (xs_s[s * 64 + p] * dt_s[s]);
            _Pragma("unroll 4") for (int n = 0; n < 128; ++n) yo += C_s[l * SB + n] * st_s[p * SB + n];
            const size_t row = (size_t)b * SEQ + t0 + l; const float zv = bf2f(proj[row * DING + C_M2Z + h * 64 + p]);
            const float y = yd + expf(acs_s[l]) * yo + xs_s[l * 64 + p] * Dh;
            oraw[row * DM + 768 + h * 64 + p] = y * (zv * sigm(zv)); }
        __syncthreads();
        { const int n = tid & 127, pq = tid >> 7; const float dec = expf(acs_s[63]);
#pragma unroll 1
            for (int i = 0; i < 16; ++i) { const int p = pq + 4 * i; float a = dec * st_s[p * SB + n];
                _Pragma("unroll 4") for (int s = 0; s < 64; ++s) a += B_s[s * SB + n] * (w_s[s] * xs_s[s * 64 + p]);
                st_s[p * SB + n] = a; } }
        __syncthreads();
    }
}

__device__ __forceinline__ void norm_row(const float* orow, const bf16* prow, bf16* mrow, const float* gA, const float* gB, const float* gC, const float* gD, int lane) {
    f32x4 v[4];
#pragma unroll
    for (int j = 0; j < 4; ++j) v[j] = *(const f32x4*)(orow + 256 * j + 4 * lane);
    float s[4];
#pragma unroll
    for (int j = 0; j < 4; ++j) s[j] = (v[j][0] * v[j][0] + v[j][1] * v[j][1]) + (v[j][2] * v[j][2] + v[j][3] * v[j][3]);
#pragma unroll
    for (int o = 1; o < 64; o <<= 1) { s[0] += __shfl_xor(s[0], o); s[1] += __shfl_xor(s[1], o); if (o < 16) s[2] += __shfl_xor(s[2], o); if (o < 32) s[3] += __shfl_xor(s[3], o); }
    const float r0 = 1.0f / sqrtf(s[0] * (1.0f / 256) + EPS), r1 = 1.0f / sqrtf(s[1] * (1.0f / 256) + EPS), r2 = 1.0f / sqrtf(s[2] * (1.0f / 64) + EPS), r3 = 1.0f / sqrtf(s[3] * (1.0f / 128) + EPS);
    const int c = 4 * lane;
    const f32x4 g0 = *(const f32x4*)(gA + c), g1 = *(const f32x4*)(gB + c), g2 = *(const f32x4*)(gC + c), g3 = *(const f32x4*)(gD + c);
    const u32x2 gw = *(const u32x2*)(prow + C_HGG + c);
    const float gi[4] = {bflo(gw.x), bfhi(gw.x), bflo(gw.y), bfhi(gw.y)};
    f32x4 o0 = v[0] * r0 * g0, o1 = v[1] * r1 * g1, o2 = v[2] * r2 * g2, o3 = v[3] * r3 * g3;
#pragma unroll
    for (int i = 0; i < 4; ++i) o2[i] *= gi[i] * sigm(gi[i]);
    u32x2 w;
    w.x = pk2(o0[0], o0[1]); w.y = pk2(o0[2], o0[3]); *(u32x2*)(mrow + c) = w;
    w.x = pk2(o1[0], o1[1]); w.y = pk2(o1[2], o1[3]); *(u32x2*)(mrow + 256 + c) = w;
    w.x = pk2(o2[0], o2[1]); w.y = pk2(o2[2], o2[3]); *(u32x2*)(mrow + 512 + c) = w;
    w.x = pk2(o3[0], o3[1]); w.y = pk2(o3[2], o3[3]); *(u32x2*)(mrow + 768 + c) = w;
}

constexpr int RWS = 1028;
__device__ __forceinline__ void router_load(const bf16* hrow, f32x4 (&v)[4], int lane) {
#pragma unroll
    for (int j = 0; j < 4; ++j) { const u32x2 w = *(const u32x2*)(hrow + 256 * j + 4 * lane); v[j] = (f32x4){bflo(w.x), bfhi(w.x), bflo(w.y), bfhi(w.y)}; }
}
__device__ __forceinline__ void router_row(f32x4 (&v)[4], const float* g, const LAS float* rw_t, const float* rb, bf16* xn_row, int& cntl, int& oe, int& orank, float& ogate, int lane) {
    float ss = 0.f;
#pragma unroll
    for (int j = 0; j < 4; ++j) ss += (v[j][0] * v[j][0] + v[j][1] * v[j][1]) + (v[j][2] * v[j][2] + v[j][3] * v[j][3]);
    ss = wave_sum(ss);
    const float rstd = 1.0f / sqrtf(ss * (1.0f / DM) + EPS);
#pragma unroll
    for (int j = 0; j < 4; ++j) { const int col = 256 * j + 4 * lane; v[j] = v[j] * rstd * *(const f32x4*)(g + col);
        u32x2 w; w.x = pk2(v[j][0], v[j][1]); w.y = pk2(v[j][2], v[j][3]); *(u32x2*)(xn_row + col) = w; }
    float p[32];
#pragma unroll
    for (int e = 0; e < 32; ++e) { float a = 0.f;
#pragma unroll
        for (int j = 0; j < 4; ++j) { const f32x4 w = *(const LAS f32x4*)(rw_t + e * RWS + 256 * j + 4 * lane); a += (v[j][0] * w[0] + v[j][1] * w[1]) + (v[j][2] * w[2] + v[j][3] * w[3]); }
        p[e] = a; }
    float q16[16], q8[8], q4[4], q2[2];
    { const bool hi = (lane & 32) != 0;
#pragma unroll
        for (int i = 0; i < 16; ++i) { const float keep = hi ? p[16 + i] : p[i], send = hi ? p[i] : p[16 + i]; q16[i] = keep + __shfl_xor(send, 32); } }
    { const bool hi = (lane & 16) != 0;
#pragma unroll
        for (int i = 0; i < 8; ++i) { const float keep = hi ? q16[8 + i] : q16[i], send = hi ? q16[i] : q16[8 + i]; q8[i] = keep + __shfl_xor(send, 16); } }
    { const bool hi = (lane & 8) != 0;
#pragma unroll
        for (int i = 0; i < 4; ++i) { const float keep = hi ? q8[4 + i] : q8[i], send = hi ? q8[i] : q8[4 + i]; q4[i] = keep + __shfl_xor(send, 8); } }
    { const bool hi = (lane & 4) != 0;
#pragma unroll
        for (int i = 0; i < 2; ++i) { const float keep = hi ? q4[2 + i] : q4[i], send = hi ? q4[i] : q4[2 + i]; q2[i] = keep + __shfl_xor(send, 4); } }
    float mine;
    { const bool hi = (lane & 2) != 0; const float keep = hi ? q2[1] : q2[0], send = hi ? q2[0] : q2[1]; mine = keep + __shfl_xor(send, 2); }
    mine += __shfl_xor(mine, 1);
    const int myexp = lane >> 1;
    mine += rb[myexp];
    int rank = 0;
#pragma unroll
    for (int e = 0; e < 32; ++e) { const float o = __uint_as_float(__builtin_amdgcn_readlane(__float_as_uint(mine), 2 * e)); rank += (o > mine || (o == mine && e < myexp)) ? 1 : 0; }
    int be[4]; float bl[4];
#pragma unroll
    for (int r = 0; r < 4; ++r) { const unsigned long long m = __ballot(rank == r && (lane & 1) == 0); be[r] = (int)(__builtin_ctzll(m) >> 1);
        bl[r] = __uint_as_float(__builtin_amdgcn_readlane(__float_as_uint(mine), 2 * be[r])); }
    const float e1 = expf(bl[1] - bl[0]), e2 = expf(bl[2] - bl[0]), e3 = expf(bl[3] - bl[0]), inv = 1.0f / (1.0f + e1 + e2 + e3);
    int rk[4];
#pragma unroll
    for (int r = 0; r < 4; ++r) { rk[r] = __builtin_amdgcn_readlane(cntl, be[r]); if (lane == be[r]) cntl += 1; }
    { const int k = lane & 3;
        oe = k == 0 ? be[0] : k == 1 ? be[1] : k == 2 ? be[2] : be[3]; orank = k == 0 ? rk[0] : k == 1 ? rk[1] : k == 2 ? rk[2] : rk[3];
        ogate = (k == 0 ? 1.0f : k == 1 ? e1 : k == 2 ? e2 : e3) * inv; }
}

__device__ __forceinline__ void router_row2(f32x4 (&va)[4], f32x4 (&vb)[4], const float* g, const LAS float* rw_t, const float* rb, bf16* xn_a, bf16* xn_b, int& cntl,
                                            int& oeA, int& orA, float& ogA, int& oeB, int& orB, float& ogB, int lane) {
    float sa = 0.f, sb = 0.f;
#pragma unroll
    for (int j = 0; j < 4; ++j) { sa += (va[j][0] * va[j][0] + va[j][1] * va[j][1]) + (va[j][2] * va[j][2] + va[j][3] * va[j][3]); sb += (vb[j][0] * vb[j][0] + vb[j][1] * vb[j][1]) + (vb[j][2] * vb[j][2] + vb[j][3] * vb[j][3]); }
#pragma unroll
    for (int o = 1; o < 64; o <<= 1) { sa += __shfl_xor(sa, o); sb += __shfl_xor(sb, o); }
    const float ra = 1.0f / sqrtf(sa * (1.0f / DM) + EPS), rbs = 1.0f / sqrtf(sb * (1.0f / DM) + EPS);
#pragma unroll
    for (int j = 0; j < 4; ++j) { const int col = 256 * j + 4 * lane; const f32x4 gg = *(const f32x4*)(g + col); va[j] = va[j] * ra * gg; vb[j] = vb[j] * rbs * gg;
        u32x2 w; w.x = pk2(va[j][0], va[j][1]); w.y = pk2(va[j][2], va[j][3]); *(u32x2*)(xn_a + col) = w;
        w.x = pk2(vb[j][0], vb[j][1]); w.y = pk2(vb[j][2], vb[j][3]); *(u32x2*)(xn_b + col) = w; }
    float pa[32], pb[32];
#pragma unroll
    for (int e = 0; e < 32; ++e) { float a = 0.f, b = 0.f;
#pragma unroll
        for (int j = 0; j < 4; ++j) { const f32x4 w = *(const LAS f32x4*)(rw_t + e * RWS + 256 * j + 4 * lane);
            a += (va[j][0] * w[0] + va[j][1] * w[1]) + (va[j][2] * w[2] + va[j][3] * w[3]); b += (vb[j][0] * w[0] + vb[j][1] * w[1]) + (vb[j][2] * w[2] + vb[j][3] * w[3]); }
        pa[e] = a; pb[e] = b; }
    float q32[32], q16[16], q8[8], q4[4], q2[2];
    { const bool hi = (lane & 32) != 0;
#pragma unroll
        for (int i = 0; i < 32; ++i) { const float keep = hi ? pb[i] : pa[i], send = hi ? pa[i] : pb[i]; q32[i] = keep + __shfl_xor(send, 32); } }
    { const bool hi = (lane & 16) != 0;
#pragma unroll
        for (int i = 0; i < 16; ++i) { const float keep = hi ? q32[16 + i] : q32[i], send = hi ? q32[i] : q32[16 + i]; q16[i] = keep + __shfl_xor(send, 16); } }
    { const bool hi = (lane & 8) != 0;
#pragma unroll
        for (int i = 0; i < 8; ++i) { const float keep = hi ? q16[8 + i] : q16[i], send = hi ? q16[i] : q16[8 + i]; q8[i] = keep + __shfl_xor(send, 8); } }
    { const bool hi = (lane & 4) != 0;
#pragma unroll
        for (int i = 0; i < 4; ++i) { const float keep = hi ? q8[4 + i] : q8[i], send = hi ? q8[i] : q8[4 + i]; q4[i] = keep + __shfl_xor(send, 4); } }
    { const bool hi = (lane & 2) != 0;
#pragma unroll
        for (int i = 0; i < 2; ++i) { const float keep = hi ? q4[2 + i] : q4[i], send = hi ? q4[i] : q4[2 + i]; q2[i] = keep + __shfl_xor(send, 2); } }
    float mine;
    { const bool hi = (lane & 1) != 0; const float keep = hi ? q2[1] : q2[0], send = hi ? q2[0] : q2[1]; mine = keep + __shfl_xor(send, 1); }
    const int myexp = lane & 31;
    mine += rb[myexp];
    int rank = 0;
#pragma unroll
    for (int e = 0; e < 32; ++e) { const float o = __shfl(mine, (lane & 32) + e); rank += (o > mine || (o == mine && e < myexp)) ? 1 : 0; }
    int beA[4], beB[4]; float blA[4], blB[4];
#pragma unroll
    for (int r = 0; r < 4; ++r) { const unsigned long long m = __ballot(rank == r); beA[r] = (int)__builtin_ctz((unsigned)m); beB[r] = (int)__builtin_ctz((unsigned)(m >> 32));
        blA[r] = __uint_as_float(__builtin_amdgcn_readlane(__float_as_uint(mine), beA[r])); blB[r] = __uint_as_float(__builtin_amdgcn_readlane(__float_as_uint(mine), 32 + beB[r])); }
    const float a1 = expf(blA[1] - blA[0]), a2 = expf(blA[2] - blA[0]), a3 = expf(blA[3] - blA[0]), ia = 1.0f / (1.0f + a1 + a2 + a3);
    const float b1 = expf(blB[1] - blB[0]), b2 = expf(blB[2] - blB[0]), b3 = expf(blB[3] - blB[0]), ib = 1.0f / (1.0f + b1 + b2 + b3);
    int rkA[4], rkB[4];
#pragma unroll
    for (int r = 0; r < 4; ++r) { rkA[r] = __builtin_amdgcn_readlane(cntl, beA[r]); if (lane == beA[r]) cntl += 1; }
#pragma unroll
    for (int r = 0; r < 4; ++r) { rkB[r] = __builtin_amdgcn_readlane(cntl, beB[r]); if (lane == beB[r]) cntl += 1; }
    { const int k = lane & 3;
        oeA = k == 0 ? beA[0] : k == 1 ? beA[1] : k == 2 ? beA[2] : beA[3]; orA = k == 0 ? rkA[0] : k == 1 ? rkA[1] : k == 2 ? rkA[2] : rkA[3]; ogA = (k == 0 ? 1.0f : k == 1 ? a1 : k == 2 ? a2 : a3) * ia;
        oeB = k == 0 ? beB[0] : k == 1 ? beB[1] : k == 2 ? beB[2] : beB[3]; orB = k == 0 ? rkB[0] : k == 1 ? rkB[1] : k == 2 ? rkB[2] : rkB[3]; ogB = (k == 0 ? 1.0f : k == 1 ? b1 : k == 2 ? b2 : b3) * ib; }
}

__device__ __forceinline__ void build_tb(const int* tot, LAS int* tb, int tid) {
    if (tid == 0) { int run = 0; for (int e = 0; e < 32; ++e) { tb[e] = run; run += (tot[e] + 255) >> 8; } tb[32] = run; }
    __syncthreads();
}

typedef short s16x4 __attribute__((ext_vector_type(4)));
typedef short v4i16_t __attribute__((ext_vector_type(4)));
#define MFMA16(a, b, c) __builtin_amdgcn_mfma_f32_16x16x32_bf16((a), (b), (c), 0, 0, 0)
__device__ __forceinline__ bf16x8 frag_kc(const LAS bf16* M, int ld, int idx0, int k0, int lane) { return *(const LAS bf16x8*)(M + (idx0 + (lane & 15)) * ld + k0 + 8 * (lane >> 4)); }
__device__ __forceinline__ bf16x8 frag_ks(const LAS bf16* M, int ld, int idx0, int k0, int lane) {
    const LAS bf16* p = M + (k0 + 8 * (lane >> 4) + ((lane & 15) >> 2)) * ld + idx0 + 4 * (lane & 3);
    const s16x4 lo = __builtin_bit_cast(s16x4, __builtin_amdgcn_ds_read_tr16_b64_v4i16((LAS v4i16_t*)p));
    const s16x4 hi = __builtin_bit_cast(s16x4, __builtin_amdgcn_ds_read_tr16_b64_v4i16((LAS v4i16_t*)(p + 4 * ld)));
    return (bf16x8){lo[0], lo[1], lo[2], lo[3], hi[0], hi[1], hi[2], hi[3]};
}
__device__ __forceinline__ bf16x8 frag_g32(const float* M, int ld, int idx0, int k0, int lane) {
    const float* p = M + (size_t)(idx0 + (lane & 15)) * ld + k0 + 8 * (lane >> 4);
    const f32x4 a = *(const f32x4*)p, b = *(const f32x4*)(p + 4);
    v4u w; w.x = pk2(a[0], a[1]); w.y = pk2(a[2], a[3]); w.z = pk2(b[0], b[1]); w.w = pk2(b[2], b[3]);
    return __builtin_bit_cast(bf16x8, w);
}
__device__ __forceinline__ float fsigm(float x) { return __builtin_amdgcn_rcpf(1.0f + __builtin_amdgcn_exp2f(-1.4426950408889634f * x)); }
__device__ __forceinline__ float fexp(float x) { return __builtin_amdgcn_exp2f(1.4426950408889634f * x); }

constexpr int M2LD = 136, M2WLD = 72;
__device__ __forceinline__ void m2_conv_block(const bf16* proj, const float* cw, const float* cb, int b, int t0, int tq, int cc0, float (&o)[8][8]) {
    v4u x[11]; f32x4 w[4][2];
    const int ts0 = t0 + 8 * tq - 3;
#pragma unroll
    for (int r = 0; r < 11; ++r) { const int ts = ts0 + r; x[r] = (v4u){0u, 0u, 0u, 0u}; if (ts >= 0) x[r] = *(const v4u*)(proj + ((size_t)b * SEQ + ts) * DING + C_M2X + cc0); }
#pragma unroll
    for (int k = 0; k < 4; ++k) { w[k][0] = *(const f32x4*)(cw + k * 768 + cc0); w[k][1] = *(const f32x4*)(cw + k * 768 + cc0 + 4); }
    const f32x4 b0 = *(const f32x4*)(cb + cc0), b1 = *(const f32x4*)(cb + cc0 + 4);
#pragma unroll
    for (int j = 0; j < 8; ++j) { float a[8] = {b0[0], b0[1], b0[2], b0[3], b1[0], b1[1], b1[2], b1[3]};
#pragma unroll
        for (int k = 0; k < 4; ++k) { const v4u xv = x[j + k];
            a[0] += w[k][0][0] * bflo(xv[0]); a[1] += w[k][0][1] * bfhi(xv[0]); a[2] += w[k][0][2] * bflo(xv[1]); a[3] += w[k][0][3] * bfhi(xv[1]);
            a[4] += w[k][1][0] * bflo(xv[2]); a[5] += w[k][1][1] * bfhi(xv[2]); a[6] += w[k][1][2] * bflo(xv[3]); a[7] += w[k][1][3] * bfhi(xv[3]); }
#pragma unroll
        for (int i = 0; i < 8; ++i) o[j][i] = a[i] * fsigm(a[i]); }
}
__device__ __forceinline__ void m2_dt_scan(const float* dtraw, const float* dt_bias, const float* a_log, int b, int t0, int g, LAS float* dt_s, LAS float* acs_s, LAS float* w_s, float* dec_out, int tid) {
    if (tid >= 384) { const int hh = (tid - 384) >> 6, t = tid & 63, h = 2 * g + hh;
        const float dtv = softplusf_(dtraw[((size_t)b * SEQ + t0 + t) * 4 + h] + dt_bias[h]);
        float v = dtv * (-expf(a_log[h]));
#pragma unroll
        for (int o = 1; o < 64; o <<= 1) { const float nb = __shfl_up(v, o); if (t >= o) v += nb; }
        const float last = __shfl(v, 63);
        dt_s[hh * 64 + t] = dtv; acs_s[hh * 64 + t] = v; w_s[hh * 64 + t] = expf(last - v) * dtv;
        if (dec_out && t == 63) dec_out[h] = expf(last); }
}
__device__ __forceinline__ void m2_state_unit(const bf16* proj, const float* dtraw, float* sloc, float* dec, int b, int ch, int g, const float* cw, const float* cb, const float* dt_bias, const float* a_log, LAS unsigned char* lds, int tid) {
    LAS bf16* XS = (LAS bf16*)lds; LAS bf16* BS = XS + 64 * M2LD; LAS float* dt_s = (LAS float*)(BS + 64 * M2LD); LAS float* acs_s = dt_s + 128; LAS float* w_s = acs_s + 128;
    const int lane = tid & 63, w = tid >> 6, t0 = ch * 64;
    m2_dt_scan(dtraw, dt_bias, a_log, b, t0, g, dt_s, acs_s, w_s, dec + (size_t)(b * 32 + ch) * 4, tid);
    float o[8][8]; const int cg = tid & 31, tq = tid >> 5;
    if (tid < 256) m2_conv_block(proj, cw, cb, b, t0, tq, cg < 16 ? g * 128 + 8 * cg : 256 + g * 128 + 8 * (cg - 16), o);
    __syncthreads();
    if (tid < 256) {
#pragma unroll
        for (int j = 0; j < 8; ++j) { const int t = 8 * tq + j; const float sc = cg < 16 ? w_s[(cg >> 3) * 64 + t] : 1.0f;
            v4u q; q.x = pk2(o[j][0] * sc, o[j][1] * sc); q.y = pk2(o[j][2] * sc, o[j][3] * sc); q.z = pk2(o[j][4] * sc, o[j][5] * sc); q.w = pk2(o[j][6] * sc, o[j][7] * sc);
            *(LAS v4u*)((cg < 16 ? XS + 8 * cg : BS + 8 * (cg - 16)) + t * M2LD) = q; } }
    __syncthreads();
    { const int hh = w >> 2, mi = w & 3;
        const bf16x8 a0 = frag_ks(XS, M2LD, hh * 64 + mi * 16, 0, lane), a1 = frag_ks(XS, M2LD, hh * 64 + mi * 16, 32, lane);
        float* outp = sloc + ((size_t)((b * 32 + ch) * 4 + 2 * g + hh) * 64 + mi * 16 + 4 * (lane >> 4)) * 128 + (lane & 15);
#pragma unroll
        for (int ni = 0; ni < 8; ++ni) { const bf16x8 b0 = frag_ks(BS, M2LD, ni * 16, 0, lane), b1 = frag_ks(BS, M2LD, ni * 16, 32, lane);
            f32x4 acc = {0.f, 0.f, 0.f, 0.f}; acc = MFMA16(a0, b0, acc); acc = MFMA16(a1, b1, acc);
#pragma unroll
            for (int i = 0; i < 4; ++i) outp[i * 128 + ni * 16] = acc[i]; } }
    __syncthreads();
}
__device__ __forceinline__ void m2_out_unit(const bf16* proj, const float* dtraw, const bf16* prevb, float* oraw, int b, int ch, int g, const float* cw, const float* cb, const float* dt_bias, const float* a_log, const float* dskip, LAS unsigned char* lds, int tid) {
    LAS bf16* XS = (LAS bf16*)lds; LAS bf16* BS = XS + 64 * M2LD; LAS bf16* CS = BS + 64 * M2LD; LAS bf16* WS = CS + 64 * M2LD;
    LAS float* dt_s = (LAS float*)(WS + 2 * 64 * M2WLD); LAS float* acs_s = dt_s + 128; LAS float* w_s = acs_s + 128;
    const int lane = tid & 63, w = tid >> 6, t0 = ch * 64;
    bf16x8 pf[4][4];
    { const bf16* pv = prevb + (size_t)((b * 32 + ch) * 4 + 2 * g + (w >> 2)) * 64 * 128;
#pragma unroll
        for (int kk = 0; kk < 4; ++kk)
#pragma unroll
            for (int ni = 0; ni < 4; ++ni) pf[kk][ni] = *(const bf16x8*)(pv + (size_t)(ni * 16 + (lane & 15)) * 128 + 32 * kk + 8 * (lane >> 4)); }
    m2_dt_scan(dtraw, dt_bias, a_log, b, t0, g, dt_s, acs_s, w_s, nullptr, tid);
    if (tid < 384) { float o[8][8]; const int cg = tid % 48, tq = tid / 48;
        const int cc0 = cg < 16 ? g * 128 + 8 * cg : cg < 32 ? 256 + g * 128 + 8 * (cg - 16) : 512 + g * 128 + 8 * (cg - 32);
        m2_conv_block(proj, cw, cb, b, t0, tq, cc0, o);
        LAS bf16* dst = cg < 16 ? XS + 8 * cg : cg < 32 ? BS + 8 * (cg - 16) : CS + 8 * (cg - 32);
#pragma unroll
        for (int j = 0; j < 8; ++j) { v4u q; q.x = pk2(o[j][0], o[j][1]); q.y = pk2(o[j][2], o[j][3]); q.z = pk2(o[j][4], o[j][5]); q.w = pk2(o[j][6], o[j][7]); *(LAS v4u*)(dst + (8 * tq + j) * M2LD) = q; } }
    __syncthreads();
    { const int mi = w >> 1, ni0 = (w & 1) * 2;
        f32x4 acc[2] = {{0.f, 0.f, 0.f, 0.f}, {0.f, 0.f, 0.f, 0.f}};
#pragma unroll
        for (int kk = 0; kk < 4; ++kk) { const bf16x8 a = frag_kc(CS, M2LD, mi * 16, 32 * kk, lane);
#pragma unroll
            for (int q = 0; q < 2; ++q) { const bf16x8 bb = frag_kc(BS, M2LD, (ni0 + q) * 16, 32 * kk, lane); acc[q] = MFMA16(a, bb, acc[q]); } }
#pragma unroll
        for (int q = 0; q < 2; ++q) { const int s = (ni0 + q) * 16 + (lane & 15);
#pragma unroll
            for (int hh = 0; hh < 2; ++hh) { const float as = acs_s[hh * 64 + s], ds = dt_s[hh * 64 + s];
#pragma unroll
                for (int i = 0; i < 4; ++i) { const int l = mi * 16 + 4 * (lane >> 4) + i;
                    const float v = (s <= l) ? acc[q][i] * fexp(acs_s[hh * 64 + l] - as) * ds : 0.f;
                    WS[(hh * 64 + l) * M2WLD + s] = (bf16)f2bf(v); } } } }
    __syncthreads();
    { const int hh = w >> 2, mi = w & 3, h = 2 * g + hh;
        f32x4 yd[4], yo[4];
#pragma unroll
        for (int ni = 0; ni < 4; ++ni) { yd[ni] = (f32x4){0.f, 0.f, 0.f, 0.f}; yo[ni] = (f32x4){0.f, 0.f, 0.f, 0.f}; }
#pragma unroll
        for (int kk = 0; kk < 2; ++kk) { const bf16x8 a = frag_kc(WS + hh * 64 * M2WLD, M2WLD, mi * 16, 32 * kk, lane);
#pragma unroll
            for (int ni = 0; ni < 4; ++ni) { const bf16x8 bb = frag_ks(XS, M2LD, hh * 64 + ni * 16, 32 * kk, lane); yd[ni] = MFMA16(a, bb, yd[ni]); } }
#pragma unroll
        for (int kk = 0; kk < 4; ++kk) { const bf16x8 a = frag_kc(CS, M2LD, mi * 16, 32 * kk, lane);
#pragma unroll
            for (int ni = 0; ni < 4; ++ni) yo[ni] = MFMA16(a, pf[kk][ni], yo[ni]); }
        const float Dh = dskip[h];
#pragma unroll
        for (int i = 0; i < 4; ++i) { const int l = mi * 16 + 4 * (lane >> 4) + i; const float ea = fexp(acs_s[hh * 64 + l]); const size_t row = (size_t)b * SEQ + t0 + l;
#pragma unroll
            for (int ni = 0; ni < 4; ++ni) { const int p = ni * 16 + (lane & 15);
                const float xv = bf2f(XS[l * M2LD + hh * 64 + p]), zv = bf2f(proj[row * DING + C_M2Z + h * 64 + p]);
                const float y = yd[ni][i] + ea * yo[ni][i] + xv * Dh;
                oraw[row * DM + 768 + h * 64 + p] = y * (zv * fsigm(zv)); } } }
    __syncthreads();
}

constexpr int HGLD = 136, HGWLD = 72;
template <bool WITH_Q>
__device__ __forceinline__ void hg_prep(const bf16* proj, int b, int t0, int hp, const float* lb1, int layer, LAS float* bc_s, LAS bf16* QS, LAS bf16* KS, LAS bf16* VS, LAS bf16* Q2, int tid) {
    const int c0 = (tid & 15) * 8, ta = tid >> 4;
    float lb[8];
#pragma unroll
    for (int i = 0; i < 8; ++i) lb[i] = 0.f;
    if (layer == 1) { const f32x4 l0 = *(const f32x4*)(lb1 + hp * 128 + c0), l1 = *(const f32x4*)(lb1 + hp * 128 + c0 + 4); lb[0] = l0[0]; lb[1] = l0[1]; lb[2] = l0[2]; lb[3] = l0[3]; lb[4] = l1[0]; lb[5] = l1[1]; lb[6] = l1[2]; lb[7] = l1[3]; }
    v4u fw[2], iw[2], qw[2];
#pragma unroll
    for (int u = 0; u < 2; ++u) { const size_t row = (size_t)b * SEQ + t0 + ta + 32 * u;
        fw[u] = *(const v4u*)(proj + row * DING + C_HGF + hp * 128 + c0); iw[u] = *(const v4u*)(proj + row * DING + C_HGI + hp * 128 + c0);
        if (WITH_Q) qw[u] = *(const v4u*)(proj + row * DING + C_HGQ + hp * 128 + c0); }
    float key[2][8];
#pragma unroll
    for (int u = 0; u < 2; ++u) { const int t = ta + 32 * u;
        const float f[8] = {bflo(fw[u][0]), bfhi(fw[u][0]), bflo(fw[u][1]), bfhi(fw[u][1]), bflo(fw[u][2]), bfhi(fw[u][2]), bflo(fw[u][3]), bfhi(fw[u][3])};
        float lf[8];
#pragma unroll
        for (int i = 0; i < 8; ++i) { const float sg = fsigm(f[i]); lf[i] = __builtin_amdgcn_logf(lb[i] + (1.0f - lb[i]) * sg) * 0.6931471805599453f; key[u][i] = (1.0f - lb[i]) * (1.0f - sg); }
        *(LAS f32x4*)(bc_s + t * 128 + c0) = (f32x4){lf[0], lf[1], lf[2], lf[3]}; *(LAS f32x4*)(bc_s + t * 128 + c0 + 4) = (f32x4){lf[4], lf[5], lf[6], lf[7]};
        *(LAS v4u*)(VS + t * HGLD + c0) = iw[u]; }
    __syncthreads();
    if (tid < 128) { float run = 0.f;
#pragma unroll 8
        for (int t = 0; t < 64; ++t) { run += bc_s[t * 128 + tid]; bc_s[t * 128 + tid] = run; } }
    __syncthreads();
    const f32x4 m0 = *(const LAS f32x4*)(bc_s + 31 * 128 + c0), m1 = *(const LAS f32x4*)(bc_s + 31 * 128 + c0 + 4);
    const float b31[8] = {m0[0], m0[1], m0[2], m0[3], m1[0], m1[1], m1[2], m1[3]};
#pragma unroll
    for (int u = 0; u < 2; ++u) { const int t = ta + 32 * u;
        const f32x4 x0 = *(const LAS f32x4*)(bc_s + t * 128 + c0), x1 = *(const LAS f32x4*)(bc_s + t * 128 + c0 + 4);
        const float bc[8] = {x0[0], x0[1], x0[2], x0[3], x1[0], x1[1], x1[2], x1[3]};
        float kk[8], qq[8], q2[8];
#pragma unroll
        for (int i = 0; i < 8; ++i) { const float d = b31[i] - bc[i]; kk[i] = key[u][i] * fexp(fminf(d, 60.0f));
            if (WITH_Q) { const float qv = (i & 1) ? bfhi(qw[u][i >> 1]) : bflo(qw[u][i >> 1]); const float qs = qv * fsigm(qv); qq[i] = qs * fexp(fminf(-d, 60.0f)); q2[i] = qs * fexp(bc[i]); } }
        v4u o; o.x = pk2(kk[0], kk[1]); o.y = pk2(kk[2], kk[3]); o.z = pk2(kk[4], kk[5]); o.w = pk2(kk[6], kk[7]); *(LAS v4u*)(KS + t * HGLD + c0) = o;
        if (WITH_Q) { o.x = pk2(qq[0], qq[1]); o.y = pk2(qq[2], qq[3]); o.z = pk2(qq[4], qq[5]); o.w = pk2(qq[6], qq[7]); *(LAS v4u*)(QS + t * HGLD + c0) = o;
            o.x = pk2(q2[0], q2[1]); o.y = pk2(q2[2], q2[3]); o.z = pk2(q2[4], q2[5]); o.w = pk2(q2[6], q2[7]); *(LAS v4u*)(Q2 + t * HGLD + c0) = o; } }
    __syncthreads();
}
__device__ __forceinline__ void hg_state_unit(const bf16* proj, float* slt, float* decc, int b, int ch, int hp, const float* lbp, int layer, LAS unsigned char* lds, int tid) {
    LAS float* bc_s = (LAS float*)lds; LAS bf16* KS = (LAS bf16*)(lds + 32768); LAS bf16* VS = KS + 64 * HGLD;
    const int lane = tid & 63, w = tid >> 6;
    hg_prep<false>(proj, b, ch * 64, hp, lbp, layer, bc_s, nullptr, KS, VS, nullptr, tid);
    if (tid < 128) decc[(size_t)((b * 32 + ch) * 4 + 2 * hp) * 64 + tid] = fexp(bc_s[63 * 128 + tid]);
    { const int hh = w >> 2, mi = w & 3, h = 2 * hp + hh;
        const bf16x8 a0 = frag_ks(VS, HGLD, hh * 64 + mi * 16, 0, lane), a1 = frag_ks(VS, HGLD, hh * 64 + mi * 16, 32, lane);
        float* outp = slt + ((size_t)((b * 32 + ch) * 4 + h) * 64 + mi * 16 + 4 * (lane >> 4)) * 64 + (lane & 15);
#pragma unroll
        for (int ni = 0; ni < 4; ++ni) { const bf16x8 b0 = frag_ks(KS, HGLD, hh * 64 + ni * 16, 0, lane), b1 = frag_ks(KS, HGLD, hh * 64 + ni * 16, 32, lane);
            f32x4 acc = {0.f, 0.f, 0.f, 0.f}; acc = MFMA16(a0, b0, acc); acc = MFMA16(a1, b1, acc);
            const int c = hh * 64 + ni * 16 + (lane & 15); const float sc = fexp(bc_s[63 * 128 + c] - bc_s[31 * 128 + c]);
#pragma unroll
            for (int i = 0; i < 4; ++i) outp[i * 64 + ni * 16] = acc[i] * sc; } }
    __syncthreads();
}
__device__ __forceinline__ void hg_out_unit(const bf16* proj, const bf16* stb, float* oraw, int b, int ch, int hp, const float* lbp, int layer, LAS unsigned char* lds, int tid) {
    LAS float* bc_s = (LAS float*)lds; LAS bf16* KS = (LAS bf16*)(lds + 32768); LAS bf16* VS = KS + 64 * HGLD; LAS bf16* QS = VS + 64 * HGLD; LAS bf16* WS = QS + 64 * HGLD; LAS bf16* Q2 = WS + 2 * 64 * HGWLD;
    const int lane = tid & 63, w = tid >> 6, t0 = ch * 64;
    const int hh = w >> 2, mi = w & 3, h = 2 * hp + hh;
    bf16x8 sf[2][4];
    { const bf16* st = stb + (size_t)((b * 32 + ch) * 4 + h) * 64 * 64;
#pragma unroll
        for (int kk = 0; kk < 2; ++kk)
#pragma unroll
            for (int ni = 0; ni < 4; ++ni) sf[kk][ni] = *(const bf16x8*)(st + (size_t)(ni * 16 + (lane & 15)) * 64 + 32 * kk + 8 * (lane >> 4)); }
    hg_prep<true>(proj, b, t0, hp, lbp, layer, bc_s, QS, KS, VS, Q2, tid);
    { f32x4 sc[4];
#pragma unroll
        for (int ni = 0; ni < 4; ++ni) sc[ni] = (f32x4){0.f, 0.f, 0.f, 0.f};
#pragma unroll
        for (int kk = 0; kk < 2; ++kk) { const bf16x8 a = frag_kc(QS, HGLD, mi * 16, hh * 64 + 32 * kk, lane);
#pragma unroll
            for (int ni = 0; ni < 4; ++ni) { const bf16x8 bb = frag_kc(KS, HGLD, ni * 16, hh * 64 + 32 * kk, lane); sc[ni] = MFMA16(a, bb, sc[ni]); } }
#pragma unroll
        for (int ni = 0; ni < 4; ++ni) { const int s = ni * 16 + (lane & 15);
#pragma unroll
            for (int i = 0; i < 4; ++i) { const int t = mi * 16 + 4 * (lane >> 4) + i; WS[(hh * 64 + t) * HGWLD + s] = (bf16)f2bf(s <= t ? sc[ni][i] : 0.f); } } }
    __syncthreads();
    { f32x4 o[4];
#pragma unroll
        for (int ni = 0; ni < 4; ++ni) o[ni] = (f32x4){0.f, 0.f, 0.f, 0.f};
#pragma unroll
        for (int kk = 0; kk < 2; ++kk) { const bf16x8 a = frag_kc(WS + hh * 64 * HGWLD, HGWLD, mi * 16, 32 * kk, lane);
#pragma unroll
            for (int ni = 0; ni < 4; ++ni) { const bf16x8 bb = frag_ks(VS, HGLD, hh * 64 + ni * 16, 32 * kk, lane); o[ni] = MFMA16(a, bb, o[ni]); } }
#pragma unroll
        for (int kk = 0; kk < 2; ++kk) { const bf16x8 a = frag_kc(Q2, HGLD, mi * 16, hh * 64 + 32 * kk, lane);
#pragma unroll
            for (int ni = 0; ni < 4; ++ni) o[ni] = MFMA16(a, sf[kk][ni], o[ni]); }
#pragma unroll
        for (int i = 0; i < 4; ++i) { const size_t row = (size_t)b * SEQ + t0 + mi * 16 + 4 * (lane >> 4) + i;
#pragma unroll
            for (int ni = 0; ni < 4; ++ni) oraw[row * DM + 512 + h * 64 + ni * 16 + (lane & 15)] = o[ni][i]; } }
    __syncthreads();
}

constexpr int RGLD = 136;
__device__ __forceinline__ void rg_local_unit(const bf16* proj, float* hloc, float* pcum, float* rgs, int b, int ch, int half, const float* conv_w, const float* conv_b, const bf16* waT, const bf16* wxT,
                                              const float* ba, const float* bx, const float* lam, LAS unsigned char* lds, int tid) {
    LAS float* xc32 = (LAS float*)lds; LAS float* a_s = xc32 + 64 * 128; LAS bf16* xcb = (LAS bf16*)(a_s + 64 * 128); LAS float* par = (LAS float*)(xcb + 64 * RGLD);
    const int lane = tid & 63, w = tid >> 6, t0 = ch * 64, cg0 = half * 128;
    if (tid < 128) { par[tid] = ba[cg0 + tid]; par[128 + tid] = bx[cg0 + tid]; par[256 + tid] = softplusf_(-lam[cg0 + tid]); }
    { const int c0 = (tid & 15) * 8, cg = cg0 + c0, tp = tid >> 4;
        v4u x[5]; f32x4 wk[4][2];
#pragma unroll
        for (int r = 0; r < 5; ++r) { const int ts = t0 + 2 * tp - 3 + r; x[r] = (v4u){0u, 0u, 0u, 0u}; if (ts >= 0) x[r] = *(const v4u*)(proj + ((size_t)b * SEQ + ts) * DING + C_RGX + cg); }
#pragma unroll
        for (int k = 0; k < 4; ++k) { wk[k][0] = *(const f32x4*)(conv_w + k * 256 + cg); wk[k][1] = *(const f32x4*)(conv_w + k * 256 + cg + 4); }
        const f32x4 b0 = *(const f32x4*)(conv_b + cg), b1 = *(const f32x4*)(conv_b + cg + 4);
#pragma unroll
        for (int j = 0; j < 2; ++j) { const int t = 2 * tp + j; float o[8] = {b0[0], b0[1], b0[2], b0[3], b1[0], b1[1], b1[2], b1[3]};
#pragma unroll
            for (int k = 0; k < 4; ++k) { const v4u xv = x[j + k];
                o[0] += wk[k][0][0] * bflo(xv[0]); o[1] += wk[k][0][1] * bfhi(xv[0]); o[2] += wk[k][0][2] * bflo(xv[1]); o[3] += wk[k][0][3] * bfhi(xv[1]);
                o[4] += wk[k][1][0] * bflo(xv[2]); o[5] += wk[k][1][1] * bfhi(xv[2]); o[6] += wk[k][1][2] * bflo(xv[3]); o[7] += wk[k][1][3] * bfhi(xv[3]); }
            *(LAS f32x4*)(xc32 + t * 128 + c0) = (f32x4){o[0], o[1], o[2], o[3]}; *(LAS f32x4*)(xc32 + t * 128 + c0 + 4) = (f32x4){o[4], o[5], o[6], o[7]};
            v4u q; q.x = pk2(o[0], o[1]); q.y = pk2(o[2], o[3]); q.z = pk2(o[4], o[5]); q.w = pk2(o[6], o[7]); *(LAS v4u*)(xcb + t * RGLD + c0) = q; } }
    __syncthreads();
    { const int nb = w >> 2, mi = w & 3, n = 2 * half + nb;
        f32x4 ra[4], ga[4];
#pragma unroll
        for (int ni = 0; ni < 4; ++ni) { ra[ni] = (f32x4){0.f, 0.f, 0.f, 0.f}; ga[ni] = (f32x4){0.f, 0.f, 0.f, 0.f}; }
#pragma unroll
        for (int kk = 0; kk < 2; ++kk) { const bf16x8 a = frag_kc(xcb, RGLD, mi * 16, nb * 64 + 32 * kk, lane);
#pragma unroll
            for (int ni = 0; ni < 4; ++ni) { const size_t off = (size_t)(n * 64 + ni * 16 + (lane & 15)) * 64 + 32 * kk + 8 * (lane >> 4);
                ra[ni] = MFMA16(a, *(const bf16x8*)(waT + off), ra[ni]); ga[ni] = MFMA16(a, *(const bf16x8*)(wxT + off), ga[ni]); } }
#pragma unroll
        for (int ni = 0; ni < 4; ++ni) { const int c = nb * 64 + ni * 16 + (lane & 15); const float bav = par[c], bxv = par[128 + c], spl = par[256 + c];
#pragma unroll
            for (int i = 0; i < 4; ++i) { const int t = mi * 16 + 4 * (lane >> 4) + i;
                const float r = fsigm(ra[ni][i] + bav), ig = fsigm(ga[ni][i] + bxv), log_a = -8.0f * r * spl;
                float mult = sqrtf(-expm1f(2.0f * log_a)); if (t0 + t == 0) mult = 1.0f;
                a_s[t * 128 + c] = expf(log_a); xc32[t * 128 + c] = mult * ig * xc32[t * 128 + c]; } } }
    __syncthreads();
    if (tid < 128) { float h = 0.f, P = 1.f; const size_t base = ((size_t)b * SEQ + t0) * 256 + cg0 + tid;
#pragma unroll 8
        for (int t = 0; t < 64; ++t) { const float a = a_s[t * 128 + tid]; h = a * h + xc32[t * 128 + tid]; P *= a; hloc[base + (size_t)t * 256] = h; pcum[base + (size_t)t * 256] = P; }
        rgs[((size_t)(b * 32 + ch) * 256 + cg0 + tid) * 2] = P; rgs[((size_t)(b * 32 + ch) * 256 + cg0 + tid) * 2 + 1] = h; }
    __syncthreads();
}

typedef float f32x16 __attribute__((ext_vector_type(16)));
#define MFMA32(a, b, c) __builtin_amdgcn_mfma_f32_32x32x16_bf16((a), (b), (c), 0, 0, 0)
constexpr int AVLD = 72;
__device__ __forceinline__ bf16x8 pack8(const f32x16& x, int o) {
    v4u w; w.x = pg8::cvt_pk_bf16(x[o], x[o + 1]); w.y = pg8::cvt_pk_bf16(x[o + 2], x[o + 3]); w.z = pg8::cvt_pk_bf16(x[o + 4], x[o + 5]); w.w = pg8::cvt_pk_bf16(x[o + 6], x[o + 7]);
    return __builtin_bit_cast(bf16x8, w);
}
__device__ __forceinline__ float lk2(float z) { return -(fmaxf(z, 0.f) + __builtin_amdgcn_logf(1.0f + __builtin_amdgcn_exp2f(-fabsf(z)))); }
__device__ __forceinline__ void attn_unit(const bf16* proj, float* oraw, int b, int h, int qb, LAS bf16* VL, int lane) {
    const int q = lane & 31, h2 = lane >> 5, qw = qb * 32; const size_t rowb = (size_t)b * SEQ;
    bf16x8 qf[4];
    { const bf16* qp = proj + (rowb + qw + q) * DING + C_SBQ + h * 64 + 8 * h2; const float C2 = 0.125f * 1.4426950408889634f;
#pragma unroll
        for (int kk = 0; kk < 4; ++kk) { const v4u w = *(const v4u*)(qp + 16 * kk); v4u o;
            o.x = pg8::cvt_pk_bf16(bflo(w.x) * C2, bfhi(w.x) * C2); o.y = pg8::cvt_pk_bf16(bflo(w.y) * C2, bfhi(w.y) * C2); o.z = pg8::cvt_pk_bf16(bflo(w.z) * C2, bfhi(w.z) * C2); o.w = pg8::cvt_pk_bf16(bflo(w.w) * C2, bfhi(w.w) * C2);
            qf[kk] = __builtin_bit_cast(bf16x8, o); } }
    bf16x8 m0[2], ones;
#pragma unroll
    for (int s = 0; s < 2; ++s) {
#pragma unroll
        for (int jj = 0; jj < 8; ++jj) { const int j = 16 * s + 8 * (jj >> 2) + 4 * h2 + (jj & 3); m0[s][jj] = (short)(j >= q ? 0x3F80 : 0); } }
#pragma unroll
    for (int jj = 0; jj < 8; ++jj) ones[jj] = (short)0x3F80;
    f32x16 o0, o1;
#pragma unroll
    for (int r = 0; r < 16; ++r) { o0[r] = 0.f; o1[r] = 0.f; }
    float R = 0.f;
    const int sd = (qw >> 6) << 6;
    for (int s0 = sd; s0 >= 0; s0 -= 64) {
        bf16x8 kf[2][4];
        { const bf16* kp = proj + (rowb + s0 + q) * DING + C_SBK + h * 64 + 8 * h2;
#pragma unroll
            for (int hf = 0; hf < 2; ++hf)
#pragma unroll
                for (int kk = 0; kk < 4; ++kk) kf[hf][kk] = *(const bf16x8*)(kp + (size_t)hf * 32 * DING + 16 * kk); }
#pragma unroll
        for (int i = 0; i < 8; ++i) { const int row = (lane >> 3) + 8 * i; const v4u w = *(const v4u*)(proj + (rowb + s0 + row) * DING + C_SBV + h * 64 + 8 * (lane & 7)); *(LAS v4u*)(VL + row * AVLD + 8 * (lane & 7)) = w; }
        f32x16 z0, z1;
#pragma unroll
        for (int r = 0; r < 16; ++r) { z0[r] = 0.f; z1[r] = 0.f; }
#pragma unroll
        for (int kk = 0; kk < 4; ++kk) { z0 = MFMA32(kf[0][kk], qf[kk], z0); z1 = MFMA32(kf[1][kk], qf[kk], z1); }
        const int lim = (s0 == sd) ? (qw - sd) + q : 64;
        f32x16 l0, l1;
#pragma unroll
        for (int r = 0; r < 16; ++r) { const int key = (r & 3) + 8 * (r >> 2) + 4 * h2; l0[r] = key < lim ? lk2(z0[r]) : 0.f; l1[r] = key + 32 < lim ? lk2(z1[r]) : 0.f; }
        const bf16x8 bl0 = pack8(l0, 0), bl1 = pack8(l0, 8), bh0 = pack8(l1, 0), bh1 = pack8(l1, 8);
        f32x16 i0 = z0, i1 = z1;
        i0 = MFMA32(m0[0], bl0, i0); i0 = MFMA32(m0[1], bl1, i0); i0 = MFMA32(ones, bh0, i0); i0 = MFMA32(ones, bh1, i0);
        i1 = MFMA32(m0[0], bh0, i1); i1 = MFMA32(m0[1], bh1, i1);
        float tot = h2 == 0 ? i0[0] - z0[0] : 0.f; tot += __shfl_xor(tot, 32);
#pragma unroll
        for (int r = 0; r < 16; ++r) { const int key = (r & 3) + 8 * (r >> 2) + 4 * h2; l0[r] = key < lim ? __builtin_amdgcn_exp2f(i0[r] + R) : 0.f; l1[r] = key + 32 < lim ? __builtin_amdgcn_exp2f(i1[r] + R) : 0.f; }
        R += tot;
        const bf16x8 pa0 = pack8(l0, 0), pa1 = pack8(l0, 8), pa2 = pack8(l1, 0), pa3 = pack8(l1, 8);
        const LAS bf16* vb = VL + (4 * h2 + ((lane & 15) >> 2)) * AVLD + 16 * ((lane >> 4) & 1) + 4 * (lane & 3);
#define VFRAG(kb, db) ({ const s16x4 lo_ = __builtin_bit_cast(s16x4, __builtin_amdgcn_ds_read_tr16_b64_v4i16((LAS v4i16_t*)(vb + (kb) * AVLD + (db) * 32))); \
                         const s16x4 hi_ = __builtin_bit_cast(s16x4, __builtin_amdgcn_ds_read_tr16_b64_v4i16((LAS v4i16_t*)(vb + ((kb) + 8) * AVLD + (db) * 32))); \
                         (bf16x8){lo_[0], lo_[1], lo_[2], lo_[3], hi_[0], hi_[1], hi_[2], hi_[3]}; })
        o0 = MFMA32(pa0, VFRAG(0, 0), o0); o1 = MFMA32(pa0, VFRAG(0, 1), o1);
        o0 = MFMA32(pa1, VFRAG(16, 0), o0); o1 = MFMA32(pa1, VFRAG(16, 1), o1);
        o0 = MFMA32(pa2, VFRAG(32, 0), o0); o1 = MFMA32(pa2, VFRAG(32, 1), o1);
        o0 = MFMA32(pa3, VFRAG(48, 0), o0); o1 = MFMA32(pa3, VFRAG(48, 1), o1);
#undef VFRAG
        if (__all(R < -127.0f)) break;
    }
    float* op = oraw + (rowb + qw) * DM + h * 64 + q;
#pragma unroll
    for (int r = 0; r < 16; ++r) { const int qq = (r & 3) + 8 * (r >> 2) + 4 * h2; op[(size_t)qq * DM] = o0[r]; op[(size_t)qq * DM + 32] = o1[r]; }
}


constexpr int NPL = 11, NPHASE = 1 + NPL * DEPTH;
struct Args { const float* in[29]; float* out; unsigned char* ws; int ph_lo, ph_hi, use_bar, pad; };

typedef const __attribute__((address_space(4))) Args* KArgP;
__device__ __forceinline__ KArgP kargs() { KArgP p = (KArgP)__builtin_amdgcn_kernarg_segment_ptr(); asm volatile("" : "+s"(p)); return p; }
#define WSP(type, off) ((type*)(kargs()->ws + (off)))
#define INP(i) (kargs()->in[i])

constexpr int CV_MOE = NE * IT_GU + NE * IT_DN;
constexpr int CV_TAILQ = 5, CV_TAILW = (256 - 64) * NWAVES;
constexpr int CV_TAIL = CV_TAILQ * CV_TAILW;
constexpr int CV_SMALL = NIT_WIN + NIT_WOUT;
#ifndef CV_SLOT_MASK
#define CV_SLOT_MASK 0
#endif
constexpr int CV_P0_ITEMS = CV_SLOT_MASK ? CV_SMALL : CV_SMALL + DEPTH * (CV_MOE - CV_TAIL);
__device__ __forceinline__ TDesc cv_moe(int l, int r) { TDesc d;
    if (r < NE * IT_GU) { const int le = l * NE + r / IT_GU, q = r % IT_GU; d.W = INP(24) + (size_t)le * DM * 2048; d.ldw = 2048; d.WT = WSP(bf16, WS_WGU) + (size_t)le * 2048 * DM; d.K = DM; d.k0 = 64 * (q / 32); d.n0 = 64 * (q % 32); d.gu = 1; return d; }
    r -= NE * IT_GU;
    { const int le = l * NE + r / IT_DN, q = r % IT_DN; d.W = INP(26) + (size_t)le * DFF * DM; d.ldw = DM; d.WT = WSP(bf16, WS_WDN) + (size_t)le * DM * DFF; d.K = DFF; d.k0 = 64 * (q / 16); d.n0 = 64 * (q % 16); d.gu = 0; return d; } }
__device__ __forceinline__ TDesc cv_p0(int r) { TDesc d;
    if (r < NIT_WIN) { const int l = r / IT_WIN, q = r % IT_WIN; d.W = INP(2) + (size_t)l * DM * DIN; d.ldw = DIN; d.WT = WSP(bf16, WS_WIN) + (size_t)l * DING * DM; d.K = DM; d.k0 = 64 * (q / 52); d.n0 = 64 * (q % 52); d.gu = 0; return d; }
    r -= NIT_WIN;
    if (r < NIT_WOUT) { const int l = r / IT_WOUT, q = r % IT_WOUT; d.W = INP(20) + (size_t)l * DM * DM; d.ldw = DM; d.WT = WSP(bf16, WS_WOUT) + (size_t)l * DM * DM; d.K = DM; d.k0 = 64 * (q / 16); d.n0 = 64 * (q % 16); d.gu = 0; return d; }
    r -= NIT_WOUT;
    const int l = r / (CV_MOE - CV_TAIL); return cv_moe(l, CV_TAIL + r % (CV_MOE - CV_TAIL)); }
__device__ __forceinline__ void convert_items(int n, int first, int stride, int tail_layer_p1, LAS float* scr, int lane) {
    int it = first; TDesc dc, dn; f32x4 va[16], vb[16];
    if (it < n) { dc = tail_layer_p1 ? cv_moe(tail_layer_p1 - 1, it) : cv_p0(it); tload(dc, va, lane); }
    while (it < n) { const int nx = it + stride; const bool hn = nx < n;
        if (hn) { dn = tail_layer_p1 ? cv_moe(tail_layer_p1 - 1, nx) : cv_p0(nx); tload(dn, vb, lane); }
        tstore(dc, va, scr, lane);
        if (hn) { dc = dn;
#pragma unroll
            for (int i = 0; i < 16; ++i) va[i] = vb[i]; }
        it = nx; }
}

__global__ void __launch_bounds__(NTHR, 2) fwd_kernel(Args args_unused) {
    extern __shared__ __attribute__((aligned(16))) unsigned char lds_raw[];
    LAS unsigned char* lds = (LAS unsigned char*)lds_raw;
    LAS float* ldsf = (LAS float*)lds_raw;
    volatile LAS unsigned* MISC = (volatile LAS unsigned*)(lds + MISC_OFF);
    LAS int* tb = (LAS int*)(lds + TB_OFF);
    const int tid0 = threadIdx.x;
#define PH_IDS int tid = threadIdx.x; asm volatile("" : "+v"(tid)); const int lane = tid & 63, wave = __builtin_amdgcn_readfirstlane(tid >> 6); const int gw = vcu * NWAVES + wave; (void)lane; (void)gw;
    const int G = gridDim.x, bx = blockIdx.x;
    const int vcu = (G % 8 == 0) ? (bx % 8) * (G / 8) + bx / 8 : bx;
    const int NGW = G * NWAVES;
    gu32* ctl = (gu32*)WSP(unsigned char, WS_CTL);

    for (int u = tid0; u < (LDS_BYTES - LDSCTL_OFF) / 4; u += NTHR) ((LAS unsigned*)(lds + LDSCTL_OFF))[u] = 0u;
    __syncthreads();
    XcdBarrier bar; bar.bar = (unsigned*)(ctl + CW_BAR); bar.x = 0; bar.st = nullptr;
    if (kargs()->use_bar) bar = xcd_barrier_post((unsigned*)(ctl + CW_BAR), MISC + 8);
    const int lo = kargs()->ph_lo, hi = kargs()->ph_hi;
#ifndef PH_MASK
#define PH_MASK 0xfff
#endif
#ifndef REP_MASK
#define REP_MASK 0
#endif
#define IN(k) (lo <= (k) && (k) < hi)
#define EN(ty) ((PH_MASK >> (ty)) & 1)
#define REPS(ty) (1 + ((REP_MASK >> (ty)) & 1))
#ifndef REP2_MASK
#define REP2_MASK 0
#endif
#define SUB(bit) _Pragma("unroll 1") for (int rep2_ = 0; rep2_ < 1 + ((REP2_MASK >> (bit)) & 1); ++rep2_)
#define SEAM(k) do { if (IN(k) && IN((k) + 1)) xcd_barrier(bar); } while (0)
#define PHASE(ty, k) if (EN(ty) && IN(k)) _Pragma("unroll 1") for (int rep_ = 0; rep_ < REPS(ty); ++rep_)

    PHASE(11, 0) { PH_IDS
        LAS float* scr = ldsf + wave * (64 * 65);
        convert_items(CV_P0_ITEMS, gw, NGW, 0, scr, lane);
        for (int idx = gw * 64 + lane; idx < DEPTH * 4 * 4096; idx += NGW * 64) { const int i = idx & 63, j = (idx >> 6) & 63, ln = idx >> 12;
            WSP(bf16, WS_WAT)[idx] = (bf16)f2bf(INP(6)[(size_t)ln * 4096 + i * 64 + j]); WSP(bf16, WS_WAT + 512 * 1024)[idx] = (bf16)f2bf(INP(8)[(size_t)ln * 4096 + i * 64 + j]); }
        for (int idx = gw * 64 + lane; idx < DEPTH * NE * DM; idx += NGW * 64) { const int k = idx & 1023, e = (idx >> 10) & 31, ll = idx >> 15;
            const float w = INP(21)[ll * DM + k] * INP(22)[((size_t)ll * DM + k) * NE + e]; const unsigned hi = f2bf(w); const float lo = w - __uint_as_float(hi << 16);
            bf16* dst = WSP(bf16, WS_RWB) + (size_t)ll * 2 * NE * DM + e * DM + k; dst[0] = (bf16)hi; dst[NE * DM] = (bf16)f2bf(lo); }
        if (gw == 0) for (int c = lane; c < 256; c += 64) { const float x0 = INP(12)[c], x1 = INP(12)[256 + c], mx = fmaxf(x0, x1), e0 = expf(x0 - mx), e1 = expf(x1 - mx); WSP(float, WS_LB1)[c] = e1 / (e0 + e1); }
        for (int m = gw; m < T; m += NGW) { f32x4 v[4];
#pragma unroll
            for (int j = 0; j < 4; ++j) v[j] = *(const f32x4*)(INP(0) + (size_t)m * DM + 256 * j + 4 * lane);
            emit_xn_dt(v, INP(1), INP(2), WSP(bf16, WS_XN) + (size_t)m * DM, WSP(float, WS_DT) + (size_t)m * 4, lane); }
    }
    SEAM(0);

#pragma unroll 1
    for (int l = 0; l < DEPTH; ++l) {
        const int P = 1 + NPL * l;
        PHASE(0, P) { PH_IDS
            pg8::Gemm g{WSP(bf16, WS_XN), WSP(bf16, WS_WIN) + (size_t)l * DING * DM, T, DING, DM}; pg8::StaticOrder S; S.init(T, DING, G, bx);
            pg8::EpiBf16 E{WSP(bf16, WS_PROJ), DING, nullptr, 0};
            pg8::gemm_phase<pg8::EpiBf16, pg8::StaticOrder, true, true>(lds, g, S, E);
            if (G == 256 && bx >= 64) convert_items(CV_TAIL, (bx - 64) * NWAVES + wave, CV_TAILW, l + 1, ldsf + wave * (64 * 65), lane);
            else if (G != 256) convert_items(CV_TAIL, gw, NGW, l + 1, ldsf + wave * (64 * 65), lane);
            __syncthreads();
        }
        SEAM(P);
#ifndef CV_SLOT_MASK
#define CV_SLOT_MASK 0
#endif
#define CV_SLOT_BEGIN(site, s) TDesc cd_; f32x4 cv_[16]; const int ci_ = CV_TAIL + (s) * NGW + gw; const bool ch_ = ((CV_SLOT_MASK >> (site)) & 1) && ci_ < CV_MOE; if (ch_) { cd_ = cv_moe(l, ci_); tload(cd_, cv_, lane); }
#define LAUNDER_TID int tidu = threadIdx.x; asm volatile("" : "+v"(tidu));
#define CV_SLOT_END() if (ch_) tstore(cd_, cv_, ldsf + wave * (64 * 65), lane); __syncthreads();
        PHASE(1, P + 1) { PH_IDS
            { const int v = vcu, b = v >> 5, ch = v & 31;
                SUB(0)
#pragma unroll 1
                for (int g = 0; g < 2; ++g) { LAUNDER_TID CV_SLOT_BEGIN(0, g) m2_state_unit(WSP(bf16, WS_PROJ), WSP(float, WS_DT), WSP(float, WS_SLOC), WSP(float, WS_DEC), b, ch, g, INP(14) + l * 3072, INP(15) + l * 768, INP(16) + l * 4, INP(17) + l * 4, lds, tidu); CV_SLOT_END() }
                SUB(1)
#pragma unroll 1
                for (int g = 0; g < 2; ++g) { LAUNDER_TID CV_SLOT_BEGIN(1, 2 + g) hg_state_unit(WSP(bf16, WS_PROJ), WSP(float, WS_SLT), WSP(float, WS_DECC), b, ch, g, WSP(float, WS_LB1), l, lds, tidu); CV_SLOT_END() }
                SUB(2)
#pragma unroll 1
                for (int g = 0; g < 2; ++g) { LAUNDER_TID CV_SLOT_BEGIN(2, 4 + g) rg_local_unit(WSP(bf16, WS_PROJ), WSP(float, WS_HLOC), WSP(float, WS_PCUM), WSP(float, WS_RGS), b, ch, g, INP(4) + l * 1024, INP(5) + l * 256, WSP(bf16, WS_WAT) + l * 16384, WSP(bf16, WS_WAT + 512 * 1024) + l * 16384, INP(7) + l * 256, INP(9) + l * 256, INP(10) + l * 256, lds, tidu); CV_SLOT_END() }
            }
            SUB(3) { __syncthreads();
            for (int u = gw; u < 2048; u += NGW) { const int qb = 63 - (u >> 5), bh = u & 31; attn_unit(WSP(bf16, WS_PROJ), WSP(float, WS_ORAW), bh >> 2, bh & 3, qb, (LAS bf16*)(lds + wave * (64 * AVLD * 2)), lane); }
            __syncthreads(); }
        }
        SEAM(P + 1);
        PHASE(2, P + 2) { PH_IDS
            { float* sl = WSP(float, WS_SLOC); const float* dc = WSP(float, WS_DEC); bf16* pb = WSP(bf16, WS_PREVB);
                const int e = (vcu * NTHR + tid) * 2, n = e & 127, p = (e >> 7) & 63, h = (e >> 13) & 3, b = e >> 15;
                if (b < NB) { float r0 = 0.f, r1 = 0.f;
#pragma unroll 8
                    for (int c = 0; c < 32; ++c) { float* a = sl + ((size_t)((b * 32 + c) * 4 + h) * 64 + p) * 128 + n; const float d = dc[(b * 32 + c) * 4 + h];
                        const float s0 = a[0], s1 = a[1]; *(unsigned*)(pb + (a - sl)) = pk2(r0, r1); r0 = d * r0 + s0; r1 = d * r1 + s1; } } }
            { float* sl = WSP(float, WS_SLT); const float* dc = WSP(float, WS_DECC); bf16* pb = WSP(bf16, WS_STB);
                const int e = vcu * NTHR + tid, c = e & 63, v = (e >> 6) & 63, h = (e >> 12) & 3, b = e >> 14;
                if (b < NB) { float r = 0.f;
#pragma unroll 8
                    for (int k = 0; k < 32; ++k) { float* a = sl + ((size_t)((b * 32 + k) * 4 + h) * 64 + v) * 64 + c; const float d = dc[(size_t)((b * 32 + k) * 4 + h) * 64 + c];
                        const float s0 = a[0]; pb[a - sl] = (bf16)f2bf(r); r = d * r + s0; } } }
            { const int e = vcu * NTHR + tid;
                if (e < NB * 256) { const int b = e >> 8, c = e & 255; const float* rs = WSP(float, WS_RGS); float* cy = WSP(float, WS_CARRY); float r = 0.f;
#pragma unroll 8
                    for (int k = 0; k < 32; ++k) { const size_t o = (size_t)(b * 32 + k) * 256 + c; cy[o] = r; r = rs[2 * o] * r + rs[2 * o + 1]; } } }
        }
        SEAM(P + 2);
        PHASE(3, P + 3) { PH_IDS
            { const int v = vcu, b = v >> 5, ch = v & 31;
                SUB(4)
#pragma unroll 1
                for (int g = 0; g < 2; ++g) { LAUNDER_TID m2_out_unit(WSP(bf16, WS_PROJ), WSP(float, WS_DT), WSP(bf16, WS_PREVB), WSP(float, WS_ORAW), b, ch, g, INP(14) + l * 3072, INP(15) + l * 768, INP(16) + l * 4, INP(17) + l * 4, INP(18) + l * 4, lds, tidu); }
                SUB(5)
#pragma unroll 1
                for (int g = 0; g < 2; ++g) { LAUNDER_TID CV_SLOT_BEGIN(3, 6 + g) hg_out_unit(WSP(bf16, WS_PROJ), WSP(bf16, WS_STB), WSP(float, WS_ORAW), b, ch, g, WSP(float, WS_LB1), l, lds, tidu); CV_SLOT_END() }
                SUB(6)
                { CV_SLOT_BEGIN(4, 8)
                    const float* hl = WSP(float, WS_HLOC); const float* pc = WSP(float, WS_PCUM); const float* cy = WSP(float, WS_CARRY); const bf16* pj = WSP(bf16, WS_PROJ); float* orw = WSP(float, WS_ORAW);
                    _Pragma("unroll 1") for (int r = 0; r < 8; ++r) { const int m = v * 64 + wave * 8 + r, c = 4 * lane; const size_t cb = (size_t)v * 256 + c;
                        const f32x4 hv = *(const f32x4*)(hl + (size_t)m * 256 + c), pv = *(const f32x4*)(pc + (size_t)m * 256 + c), cv = *(const f32x4*)(cy + cb);
                        const u32x2 gwd = *(const u32x2*)(pj + (size_t)m * DING + C_RGG + c);
                        f32x4 o = hv + pv * cv; o[0] *= gelu_tanh(bflo(gwd.x)); o[1] *= gelu_tanh(bfhi(gwd.x)); o[2] *= gelu_tanh(bflo(gwd.y)); o[3] *= gelu_tanh(bfhi(gwd.y));
                        *(f32x4*)(orw + (size_t)m * DM + 256 + c) = o; }
                    CV_SLOT_END()
                }
                _Pragma("unroll 1") for (int r = 0; r < 8; ++r) { const int m = v * 64 + wave * 8 + r;
                    norm_row(WSP(float, WS_ORAW) + (size_t)m * DM, WSP(bf16, WS_PROJ) + (size_t)m * DING, WSP(bf16, WS_MIX) + (size_t)m * DM, INP(3) + l * 256, INP(11) + l * 256, INP(13) + l * 256, INP(19) + l * 256, lane); }
            }
        }
        SEAM(P + 3);
        PHASE(5, P + 5) { PH_IDS
            pg8::Gemm g{WSP(bf16, WS_MIX), WSP(bf16, WS_WOUT) + (size_t)l * DM * DM, T, DM, DM}; pg8::StaticOrder S; S.init(T, DM, G, bx);
            if (l == 0) { pg8::EpiResBf16<true> E{INP(0), WSP(bf16, WS_H1), DM}; pg8::gemm_phase<pg8::EpiResBf16<true>, pg8::StaticOrder, true, true>(lds, g, S, E); }
            else { pg8::EpiResBf16<false> E{WSP(bf16, WS_HB), WSP(bf16, WS_H1), DM}; pg8::gemm_phase<pg8::EpiResBf16<false>, pg8::StaticOrder, true, true>(lds, g, S, E); }
        }
        SEAM(P + 5);
        PHASE(6, P + 6) { PH_IDS
            constexpr int WLD = 1032;
            LAS bf16* WB = (LAS bf16*)lds; LAS float* LG = (LAS float*)(lds + 2 * 32 * WLD * 2); LAS float* SS = LG + 64 * 33; LAS float* RS = SS + 64;
            { const bf16* src = WSP(bf16, WS_RWB) + (size_t)l * 2 * 32 * 1024; v4u wv[16];
#pragma unroll
                for (int i = 0; i < 16; ++i) wv[i] = *(const v4u*)(src + (size_t)(tid + NTHR * i) * 8);
#pragma unroll
                for (int i = 0; i < 16; ++i) { const int c = tid + NTHR * i; *(LAS v4u*)(WB + (c >> 7) * WLD + (c & 127) * 8) = wv[i]; } }
            __syncthreads();
            const bf16* h1 = WSP(bf16, WS_H1);
            { const int rt = wave >> 1, et = wave & 1; const bf16* hp = h1 + (size_t)(vcu * 64 + rt * 16 + (lane & 15)) * DM + 8 * (lane >> 4);
                f32x4 acc = {0.f, 0.f, 0.f, 0.f}; float ssum = 0.f;
#pragma unroll 8
                for (int ks = 0; ks < 32; ++ks) { const bf16x8 a = *(const bf16x8*)(hp + 32 * ks);
                    acc = MFMA16(a, frag_kc(WB, WLD, et * 16, 32 * ks, lane), acc); acc = MFMA16(a, frag_kc(WB + 32 * WLD, WLD, et * 16, 32 * ks, lane), acc);
                    const v4u aw = __builtin_bit_cast(v4u, a);
#pragma unroll
                    for (int i = 0; i < 4; ++i) { const float x0 = bflo(aw[i]), x1 = bfhi(aw[i]); ssum += x0 * x0 + x1 * x1; } }
                ssum += __shfl_xor(ssum, 16); ssum += __shfl_xor(ssum, 32);
                if (et == 0 && lane < 16) SS[rt * 16 + lane] = ssum;
#pragma unroll
                for (int i = 0; i < 4; ++i) LG[(rt * 16 + 4 * (lane >> 4) + i) * 33 + et * 16 + (lane & 15)] = acc[i]; }
            __syncthreads();
            if (wave == 0) { const int row = lane; const float rstd = 1.0f / sqrtf(SS[row] * (1.0f / DM) + EPS); RS[row] = rstd;
                const float* rb = INP(23) + l * NE;
                float lg[32];
#pragma unroll
                for (int e = 0; e < 32; ++e) lg[e] = rstd * LG[row * 33 + e] + rb[e];
                int be[4]; float bl[4];
#pragma unroll
                for (int r = 0; r < 4; ++r) { float best = -INFINITY; int bi = 0;
#pragma unroll
                    for (int e = 0; e < 32; ++e) if (lg[e] > best) { best = lg[e]; bi = e; }
#pragma unroll
                    for (int e = 0; e < 32; ++e) if (e == bi) lg[e] = -INFINITY;
                    be[r] = bi; bl[r] = best; }
                const float e1 = expf(bl[1] - bl[0]), e2 = expf(bl[2] - bl[0]), e3 = expf(bl[3] - bl[0]), inv = 1.0f / (1.0f + e1 + e2 + e3);
                int rk0 = 0, rk1 = 0, rk2 = 0, rk3 = 0, hist = 0; const unsigned long long lt = (1ull << lane) - 1ull;
#pragma unroll
                for (int e = 0; e < 32; ++e) { const bool h0 = be[0] == e, h1b = be[1] == e, h2 = be[2] == e, h3 = be[3] == e; const unsigned long long m = __ballot(h0 | h1b | h2 | h3);
                    const int below = __popcll(m & lt); rk0 = h0 ? below : rk0; rk1 = h1b ? below : rk1; rk2 = h2 ? below : rk2; rk3 = h3 ? below : rk3; if (lane == e) hist = __popcll(m); }
                if (lane < 32) WSP(int, WS_HIST)[(size_t)vcu * 32 + lane] = hist;
                const int a = (vcu * 64 + row) * 4;
                *(int4*)(WSP(int, WS_ASGE) + a) = make_int4(be[0], be[1], be[2], be[3]); *(int4*)(WSP(int, WS_ASGP) + a) = make_int4(rk0, rk1, rk2, rk3);
                *(f32x4*)(WSP(float, WS_GATE) + a) = (f32x4){inv, e1 * inv, e2 * inv, e3 * inv}; }
            __syncthreads();
            { const float* g = INP(21) + l * DM; bf16* xn = WSP(bf16, WS_XN);
#pragma unroll
                for (int r = 0; r < 8; ++r) { const int row = wave * 8 + r; const size_t m = (size_t)vcu * 64 + row; const float rstd = RS[row];
#pragma unroll
                    for (int j = 0; j < 2; ++j) { const int col = 512 * j + 8 * lane; const v4u w = *(const v4u*)(h1 + m * DM + col); const f32x4 g0 = *(const f32x4*)(g + col), g1 = *(const f32x4*)(g + col + 4);
                        v4u o; o.x = pk2(bflo(w.x) * rstd * g0[0], bfhi(w.x) * rstd * g0[1]); o.y = pk2(bflo(w.y) * rstd * g0[2], bfhi(w.y) * rstd * g0[3]);
                        o.z = pk2(bflo(w.z) * rstd * g1[0], bfhi(w.z) * rstd * g1[1]); o.w = pk2(bflo(w.w) * rstd * g1[2], bfhi(w.w) * rstd * g1[3]);
                        *(v4u*)(xn + m * DM + col) = o; } } }
        }
        SEAM(P + 6);
        PHASE(7, P + 7) { PH_IDS
            LAS int* bs = (LAS int*)(lds + 131072);
            if (tid < 32) { const int* hs = WSP(int, WS_HIST); int base = 0, tot = 0;
#pragma unroll 8
                for (int w = 0; w < G; ++w) { const int c = hs[w * 32 + tid]; tot += c; if (w < vcu) base += c; }
                bs[tid] = base; bs[32 + tid] = tot; if (vcu == 0) WSP(int, WS_TOT)[tid] = tot; }
            __syncthreads();
            if (tid == 0) { int run = 0; for (int e = 0; e < 32; ++e) { tb[e] = run; run += (bs[32 + e] + 255) >> 8; } tb[32] = run; }
            __syncthreads();
            const int* asge = WSP(int, WS_ASGE); const int* asgp = WSP(int, WS_ASGP); int* slotp = WSP(int, WS_SLOT); int* toks = (int*)(kargs()->ws + WS_CTL + CTL_TOKS) + (size_t)l * MAXSLOT;
            if (tid < 256) { const int a = vcu * 256 + tid; const int e = asge[a], slot = tb[e] * 256 + bs[e] + asgp[a]; slotp[a] = slot; toks[slot] = a >> 2; }
        }
        SEAM(P + 7);
        PHASE(8, P + 8) { PH_IDS
            build_tb(WSP(int, WS_TOT), tb, tid);
            LAS int* tokl = (LAS int*)(lds + 131072);
            pg8::MoeOrder S{(const LAS int*)tb, 8, G, bx, (const LAS int*)tokl};
            { const int* toks = (const int*)(kargs()->ws + WS_CTL + CTL_TOKS) + (size_t)l * MAXSLOT; pg8::Unit u;
                for (int i = 0; i < 15 && S.next(i, u); ++i) if (tid < 256) tokl[i * 256 + tid] = toks[u.pm * 256 + tid];
                __syncthreads(); }
            pg8::Gemm g{WSP(bf16, WS_XN), WSP(bf16, WS_WGU) + (size_t)l * NE * 2048 * DM, T, 2048, DM};
            pg8::EpiSwiglu E{WSP(bf16, WS_ACT), INP(25) + (size_t)l * NE * 2048};
            pg8::gemm_phase<pg8::EpiSwiglu, pg8::MoeOrder, true, true>(lds, g, S, E);
        }
        SEAM(P + 8);
        PHASE(9, P + 9) { PH_IDS
            build_tb(WSP(int, WS_TOT), tb, tid);
            pg8::Gemm g{WSP(bf16, WS_ACT), WSP(bf16, WS_WDN) + (size_t)l * NE * DM * DFF, MAXSLOT, DM, DFF}; pg8::MoeOrder S{(const LAS int*)tb, 4, G, bx};
            pg8::EpiBf16 E{WSP(bf16, WS_Y), DM, INP(27) + (size_t)l * NE * DM, DM};
            pg8::gemm_phase<pg8::EpiBf16, pg8::MoeOrder, true, true>(lds, g, S, E);
        }
        SEAM(P + 9);
        PHASE(10, P + 10) { PH_IDS
            const bf16* h1 = WSP(bf16, WS_H1); const int* slotp = WSP(int, WS_SLOT); const float* gatep = WSP(float, WS_GATE); const bf16* yb = WSP(bf16, WS_Y);
            for (int m = gw; m < T; m += NGW) { f32x4 v[4];
#pragma unroll
                for (int j = 0; j < 4; ++j) { const u32x2 w = *(const u32x2*)(h1 + (size_t)m * DM + 256 * j + 4 * lane); v[j] = (f32x4){bflo(w.x), bfhi(w.x), bflo(w.y), bfhi(w.y)}; }
#pragma unroll
                for (int r = 0; r < 4; ++r) { const int slot = slotp[m * 4 + r]; const float gg = gatep[m * 4 + r]; const bf16* yr = yb + (size_t)slot * DM;
#pragma unroll
                    for (int j = 0; j < 4; ++j) { const u32x2 w = *(const u32x2*)(yr + 256 * j + 4 * lane); v[j][0] += gg * bflo(w.x); v[j][1] += gg * bfhi(w.x); v[j][2] += gg * bflo(w.y); v[j][3] += gg * bfhi(w.y); } }
                if (l + 1 < DEPTH) {
#pragma unroll
                    for (int j = 0; j < 4; ++j) { u32x2 w; w.x = pk2(v[j][0], v[j][1]); w.y = pk2(v[j][2], v[j][3]); *(u32x2*)(WSP(bf16, WS_HB) + (size_t)m * DM + 256 * j + 4 * lane) = w; }
                    emit_xn_dt(v, INP(1) + (l + 1) * DM, INP(2) + (size_t)(l + 1) * DM * DIN, WSP(bf16, WS_XN) + (size_t)m * DM, WSP(float, WS_DT) + (size_t)m * 4, lane);
                } else { float ss = 0.f;
#pragma unroll
                    for (int j = 0; j < 4; ++j) ss += (v[j][0] * v[j][0] + v[j][1] * v[j][1]) + (v[j][2] * v[j][2] + v[j][3] * v[j][3]);
                    ss = wave_sum(ss); const float rstd = 1.0f / sqrtf(ss * (1.0f / DM) + EPS);
#pragma unroll
                    for (int j = 0; j < 4; ++j) *(f32x4*)(kargs()->out + (size_t)m * DM + 256 * j + 4 * lane) = v[j] * rstd * *(const f32x4*)(INP(28) + 256 * j + 4 * lane); }
            }
        }
        if (l + 1 < DEPTH) SEAM(P + 10);
    }
#undef IN
#undef SEAM
}

extern "C" void kernel_launch(void* const* d_in, const int* in_sizes, int n_in, void* d_out, int out_size, void* d_ws, size_t ws_size, hipStream_t stream) {
    static int grid = 0;
    if (grid == 0) {
        if (n_in != 29 || in_sizes[0] != T * DM || out_size != T * DM || ws_size < WS_END) { fprintf(stderr, "kernel_launch: unexpected shapes (n_in %d, in0 %d, out %d, ws %zu); nothing launched\n", n_in, n_in > 0 ? in_sizes[0] : -1, out_size, ws_size); grid = -1; return; }
        int dev = 0, cus = 0, per_cu = 0;
        if (hipGetDevice(&dev) != hipSuccess || hipDeviceGetAttribute(&cus, hipDeviceAttributeMultiprocessorCount, dev) != hipSuccess) { grid = -1; return; }
        if (hipFuncSetAttribute((const void*)fwd_kernel, hipFuncAttributeMaxDynamicSharedMemorySize, LDS_BYTES) != hipSuccess) { fprintf(stderr, "kernel_launch: hipFuncSetAttribute failed\n"); grid = -1; return; }
        if (hipOccupancyMaxActiveBlocksPerMultiprocessor(&per_cu, (const void*)fwd_kernel, NTHR, LDS_BYTES) != hipSuccess || per_cu < 1) fprintf(stderr, "kernel_launch: occupancy query reports %d\n", per_cu);
        (void)hipGetLastError();
        grid = cus;
    }
    if (grid < 0) return;
    if (hipMemsetAsync((char*)d_ws + WS_CTL, 0, CTL_ZERO_BYTES, stream) != hipSuccess) { fprintf(stderr, "kernel_launch: memset failed\n"); return; }
    Args a{};
    for (int i = 0; i < 29; ++i) a.in[i] = (const float*)d_in[i];
    a.out = (float*)d_out; a.ws = (unsigned char*)d_ws;
#if MK_N_LAUNCHES == 1
    a.ph_lo = 0; a.ph_hi = NPHASE; a.use_bar = 1;
    hipLaunchKernelGGL(fwd_kernel, dim3(grid), dim3(NTHR), LDS_BYTES, stream, a);
#else
    for (int p = 0; p < NPHASE; ++p) { a.ph_lo = p; a.ph_hi = p + 1; a.use_bar = 0; hipLaunchKernelGGL(fwd_kernel, dim3(grid), dim3(NTHR), LDS_BYTES, stream, a); }
#endif
}
```

```cpp
#include <hip/hip_runtime.h>
#include <cstdio>
#include <cstdint>

#ifndef MK_N_LAUNCHES
#define MK_N_LAUNCHES 1
#endif

constexpr int NB = 8, SEQ = 2048, DM = 1024, T = NB * SEQ, DEPTH = 2;
constexpr int DIN = 3332, DING = 3328;
constexpr int NE = 32, TOPK = 4, DFF = 1024;
constexpr int NASG = T * TOPK;
constexpr int MAXSLOT = NASG + NE * 256;
constexpr float EPS = 1e-6f;
constexpr int C_SBQ = 0, C_SBK = 256, C_SBV = 512, C_RGX = 768, C_RGG = 1024, C_HGQ = 1280, C_HGF = 1536, C_HGI = 1792, C_HGG = 2048,
              C_M2Z = 2304, C_M2X = 2560, C_DT = 3328;
constexpr int NWAVES = 8, NTHR = 512;

constexpr size_t MiB = 1u << 20;
constexpr size_t WS_CTL = 0, CTL_ZERO_BYTES = 1 * MiB;
constexpr size_t WS_WIN = 2 * MiB;
constexpr size_t WS_WOUT = 16 * MiB;
constexpr size_t WS_WGU = 32 * MiB;
constexpr size_t WS_WDN = 288 * MiB;
constexpr size_t WS_XN = 416 * MiB;
constexpr size_t WS_PROJ = 448 * MiB;
constexpr size_t WS_ORAW = 552 * MiB;
constexpr size_t WS_MIX = 616 * MiB;
constexpr size_t WS_H1 = 648 * MiB;
constexpr size_t WS_HB = 712 * MiB;
constexpr size_t WS_XS = 776 * MiB;
constexpr size_t WS_ACT = 920 * MiB;
constexpr size_t WS_Y = 1064 * MiB;
constexpr size_t WS_DT = 1208 * MiB;
constexpr size_t WS_ASGE = 1209 * MiB;
constexpr size_t WS_ASGP = 1210 * MiB;
constexpr size_t WS_GATE = 1211 * MiB;
constexpr size_t WS_SLOT = 1212 * MiB;
constexpr size_t WS_SLOC = 1216 * MiB;
constexpr size_t WS_DEC = 1248 * MiB;
constexpr size_t WS_SLT = 1250 * MiB;
constexpr size_t WS_DECC = 1266 * MiB;
constexpr size_t WS_HLOC = 1268 * MiB;
constexpr size_t WS_PCUM = 1284 * MiB;
constexpr size_t WS_RGS = 1300 * MiB;
constexpr size_t WS_CARRY = 1301 * MiB;
constexpr size_t WS_WAT = 1302 * MiB;
constexpr size_t WS_HIST = 1303 * MiB;
constexpr size_t WS_TOT = WS_HIST + 512 * 1024;
constexpr size_t WS_LB1 = WS_HIST + 768 * 1024;
constexpr size_t WS_PREVB = 1304 * MiB;
constexpr size_t WS_STB = 1320 * MiB;
constexpr size_t WS_RWB = 1328 * MiB;
constexpr size_t WS_END = 1329 * MiB;
constexpr int CW_TMO = 0, CW_CODE = 1;
constexpr int CW_CNT = 256;
constexpr int CW_BAR = 4096;
constexpr size_t CTL_TOKS = 256 * 1024;

constexpr int LDS_BYTES = 147456;
constexpr int LDSCTL_OFF = LDS_BYTES - 1024;
constexpr int MISC_OFF = LDSCTL_OFF;
constexpr int TB_OFF = LDSCTL_OFF + 256;

namespace pg8 {
#define PG8_LAS __attribute__((address_space(3)))
typedef unsigned short bf16_t;
typedef short bf16x8 __attribute__((ext_vector_type(8)));
typedef float f32x4 __attribute__((ext_vector_type(4)));
typedef unsigned u32x4 __attribute__((ext_vector_type(4)));
constexpr int BM = 256, BK = 64, HALF = 128, HTB = HALF * BK * 2  , STAGE_BYTES = 8 * HTB, NXCD = 8, WGM = 8;

__host__ __device__ __forceinline__ int lds_byte(int r, int c) { const int st = (r >> 4) * 2 + (c >> 5), rr = r & 15, cc = c & 31, ob = rr * 64 + cc * 2; return st * 1024 + (ob ^ (((ob >> 9) & 1) << 5)); }
__host__ __device__ __forceinline__ void stage_rc(int b, int& R, int& C) { const int st = b / 1024, sb = b % 1024, swz = sb ^ (((sb >> 9) & 1) << 5); R = (st >> 1) * 16 + swz / 64; C = (st & 1) * 32 + (swz % 64) / 2; }
__host__ __device__ __forceinline__ int perm32(int rho) { const int n = rho >> 4, i = rho & 15; return 8 * (i >> 2) + 4 * n + (i & 3); }

struct Unit { int pm, pn, pb, e, ui; };
struct Gemm { const bf16_t* A; const bf16_t* Bt; int M, N, K; };

__host__ __device__ __forceinline__ int xcd_remap(int wgid, int nwg) { const int q = nwg / NXCD, r = nwg % NXCD, xcd = wgid % NXCD, off = wgid / NXCD; return (xcd < r ? xcd * (q + 1) : r * (q + 1) + (xcd - r) * q) + off; }

struct StaticOrder {
    int nM, nN, nwg, G, c;
    __host__ __device__ void init(int M, int N, int G_, int c_) { nM = M / BM; nN = N / BM; nwg = nM * nN; G = G_; c = c_; }
    __host__ __device__ bool next(int i, Unit& u) const {
        const long L = (long)i * G + c; if (L >= nwg) return false;
        const int wgid = xcd_remap((int)L, nwg);
        const int nig = WGM * nN, gid = wgid / nig, fm = gid * WGM, gsz = (nM - fm) < WGM ? (nM - fm) : WGM;
        u.pm = fm + ((wgid % nig) % gsz); u.pn = (wgid % nig) / gsz; u.pb = u.pn; u.e = 0; u.ui = i; return true;
    }
    __device__ __forceinline__ void a_ready(const Unit&) const {}
    __device__ __forceinline__ void done(const Unit&) const {}
    __device__ __forceinline__ size_t a_base(const Unit& u, size_t tstep) const { return (size_t)u.pm * tstep; }
    __device__ __forceinline__ unsigned a_off(const Unit&, int r, int K) const { return (unsigned)(r * K) * 2u; }
};
struct MoeOrder {
    const PG8_LAS int* tb; int NP, G, c; const PG8_LAS int* tokl;
    __device__ __forceinline__ bool next(int i, Unit& u) const {
        const int ntot = tb[32], nunits = ntot * NP;
        const long L = (long)i * G + c; if (L >= nunits) return false;
        const int id = xcd_remap((int)L, nunits);
        int e = 0;
        for (int j = 1; j < 32; ++j) if (id >= tb[j] * NP) e = j;
        e = __builtin_amdgcn_readfirstlane(e);
        const int t0 = tb[e], nt = tb[e + 1] - t0, rem = id - t0 * NP;
        u.pm = __builtin_amdgcn_readfirstlane(t0 + rem % nt); u.pn = __builtin_amdgcn_readfirstlane(rem / nt); u.pb = e * NP + u.pn; u.e = e; u.ui = i; return true;
    }
    __device__ __forceinline__ void a_ready(const Unit&) const {}
    __device__ __forceinline__ void done(const Unit&) const {}
    __device__ __forceinline__ size_t a_base(const Unit& u, size_t tstep) const { return tokl ? (size_t)0 : (size_t)u.pm * tstep; }
    __device__ __forceinline__ unsigned a_off(const Unit& u, int r, int K) const { return tokl ? (unsigned)(tokl[u.ui * 256 + r] * K) * 2u : (unsigned)(r * K) * 2u; }
};

__device__ __forceinline__ unsigned cvt_pk_bf16(float lo, float hi) { unsigned r; asm volatile("v_cvt_pk_bf16_f32 %0, %1, %2" : "=v"(r) : "v"(lo), "v"(hi)); return r; }

struct EpiBf16 {
    static constexpr bool PERM = true, AFTER_DRAIN = false;
    bf16_t* O; int ldc; const float* bias; int bias_estride;
    __device__ __forceinline__ void operator()(const f32x4 (&acc)[2][2][4][2], const Unit& u, int wr, int wc, int fr, int fq) const {
        const int row0 = u.pm * BM + wr * 64 + fr; const int col0 = u.pn * BM + wc * 32 + 8 * fq;
        f32x4 bv[2][2];
#pragma unroll
        for (int bj = 0; bj < 2; ++bj)
#pragma unroll
            for (int n = 0; n < 2; ++n) bv[bj][n] = bias ? *(const f32x4*)(bias + (size_t)u.e * bias_estride + col0 + bj * HALF + 4 * n) : (f32x4){0.f, 0.f, 0.f, 0.f};
#pragma unroll
        for (int ai = 0; ai < 2; ++ai)
#pragma unroll
            for (int m = 0; m < 4; ++m) { bf16_t* rowp = O + (size_t)(row0 + ai * HALF + m * 16) * ldc + col0;
#pragma unroll
                for (int bj = 0; bj < 2; ++bj) { const f32x4 v0 = acc[ai][bj][m][0] + bv[bj][0], v1 = acc[ai][bj][m][1] + bv[bj][1];
                    u32x4 w; w.x = cvt_pk_bf16(v0[0], v0[1]); w.y = cvt_pk_bf16(v0[2], v0[3]); w.z = cvt_pk_bf16(v1[0], v1[1]); w.w = cvt_pk_bf16(v1[2], v1[3]);
                    *(u32x4*)(rowp + bj * HALF) = w; } }
    }
};
template <bool BASE_F32> struct EpiResBf16 {
    static constexpr bool PERM = true, AFTER_DRAIN = false;
    const void* base; bf16_t* out; int ldc;
    __device__ __forceinline__ void operator()(const f32x4 (&acc)[2][2][4][2], const Unit& u, int wr, int wc, int fr, int fq) const {
        const int row0 = u.pm * BM + wr * 64 + fr, col0 = u.pn * BM + wc * 32 + 8 * fq;
#pragma unroll
        for (int ai = 0; ai < 2; ++ai)
#pragma unroll
            for (int m = 0; m < 4; ++m) { const size_t off = (size_t)(row0 + ai * HALF + m * 16) * ldc + col0;
#pragma unroll
                for (int bj = 0; bj < 2; ++bj) { f32x4 b0, b1;
                    if (BASE_F32) { const float* bp = (const float*)base + off + bj * HALF; b0 = *(const f32x4*)bp; b1 = *(const f32x4*)(bp + 4); }
                    else { const u32x4 w = *(const u32x4*)((const bf16_t*)base + off + bj * HALF);
                        b0 = (f32x4){__uint_as_float(w.x << 16), __uint_as_float(w.x & 0xffff0000u), __uint_as_float(w.y << 16), __uint_as_float(w.y & 0xffff0000u)};
                        b1 = (f32x4){__uint_as_float(w.z << 16), __uint_as_float(w.z & 0xffff0000u), __uint_as_float(w.w << 16), __uint_as_float(w.w & 0xffff0000u)}; }
                    const f32x4 v0 = b0 + acc[ai][bj][m][0], v1 = b1 + acc[ai][bj][m][1];
                    u32x4 o; o.x = cvt_pk_bf16(v0[0], v0[1]); o.y = cvt_pk_bf16(v0[2], v0[3]); o.z = cvt_pk_bf16(v1[0], v1[1]); o.w = cvt_pk_bf16(v1[2], v1[3]);
                    *(u32x4*)(out + off + bj * HALF) = o; } }
    }
};
struct EpiSwiglu {
    static constexpr bool PERM = true, AFTER_DRAIN = false;
    bf16_t* O; const float* bias;
    __device__ __forceinline__ void operator()(const f32x4 (&acc)[2][2][4][2], const Unit& u, int wr, int wc, int fr, int fq) const {
        const int row0 = u.pm * BM + wr * 64 + fr; const int a0 = u.pn * HALF + wc * 32 + 8 * fq;
        const float* bp = bias + (size_t)u.e * 2048 + 2 * a0;
        f32x4 b4[4];
#pragma unroll
        for (int j = 0; j < 4; ++j) b4[j] = *(const f32x4*)(bp + 4 * j);
#pragma unroll
        for (int ai = 0; ai < 2; ++ai)
#pragma unroll
            for (int m = 0; m < 4; ++m) { bf16_t* rowp = O + (size_t)(row0 + ai * HALF + m * 16) * 1024 + a0;
                float a[8];
#pragma unroll
                for (int n = 0; n < 2; ++n)
#pragma unroll
                    for (int i = 0; i < 4; ++i) { const int k = 4 * n + i;
                        float g = acc[ai][0][m][n][i] + b4[k >> 1][2 * (k & 1)], l = acc[ai][1][m][n][i] + b4[k >> 1][2 * (k & 1) + 1];
                        g = fminf(g, 7.0f); l = fminf(fmaxf(l, -7.0f), 7.0f);
                        const float sg = __builtin_amdgcn_rcpf(1.0f + __builtin_amdgcn_exp2f(-1.702f * 1.4426950408889634f * g));
                        a[k] = g * sg * (l + 1.0f); }
                u32x4 w; w.x = cvt_pk_bf16(a[0], a[1]); w.y = cvt_pk_bf16(a[2], a[3]); w.z = cvt_pk_bf16(a[4], a[5]); w.w = cvt_pk_bf16(a[6], a[7]);
                *(u32x4*)rowp = w; }
    }
};

template <class Epi, class Sched, bool ALIGN_EPI = false, bool SP2 = false>
__device__ __forceinline__ void gemm_phase(PG8_LAS unsigned char* lds, const Gemm g, const Sched& S, const Epi& E) {
    int tid = threadIdx.x; asm volatile("" : "+v"(tid));
    const int wid = __builtin_amdgcn_readfirstlane(tid >> 6), lane = tid & 63, wr = wid >> 2, wc = wid & 3, fr = lane & 15, fq = lane >> 4;
    const int K = g.K, nt = K / BK;
    unsigned vAc[2][2], vAn[2][2], voffB[2];
    int sR[2], sC[2];
#pragma unroll
    for (int i = 0; i < 2; ++i) { int R, C; stage_rc(tid * 16 + i * 8192, R, C); const int Rb = Epi::PERM ? ((R & ~31) + perm32(R & 31)) : R;
        sR[i] = R; sC[i] = C; voffB[i] = (unsigned)(Rb * K + C) * 2u; }
    const size_t kstep = (size_t)(BK * 2);
    const size_t hstep = (size_t)HALF * K * 2;
    const size_t tstep = 2 * hstep;
    const unsigned ldsw = (unsigned)wid * 1024u;
    const int aoff = lds_byte(wr * 64 + fr, fq * 8), boff = lds_byte(wc * 32 + fr, fq * 8);
#define PG8_SA(b, h) (((b) * 2 + (h)) * HTB)
#define PG8_SB(b, h) ((4 + (b) * 2 + (h)) * HTB)
#define PG8_STAGE(bufoff, gbase, voff) do { _Pragma("unroll") for (int _i = 0; _i < 2; ++_i) \
        __builtin_amdgcn_global_load_lds((const unsigned*)((const char*)(gbase) + (voff)[_i]), (PG8_LAS unsigned*)(lds + (bufoff) + ldsw + _i * 8192), 16, 0, 0); } while (0)
#define PG8_LDA(dst, b, h) do { _Pragma("unroll") for (int m = 0; m < 4; ++m) _Pragma("unroll") for (int k = 0; k < 2; ++k) dst[m][k] = *(const PG8_LAS bf16x8*)(lds + PG8_SA(b, h) + aoff + m * 2048 + k * 1024); } while (0)
#define PG8_LDB(dst, b, h) do { _Pragma("unroll") for (int n = 0; n < 2; ++n) _Pragma("unroll") for (int k = 0; k < 2; ++k) dst[n][k] = *(const PG8_LAS bf16x8*)(lds + PG8_SB(b, h) + boff + n * 2048 + k * 1024); } while (0)
#define PG8_MMA(ai, bj, At, Bt) do { __builtin_amdgcn_s_setprio(1); _Pragma("unroll") for (int m = 0; m < 4; ++m) _Pragma("unroll") for (int n = 0; n < 2; ++n) _Pragma("unroll") for (int k = 0; k < 2; ++k) \
        acc[ai][bj][m][n] = __builtin_amdgcn_mfma_f32_16x16x32_bf16(Bt[n][k], At[m][k], acc[ai][bj][m][n], 0, 0, 0); __builtin_amdgcn_s_setprio(0); } while (0)
#define PG8_WAIT_V(n) asm volatile("s_waitcnt vmcnt(" #n ")" ::: "memory")
#define PG8_WAIT_L(n) asm volatile("s_waitcnt lgkmcnt(" #n ")" ::: "memory")
#define PG8_BAR __builtin_amdgcn_s_barrier()
#define PG8_SCHED __builtin_amdgcn_sched_barrier(0)
    Unit cur, nxt; int ui = 0;
    if (!S.next(0, cur)) return;
    f32x4 acc[2][2][4][2];
#pragma unroll
    for (int a = 0; a < 2; ++a)
#pragma unroll
        for (int b = 0; b < 2; ++b)
#pragma unroll
            for (int m = 0; m < 4; ++m)
#pragma unroll
                for (int n = 0; n < 2; ++n) acc[a][b][m][n] = (f32x4){0.f, 0.f, 0.f, 0.f};
    bf16x8 At[4][2], B0[2][2], B1[2][2];
    const char* cA = (const char*)g.A + S.a_base(cur, tstep); const char* cB = (const char*)g.Bt + (size_t)cur.pb * tstep;
#pragma unroll
    for (int h = 0; h < 2; ++h)
#pragma unroll
        for (int i = 0; i < 2; ++i) { vAc[h][i] = S.a_off(cur, h * HALF + sR[i], K) + (unsigned)sC[i] * 2u; vAn[h][i] = vAc[h][i]; }
    S.a_ready(cur);
    if constexpr (SP2) {
        PG8_STAGE(PG8_SB(0, 0), cB, voffB); PG8_STAGE(PG8_SB(0, 1), cB + hstep, voffB); PG8_STAGE(PG8_SA(0, 0), cA, vAc[0]); PG8_STAGE(PG8_SA(0, 1), cA, vAc[1]);
        if (wr == 1) PG8_BAR;
        PG8_WAIT_V(2); PG8_BAR;
        PG8_STAGE(PG8_SB(1, 0), cB + kstep, voffB); PG8_STAGE(PG8_SA(1, 0), cA + kstep, vAc[0]); PG8_STAGE(PG8_SB(1, 1), cB + hstep + kstep, voffB);
        PG8_WAIT_V(6); PG8_BAR;
    } else {
        PG8_STAGE(PG8_SB(0, 0), cB, voffB); PG8_STAGE(PG8_SA(0, 0), cA, vAc[0]); PG8_STAGE(PG8_SB(0, 1), cB + hstep, voffB); PG8_STAGE(PG8_SA(0, 1), cA, vAc[1]);
        if (wr == 1) PG8_BAR;
        PG8_WAIT_V(4); PG8_BAR;
        PG8_STAGE(PG8_SB(1, 0), cB + kstep, voffB); PG8_STAGE(PG8_SA(1, 0), cA + kstep, vAc[0]); PG8_STAGE(PG8_SB(1, 1), cB + hstep + kstep, voffB);
        PG8_WAIT_V(6); PG8_BAR;
    }
    for (;;) {
        const bool has_next = S.next(ui + 1, nxt);
        const char* nA = has_next ? (const char*)g.A + S.a_base(nxt, tstep) : cA;
        if (has_next) {
#pragma unroll
            for (int h = 0; h < 2; ++h)
#pragma unroll
                for (int i = 0; i < 2; ++i) vAn[h][i] = S.a_off(nxt, h * HALF + sR[i], K) + (unsigned)sC[i] * 2u; } const char* nB = has_next ? (const char*)g.Bt + (size_t)nxt.pb * tstep : cB;
        for (int t = 0; t < nt; t += 2) {
            const bool last = (t == nt - 2);
            const char* a1 = cA + (size_t)(t + 1) * kstep;
            const char* a2 = last ? nA : cA + (size_t)(t + 2) * kstep; const char* b2 = last ? nB : cB + (size_t)(t + 2) * kstep;
            const char* a3 = a2 + kstep; const char* b3 = b2 + kstep;
            unsigned v2[2][2];
#pragma unroll
            for (int h = 0; h < 2; ++h)
#pragma unroll
                for (int i = 0; i < 2; ++i) v2[h][i] = last ? vAn[h][i] : vAc[h][i];
            if (last && has_next) S.a_ready(nxt);
            if constexpr (SP2) {
            PG8_LDB(B0, 0, 0); PG8_LDB(B1, 0, 1); PG8_SCHED; PG8_LDA(At, 0, 0); PG8_STAGE(PG8_SA(1, 1), a1, vAc[1]);
            PG8_WAIT_V(8); PG8_WAIT_L(0); PG8_BAR; PG8_MMA(0, 0, At, B0); PG8_MMA(0, 1, At, B1); PG8_BAR; PG8_SCHED;
            PG8_LDA(At, 0, 1); PG8_STAGE(PG8_SB(0, 0), b2, voffB); PG8_STAGE(PG8_SB(0, 1), b2 + hstep, voffB); PG8_STAGE(PG8_SA(0, 0), a2, v2[0]);
            PG8_WAIT_V(8); PG8_WAIT_L(0); PG8_BAR; PG8_MMA(1, 0, At, B0); PG8_MMA(1, 1, At, B1); PG8_BAR; PG8_SCHED;
            PG8_LDB(B0, 1, 0); PG8_LDB(B1, 1, 1); PG8_SCHED; PG8_LDA(At, 1, 0); PG8_STAGE(PG8_SA(0, 1), a2, v2[1]);
            PG8_WAIT_V(8); PG8_WAIT_L(0); PG8_BAR; PG8_MMA(0, 0, At, B0); PG8_MMA(0, 1, At, B1); PG8_BAR; PG8_SCHED;
            PG8_LDA(At, 1, 1); PG8_STAGE(PG8_SB(1, 0), b3, voffB); PG8_STAGE(PG8_SB(1, 1), b3 + hstep, voffB); PG8_STAGE(PG8_SA(1, 0), a3, v2[0]);
            PG8_WAIT_V(8); PG8_WAIT_L(0); PG8_BAR; PG8_MMA(1, 0, At, B0); PG8_MMA(1, 1, At, B1); PG8_BAR; PG8_SCHED;
            } else {
            PG8_LDB(B0, 0, 0); PG8_SCHED; PG8_LDA(At, 0, 0); PG8_STAGE(PG8_SA(1, 1), a1, vAc[1]);
            PG8_WAIT_L(8); PG8_BAR; PG8_WAIT_L(0); PG8_MMA(0, 0, At, B0); PG8_BAR; PG8_SCHED;
            PG8_LDB(B1, 0, 1); PG8_STAGE(PG8_SB(0, 0), b2, voffB);
            PG8_BAR; PG8_WAIT_L(0); PG8_MMA(0, 1, At, B1); PG8_BAR;
            PG8_LDA(At, 0, 1); PG8_STAGE(PG8_SA(0, 0), a2, v2[0]);
            PG8_BAR; PG8_WAIT_L(0); PG8_MMA(1, 0, At, B0); PG8_BAR; PG8_SCHED;
            PG8_STAGE(PG8_SB(0, 1), b2 + hstep, voffB);
            PG8_WAIT_V(6); PG8_BAR; PG8_MMA(1, 1, At, B1); PG8_BAR;
            PG8_LDB(B0, 1, 0); PG8_SCHED; PG8_LDA(At, 1, 0); PG8_STAGE(PG8_SA(0, 1), a2, v2[1]);
            PG8_WAIT_L(8); PG8_BAR; PG8_WAIT_L(0); PG8_MMA(0, 0, At, B0); PG8_BAR; PG8_SCHED;
            PG8_LDB(B1, 1, 1); PG8_STAGE(PG8_SB(1, 0), b3, voffB);
            PG8_BAR; PG8_WAIT_L(0); PG8_MMA(0, 1, At, B1); PG8_BAR;
            PG8_LDA(At, 1, 1); PG8_STAGE(PG8_SA(1, 0), a3, v2[0]);
            PG8_BAR; PG8_WAIT_L(0); PG8_MMA(1, 0, At, B0); PG8_BAR; PG8_SCHED;
            PG8_STAGE(PG8_SB(1, 1), b3 + hstep, voffB);
            PG8_WAIT_V(6); PG8_BAR; PG8_MMA(1, 1, At, B1); PG8_BAR;
            }
        }
        if constexpr (ALIGN_EPI) { if (wr == 0) PG8_BAR; }
        if constexpr (!Epi::AFTER_DRAIN) { E(acc, cur, wr, wc, fr, fq); S.done(cur); }
        if (!has_next) break;
#pragma unroll
        for (int a = 0; a < 2; ++a)
#pragma unroll
            for (int b = 0; b < 2; ++b)
#pragma unroll
                for (int m = 0; m < 4; ++m)
#pragma unroll
                    for (int n = 0; n < 2; ++n) acc[a][b][m][n] = (f32x4){0.f, 0.f, 0.f, 0.f};
        cur = nxt; cA = nA; cB = nB; ++ui;
#pragma unroll
        for (int h = 0; h < 2; ++h)
#pragma unroll
            for (int i = 0; i < 2; ++i) vAc[h][i] = vAn[h][i];
        if constexpr (ALIGN_EPI) { if (wr == 1) PG8_BAR; }
    }
    PG8_WAIT_V(0);
    if constexpr (!ALIGN_EPI) { if (wr == 0) PG8_BAR; }
    PG8_BAR;
    if constexpr (Epi::AFTER_DRAIN) { E.fused(acc, cur, wr, wc, fr, fq, lds, wid, lane); S.done(cur); }
#undef PG8_SA
#undef PG8_SB
#undef PG8_STAGE
#undef PG8_LDA
#undef PG8_LDB
#undef PG8_MMA
#undef PG8_WAIT_V
#undef PG8_WAIT_L
#undef PG8_BAR
#undef PG8_SCHED
}
}
#define GAS __attribute__((address_space(1)))
#define LAS __attribute__((address_space(3)))
typedef unsigned short bf16;
typedef unsigned v4u __attribute__((ext_vector_type(4)));
typedef float f32x4 __attribute__((ext_vector_type(4)));
typedef short bf16x8 __attribute__((ext_vector_type(8)));
typedef GAS unsigned gu32;
typedef GAS unsigned long long gu64;
#define RLX_AGENT __ATOMIC_RELAXED, __HIP_MEMORY_SCOPE_AGENT
#define LDS_WAIT() asm volatile("s_waitcnt lgkmcnt(0)" ::: "memory")
#define VM_WAIT() asm volatile("s_waitcnt vmcnt(0)" ::: "memory")
__device__ __forceinline__ unsigned long long rt() { return __builtin_amdgcn_s_memrealtime(); }
__device__ __forceinline__ unsigned f2bf(float f) { unsigned u = __builtin_bit_cast(unsigned, f); return (u + 0x7fffu + ((u >> 16) & 1u)) >> 16; }
__device__ __forceinline__ unsigned pk2(float lo, float hi) { return f2bf(lo) | (f2bf(hi) << 16); }

#define XB_TMO      128
#define XB_XCNT(j)  (256  + 64 * (j))
#define XB_XSUB(j)  (1280 + 64 * (j))
#define XB_XGEN(j)  (2304 + 64 * (j))
#define XB_TOP      3328
#define XB_TOPGEN   3392
#define XCD_BAR_WORDS 3456
#define XB_SPIN_CAP (1u << 18)

__device__ __forceinline__ unsigned xb_ld(unsigned* p)              { return __hip_atomic_load(p, __ATOMIC_RELAXED, __HIP_MEMORY_SCOPE_AGENT); }
__device__ __forceinline__ unsigned xb_add(unsigned* p, unsigned v) { return __hip_atomic_fetch_add(p, v, __ATOMIC_RELAXED, __HIP_MEMORY_SCOPE_AGENT); }
__device__ __forceinline__ unsigned xb_xcc_id() { return (unsigned)__builtin_amdgcn_s_getreg((3 << 11) | 20) & 0xFu; }
#define XB_SPIN(cond, bar) do { unsigned _sp = 0; while (cond) { __builtin_amdgcn_s_sleep(1); \
    if ((++_sp & 255u) == 0u) { if (xb_ld(&(bar)[XB_TMO])) break; if (_sp > XB_SPIN_CAP) { atomicAdd(&(bar)[XB_TMO], 1u); break; } } } } while (0)

struct XcdBarrier {
    unsigned* bar; unsigned x;
    volatile LAS unsigned* st;
};

__device__ __forceinline__ XcdBarrier xcd_barrier_post(unsigned* bar, volatile LAS unsigned* st) {
    XcdBarrier b; b.bar = bar; b.x = xb_xcc_id(); b.st = st;
    if (threadIdx.x == 0) (void)xb_add(&bar[XB_XCNT(b.x)], 1u);
    return b;
}
__device__ __forceinline__ void xcd_barrier_complete(unsigned* bar, unsigned x, unsigned& nloc, unsigned& nx) {
    const unsigned G = gridDim.x * gridDim.y * gridDim.z;
    unsigned sum, cnt, mine, sp = 0u;
    for (;;) {
        sum = 0u; cnt = 0u; mine = 0u;
#pragma unroll
        for (unsigned j = 0; j < 16; ++j) { const unsigned c = xb_ld(&bar[XB_XCNT(j)]); sum += c; cnt += (c > 0u) ? 1u : 0u; mine = (j == x) ? c : mine; }
        if (sum == G) break;
        __builtin_amdgcn_s_sleep(1);
        if ((++sp & 255u) == 0u) { if (xb_ld(&bar[XB_TMO])) break; if (sp > XB_SPIN_CAP) { atomicAdd(&bar[XB_TMO], 1u); break; } }
    }
    nloc = mine > 0u ? mine : 1u; nx = cnt > 0u ? cnt : 1u;
}

__device__ __forceinline__ void xcd_barrier(const XcdBarrier& b) {
    asm volatile("s_waitcnt vmcnt(0)" ::: "memory");
    __syncthreads();
    if (threadIdx.x == 0) {
        unsigned* bar = b.bar;
        __builtin_amdgcn_s_waitcnt(0);
        unsigned nloc = b.st[0], nx = b.st[1];
        if (nloc == 0u) { xcd_barrier_complete(bar, b.x, nloc, nx); b.st[0] = nloc; b.st[1] = nx; }
        const unsigned old = xb_add(&bar[XB_XSUB(b.x)], 1u);
        const unsigned gen = old / nloc;
        if (old + 1u == (gen + 1u) * nloc) {
            __builtin_amdgcn_fence(__ATOMIC_RELEASE, "agent");
            asm volatile("s_waitcnt vmcnt(0)" ::: "memory");
            const unsigned og = xb_add(&bar[XB_TOP], 1u);
            const unsigned tg = og / nx;
            if (og + 1u == (tg + 1u) * nx) xb_add(&bar[XB_TOPGEN], 1u);
            else XB_SPIN(xb_ld(&bar[XB_TOPGEN]) == tg, bar);
            __builtin_amdgcn_fence(__ATOMIC_ACQUIRE, "agent");
            xb_add(&bar[XB_XGEN(b.x)], 1u);
            asm volatile("s_waitcnt vmcnt(0)" ::: "memory");
        } else {
            XB_SPIN(xb_ld(&bar[XB_XGEN(b.x)]) == gen, bar);
            __builtin_amdgcn_fence(__ATOMIC_ACQUIRE, "agent");
            asm volatile("s_waitcnt vmcnt(0)" ::: "memory");
        }
    }
    __syncthreads();
}

using pg8::bf16_t;
typedef unsigned u32x2 __attribute__((ext_vector_type(2)));
__device__ __forceinline__ float bf2f(unsigned v) { return __uint_as_float(v << 16); }
__device__ __forceinline__ float bflo(unsigned w) { return __uint_as_float(w << 16); }
__device__ __forceinline__ float bfhi(unsigned w) { return __uint_as_float(w & 0xffff0000u); }
__device__ __forceinline__ float wave_sum(float v) {
#pragma unroll
    for (int o = 1; o < 64; o <<= 1) v += __shfl_xor(v, o);
    return v;
}
__device__ __forceinline__ float sigm(float x) { return 1.0f / (1.0f + expf(-x)); }
__device__ __forceinline__ float softplusf_(float x) { return fmaxf(x, 0.f) + log1pf(expf(-fabsf(x))); }
__device__ __forceinline__ float gelu_tanh(float x) { return 0.5f * x * (1.0f + tanhf(0.7978845608028654f * (x + 0.044715f * x * x * x))); }

__device__ __forceinline__ int gu_rowmap(int n) { const int a = n >> 1; return ((a >> 7) << 8) + (a & 127) + ((n & 1) << 7); }
struct TDesc { const float* W; bf16* WT; int ldw, K, k0, n0, gu; };
__device__ __forceinline__ void tload(const TDesc& d, f32x4 (&v)[16], int lane) {
#pragma unroll
    for (int i = 0; i < 16; ++i) v[i] = __builtin_nontemporal_load((const f32x4*)(d.W + (size_t)(d.k0 + 4 * i + (lane >> 4)) * d.ldw + d.n0 + 4 * (lane & 15)));
}
__device__ __forceinline__ void tstore(const TDesc& d, const f32x4 (&v)[16], LAS float* scr, int lane) {
#pragma unroll
    for (int i = 0; i < 16; ++i) { LAS float* p = scr + (4 * i + (lane >> 4)) * 65 + 4 * (lane & 15); p[0] = v[i][0]; p[1] = v[i][1]; p[2] = v[i][2]; p[3] = v[i][3]; }
    LDS_WAIT(); asm volatile("" ::: "memory");
    const int c = lane & 7;
#pragma unroll
    for (int j = 0; j < 8; ++j) { const int n = 8 * j + (lane >> 3); const LAS float* s = scr + (8 * c) * 65 + n;
        v4u o; o.x = pg8::cvt_pk_bf16(s[0], s[65]); o.y = pg8::cvt_pk_bf16(s[130], s[195]); o.z = pg8::cvt_pk_bf16(s[260], s[325]); o.w = pg8::cvt_pk_bf16(s[390], s[455]);
        const int nr = d.gu ? gu_rowmap(d.n0 + n) : (d.n0 + n);
        *(v4u*)(d.WT + (size_t)nr * d.K + d.k0 + 8 * c) = o; }
    LDS_WAIT(); asm volatile("" ::: "memory");
}
constexpr int IT_WIN = 16 * 52, IT_WOUT = 256, IT_GU = 512, IT_DN = 256;
constexpr int NIT_WIN = DEPTH * IT_WIN, NIT_WOUT = DEPTH * IT_WOUT, NIT_GU = DEPTH * NE * IT_GU, NIT_DN = DEPTH * NE * IT_DN, NITEMS = NIT_WIN + NIT_WOUT + NIT_GU + NIT_DN;

__device__ __forceinline__ void emit_xn_dt(const f32x4 (&v)[4], const float* g, const float* win_l, bf16* xn_row, float* dt_row, int lane) {
    float ss = 0.f;
#pragma unroll
    for (int j = 0; j < 4; ++j) ss += (v[j][0] * v[j][0] + v[j][1] * v[j][1]) + (v[j][2] * v[j][2] + v[j][3] * v[j][3]);
    ss = wave_sum(ss);
    const float rstd = 1.0f / sqrtf(ss * (1.0f / DM) + EPS);
    float d0 = 0.f, d1 = 0.f, d2 = 0.f, d3 = 0.f;
#pragma unroll
    for (int j = 0; j < 4; ++j) { const int col = 256 * j + 4 * lane; const f32x4 gg = *(const f32x4*)(g + col); const f32x4 u = v[j] * rstd * gg;
        u32x2 w; w.x = pk2(u[0], u[1]); w.y = pk2(u[2], u[3]); *(u32x2*)(xn_row + col) = w;
#pragma unroll
        for (int i = 0; i < 4; ++i) { const f32x4 ww = *(const f32x4*)(win_l + (size_t)(col + i) * DIN + C_DT); d0 += u[i] * ww[0]; d1 += u[i] * ww[1]; d2 += u[i] * ww[2]; d3 += u[i] * ww[3]; } }
    d0 = wave_sum(d0); d1 = wave_sum(d1); d2 = wave_sum(d2); d3 = wave_sum(d3);
    if (lane == 0) *(f32x4*)dt_row = (f32x4){d0, d1, d2, d3};
}

__device__ __forceinline__ void attn_naive(const bf16* proj, float* oraw, int b, int h, int qb, int lane) {
    const int t = qb * 64 + lane; const size_t row = (size_t)b * SEQ + t;
    int zero; asm volatile("v_mov_b32 %0, 0" : "=v"(zero));
    float q[64], acc[64];
    const bf16* qp = proj + row * DING + C_SBQ + h * 64;
#pragma unroll
    for (int c = 0; c < 8; ++c) { const v4u w = *(const v4u*)(qp + 8 * c);
#pragma unroll
        for (int i = 0; i < 4; ++i) { q[8 * c + 2 * i] = bflo(w[i]) * 0.125f; q[8 * c + 2 * i + 1] = bfhi(w[i]) * 0.125f; } }
#pragma unroll
    for (int d = 0; d < 64; ++d) acc[d] = 0.f;
    float R = 0.f;
    for (int s = qb * 64 + 62; s >= 0; --s) {
        const bf16* kp = proj + ((size_t)b * SEQ + s) * DING + C_SBK + h * 64 + zero;
        float z = 0.f;
#pragma unroll
        for (int c = 0; c < 8; ++c) { const v4u w = *(const v4u*)(kp + 8 * c);
#pragma unroll
            for (int i = 0; i < 4; ++i) { z += q[8 * c + 2 * i] * bflo(w[i]); z += q[8 * c + 2 * i + 1] * bfhi(w[i]); } }
        if (s < t) {
            const float sp = softplusf_(z);
            const float a = expf(z - sp + R);
            R -= sp;
            const bf16* vp = kp + 256;
#pragma unroll
            for (int c = 0; c < 8; ++c) { const v4u w = *(const v4u*)(vp + 8 * c);
#pragma unroll
                for (int i = 0; i < 4; ++i) { acc[8 * c + 2 * i] += a * bflo(w[i]); acc[8 * c + 2 * i + 1] += a * bfhi(w[i]); } }
        }
        if (__all(R < -88.0f)) break;
    }
    float* op = oraw + row * DM + h * 64;
#pragma unroll
    for (int c = 0; c < 16; ++c) *(f32x4*)(op + 4 * c) = (f32x4){acc[4 * c], acc[4 * c + 1], acc[4 * c + 2], acc[4 * c + 3]};
}

__device__ __forceinline__ void rg_chain(const bf16* proj, float* oraw, int b, int n, const float* conv_w, const float* conv_b, const float* wa, const float* ba,
                                         const float* wx, const float* bx, const float* lam, LAS float* L, int tid) {
    LAS float* wa_s = L; LAS float* wx_s = L + 4096; LAS float* xc_s = L + 8192; LAS float* a_s = L + 12288; LAS float* u_s = L + 16384;
    const int j = tid & 63, tr = tid >> 6, c = n * 64 + j;
    for (int idx = tid; idx < 4096; idx += NTHR) { wa_s[idx] = wa[n * 4096 + idx]; wx_s[idx] = wx[n * 4096 + idx]; }
    float cw[4];
#pragma unroll
    for (int k = 0; k < 4; ++k) cw[k] = conv_w[k * 256 + c];
    const float cb = conv_b[c], bav = ba[c], bxv = bx[c], spl = softplusf_(-lam[c]);
    float hstate = 0.f;
    __syncthreads();
    for (int ch = 0; ch < SEQ / 64; ++ch) {
        const int t0 = ch * 64;
#pragma unroll 1
        for (int i = 0; i < 8; ++i) { const int t = tr + 8 * i, tg = t0 + t; float a = cb;
#pragma unroll
            for (int k = 0; k < 4; ++k) { const int ts = tg - 3 + k; if (ts >= 0) a += cw[k] * bf2f(proj[((size_t)b * SEQ + ts) * DING + C_RGX + c]); }
            xc_s[t * 64 + j] = a; }
        __syncthreads();
#pragma unroll 1
        for (int i = 0; i < 8; ++i) { const int t = tr + 8 * i; float ra = bav, ga = bxv;
            _Pragma("unroll 4") for (int ii = 0; ii < 64; ++ii) { const float x = xc_s[t * 64 + ii]; ra += x * wa_s[ii * 64 + j]; ga += x * wx_s[ii * 64 + j]; }
            const float r = sigm(ra), ig = sigm(ga), log_a = -8.0f * r * spl;
            float mult = sqrtf(-expm1f(2.0f * log_a)); if (t0 + t == 0) mult = 1.0f;
            a_s[t * 64 + j] = expf(log_a); u_s[t * 64 + j] = mult * ig * xc_s[t * 64 + j]; }
        __syncthreads();
        if (tid < 64) {
            for (int t = 0; t < 64; ++t) { hstate = a_s[t * 64 + j] * hstate + u_s[t * 64 + j];
                const size_t row = (size_t)b * SEQ + t0 + t; const float gate = bf2f(proj[row * DING + C_RGG + c]);
                oraw[row * DM + 256 + c] = hstate * gelu_tanh(gate); }
        }
        __syncthreads();
    }
}

__device__ __forceinline__ void hg_chain(const bf16* proj, float* oraw, int b, int h, const float* lbp, int layer, LAS float* L, int tid) {
    constexpr int S = 65, A = 64 * S;
    LAS float* q_s = L; LAS float* k_s = L + A; LAS float* v_s = L + 2 * A; LAS float* bc_s = L + 3 * A; LAS float* sc_s = L + 4 * A; LAS float* st_s = L + 5 * A; LAS float* qe_s = L + 6 * A;
    const int j = tid & 63, tr = tid >> 6;
    float lb = 0.f;
    if (layer == 1) { const float x0 = lbp[h * 64 + j], x1 = lbp[256 + h * 64 + j], mx = fmaxf(x0, x1), e0 = expf(x0 - mx), e1 = expf(x1 - mx); lb = e1 / (e0 + e1); }
#pragma unroll
    for (int i = 0; i < 8; ++i) st_s[(tr + 8 * i) * S + j] = 0.f;
    __syncthreads();
    for (int ch = 0; ch < SEQ / 64; ++ch) {
        const int t0 = ch * 64;
#pragma unroll 1
        for (int i = 0; i < 8; ++i) { const int t = tr + 8 * i; const size_t row = (size_t)b * SEQ + t0 + t; const bf16* pp = proj + row * DING + h * 64 + j;
            const float qv = bf2f(pp[C_HGQ]), fv = bf2f(pp[C_HGF]), iv = bf2f(pp[C_HGI]);
            const float forget = lb + (1.0f - lb) * sigm(fv);
            q_s[t * S + j] = qv * sigm(qv); k_s[t * S + j] = 1.0f - forget; v_s[t * S + j] = iv; bc_s[t * S + j] = logf(forget); }
        __syncthreads();
        if (tid < 64) { float run = 0.f; for (int t = 0; t < 64; ++t) { run += bc_s[t * S + j]; bc_s[t * S + j] = run; } }
        __syncthreads();
#pragma unroll 1
        for (int i = 0; i < 8; ++i) { const int t = tr + 8 * i; qe_s[t * S + j] = q_s[t * S + j] * expf(bc_s[t * S + j]); }
#pragma unroll 1
        for (int i = 0; i < 8; ++i) { const int t = tr + 8 * i, s = j; float a = 0.f;
            if (s <= t) _Pragma("unroll 4") for (int c = 0; c < 64; ++c) a += q_s[t * S + c] * k_s[s * S + c] * expf(bc_s[t * S + c] - bc_s[s * S + c]);
            sc_s[t * S + s] = a; }
        __syncthreads();
#pragma unroll 1
        for (int i = 0; i < 8; ++i) { const int t = tr + 8 * i, v = j; float o = 0.f;
            _Pragma("unroll 4") for (int s = 0; s < 64; ++s) o += sc_s[t * S + s] * v_s[s * S + v];
            _Pragma("unroll 4") for (int c = 0; c < 64; ++c) o += qe_s[t * S + c] * st_s[c * S + v];
            oraw[((size_t)b * SEQ + t0 + t) * DM + 512 + h * 64 + v] = o; }
        __syncthreads();
#pragma unroll 1
        for (int i = 0; i < 8; ++i) { const int s = tr + 8 * i, c = j; sc_s[s * S + c] = k_s[s * S + c] * expf(bc_s[63 * S + c] - bc_s[s * S + c]); }
        __syncthreads();
#pragma unroll 1
        for (int i = 0; i < 8; ++i) { const int c = tr + 8 * i, v = j; float a = expf(bc_s[63 * S + c]) * st_s[c * S + v];
            _Pragma("unroll 4") for (int s = 0; s < 64; ++s) a += sc_s[s * S + c] * v_s[s * S + v];
            st_s[c * S + v] = a; }
        __syncthreads();
    }
}

__device__ __forceinline__ void m2_chain(const bf16* proj, const float* dtraw, float* oraw, int b, int h, const float* conv_w, const float* conv_b, const float* dt_bias,
                                         const float* a_log, const float* dskip, LAS float* L, int tid) {
    constexpr int SB = 129;
    LAS float* xs_s = L; LAS float* B_s = L + 4096; LAS float* C_s = B_s + 64 * SB; LAS float* W_s = C_s + 64 * SB; LAS float* st_s = W_s + 64 * 65;
    LAS float* dt_s = st_s + 64 * SB; LAS float* acs_s = dt_s + 64; LAS float* w_s = acs_s + 64;
    const int j = tid & 63, tr = tid >> 6, g = h >> 1;
    const float dtb = dt_bias[h], negA = -expf(a_log[h]), Dh = dskip[h];
    for (int idx = tid; idx < 64 * SB; idx += NTHR) st_s[idx] = 0.f;
    __syncthreads();
    for (int ch = 0; ch < SEQ / 64; ++ch) {
        const int t0 = ch * 64;
        for (int idx = tid; idx < 64 * 320; idx += NTHR) { const int cch = idx % 320, t = idx / 320;
            int col, cc; LAS float* dst;
            if (cch < 64) { cc = h * 64 + cch; dst = xs_s + t * 64 + cch; }
            else if (cch < 192) { cc = 256 + g * 128 + (cch - 64); dst = B_s + t * SB + (cch - 64); }
            else { cc = 512 + g * 128 + (cch - 192); dst = C_s + t * SB + (cch - 192); }
            col = C_M2X + cc;
            float a = conv_b[cc];
#pragma unroll
            for (int k = 0; k < 4; ++k) { const int ts = t0 + t - 3 + k; if (ts >= 0) a += conv_w[k * 768 + cc] * bf2f(proj[((size_t)b * SEQ + ts) * DING + col]); }
            *dst = a * sigm(a); }
        if (tid < 64) { const float dtv = softplusf_(dtraw[((size_t)b * SEQ + t0 + tid) * 4 + h] + dtb); dt_s[tid] = dtv;
            float v = dtv * negA;
#pragma unroll
            for (int o = 1; o < 64; o <<= 1) { const float nb = __shfl_up(v, o); if (tid >= o) v += nb; }
            acs_s[tid] = v; const float last = __shfl(v, 63); w_s[tid] = expf(last - v) * dtv; }
        __syncthreads();
#pragma unroll 1
        for (int i = 0; i < 8; ++i) { const int l = tr + 8 * i, s = j; float a = 0.f;
            if (s <= l) { _Pragma("unroll 4") for (int n = 0; n < 128; ++n) a += C_s[l * SB + n] * B_s[s * SB + n]; a *= expf(acs_s[l] - acs_s[s]); }
            W_s[l * 65 + s] = a; }
        __syncthreads();
#pragma unroll 1
        for (int i = 0; i < 8; ++i) { const int l = tr + 8 * i, p = j; float yd = 0.f, yo = 0.f;
            _Pragma("unroll 4") for (int s = 0; s < 64; ++s) yd += W_s[l * 65 + s] * (xs_s[s * 64 + p] * dt_s[s]);
            _Pragma("unroll 4") for (int n = 0; n < 128; ++n) yo += C_s[l * SB + n] * st_s[p * SB + n];
            const size_t row = (size_t)b * SEQ + t0 + l; const float zv = bf2f(proj[row * DING + C_M2Z + h * 64 + p]);
            const float y = yd + expf(acs_s[l]) * yo + xs_s[l * 64 + p] * Dh;
            oraw[row * DM + 768 + h * 64 + p] = y * (zv * sigm(zv)); }
        __syncthreads();
        { const int n = tid & 127, pq = tid >> 7; const float dec = expf(acs_s[63]);
#pragma unroll 1
            for (int i = 0; i < 16; ++i) { const int p = pq + 4 * i; float a = dec * st_s[p * SB + n];
                _Pragma("unroll 4") for (int s = 0; s < 64; ++s) a += B_s[s * SB + n] * (w_s[s] * xs_s[s * 64 + p]);
                st_s[p * SB + n] = a; } }
        __syncthreads();
    }
}

__device__ __forceinline__ void norm_row(const float* orow, const bf16* prow, bf16* mrow, const float* gA, const float* gB, const float* gC, const float* gD, int lane) {
    f32x4 v[4];
#pragma unroll
    for (int j = 0; j < 4; ++j) v[j] = *(const f32x4*)(orow + 256 * j + 4 * lane);
    float s[4];
#pragma unroll
    for (int j = 0; j < 4; ++j) s[j] = (v[j][0] * v[j][0] + v[j][1] * v[j][1]) + (v[j][2] * v[j][2] + v[j][3] * v[j][3]);
#pragma unroll
    for (int o = 1; o < 64; o <<= 1) { s[0] += __shfl_xor(s[0], o); s[1] += __shfl_xor(s[1], o); if (o < 16) s[2] += __shfl_xor(s[2], o); if (o < 32) s[3] += __shfl_xor(s[3], o); }
    const float r0 = 1.0f / sqrtf(s[0] * (1.0f / 256) + EPS), r1 = 1.0f / sqrtf(s[1] * (1.0f / 256) + EPS), r2 = 1.0f / sqrtf(s[2] * (1.0f / 64) + EPS), r3 = 1.0f / sqrtf(s[3] * (1.0f / 128) + EPS);
    const int c = 4 * lane;
    const f32x4 g0 = *(const f32x4*)(gA + c), g1 = *(const f32x4*)(gB + c), g2 = *(const f32x4*)(gC + c), g3 = *(const f32x4*)(gD + c);
    const u32x2 gw = *(const u32x2*)(prow + C_HGG + c);
    const float gi[4] = {bflo(gw.x), bfhi(gw.x), bflo(gw.y), bfhi(gw.y)};
    f32x4 o0 = v[0] * r0 * g0, o1 = v[1] * r1 * g1, o2 = v[2] * r2 * g2, o3 = v[3] * r3 * g3;
#pragma unroll
    for (int i = 0; i < 4; ++i) o2[i] *= gi[i] * sigm(gi[i]);
    u32x2 w;
    w.x = pk2(o0[0], o0[1]); w.y = pk2(o0[2], o0[3]); *(u32x2*)(mrow + c) = w;
    w.x = pk2(o1[0], o1[1]); w.y = pk2(o1[2], o1[3]); *(u32x2*)(mrow + 256 + c) = w;
    w.x = pk2(o2[0], o2[1]); w.y = pk2(o2[2], o2[3]); *(u32x2*)(mrow + 512 + c) = w;
    w.x = pk2(o3[0], o3[1]); w.y = pk2(o3[2], o3[3]); *(u32x2*)(mrow + 768 + c) = w;
}

constexpr int RWS = 1028;
__device__ __forceinline__ void router_load(const bf16* hrow, f32x4 (&v)[4], int lane) {
#pragma unroll
    for (int j = 0; j < 4; ++j) { const u32x2 w = *(const u32x2*)(hrow + 256 * j + 4 * lane); v[j] = (f32x4){bflo(w.x), bfhi(w.x), bflo(w.y), bfhi(w.y)}; }
}
__device__ __forceinline__ void router_row(f32x4 (&v)[4], const float* g, const LAS float* rw_t, const float* rb, bf16* xn_row, int& cntl, int& oe, int& orank, float& ogate, int lane) {
    float ss = 0.f;
#pragma unroll
    for (int j = 0; j < 4; ++j) ss += (v[j][0] * v[j][0] + v[j][1] * v[j][1]) + (v[j][2] * v[j][2] + v[j][3] * v[j][3]);
    ss = wave_sum(ss);
    const float rstd = 1.0f / sqrtf(ss * (1.0f / DM) + EPS);
#pragma unroll
    for (int j = 0; j < 4; ++j) { const int col = 256 * j + 4 * lane; v[j] = v[j] * rstd * *(const f32x4*)(g + col);
        u32x2 w; w.x = pk2(v[j][0], v[j][1]); w.y = pk2(v[j][2], v[j][3]); *(u32x2*)(xn_row + col) = w; }
    float p[32];
#pragma unroll
    for (int e = 0; e < 32; ++e) { float a = 0.f;
#pragma unroll
        for (int j = 0; j < 4; ++j) { const f32x4 w = *(const LAS f32x4*)(rw_t + e * RWS + 256 * j + 4 * lane); a += (v[j][0] * w[0] + v[j][1] * w[1]) + (v[j][2] * w[2] + v[j][3] * w[3]); }
        p[e] = a; }
    float q16[16], q8[8], q4[4], q2[2];
    { const bool hi = (lane & 32) != 0;
#pragma unroll
        for (int i = 0; i < 16; ++i) { const float keep = hi ? p[16 + i] : p[i], send = hi ? p[i] : p[16 + i]; q16[i] = keep + __shfl_xor(send, 32); } }
    { const bool hi = (lane & 16) != 0;
#pragma unroll
        for (int i = 0; i < 8; ++i) { const float keep = hi ? q16[8 + i] : q16[i], send = hi ? q16[i] : q16[8 + i]; q8[i] = keep + __shfl_xor(send, 16); } }
    { const bool hi = (lane & 8) != 0;
#pragma unroll
        for (int i = 0; i < 4; ++i) { const float keep = hi ? q8[4 + i] : q8[i], send = hi ? q8[i] : q8[4 + i]; q4[i] = keep + __shfl_xor(send, 8); } }
    { const bool hi = (lane & 4) != 0;
#pragma unroll
        for (int i = 0; i < 2; ++i) { const float keep = hi ? q4[2 + i] : q4[i], send = hi ? q4[i] : q4[2 + i]; q2[i] = keep + __shfl_xor(send, 4); } }
    float mine;
    { const bool hi = (lane & 2) != 0; const float keep = hi ? q2[1] : q2[0], send = hi ? q2[0] : q2[1]; mine = keep + __shfl_xor(send, 2); }
    mine += __shfl_xor(mine, 1);
    const int myexp = lane >> 1;
    mine += rb[myexp];
    int rank = 0;
#pragma unroll
    for (int e = 0; e < 32; ++e) { const float o = __uint_as_float(__builtin_amdgcn_readlane(__float_as_uint(mine), 2 * e)); rank += (o > mine || (o == mine && e < myexp)) ? 1 : 0; }
    int be[4]; float bl[4];
#pragma unroll
    for (int r = 0; r < 4; ++r) { const unsigned long long m = __ballot(rank == r && (lane & 1) == 0); be[r] = (int)(__builtin_ctzll(m) >> 1);
        bl[r] = __uint_as_float(__builtin_amdgcn_readlane(__float_as_uint(mine), 2 * be[r])); }
    const float e1 = expf(bl[1] - bl[0]), e2 = expf(bl[2] - bl[0]), e3 = expf(bl[3] - bl[0]), inv = 1.0f / (1.0f + e1 + e2 + e3);
    int rk[4];
#pragma unroll
    for (int r = 0; r < 4; ++r) { rk[r] = __builtin_amdgcn_readlane(cntl, be[r]); if (lane == be[r]) cntl += 1; }
    { const int k = lane & 3;
        oe = k == 0 ? be[0] : k == 1 ? be[1] : k == 2 ? be[2] : be[3]; orank = k == 0 ? rk[0] : k == 1 ? rk[1] : k == 2 ? rk[2] : rk[3];
        ogate = (k == 0 ? 1.0f : k == 1 ? e1 : k == 2 ? e2 : e3) * inv; }
}

__device__ __forceinline__ void router_row2(f32x4 (&va)[4], f32x4 (&vb)[4], const float* g, const LAS float* rw_t, const float* rb, bf16* xn_a, bf16* xn_b, int& cntl,
                                            int& oeA, int& orA, float& ogA, int& oeB, int& orB, float& ogB, int lane) {
    float sa = 0.f, sb = 0.f;
#pragma unroll
    for (int j = 0; j < 4; ++j) { sa += (va[j][0] * va[j][0] + va[j][1] * va[j][1]) + (va[j][2] * va[j][2] + va[j][3] * va[j][3]); sb += (vb[j][0] * vb[j][0] + vb[j][1] * vb[j][1]) + (vb[j][2] * vb[j][2] + vb[j][3] * vb[j][3]); }
#pragma unroll
    for (int o = 1; o < 64; o <<= 1) { sa += __shfl_xor(sa, o); sb += __shfl_xor(sb, o); }
    const float ra = 1.0f / sqrtf(sa * (1.0f / DM) + EPS), rbs = 1.0f / sqrtf(sb * (1.0f / DM) + EPS);
#pragma unroll
    for (int j = 0; j < 4; ++j) { const int col = 256 * j + 4 * lane; const f32x4 gg = *(const f32x4*)(g + col); va[j] = va[j] * ra * gg; vb[j] = vb[j] * rbs * gg;
        u32x2 w; w.x = pk2(va[j][0], va[j][1]); w.y = pk2(va[j][2], va[j][3]); *(u32x2*)(xn_a + col) = w;
        w.x = pk2(vb[j][0], vb[j][1]); w.y = pk2(vb[j][2], vb[j][3]); *(u32x2*)(xn_b + col) = w; }
    float pa[32], pb[32];
#pragma unroll
    for (int e = 0; e < 32; ++e) { float a = 0.f, b = 0.f;
#pragma unroll
        for (int j = 0; j < 4; ++j) { const f32x4 w = *(const LAS f32x4*)(rw_t + e * RWS + 256 * j + 4 * lane);
            a += (va[j][0] * w[0] + va[j][1] * w[1]) + (va[j][2] * w[2] + va[j][3] * w[3]); b += (vb[j][0] * w[0] + vb[j][1] * w[1]) + (vb[j][2] * w[2] + vb[j][3] * w[3]); }
        pa[e] = a; pb[e] = b; }
    float q32[32], q16[16], q8[8], q4[4], q2[2];
    { const bool hi = (lane & 32) != 0;
#pragma unroll
        for (int i = 0; i < 32; ++i) { const float keep = hi ? pb[i] : pa[i], send = hi ? pa[i] : pb[i]; q32[i] = keep + __shfl_xor(send, 32); } }
    { const bool hi = (lane & 16) != 0;
#pragma unroll
        for (int i = 0; i < 16; ++i) { const float keep = hi ? q32[16 + i] : q32[i], send = hi ? q32[i] : q32[16 + i]; q16[i] = keep + __shfl_xor(send, 16); } }
    { const bool hi = (lane & 8) != 0;
#pragma unroll
        for (int i = 0; i < 8; ++i) { const float keep = hi ? q16[8 + i] : q16[i], send = hi ? q16[i] : q16[8 + i]; q8[i] = keep + __shfl_xor(send, 8); } }
    { const bool hi = (lane & 4) != 0;
#pragma unroll
        for (int i = 0; i < 4; ++i) { const float keep = hi ? q8[4 + i] : q8[i], send = hi ? q8[i] : q8[4 + i]; q4[i] = keep + __shfl_xor(send, 4); } }
    { const bool hi = (lane & 2) != 0;
#pragma unroll
        for (int i = 0; i < 2; ++i) { const float keep = hi ? q4[2 + i] : q4[i], send = hi ? q4[i] : q4[2 + i]; q2[i] = keep + __shfl_xor(send, 2); } }
    float mine;
    { const bool hi = (lane & 1) != 0; const float keep = hi ? q2[1] : q2[0], send = hi ? q2[0] : q2[1]; mine = keep + __shfl_xor(send, 1); }
    const int myexp = lane & 31;
    mine += rb[myexp];
    int rank = 0;
#pragma unroll
    for (int e = 0; e < 32; ++e) { const float o = __shfl(mine, (lane & 32) + e); rank += (o > mine || (o == mine && e < myexp)) ? 1 : 0; }
    int beA[4], beB[4]; float blA[4], blB[4];
#pragma unroll
    for (int r = 0; r < 4; ++r) { const unsigned long long m = __ballot(rank == r); beA[r] = (int)__builtin_ctz((unsigned)m); beB[r] = (int)__builtin_ctz((unsigned)(m >> 32));
        blA[r] = __uint_as_float(__builtin_amdgcn_readlane(__float_as_uint(mine), beA[r])); blB[r] = __uint_as_float(__builtin_amdgcn_readlane(__float_as_uint(mine), 32 + beB[r])); }
    const float a1 = expf(blA[1] - blA[0]), a2 = expf(blA[2] - blA[0]), a3 = expf(blA[3] - blA[0]), ia = 1.0f / (1.0f + a1 + a2 + a3);
    const float b1 = expf(blB[1] - blB[0]), b2 = expf(blB[2] - blB[0]), b3 = expf(blB[3] - blB[0]), ib = 1.0f / (1.0f + b1 + b2 + b3);
    int rkA[4], rkB[4];
#pragma unroll
    for (int r = 0; r < 4; ++r) { rkA[r] = __builtin_amdgcn_readlane(cntl, beA[r]); if (lane == beA[r]) cntl += 1; }
#pragma unroll
    for (int r = 0; r < 4; ++r) { rkB[r] = __builtin_amdgcn_readlane(cntl, beB[r]); if (lane == beB[r]) cntl += 1; }
    { const int k = lane & 3;
        oeA = k == 0 ? beA[0] : k == 1 ? beA[1] : k == 2 ? beA[2] : beA[3]; orA = k == 0 ? rkA[0] : k == 1 ? rkA[1] : k == 2 ? rkA[2] : rkA[3]; ogA = (k == 0 ? 1.0f : k == 1 ? a1 : k == 2 ? a2 : a3) * ia;
        oeB = k == 0 ? beB[0] : k == 1 ? beB[1] : k == 2 ? beB[2] : beB[3]; orB = k == 0 ? rkB[0] : k == 1 ? rkB[1] : k == 2 ? rkB[2] : rkB[3]; ogB = (k == 0 ? 1.0f : k == 1 ? b1 : k == 2 ? b2 : b3) * ib; }
}

__device__ __forceinline__ void build_tb(const int* tot, LAS int* tb, int tid) {
    if (tid == 0) { int run = 0; for (int e = 0; e < 32; ++e) { tb[e] = run; run += (tot[e] + 255) >> 8; } tb[32] = run; }
    __syncthreads();
}

typedef short s16x4 __attribute__((ext_vector_type(4)));
typedef short v4i16_t __attribute__((ext_vector_type(4)));
#define MFMA16(a, b, c) __builtin_amdgcn_mfma_f32_16x16x32_bf16((a), (b), (c), 0, 0, 0)
__device__ __forceinline__ bf16x8 frag_kc(const LAS bf16* M, int ld, int idx0, int k0, int lane) { return *(const LAS bf16x8*)(M + (idx0 + (lane & 15)) * ld + k0 + 8 * (lane >> 4)); }
__device__ __forceinline__ bf16x8 frag_ks(const LAS bf16* M, int ld, int idx0, int k0, int lane) {
    const LAS bf16* p = M + (k0 + 8 * (lane >> 4) + ((lane & 15) >> 2)) * ld + idx0 + 4 * (lane & 3);
    const s16x4 lo = __builtin_bit_cast(s16x4, __builtin_amdgcn_ds_read_tr16_b64_v4i16((LAS v4i16_t*)p));
    const s16x4 hi = __builtin_bit_cast(s16x4, __builtin_amdgcn_ds_read_tr16_b64_v4i16((LAS v4i16_t*)(p + 4 * ld)));
    return (bf16x8){lo[0], lo[1], lo[2], lo[3], hi[0], hi[1], hi[2], hi[3]};
}
__device__ __forceinline__ bf16x8 frag_g32(const float* M, int ld, int idx0, int k0, int lane) {
    const float* p = M + (size_t)(idx0 + (lane & 15)) * ld + k0 + 8 * (lane >> 4);
    const f32x4 a = *(const f32x4*)p, b = *(const f32x4*)(p + 4);
    v4u w; w.x = pk2(a[0], a[1]); w.y = pk2(a[2], a[3]); w.z = pk2(b[0], b[1]); w.w = pk2(b[2], b[3]);
    return __builtin_bit_cast(bf16x8, w);
}
__device__ __forceinline__ float fsigm(float x) { return __builtin_amdgcn_rcpf(1.0f + __builtin_amdgcn_exp2f(-1.4426950408889634f * x)); }
__device__ __forceinline__ float fexp(float x) { return __builtin_amdgcn_exp2f(1.4426950408889634f * x); }

constexpr int M2LD = 136, M2WLD = 72;
__device__ __forceinline__ void m2_conv_block(const bf16* proj, const float* cw, const float* cb, int b, int t0, int tq, int cc0, float (&o)[8][8]) {
    v4u x[11]; f32x4 w[4][2];
    const int ts0 = t0 + 8 * tq - 3;
#pragma unroll
    for (int r = 0; r < 11; ++r) { const int ts = ts0 + r; x[r] = (v4u){0u, 0u, 0u, 0u}; if (ts >= 0) x[r] = *(const v4u*)(proj + ((size_t)b * SEQ + ts) * DING + C_M2X + cc0); }
#pragma unroll
    for (int k = 0; k < 4; ++k) { w[k][0] = *(const f32x4*)(cw + k * 768 + cc0); w[k][1] = *(const f32x4*)(cw + k * 768 + cc0 + 4); }
    const f32x4 b0 = *(const f32x4*)(cb + cc0), b1 = *(const f32x4*)(cb + cc0 + 4);
#pragma unroll
    for (int j = 0; j < 8; ++j) { float a[8] = {b0[0], b0[1], b0[2], b0[3], b1[0], b1[1], b1[2], b1[3]};
#pragma unroll
        for (int k = 0; k < 4; ++k) { const v4u xv = x[j + k];
            a[0] += w[k][0][0] * bflo(xv[0]); a[1] += w[k][0][1] * bfhi(xv[0]); a[2] += w[k][0][2] * bflo(xv[1]); a[3] += w[k][0][3] * bfhi(xv[1]);
            a[4] += w[k][1][0] * bflo(xv[2]); a[5] += w[k][1][1] * bfhi(xv[2]); a[6] += w[k][1][2] * bflo(xv[3]); a[7] += w[k][1][3] * bfhi(xv[3]); }
#pragma unroll
        for (int i = 0; i < 8; ++i) o[j][i] = a[i] * fsigm(a[i]); }
}
__device__ __forceinline__ void m2_dt_scan(const float* dtraw, const float* dt_bias, const float* a_log, int b, int t0, int g, LAS float* dt_s, LAS float* acs_s, LAS float* w_s, float* dec_out, int tid) {
    if (tid >= 384) { const int hh = (tid - 384) >> 6, t = tid & 63, h = 2 * g + hh;
        const float dtv = softplusf_(dtraw[((size_t)b * SEQ + t0 + t) * 4 + h] + dt_bias[h]);
        float v = dtv * (-expf(a_log[h]));
#pragma unroll
        for (int o = 1; o < 64; o <<= 1) { const float nb = __shfl_up(v, o); if (t >= o) v += nb; }
        const float last = __shfl(v, 63);
        dt_s[hh * 64 + t] = dtv; acs_s[hh * 64 + t] = v; w_s[hh * 64 + t] = expf(last - v) * dtv;
        if (dec_out && t == 63) dec_out[h] = expf(last); }
}
__device__ __forceinline__ void m2_state_unit(const bf16* proj, const float* dtraw, float* sloc, float* dec, int b, int ch, int g, const float* cw, const float* cb, const float* dt_bias, const float* a_log, LAS unsigned char* lds, int tid) {
    LAS bf16* XS = (LAS bf16*)lds; LAS bf16* BS = XS + 64 * M2LD; LAS float* dt_s = (LAS float*)(BS + 64 * M2LD); LAS float* acs_s = dt_s + 128; LAS float* w_s = acs_s + 128;
    const int lane = tid & 63, w = tid >> 6, t0 = ch * 64;
    m2_dt_scan(dtraw, dt_bias, a_log, b, t0, g, dt_s, acs_s, w_s, dec + (size_t)(b * 32 + ch) * 4, tid);
    float o[8][8]; const int cg = tid & 31, tq = tid >> 5;
    if (tid < 256) m2_conv_block(proj, cw, cb, b, t0, tq, cg < 16 ? g * 128 + 8 * cg : 256 + g * 128 + 8 * (cg - 16), o);
    __syncthreads();
    if (tid < 256) {
#pragma unroll
        for (int j = 0; j < 8; ++j) { const int t = 8 * tq + j; const float sc = cg < 16 ? w_s[(cg >> 3) * 64 + t] : 1.0f;
            v4u q; q.x = pk2(o[j][0] * sc, o[j][1] * sc); q.y = pk2(o[j][2] * sc, o[j][3] * sc); q.z = pk2(o[j][4] * sc, o[j][5] * sc); q.w = pk2(o[j][6] * sc, o[j][7] * sc);
            *(LAS v4u*)((cg < 16 ? XS + 8 * cg : BS + 8 * (cg - 16)) + t * M2LD) = q; } }
    __syncthreads();
    { const int hh = w >> 2, mi = w & 3;
        const bf16x8 a0 = frag_ks(XS, M2LD, hh * 64 + mi * 16, 0, lane), a1 = frag_ks(XS, M2LD, hh * 64 + mi * 16, 32, lane);
        float* outp = sloc + ((size_t)((b * 32 + ch) * 4 + 2 * g + hh) * 64 + mi * 16 + 4 * (lane >> 4)) * 128 + (lane & 15);
#pragma unroll
        for (int ni = 0; ni < 8; ++ni) { const bf16x8 b0 = frag_ks(BS, M2LD, ni * 16, 0, lane), b1 = frag_ks(BS, M2LD, ni * 16, 32, lane);
            f32x4 acc = {0.f, 0.f, 0.f, 0.f}; acc = MFMA16(a0, b0, acc); acc = MFMA16(a1, b1, acc);
#pragma unroll
            for (int i = 0; i < 4; ++i) outp[i * 128 + ni * 16] = acc[i]; } }
    __syncthreads();
}
__device__ __forceinline__ void m2_out_unit(const bf16* proj, const float* dtraw, const bf16* prevb, float* oraw, int b, int ch, int g, const float* cw, const float* cb, const float* dt_bias, const float* a_log, const float* dskip, LAS unsigned char* lds, int tid) {
    LAS bf16* XS = (LAS bf16*)lds; LAS bf16* BS = XS + 64 * M2LD; LAS bf16* CS = BS + 64 * M2LD; LAS bf16* WS = CS + 64 * M2LD;
    LAS float* dt_s = (LAS float*)(WS + 2 * 64 * M2WLD); LAS float* acs_s = dt_s + 128; LAS float* w_s = acs_s + 128;
    const int lane = tid & 63, w = tid >> 6, t0 = ch * 64;
    bf16x8 pf[4][4];
    { const bf16* pv = prevb + (size_t)((b * 32 + ch) * 4 + 2 * g + (w >> 2)) * 64 * 128;
#pragma unroll
        for (int kk = 0; kk < 4; ++kk)
#pragma unroll
            for (int ni = 0; ni < 4; ++ni) pf[kk][ni] = *(const bf16x8*)(pv + (size_t)(ni * 16 + (lane & 15)) * 128 + 32 * kk + 8 * (lane >> 4)); }
    m2_dt_scan(dtraw, dt_bias, a_log, b, t0, g, dt_s, acs_s, w_s, nullptr, tid);
    if (tid < 384) { float o[8][8]; const int cg = tid % 48, tq = tid / 48;
        const int cc0 = cg < 16 ? g * 128 + 8 * cg : cg < 32 ? 256 + g * 128 + 8 * (cg - 16) : 512 + g * 128 + 8 * (cg - 32);
        m2_conv_block(proj, cw, cb, b, t0, tq, cc0, o);
        LAS bf16* dst = cg < 16 ? XS + 8 * cg : cg < 32 ? BS + 8 * (cg - 16) : CS + 8 * (cg - 32);
#pragma unroll
        for (int j = 0; j < 8; ++j) { v4u q; q.x = pk2(o[j][0], o[j][1]); q.y = pk2(o[j][2], o[j][3]); q.z = pk2(o[j][4], o[j][5]); q.w = pk2(o[j][6], o[j][7]); *(LAS v4u*)(dst + (8 * tq + j) * M2LD) = q; } }
    __syncthreads();
    { const int mi = w >> 1, ni0 = (w & 1) * 2;
        f32x4 acc[2] = {{0.f, 0.f, 0.f, 0.f}, {0.f, 0.f, 0.f, 0.f}};
#pragma unroll
        for (int kk = 0; kk < 4; ++kk) { const bf16x8 a = frag_kc(CS, M2LD, mi * 16, 32 * kk, lane);
#pragma unroll
            for (int q = 0; q < 2; ++q) { const bf16x8 bb = frag_kc(BS, M2LD, (ni0 + q) * 16, 32 * kk, lane); acc[q] = MFMA16(a, bb, acc[q]); } }
#pragma unroll
        for (int q = 0; q < 2; ++q) { const int s = (ni0 + q) * 16 + (lane & 15);
#pragma unroll
            for (int hh = 0; hh < 2; ++hh) { const float as = acs_s[hh * 64 + s], ds = dt_s[hh * 64 + s];
#pragma unroll
                for (int i = 0; i < 4; ++i) { const int l = mi * 16 + 4 * (lane >> 4) + i;
                    const float v = (s <= l) ? acc[q][i] * fexp(acs_s[hh * 64 + l] - as) * ds : 0.f;
                    WS[(hh * 64 + l) * M2WLD + s] = (bf16)f2bf(v); } } } }
    __syncthreads();
    { const int hh = w >> 2, mi = w & 3, h = 2 * g + hh;
        f32x4 yd[4], yo[4];
#pragma unroll
        for (int ni = 0; ni < 4; ++ni) { yd[ni] = (f32x4){0.f, 0.f, 0.f, 0.f}; yo[ni] = (f32x4){0.f, 0.f, 0.f, 0.f}; }
#pragma unroll
        for (int kk = 0; kk < 2; ++kk) { const bf16x8 a = frag_kc(WS + hh * 64 * M2WLD, M2WLD, mi * 16, 32 * kk, lane);
#pragma unroll
            for (int ni = 0; ni < 4; ++ni) { const bf16x8 bb = frag_ks(XS, M2LD, hh * 64 + ni * 16, 32 * kk, lane); yd[ni] = MFMA16(a, bb, yd[ni]); } }
#pragma unroll
        for (int kk = 0; kk < 4; ++kk) { const bf16x8 a = frag_kc(CS, M2LD, mi * 16, 32 * kk, lane);
#pragma unroll
            for (int ni = 0; ni < 4; ++ni) yo[ni] = MFMA16(a, pf[kk][ni], yo[ni]); }
        const float Dh = dskip[h];
#pragma unroll
        for (int i = 0; i < 4; ++i) { const int l = mi * 16 + 4 * (lane >> 4) + i; const float ea = fexp(acs_s[hh * 64 + l]); const size_t row = (size_t)b * SEQ + t0 + l;
#pragma unroll
            for (int ni = 0; ni < 4; ++ni) { const int p = ni * 16 + (lane & 15);
                const float xv = bf2f(XS[l * M2LD + hh * 64 + p]), zv = bf2f(proj[row * DING + C_M2Z + h * 64 + p]);
                const float y = yd[ni][i] + ea * yo[ni][i] + xv * Dh;
                oraw[row * DM + 768 + h * 64 + p] = y * (zv * fsigm(zv)); } } }
    __syncthreads();
}

constexpr int HGLD = 136, HGWLD = 72;
template <bool WITH_Q>
__device__ __forceinline__ void hg_prep(const bf16* proj, int b, int t0, int hp, const float* lb1, int layer, LAS float* bc_s, LAS bf16* QS, LAS bf16* KS, LAS bf16* VS, LAS bf16* Q2, int tid) {
    const int c0 = (tid & 15) * 8, ta = tid >> 4;
    float lb[8];
#pragma unroll
    for (int i = 0; i < 8; ++i) lb[i] = 0.f;
    if (layer == 1) { const f32x4 l0 = *(const f32x4*)(lb1 + hp * 128 + c0), l1 = *(const f32x4*)(lb1 + hp * 128 + c0 + 4); lb[0] = l0[0]; lb[1] = l0[1]; lb[2] = l0[2]; lb[3] = l0[3]; lb[4] = l1[0]; lb[5] = l1[1]; lb[6] = l1[2]; lb[7] = l1[3]; }
    v4u fw[2], iw[2], qw[2];
#pragma unroll
    for (int u = 0; u < 2; ++u) { const size_t row = (size_t)b * SEQ + t0 + ta + 32 * u;
        fw[u] = *(const v4u*)(proj + row * DING + C_HGF + hp * 128 + c0); iw[u] = *(const v4u*)(proj + row * DING + C_HGI + hp * 128 + c0);
        if (WITH_Q) qw[u] = *(const v4u*)(proj + row * DING + C_HGQ + hp * 128 + c0); }
    float key[2][8];
#pragma unroll
    for (int u = 0; u < 2; ++u) { const int t = ta + 32 * u;
        const float f[8] = {bflo(fw[u][0]), bfhi(fw[u][0]), bflo(fw[u][1]), bfhi(fw[u][1]), bflo(fw[u][2]), bfhi(fw[u][2]), bflo(fw[u][3]), bfhi(fw[u][3])};
        float lf[8];
#pragma unroll
        for (int i = 0; i < 8; ++i) { const float sg = fsigm(f[i]); lf[i] = __builtin_amdgcn_logf(lb[i] + (1.0f - lb[i]) * sg) * 0.6931471805599453f; key[u][i] = (1.0f - lb[i]) * (1.0f - sg); }
        *(LAS f32x4*)(bc_s + t * 128 + c0) = (f32x4){lf[0], lf[1], lf[2], lf[3]}; *(LAS f32x4*)(bc_s + t * 128 + c0 + 4) = (f32x4){lf[4], lf[5], lf[6], lf[7]};
        *(LAS v4u*)(VS + t * HGLD + c0) = iw[u]; }
    __syncthreads();
    if (tid < 128) { float run = 0.f;
#pragma unroll 8
        for (int t = 0; t < 64; ++t) { run += bc_s[t * 128 + tid]; bc_s[t * 128 + tid] = run; } }
    __syncthreads();
    const f32x4 m0 = *(const LAS f32x4*)(bc_s + 31 * 128 + c0), m1 = *(const LAS f32x4*)(bc_s + 31 * 128 + c0 + 4);
    const float b31[8] = {m0[0], m0[1], m0[2], m0[3], m1[0], m1[1], m1[2], m1[3]};
#pragma unroll
    for (int u = 0; u < 2; ++u) { const int t = ta + 32 * u;
        const f32x4 x0 = *(const LAS f32x4*)(bc_s + t * 128 + c0), x1 = *(const LAS f32x4*)(bc_s + t * 128 + c0 + 4);
        const float bc[8] = {x0[0], x0[1], x0[2], x0[3], x1[0], x1[1], x1[2], x1[3]};
        float kk[8], qq[8], q2[8];
#pragma unroll
        for (int i = 0; i < 8; ++i) { const float d = b31[i] - bc[i]; kk[i] = key[u][i] * fexp(fminf(d, 60.0f));
            if (WITH_Q) { const float qv = (i & 1) ? bfhi(qw[u][i >> 1]) : bflo(qw[u][i >> 1]); const float qs = qv * fsigm(qv); qq[i] = qs * fexp(fminf(-d, 60.0f)); q2[i] = qs * fexp(bc[i]); } }
        v4u o; o.x = pk2(kk[0], kk[1]); o.y = pk2(kk[2], kk[3]); o.z = pk2(kk[4], kk[5]); o.w = pk2(kk[6], kk[7]); *(LAS v4u*)(KS + t * HGLD + c0) = o;
        if (WITH_Q) { o.x = pk2(qq[0], qq[1]); o.y = pk2(qq[2], qq[3]); o.z = pk2(qq[4], qq[5]); o.w = pk2(qq[6], qq[7]); *(LAS v4u*)(QS + t * HGLD + c0) = o;
            o.x = pk2(q2[0], q2[1]); o.y = pk2(q2[2], q2[3]); o.z = pk2(q2[4], q2[5]); o.w = pk2(q2[6], q2[7]); *(LAS v4u*)(Q2 + t * HGLD + c0) = o; } }
    __syncthreads();
}
__device__ __forceinline__ void hg_state_unit(const bf16* proj, float* slt, float* decc, int b, int ch, int hp, const float* lbp, int layer, LAS unsigned char* lds, int tid) {
    LAS float* bc_s = (LAS float*)lds; LAS bf16* KS = (LAS bf16*)(lds + 32768); LAS bf16* VS = KS + 64 * HGLD;
    const int lane = tid & 63, w = tid >> 6;
    hg_prep<false>(proj, b, ch * 64, hp, lbp, layer, bc_s, nullptr, KS, VS, nullptr, tid);
    if (tid < 128) decc[(size_t)((b * 32 + ch) * 4 + 2 * hp) * 64 + tid] = fexp(bc_s[63 * 128 + tid]);
    { const int hh = w >> 2, mi = w & 3, h = 2 * hp + hh;
        const bf16x8 a0 = frag_ks(VS, HGLD, hh * 64 + mi * 16, 0, lane), a1 = frag_ks(VS, HGLD, hh * 64 + mi * 16, 32, lane);
        float* outp = slt + ((size_t)((b * 32 + ch) * 4 + h) * 64 + mi * 16 + 4 * (lane >> 4)) * 64 + (lane & 15);
#pragma unroll
        for (int ni = 0; ni < 4; ++ni) { const bf16x8 b0 = frag_ks(KS, HGLD, hh * 64 + ni * 16, 0, lane), b1 = frag_ks(KS, HGLD, hh * 64 + ni * 16, 32, lane);
            f32x4 acc = {0.f, 0.f, 0.f, 0.f}; acc = MFMA16(a0, b0, acc); acc = MFMA16(a1, b1, acc);
            const int c = hh * 64 + ni * 16 + (lane & 15); const float sc = fexp(bc_s[63 * 128 + c] - bc_s[31 * 128 + c]);
#pragma unroll
            for (int i = 0; i < 4; ++i) outp[i * 64 + ni * 16] = acc[i] * sc; } }
    __syncthreads();
}
__device__ __forceinline__ void hg_out_unit(const bf16* proj, const bf16* stb, float* oraw, int b, int ch, int hp, const float* lbp, int layer, LAS unsigned char* lds, int tid) {
    LAS float* bc_s = (LAS float*)lds; LAS bf16* KS = (LAS bf16*)(lds + 32768); LAS bf16* VS = KS + 64 * HGLD; LAS bf16* QS = VS + 64 * HGLD; LAS bf16* WS = QS + 64 * HGLD; LAS bf16* Q2 = WS + 2 * 64 * HGWLD;
    const int lane = tid & 63, w = tid >> 6, t0 = ch * 64;
    const int hh = w >> 2, mi = w & 3, h = 2 * hp + hh;
    bf16x8 sf[2][4];
    { const bf16* st = stb + (size_t)((b * 32 + ch) * 4 + h) * 64 * 64;
#pragma unroll
        for (int kk = 0; kk < 2; ++kk)
#pragma unroll
            for (int ni = 0; ni < 4; ++ni) sf[kk][ni] = *(const bf16x8*)(st + (size_t)(ni * 16 + (lane & 15)) * 64 + 32 * kk + 8 * (lane >> 4)); }
    hg_prep<true>(proj, b, t0, hp, lbp, layer, bc_s, QS, KS, VS, Q2, tid);
    { f32x4 sc[4];
#pragma unroll
        for (int ni = 0; ni < 4; ++ni) sc[ni] = (f32x4){0.f, 0.f, 0.f, 0.f};
#pragma unroll
        for (int kk = 0; kk < 2; ++kk) { const bf16x8 a = frag_kc(QS, HGLD, mi * 16, hh * 64 + 32 * kk, lane);
#pragma unroll
            for (int ni = 0; ni < 4; ++ni) { const bf16x8 bb = frag_kc(KS, HGLD, ni * 16, hh * 64 + 32 * kk, lane); sc[ni] = MFMA16(a, bb, sc[ni]); } }
#pragma unroll
        for (int ni = 0; ni < 4; ++ni) { const int s = ni * 16 + (lane & 15);
#pragma unroll
            for (int i = 0; i < 4; ++i) { const int t = mi * 16 + 4 * (lane >> 4) + i; WS[(hh * 64 + t) * HGWLD + s] = (bf16)f2bf(s <= t ? sc[ni][i] : 0.f); } } }
    __syncthreads();
    { f32x4 o[4];
#pragma unroll
        for (int ni = 0; ni < 4; ++ni) o[ni] = (f32x4){0.f, 0.f, 0.f, 0.f};
#pragma unroll
        for (int kk = 0; kk < 2; ++kk) { const bf16x8 a = frag_kc(WS + hh * 64 * HGWLD, HGWLD, mi * 16, 32 * kk, lane);
#pragma unroll
            for (int ni = 0; ni < 4; ++ni) { const bf16x8 bb = frag_ks(VS, HGLD, hh * 64 + ni * 16, 32 * kk, lane); o[ni] = MFMA16(a, bb, o[ni]); } }
#pragma unroll
        for (int kk = 0; kk < 2; ++kk) { const bf16x8 a = frag_kc(Q2, HGLD, mi * 16, hh * 64 + 32 * kk, lane);
#pragma unroll
            for (int ni = 0; ni < 4; ++ni) o[ni] = MFMA16(a, sf[kk][ni], o[ni]); }
#pragma unroll
        for (int i = 0; i < 4; ++i) { const size_t row = (size_t)b * SEQ + t0 + mi * 16 + 4 * (lane >> 4) + i;
#pragma unroll
            for (int ni = 0; ni < 4; ++ni) oraw[row * DM + 512 + h * 64 + ni * 16 + (lane & 15)] = o[ni][i]; } }
    __syncthreads();
}

constexpr int RGLD = 136;
__device__ __forceinline__ void rg_local_unit(const bf16* proj, float* hloc, float* pcum, float* rgs, int b, int ch, int half, const float* conv_w, const float* conv_b, const bf16* waT, const bf16* wxT,
                                              const float* ba, const float* bx, const float* lam, LAS unsigned char* lds, int tid) {
    LAS float* xc32 = (LAS float*)lds; LAS float* a_s = xc32 + 64 * 128; LAS bf16* xcb = (LAS bf16*)(a_s + 64 * 128); LAS float* par = (LAS float*)(xcb + 64 * RGLD);
    const int lane = tid & 63, w = tid >> 6, t0 = ch * 64, cg0 = half * 128;
    if (tid < 128) { par[tid] = ba[cg0 + tid]; par[128 + tid] = bx[cg0 + tid]; par[256 + tid] = softplusf_(-lam[cg0 + tid]); }
    { const int c0 = (tid & 15) * 8, cg = cg0 + c0, tp = tid >> 4;
        v4u x[5]; f32x4 wk[4][2];
#pragma unroll
        for (int r = 0; r < 5; ++r) { const int ts = t0 + 2 * tp - 3 + r; x[r] = (v4u){0u, 0u, 0u, 0u}; if (ts >= 0) x[r] = *(const v4u*)(proj + ((size_t)b * SEQ + ts) * DING + C_RGX + cg); }
#pragma unroll
        for (int k = 0; k < 4; ++k) { wk[k][0] = *(const f32x4*)(conv_w + k * 256 + cg); wk[k][1] = *(const f32x4*)(conv_w + k * 256 + cg + 4); }
        const f32x4 b0 = *(const f32x4*)(conv_b + cg), b1 = *(const f32x4*)(conv_b + cg + 4);
#pragma unroll
        for (int j = 0; j < 2; ++j) { const int t = 2 * tp + j; float o[8] = {b0[0], b0[1], b0[2], b0[3], b1[0], b1[1], b1[2], b1[3]};
#pragma unroll
            for (int k = 0; k < 4; ++k) { const v4u xv = x[j + k];
                o[0] += wk[k][0][0] * bflo(xv[0]); o[1] += wk[k][0][1] * bfhi(xv[0]); o[2] += wk[k][0][2] * bflo(xv[1]); o[3] += wk[k][0][3] * bfhi(xv[1]);
                o[4] += wk[k][1][0] * bflo(xv[2]); o[5] += wk[k][1][1] * bfhi(xv[2]); o[6] += wk[k][1][2] * bflo(xv[3]); o[7] += wk[k][1][3] * bfhi(xv[3]); }
            *(LAS f32x4*)(xc32 + t * 128 + c0) = (f32x4){o[0], o[1], o[2], o[3]}; *(LAS f32x4*)(xc32 + t * 128 + c0 + 4) = (f32x4){o[4], o[5], o[6], o[7]};
            v4u q; q.x = pk2(o[0], o[1]); q.y = pk2(o[2], o[3]); q.z = pk2(o[4], o[5]); q.w = pk2(o[6], o[7]); *(LAS v4u*)(xcb + t * RGLD + c0) = q; } }
    __syncthreads();
    { const int nb = w >> 2, mi = w & 3, n = 2 * half + nb;
        f32x4 ra[4], ga[4];
#pragma unroll
        for (int ni = 0; ni < 4; ++ni) { ra[ni] = (f32x4){0.f, 0.f, 0.f, 0.f}; ga[ni] = (f32x4){0.f, 0.f, 0.f, 0.f}; }
#pragma unroll
        for (int kk = 0; kk < 2; ++kk) { const bf16x8 a = frag_kc(xcb, RGLD, mi * 16, nb * 64 + 32 * kk, lane);
#pragma unroll
            for (int ni = 0; ni < 4; ++ni) { const size_t off = (size_t)(n * 64 + ni * 16 + (lane & 15)) * 64 + 32 * kk + 8 * (lane >> 4);
                ra[ni] = MFMA16(a, *(const bf16x8*)(waT + off), ra[ni]); ga[ni] = MFMA16(a, *(const bf16x8*)(wxT + off), ga[ni]); } }
#pragma unroll
        for (int ni = 0; ni < 4; ++ni) { const int c = nb * 64 + ni * 16 + (lane & 15); const float bav = par[c], bxv = par[128 + c], spl = par[256 + c];
#pragma unroll
            for (int i = 0; i < 4; ++i) { const int t = mi * 16 + 4 * (lane >> 4) + i;
                const float r = fsigm(ra[ni][i] + bav), ig = fsigm(ga[ni][i] + bxv), log_a = -8.0f * r * spl;
                float mult = sqrtf(-expm1f(2.0f * log_a)); if (t0 + t == 0) mult = 1.0f;
                a_s[t * 128 + c] = expf(log_a); xc32[t * 128 + c] = mult * ig * xc32[t * 128 + c]; } } }
    __syncthreads();
    if (tid < 128) { float h = 0.f, P = 1.f; const size_t base = ((size_t)b * SEQ + t0) * 256 + cg0 + tid;
#pragma unroll 8
        for (int t = 0; t < 64; ++t) { const float a = a_s[t * 128 + tid]; h = a * h + xc32[t * 128 + tid]; P *= a; hloc[base + (size_t)t * 256] = h; pcum[base + (size_t)t * 256] = P; }
        rgs[((size_t)(b * 32 + ch) * 256 + cg0 + tid) * 2] = P; rgs[((size_t)(b * 32 + ch) * 256 + cg0 + tid) * 2 + 1] = h; }
    __syncthreads();
}

typedef float f32x16 __attribute__((ext_vector_type(16)));
#define MFMA32(a, b, c) __builtin_amdgcn_mfma_f32_32x32x16_bf16((a), (b), (c), 0, 0, 0)
constexpr int AVLD = 72;
__device__ __forceinline__ bf16x8 pack8(const f32x16& x, int o) {
    v4u w; w.x = pg8::cvt_pk_bf16(x[o], x[o + 1]); w.y = pg8::cvt_pk_bf16(x[o + 2], x[o + 3]); w.z = pg8::cvt_pk_bf16(x[o + 4], x[o + 5]); w.w = pg8::cvt_pk_bf16(x[o + 6], x[o + 7]);
    return __builtin_bit_cast(bf16x8, w);
}
__device__ __forceinline__ float lk2(float z) { return -(fmaxf(z, 0.f) + __builtin_amdgcn_logf(1.0f + __builtin_amdgcn_exp2f(-fabsf(z)))); }
__device__ __forceinline__ void attn_unit(const bf16* proj, float* oraw, int b, int h, int qb, LAS bf16* VL, int lane) {
    const int q = lane & 31, h2 = lane >> 5, qw = qb * 32; const size_t rowb = (size_t)b * SEQ;
    bf16x8 qf[4];
    { const bf16* qp = proj + (rowb + qw + q) * DING + C_SBQ + h * 64 + 8 * h2; const float C2 = 0.125f * 1.4426950408889634f;
#pragma unroll
        for (int kk = 0; kk < 4; ++kk) { const v4u w = *(const v4u*)(qp + 16 * kk); v4u o;
            o.x = pg8::cvt_pk_bf16(bflo(w.x) * C2, bfhi(w.x) * C2); o.y = pg8::cvt_pk_bf16(bflo(w.y) * C2, bfhi(w.y) * C2); o.z = pg8::cvt_pk_bf16(bflo(w.z) * C2, bfhi(w.z) * C2); o.w = pg8::cvt_pk_bf16(bflo(w.w) * C2, bfhi(w.w) * C2);
            qf[kk] = __builtin_bit_cast(bf16x8, o); } }
    bf16x8 m0[2], ones;
#pragma unroll
    for (int s = 0; s < 2; ++s) {
#pragma unroll
        for (int jj = 0; jj < 8; ++jj) { const int j = 16 * s + 8 * (jj >> 2) + 4 * h2 + (jj & 3); m0[s][jj] = (short)(j >= q ? 0x3F80 : 0); } }
#pragma unroll
    for (int jj = 0; jj < 8; ++jj) ones[jj] = (short)0x3F80;
    f32x16 o0, o1;
#pragma unroll
    for (int r = 0; r < 16; ++r) { o0[r] = 0.f; o1[r] = 0.f; }
    float R = 0.f;
    const int sd = (qw >> 6) << 6;
    bf16x8 kf[2][4];
    { const bf16* kp = proj + (rowb + sd + q) * DING + C_SBK + h * 64 + 8 * h2;
#pragma unroll
        for (int hf = 0; hf < 2; ++hf)
#pragma unroll
            for (int kk = 0; kk < 4; ++kk) kf[hf][kk] = *(const bf16x8*)(kp + (size_t)hf * 32 * DING + 16 * kk); }
    for (int s0 = sd; s0 >= 0; s0 -= 64) {
        bf16x8 kn[2][4];
        { const int sn = s0 >= 64 ? s0 - 64 : s0; const bf16* kp = proj + (rowb + sn + q) * DING + C_SBK + h * 64 + 8 * h2;
#pragma unroll
            for (int hf = 0; hf < 2; ++hf)
#pragma unroll
                for (int kk = 0; kk < 4; ++kk) kn[hf][kk] = *(const bf16x8*)(kp + (size_t)hf * 32 * DING + 16 * kk); }
#pragma unroll
        for (int i = 0; i < 8; ++i) { const int row = (lane >> 3) + 8 * i; const v4u w = *(const v4u*)(proj + (rowb + s0 + row) * DING + C_SBV + h * 64 + 8 * (lane & 7)); *(LAS v4u*)(VL + row * AVLD + 8 * (lane & 7)) = w; }
        f32x16 z0, z1;
#pragma unroll
        for (int r = 0; r < 16; ++r) { z0[r] = 0.f; z1[r] = 0.f; }
#pragma unroll
        for (int kk = 0; kk < 4; ++kk) { z0 = MFMA32(kf[0][kk], qf[kk], z0); z1 = MFMA32(kf[1][kk], qf[kk], z1); }
        const int lim = (s0 == sd) ? (qw - sd) + q : 64;
        f32x16 l0, l1;
#pragma unroll
        for (int r = 0; r < 16; ++r) { const int key = (r & 3) + 8 * (r >> 2) + 4 * h2; l0[r] = key < lim ? lk2(z0[r]) : 0.f; l1[r] = key + 32 < lim ? lk2(z1[r]) : 0.f; }
        const bf16x8 bl0 = pack8(l0, 0), bl1 = pack8(l0, 8), bh0 = pack8(l1, 0), bh1 = pack8(l1, 8);
        f32x16 i0 = z0, i1 = z1;
        i0 = MFMA32(m0[0], bl0, i0); i0 = MFMA32(m0[1], bl1, i0); i0 = MFMA32(ones, bh0, i0); i0 = MFMA32(ones, bh1, i0);
        i1 = MFMA32(m0[0], bh0, i1); i1 = MFMA32(m0[1], bh1, i1);
        float tot = h2 == 0 ? i0[0] - z0[0] : 0.f; tot += __shfl_xor(tot, 32);
#pragma unroll
        for (int r = 0; r < 16; ++r) { const int key = (r & 3) + 8 * (r >> 2) + 4 * h2; l0[r] = key < lim ? __builtin_amdgcn_exp2f(i0[r] + R) : 0.f; l1[r] = key + 32 < lim ? __builtin_amdgcn_exp2f(i1[r] + R) : 0.f; }
        R += tot;
        const bf16x8 pa0 = pack8(l0, 0), pa1 = pack8(l0, 8), pa2 = pack8(l1, 0), pa3 = pack8(l1, 8);
        const LAS bf16* vb = VL + (4 * h2 + ((lane & 15) >> 2)) * AVLD + 16 * ((lane >> 4) & 1) + 4 * (lane & 3);
#define VFRAG(kb, db) ({ const s16x4 lo_ = __builtin_bit_cast(s16x4, __builtin_amdgcn_ds_read_tr16_b64_v4i16((LAS v4i16_t*)(vb + (kb) * AVLD + (db) * 32))); \
                         const s16x4 hi_ = __builtin_bit_cast(s16x4, __builtin_amdgcn_ds_read_tr16_b64_v4i16((LAS v4i16_t*)(vb + ((kb) + 8) * AVLD + (db) * 32))); \
                         (bf16x8){lo_[0], lo_[1], lo_[2], lo_[3], hi_[0], hi_[1], hi_[2], hi_[3]}; })
        o0 = MFMA32(pa0, VFRAG(0, 0), o0); o1 = MFMA32(pa0, VFRAG(0, 1), o1);
        o0 = MFMA32(pa1, VFRAG(16, 0), o0); o1 = MFMA32(pa1, VFRAG(16, 1), o1);
        o0 = MFMA32(pa2, VFRAG(32, 0), o0); o1 = MFMA32(pa2, VFRAG(32, 1), o1);
        o0 = MFMA32(pa3, VFRAG(48, 0), o0); o1 = MFMA32(pa3, VFRAG(48, 1), o1);
#undef VFRAG
#pragma unroll
        for (int hf = 0; hf < 2; ++hf)
#pragma unroll
            for (int kk = 0; kk < 4; ++kk) kf[hf][kk] = kn[hf][kk];
        if (__all(R < -127.0f)) break;
    }
    float* op = oraw + (rowb + qw) * DM + h * 64 + q;
#pragma unroll
    for (int r = 0; r < 16; ++r) { const int qq = (r & 3) + 8 * (r >> 2) + 4 * h2; op[(size_t)qq * DM] = o0[r]; op[(size_t)qq * DM + 32] = o1[r]; }
}


constexpr int NPL = 11, NPHASE = 1 + NPL * DEPTH;
struct Args { const float* in[29]; float* out; unsigned char* ws; int ph_lo, ph_hi, use_bar, pad; };

typedef const __attribute__((address_space(4))) Args* KArgP;
__device__ __forceinline__ KArgP kargs() { KArgP p = (KArgP)__builtin_amdgcn_kernarg_segment_ptr(); asm volatile("" : "+s"(p)); return p; }
#define WSP(type, off) ((type*)(kargs()->ws + (off)))
#define INP(i) (kargs()->in[i])

constexpr int CV_MOE = NE * IT_GU + NE * IT_DN;
constexpr int CV_TAILQ = 5, CV_TAILW = (256 - 64) * NWAVES;
constexpr int CV_TAIL = CV_TAILQ * CV_TAILW;
constexpr int CV_SMALL = NIT_WIN + NIT_WOUT;
#ifndef CV_SLOT_MASK
#define CV_SLOT_MASK 0
#endif
constexpr int CV_P0_ITEMS = CV_SLOT_MASK ? CV_SMALL : CV_SMALL + DEPTH * (CV_MOE - CV_TAIL);
__device__ __forceinline__ TDesc cv_moe(int l, int r) { TDesc d;
    if (r < NE * IT_GU) { const int le = l * NE + r / IT_GU, q = r % IT_GU; d.W = INP(24) + (size_t)le * DM * 2048; d.ldw = 2048; d.WT = WSP(bf16, WS_WGU) + (size_t)le * 2048 * DM; d.K = DM; d.k0 = 64 * (q / 32); d.n0 = 64 * (q % 32); d.gu = 1; return d; }
    r -= NE * IT_GU;
    { const int le = l * NE + r / IT_DN, q = r % IT_DN; d.W = INP(26) + (size_t)le * DFF * DM; d.ldw = DM; d.WT = WSP(bf16, WS_WDN) + (size_t)le * DM * DFF; d.K = DFF; d.k0 = 64 * (q / 16); d.n0 = 64 * (q % 16); d.gu = 0; return d; } }
__device__ __forceinline__ TDesc cv_p0(int r) { TDesc d;
    if (r < NIT_WIN) { const int l = r / IT_WIN, q = r % IT_WIN; d.W = INP(2) + (size_t)l * DM * DIN; d.ldw = DIN; d.WT = WSP(bf16, WS_WIN) + (size_t)l * DING * DM; d.K = DM; d.k0 = 64 * (q / 52); d.n0 = 64 * (q % 52); d.gu = 0; return d; }
    r -= NIT_WIN;
    if (r < NIT_WOUT) { const int l = r / IT_WOUT, q = r % IT_WOUT; d.W = INP(20) + (size_t)l * DM * DM; d.ldw = DM; d.WT = WSP(bf16, WS_WOUT) + (size_t)l * DM * DM; d.K = DM; d.k0 = 64 * (q / 16); d.n0 = 64 * (q % 16); d.gu = 0; return d; }
    r -= NIT_WOUT;
    const int l = r / (CV_MOE - CV_TAIL); return cv_moe(l, CV_TAIL + r % (CV_MOE - CV_TAIL)); }
__device__ __forceinline__ void convert_items(int n, int first, int stride, int tail_layer_p1, LAS float* scr, int lane) {
    int it = first; TDesc dc, dn; f32x4 va[16], vb[16];
    if (it < n) { dc = tail_layer_p1 ? cv_moe(tail_layer_p1 - 1, it) : cv_p0(it); tload(dc, va, lane); }
    while (it < n) { const int nx = it + stride; const bool hn = nx < n;
        if (hn) { dn = tail_layer_p1 ? cv_moe(tail_layer_p1 - 1, nx) : cv_p0(nx); tload(dn, vb, lane); }
        tstore(dc, va, scr, lane);
        if (hn) { dc = dn;
#pragma unroll
            for (int i = 0; i < 16; ++i) va[i] = vb[i]; }
        it = nx; }
}

__global__ void __launch_bounds__(NTHR, 2) fwd_kernel(Args args_unused) {
    extern __shared__ __attribute__((aligned(16))) unsigned char lds_raw[];
    LAS unsigned char* lds = (LAS unsigned char*)lds_raw;
    LAS float* ldsf = (LAS float*)lds_raw;
    volatile LAS unsigned* MISC = (volatile LAS unsigned*)(lds + MISC_OFF);
    LAS int* tb = (LAS int*)(lds + TB_OFF);
    const int tid0 = threadIdx.x;
#define PH_IDS int tid = threadIdx.x; asm volatile("" : "+v"(tid)); const int lane = tid & 63, wave = __builtin_amdgcn_readfirstlane(tid >> 6); const int gw = vcu * NWAVES + wave; (void)lane; (void)gw;
    const int G = gridDim.x, bx = blockIdx.x;
    const int vcu = (G % 8 == 0) ? (bx % 8) * (G / 8) + bx / 8 : bx;
    const int NGW = G * NWAVES;
    gu32* ctl = (gu32*)WSP(unsigned char, WS_CTL);

    for (int u = tid0; u < (LDS_BYTES - LDSCTL_OFF) / 4; u += NTHR) ((LAS unsigned*)(lds + LDSCTL_OFF))[u] = 0u;
    __syncthreads();
    XcdBarrier bar; bar.bar = (unsigned*)(ctl + CW_BAR); bar.x = 0; bar.st = nullptr;
    if (kargs()->use_bar) bar = xcd_barrier_post((unsigned*)(ctl + CW_BAR), MISC + 8);
    const int lo = kargs()->ph_lo, hi = kargs()->ph_hi;
#ifndef PH_MASK
#define PH_MASK 0xfff
#endif
#ifndef REP_MASK
#define REP_MASK 0
#endif
#define IN(k) (lo <= (k) && (k) < hi)
#define EN(ty) ((PH_MASK >> (ty)) & 1)
#define REPS(ty) (1 + ((REP_MASK >> (ty)) & 1))
#ifndef REP2_MASK
#define REP2_MASK 0
#endif
#define SUB(bit) _Pragma("unroll 1") for (int rep2_ = 0; rep2_ < 1 + ((REP2_MASK >> (bit)) & 1); ++rep2_)
#define SEAM(k) do { if (IN(k) && IN((k) + 1)) xcd_barrier(bar); } while (0)
#define PHASE(ty, k) if (EN(ty) && IN(k)) _Pragma("unroll 1") for (int rep_ = 0; rep_ < REPS(ty); ++rep_)

    PHASE(11, 0) { PH_IDS
        LAS float* scr = ldsf + wave * (64 * 65);
        convert_items(CV_P0_ITEMS, gw, NGW, 0, scr, lane);
        for (int idx = gw * 64 + lane; idx < DEPTH * 4 * 4096; idx += NGW * 64) { const int i = idx & 63, j = (idx >> 6) & 63, ln = idx >> 12;
            WSP(bf16, WS_WAT)[idx] = (bf16)f2bf(INP(6)[(size_t)ln * 4096 + i * 64 + j]); WSP(bf16, WS_WAT + 512 * 1024)[idx] = (bf16)f2bf(INP(8)[(size_t)ln * 4096 + i * 64 + j]); }
        for (int idx = gw * 64 + lane; idx < DEPTH * NE * DM; idx += NGW * 64) { const int k = idx & 1023, e = (idx >> 10) & 31, ll = idx >> 15;
            const float w = INP(21)[ll * DM + k] * INP(22)[((size_t)ll * DM + k) * NE + e]; const unsigned hi = f2bf(w); const float lo = w - __uint_as_float(hi << 16);
            bf16* dst = WSP(bf16, WS_RWB) + (size_t)ll * 2 * NE * DM + e * DM + k; dst[0] = (bf16)hi; dst[NE * DM] = (bf16)f2bf(lo); }
        if (gw == 0) for (int c = lane; c < 256; c += 64) { const float x0 = INP(12)[c], x1 = INP(12)[256 + c], mx = fmaxf(x0, x1), e0 = expf(x0 - mx), e1 = expf(x1 - mx); WSP(float, WS_LB1)[c] = e1 / (e0 + e1); }
        for (int m = gw; m < T; m += NGW) { f32x4 v[4];
#pragma unroll
            for (int j = 0; j < 4; ++j) v[j] = *(const f32x4*)(INP(0) + (size_t)m * DM + 256 * j + 4 * lane);
            emit_xn_dt(v, INP(1), INP(2), WSP(bf16, WS_XN) + (size_t)m * DM, WSP(float, WS_DT) + (size_t)m * 4, lane); }
    }
    SEAM(0);

#pragma unroll 1
    for (int l = 0; l < DEPTH; ++l) {
        const int P = 1 + NPL * l;
        PHASE(0, P) { PH_IDS
            pg8::Gemm g{WSP(bf16, WS_XN), WSP(bf16, WS_WIN) + (size_t)l * DING * DM, T, DING, DM}; pg8::StaticOrder S; S.init(T, DING, G, bx);
            pg8::EpiBf16 E{WSP(bf16, WS_PROJ), DING, nullptr, 0};
            pg8::gemm_phase<pg8::EpiBf16, pg8::StaticOrder, true, true>(lds, g, S, E);
            if (G == 256 && bx >= 64) convert_items(CV_TAIL, (bx - 64) * NWAVES + wave, CV_TAILW, l + 1, ldsf + wave * (64 * 65), lane);
            else if (G != 256) convert_items(CV_TAIL, gw, NGW, l + 1, ldsf + wave * (64 * 65), lane);
            __syncthreads();
        }
        SEAM(P);
#ifndef CV_SLOT_MASK
#define CV_SLOT_MASK 0
#endif
#define CV_SLOT_BEGIN(site, s) TDesc cd_; f32x4 cv_[16]; const int ci_ = CV_TAIL + (s) * NGW + gw; const bool ch_ = ((CV_SLOT_MASK >> (site)) & 1) && ci_ < CV_MOE; if (ch_) { cd_ = cv_moe(l, ci_); tload(cd_, cv_, lane); }
#define LAUNDER_TID int tidu = threadIdx.x; asm volatile("" : "+v"(tidu));
#define CV_SLOT_END() if (ch_) tstore(cd_, cv_, ldsf + wave * (64 * 65), lane); __syncthreads();
        PHASE(1, P + 1) { PH_IDS
            { const int v = vcu, b = v >> 5, ch = v & 31;
                SUB(0)
#pragma unroll 1
                for (int g = 0; g < 2; ++g) { LAUNDER_TID CV_SLOT_BEGIN(0, g) m2_state_unit(WSP(bf16, WS_PROJ), WSP(float, WS_DT), WSP(float, WS_SLOC), WSP(float, WS_DEC), b, ch, g, INP(14) + l * 3072, INP(15) + l * 768, INP(16) + l * 4, INP(17) + l * 4, lds, tidu); CV_SLOT_END() }
                SUB(1)
#pragma unroll 1
                for (int g = 0; g < 2; ++g) { LAUNDER_TID CV_SLOT_BEGIN(1, 2 + g) hg_state_unit(WSP(bf16, WS_PROJ), WSP(float, WS_SLT), WSP(float, WS_DECC), b, ch, g, WSP(float, WS_LB1), l, lds, tidu); CV_SLOT_END() }
                SUB(2)
#pragma unroll 1
                for (int g = 0; g < 2; ++g) { LAUNDER_TID CV_SLOT_BEGIN(2, 4 + g) rg_local_unit(WSP(bf16, WS_PROJ), WSP(float, WS_HLOC), WSP(float, WS_PCUM), WSP(float, WS_RGS), b, ch, g, INP(4) + l * 1024, INP(5) + l * 256, WSP(bf16, WS_WAT) + l * 16384, WSP(bf16, WS_WAT + 512 * 1024) + l * 16384, INP(7) + l * 256, INP(9) + l * 256, INP(10) + l * 256, lds, tidu); CV_SLOT_END() }
            }
            SUB(3) { __syncthreads();
            for (int u = gw; u < 2048; u += NGW) { const int qb = 63 - (u >> 5), bh = u & 31; attn_unit(WSP(bf16, WS_PROJ), WSP(float, WS_ORAW), bh >> 2, bh & 3, qb, (LAS bf16*)(lds + wave * (64 * AVLD * 2)), lane); }
            __syncthreads(); }
        }
        SEAM(P + 1);
        PHASE(2, P + 2) { PH_IDS
            { float* sl = WSP(float, WS_SLOC); const float* dc = WSP(float, WS_DEC); bf16* pb = WSP(bf16, WS_PREVB);
                const int e = (vcu * NTHR + tid) * 2, n = e & 127, p = (e >> 7) & 63, h = (e >> 13) & 3, b = e >> 15;
                if (b < NB) { float r0 = 0.f, r1 = 0.f;
#pragma unroll 8
                    for (int c = 0; c < 32; ++c) { float* a = sl + ((size_t)((b * 32 + c) * 4 + h) * 64 + p) * 128 + n; const float d = dc[(b * 32 + c) * 4 + h];
                        const float s0 = a[0], s1 = a[1]; *(unsigned*)(pb + (a - sl)) = pk2(r0, r1); r0 = d * r0 + s0; r1 = d * r1 + s1; } } }
            { float* sl = WSP(float, WS_SLT); const float* dc = WSP(float, WS_DECC); bf16* pb = WSP(bf16, WS_STB);
                const int e = vcu * NTHR + tid, c = e & 63, v = (e >> 6) & 63, h = (e >> 12) & 3, b = e >> 14;
                if (b < NB) { float r = 0.f;
#pragma unroll 8
                    for (int k = 0; k < 32; ++k) { float* a = sl + ((size_t)((b * 32 + k) * 4 + h) * 64 + v) * 64 + c; const float d = dc[(size_t)((b * 32 + k) * 4 + h) * 64 + c];
                        const float s0 = a[0]; pb[a - sl] = (bf16)f2bf(r); r = d * r + s0; } } }
            { const int e = vcu * NTHR + tid;
                if (e < NB * 256) { const int b = e >> 8, c = e & 255; const float* rs = WSP(float, WS_RGS); float* cy = WSP(float, WS_CARRY); float r = 0.f;
#pragma unroll 8
                    for (int k = 0; k < 32; ++k) { const size_t o = (size_t)(b * 32 + k) * 256 + c; cy[o] = r; r = rs[2 * o] * r + rs[2 * o + 1]; } } }
        }
        SEAM(P + 2);
        PHASE(3, P + 3) { PH_IDS
            { const int v = vcu, b = v >> 5, ch = v & 31;
                SUB(4)
#pragma unroll 1
                for (int g = 0; g < 2; ++g) { LAUNDER_TID m2_out_unit(WSP(bf16, WS_PROJ), WSP(float, WS_DT), WSP(bf16, WS_PREVB), WSP(float, WS_ORAW), b, ch, g, INP(14) + l * 3072, INP(15) + l * 768, INP(16) + l * 4, INP(17) + l * 4, INP(18) + l * 4, lds, tidu); }
                SUB(5)
#pragma unroll 1
                for (int g = 0; g < 2; ++g) { LAUNDER_TID CV_SLOT_BEGIN(3, 6 + g) hg_out_unit(WSP(bf16, WS_PROJ), WSP(bf16, WS_STB), WSP(float, WS_ORAW), b, ch, g, WSP(float, WS_LB1), l, lds, tidu); CV_SLOT_END() }
                SUB(6)
                { CV_SLOT_BEGIN(4, 8)
                    const float* hl = WSP(float, WS_HLOC); const float* pc = WSP(float, WS_PCUM); const float* cy = WSP(float, WS_CARRY); const bf16* pj = WSP(bf16, WS_PROJ); float* orw = WSP(float, WS_ORAW);
                    _Pragma("unroll 1") for (int r = 0; r < 8; ++r) { const int m = v * 64 + wave * 8 + r, c = 4 * lane; const size_t cb = (size_t)v * 256 + c;
                        const f32x4 hv = *(const f32x4*)(hl + (size_t)m * 256 + c), pv = *(const f32x4*)(pc + (size_t)m * 256 + c), cv = *(const f32x4*)(cy + cb);
                        const u32x2 gwd = *(const u32x2*)(pj + (size_t)m * DING + C_RGG + c);
                        f32x4 o = hv + pv * cv; o[0] *= gelu_tanh(bflo(gwd.x)); o[1] *= gelu_tanh(bfhi(gwd.x)); o[2] *= gelu_tanh(bflo(gwd.y)); o[3] *= gelu_tanh(bfhi(gwd.y));
                        *(f32x4*)(orw + (size_t)m * DM + 256 + c) = o; }
                    CV_SLOT_END()
                }
                _Pragma("unroll 1") for (int r = 0; r < 8; ++r) { const int m = v * 64 + wave * 8 + r;
                    norm_row(WSP(float, WS_ORAW) + (size_t)m * DM, WSP(bf16, WS_PROJ) + (size_t)m * DING, WSP(bf16, WS_MIX) + (size_t)m * DM, INP(3) + l * 256, INP(11) + l * 256, INP(13) + l * 256, INP(19) + l * 256, lane); }
            }
        }
        SEAM(P + 3);
        PHASE(5, P + 5) { PH_IDS
            pg8::Gemm g{WSP(bf16, WS_MIX), WSP(bf16, WS_WOUT) + (size_t)l * DM * DM, T, DM, DM}; pg8::StaticOrder S; S.init(T, DM, G, bx);
            if (l == 0) { pg8::EpiResBf16<true> E{INP(0), WSP(bf16, WS_H1), DM}; pg8::gemm_phase<pg8::EpiResBf16<true>, pg8::StaticOrder, true, true>(lds, g, S, E); }
            else { pg8::EpiResBf16<false> E{WSP(bf16, WS_HB), WSP(bf16, WS_H1), DM}; pg8::gemm_phase<pg8::EpiResBf16<false>, pg8::StaticOrder, true, true>(lds, g, S, E); }
        }
        SEAM(P + 5);
        PHASE(6, P + 6) { PH_IDS
            constexpr int WLD = 1032;
            LAS bf16* WB = (LAS bf16*)lds; LAS float* LG = (LAS float*)(lds + 2 * 32 * WLD * 2); LAS float* SS = LG + 64 * 33; LAS float* RS = SS + 64;
            { const bf16* src = WSP(bf16, WS_RWB) + (size_t)l * 2 * 32 * 1024; v4u wv[16];
#pragma unroll
                for (int i = 0; i < 16; ++i) wv[i] = *(const v4u*)(src + (size_t)(tid + NTHR * i) * 8);
#pragma unroll
                for (int i = 0; i < 16; ++i) { const int c = tid + NTHR * i; *(LAS v4u*)(WB + (c >> 7) * WLD + (c & 127) * 8) = wv[i]; } }
            __syncthreads();
            const bf16* h1 = WSP(bf16, WS_H1);
            { const int rt = wave >> 1, et = wave & 1; const bf16* hp = h1 + (size_t)(vcu * 64 + rt * 16 + (lane & 15)) * DM + 8 * (lane >> 4);
                f32x4 acc = {0.f, 0.f, 0.f, 0.f}; float ssum = 0.f;
#pragma unroll 8
                for (int ks = 0; ks < 32; ++ks) { const bf16x8 a = *(const bf16x8*)(hp + 32 * ks);
                    acc = MFMA16(a, frag_kc(WB, WLD, et * 16, 32 * ks, lane), acc); acc = MFMA16(a, frag_kc(WB + 32 * WLD, WLD, et * 16, 32 * ks, lane), acc);
                    const v4u aw = __builtin_bit_cast(v4u, a);
#pragma unroll
                    for (int i = 0; i < 4; ++i) { const float x0 = bflo(aw[i]), x1 = bfhi(aw[i]); ssum += x0 * x0 + x1 * x1; } }
                ssum += __shfl_xor(ssum, 16); ssum += __shfl_xor(ssum, 32);
                if (et == 0 && lane < 16) SS[rt * 16 + lane] = ssum;
#pragma unroll
                for (int i = 0; i < 4; ++i) LG[(rt * 16 + 4 * (lane >> 4) + i) * 33 + et * 16 + (lane & 15)] = acc[i]; }
            __syncthreads();
            if (wave == 0) { const int row = lane; const float rstd = 1.0f / sqrtf(SS[row] * (1.0f / DM) + EPS); RS[row] = rstd;
                const float* rb = INP(23) + l * NE;
                float lg[32];
#pragma unroll
                for (int e = 0; e < 32; ++e) lg[e] = rstd * LG[row * 33 + e] + rb[e];
                int be[4]; float bl[4];
#pragma unroll
                for (int r = 0; r < 4; ++r) { float best = -INFINITY; int bi = 0;
#pragma unroll
                    for (int e = 0; e < 32; ++e) if (lg[e] > best) { best = lg[e]; bi = e; }
#pragma unroll
                    for (int e = 0; e < 32; ++e) if (e == bi) lg[e] = -INFINITY;
                    be[r] = bi; bl[r] = best; }
                const float e1 = expf(bl[1] - bl[0]), e2 = expf(bl[2] - bl[0]), e3 = expf(bl[3] - bl[0]), inv = 1.0f / (1.0f + e1 + e2 + e3);
                int rk0 = 0, rk1 = 0, rk2 = 0, rk3 = 0, hist = 0; const unsigned long long lt = (1ull << lane) - 1ull;
#pragma unroll
                for (int e = 0; e < 32; ++e) { const bool h0 = be[0] == e, h1b = be[1] == e, h2 = be[2] == e, h3 = be[3] == e; const unsigned long long m = __ballot(h0 | h1b | h2 | h3);
                    const int below = __popcll(m & lt); rk0 = h0 ? below : rk0; rk1 = h1b ? below : rk1; rk2 = h2 ? below : rk2; rk3 = h3 ? below : rk3; if (lane == e) hist = __popcll(m); }
                if (lane < 32) WSP(int, WS_HIST)[(size_t)vcu * 32 + lane] = hist;
                const int a = (vcu * 64 + row) * 4;
                *(int4*)(WSP(int, WS_ASGE) + a) = make_int4(be[0], be[1], be[2], be[3]); *(int4*)(WSP(int, WS_ASGP) + a) = make_int4(rk0, rk1, rk2, rk3);
                *(f32x4*)(WSP(float, WS_GATE) + a) = (f32x4){inv, e1 * inv, e2 * inv, e3 * inv}; }
            __syncthreads();
            { const float* g = INP(21) + l * DM; bf16* xn = WSP(bf16, WS_XN);
#pragma unroll
                for (int r = 0; r < 8; ++r) { const int row = wave * 8 + r; const size_t m = (size_t)vcu * 64 + row; const float rstd = RS[row];
#pragma unroll
                    for (int j = 0; j < 2; ++j) { const int col = 512 * j + 8 * lane; const v4u w = *(const v4u*)(h1 + m * DM + col); const f32x4 g0 = *(const f32x4*)(g + col), g1 = *(const f32x4*)(g + col + 4);
                        v4u o; o.x = pk2(bflo(w.x) * rstd * g0[0], bfhi(w.x) * rstd * g0[1]); o.y = pk2(bflo(w.y) * rstd * g0[2], bfhi(w.y) * rstd * g0[3]);
                        o.z = pk2(bflo(w.z) * rstd * g1[0], bfhi(w.z) * rstd * g1[1]); o.w = pk2(bflo(w.w) * rstd * g1[2], bfhi(w.w) * rstd * g1[3]);
                        *(v4u*)(xn + m * DM + col) = o; } } }
        }
        SEAM(P + 6);
        PHASE(7, P + 7) { PH_IDS
            LAS int* bs = (LAS int*)(lds + 131072);
            if (tid < 32) { const int* hs = WSP(int, WS_HIST); int base = 0, tot = 0;
#pragma unroll 8
                for (int w = 0; w < G; ++w) { const int c = hs[w * 32 + tid]; tot += c; if (w < vcu) base += c; }
                bs[tid] = base; bs[32 + tid] = tot; if (vcu == 0) WSP(int, WS_TOT)[tid] = tot; }
            __syncthreads();
            if (tid == 0) { int run = 0; for (int e = 0; e < 32; ++e) { tb[e] = run; run += (bs[32 + e] + 255) >> 8; } tb[32] = run; }
            __syncthreads();
            const int* asge = WSP(int, WS_ASGE); const int* asgp = WSP(int, WS_ASGP); int* slotp = WSP(int, WS_SLOT); int* toks = (int*)(kargs()->ws + WS_CTL + CTL_TOKS) + (size_t)l * MAXSLOT;
            if (tid < 256) { const int a = vcu * 256 + tid; const int e = asge[a], slot = tb[e] * 256 + bs[e] + asgp[a]; slotp[a] = slot; toks[slot] = a >> 2; }
        }
        SEAM(P + 7);
        PHASE(8, P + 8) { PH_IDS
            build_tb(WSP(int, WS_TOT), tb, tid);
            LAS int* tokl = (LAS int*)(lds + 131072);
            pg8::MoeOrder S{(const LAS int*)tb, 8, G, bx, (const LAS int*)tokl};
            { const int* toks = (const int*)(kargs()->ws + WS_CTL + CTL_TOKS) + (size_t)l * MAXSLOT; pg8::Unit u;
                for (int i = 0; i < 15 && S.next(i, u); ++i) if (tid < 256) tokl[i * 256 + tid] = toks[u.pm * 256 + tid];
                __syncthreads(); }
            pg8::Gemm g{WSP(bf16, WS_XN), WSP(bf16, WS_WGU) + (size_t)l * NE * 2048 * DM, T, 2048, DM};
            pg8::EpiSwiglu E{WSP(bf16, WS_ACT), INP(25) + (size_t)l * NE * 2048};
            pg8::gemm_phase<pg8::EpiSwiglu, pg8::MoeOrder, true, true>(lds, g, S, E);
        }
        SEAM(P + 8);
        PHASE(9, P + 9) { PH_IDS
            build_tb(WSP(int, WS_TOT), tb, tid);
            pg8::Gemm g{WSP(bf16, WS_ACT), WSP(bf16, WS_WDN) + (size_t)l * NE * DM * DFF, MAXSLOT, DM, DFF}; pg8::MoeOrder S{(const LAS int*)tb, 4, G, bx};
            pg8::EpiBf16 E{WSP(bf16, WS_Y), DM, INP(27) + (size_t)l * NE * DM, DM};
            pg8::gemm_phase<pg8::EpiBf16, pg8::MoeOrder, true, true>(lds, g, S, E);
        }
        SEAM(P + 9);
        PHASE(10, P + 10) { PH_IDS
            const bf16* h1 = WSP(bf16, WS_H1); const int* slotp = WSP(int, WS_SLOT); const float* gatep = WSP(float, WS_GATE); const bf16* yb = WSP(bf16, WS_Y);
            for (int m = gw; m < T; m += NGW) { f32x4 v[4];
#pragma unroll
                for (int j = 0; j < 4; ++j) { const u32x2 w = *(const u32x2*)(h1 + (size_t)m * DM + 256 * j + 4 * lane); v[j] = (f32x4){bflo(w.x), bfhi(w.x), bflo(w.y), bfhi(w.y)}; }
#pragma unroll
                for (int r = 0; r < 4; ++r) { const int slot = slotp[m * 4 + r]; const float gg = gatep[m * 4 + r]; const bf16* yr = yb + (size_t)slot * DM;
#pragma unroll
                    for (int j = 0; j < 4; ++j) { const u32x2 w = *(const u32x2*)(yr + 256 * j + 4 * lane); v[j][0] += gg * bflo(w.x); v[j][1] += gg * bfhi(w.x); v[j][2] += gg * bflo(w.y); v[j][3] += gg * bfhi(w.y); } }
                if (l + 1 < DEPTH) {
#pragma unroll
                    for (int j = 0; j < 4; ++j) { u32x2 w; w.x = pk2(v[j][0], v[j][1]); w.y = pk2(v[j][2], v[j][3]); *(u32x2*)(WSP(bf16, WS_HB) + (size_t)m * DM + 256 * j + 4 * lane) = w; }
                    emit_xn_dt(v, INP(1) + (l + 1) * DM, INP(2) + (size_t)(l + 1) * DM * DIN, WSP(bf16, WS_XN) + (size_t)m * DM, WSP(float, WS_DT) + (size_t)m * 4, lane);
                } else { float ss = 0.f;
#pragma unroll
                    for (int j = 0; j < 4; ++j) ss += (v[j][0] * v[j][0] + v[j][1] * v[j][1]) + (v[j][2] * v[j][2] + v[j][3] * v[j][3]);
                    ss = wave_sum(ss); const float rstd = 1.0f / sqrtf(ss * (1.0f / DM) + EPS);
#pragma unroll
                    for (int j = 0; j < 4; ++j) *(f32x4*)(kargs()->out + (size_t)m * DM + 256 * j + 4 * lane) = v[j] * rstd * *(const f32x4*)(INP(28) + 256 * j + 4 * lane); }
            }
        }
        if (l + 1 < DEPTH) SEAM(P + 10);
    }
#undef IN
#undef SEAM
}

extern "C" void kernel_launch(void* const* d_in, const int* in_sizes, int n_in, void* d_out, int out_size, void* d_ws, size_t ws_size, hipStream_t stream) {
    static int grid = 0;
    if (grid == 0) {
        if (n_in != 29 || in_sizes[0] != T * DM || out_size != T * DM || ws_size < WS_END) { fprintf(stderr, "kernel_launch: unexpected shapes (n_in %d, in0 %d, out %d, ws %zu); nothing launched\n", n_in, n_in > 0 ? in_sizes[0] : -1, out_size, ws_size); grid = -1; return; }
        int dev = 0, cus = 0, per_cu = 0;
        if (hipGetDevice(&dev) != hipSuccess || hipDeviceGetAttribute(&cus, hipDeviceAttributeMultiprocessorCount, dev) != hipSuccess) { grid = -1; return; }
        if (hipFuncSetAttribute((const void*)fwd_kernel, hipFuncAttributeMaxDynamicSharedMemorySize, LDS_BYTES) != hipSuccess) { fprintf(stderr, "kernel_launch: hipFuncSetAttribute failed\n"); grid = -1; return; }
        if (hipOccupancyMaxActiveBlocksPerMultiprocessor(&per_cu, (const void*)fwd_kernel, NTHR, LDS_BYTES) != hipSuccess || per_cu < 1) fprintf(stderr, "kernel_launch: occupancy query reports %d\n", per_cu);
        (void)hipGetLastError();
        grid = cus;
    }
    if (grid < 0) return;
    if (hipMemsetAsync((char*)d_ws + WS_CTL, 0, CTL_ZERO_BYTES, stream) != hipSuccess) { fprintf(stderr, "kernel_launch: memset failed\n"); return; }
    Args a{};
    for (int i = 0; i < 29; ++i) a.in[i] = (const float*)d_in[i];
    a.out = (float*)d_out; a.ws = (unsigned char*)d_ws;
#if MK_N_LAUNCHES == 1
    a.ph_lo = 0; a.ph_hi = NPHASE; a.use_bar = 1;
    hipLaunchKernelGGL(fwd_kernel, dim3(grid), dim3(NTHR), LDS_BYTES, stream, a);
#else
    for (int p = 0; p < NPHASE; ++p) { a.ph_lo = p; a.ph_hi = p + 1; a.use_bar = 0; hipLaunchKernelGGL(fwd_kernel, dim3(grid), dim3(NTHR), LDS_BYTES, stream, a); }
#endif
}
```

```cpp
#include <hip/hip_runtime.h>
#include <cstdio>
#include <cstdint>

#ifndef MK_N_LAUNCHES
#define MK_N_LAUNCHES 1
#endif

constexpr int NB = 8, SEQ = 2048, DM = 1024, T = NB * SEQ, DEPTH = 2;
constexpr int DIN = 3332, DING = 3328;
constexpr int NE = 32, TOPK = 4, DFF = 1024;
constexpr int NASG = T * TOPK;
constexpr int MAXSLOT = NASG + NE * 256;
constexpr float EPS = 1e-6f;
constexpr int C_SBQ = 0, C_SBK = 256, C_SBV = 512, C_RGX = 768, C_RGG = 1024, C_HGQ = 1280, C_HGF = 1536, C_HGI = 1792, C_HGG = 2048,
              C_M2Z = 2304, C_M2X = 2560, C_DT = 3328;
constexpr int NWAVES = 8, NTHR = 512;

constexpr size_t MiB = 1u << 20;
constexpr size_t WS_CTL = 0, CTL_ZERO_BYTES = 1 * MiB;
constexpr size_t WS_WIN = 2 * MiB;
constexpr size_t WS_WOUT = 16 * MiB;
constexpr size_t WS_WGU = 32 * MiB;
constexpr size_t WS_WDN = 288 * MiB;
constexpr size_t WS_XN = 416 * MiB;
constexpr size_t WS_PROJ = 448 * MiB;
constexpr size_t WS_ORAW = 552 * MiB;
constexpr size_t WS_MIX = 616 * MiB;
constexpr size_t WS_H1 = 648 * MiB;
constexpr size_t WS_HB = 712 * MiB;
constexpr size_t WS_XS = 776 * MiB;
constexpr size_t WS_ACT = 920 * MiB;
constexpr size_t WS_Y = 1064 * MiB;
constexpr size_t WS_DT = 1208 * MiB;
constexpr size_t WS_ASGE = 1209 * MiB;
constexpr size_t WS_ASGP = 1210 * MiB;
constexpr size_t WS_GATE = 1211 * MiB;
constexpr size_t WS_SLOT = 1212 * MiB;
constexpr size_t WS_SLOC = 1216 * MiB;
constexpr size_t WS_DEC = 1248 * MiB;
constexpr size_t WS_SLT = 1250 * MiB;
constexpr size_t WS_DECC = 1266 * MiB;
constexpr size_t WS_HLOC = 1268 * MiB;
constexpr size_t WS_PCUM = 1284 * MiB;
constexpr size_t WS_RGS = 1300 * MiB;
constexpr size_t WS_CARRY = 1301 * MiB;
constexpr size_t WS_WAT = 1302 * MiB;
constexpr size_t WS_HIST = 1303 * MiB;
constexpr size_t WS_TOT = WS_HIST + 512 * 1024;
constexpr size_t WS_LB1 = WS_HIST + 768 * 1024;
constexpr size_t WS_PREVB = 1304 * MiB;
constexpr size_t WS_STB = 1320 * MiB;
constexpr size_t WS_RWB = 1328 * MiB;
constexpr size_t WS_END = 1329 * MiB;
constexpr int CW_TMO = 0, CW_CODE = 1;
constexpr int CW_CNT = 256;
constexpr int CW_BAR = 4096;
constexpr size_t CTL_TOKS = 256 * 1024;

constexpr int LDS_BYTES = 147456;
constexpr int LDSCTL_OFF = LDS_BYTES - 1024;
constexpr int MISC_OFF = LDSCTL_OFF;
constexpr int TB_OFF = LDSCTL_OFF + 256;

namespace pg8 {
#define PG8_LAS __attribute__((address_space(3)))
typedef unsigned short bf16_t;
typedef short bf16x8 __attribute__((ext_vector_type(8)));
typedef float f32x4 __attribute__((ext_vector_type(4)));
typedef unsigned u32x4 __attribute__((ext_vector_type(4)));
constexpr int BM = 256, BK = 64, HALF = 128, HTB = HALF * BK * 2  , STAGE_BYTES = 8 * HTB, NXCD = 8, WGM = 8;

__host__ __device__ __forceinline__ int lds_byte(int r, int c) { const int st = (r >> 4) * 2 + (c >> 5), rr = r & 15, cc = c & 31, ob = rr * 64 + cc * 2; return st * 1024 + (ob ^ (((ob >> 9) & 1) << 5)); }
__host__ __device__ __forceinline__ void stage_rc(int b, int& R, int& C) { const int st = b / 1024, sb = b % 1024, swz = sb ^ (((sb >> 9) & 1) << 5); R = (st >> 1) * 16 + swz / 64; C = (st & 1) * 32 + (swz % 64) / 2; }
__host__ __device__ __forceinline__ int perm32(int rho) { const int n = rho >> 4, i = rho & 15; return 8 * (i >> 2) + 4 * n + (i & 3); }

struct Unit { int pm, pn, pb, e, ui; };
struct Gemm { const bf16_t* A; const bf16_t* Bt; int M, N, K; };

__host__ __device__ __forceinline__ int xcd_remap(int wgid, int nwg) { const int q = nwg / NXCD, r = nwg % NXCD, xcd = wgid % NXCD, off = wgid / NXCD; return (xcd < r ? xcd * (q + 1) : r * (q + 1) + (xcd - r) * q) + off; }

struct StaticOrder {
    int nM, nN, nwg, G, c;
    __host__ __device__ void init(int M, int N, int G_, int c_) { nM = M / BM; nN = N / BM; nwg = nM * nN; G = G_; c = c_; }
    __host__ __device__ bool next(int i, Unit& u) const {
        const long L = (long)i * G + c; if (L >= nwg) return false;
        const int wgid = xcd_remap((int)L, nwg);
        const int nig = WGM * nN, gid = wgid / nig, fm = gid * WGM, gsz = (nM - fm) < WGM ? (nM - fm) : WGM;
        u.pm = fm + ((wgid % nig) % gsz); u.pn = (wgid % nig) / gsz; u.pb = u.pn; u.e = 0; u.ui = i; return true;
    }
    __device__ __forceinline__ void a_ready(const Unit&) const {}
    __device__ __forceinline__ void done(const Unit&) const {}
    __device__ __forceinline__ size_t a_base(const Unit& u, size_t tstep) const { return (size_t)u.pm * tstep; }
    __device__ __forceinline__ unsigned a_off(const Unit&, int r, int K) const { return (unsigned)(r * K) * 2u; }
};
struct MoeOrder {
    const PG8_LAS int* tb; int NP, G, c; const PG8_LAS int* tokl;
    __device__ __forceinline__ bool next(int i, Unit& u) const {
        const int ntot = tb[32], nunits = ntot * NP;
        const long L = (long)i * G + c; if (L >= nunits) return false;
        const int id = xcd_remap((int)L, nunits);
        int e = 0;
        for (int j = 1; j < 32; ++j) if (id >= tb[j] * NP) e = j;
        e = __builtin_amdgcn_readfirstlane(e);
        const int t0 = tb[e], nt = tb[e + 1] - t0, rem = id - t0 * NP;
        u.pm = __builtin_amdgcn_readfirstlane(t0 + rem % nt); u.pn = __builtin_amdgcn_readfirstlane(rem / nt); u.pb = e * NP + u.pn; u.e = e; u.ui = i; return true;
    }
    __device__ __forceinline__ void a_ready(const Unit&) const {}
    __device__ __forceinline__ void done(const Unit&) const {}
    __device__ __forceinline__ size_t a_base(const Unit& u, size_t tstep) const { return tokl ? (size_t)0 : (size_t)u.pm * tstep; }
    __device__ __forceinline__ unsigned a_off(const Unit& u, int r, int K) const { return tokl ? (unsigned)(tokl[u.ui * 256 + r] * K) * 2u : (unsigned)(r * K) * 2u; }
};

__device__ __forceinline__ unsigned cvt_pk_bf16(float lo, float hi) { unsigned r; asm volatile("v_cvt_pk_bf16_f32 %0, %1, %2" : "=v"(r) : "v"(lo), "v"(hi)); return r; }

struct EpiBf16 {
    static constexpr bool PERM = true, AFTER_DRAIN = false;
    bf16_t* O; int ldc; const float* bias; int bias_estride;
    __device__ __forceinline__ void operator()(const f32x4 (&acc)[2][2][4][2], const Unit& u, int wr, int wc, int fr, int fq) const {
        const int row0 = u.pm * BM + wr * 64 + fr; const int col0 = u.pn * BM + wc * 32 + 8 * fq;
        f32x4 bv[2][2];
#pragma unroll
        for (int bj = 0; bj < 2; ++bj)
#pragma unroll
            for (int n = 0; n < 2; ++n) bv[bj][n] = bias ? *(const f32x4*)(bias + (size_t)u.e * bias_estride + col0 + bj * HALF + 4 * n) : (f32x4){0.f, 0.f, 0.f, 0.f};
#pragma unroll
        for (int ai = 0; ai < 2; ++ai)
#pragma unroll
            for (int m = 0; m < 4; ++m) { bf16_t* rowp = O + (size_t)(row0 + ai * HALF + m * 16) * ldc + col0;
#pragma unroll
                for (int bj = 0; bj < 2; ++bj) { const f32x4 v0 = acc[ai][bj][m][0] + bv[bj][0], v1 = acc[ai][bj][m][1] + bv[bj][1];
                    u32x4 w; w.x = cvt_pk_bf16(v0[0], v0[1]); w.y = cvt_pk_bf16(v0[2], v0[3]); w.z = cvt_pk_bf16(v1[0], v1[1]); w.w = cvt_pk_bf16(v1[2], v1[3]);
                    *(u32x4*)(rowp + bj * HALF) = w; } }
    }
};
template <bool BASE_F32> struct EpiResBf16 {
    static constexpr bool PERM = true, AFTER_DRAIN = false;
    const void* base; bf16_t* out; int ldc;
    __device__ __forceinline__ void operator()(const f32x4 (&acc)[2][2][4][2], const Unit& u, int wr, int wc, int fr, int fq) const {
        const int row0 = u.pm * BM + wr * 64 + fr, col0 = u.pn * BM + wc * 32 + 8 * fq;
#pragma unroll
        for (int ai = 0; ai < 2; ++ai)
#pragma unroll
            for (int m = 0; m < 4; ++m) { const size_t off = (size_t)(row0 + ai * HALF + m * 16) * ldc + col0;
#pragma unroll
                for (int bj = 0; bj < 2; ++bj) { f32x4 b0, b1;
                    if (BASE_F32) { const float* bp = (const float*)base + off + bj * HALF; b0 = *(const f32x4*)bp; b1 = *(const f32x4*)(bp + 4); }
                    else { const u32x4 w = *(const u32x4*)((const bf16_t*)base + off + bj * HALF);
                        b0 = (f32x4){__uint_as_float(w.x << 16), __uint_as_float(w.x & 0xffff0000u), __uint_as_float(w.y << 16), __uint_as_float(w.y & 0xffff0000u)};
                        b1 = (f32x4){__uint_as_float(w.z << 16), __uint_as_float(w.z & 0xffff0000u), __uint_as_float(w.w << 16), __uint_as_float(w.w & 0xffff0000u)}; }
                    const f32x4 v0 = b0 + acc[ai][bj][m][0], v1 = b1 + acc[ai][bj][m][1];
                    u32x4 o; o.x = cvt_pk_bf16(v0[0], v0[1]); o.y = cvt_pk_bf16(v0[2], v0[3]); o.z = cvt_pk_bf16(v1[0], v1[1]); o.w = cvt_pk_bf16(v1[2], v1[3]);
                    *(u32x4*)(out + off + bj * HALF) = o; } }
    }
};
struct EpiSwiglu {
    static constexpr bool PERM = true, AFTER_DRAIN = false;
    bf16_t* O; const float* bias;
    __device__ __forceinline__ void operator()(const f32x4 (&acc)[2][2][4][2], const Unit& u, int wr, int wc, int fr, int fq) const {
        const int row0 = u.pm * BM + wr * 64 + fr; const int a0 = u.pn * HALF + wc * 32 + 8 * fq;
        const float* bp = bias + (size_t)u.e * 2048 + 2 * a0;
        f32x4 b4[4];
#pragma unroll
        for (int j = 0; j < 4; ++j) b4[j] = *(const f32x4*)(bp + 4 * j);
#pragma unroll
        for (int ai = 0; ai < 2; ++ai)
#pragma unroll
            for (int m = 0; m < 4; ++m) { bf16_t* rowp = O + (size_t)(row0 + ai * HALF + m * 16) * 1024 + a0;
                float a[8];
#pragma unroll
                for (int n = 0; n < 2; ++n)
#pragma unroll
                    for (int i = 0; i < 4; ++i) { const int k = 4 * n + i;
                        float g = acc[ai][0][m][n][i] + b4[k >> 1][2 * (k & 1)], l = acc[ai][1][m][n][i] + b4[k >> 1][2 * (k & 1) + 1];
                        g = fminf(g, 7.0f); l = fminf(fmaxf(l, -7.0f), 7.0f);
                        const float sg = __builtin_amdgcn_rcpf(1.0f + __builtin_amdgcn_exp2f(-1.702f * 1.4426950408889634f * g));
                        a[k] = g * sg * (l + 1.0f); }
                u32x4 w; w.x = cvt_pk_bf16(a[0], a[1]); w.y = cvt_pk_bf16(a[2], a[3]); w.z = cvt_pk_bf16(a[4], a[5]); w.w = cvt_pk_bf16(a[6], a[7]);
                *(u32x4*)rowp = w; }
    }
};

template <class Epi, class Sched, bool ALIGN_EPI = false, bool SP2 = false>
__device__ __forceinline__ void gemm_phase(PG8_LAS unsigned char* lds, const Gemm g, const Sched& S, const Epi& E) {
    int tid = threadIdx.x; asm volatile("" : "+v"(tid));
    const int wid = __builtin_amdgcn_readfirstlane(tid >> 6), lane = tid & 63, wr = wid >> 2, wc = wid & 3, fr = lane & 15, fq = lane >> 4;
    const int K = g.K, nt = K / BK;
    unsigned vAc[2][2], vAn[2][2], voffB[2];
    int sR[2], sC[2];
#pragma unroll
    for (int i = 0; i < 2; ++i) { int R, C; stage_rc(tid * 16 + i * 8192, R, C); const int Rb = Epi::PERM ? ((R & ~31) + perm32(R & 31)) : R;
        sR[i] = R; sC[i] = C; voffB[i] = (unsigned)(Rb * K + C) * 2u; }
    const size_t kstep = (size_t)(BK * 2);
    const size_t hstep = (size_t)HALF * K * 2;
    const size_t tstep = 2 * hstep;
    const unsigned ldsw = (unsigned)wid * 1024u;
    const int aoff = lds_byte(wr * 64 + fr, fq * 8), boff = lds_byte(wc * 32 + fr, fq * 8);
#define PG8_SA(b, h) (((b) * 2 + (h)) * HTB)
#define PG8_SB(b, h) ((4 + (b) * 2 + (h)) * HTB)
#define PG8_STAGE(bufoff, gbase, voff) do { _Pragma("unroll") for (int _i = 0; _i < 2; ++_i) \
        __builtin_amdgcn_global_load_lds((const unsigned*)((const char*)(gbase) + (voff)[_i]), (PG8_LAS unsigned*)(lds + (bufoff) + ldsw + _i * 8192), 16, 0, 0); } while (0)
#define PG8_LDA(dst, b, h) do { _Pragma("unroll") for (int m = 0; m < 4; ++m) _Pragma("unroll") for (int k = 0; k < 2; ++k) dst[m][k] = *(const PG8_LAS bf16x8*)(lds + PG8_SA(b, h) + aoff + m * 2048 + k * 1024); } while (0)
#define PG8_LDB(dst, b, h) do { _Pragma("unroll") for (int n = 0; n < 2; ++n) _Pragma("unroll") for (int k = 0; k < 2; ++k) dst[n][k] = *(const PG8_LAS bf16x8*)(lds + PG8_SB(b, h) + boff + n * 2048 + k * 1024); } while (0)
#define PG8_MMA(ai, bj, At, Bt) do { __builtin_amdgcn_s_setprio(1); _Pragma("unroll") for (int m = 0; m < 4; ++m) _Pragma("unroll") for (int n = 0; n < 2; ++n) _Pragma("unroll") for (int k = 0; k < 2; ++k) \
        acc[ai][bj][m][n] = __builtin_amdgcn_mfma_f32_16x16x32_bf16(Bt[n][k], At[m][k], acc[ai][bj][m][n], 0, 0, 0); __builtin_amdgcn_s_setprio(0); } while (0)
#define PG8_WAIT_V(n) asm volatile("s_waitcnt vmcnt(" #n ")" ::: "memory")
#define PG8_WAIT_L(n) asm volatile("s_waitcnt lgkmcnt(" #n ")" ::: "memory")
#define PG8_BAR __builtin_amdgcn_s_barrier()
#define PG8_SCHED __builtin_amdgcn_sched_barrier(0)
    Unit cur, nxt; int ui = 0;
    if (!S.next(0, cur)) return;
    f32x4 acc[2][2][4][2];
#pragma unroll
    for (int a = 0; a < 2; ++a)
#pragma unroll
        for (int b = 0; b < 2; ++b)
#pragma unroll
            for (int m = 0; m < 4; ++m)
#pragma unroll
                for (int n = 0; n < 2; ++n) acc[a][b][m][n] = (f32x4){0.f, 0.f, 0.f, 0.f};
    bf16x8 At[4][2], B0[2][2], B1[2][2];
    const char* cA = (const char*)g.A + S.a_base(cur, tstep); const char* cB = (const char*)g.Bt + (size_t)cur.pb * tstep;
#pragma unroll
    for (int h = 0; h < 2; ++h)
#pragma unroll
        for (int i = 0; i < 2; ++i) { vAc[h][i] = S.a_off(cur, h * HALF + sR[i], K) + (unsigned)sC[i] * 2u; vAn[h][i] = vAc[h][i]; }
    S.a_ready(cur);
    if constexpr (SP2) {
        PG8_STAGE(PG8_SB(0, 0), cB, voffB); PG8_STAGE(PG8_SB(0, 1), cB + hstep, voffB); PG8_STAGE(PG8_SA(0, 0), cA, vAc[0]); PG8_STAGE(PG8_SA(0, 1), cA, vAc[1]);
        if (wr == 1) PG8_BAR;
        PG8_WAIT_V(2); PG8_BAR;
        PG8_STAGE(PG8_SB(1, 0), cB + kstep, voffB); PG8_STAGE(PG8_SA(1, 0), cA + kstep, vAc[0]); PG8_STAGE(PG8_SB(1, 1), cB + hstep + kstep, voffB);
        PG8_WAIT_V(6); PG8_BAR;
    } else {
        PG8_STAGE(PG8_SB(0, 0), cB, voffB); PG8_STAGE(PG8_SA(0, 0), cA, vAc[0]); PG8_STAGE(PG8_SB(0, 1), cB + hstep, voffB); PG8_STAGE(PG8_SA(0, 1), cA, vAc[1]);
        if (wr == 1) PG8_BAR;
        PG8_WAIT_V(4); PG8_BAR;
        PG8_STAGE(PG8_SB(1, 0), cB + kstep, voffB); PG8_STAGE(PG8_SA(1, 0), cA + kstep, vAc[0]); PG8_STAGE(PG8_SB(1, 1), cB + hstep + kstep, voffB);
        PG8_WAIT_V(6); PG8_BAR;
    }
    for (;;) {
        const bool has_next = S.next(ui + 1, nxt);
        const char* nA = has_next ? (const char*)g.A + S.a_base(nxt, tstep) : cA;
        if (has_next) {
#pragma unroll
            for (int h = 0; h < 2; ++h)
#pragma unroll
                for (int i = 0; i < 2; ++i) vAn[h][i] = S.a_off(nxt, h * HALF + sR[i], K) + (unsigned)sC[i] * 2u; } const char* nB = has_next ? (const char*)g.Bt + (size_t)nxt.pb * tstep : cB;
        for (int t = 0; t < nt; t += 2) {
            const bool last = (t == nt - 2);
            const char* a1 = cA + (size_t)(t + 1) * kstep;
            const char* a2 = last ? nA : cA + (size_t)(t + 2) * kstep; const char* b2 = last ? nB : cB + (size_t)(t + 2) * kstep;
            const char* a3 = a2 + kstep; const char* b3 = b2 + kstep;
            unsigned v2[2][2];
#pragma unroll
            for (int h = 0; h < 2; ++h)
#pragma unroll
                for (int i = 0; i < 2; ++i) v2[h][i] = last ? vAn[h][i] : vAc[h][i];
            if (last && has_next) S.a_ready(nxt);
            if constexpr (SP2) {
            PG8_LDB(B0, 0, 0); PG8_LDB(B1, 0, 1); PG8_SCHED; PG8_LDA(At, 0, 0); PG8_STAGE(PG8_SA(1, 1), a1, vAc[1]);
            PG8_WAIT_V(8); PG8_WAIT_L(0); PG8_BAR; PG8_MMA(0, 0, At, B0); PG8_MMA(0, 1, At, B1); PG8_BAR; PG8_SCHED;
            PG8_LDA(At, 0, 1); PG8_STAGE(PG8_SB(0, 0), b2, voffB); PG8_STAGE(PG8_SB(0, 1), b2 + hstep, voffB); PG8_STAGE(PG8_SA(0, 0), a2, v2[0]);
            PG8_WAIT_V(8); PG8_WAIT_L(0); PG8_BAR; PG8_MMA(1, 0, At, B0); PG8_MMA(1, 1, At, B1); PG8_BAR; PG8_SCHED;
            PG8_LDB(B0, 1, 0); PG8_LDB(B1, 1, 1); PG8_SCHED; PG8_LDA(At, 1, 0); PG8_STAGE(PG8_SA(0, 1), a2, v2[1]);
            PG8_WAIT_V(8); PG8_WAIT_L(0); PG8_BAR; PG8_MMA(0, 0, At, B0); PG8_MMA(0, 1, At, B1); PG8_BAR; PG8_SCHED;
            PG8_LDA(At, 1, 1); PG8_STAGE(PG8_SB(1, 0), b3, voffB); PG8_STAGE(PG8_SB(1, 1), b3 + hstep, voffB); PG8_STAGE(PG8_SA(1, 0), a3, v2[0]);
            PG8_WAIT_V(8); PG8_WAIT_L(0); PG8_BAR; PG8_MMA(1, 0, At, B0); PG8_MMA(1, 1, At, B1); PG8_BAR; PG8_SCHED;
            } else {
            PG8_LDB(B0, 0, 0); PG8_SCHED; PG8_LDA(At, 0, 0); PG8_STAGE(PG8_SA(1, 1), a1, vAc[1]);
            PG8_WAIT_L(8); PG8_BAR; PG8_WAIT_L(0); PG8_MMA(0, 0, At, B0); PG8_BAR; PG8_SCHED;
            PG8_LDB(B1, 0, 1); PG8_STAGE(PG8_SB(0, 0), b2, voffB);
            PG8_BAR; PG8_WAIT_L(0); PG8_MMA(0, 1, At, B1); PG8_BAR;
            PG8_LDA(At, 0, 1); PG8_STAGE(PG8_SA(0, 0), a2, v2[0]);
            PG8_BAR; PG8_WAIT_L(0); PG8_MMA(1, 0, At, B0); PG8_BAR; PG8_SCHED;
            PG8_STAGE(PG8_SB(0, 1), b2 + hstep, voffB);
            PG8_WAIT_V(6); PG8_BAR; PG8_MMA(1, 1, At, B1); PG8_BAR;
            PG8_LDB(B0, 1, 0); PG8_SCHED; PG8_LDA(At, 1, 0); PG8_STAGE(PG8_SA(0, 1), a2, v2[1]);
            PG8_WAIT_L(8); PG8_BAR; PG8_WAIT_L(0); PG8_MMA(0, 0, At, B0); PG8_BAR; PG8_SCHED;
            PG8_LDB(B1, 1, 1); PG8_STAGE(PG8_SB(1, 0), b3, voffB);
            PG8_BAR; PG8_WAIT_L(0); PG8_MMA(0, 1, At, B1); PG8_BAR;
            PG8_LDA(At, 1, 1); PG8_STAGE(PG8_SA(1, 0), a3, v2[0]);
            PG8_BAR; PG8_WAIT_L(0); PG8_MMA(1, 0, At, B0); PG8_BAR; PG8_SCHED;
            PG8_STAGE(PG8_SB(1, 1), b3 + hstep, voffB);
            PG8_WAIT_V(6); PG8_BAR; PG8_MMA(1, 1, At, B1); PG8_BAR;
            }
        }
        if constexpr (ALIGN_EPI) { if (wr == 0) PG8_BAR; }
        if constexpr (!Epi::AFTER_DRAIN) { E(acc, cur, wr, wc, fr, fq); S.done(cur); }
        if (!has_next) break;
#pragma unroll
        for (int a = 0; a < 2; ++a)
#pragma unroll
            for (int b = 0; b < 2; ++b)
#pragma unroll
                for (int m = 0; m < 4; ++m)
#pragma unroll
                    for (int n = 0; n < 2; ++n) acc[a][b][m][n] = (f32x4){0.f, 0.f, 0.f, 0.f};
        cur = nxt; cA = nA; cB = nB; ++ui;
#pragma unroll
        for (int h = 0; h < 2; ++h)
#pragma unroll
            for (int i = 0; i < 2; ++i) vAc[h][i] = vAn[h][i];
        if constexpr (ALIGN_EPI) { if (wr == 1) PG8_BAR; }
    }
    PG8_WAIT_V(0);
    if constexpr (!ALIGN_EPI) { if (wr == 0) PG8_BAR; }
    PG8_BAR;
    if constexpr (Epi::AFTER_DRAIN) { E.fused(acc, cur, wr, wc, fr, fq, lds, wid, lane); S.done(cur); }
#undef PG8_SA
#undef PG8_SB
#undef PG8_STAGE
#undef PG8_LDA
#undef PG8_LDB
#undef PG8_MMA
#undef PG8_WAIT_V
#undef PG8_WAIT_L
#undef PG8_BAR
#undef PG8_SCHED
}
}
#define GAS __attribute__((address_space(1)))
#define LAS __attribute__((address_space(3)))
typedef unsigned short bf16;
typedef unsigned v4u __attribute__((ext_vector_type(4)));
typedef float f32x4 __attribute__((ext_vector_type(4)));
typedef short bf16x8 __attribute__((ext_vector_type(8)));
typedef GAS unsigned gu32;
typedef GAS unsigned long long gu64;
#define RLX_AGENT __ATOMIC_RELAXED, __HIP_MEMORY_SCOPE_AGENT
#define LDS_WAIT() asm volatile("s_waitcnt lgkmcnt(0)" ::: "memory")
#define VM_WAIT() asm volatile("s_waitcnt vmcnt(0)" ::: "memory")
__device__ __forceinline__ unsigned long long rt() { return __builtin_amdgcn_s_memrealtime(); }
__device__ __forceinline__ unsigned f2bf(float f) { unsigned u = __builtin_bit_cast(unsigned, f); return (u + 0x7fffu + ((u >> 16) & 1u)) >> 16; }
__device__ __forceinline__ unsigned pk2(float lo, float hi) { return f2bf(lo) | (f2bf(hi) << 16); }

#define XB_TMO      128
#define XB_XCNT(j)  (256  + 64 * (j))
#define XB_XSUB(j)  (1280 + 64 * (j))
#define XB_XGEN(j)  (2304 + 64 * (j))
#define XB_TOP      3328
#define XB_TOPGEN   3392
#define XCD_BAR_WORDS 3456
#define XB_SPIN_CAP (1u << 18)

__device__ __forceinline__ unsigned xb_ld(unsigned* p)              { return __hip_atomic_load(p, __ATOMIC_RELAXED, __HIP_MEMORY_SCOPE_AGENT); }
__device__ __forceinline__ unsigned xb_add(unsigned* p, unsigned v) { return __hip_atomic_fetch_add(p, v, __ATOMIC_RELAXED, __HIP_MEMORY_SCOPE_AGENT); }
__device__ __forceinline__ unsigned xb_xcc_id() { return (unsigned)__builtin_amdgcn_s_getreg((3 << 11) | 20) & 0xFu; }
#define XB_SPIN(cond, bar) do { unsigned _sp = 0; while (cond) { __builtin_amdgcn_s_sleep(1); \
    if ((++_sp & 255u) == 0u) { if (xb_ld(&(bar)[XB_TMO])) break; if (_sp > XB_SPIN_CAP) { atomicAdd(&(bar)[XB_TMO], 1u); break; } } } } while (0)

struct XcdBarrier {
    unsigned* bar; unsigned x;
    volatile LAS unsigned* st;
};

__device__ __forceinline__ XcdBarrier xcd_barrier_post(unsigned* bar, volatile LAS unsigned* st) {
    XcdBarrier b; b.bar = bar; b.x = xb_xcc_id(); b.st = st;
    if (threadIdx.x == 0) (void)xb_add(&bar[XB_XCNT(b.x)], 1u);
    return b;
}
__device__ __forceinline__ void xcd_barrier_complete(unsigned* bar, unsigned x, unsigned& nloc, unsigned& nx) {
    const unsigned G = gridDim.x * gridDim.y * gridDim.z;
    unsigned sum, cnt, mine, sp = 0u;
    for (;;) {
        sum = 0u; cnt = 0u; mine = 0u;
#pragma unroll
        for (unsigned j = 0; j < 16; ++j) { const unsigned c = xb_ld(&bar[XB_XCNT(j)]); sum += c; cnt += (c > 0u) ? 1u : 0u; mine = (j == x) ? c : mine; }
        if (sum == G) break;
        __builtin_amdgcn_s_sleep(1);
        if ((++sp & 255u) == 0u) { if (xb_ld(&bar[XB_TMO])) break; if (sp > XB_SPIN_CAP) { atomicAdd(&bar[XB_TMO], 1u); break; } }
    }
    nloc = mine > 0u ? mine : 1u; nx = cnt > 0u ? cnt : 1u;
}

__device__ __forceinline__ void xcd_barrier(const XcdBarrier& b) {
    asm volatile("s_waitcnt vmcnt(0)" ::: "memory");
    __syncthreads();
    if (threadIdx.x == 0) {
        unsigned* bar = b.bar;
        __builtin_amdgcn_s_waitcnt(0);
        unsigned nloc = b.st[0], nx = b.st[1];
        if (nloc == 0u) { xcd_barrier_complete(bar, b.x, nloc, nx); b.st[0] = nloc; b.st[1] = nx; }
        const unsigned old = xb_add(&bar[XB_XSUB(b.x)], 1u);
        const unsigned gen = old / nloc;
        if (old + 1u == (gen + 1u) * nloc) {
            __builtin_amdgcn_fence(__ATOMIC_RELEASE, "agent");
            asm volatile("s_waitcnt vmcnt(0)" ::: "memory");
            const unsigned og = xb_add(&bar[XB_TOP], 1u);
            const unsigned tg = og / nx;
            if (og + 1u == (tg + 1u) * nx) xb_add(&bar[XB_TOPGEN], 1u);
            else XB_SPIN(xb_ld(&bar[XB_TOPGEN]) == tg, bar);
            __builtin_amdgcn_fence(__ATOMIC_ACQUIRE, "agent");
            xb_add(&bar[XB_XGEN(b.x)], 1u);
            asm volatile("s_waitcnt vmcnt(0)" ::: "memory");
        } else {
            XB_SPIN(xb_ld(&bar[XB_XGEN(b.x)]) == gen, bar);
            __builtin_amdgcn_fence(__ATOMIC_ACQUIRE, "agent");
            asm volatile("s_waitcnt vmcnt(0)" ::: "memory");
        }
    }
    __syncthreads();
}

using pg8::bf16_t;
typedef unsigned u32x2 __attribute__((ext_vector_type(2)));
__device__ __forceinline__ float bf2f(unsigned v) { return __uint_as_float(v << 16); }
__device__ __forceinline__ float bflo(unsigned w) { return __uint_as_float(w << 16); }
__device__ __forceinline__ float bfhi(unsigned w) { return __uint_as_float(w & 0xffff0000u); }
__device__ __forceinline__ float wave_sum(float v) {
#pragma unroll
    for (int o = 1; o < 64; o <<= 1) v += __shfl_xor(v, o);
    return v;
}
__device__ __forceinline__ float sigm(float x) { return 1.0f / (1.0f + expf(-x)); }
__device__ __forceinline__ float softplusf_(float x) { return fmaxf(x, 0.f) + log1pf(expf(-fabsf(x))); }
__device__ __forceinline__ float gelu_tanh(float x) { const float y = 0.7978845608028654f * (x + 0.044715f * x * x * x);
    return x * __builtin_amdgcn_rcpf(1.0f + __builtin_amdgcn_exp2f(-2.0f * 1.4426950408889634f * y)); }

__device__ __forceinline__ int gu_rowmap(int n) { const int a = n >> 1; return ((a >> 7) << 8) + (a & 127) + ((n & 1) << 7); }
struct TDesc { const float* W; bf16* WT; int ldw, K, k0, n0, gu; };
__device__ __forceinline__ void tload(const TDesc& d, f32x4 (&v)[16], int lane) {
#pragma unroll
    for (int i = 0; i < 16; ++i) v[i] = __builtin_nontemporal_load((const f32x4*)(d.W + (size_t)(d.k0 + 4 * i + (lane >> 4)) * d.ldw + d.n0 + 4 * (lane & 15)));
}
__device__ __forceinline__ void tstore(const TDesc& d, const f32x4 (&v)[16], LAS float* scr, int lane) {
#pragma unroll
    for (int i = 0; i < 16; ++i) { LAS float* p = scr + (4 * i + (lane >> 4)) * 65 + 4 * (lane & 15); p[0] = v[i][0]; p[1] = v[i][1]; p[2] = v[i][2]; p[3] = v[i][3]; }
    LDS_WAIT(); asm volatile("" ::: "memory");
    const int c = lane & 7;
#pragma unroll
    for (int j = 0; j < 8; ++j) { const int n = 8 * j + (lane >> 3); const LAS float* s = scr + (8 * c) * 65 + n;
        v4u o; o.x = pg8::cvt_pk_bf16(s[0], s[65]); o.y = pg8::cvt_pk_bf16(s[130], s[195]); o.z = pg8::cvt_pk_bf16(s[260], s[325]); o.w = pg8::cvt_pk_bf16(s[390], s[455]);
        const int nr = d.gu ? gu_rowmap(d.n0 + n) : (d.n0 + n);
        *(v4u*)(d.WT + (size_t)nr * d.K + d.k0 + 8 * c) = o; }
    LDS_WAIT(); asm volatile("" ::: "memory");
}
constexpr int IT_WIN = 16 * 52, IT_WOUT = 256, IT_GU = 512, IT_DN = 256;
constexpr int NIT_WIN = DEPTH * IT_WIN, NIT_WOUT = DEPTH * IT_WOUT, NIT_GU = DEPTH * NE * IT_GU, NIT_DN = DEPTH * NE * IT_DN, NITEMS = NIT_WIN + NIT_WOUT + NIT_GU + NIT_DN;

__device__ __forceinline__ void emit_xn_dt(const f32x4 (&v)[4], const float* g, const float* win_l, bf16* xn_row, float* dt_row, int lane) {
    float ss = 0.f;
#pragma unroll
    for (int j = 0; j < 4; ++j) ss += (v[j][0] * v[j][0] + v[j][1] * v[j][1]) + (v[j][2] * v[j][2] + v[j][3] * v[j][3]);
    ss = wave_sum(ss);
    const float rstd = 1.0f / sqrtf(ss * (1.0f / DM) + EPS);
    float d0 = 0.f, d1 = 0.f, d2 = 0.f, d3 = 0.f;
#pragma unroll
    for (int j = 0; j < 4; ++j) { const int col = 256 * j + 4 * lane; const f32x4 gg = *(const f32x4*)(g + col); const f32x4 u = v[j] * rstd * gg;
        u32x2 w; w.x = pk2(u[0], u[1]); w.y = pk2(u[2], u[3]); *(u32x2*)(xn_row + col) = w;
#pragma unroll
        for (int i = 0; i < 4; ++i) { const f32x4 ww = *(const f32x4*)(win_l + (size_t)(col + i) * DIN + C_DT); d0 += u[i] * ww[0]; d1 += u[i] * ww[1]; d2 += u[i] * ww[2]; d3 += u[i] * ww[3]; } }
    d0 = wave_sum(d0); d1 = wave_sum(d1); d2 = wave_sum(d2); d3 = wave_sum(d3);
    if (lane == 0) *(f32x4*)dt_row = (f32x4){d0, d1, d2, d3};
}

__device__ __forceinline__ void attn_naive(const bf16* proj, float* oraw, int b, int h, int qb, int lane) {
    const int t = qb * 64 + lane; const size_t row = (size_t)b * SEQ + t;
    int zero; asm volatile("v_mov_b32 %0, 0" : "=v"(zero));
    float q[64], acc[64];
    const bf16* qp = proj + row * DING + C_SBQ + h * 64;
#pragma unroll
    for (int c = 0; c < 8; ++c) { const v4u w = *(const v4u*)(qp + 8 * c);
#pragma unroll
        for (int i = 0; i < 4; ++i) { q[8 * c + 2 * i] = bflo(w[i]) * 0.125f; q[8 * c + 2 * i + 1] = bfhi(w[i]) * 0.125f; } }
#pragma unroll
    for (int d = 0; d < 64; ++d) acc[d] = 0.f;
    float R = 0.f;
    for (int s = qb * 64 + 62; s >= 0; --s) {
        const bf16* kp = proj + ((size_t)b * SEQ + s) * DING + C_SBK + h * 64 + zero;
        float z = 0.f;
#pragma unroll
        for (int c = 0; c < 8; ++c) { const v4u w = *(const v4u*)(kp + 8 * c);
#pragma unroll
            for (int i = 0; i < 4; ++i) { z += q[8 * c + 2 * i] * bflo(w[i]); z += q[8 * c + 2 * i + 1] * bfhi(w[i]); } }
        if (s < t) {
            const float sp = softplusf_(z);
            const float a = expf(z - sp + R);
            R -= sp;
            const bf16* vp = kp + 256;
#pragma unroll
            for (int c = 0; c < 8; ++c) { const v4u w = *(const v4u*)(vp + 8 * c);
#pragma unroll
                for (int i = 0; i < 4; ++i) { acc[8 * c + 2 * i] += a * bflo(w[i]); acc[8 * c + 2 * i + 1] += a * bfhi(w[i]); } }
        }
        if (__all(R < -88.0f)) break;
    }
    float* op = oraw + row * DM + h * 64;
#pragma unroll
    for (int c = 0; c < 16; ++c) *(f32x4*)(op + 4 * c) = (f32x4){acc[4 * c], acc[4 * c + 1], acc[4 * c + 2], acc[4 * c + 3]};
}

__device__ __forceinline__ void rg_chain(const bf16* proj, float* oraw, int b, int n, const float* conv_w, const float* conv_b, const float* wa, const float* ba,
                                         const float* wx, const float* bx, const float* lam, LAS float* L, int tid) {
    LAS float* wa_s = L; LAS float* wx_s = L + 4096; LAS float* xc_s = L + 8192; LAS float* a_s = L + 12288; LAS float* u_s = L + 16384;
    const int j = tid & 63, tr = tid >> 6, c = n * 64 + j;
    for (int idx = tid; idx < 4096; idx += NTHR) { wa_s[idx] = wa[n * 4096 + idx]; wx_s[idx] = wx[n * 4096 + idx]; }
    float cw[4];
#pragma unroll
    for (int k = 0; k < 4; ++k) cw[k] = conv_w[k * 256 + c];
    const float cb = conv_b[c], bav = ba[c], bxv = bx[c], spl = softplusf_(-lam[c]);
    float hstate = 0.f;
    __syncthreads();
    for (int ch = 0; ch < SEQ / 64; ++ch) {
        const int t0 = ch * 64;
#pragma unroll 1
        for (int i = 0; i < 8; ++i) { const int t = tr + 8 * i, tg = t0 + t; float a = cb;
#pragma unroll
            for (int k = 0; k < 4; ++k) { const int ts = tg - 3 + k; if (ts >= 0) a += cw[k] * bf2f(proj[((size_t)b * SEQ + ts) * DING + C_RGX + c]); }
            xc_s[t * 64 + j] = a; }
        __syncthreads();
#pragma unroll 1
        for (int i = 0; i < 8; ++i) { const int t = tr + 8 * i; float ra = bav, ga = bxv;
            _Pragma("unroll 4") for (int ii = 0; ii < 64; ++ii) { const float x = xc_s[t * 64 + ii]; ra += x * wa_s[ii * 64 + j]; ga += x * wx_s[ii * 64 + j]; }
            const float r = sigm(ra), ig = sigm(ga), log_a = -8.0f * r * spl;
            float mult = sqrtf(-expm1f(2.0f * log_a)); if (t0 + t == 0) mult = 1.0f;
            a_s[t * 64 + j] = expf(log_a); u_s[t * 64 + j] = mult * ig * xc_s[t * 64 + j]; }
        __syncthreads();
        if (tid < 64) {
            for (int t = 0; t < 64; ++t) { hstate = a_s[t * 64 + j] * hstate + u_s[t * 64 + j];
                const size_t row = (size_t)b * SEQ + t0 + t; const float gate = bf2f(proj[row * DING + C_RGG + c]);
                oraw[row * DM + 256 + c] = hstate * gelu_tanh(gate); }
        }
        __syncthreads();
    }
}

__device__ __forceinline__ void hg_chain(const bf16* proj, float* oraw, int b, int h, const float* lbp, int layer, LAS float* L, int tid) {
    constexpr int S = 65, A = 64 * S;
    LAS float* q_s = L; LAS float* k_s = L + A; LAS float* v_s = L + 2 * A; LAS float* bc_s = L + 3 * A; LAS float* sc_s = L + 4 * A; LAS float* st_s = L + 5 * A; LAS float* qe_s = L + 6 * A;
    const int j = tid & 63, tr = tid >> 6;
    float lb = 0.f;
    if (layer == 1) { const float x0 = lbp[h * 64 + j], x1 = lbp[256 + h * 64 + j], mx = fmaxf(x0, x1), e0 = expf(x0 - mx), e1 = expf(x1 - mx); lb = e1 / (e0 + e1); }
#pragma unroll
    for (int i = 0; i < 8; ++i) st_s[(tr + 8 * i) * S + j] = 0.f;
    __syncthreads();
    for (int ch = 0; ch < SEQ / 64; ++ch) {
        const int t0 = ch * 64;
#pragma unroll 1
        for (int i = 0; i < 8; ++i) { const int t = tr + 8 * i; const size_t row = (size_t)b * SEQ + t0 + t; const bf16* pp = proj + row * DING + h * 64 + j;
            const float qv = bf2f(pp[C_HGQ]), fv = bf2f(pp[C_HGF]), iv = bf2f(pp[C_HGI]);
            const float forget = lb + (1.0f - lb) * sigm(fv);
            q_s[t * S + j] = qv * sigm(qv); k_s[t * S + j] = 1.0f - forget; v_s[t * S + j] = iv; bc_s[t * S + j] = logf(forget); }
        __syncthreads();
        if (tid < 64) { float run = 0.f; for (int t = 0; t < 64; ++t) { run += bc_s[t * S + j]; bc_s[t * S + j] = run; } }
        __syncthreads();
#pragma unroll 1
        for (int i = 0; i < 8; ++i) { const int t = tr + 8 * i; qe_s[t * S + j] = q_s[t * S + j] * expf(bc_s[t * S + j]); }
#pragma unroll 1
        for (int i = 0; i < 8; ++i) { const int t = tr + 8 * i, s = j; float a = 0.f;
            if (s <= t) _Pragma("unroll 4") for (int c = 0; c < 64; ++c) a += q_s[t * S + c] * k_s[s * S + c] * expf(bc_s[t * S + c] - bc_s[s * S + c]);
            sc_s[t * S + s] = a; }
        __syncthreads();
#pragma unroll 1
        for (int i = 0; i < 8; ++i) { const int t = tr + 8 * i, v = j; float o = 0.f;
            _Pragma("unroll 4") for (int s = 0; s < 64; ++s) o += sc_s[t * S + s] * v_s[s * S + v];
            _Pragma("unroll 4") for (int c = 0; c < 64; ++c) o += qe_s[t * S + c] * st_s[c * S + v];
            oraw[((size_t)b * SEQ + t0 + t) * DM + 512 + h * 64 + v] = o; }
        __syncthreads();
#pragma unroll 1
        for (int i = 0; i < 8; ++i) { const int s = tr + 8 * i, c = j; sc_s[s * S + c] = k_s[s * S + c] * expf(bc_s[63 * S + c] - bc_s[s * S + c]); }
        __syncthreads();
#pragma unroll 1
        for (int i = 0; i < 8; ++i) { const int c = tr + 8 * i, v = j; float a = expf(bc_s[63 * S + c]) * st_s[c * S + v];
            _Pragma("unroll 4") for (int s = 0; s < 64; ++s) a += sc_s[s * S + c] * v_s[s * S + v];
            st_s[c * S + v] = a; }
        __syncthreads();
    }
}

__device__ __forceinline__ void m2_chain(const bf16* proj, const float* dtraw, float* oraw, int b, int h, const float* conv_w, const float* conv_b, const float* dt_bias,
                                         const float* a_log, const float* dskip, LAS float* L, int tid) {
    constexpr int SB = 129;
    LAS float* xs_s = L; LAS float* B_s = L + 4096; LAS float* C_s = B_s + 64 * SB; LAS float* W_s = C_s + 64 * SB; LAS float* st_s = W_s + 64 * 65;
    LAS float* dt_s = st_s + 64 * SB; LAS float* acs_s = dt_s + 64; LAS float* w_s = acs_s + 64;
    const int j = tid & 63, tr = tid >> 6, g = h >> 1;
    const float dtb = dt_bias[h], negA = -expf(a_log[h]), Dh = dskip[h];
    for (int idx = tid; idx < 64 * SB; idx += NTHR) st_s[idx] = 0.f;
    __syncthreads();
    for (int ch = 0; ch < SEQ / 64; ++ch) {
        const int t0 = ch * 64;
        for (int idx = tid; idx < 64 * 320; idx += NTHR) { const int cch = idx % 320, t = idx / 320;
            int col, cc; LAS float* dst;
            if (cch < 64) { cc = h * 64 + cch; dst = xs_s + t * 64 + cch; }
            else if (cch < 192) { cc = 256 + g * 128 + (cch - 64); dst = B_s + t * SB + (cch - 64); }
            else { cc = 512 + g * 128 + (cch - 192); dst = C_s + t * SB + (cch - 192); }
            col = C_M2X + cc;
            float a = conv_b[cc];
#pragma unroll
            for (int k = 0; k < 4; ++k) { const int ts = t0 + t - 3 + k; if (ts >= 0) a += conv_w[k * 768 + cc] * bf2f(proj[((size_t)b * SEQ + ts) * DING + col]); }
            *dst = a * sigm(a); }
        if (tid < 64) { const float dtv = softplusf_(dtraw[((size_t)b * SEQ + t0 + tid) * 4 + h] + dtb); dt_s[tid] = dtv;
            float v = dtv * negA;
#pragma unroll
            for (int o = 1; o < 64; o <<= 1) { const float nb = __shfl_up(v, o); if (tid >= o) v += nb; }
            acs_s[tid] = v; const float last = __shfl(v, 63); w_s[tid] = expf(last - v) * dtv; }
        __syncthreads();
#pragma unroll 1
        for (int i = 0; i < 8; ++i) { const int l = tr + 8 * i, s = j; float a = 0.f;
            if (s <= l) { _Pragma("unroll 4") for (int n = 0; n < 128; ++n) a += C_s[l * SB + n] * B_s[s * SB + n]; a *= expf(acs_s[l] - acs_s[s]); }
            W_s[l * 65 + s] = a; }
        __syncthreads();
#pragma unroll 1
        for (int i = 0; i < 8; ++i) { const int l = tr + 8 * i, p = j; float yd = 0.f, yo = 0.f;
            _Pragma("unroll 4") for (int s = 0; s < 64; ++s) yd += W_s[l * 65 + s] * (xs_s[s * 64 + p] * dt_s[s]);
            _Pragma("unroll 4") for (int n = 0; n < 128; ++n) yo += C_s[l * SB + n] * st_s[p * SB + n];
            const size_t row = (size_t)b * SEQ + t0 + l; const float zv = bf2f(proj[row * DING + C_M2Z + h * 64 + p]);
            const float y = yd + expf(acs_s[l]) * yo + xs_s[l * 64 + p] * Dh;
            oraw[row * DM + 768 + h * 64 + p] = y * (zv * sigm(zv)); }
        __syncthreads();
        { const int n = tid & 127, pq = tid >> 7; const float dec = expf(acs_s[63]);
#pragma unroll 1
            for (int i = 0; i < 16; ++i) { const int p = pq + 4 * i; float a = dec * st_s[p * SB + n];
                _Pragma("unroll 4") for (int s = 0; s < 64; ++s) a += B_s[s * SB + n] * (w_s[s] * xs_s[s * 64 + p]);
                st_s[p * SB + n] = a; } }
        __syncthreads();
    }
}

__device__ __forceinline__ void norm_row(const float* orow, const bf16* prow, bf16* mrow, const float* gA, const float* gB, const float* gC, const float* gD, int lane) {
    f32x4 v[4];
#pragma unroll
    for (int j = 0; j < 4; ++j) v[j] = *(const f32x4*)(orow + 256 * j + 4 * lane);
    float s[4];
#pragma unroll
    for (int j = 0; j < 4; ++j) s[j] = (v[j][0] * v[j][0] + v[j][1] * v[j][1]) + (v[j][2] * v[j][2] + v[j][3] * v[j][3]);
#pragma unroll
    for (int o = 1; o < 64; o <<= 1) { s[0] += __shfl_xor(s[0], o); s[1] += __shfl_xor(s[1], o); if (o < 16) s[2] += __shfl_xor(s[2], o); if (o < 32) s[3] += __shfl_xor(s[3], o); }
    const float r0 = 1.0f / sqrtf(s[0] * (1.0f / 256) + EPS), r1 = 1.0f / sqrtf(s[1] * (1.0f / 256) + EPS), r2 = 1.0f / sqrtf(s[2] * (1.0f / 64) + EPS), r3 = 1.0f / sqrtf(s[3] * (1.0f / 128) + EPS);
    const int c = 4 * lane;
    const f32x4 g0 = *(const f32x4*)(gA + c), g1 = *(const f32x4*)(gB + c), g2 = *(const f32x4*)(gC + c), g3 = *(const f32x4*)(gD + c);
    const u32x2 gw = *(const u32x2*)(prow + C_HGG + c);
    const float gi[4] = {bflo(gw.x), bfhi(gw.x), bflo(gw.y), bfhi(gw.y)};
    f32x4 o0 = v[0] * r0 * g0, o1 = v[1] * r1 * g1, o2 = v[2] * r2 * g2, o3 = v[3] * r3 * g3;
#pragma unroll
    for (int i = 0; i < 4; ++i) o2[i] *= gi[i] * sigm(gi[i]);
    u32x2 w;
    w.x = pk2(o0[0], o0[1]); w.y = pk2(o0[2], o0[3]); *(u32x2*)(mrow + c) = w;
    w.x = pk2(o1[0], o1[1]); w.y = pk2(o1[2], o1[3]); *(u32x2*)(mrow + 256 + c) = w;
    w.x = pk2(o2[0], o2[1]); w.y = pk2(o2[2], o2[3]); *(u32x2*)(mrow + 512 + c) = w;
    w.x = pk2(o3[0], o3[1]); w.y = pk2(o3[2], o3[3]); *(u32x2*)(mrow + 768 + c) = w;
}

constexpr int RWS = 1028;
__device__ __forceinline__ void router_load(const bf16* hrow, f32x4 (&v)[4], int lane) {
#pragma unroll
    for (int j = 0; j < 4; ++j) { const u32x2 w = *(const u32x2*)(hrow + 256 * j + 4 * lane); v[j] = (f32x4){bflo(w.x), bfhi(w.x), bflo(w.y), bfhi(w.y)}; }
}
__device__ __forceinline__ void router_row(f32x4 (&v)[4], const float* g, const LAS float* rw_t, const float* rb, bf16* xn_row, int& cntl, int& oe, int& orank, float& ogate, int lane) {
    float ss = 0.f;
#pragma unroll
    for (int j = 0; j < 4; ++j) ss += (v[j][0] * v[j][0] + v[j][1] * v[j][1]) + (v[j][2] * v[j][2] + v[j][3] * v[j][3]);
    ss = wave_sum(ss);
    const float rstd = 1.0f / sqrtf(ss * (1.0f / DM) + EPS);
#pragma unroll
    for (int j = 0; j < 4; ++j) { const int col = 256 * j + 4 * lane; v[j] = v[j] * rstd * *(const f32x4*)(g + col);
        u32x2 w; w.x = pk2(v[j][0], v[j][1]); w.y = pk2(v[j][2], v[j][3]); *(u32x2*)(xn_row + col) = w; }
    float p[32];
#pragma unroll
    for (int e = 0; e < 32; ++e) { float a = 0.f;
#pragma unroll
        for (int j = 0; j < 4; ++j) { const f32x4 w = *(const LAS f32x4*)(rw_t + e * RWS + 256 * j + 4 * lane); a += (v[j][0] * w[0] + v[j][1] * w[1]) + (v[j][2] * w[2] + v[j][3] * w[3]); }
        p[e] = a; }
    float q16[16], q8[8], q4[4], q2[2];
    { const bool hi = (lane & 32) != 0;
#pragma unroll
        for (int i = 0; i < 16; ++i) { const float keep = hi ? p[16 + i] : p[i], send = hi ? p[i] : p[16 + i]; q16[i] = keep + __shfl_xor(send, 32); } }
    { const bool hi = (lane & 16) != 0;
#pragma unroll
        for (int i = 0; i < 8; ++i) { const float keep = hi ? q16[8 + i] : q16[i], send = hi ? q16[i] : q16[8 + i]; q8[i] = keep + __shfl_xor(send, 16); } }
    { const bool hi = (lane & 8) != 0;
#pragma unroll
        for (int i = 0; i < 4; ++i) { const float keep = hi ? q8[4 + i] : q8[i], send = hi ? q8[i] : q8[4 + i]; q4[i] = keep + __shfl_xor(send, 8); } }
    { const bool hi = (lane & 4) != 0;
#pragma unroll
        for (int i = 0; i < 2; ++i) { const float keep = hi ? q4[2 + i] : q4[i], send = hi ? q4[i] : q4[2 + i]; q2[i] = keep + __shfl_xor(send, 4); } }
    float mine;
    { const bool hi = (lane & 2) != 0; const float keep = hi ? q2[1] : q2[0], send = hi ? q2[0] : q2[1]; mine = keep + __shfl_xor(send, 2); }
    mine += __shfl_xor(mine, 1);
    const int myexp = lane >> 1;
    mine += rb[myexp];
    int rank = 0;
#pragma unroll
    for (int e = 0; e < 32; ++e) { const float o = __uint_as_float(__builtin_amdgcn_readlane(__float_as_uint(mine), 2 * e)); rank += (o > mine || (o == mine && e < myexp)) ? 1 : 0; }
    int be[4]; float bl[4];
#pragma unroll
    for (int r = 0; r < 4; ++r) { const unsigned long long m = __ballot(rank == r && (lane & 1) == 0); be[r] = (int)(__builtin_ctzll(m) >> 1);
        bl[r] = __uint_as_float(__builtin_amdgcn_readlane(__float_as_uint(mine), 2 * be[r])); }
    const float e1 = expf(bl[1] - bl[0]), e2 = expf(bl[2] - bl[0]), e3 = expf(bl[3] - bl[0]), inv = 1.0f / (1.0f + e1 + e2 + e3);
    int rk[4];
#pragma unroll
    for (int r = 0; r < 4; ++r) { rk[r] = __builtin_amdgcn_readlane(cntl, be[r]); if (lane == be[r]) cntl += 1; }
    { const int k = lane & 3;
        oe = k == 0 ? be[0] : k == 1 ? be[1] : k == 2 ? be[2] : be[3]; orank = k == 0 ? rk[0] : k == 1 ? rk[1] : k == 2 ? rk[2] : rk[3];
        ogate = (k == 0 ? 1.0f : k == 1 ? e1 : k == 2 ? e2 : e3) * inv; }
}

__device__ __forceinline__ void router_row2(f32x4 (&va)[4], f32x4 (&vb)[4], const float* g, const LAS float* rw_t, const float* rb, bf16* xn_a, bf16* xn_b, int& cntl,
                                            int& oeA, int& orA, float& ogA, int& oeB, int& orB, float& ogB, int lane) {
    float sa = 0.f, sb = 0.f;
#pragma unroll
    for (int j = 0; j < 4; ++j) { sa += (va[j][0] * va[j][0] + va[j][1] * va[j][1]) + (va[j][2] * va[j][2] + va[j][3] * va[j][3]); sb += (vb[j][0] * vb[j][0] + vb[j][1] * vb[j][1]) + (vb[j][2] * vb[j][2] + vb[j][3] * vb[j][3]); }
#pragma unroll
    for (int o = 1; o < 64; o <<= 1) { sa += __shfl_xor(sa, o); sb += __shfl_xor(sb, o); }
    const float ra = 1.0f / sqrtf(sa * (1.0f / DM) + EPS), rbs = 1.0f / sqrtf(sb * (1.0f / DM) + EPS);
#pragma unroll
    for (int j = 0; j < 4; ++j) { const int col = 256 * j + 4 * lane; const f32x4 gg = *(const f32x4*)(g + col); va[j] = va[j] * ra * gg; vb[j] = vb[j] * rbs * gg;
        u32x2 w; w.x = pk2(va[j][0], va[j][1]); w.y = pk2(va[j][2], va[j][3]); *(u32x2*)(xn_a + col) = w;
        w.x = pk2(vb[j][0], vb[j][1]); w.y = pk2(vb[j][2], vb[j][3]); *(u32x2*)(xn_b + col) = w; }
    float pa[32], pb[32];
#pragma unroll
    for (int e = 0; e < 32; ++e) { float a = 0.f, b = 0.f;
#pragma unroll
        for (int j = 0; j < 4; ++j) { const f32x4 w = *(const LAS f32x4*)(rw_t + e * RWS + 256 * j + 4 * lane);
            a += (va[j][0] * w[0] + va[j][1] * w[1]) + (va[j][2] * w[2] + va[j][3] * w[3]); b += (vb[j][0] * w[0] + vb[j][1] * w[1]) + (vb[j][2] * w[2] + vb[j][3] * w[3]); }
        pa[e] = a; pb[e] = b; }
    float q32[32], q16[16], q8[8], q4[4], q2[2];
    { const bool hi = (lane & 32) != 0;
#pragma unroll
        for (int i = 0; i < 32; ++i) { const float keep = hi ? pb[i] : pa[i], send = hi ? pa[i] : pb[i]; q32[i] = keep + __shfl_xor(send, 32); } }
    { const bool hi = (lane & 16) != 0;
#pragma unroll
        for (int i = 0; i < 16; ++i) { const float keep = hi ? q32[16 + i] : q32[i], send = hi ? q32[i] : q32[16 + i]; q16[i] = keep + __shfl_xor(send, 16); } }
    { const bool hi = (lane & 8) != 0;
#pragma unroll
        for (int i = 0; i < 8; ++i) { const float keep = hi ? q16[8 + i] : q16[i], send = hi ? q16[i] : q16[8 + i]; q8[i] = keep + __shfl_xor(send, 8); } }
    { const bool hi = (lane & 4) != 0;
#pragma unroll
        for (int i = 0; i < 4; ++i) { const float keep = hi ? q8[4 + i] : q8[i], send = hi ? q8[i] : q8[4 + i]; q4[i] = keep + __shfl_xor(send, 4); } }
    { const bool hi = (lane & 2) != 0;
#pragma unroll
        for (int i = 0; i < 2; ++i) { const float keep = hi ? q4[2 + i] : q4[i], send = hi ? q4[i] : q4[2 + i]; q2[i] = keep + __shfl_xor(send, 2); } }
    float mine;
    { const bool hi = (lane & 1) != 0; const float keep = hi ? q2[1] : q2[0], send = hi ? q2[0] : q2[1]; mine = keep + __shfl_xor(send, 1); }
    const int myexp = lane & 31;
    mine += rb[myexp];
    int rank = 0;
#pragma unroll
    for (int e = 0; e < 32; ++e) { const float o = __shfl(mine, (lane & 32) + e); rank += (o > mine || (o == mine && e < myexp)) ? 1 : 0; }
    int beA[4], beB[4]; float blA[4], blB[4];
#pragma unroll
    for (int r = 0; r < 4; ++r) { const unsigned long long m = __ballot(rank == r); beA[r] = (int)__builtin_ctz((unsigned)m); beB[r] = (int)__builtin_ctz((unsigned)(m >> 32));
        blA[r] = __uint_as_float(__builtin_amdgcn_readlane(__float_as_uint(mine), beA[r])); blB[r] = __uint_as_float(__builtin_amdgcn_readlane(__float_as_uint(mine), 32 + beB[r])); }
    const float a1 = expf(blA[1] - blA[0]), a2 = expf(blA[2] - blA[0]), a3 = expf(blA[3] - blA[0]), ia = 1.0f / (1.0f + a1 + a2 + a3);
    const float b1 = expf(blB[1] - blB[0]), b2 = expf(blB[2] - blB[0]), b3 = expf(blB[3] - blB[0]), ib = 1.0f / (1.0f + b1 + b2 + b3);
    int rkA[4], rkB[4];
#pragma unroll
    for (int r = 0; r < 4; ++r) { rkA[r] = __builtin_amdgcn_readlane(cntl, beA[r]); if (lane == beA[r]) cntl += 1; }
#pragma unroll
    for (int r = 0; r < 4; ++r) { rkB[r] = __builtin_amdgcn_readlane(cntl, beB[r]); if (lane == beB[r]) cntl += 1; }
    { const int k = lane & 3;
        oeA = k == 0 ? beA[0] : k == 1 ? beA[1] : k == 2 ? beA[2] : beA[3]; orA = k == 0 ? rkA[0] : k == 1 ? rkA[1] : k == 2 ? rkA[2] : rkA[3]; ogA = (k == 0 ? 1.0f : k == 1 ? a1 : k == 2 ? a2 : a3) * ia;
        oeB = k == 0 ? beB[0] : k == 1 ? beB[1] : k == 2 ? beB[2] : beB[3]; orB = k == 0 ? rkB[0] : k == 1 ? rkB[1] : k == 2 ? rkB[2] : rkB[3]; ogB = (k == 0 ? 1.0f : k == 1 ? b1 : k == 2 ? b2 : b3) * ib; }
}

__device__ __forceinline__ void build_tb(const int* tot, LAS int* tb, int tid) {
    if (tid == 0) { int run = 0; for (int e = 0; e < 32; ++e) { tb[e] = run; run += (tot[e] + 255) >> 8; } tb[32] = run; }
    __syncthreads();
}

typedef short s16x4 __attribute__((ext_vector_type(4)));
typedef short v4i16_t __attribute__((ext_vector_type(4)));
#define MFMA16(a, b, c) __builtin_amdgcn_mfma_f32_16x16x32_bf16((a), (b), (c), 0, 0, 0)
__device__ __forceinline__ bf16x8 frag_kc(const LAS bf16* M, int ld, int idx0, int k0, int lane) { return *(const LAS bf16x8*)(M + (idx0 + (lane & 15)) * ld + k0 + 8 * (lane >> 4)); }
__device__ __forceinline__ bf16x8 frag_ks(const LAS bf16* M, int ld, int idx0, int k0, int lane) {
    const LAS bf16* p = M + (k0 + 8 * (lane >> 4) + ((lane & 15) >> 2)) * ld + idx0 + 4 * (lane & 3);
    const s16x4 lo = __builtin_bit_cast(s16x4, __builtin_amdgcn_ds_read_tr16_b64_v4i16((LAS v4i16_t*)p));
    const s16x4 hi = __builtin_bit_cast(s16x4, __builtin_amdgcn_ds_read_tr16_b64_v4i16((LAS v4i16_t*)(p + 4 * ld)));
    return (bf16x8){lo[0], lo[1], lo[2], lo[3], hi[0], hi[1], hi[2], hi[3]};
}
__device__ __forceinline__ bf16x8 frag_g32(const float* M, int ld, int idx0, int k0, int lane) {
    const float* p = M + (size_t)(idx0 + (lane & 15)) * ld + k0 + 8 * (lane >> 4);
    const f32x4 a = *(const f32x4*)p, b = *(const f32x4*)(p + 4);
    v4u w; w.x = pk2(a[0], a[1]); w.y = pk2(a[2], a[3]); w.z = pk2(b[0], b[1]); w.w = pk2(b[2], b[3]);
    return __builtin_bit_cast(bf16x8, w);
}
__device__ __forceinline__ float fsigm(float x) { return __builtin_amdgcn_rcpf(1.0f + __builtin_amdgcn_exp2f(-1.4426950408889634f * x)); }
__device__ __forceinline__ float fexp(float x) { return __builtin_amdgcn_exp2f(1.4426950408889634f * x); }

constexpr int M2LD = 136, M2WLD = 72;
__device__ __forceinline__ void m2_conv_block(const bf16* proj, const float* cw, const float* cb, int b, int t0, int tq, int cc0, float (&o)[8][8]) {
    v4u x[11]; f32x4 w[4][2];
    const int ts0 = t0 + 8 * tq - 3;
#pragma unroll
    for (int r = 0; r < 11; ++r) { const int ts = ts0 + r; x[r] = (v4u){0u, 0u, 0u, 0u}; if (ts >= 0) x[r] = *(const v4u*)(proj + ((size_t)b * SEQ + ts) * DING + C_M2X + cc0); }
#pragma unroll
    for (int k = 0; k < 4; ++k) { w[k][0] = *(const f32x4*)(cw + k * 768 + cc0); w[k][1] = *(const f32x4*)(cw + k * 768 + cc0 + 4); }
    const f32x4 b0 = *(const f32x4*)(cb + cc0), b1 = *(const f32x4*)(cb + cc0 + 4);
#pragma unroll
    for (int j = 0; j < 8; ++j) { float a[8] = {b0[0], b0[1], b0[2], b0[3], b1[0], b1[1], b1[2], b1[3]};
#pragma unroll
        for (int k = 0; k < 4; ++k) { const v4u xv = x[j + k];
            a[0] += w[k][0][0] * bflo(xv[0]); a[1] += w[k][0][1] * bfhi(xv[0]); a[2] += w[k][0][2] * bflo(xv[1]); a[3] += w[k][0][3] * bfhi(xv[1]);
            a[4] += w[k][1][0] * bflo(xv[2]); a[5] += w[k][1][1] * bfhi(xv[2]); a[6] += w[k][1][2] * bflo(xv[3]); a[7] += w[k][1][3] * bfhi(xv[3]); }
#pragma unroll
        for (int i = 0; i < 8; ++i) o[j][i] = a[i] * fsigm(a[i]); }
}
__device__ __forceinline__ void m2_dt_scan(const float* dtraw, const float* dt_bias, const float* a_log, int b, int t0, int g, LAS float* dt_s, LAS float* acs_s, LAS float* w_s, float* dec_out, int tid) {
    if (tid >= 384) { const int hh = (tid - 384) >> 6, t = tid & 63, h = 2 * g + hh;
        const float dtv = softplusf_(dtraw[((size_t)b * SEQ + t0 + t) * 4 + h] + dt_bias[h]);
        float v = dtv * (-expf(a_log[h]));
#pragma unroll
        for (int o = 1; o < 64; o <<= 1) { const float nb = __shfl_up(v, o); if (t >= o) v += nb; }
        const float last = __shfl(v, 63);
        dt_s[hh * 64 + t] = dtv; acs_s[hh * 64 + t] = v; w_s[hh * 64 + t] = expf(last - v) * dtv;
        if (dec_out && t == 63) dec_out[h] = expf(last); }
}
__device__ __forceinline__ void m2_state_unit(const bf16* proj, const float* dtraw, float* sloc, float* dec, int b, int ch, int g, const float* cw, const float* cb, const float* dt_bias, const float* a_log, LAS unsigned char* lds, int tid) {
    LAS bf16* XS = (LAS bf16*)lds; LAS bf16* BS = XS + 64 * M2LD; LAS float* dt_s = (LAS float*)(BS + 64 * M2LD); LAS float* acs_s = dt_s + 128; LAS float* w_s = acs_s + 128;
    const int lane = tid & 63, w = tid >> 6, t0 = ch * 64;
    m2_dt_scan(dtraw, dt_bias, a_log, b, t0, g, dt_s, acs_s, w_s, dec + (size_t)(b * 32 + ch) * 4, tid);
    float o[8][8]; const int cg = tid & 31, tq = tid >> 5;
    if (tid < 256) m2_conv_block(proj, cw, cb, b, t0, tq, cg < 16 ? g * 128 + 8 * cg : 256 + g * 128 + 8 * (cg - 16), o);
    __syncthreads();
    if (tid < 256) {
#pragma unroll
        for (int j = 0; j < 8; ++j) { const int t = 8 * tq + j; const float sc = cg < 16 ? w_s[(cg >> 3) * 64 + t] : 1.0f;
            v4u q; q.x = pk2(o[j][0] * sc, o[j][1] * sc); q.y = pk2(o[j][2] * sc, o[j][3] * sc); q.z = pk2(o[j][4] * sc, o[j][5] * sc); q.w = pk2(o[j][6] * sc, o[j][7] * sc);
            *(LAS v4u*)((cg < 16 ? XS + 8 * cg : BS + 8 * (cg - 16)) + t * M2LD) = q; } }
    __syncthreads();
    { const int hh = w >> 2, mi = w & 3;
        const bf16x8 a0 = frag_ks(XS, M2LD, hh * 64 + mi * 16, 0, lane), a1 = frag_ks(XS, M2LD, hh * 64 + mi * 16, 32, lane);
        float* outp = sloc + ((size_t)((b * 32 + ch) * 4 + 2 * g + hh) * 64 + mi * 16 + 4 * (lane >> 4)) * 128 + (lane & 15);
#pragma unroll
        for (int ni = 0; ni < 8; ++ni) { const bf16x8 b0 = frag_ks(BS, M2LD, ni * 16, 0, lane), b1 = frag_ks(BS, M2LD, ni * 16, 32, lane);
            f32x4 acc = {0.f, 0.f, 0.f, 0.f}; acc = MFMA16(a0, b0, acc); acc = MFMA16(a1, b1, acc);
#pragma unroll
            for (int i = 0; i < 4; ++i) outp[i * 128 + ni * 16] = acc[i]; } }
    __syncthreads();
}
__device__ __forceinline__ void m2_out_unit(const bf16* proj, const float* dtraw, const bf16* prevb, float* oraw, int b, int ch, int g, const float* cw, const float* cb, const float* dt_bias, const float* a_log, const float* dskip, LAS unsigned char* lds, int tid) {
    LAS bf16* XS = (LAS bf16*)lds; LAS bf16* BS = XS + 64 * M2LD; LAS bf16* CS = BS + 64 * M2LD; LAS bf16* WS = CS + 64 * M2LD;
    LAS float* dt_s = (LAS float*)(WS + 2 * 64 * M2WLD); LAS float* acs_s = dt_s + 128; LAS float* w_s = acs_s + 128;
    const int lane = tid & 63, w = tid >> 6, t0 = ch * 64;
    bf16x8 pf[4][4];
    { const bf16* pv = prevb + (size_t)((b * 32 + ch) * 4 + 2 * g + (w >> 2)) * 64 * 128;
#pragma unroll
        for (int kk = 0; kk < 4; ++kk)
#pragma unroll
            for (int ni = 0; ni < 4; ++ni) pf[kk][ni] = *(const bf16x8*)(pv + (size_t)(ni * 16 + (lane & 15)) * 128 + 32 * kk + 8 * (lane >> 4)); }
    m2_dt_scan(dtraw, dt_bias, a_log, b, t0, g, dt_s, acs_s, w_s, nullptr, tid);
    if (tid < 384) { float o[8][8]; const int cg = tid % 48, tq = tid / 48;
        const int cc0 = cg < 16 ? g * 128 + 8 * cg : cg < 32 ? 256 + g * 128 + 8 * (cg - 16) : 512 + g * 128 + 8 * (cg - 32);
        m2_conv_block(proj, cw, cb, b, t0, tq, cc0, o);
        LAS bf16* dst = cg < 16 ? XS + 8 * cg : cg < 32 ? BS + 8 * (cg - 16) : CS + 8 * (cg - 32);
#pragma unroll
        for (int j = 0; j < 8; ++j) { v4u q; q.x = pk2(o[j][0], o[j][1]); q.y = pk2(o[j][2], o[j][3]); q.z = pk2(o[j][4], o[j][5]); q.w = pk2(o[j][6], o[j][7]); *(LAS v4u*)(dst + (8 * tq + j) * M2LD) = q; } }
    __syncthreads();
    { const int mi = w >> 1, ni0 = (w & 1) * 2;
        f32x4 acc[2] = {{0.f, 0.f, 0.f, 0.f}, {0.f, 0.f, 0.f, 0.f}};
#pragma unroll
        for (int kk = 0; kk < 4; ++kk) { const bf16x8 a = frag_kc(CS, M2LD, mi * 16, 32 * kk, lane);
#pragma unroll
            for (int q = 0; q < 2; ++q) { const bf16x8 bb = frag_kc(BS, M2LD, (ni0 + q) * 16, 32 * kk, lane); acc[q] = MFMA16(a, bb, acc[q]); } }
#pragma unroll
        for (int q = 0; q < 2; ++q) { const int s = (ni0 + q) * 16 + (lane & 15);
#pragma unroll
            for (int hh = 0; hh < 2; ++hh) { const float as = acs_s[hh * 64 + s], ds = dt_s[hh * 64 + s];
#pragma unroll
                for (int i = 0; i < 4; ++i) { const int l = mi * 16 + 4 * (lane >> 4) + i;
                    const float v = (s <= l) ? acc[q][i] * fexp(acs_s[hh * 64 + l] - as) * ds : 0.f;
                    WS[(hh * 64 + l) * M2WLD + s] = (bf16)f2bf(v); } } } }
    __syncthreads();
    { const int hh = w >> 2, mi = w & 3, h = 2 * g + hh;
        f32x4 yd[4], yo[4];
#pragma unroll
        for (int ni = 0; ni < 4; ++ni) { yd[ni] = (f32x4){0.f, 0.f, 0.f, 0.f}; yo[ni] = (f32x4){0.f, 0.f, 0.f, 0.f}; }
#pragma unroll
        for (int kk = 0; kk < 2; ++kk) { const bf16x8 a = frag_kc(WS + hh * 64 * M2WLD, M2WLD, mi * 16, 32 * kk, lane);
#pragma unroll
            for (int ni = 0; ni < 4; ++ni) { const bf16x8 bb = frag_ks(XS, M2LD, hh * 64 + ni * 16, 32 * kk, lane); yd[ni] = MFMA16(a, bb, yd[ni]); } }
#pragma unroll
        for (int kk = 0; kk < 4; ++kk) { const bf16x8 a = frag_kc(CS, M2LD, mi * 16, 32 * kk, lane);
#pragma unroll
            for (int ni = 0; ni < 4; ++ni) yo[ni] = MFMA16(a, pf[kk][ni], yo[ni]); }
        const float Dh = dskip[h];
#pragma unroll
        for (int i = 0; i < 4; ++i) { const int l = mi * 16 + 4 * (lane >> 4) + i; const float ea = fexp(acs_s[hh * 64 + l]); const size_t row = (size_t)b * SEQ + t0 + l;
#pragma unroll
            for (int ni = 0; ni < 4; ++ni) { const int p = ni * 16 + (lane & 15);
                const float xv = bf2f(XS[l * M2LD + hh * 64 + p]), zv = bf2f(proj[row * DING + C_M2Z + h * 64 + p]);
                const float y = yd[ni][i] + ea * yo[ni][i] + xv * Dh;
                oraw[row * DM + 768 + h * 64 + p] = y * (zv * fsigm(zv)); } } }
    __syncthreads();
}

constexpr int HGLD = 136, HGWLD = 72;
template <bool WITH_Q>
__device__ __forceinline__ void hg_prep(const bf16* proj, int b, int t0, int hp, const float* lb1, int layer, LAS float* bc_s, LAS bf16* QS, LAS bf16* KS, LAS bf16* VS, LAS bf16* Q2, int tid) {
    const int c0 = (tid & 15) * 8, ta = tid >> 4;
    float lb[8];
#pragma unroll
    for (int i = 0; i < 8; ++i) lb[i] = 0.f;
    if (layer == 1) { const f32x4 l0 = *(const f32x4*)(lb1 + hp * 128 + c0), l1 = *(const f32x4*)(lb1 + hp * 128 + c0 + 4); lb[0] = l0[0]; lb[1] = l0[1]; lb[2] = l0[2]; lb[3] = l0[3]; lb[4] = l1[0]; lb[5] = l1[1]; lb[6] = l1[2]; lb[7] = l1[3]; }
    v4u fw[2], iw[2], qw[2];
#pragma unroll
    for (int u = 0; u < 2; ++u) { const size_t row = (size_t)b * SEQ + t0 + ta + 32 * u;
        fw[u] = *(const v4u*)(proj + row * DING + C_HGF + hp * 128 + c0); iw[u] = *(const v4u*)(proj + row * DING + C_HGI + hp * 128 + c0);
        if (WITH_Q) qw[u] = *(const v4u*)(proj + row * DING + C_HGQ + hp * 128 + c0); }
    float key[2][8];
#pragma unroll
    for (int u = 0; u < 2; ++u) { const int t = ta + 32 * u;
        const float f[8] = {bflo(fw[u][0]), bfhi(fw[u][0]), bflo(fw[u][1]), bfhi(fw[u][1]), bflo(fw[u][2]), bfhi(fw[u][2]), bflo(fw[u][3]), bfhi(fw[u][3])};
        float lf[8];
#pragma unroll
        for (int i = 0; i < 8; ++i) { const float sg = fsigm(f[i]); lf[i] = __builtin_amdgcn_logf(lb[i] + (1.0f - lb[i]) * sg) * 0.6931471805599453f; key[u][i] = (1.0f - lb[i]) * (1.0f - sg); }
        *(LAS f32x4*)(bc_s + t * 128 + c0) = (f32x4){lf[0], lf[1], lf[2], lf[3]}; *(LAS f32x4*)(bc_s + t * 128 + c0 + 4) = (f32x4){lf[4], lf[5], lf[6], lf[7]};
        *(LAS v4u*)(VS + t * HGLD + c0) = iw[u]; }
    __syncthreads();
    if (tid < 128) { float run = 0.f;
#pragma unroll 8
        for (int t = 0; t < 64; ++t) { run += bc_s[t * 128 + tid]; bc_s[t * 128 + tid] = run; } }
    __syncthreads();
    const f32x4 m0 = *(const LAS f32x4*)(bc_s + 31 * 128 + c0), m1 = *(const LAS f32x4*)(bc_s + 31 * 128 + c0 + 4);
    const float b31[8] = {m0[0], m0[1], m0[2], m0[3], m1[0], m1[1], m1[2], m1[3]};
#pragma unroll
    for (int u = 0; u < 2; ++u) { const int t = ta + 32 * u;
        const f32x4 x0 = *(const LAS f32x4*)(bc_s + t * 128 + c0), x1 = *(const LAS f32x4*)(bc_s + t * 128 + c0 + 4);
        const float bc[8] = {x0[0], x0[1], x0[2], x0[3], x1[0], x1[1], x1[2], x1[3]};
        float kk[8], qq[8], q2[8];
#pragma unroll
        for (int i = 0; i < 8; ++i) { const float d = b31[i] - bc[i]; kk[i] = key[u][i] * fexp(fminf(d, 60.0f));
            if (WITH_Q) { const float qv = (i & 1) ? bfhi(qw[u][i >> 1]) : bflo(qw[u][i >> 1]); const float qs = qv * fsigm(qv); qq[i] = qs * fexp(fminf(-d, 60.0f)); q2[i] = qs * fexp(bc[i]); } }
        v4u o; o.x = pk2(kk[0], kk[1]); o.y = pk2(kk[2], kk[3]); o.z = pk2(kk[4], kk[5]); o.w = pk2(kk[6], kk[7]); *(LAS v4u*)(KS + t * HGLD + c0) = o;
        if (WITH_Q) { o.x = pk2(qq[0], qq[1]); o.y = pk2(qq[2], qq[3]); o.z = pk2(qq[4], qq[5]); o.w = pk2(qq[6], qq[7]); *(LAS v4u*)(QS + t * HGLD + c0) = o;
            o.x = pk2(q2[0], q2[1]); o.y = pk2(q2[2], q2[3]); o.z = pk2(q2[4], q2[5]); o.w = pk2(q2[6], q2[7]); *(LAS v4u*)(Q2 + t * HGLD + c0) = o; } }
    __syncthreads();
}
__device__ __forceinline__ void hg_state_unit(const bf16* proj, float* slt, float* decc, int b, int ch, int hp, const float* lbp, int layer, LAS unsigned char* lds, int tid) {
    LAS float* bc_s = (LAS float*)lds; LAS bf16* KS = (LAS bf16*)(lds + 32768); LAS bf16* VS = KS + 64 * HGLD;
    const int lane = tid & 63, w = tid >> 6;
    hg_prep<false>(proj, b, ch * 64, hp, lbp, layer, bc_s, nullptr, KS, VS, nullptr, tid);
    if (tid < 128) decc[(size_t)((b * 32 + ch) * 4 + 2 * hp) * 64 + tid] = fexp(bc_s[63 * 128 + tid]);
    { const int hh = w >> 2, mi = w & 3, h = 2 * hp + hh;
        const bf16x8 a0 = frag_ks(VS, HGLD, hh * 64 + mi * 16, 0, lane), a1 = frag_ks(VS, HGLD, hh * 64 + mi * 16, 32, lane);
        float* outp = slt + ((size_t)((b * 32 + ch) * 4 + h) * 64 + mi * 16 + 4 * (lane >> 4)) * 64 + (lane & 15);
#pragma unroll
        for (int ni = 0; ni < 4; ++ni) { const bf16x8 b0 = frag_ks(KS, HGLD, hh * 64 + ni * 16, 0, lane), b1 = frag_ks(KS, HGLD, hh * 64 + ni * 16, 32, lane);
            f32x4 acc = {0.f, 0.f, 0.f, 0.f}; acc = MFMA16(a0, b0, acc); acc = MFMA16(a1, b1, acc);
            const int c = hh * 64 + ni * 16 + (lane & 15); const float sc = fexp(bc_s[63 * 128 + c] - bc_s[31 * 128 + c]);
#pragma unroll
            for (int i = 0; i < 4; ++i) outp[i * 64 + ni * 16] = acc[i] * sc; } }
    __syncthreads();
}
__device__ __forceinline__ void hg_out_unit(const bf16* proj, const bf16* stb, float* oraw, int b, int ch, int hp, const float* lbp, int layer, LAS unsigned char* lds, int tid) {
    LAS float* bc_s = (LAS float*)lds; LAS bf16* KS = (LAS bf16*)(lds + 32768); LAS bf16* VS = KS + 64 * HGLD; LAS bf16* QS = VS + 64 * HGLD; LAS bf16* WS = QS + 64 * HGLD; LAS bf16* Q2 = WS + 2 * 64 * HGWLD;
    const int lane = tid & 63, w = tid >> 6, t0 = ch * 64;
    const int hh = w >> 2, mi = w & 3, h = 2 * hp + hh;
    bf16x8 sf[2][4];
    { const bf16* st = stb + (size_t)((b * 32 + ch) * 4 + h) * 64 * 64;
#pragma unroll
        for (int kk = 0; kk < 2; ++kk)
#pragma unroll
            for (int ni = 0; ni < 4; ++ni) sf[kk][ni] = *(const bf16x8*)(st + (size_t)(ni * 16 + (lane & 15)) * 64 + 32 * kk + 8 * (lane >> 4)); }
    hg_prep<true>(proj, b, t0, hp, lbp, layer, bc_s, QS, KS, VS, Q2, tid);
    { f32x4 sc[4];
#pragma unroll
        for (int ni = 0; ni < 4; ++ni) sc[ni] = (f32x4){0.f, 0.f, 0.f, 0.f};
#pragma unroll
        for (int kk = 0; kk < 2; ++kk) { const bf16x8 a = frag_kc(QS, HGLD, mi * 16, hh * 64 + 32 * kk, lane);
#pragma unroll
            for (int ni = 0; ni < 4; ++ni) { const bf16x8 bb = frag_kc(KS, HGLD, ni * 16, hh * 64 + 32 * kk, lane); sc[ni] = MFMA16(a, bb, sc[ni]); } }
#pragma unroll
        for (int ni = 0; ni < 4; ++ni) { const int s = ni * 16 + (lane & 15);
#pragma unroll
            for (int i = 0; i < 4; ++i) { const int t = mi * 16 + 4 * (lane >> 4) + i; WS[(hh * 64 + t) * HGWLD + s] = (bf16)f2bf(s <= t ? sc[ni][i] : 0.f); } } }
    __syncthreads();
    { f32x4 o[4];
#pragma unroll
        for (int ni = 0; ni < 4; ++ni) o[ni] = (f32x4){0.f, 0.f, 0.f, 0.f};
#pragma unroll
        for (int kk = 0; kk < 2; ++kk) { const bf16x8 a = frag_kc(WS + hh * 64 * HGWLD, HGWLD, mi * 16, 32 * kk, lane);
#pragma unroll
            for (int ni = 0; ni < 4; ++ni) { const bf16x8 bb = frag_ks(VS, HGLD, hh * 64 + ni * 16, 32 * kk, lane); o[ni] = MFMA16(a, bb, o[ni]); } }
#pragma unroll
        for (int kk = 0; kk < 2; ++kk) { const bf16x8 a = frag_kc(Q2, HGLD, mi * 16, hh * 64 + 32 * kk, lane);
#pragma unroll
            for (int ni = 0; ni < 4; ++ni) o[ni] = MFMA16(a, sf[kk][ni], o[ni]); }
#pragma unroll
        for (int i = 0; i < 4; ++i) { const size_t row = (size_t)b * SEQ + t0 + mi * 16 + 4 * (lane >> 4) + i;
#pragma unroll
            for (int ni = 0; ni < 4; ++ni) oraw[row * DM + 512 + h * 64 + ni * 16 + (lane & 15)] = o[ni][i]; } }
    __syncthreads();
}

constexpr int RGLD = 136;
__device__ __forceinline__ void rg_local_unit(const bf16* proj, float* hloc, float* pcum, float* rgs, int b, int ch, int half, const float* conv_w, const float* conv_b, const bf16* waT, const bf16* wxT,
                                              const float* ba, const float* bx, const float* lam, LAS unsigned char* lds, int tid) {
    LAS float* xc32 = (LAS float*)lds; LAS float* a_s = xc32 + 64 * 128; LAS bf16* xcb = (LAS bf16*)(a_s + 64 * 128); LAS float* par = (LAS float*)(xcb + 64 * RGLD);
    const int lane = tid & 63, w = tid >> 6, t0 = ch * 64, cg0 = half * 128;
    if (tid < 128) { par[tid] = ba[cg0 + tid]; par[128 + tid] = bx[cg0 + tid]; par[256 + tid] = softplusf_(-lam[cg0 + tid]); }
    { const int c0 = (tid & 15) * 8, cg = cg0 + c0, tp = tid >> 4;
        v4u x[5]; f32x4 wk[4][2];
#pragma unroll
        for (int r = 0; r < 5; ++r) { const int ts = t0 + 2 * tp - 3 + r; x[r] = (v4u){0u, 0u, 0u, 0u}; if (ts >= 0) x[r] = *(const v4u*)(proj + ((size_t)b * SEQ + ts) * DING + C_RGX + cg); }
#pragma unroll
        for (int k = 0; k < 4; ++k) { wk[k][0] = *(const f32x4*)(conv_w + k * 256 + cg); wk[k][1] = *(const f32x4*)(conv_w + k * 256 + cg + 4); }
        const f32x4 b0 = *(const f32x4*)(conv_b + cg), b1 = *(const f32x4*)(conv_b + cg + 4);
#pragma unroll
        for (int j = 0; j < 2; ++j) { const int t = 2 * tp + j; float o[8] = {b0[0], b0[1], b0[2], b0[3], b1[0], b1[1], b1[2], b1[3]};
#pragma unroll
            for (int k = 0; k < 4; ++k) { const v4u xv = x[j + k];
                o[0] += wk[k][0][0] * bflo(xv[0]); o[1] += wk[k][0][1] * bfhi(xv[0]); o[2] += wk[k][0][2] * bflo(xv[1]); o[3] += wk[k][0][3] * bfhi(xv[1]);
                o[4] += wk[k][1][0] * bflo(xv[2]); o[5] += wk[k][1][1] * bfhi(xv[2]); o[6] += wk[k][1][2] * bflo(xv[3]); o[7] += wk[k][1][3] * bfhi(xv[3]); }
            *(LAS f32x4*)(xc32 + t * 128 + c0) = (f32x4){o[0], o[1], o[2], o[3]}; *(LAS f32x4*)(xc32 + t * 128 + c0 + 4) = (f32x4){o[4], o[5], o[6], o[7]};
            v4u q; q.x = pk2(o[0], o[1]); q.y = pk2(o[2], o[3]); q.z = pk2(o[4], o[5]); q.w = pk2(o[6], o[7]); *(LAS v4u*)(xcb + t * RGLD + c0) = q; } }
    __syncthreads();
    { const int nb = w >> 2, mi = w & 3, n = 2 * half + nb;
        f32x4 ra[4], ga[4];
#pragma unroll
        for (int ni = 0; ni < 4; ++ni) { ra[ni] = (f32x4){0.f, 0.f, 0.f, 0.f}; ga[ni] = (f32x4){0.f, 0.f, 0.f, 0.f}; }
#pragma unroll
        for (int kk = 0; kk < 2; ++kk) { const bf16x8 a = frag_kc(xcb, RGLD, mi * 16, nb * 64 + 32 * kk, lane);
#pragma unroll
            for (int ni = 0; ni < 4; ++ni) { const size_t off = (size_t)(n * 64 + ni * 16 + (lane & 15)) * 64 + 32 * kk + 8 * (lane >> 4);
                ra[ni] = MFMA16(a, *(const bf16x8*)(waT + off), ra[ni]); ga[ni] = MFMA16(a, *(const bf16x8*)(wxT + off), ga[ni]); } }
#pragma unroll
        for (int ni = 0; ni < 4; ++ni) { const int c = nb * 64 + ni * 16 + (lane & 15); const float bav = par[c], bxv = par[128 + c], spl = par[256 + c];
#pragma unroll
            for (int i = 0; i < 4; ++i) { const int t = mi * 16 + 4 * (lane >> 4) + i;
                const float r = fsigm(ra[ni][i] + bav), ig = fsigm(ga[ni][i] + bxv), log_a = -8.0f * r * spl, x2 = 2.0f * log_a;
                const float em1 = x2 > -0.25f ? -x2 * (1.0f + x2 * (0.5f + x2 * (0.16666667f + x2 * (0.041666668f + x2 * 0.0083333338f)))) : 1.0f - fexp(x2);
                float mult = __builtin_amdgcn_sqrtf(em1); if (t0 + t == 0) mult = 1.0f;
                a_s[t * 128 + c] = fexp(log_a); xc32[t * 128 + c] = mult * ig * xc32[t * 128 + c]; } } }
    __syncthreads();
    if (tid < 128) { float h = 0.f, P = 1.f; const size_t base = ((size_t)b * SEQ + t0) * 256 + cg0 + tid;
#pragma unroll 8
        for (int t = 0; t < 64; ++t) { const float a = a_s[t * 128 + tid]; h = a * h + xc32[t * 128 + tid]; P *= a; hloc[base + (size_t)t * 256] = h; pcum[base + (size_t)t * 256] = P; }
        rgs[((size_t)(b * 32 + ch) * 256 + cg0 + tid) * 2] = P; rgs[((size_t)(b * 32 + ch) * 256 + cg0 + tid) * 2 + 1] = h; }
    __syncthreads();
}

typedef float f32x16 __attribute__((ext_vector_type(16)));
#define MFMA32(a, b, c) __builtin_amdgcn_mfma_f32_32x32x16_bf16((a), (b), (c), 0, 0, 0)
constexpr int AVLD = 72;
__device__ __forceinline__ bf16x8 pack8(const f32x16& x, int o) {
    v4u w; w.x = pg8::cvt_pk_bf16(x[o], x[o + 1]); w.y = pg8::cvt_pk_bf16(x[o + 2], x[o + 3]); w.z = pg8::cvt_pk_bf16(x[o + 4], x[o + 5]); w.w = pg8::cvt_pk_bf16(x[o + 6], x[o + 7]);
    return __builtin_bit_cast(bf16x8, w);
}
__device__ __forceinline__ float lk2(float z) { return -(fmaxf(z, 0.f) + __builtin_amdgcn_logf(1.0f + __builtin_amdgcn_exp2f(-fabsf(z)))); }
__device__ __forceinline__ void attn_unit(const bf16* proj, float* oraw, int b, int h, int qb, LAS bf16* VL, int lane) {
    const int q = lane & 31, h2 = lane >> 5, qw = qb * 32; const size_t rowb = (size_t)b * SEQ;
    bf16x8 qf[4];
    { const bf16* qp = proj + (rowb + qw + q) * DING + C_SBQ + h * 64 + 8 * h2; const float C2 = 0.125f * 1.4426950408889634f;
#pragma unroll
        for (int kk = 0; kk < 4; ++kk) { const v4u w = *(const v4u*)(qp + 16 * kk); v4u o;
            o.x = pg8::cvt_pk_bf16(bflo(w.x) * C2, bfhi(w.x) * C2); o.y = pg8::cvt_pk_bf16(bflo(w.y) * C2, bfhi(w.y) * C2); o.z = pg8::cvt_pk_bf16(bflo(w.z) * C2, bfhi(w.z) * C2); o.w = pg8::cvt_pk_bf16(bflo(w.w) * C2, bfhi(w.w) * C2);
            qf[kk] = __builtin_bit_cast(bf16x8, o); } }
    bf16x8 m0[2], ones;
#pragma unroll
    for (int s = 0; s < 2; ++s) {
#pragma unroll
        for (int jj = 0; jj < 8; ++jj) { const int j = 16 * s + 8 * (jj >> 2) + 4 * h2 + (jj & 3); m0[s][jj] = (short)(j >= q ? 0x3F80 : 0); } }
#pragma unroll
    for (int jj = 0; jj < 8; ++jj) ones[jj] = (short)0x3F80;
    f32x16 o0, o1;
#pragma unroll
    for (int r = 0; r < 16; ++r) { o0[r] = 0.f; o1[r] = 0.f; }
    float R = 0.f;
    const int sd = (qw >> 6) << 6;
    bf16x8 kf[2][4];
    { const bf16* kp = proj + (rowb + sd + q) * DING + C_SBK + h * 64 + 8 * h2;
#pragma unroll
        for (int hf = 0; hf < 2; ++hf)
#pragma unroll
            for (int kk = 0; kk < 4; ++kk) kf[hf][kk] = *(const bf16x8*)(kp + (size_t)hf * 32 * DING + 16 * kk); }
    for (int s0 = sd; s0 >= 0; s0 -= 64) {
        bf16x8 kn[2][4];
        { const int sn = s0 >= 64 ? s0 - 64 : s0; const bf16* kp = proj + (rowb + sn + q) * DING + C_SBK + h * 64 + 8 * h2;
#pragma unroll
            for (int hf = 0; hf < 2; ++hf)
#pragma unroll
                for (int kk = 0; kk < 4; ++kk) kn[hf][kk] = *(const bf16x8*)(kp + (size_t)hf * 32 * DING + 16 * kk); }
#pragma unroll
        for (int i = 0; i < 8; ++i) { const int row = (lane >> 3) + 8 * i; const v4u w = *(const v4u*)(proj + (rowb + s0 + row) * DING + C_SBV + h * 64 + 8 * (lane & 7)); *(LAS v4u*)(VL + row * AVLD + 8 * (lane & 7)) = w; }
        f32x16 z0, z1;
#pragma unroll
        for (int r = 0; r < 16; ++r) { z0[r] = 0.f; z1[r] = 0.f; }
#pragma unroll
        for (int kk = 0; kk < 4; ++kk) { z0 = MFMA32(kf[0][kk], qf[kk], z0); z1 = MFMA32(kf[1][kk], qf[kk], z1); }
        const int lim = (s0 == sd) ? (qw - sd) + q : 64;
        f32x16 l0, l1;
#pragma unroll
        for (int r = 0; r < 16; ++r) { const int key = (r & 3) + 8 * (r >> 2) + 4 * h2; l0[r] = key < lim ? lk2(z0[r]) : 0.f; l1[r] = key + 32 < lim ? lk2(z1[r]) : 0.f; }
        const bf16x8 bl0 = pack8(l0, 0), bl1 = pack8(l0, 8), bh0 = pack8(l1, 0), bh1 = pack8(l1, 8);
        f32x16 i0 = z0, i1 = z1;
        i0 = MFMA32(m0[0], bl0, i0); i0 = MFMA32(m0[1], bl1, i0); i0 = MFMA32(ones, bh0, i0); i0 = MFMA32(ones, bh1, i0);
        i1 = MFMA32(m0[0], bh0, i1); i1 = MFMA32(m0[1], bh1, i1);
        float tot = h2 == 0 ? i0[0] - z0[0] : 0.f; tot += __shfl_xor(tot, 32);
#pragma unroll
        for (int r = 0; r < 16; ++r) { const int key = (r & 3) + 8 * (r >> 2) + 4 * h2; l0[r] = key < lim ? __builtin_amdgcn_exp2f(i0[r] + R) : 0.f; l1[r] = key + 32 < lim ? __builtin_amdgcn_exp2f(i1[r] + R) : 0.f; }
        R += tot;
        const bf16x8 pa0 = pack8(l0, 0), pa1 = pack8(l0, 8), pa2 = pack8(l1, 0), pa3 = pack8(l1, 8);
        const LAS bf16* vb = VL + (4 * h2 + ((lane & 15) >> 2)) * AVLD + 16 * ((lane >> 4) & 1) + 4 * (lane & 3);
#define VFRAG(kb, db) ({ const s16x4 lo_ = __builtin_bit_cast(s16x4, __builtin_amdgcn_ds_read_tr16_b64_v4i16((LAS v4i16_t*)(vb + (kb) * AVLD + (db) * 32))); \
                         const s16x4 hi_ = __builtin_bit_cast(s16x4, __builtin_amdgcn_ds_read_tr16_b64_v4i16((LAS v4i16_t*)(vb + ((kb) + 8) * AVLD + (db) * 32))); \
                         (bf16x8){lo_[0], lo_[1], lo_[2], lo_[3], hi_[0], hi_[1], hi_[2], hi_[3]}; })
        o0 = MFMA32(pa0, VFRAG(0, 0), o0); o1 = MFMA32(pa0, VFRAG(0, 1), o1);
        o0 = MFMA32(pa1, VFRAG(16, 0), o0); o1 = MFMA32(pa1, VFRAG(16, 1), o1);
        o0 = MFMA32(pa2, VFRAG(32, 0), o0); o1 = MFMA32(pa2, VFRAG(32, 1), o1);
        o0 = MFMA32(pa3, VFRAG(48, 0), o0); o1 = MFMA32(pa3, VFRAG(48, 1), o1);
#undef VFRAG
#pragma unroll
        for (int hf = 0; hf < 2; ++hf)
#pragma unroll
            for (int kk = 0; kk < 4; ++kk) kf[hf][kk] = kn[hf][kk];
        if (__all(R < -127.0f)) break;
    }
    float* op = oraw + (rowb + qw) * DM + h * 64 + q;
#pragma unroll
    for (int r = 0; r < 16; ++r) { const int qq = (r & 3) + 8 * (r >> 2) + 4 * h2; op[(size_t)qq * DM] = o0[r]; op[(size_t)qq * DM + 32] = o1[r]; }
}


constexpr int NPL = 11, NPHASE = 1 + NPL * DEPTH;
struct Args { const float* in[29]; float* out; unsigned char* ws; int ph_lo, ph_hi, use_bar, pad; };

typedef const __attribute__((address_space(4))) Args* KArgP;
__device__ __forceinline__ KArgP kargs() { KArgP p = (KArgP)__builtin_amdgcn_kernarg_segment_ptr(); asm volatile("" : "+s"(p)); return p; }
#define WSP(type, off) ((type*)(kargs()->ws + (off)))
#define INP(i) (kargs()->in[i])

constexpr int CV_MOE = NE * IT_GU + NE * IT_DN;
constexpr int CV_TAILQ = 5, CV_TAILW = (256 - 64) * NWAVES;
constexpr int CV_TAIL = CV_TAILQ * CV_TAILW;
constexpr int CV_SMALL = NIT_WIN + NIT_WOUT;
#ifndef CV_SLOT_MASK
#define CV_SLOT_MASK 0
#endif
constexpr int CV_GHQ = 3;
constexpr int CV_P0_ITEMS = CV_SMALL + (CV_MOE - CV_TAIL);
__device__ __forceinline__ TDesc cv_moe(int l, int r) { TDesc d;
    if (r < NE * IT_GU) { const int le = l * NE + r / IT_GU, q = r % IT_GU; d.W = INP(24) + (size_t)le * DM * 2048; d.ldw = 2048; d.WT = WSP(bf16, WS_WGU) + (size_t)le * 2048 * DM; d.K = DM; d.k0 = 64 * (q / 32); d.n0 = 64 * (q % 32); d.gu = 1; return d; }
    r -= NE * IT_GU;
    { const int le = l * NE + r / IT_DN, q = r % IT_DN; d.W = INP(26) + (size_t)le * DFF * DM; d.ldw = DM; d.WT = WSP(bf16, WS_WDN) + (size_t)le * DM * DFF; d.K = DFF; d.k0 = 64 * (q / 16); d.n0 = 64 * (q % 16); d.gu = 0; return d; } }
__device__ __forceinline__ TDesc cv_p0(int r) { TDesc d;
    if (r < NIT_WIN) { const int l = r / IT_WIN, q = r % IT_WIN; d.W = INP(2) + (size_t)l * DM * DIN; d.ldw = DIN; d.WT = WSP(bf16, WS_WIN) + (size_t)l * DING * DM; d.K = DM; d.k0 = 64 * (q / 52); d.n0 = 64 * (q % 52); d.gu = 0; return d; }
    r -= NIT_WIN;
    if (r < NIT_WOUT) { const int l = r / IT_WOUT, q = r % IT_WOUT; d.W = INP(20) + (size_t)l * DM * DM; d.ldw = DM; d.WT = WSP(bf16, WS_WOUT) + (size_t)l * DM * DM; d.K = DM; d.k0 = 64 * (q / 16); d.n0 = 64 * (q % 16); d.gu = 0; return d; }
    r -= NIT_WOUT;
    return cv_moe(0, CV_TAIL + r); }
__device__ __forceinline__ void convert_items(int n, int first, int stride, int tail_layer_p1, LAS float* scr, int lane) {
    int it = first; TDesc dc, dn; f32x4 va[16], vb[16];
    if (it < n) { dc = tail_layer_p1 ? cv_moe(tail_layer_p1 - 1, it) : cv_p0(it); tload(dc, va, lane); }
    while (it < n) { const int nx = it + stride; const bool hn = nx < n;
        if (hn) { dn = tail_layer_p1 ? cv_moe(tail_layer_p1 - 1, nx) : cv_p0(nx); tload(dn, vb, lane); }
        tstore(dc, va, scr, lane);
        if (hn) { dc = dn;
#pragma unroll
            for (int i = 0; i < 16; ++i) va[i] = vb[i]; }
        it = nx; }
}

__global__ void __launch_bounds__(NTHR, 2) fwd_kernel(Args args_unused) {
    extern __shared__ __attribute__((aligned(16))) unsigned char lds_raw[];
    LAS unsigned char* lds = (LAS unsigned char*)lds_raw;
    LAS float* ldsf = (LAS float*)lds_raw;
    volatile LAS unsigned* MISC = (volatile LAS unsigned*)(lds + MISC_OFF);
    LAS int* tb = (LAS int*)(lds + TB_OFF);
    const int tid0 = threadIdx.x;
#define PH_IDS int tid = threadIdx.x; asm volatile("" : "+v"(tid)); const int lane = tid & 63, wave = __builtin_amdgcn_readfirstlane(tid >> 6); const int gw = vcu * NWAVES + wave; (void)lane; (void)gw;
    const int G = gridDim.x, bx = blockIdx.x;
    const int vcu = (G % 8 == 0) ? (bx % 8) * (G / 8) + bx / 8 : bx;
    const int NGW = G * NWAVES;
    gu32* ctl = (gu32*)WSP(unsigned char, WS_CTL);

    for (int u = tid0; u < (LDS_BYTES - LDSCTL_OFF) / 4; u += NTHR) ((LAS unsigned*)(lds + LDSCTL_OFF))[u] = 0u;
    __syncthreads();
    XcdBarrier bar; bar.bar = (unsigned*)(ctl + CW_BAR); bar.x = 0; bar.st = nullptr;
    if (kargs()->use_bar) bar = xcd_barrier_post((unsigned*)(ctl + CW_BAR), MISC + 8);
    const int lo = kargs()->ph_lo, hi = kargs()->ph_hi;
#ifndef PH_MASK
#define PH_MASK 0xfff
#endif
#ifndef REP_MASK
#define REP_MASK 0
#endif
#define IN(k) (lo <= (k) && (k) < hi)
#define EN(ty) ((PH_MASK >> (ty)) & 1)
#define REPS(ty) (1 + ((REP_MASK >> (ty)) & 1))
#ifndef REP2_MASK
#define REP2_MASK 0
#endif
#define SUB(bit) _Pragma("unroll 1") for (int rep2_ = 0; rep2_ < 1 + ((REP2_MASK >> (bit)) & 1); ++rep2_)
#define SEAM(k) do { if (IN(k) && IN((k) + 1)) xcd_barrier(bar); } while (0)
#define PHASE(ty, k) if (EN(ty) && IN(k)) _Pragma("unroll 1") for (int rep_ = 0; rep_ < REPS(ty); ++rep_)

    PHASE(11, 0) { PH_IDS
        LAS float* scr = ldsf + wave * (64 * 65);
        convert_items(CV_P0_ITEMS, gw, NGW, 0, scr, lane);
        for (int idx = gw * 64 + lane; idx < DEPTH * 4 * 4096; idx += NGW * 64) { const int i = idx & 63, j = (idx >> 6) & 63, ln = idx >> 12;
            WSP(bf16, WS_WAT)[idx] = (bf16)f2bf(INP(6)[(size_t)ln * 4096 + i * 64 + j]); WSP(bf16, WS_WAT + 512 * 1024)[idx] = (bf16)f2bf(INP(8)[(size_t)ln * 4096 + i * 64 + j]); }
        for (int idx = gw * 64 + lane; idx < DEPTH * NE * DM; idx += NGW * 64) { const int k = idx & 1023, e = (idx >> 10) & 31, ll = idx >> 15;
            const float w = INP(21)[ll * DM + k] * INP(22)[((size_t)ll * DM + k) * NE + e]; const unsigned hi = f2bf(w); const float lo = w - __uint_as_float(hi << 16);
            bf16* dst = WSP(bf16, WS_RWB) + (size_t)ll * 2 * NE * DM + e * DM + k; dst[0] = (bf16)hi; dst[NE * DM] = (bf16)f2bf(lo); }
        if (gw == 0) for (int c = lane; c < 256; c += 64) { const float x0 = INP(12)[c], x1 = INP(12)[256 + c], mx = fmaxf(x0, x1), e0 = expf(x0 - mx), e1 = expf(x1 - mx); WSP(float, WS_LB1)[c] = e1 / (e0 + e1); }
        for (int m = gw; m < T; m += NGW) { f32x4 v[4];
#pragma unroll
            for (int j = 0; j < 4; ++j) v[j] = *(const f32x4*)(INP(0) + (size_t)m * DM + 256 * j + 4 * lane);
            emit_xn_dt(v, INP(1), INP(2), WSP(bf16, WS_XN) + (size_t)m * DM, WSP(float, WS_DT) + (size_t)m * 4, lane); }
    }
    SEAM(0);

#pragma unroll 1
    for (int l = 0; l < DEPTH; ++l) {
        const int P = 1 + NPL * l;
        PHASE(0, P) { PH_IDS
            pg8::Gemm g{WSP(bf16, WS_XN), WSP(bf16, WS_WIN) + (size_t)l * DING * DM, T, DING, DM}; pg8::StaticOrder S; S.init(T, DING, G, bx);
            pg8::EpiBf16 E{WSP(bf16, WS_PROJ), DING, nullptr, 0};
            pg8::gemm_phase<pg8::EpiBf16, pg8::StaticOrder, true, true>(lds, g, S, E);
            if (G == 256 && bx >= 64) convert_items(CV_TAIL, (bx - 64) * NWAVES + wave, CV_TAILW, l + 1, ldsf + wave * (64 * 65), lane);
            else if (G != 256) convert_items(CV_TAIL, gw, NGW, l + 1, ldsf + wave * (64 * 65), lane);
            __syncthreads();
        }
        SEAM(P);
#ifndef CV_SLOT_MASK
#define CV_SLOT_MASK 0
#endif
#define CV_SLOT_BEGIN(site, s) TDesc cd_; f32x4 cv_[16]; const int ci_ = CV_TAIL + (s) * NGW + gw; const bool ch_ = ((CV_SLOT_MASK >> (site)) & 1) && ci_ < CV_MOE; if (ch_) { cd_ = cv_moe(l, ci_); tload(cd_, cv_, lane); }
#define LAUNDER_TID int tidu = threadIdx.x; asm volatile("" : "+v"(tidu));
#define CV_SLOT_END() if (ch_) tstore(cd_, cv_, ldsf + wave * (64 * 65), lane); __syncthreads();
        PHASE(1, P + 1) { PH_IDS
            { const int v = vcu, b = v >> 5, ch = v & 31;
                SUB(0)
#pragma unroll 1
                for (int g = 0; g < 2; ++g) { LAUNDER_TID CV_SLOT_BEGIN(0, g) m2_state_unit(WSP(bf16, WS_PROJ), WSP(float, WS_DT), WSP(float, WS_SLOC), WSP(float, WS_DEC), b, ch, g, INP(14) + l * 3072, INP(15) + l * 768, INP(16) + l * 4, INP(17) + l * 4, lds, tidu); CV_SLOT_END() }
                SUB(1)
#pragma unroll 1
                for (int g = 0; g < 2; ++g) { LAUNDER_TID CV_SLOT_BEGIN(1, 2 + g) hg_state_unit(WSP(bf16, WS_PROJ), WSP(float, WS_SLT), WSP(float, WS_DECC), b, ch, g, WSP(float, WS_LB1), l, lds, tidu); CV_SLOT_END() }
                SUB(2)
#pragma unroll 1
                for (int g = 0; g < 2; ++g) { LAUNDER_TID CV_SLOT_BEGIN(2, 4 + g) rg_local_unit(WSP(bf16, WS_PROJ), WSP(float, WS_HLOC), WSP(float, WS_PCUM), WSP(float, WS_RGS), b, ch, g, INP(4) + l * 1024, INP(5) + l * 256, WSP(bf16, WS_WAT) + l * 16384, WSP(bf16, WS_WAT + 512 * 1024) + l * 16384, INP(7) + l * 256, INP(9) + l * 256, INP(10) + l * 256, lds, tidu); CV_SLOT_END() }
            }
            SUB(3) { __syncthreads();
            for (int u = gw; u < 2048; u += NGW) { const int qb = 63 - (u >> 5), bh = u & 31; attn_unit(WSP(bf16, WS_PROJ), WSP(float, WS_ORAW), bh >> 2, bh & 3, qb, (LAS bf16*)(lds + wave * (64 * AVLD * 2)), lane); }
            __syncthreads(); }
        }
        SEAM(P + 1);
        PHASE(2, P + 2) { PH_IDS
            { float* sl = WSP(float, WS_SLOC); const float* dc = WSP(float, WS_DEC); bf16* pb = WSP(bf16, WS_PREVB);
                const int e = (vcu * NTHR + tid) * 2, n = e & 127, p = (e >> 7) & 63, h = (e >> 13) & 3, b = e >> 15;
                if (b < NB) { float r0 = 0.f, r1 = 0.f;
#pragma unroll 8
                    for (int c = 0; c < 32; ++c) { float* a = sl + ((size_t)((b * 32 + c) * 4 + h) * 64 + p) * 128 + n; const float d = dc[(b * 32 + c) * 4 + h];
                        const float s0 = a[0], s1 = a[1]; *(unsigned*)(pb + (a - sl)) = pk2(r0, r1); r0 = d * r0 + s0; r1 = d * r1 + s1; } } }
            { float* sl = WSP(float, WS_SLT); const float* dc = WSP(float, WS_DECC); bf16* pb = WSP(bf16, WS_STB);
                const int e = vcu * NTHR + tid, c = e & 63, v = (e >> 6) & 63, h = (e >> 12) & 3, b = e >> 14;
                if (b < NB) { float r = 0.f;
#pragma unroll 8
                    for (int k = 0; k < 32; ++k) { float* a = sl + ((size_t)((b * 32 + k) * 4 + h) * 64 + v) * 64 + c; const float d = dc[(size_t)((b * 32 + k) * 4 + h) * 64 + c];
                        const float s0 = a[0]; pb[a - sl] = (bf16)f2bf(r); r = d * r + s0; } } }
            { const int e = vcu * NTHR + tid;
                if (e < NB * 256) { const int b = e >> 8, c = e & 255; const float* rs = WSP(float, WS_RGS); float* cy = WSP(float, WS_CARRY); float r = 0.f;
#pragma unroll 8
                    for (int k = 0; k < 32; ++k) { const size_t o = (size_t)(b * 32 + k) * 256 + c; cy[o] = r; r = rs[2 * o] * r + rs[2 * o + 1]; } } }
        }
        SEAM(P + 2);
        PHASE(3, P + 3) { PH_IDS
            { const int v = vcu, b = v >> 5, ch = v & 31;
                SUB(4)
#pragma unroll 1
                for (int g = 0; g < 2; ++g) { LAUNDER_TID m2_out_unit(WSP(bf16, WS_PROJ), WSP(float, WS_DT), WSP(bf16, WS_PREVB), WSP(float, WS_ORAW), b, ch, g, INP(14) + l * 3072, INP(15) + l * 768, INP(16) + l * 4, INP(17) + l * 4, INP(18) + l * 4, lds, tidu); }
                SUB(5)
#pragma unroll 1
                for (int g = 0; g < 2; ++g) { LAUNDER_TID CV_SLOT_BEGIN(3, 6 + g) hg_out_unit(WSP(bf16, WS_PROJ), WSP(bf16, WS_STB), WSP(float, WS_ORAW), b, ch, g, WSP(float, WS_LB1), l, lds, tidu); CV_SLOT_END() }
                SUB(6)
                { CV_SLOT_BEGIN(4, 8)
                    const float* hl = WSP(float, WS_HLOC); const float* pc = WSP(float, WS_PCUM); const float* cy = WSP(float, WS_CARRY); const bf16* pj = WSP(bf16, WS_PROJ); float* orw = WSP(float, WS_ORAW);
                    _Pragma("unroll 1") for (int r = 0; r < 8; ++r) { const int m = v * 64 + wave * 8 + r, c = 4 * lane; const size_t cb = (size_t)v * 256 + c;
                        const f32x4 hv = *(const f32x4*)(hl + (size_t)m * 256 + c), pv = *(const f32x4*)(pc + (size_t)m * 256 + c), cv = *(const f32x4*)(cy + cb);
                        const u32x2 gwd = *(const u32x2*)(pj + (size_t)m * DING + C_RGG + c);
                        f32x4 o = hv + pv * cv; o[0] *= gelu_tanh(bflo(gwd.x)); o[1] *= gelu_tanh(bfhi(gwd.x)); o[2] *= gelu_tanh(bflo(gwd.y)); o[3] *= gelu_tanh(bfhi(gwd.y));
                        *(f32x4*)(orw + (size_t)m * DM + 256 + c) = o; }
                    CV_SLOT_END()
                }
                _Pragma("unroll 1") for (int r = 0; r < 8; ++r) { const int m = v * 64 + wave * 8 + r;
                    norm_row(WSP(float, WS_ORAW) + (size_t)m * DM, WSP(bf16, WS_PROJ) + (size_t)m * DING, WSP(bf16, WS_MIX) + (size_t)m * DM, INP(3) + l * 256, INP(11) + l * 256, INP(13) + l * 256, INP(19) + l * 256, lane); }
            }
        }
        SEAM(P + 3);
        PHASE(5, P + 5) { PH_IDS
            pg8::Gemm g{WSP(bf16, WS_MIX), WSP(bf16, WS_WOUT) + (size_t)l * DM * DM, T, DM, DM}; pg8::StaticOrder S; S.init(T, DM, G, bx);
            if (l == 0) { pg8::EpiResBf16<true> E{INP(0), WSP(bf16, WS_H1), DM}; pg8::gemm_phase<pg8::EpiResBf16<true>, pg8::StaticOrder, true, true>(lds, g, S, E); }
            else { pg8::EpiResBf16<false> E{WSP(bf16, WS_HB), WSP(bf16, WS_H1), DM}; pg8::gemm_phase<pg8::EpiResBf16<false>, pg8::StaticOrder, true, true>(lds, g, S, E); }
        }
        SEAM(P + 5);
        PHASE(6, P + 6) { PH_IDS
            constexpr int WLD = 1032;
            LAS bf16* WB = (LAS bf16*)lds; LAS float* LG = (LAS float*)(lds + 2 * 32 * WLD * 2); LAS float* SS = LG + 64 * 33; LAS float* RS = SS + 64;
            { const bf16* src = WSP(bf16, WS_RWB) + (size_t)l * 2 * 32 * 1024; v4u wv[16];
#pragma unroll
                for (int i = 0; i < 16; ++i) wv[i] = *(const v4u*)(src + (size_t)(tid + NTHR * i) * 8);
#pragma unroll
                for (int i = 0; i < 16; ++i) { const int c = tid + NTHR * i; *(LAS v4u*)(WB + (c >> 7) * WLD + (c & 127) * 8) = wv[i]; } }
            __syncthreads();
            const bf16* h1 = WSP(bf16, WS_H1);
            { const int rt = wave >> 1, et = wave & 1; const bf16* hp = h1 + (size_t)(vcu * 64 + rt * 16 + (lane & 15)) * DM + 8 * (lane >> 4);
                f32x4 acc = {0.f, 0.f, 0.f, 0.f}; float ssum = 0.f;
#pragma unroll 8
                for (int ks = 0; ks < 32; ++ks) { const bf16x8 a = *(const bf16x8*)(hp + 32 * ks);
                    acc = MFMA16(a, frag_kc(WB, WLD, et * 16, 32 * ks, lane), acc); acc = MFMA16(a, frag_kc(WB + 32 * WLD, WLD, et * 16, 32 * ks, lane), acc);
                    const v4u aw = __builtin_bit_cast(v4u, a);
#pragma unroll
                    for (int i = 0; i < 4; ++i) { const float x0 = bflo(aw[i]), x1 = bfhi(aw[i]); ssum += x0 * x0 + x1 * x1; } }
                ssum += __shfl_xor(ssum, 16); ssum += __shfl_xor(ssum, 32);
                if (et == 0 && lane < 16) SS[rt * 16 + lane] = ssum;
#pragma unroll
                for (int i = 0; i < 4; ++i) LG[(rt * 16 + 4 * (lane >> 4) + i) * 33 + et * 16 + (lane & 15)] = acc[i]; }
            __syncthreads();
            if (wave == 0) { const int row = lane; const float rstd = 1.0f / sqrtf(SS[row] * (1.0f / DM) + EPS); RS[row] = rstd;
                const float* rb = INP(23) + l * NE;
                float lg[32];
#pragma unroll
                for (int e = 0; e < 32; ++e) lg[e] = rstd * LG[row * 33 + e] + rb[e];
                int be[4]; float bl[4];
#pragma unroll
                for (int r = 0; r < 4; ++r) { float best = -INFINITY; int bi = 0;
#pragma unroll
                    for (int e = 0; e < 32; ++e) if (lg[e] > best) { best = lg[e]; bi = e; }
#pragma unroll
                    for (int e = 0; e < 32; ++e) if (e == bi) lg[e] = -INFINITY;
                    be[r] = bi; bl[r] = best; }
                const float e1 = expf(bl[1] - bl[0]), e2 = expf(bl[2] - bl[0]), e3 = expf(bl[3] - bl[0]), inv = 1.0f / (1.0f + e1 + e2 + e3);
                int rk0 = 0, rk1 = 0, rk2 = 0, rk3 = 0, hist = 0; const unsigned long long lt = (1ull << lane) - 1ull;
#pragma unroll
                for (int e = 0; e < 32; ++e) { const bool h0 = be[0] == e, h1b = be[1] == e, h2 = be[2] == e, h3 = be[3] == e; const unsigned long long m = __ballot(h0 | h1b | h2 | h3);
                    const int below = __popcll(m & lt); rk0 = h0 ? below : rk0; rk1 = h1b ? below : rk1; rk2 = h2 ? below : rk2; rk3 = h3 ? below : rk3; if (lane == e) hist = __popcll(m); }
                if (lane < 32) WSP(int, WS_HIST)[(size_t)vcu * 32 + lane] = hist;
                const int a = (vcu * 64 + row) * 4;
                *(int4*)(WSP(int, WS_ASGE) + a) = make_int4(be[0], be[1], be[2], be[3]); *(int4*)(WSP(int, WS_ASGP) + a) = make_int4(rk0, rk1, rk2, rk3);
                *(f32x4*)(WSP(float, WS_GATE) + a) = (f32x4){inv, e1 * inv, e2 * inv, e3 * inv}; }
            __syncthreads();
            { const float* g = INP(21) + l * DM; bf16* xn = WSP(bf16, WS_XN);
#pragma unroll
                for (int r = 0; r < 8; ++r) { const int row = wave * 8 + r; const size_t m = (size_t)vcu * 64 + row; const float rstd = RS[row];
#pragma unroll
                    for (int j = 0; j < 2; ++j) { const int col = 512 * j + 8 * lane; const v4u w = *(const v4u*)(h1 + m * DM + col); const f32x4 g0 = *(const f32x4*)(g + col), g1 = *(const f32x4*)(g + col + 4);
                        v4u o; o.x = pk2(bflo(w.x) * rstd * g0[0], bfhi(w.x) * rstd * g0[1]); o.y = pk2(bflo(w.y) * rstd * g0[2], bfhi(w.y) * rstd * g0[3]);
                        o.z = pk2(bflo(w.z) * rstd * g1[0], bfhi(w.z) * rstd * g1[1]); o.w = pk2(bflo(w.w) * rstd * g1[2], bfhi(w.w) * rstd * g1[3]);
                        *(v4u*)(xn + m * DM + col) = o; } } }
        }
        SEAM(P + 6);
        PHASE(7, P + 7) { PH_IDS
            LAS int* bs = (LAS int*)(lds + 131072);
            if (tid < 32) { const int* hs = WSP(int, WS_HIST); int base = 0, tot = 0;
#pragma unroll 8
                for (int w = 0; w < G; ++w) { const int c = hs[w * 32 + tid]; tot += c; if (w < vcu) base += c; }
                bs[tid] = base; bs[32 + tid] = tot; if (vcu == 0) WSP(int, WS_TOT)[tid] = tot; }
            __syncthreads();
            if (tid == 0) { int run = 0; for (int e = 0; e < 32; ++e) { tb[e] = run; run += (bs[32 + e] + 255) >> 8; } tb[32] = run; }
            __syncthreads();
            const int* asge = WSP(int, WS_ASGE); const int* asgp = WSP(int, WS_ASGP); int* slotp = WSP(int, WS_SLOT); int* toks = (int*)(kargs()->ws + WS_CTL + CTL_TOKS) + (size_t)l * MAXSLOT;
            if (tid < 256) { const int a = vcu * 256 + tid; const int e = asge[a], slot = tb[e] * 256 + bs[e] + asgp[a]; slotp[a] = slot; toks[slot] = a >> 2; }
        }
        SEAM(P + 7);
        PHASE(8, P + 8) { PH_IDS
            build_tb(WSP(int, WS_TOT), tb, tid);
            LAS int* tokl = (LAS int*)(lds + 131072);
            pg8::MoeOrder S{(const LAS int*)tb, 8, G, bx, (const LAS int*)tokl};
            { const int* toks = (const int*)(kargs()->ws + WS_CTL + CTL_TOKS) + (size_t)l * MAXSLOT; pg8::Unit u;
                for (int i = 0; i < 15 && S.next(i, u); ++i) if (tid < 256) tokl[i * 256 + tid] = toks[u.pm * 256 + tid];
                __syncthreads(); }
            pg8::Gemm g{WSP(bf16, WS_XN), WSP(bf16, WS_WGU) + (size_t)l * NE * 2048 * DM, T, 2048, DM};
            pg8::EpiSwiglu E{WSP(bf16, WS_ACT), INP(25) + (size_t)l * NE * 2048};
            pg8::gemm_phase<pg8::EpiSwiglu, pg8::MoeOrder, true, true>(lds, g, S, E);
            if (l + 1 < DEPTH) { const int rem = (tb[32] * 8) % G;
                if (rem != 0 && bx >= rem) { const int nw = (G - rem) * NWAVES; convert_items(CV_TAIL + nw * CV_GHQ, CV_TAIL + (bx - rem) * NWAVES + wave, nw, l + 2, ldsf + wave * (64 * 65), lane); } }
        }
        SEAM(P + 8);
        PHASE(9, P + 9) { PH_IDS
            build_tb(WSP(int, WS_TOT), tb, tid);
            pg8::Gemm g{WSP(bf16, WS_ACT), WSP(bf16, WS_WDN) + (size_t)l * NE * DM * DFF, MAXSLOT, DM, DFF}; pg8::MoeOrder S{(const LAS int*)tb, 4, G, bx};
            pg8::EpiBf16 E{WSP(bf16, WS_Y), DM, INP(27) + (size_t)l * NE * DM, DM};
            pg8::gemm_phase<pg8::EpiBf16, pg8::MoeOrder, true, true>(lds, g, S, E);
            if (l + 1 < DEPTH) { const int remg = (tb[32] * 8) % G, remh = (tb[32] * 4) % G; const int offh = CV_TAIL + (remg ? (G - remg) * NWAVES * CV_GHQ : 0);
                if (remh != 0 && bx >= remh) { const int nw = (G - remh) * NWAVES; convert_items(offh + nw * CV_GHQ, offh + (bx - remh) * NWAVES + wave, nw, l + 2, ldsf + wave * (64 * 65), lane); } }
        }
        SEAM(P + 9);
        PHASE(10, P + 10) { PH_IDS
            if (l + 1 < DEPTH) { build_tb(WSP(int, WS_TOT), tb, tid);
                const int remg = (tb[32] * 8) % G, remh = (tb[32] * 4) % G; const int offc = CV_TAIL + (remg ? (G - remg) * NWAVES * CV_GHQ : 0) + (remh ? (G - remh) * NWAVES * CV_GHQ : 0);
                convert_items(CV_MOE, offc + gw, NGW, l + 2, ldsf + wave * (64 * 65), lane); }
            const bf16* h1 = WSP(bf16, WS_H1); const int* slotp = WSP(int, WS_SLOT); const float* gatep = WSP(float, WS_GATE); const bf16* yb = WSP(bf16, WS_Y);
            for (int m = gw; m < T; m += NGW) { f32x4 v[4];
#pragma unroll
                for (int j = 0; j < 4; ++j) { const u32x2 w = *(const u32x2*)(h1 + (size_t)m * DM + 256 * j + 4 * lane); v[j] = (f32x4){bflo(w.x), bfhi(w.x), bflo(w.y), bfhi(w.y)}; }
#pragma unroll
                for (int r = 0; r < 4; ++r) { const int slot = slotp[m * 4 + r]; const float gg = gatep[m * 4 + r]; const bf16* yr = yb + (size_t)slot * DM;
#pragma unroll
                    for (int j = 0; j < 4; ++j) { const u32x2 w = *(const u32x2*)(yr + 256 * j + 4 * lane); v[j][0] += gg * bflo(w.x); v[j][1] += gg * bfhi(w.x); v[j][2] += gg * bflo(w.y); v[j][3] += gg * bfhi(w.y); } }
                if (l + 1 < DEPTH) {
#pragma unroll
                    for (int j = 0; j < 4; ++j) { u32x2 w; w.x = pk2(v[j][0], v[j][1]); w.y = pk2(v[j][2], v[j][3]); *(u32x2*)(WSP(bf16, WS_HB) + (size_t)m * DM + 256 * j + 4 * lane) = w; }
                    emit_xn_dt(v, INP(1) + (l + 1) * DM, INP(2) + (size_t)(l + 1) * DM * DIN, WSP(bf16, WS_XN) + (size_t)m * DM, WSP(float, WS_DT) + (size_t)m * 4, lane);
                } else { float ss = 0.f;
#pragma unroll
                    for (int j = 0; j < 4; ++j) ss += (v[j][0] * v[j][0] + v[j][1] * v[j][1]) + (v[j][2] * v[j][2] + v[j][3] * v[j][3]);
                    ss = wave_sum(ss); const float rstd = 1.0f / sqrtf(ss * (1.0f / DM) + EPS);
#pragma unroll
                    for (int j = 0; j < 4; ++j) *(f32x4*)(kargs()->out + (size_t)m * DM + 256 * j + 4 * lane) = v[j] * rstd * *(const f32x4*)(INP(28) + 256 * j + 4 * lane); }
            }
        }
        if (l + 1 < DEPTH) SEAM(P + 10);
    }
#undef IN
#undef SEAM
}

extern "C" void kernel_launch(void* const* d_in, const int* in_sizes, int n_in, void* d_out, int out_size, void* d_ws, size_t ws_size, hipStream_t stream) {
    static int grid = 0;
    if (grid == 0) {
        if (n_in != 29 || in_sizes[0] != T * DM || out_size != T * DM || ws_size < WS_END) { fprintf(stderr, "kernel_launch: unexpected shapes (n_in %d, in0 %d, out %d, ws %zu); nothing launched\n", n_in, n_in > 0 ? in_sizes[0] : -1, out_size, ws_size); grid = -1; return; }
        int dev = 0, cus = 0, per_cu = 0;
        if (hipGetDevice(&dev) != hipSuccess || hipDeviceGetAttribute(&cus, hipDeviceAttributeMultiprocessorCount, dev) != hipSuccess) { grid = -1; return; }
        if (hipFuncSetAttribute((const void*)fwd_kernel, hipFuncAttributeMaxDynamicSharedMemorySize, LDS_BYTES) != hipSuccess) { fprintf(stderr, "kernel_launch: hipFuncSetAttribute failed\n"); grid = -1; return; }
        if (hipOccupancyMaxActiveBlocksPerMultiprocessor(&per_cu, (const void*)fwd_kernel, NTHR, LDS_BYTES) != hipSuccess || per_cu < 1) fprintf(stderr, "kernel_launch: occupancy query reports %d\n", per_cu);
        (void)hipGetLastError();
        if (cus != 256) { fprintf(stderr, "kernel_launch: built for a 256-CU device (one workgroup per CU, work lists sized for 256 workgroups); found %d CUs; nothing launched\n", cus); grid = -1; return; }
        grid = cus;
    }
    if (grid < 0) return;
    if (hipMemsetAsync((char*)d_ws + WS_CTL, 0, CTL_ZERO_BYTES, stream) != hipSuccess) { fprintf(stderr, "kernel_launch: memset failed\n"); return; }
    Args a{};
    for (int i = 0; i < 29; ++i) a.in[i] = (const float*)d_in[i];
    a.out = (float*)d_out; a.ws = (unsigned char*)d_ws;
#if MK_N_LAUNCHES == 1
    a.ph_lo = 0; a.ph_hi = NPHASE; a.use_bar = 1;
    hipLaunchKernelGGL(fwd_kernel, dim3(grid), dim3(NTHR), LDS_BYTES, stream, a);
#else
    for (int p = 0; p < NPHASE; ++p) { a.ph_lo = p; a.ph_hi = p + 1; a.use_bar = 0; hipLaunchKernelGGL(fwd_kernel, dim3(grid), dim3(NTHR), LDS_BYTES, stream, a); }
#endif
}
```

```cpp
#include <hip/hip_runtime.h>
#include <cstdio>
#include <cstdint>

#ifndef MK_N_LAUNCHES
#define MK_N_LAUNCHES 1
#endif

constexpr int NB = 8, SEQ = 2048, DM = 1024, T = NB * SEQ, DEPTH = 2;
constexpr int DIN = 3332, DING = 3328;
constexpr int NE = 32, TOPK = 4, DFF = 1024;
constexpr int NASG = T * TOPK;
constexpr int MAXSLOT = NASG + NE * 256;
constexpr float EPS = 1e-6f;
constexpr int C_SBQ = 0, C_SBK = 256, C_SBV = 512, C_RGX = 768, C_RGG = 1024, C_HGQ = 1280, C_HGF = 1536, C_HGI = 1792, C_HGG = 2048,
              C_M2Z = 2304, C_M2X = 2560, C_DT = 3328;
constexpr int NWAVES = 8, NTHR = 512;

constexpr size_t MiB = 1u << 20;
constexpr size_t WS_CTL = 0, CTL_ZERO_BYTES = 1 * MiB;
constexpr size_t WS_WIN = 2 * MiB;
constexpr size_t WS_WOUT = 16 * MiB;
constexpr size_t WS_WGU = 32 * MiB;
constexpr size_t WS_WDN = 288 * MiB;
constexpr size_t WS_XN = 416 * MiB;
constexpr size_t WS_PROJ = 448 * MiB;
constexpr size_t WS_ORAW = 552 * MiB;
constexpr size_t WS_MIX = 616 * MiB;
constexpr size_t WS_H1 = 648 * MiB;
constexpr size_t WS_HB = 712 * MiB;
constexpr size_t WS_XS = 776 * MiB;
constexpr size_t WS_ACT = 920 * MiB;
constexpr size_t WS_Y = 1064 * MiB;
constexpr size_t WS_DT = 1208 * MiB;
constexpr size_t WS_ASGE = 1209 * MiB;
constexpr size_t WS_ASGP = 1210 * MiB;
constexpr size_t WS_GATE = 1211 * MiB;
constexpr size_t WS_SLOT = 1212 * MiB;
constexpr size_t WS_SLOC = 1216 * MiB;
constexpr size_t WS_DEC = 1248 * MiB;
constexpr size_t WS_SLT = 1250 * MiB;
constexpr size_t WS_DECC = 1266 * MiB;
constexpr size_t WS_HLOC = 1268 * MiB;
constexpr size_t WS_PCUM = 1284 * MiB;
constexpr size_t WS_RGS = 1300 * MiB;
constexpr size_t WS_CARRY = 1301 * MiB;
constexpr size_t WS_WAT = 1302 * MiB;
constexpr size_t WS_HIST = 1303 * MiB;
constexpr size_t WS_TOT = WS_HIST + 512 * 1024;
constexpr size_t WS_LB1 = WS_HIST + 768 * 1024;
constexpr size_t WS_PREVB = 1304 * MiB;
constexpr size_t WS_STB = 1320 * MiB;
constexpr size_t WS_RWB = 1328 * MiB;
constexpr size_t WS_END = 1329 * MiB;
constexpr int CW_TMO = 0, CW_CODE = 1;
constexpr int CW_CNT = 256;
constexpr int CW_BAR = 4096;
constexpr size_t CTL_TOKS = 256 * 1024;

constexpr int LDS_BYTES = 147456;
constexpr int LDSCTL_OFF = LDS_BYTES - 1024;
constexpr int MISC_OFF = LDSCTL_OFF;
constexpr int TB_OFF = LDSCTL_OFF + 256;

namespace pg8 {
#define PG8_LAS __attribute__((address_space(3)))
typedef unsigned short bf16_t;
typedef short bf16x8 __attribute__((ext_vector_type(8)));
typedef float f32x4 __attribute__((ext_vector_type(4)));
typedef unsigned u32x4 __attribute__((ext_vector_type(4)));
constexpr int BM = 256, BK = 64, HALF = 128, HTB = HALF * BK * 2  , STAGE_BYTES = 8 * HTB, NXCD = 8, WGM = 8;

__host__ __device__ __forceinline__ int lds_byte(int r, int c) { const int st = (r >> 4) * 2 + (c >> 5), rr = r & 15, cc = c & 31, ob = rr * 64 + cc * 2; return st * 1024 + (ob ^ (((ob >> 9) & 1) << 5)); }
__host__ __device__ __forceinline__ void stage_rc(int b, int& R, int& C) { const int st = b / 1024, sb = b % 1024, swz = sb ^ (((sb >> 9) & 1) << 5); R = (st >> 1) * 16 + swz / 64; C = (st & 1) * 32 + (swz % 64) / 2; }
__host__ __device__ __forceinline__ int perm32(int rho) { const int n = rho >> 4, i = rho & 15; return 8 * (i >> 2) + 4 * n + (i & 3); }

struct Unit { int pm, pn, pb, e, ui; };
struct Gemm { const bf16_t* A; const bf16_t* Bt; int M, N, K; };

__host__ __device__ __forceinline__ int xcd_remap(int wgid, int nwg) { const int q = nwg / NXCD, r = nwg % NXCD, xcd = wgid % NXCD, off = wgid / NXCD; return (xcd < r ? xcd * (q + 1) : r * (q + 1) + (xcd - r) * q) + off; }

struct StaticOrder {
    int nM, nN, nwg, G, c;
    __host__ __device__ void init(int M, int N, int G_, int c_) { nM = M / BM; nN = N / BM; nwg = nM * nN; G = G_; c = c_; }
    __host__ __device__ bool next(int i, Unit& u) const {
        const long L = (long)i * G + c; if (L >= nwg) return false;
        const int wgid = xcd_remap((int)L, nwg);
        const int nig = WGM * nN, gid = wgid / nig, fm = gid * WGM, gsz = (nM - fm) < WGM ? (nM - fm) : WGM;
        u.pm = fm + ((wgid % nig) % gsz); u.pn = (wgid % nig) / gsz; u.pb = u.pn; u.e = 0; u.ui = i; return true;
    }
    __device__ __forceinline__ void a_ready(const Unit&) const {}
    __device__ __forceinline__ void done(const Unit&) const {}
    __device__ __forceinline__ size_t a_base(const Unit& u, size_t tstep) const { return (size_t)u.pm * tstep; }
    __device__ __forceinline__ unsigned a_off(const Unit&, int r, int K) const { return (unsigned)(r * K) * 2u; }
};
struct MoeOrder {
    const PG8_LAS int* tb; int NP, G, c; const PG8_LAS int* tokl;
    __device__ __forceinline__ bool next(int i, Unit& u) const {
        const int ntot = tb[32], nunits = ntot * NP;
        const long L = (long)i * G + c; if (L >= nunits) return false;
        const int id = xcd_remap((int)L, nunits);
        int e = 0;
        for (int j = 1; j < 32; ++j) if (id >= tb[j] * NP) e = j;
        e = __builtin_amdgcn_readfirstlane(e);
        const int t0 = tb[e], nt = tb[e + 1] - t0, rem = id - t0 * NP;
        u.pm = __builtin_amdgcn_readfirstlane(t0 + rem % nt); u.pn = __builtin_amdgcn_readfirstlane(rem / nt); u.pb = e * NP + u.pn; u.e = e; u.ui = i; return true;
    }
    __device__ __forceinline__ void a_ready(const Unit&) const {}
    __device__ __forceinline__ void done(const Unit&) const {}
    __device__ __forceinline__ size_t a_base(const Unit& u, size_t tstep) const { return tokl ? (size_t)0 : (size_t)u.pm * tstep; }
    __device__ __forceinline__ unsigned a_off(const Unit& u, int r, int K) const { return tokl ? (unsigned)(tokl[u.ui * 256 + r] * K) * 2u : (unsigned)(r * K) * 2u; }
};

__device__ __forceinline__ unsigned cvt_pk_bf16(float lo, float hi) { unsigned r; asm volatile("v_cvt_pk_bf16_f32 %0, %1, %2" : "=v"(r) : "v"(lo), "v"(hi)); return r; }

struct EpiBf16 {
    static constexpr bool PERM = true, AFTER_DRAIN = false;
    bf16_t* O; int ldc; const float* bias; int bias_estride;
    __device__ __forceinline__ void operator()(const f32x4 (&acc)[2][2][4][2], const Unit& u, int wr, int wc, int fr, int fq) const {
        const int row0 = u.pm * BM + wr * 64 + fr; const int col0 = u.pn * BM + wc * 32 + 8 * fq;
        f32x4 bv[2][2];
#pragma unroll
        for (int bj = 0; bj < 2; ++bj)
#pragma unroll
            for (int n = 0; n < 2; ++n) bv[bj][n] = bias ? *(const f32x4*)(bias + (size_t)u.e * bias_estride + col0 + bj * HALF + 4 * n) : (f32x4){0.f, 0.f, 0.f, 0.f};
#pragma unroll
        for (int ai = 0; ai < 2; ++ai)
#pragma unroll
            for (int m = 0; m < 4; ++m) { bf16_t* rowp = O + (size_t)(row0 + ai * HALF + m * 16) * ldc + col0;
#pragma unroll
                for (int bj = 0; bj < 2; ++bj) { const f32x4 v0 = acc[ai][bj][m][0] + bv[bj][0], v1 = acc[ai][bj][m][1] + bv[bj][1];
                    u32x4 w; w.x = cvt_pk_bf16(v0[0], v0[1]); w.y = cvt_pk_bf16(v0[2], v0[3]); w.z = cvt_pk_bf16(v1[0], v1[1]); w.w = cvt_pk_bf16(v1[2], v1[3]);
                    *(u32x4*)(rowp + bj * HALF) = w; } }
    }
};
template <bool BASE_F32> struct EpiResBf16 {
    static constexpr bool PERM = true, AFTER_DRAIN = false;
    const void* base; bf16_t* out; int ldc;
    __device__ __forceinline__ void operator()(const f32x4 (&acc)[2][2][4][2], const Unit& u, int wr, int wc, int fr, int fq) const {
        const int row0 = u.pm * BM + wr * 64 + fr, col0 = u.pn * BM + wc * 32 + 8 * fq;
#pragma unroll
        for (int ai = 0; ai < 2; ++ai)
#pragma unroll
            for (int m = 0; m < 4; ++m) { const size_t off = (size_t)(row0 + ai * HALF + m * 16) * ldc + col0;
#pragma unroll
                for (int bj = 0; bj < 2; ++bj) { f32x4 b0, b1;
                    if (BASE_F32) { const float* bp = (const float*)base + off + bj * HALF; b0 = *(const f32x4*)bp; b1 = *(const f32x4*)(bp + 4); }
                    else { const u32x4 w = *(const u32x4*)((const bf16_t*)base + off + bj * HALF);
                        b0 = (f32x4){__uint_as_float(w.x << 16), __uint_as_float(w.x & 0xffff0000u), __uint_as_float(w.y << 16), __uint_as_float(w.y & 0xffff0000u)};
                        b1 = (f32x4){__uint_as_float(w.z << 16), __uint_as_float(w.z & 0xffff0000u), __uint_as_float(w.w << 16), __uint_as_float(w.w & 0xffff0000u)}; }
                    const f32x4 v0 = b0 + acc[ai][bj][m][0], v1 = b1 + acc[ai][bj][m][1];
                    u32x4 o; o.x = cvt_pk_bf16(v0[0], v0[1]); o.y = cvt_pk_bf16(v0[2], v0[3]); o.z = cvt_pk_bf16(v1[0], v1[1]); o.w = cvt_pk_bf16(v1[2], v1[3]);
                    *(u32x4*)(out + off + bj * HALF) = o; } }
    }
};
struct EpiSwiglu {
    static constexpr bool PERM = true, AFTER_DRAIN = false;
    bf16_t* O; const float* bias;
    __device__ __forceinline__ void operator()(const f32x4 (&acc)[2][2][4][2], const Unit& u, int wr, int wc, int fr, int fq) const {
        const int row0 = u.pm * BM + wr * 64 + fr; const int a0 = u.pn * HALF + wc * 32 + 8 * fq;
        const float* bp = bias + (size_t)u.e * 2048 + 2 * a0;
        f32x4 b4[4];
#pragma unroll
        for (int j = 0; j < 4; ++j) b4[j] = *(const f32x4*)(bp + 4 * j);
#pragma unroll
        for (int ai = 0; ai < 2; ++ai)
#pragma unroll
            for (int m = 0; m < 4; ++m) { bf16_t* rowp = O + (size_t)(row0 + ai * HALF + m * 16) * 1024 + a0;
                float a[8];
#pragma unroll
                for (int n = 0; n < 2; ++n)
#pragma unroll
                    for (int i = 0; i < 4; ++i) { const int k = 4 * n + i;
                        float g = acc[ai][0][m][n][i] + b4[k >> 1][2 * (k & 1)], l = acc[ai][1][m][n][i] + b4[k >> 1][2 * (k & 1) + 1];
                        g = fminf(g, 7.0f); l = fminf(fmaxf(l, -7.0f), 7.0f);
                        const float sg = __builtin_amdgcn_rcpf(1.0f + __builtin_amdgcn_exp2f(-1.702f * 1.4426950408889634f * g));
                        a[k] = g * sg * (l + 1.0f); }
                u32x4 w; w.x = cvt_pk_bf16(a[0], a[1]); w.y = cvt_pk_bf16(a[2], a[3]); w.z = cvt_pk_bf16(a[4], a[5]); w.w = cvt_pk_bf16(a[6], a[7]);
                *(u32x4*)rowp = w; }
    }
};

template <class Epi, class Sched, bool ALIGN_EPI = false, bool SP2 = false>
__device__ __forceinline__ void gemm_phase(PG8_LAS unsigned char* lds, const Gemm g, const Sched& S, const Epi& E) {
    int tid = threadIdx.x; asm volatile("" : "+v"(tid));
    const int wid = __builtin_amdgcn_readfirstlane(tid >> 6), lane = tid & 63, wr = wid >> 2, wc = wid & 3, fr = lane & 15, fq = lane >> 4;
    const int K = g.K, nt = K / BK;
    unsigned vAc[2][2], vAn[2][2], voffB[2];
    int sR[2], sC[2];
#pragma unroll
    for (int i = 0; i < 2; ++i) { int R, C; stage_rc(tid * 16 + i * 8192, R, C); const int Rb = Epi::PERM ? ((R & ~31) + perm32(R & 31)) : R;
        sR[i] = R; sC[i] = C; voffB[i] = (unsigned)(Rb * K + C) * 2u; }
    const size_t kstep = (size_t)(BK * 2);
    const size_t hstep = (size_t)HALF * K * 2;
    const size_t tstep = 2 * hstep;
    const unsigned ldsw = (unsigned)wid * 1024u;
    const int aoff = lds_byte(wr * 64 + fr, fq * 8), boff = lds_byte(wc * 32 + fr, fq * 8);
#define PG8_SA(b, h) (((b) * 2 + (h)) * HTB)
#define PG8_SB(b, h) ((4 + (b) * 2 + (h)) * HTB)
#define PG8_STAGE(bufoff, gbase, voff) do { _Pragma("unroll") for (int _i = 0; _i < 2; ++_i) \
        __builtin_amdgcn_global_load_lds((const unsigned*)((const char*)(gbase) + (voff)[_i]), (PG8_LAS unsigned*)(lds + (bufoff) + ldsw + _i * 8192), 16, 0, 0); } while (0)
#define PG8_LDA(dst, b, h) do { _Pragma("unroll") for (int m = 0; m < 4; ++m) _Pragma("unroll") for (int k = 0; k < 2; ++k) dst[m][k] = *(const PG8_LAS bf16x8*)(lds + PG8_SA(b, h) + aoff + m * 2048 + k * 1024); } while (0)
#define PG8_LDB(dst, b, h) do { _Pragma("unroll") for (int n = 0; n < 2; ++n) _Pragma("unroll") for (int k = 0; k < 2; ++k) dst[n][k] = *(const PG8_LAS bf16x8*)(lds + PG8_SB(b, h) + boff + n * 2048 + k * 1024); } while (0)
#define PG8_MMA(ai, bj, At, Bt) do { __builtin_amdgcn_s_setprio(1); _Pragma("unroll") for (int m = 0; m < 4; ++m) _Pragma("unroll") for (int n = 0; n < 2; ++n) _Pragma("unroll") for (int k = 0; k < 2; ++k) \
        acc[ai][bj][m][n] = __builtin_amdgcn_mfma_f32_16x16x32_bf16(Bt[n][k], At[m][k], acc[ai][bj][m][n], 0, 0, 0); __builtin_amdgcn_s_setprio(0); } while (0)
#define PG8_WAIT_V(n) asm volatile("s_waitcnt vmcnt(" #n ")" ::: "memory")
#define PG8_WAIT_L(n) asm volatile("s_waitcnt lgkmcnt(" #n ")" ::: "memory")
#define PG8_BAR __builtin_amdgcn_s_barrier()
#define PG8_SCHED __builtin_amdgcn_sched_barrier(0)
    Unit cur, nxt; int ui = 0;
    if (!S.next(0, cur)) return;
    f32x4 acc[2][2][4][2];
#pragma unroll
    for (int a = 0; a < 2; ++a)
#pragma unroll
        for (int b = 0; b < 2; ++b)
#pragma unroll
            for (int m = 0; m < 4; ++m)
#pragma unroll
                for (int n = 0; n < 2; ++n) acc[a][b][m][n] = (f32x4){0.f, 0.f, 0.f, 0.f};
    bf16x8 At[4][2], B0[2][2], B1[2][2];
    const char* cA = (const char*)g.A + S.a_base(cur, tstep); const char* cB = (const char*)g.Bt + (size_t)cur.pb * tstep;
#pragma unroll
    for (int h = 0; h < 2; ++h)
#pragma unroll
        for (int i = 0; i < 2; ++i) { vAc[h][i] = S.a_off(cur, h * HALF + sR[i], K) + (unsigned)sC[i] * 2u; vAn[h][i] = vAc[h][i]; }
    S.a_ready(cur);
    if constexpr (SP2) {
        PG8_STAGE(PG8_SB(0, 0), cB, voffB); PG8_STAGE(PG8_SB(0, 1), cB + hstep, voffB); PG8_STAGE(PG8_SA(0, 0), cA, vAc[0]); PG8_STAGE(PG8_SA(0, 1), cA, vAc[1]);
        if (wr == 1) PG8_BAR;
        PG8_WAIT_V(2); PG8_BAR;
        PG8_STAGE(PG8_SB(1, 0), cB + kstep, voffB); PG8_STAGE(PG8_SA(1, 0), cA + kstep, vAc[0]); PG8_STAGE(PG8_SB(1, 1), cB + hstep + kstep, voffB);
        PG8_WAIT_V(6); PG8_BAR;
    } else {
        PG8_STAGE(PG8_SB(0, 0), cB, voffB); PG8_STAGE(PG8_SA(0, 0), cA, vAc[0]); PG8_STAGE(PG8_SB(0, 1), cB + hstep, voffB); PG8_STAGE(PG8_SA(0, 1), cA, vAc[1]);
        if (wr == 1) PG8_BAR;
        PG8_WAIT_V(4); PG8_BAR;
        PG8_STAGE(PG8_SB(1, 0), cB + kstep, voffB); PG8_STAGE(PG8_SA(1, 0), cA + kstep, vAc[0]); PG8_STAGE(PG8_SB(1, 1), cB + hstep + kstep, voffB);
        PG8_WAIT_V(6); PG8_BAR;
    }
    for (;;) {
        const bool has_next = S.next(ui + 1, nxt);
        const char* nA = has_next ? (const char*)g.A + S.a_base(nxt, tstep) : cA;
        if (has_next) {
#pragma unroll
            for (int h = 0; h < 2; ++h)
#pragma unroll
                for (int i = 0; i < 2; ++i) vAn[h][i] = S.a_off(nxt, h * HALF + sR[i], K) + (unsigned)sC[i] * 2u; } const char* nB = has_next ? (const char*)g.Bt + (size_t)nxt.pb * tstep : cB;
        for (int t = 0; t < nt; t += 2) {
            const bool last = (t == nt - 2);
            const char* a1 = cA + (size_t)(t + 1) * kstep;
            const char* a2 = last ? nA : cA + (size_t)(t + 2) * kstep; const char* b2 = last ? nB : cB + (size_t)(t + 2) * kstep;
            const char* a3 = a2 + kstep; const char* b3 = b2 + kstep;
            unsigned v2[2][2];
#pragma unroll
            for (int h = 0; h < 2; ++h)
#pragma unroll
                for (int i = 0; i < 2; ++i) v2[h][i] = last ? vAn[h][i] : vAc[h][i];
            if (last && has_next) S.a_ready(nxt);
            if constexpr (SP2) {
            PG8_LDB(B0, 0, 0); PG8_LDB(B1, 0, 1); PG8_SCHED; PG8_LDA(At, 0, 0); PG8_STAGE(PG8_SA(1, 1), a1, vAc[1]);
            PG8_WAIT_V(8); PG8_WAIT_L(0); PG8_BAR; PG8_MMA(0, 0, At, B0); PG8_MMA(0, 1, At, B1); PG8_BAR; PG8_SCHED;
            PG8_LDA(At, 0, 1); PG8_STAGE(PG8_SB(0, 0), b2, voffB); PG8_STAGE(PG8_SB(0, 1), b2 + hstep, voffB); PG8_STAGE(PG8_SA(0, 0), a2, v2[0]);
            PG8_WAIT_V(8); PG8_WAIT_L(0); PG8_BAR; PG8_MMA(1, 0, At, B0); PG8_MMA(1, 1, At, B1); PG8_BAR; PG8_SCHED;
            PG8_LDB(B0, 1, 0); PG8_LDB(B1, 1, 1); PG8_SCHED; PG8_LDA(At, 1, 0); PG8_STAGE(PG8_SA(0, 1), a2, v2[1]);
            PG8_WAIT_V(8); PG8_WAIT_L(0); PG8_BAR; PG8_MMA(0, 0, At, B0); PG8_MMA(0, 1, At, B1); PG8_BAR; PG8_SCHED;
            PG8_LDA(At, 1, 1); PG8_STAGE(PG8_SB(1, 0), b3, voffB); PG8_STAGE(PG8_SB(1, 1), b3 + hstep, voffB); PG8_STAGE(PG8_SA(1, 0), a3, v2[0]);
            PG8_WAIT_V(8); PG8_WAIT_L(0); PG8_BAR; PG8_MMA(1, 0, At, B0); PG8_MMA(1, 1, At, B1); PG8_BAR; PG8_SCHED;
            } else {
            PG8_LDB(B0, 0, 0); PG8_SCHED; PG8_LDA(At, 0, 0); PG8_STAGE(PG8_SA(1, 1), a1, vAc[1]);
            PG8_WAIT_L(8); PG8_BAR; PG8_WAIT_L(0); PG8_MMA(0, 0, At, B0); PG8_BAR; PG8_SCHED;
            PG8_LDB(B1, 0, 1); PG8_STAGE(PG8_SB(0, 0), b2, voffB);
            PG8_BAR; PG8_WAIT_L(0); PG8_MMA(0, 1, At, B1); PG8_BAR;
            PG8_LDA(At, 0, 1); PG8_STAGE(PG8_SA(0, 0), a2, v2[0]);
            PG8_BAR; PG8_WAIT_L(0); PG8_MMA(1, 0, At, B0); PG8_BAR; PG8_SCHED;
            PG8_STAGE(PG8_SB(0, 1), b2 + hstep, voffB);
            PG8_WAIT_V(6); PG8_BAR; PG8_MMA(1, 1, At, B1); PG8_BAR;
            PG8_LDB(B0, 1, 0); PG8_SCHED; PG8_LDA(At, 1, 0); PG8_STAGE(PG8_SA(0, 1), a2, v2[1]);
            PG8_WAIT_L(8); PG8_BAR; PG8_WAIT_L(0); PG8_MMA(0, 0, At, B0); PG8_BAR; PG8_SCHED;
            PG8_LDB(B1, 1, 1); PG8_STAGE(PG8_SB(1, 0), b3, voffB);
            PG8_BAR; PG8_WAIT_L(0); PG8_MMA(0, 1, At, B1); PG8_BAR;
            PG8_LDA(At, 1, 1); PG8_STAGE(PG8_SA(1, 0), a3, v2[0]);
            PG8_BAR; PG8_WAIT_L(0); PG8_MMA(1, 0, At, B0); PG8_BAR; PG8_SCHED;
            PG8_STAGE(PG8_SB(1, 1), b3 + hstep, voffB);
            PG8_WAIT_V(6); PG8_BAR; PG8_MMA(1, 1, At, B1); PG8_BAR;
            }
        }
        if constexpr (ALIGN_EPI) { if (wr == 0) PG8_BAR; }
        if constexpr (!Epi::AFTER_DRAIN) { E(acc, cur, wr, wc, fr, fq); S.done(cur); }
        if (!has_next) break;
#pragma unroll
        for (int a = 0; a < 2; ++a)
#pragma unroll
            for (int b = 0; b < 2; ++b)
#pragma unroll
                for (int m = 0; m < 4; ++m)
#pragma unroll
                    for (int n = 0; n < 2; ++n) acc[a][b][m][n] = (f32x4){0.f, 0.f, 0.f, 0.f};
        cur = nxt; cA = nA; cB = nB; ++ui;
#pragma unroll
        for (int h = 0; h < 2; ++h)
#pragma unroll
            for (int i = 0; i < 2; ++i) vAc[h][i] = vAn[h][i];
        if constexpr (ALIGN_EPI) { if (wr == 1) PG8_BAR; }
    }
    PG8_WAIT_V(0);
    if constexpr (!ALIGN_EPI) { if (wr == 0) PG8_BAR; }
    PG8_BAR;
    if constexpr (Epi::AFTER_DRAIN) { E.fused(acc, cur, wr, wc, fr, fq, lds, wid, lane); S.done(cur); }
#undef PG8_SA
#undef PG8_SB
#undef PG8_STAGE
#undef PG8_LDA
#undef PG8_LDB
#undef PG8_MMA
#undef PG8_WAIT_V
#undef PG8_WAIT_L
#undef PG8_BAR
#undef PG8_SCHED
}
}
#define GAS __attribute__((address_space(1)))
#define LAS __attribute__((address_space(3)))
typedef unsigned short bf16;
typedef unsigned v4u __attribute__((ext_vector_type(4)));
typedef float f32x4 __attribute__((ext_vector_type(4)));
typedef short bf16x8 __attribute__((ext_vector_type(8)));
typedef GAS unsigned gu32;
typedef GAS unsigned long long gu64;
#define RLX_AGENT __ATOMIC_RELAXED, __HIP_MEMORY_SCOPE_AGENT
#define LDS_WAIT() asm volatile("s_waitcnt lgkmcnt(0)" ::: "memory")
#define VM_WAIT() asm volatile("s_waitcnt vmcnt(0)" ::: "memory")
__device__ __forceinline__ unsigned long long rt() { return __builtin_amdgcn_s_memrealtime(); }
__device__ __forceinline__ unsigned f2bf(float f) { unsigned u = __builtin_bit_cast(unsigned, f); return (u + 0x7fffu + ((u >> 16) & 1u)) >> 16; }
__device__ __forceinline__ unsigned pk2(float lo, float hi) { return f2bf(lo) | (f2bf(hi) << 16); }

#define XB_TMO      128
#define XB_XCNT(j)  (256  + 64 * (j))
#define XB_XSUB(j)  (1280 + 64 * (j))
#define XB_XGEN(j)  (2304 + 64 * (j))
#define XB_TOP      3328
#define XB_TOPGEN   3392
#define XCD_BAR_WORDS 3456
#define XB_SPIN_CAP (1u << 18)

__device__ __forceinline__ unsigned xb_ld(unsigned* p)              { return __hip_atomic_load(p, __ATOMIC_RELAXED, __HIP_MEMORY_SCOPE_AGENT); }
__device__ __forceinline__ unsigned xb_add(unsigned* p, unsigned v) { return __hip_atomic_fetch_add(p, v, __ATOMIC_RELAXED, __HIP_MEMORY_SCOPE_AGENT); }
__device__ __forceinline__ unsigned xb_xcc_id() { return (unsigned)__builtin_amdgcn_s_getreg((3 << 11) | 20) & 0xFu; }
#define XB_SPIN(cond, bar) do { unsigned _sp = 0; while (cond) { __builtin_amdgcn_s_sleep(1); \
    if ((++_sp & 255u) == 0u) { if (xb_ld(&(bar)[XB_TMO])) break; if (_sp > XB_SPIN_CAP) { atomicAdd(&(bar)[XB_TMO], 1u); break; } } } } while (0)

struct XcdBarrier {
    unsigned* bar; unsigned x;
    volatile LAS unsigned* st;
};

__device__ __forceinline__ XcdBarrier xcd_barrier_post(unsigned* bar, volatile LAS unsigned* st) {
    XcdBarrier b; b.bar = bar; b.x = xb_xcc_id(); b.st = st;
    if (threadIdx.x == 0) (void)xb_add(&bar[XB_XCNT(b.x)], 1u);
    return b;
}
__device__ __forceinline__ void xcd_barrier_complete(unsigned* bar, unsigned x, unsigned& nloc, unsigned& nx) {
    const unsigned G = gridDim.x * gridDim.y * gridDim.z;
    unsigned sum, cnt, mine, sp = 0u;
    for (;;) {
        sum = 0u; cnt = 0u; mine = 0u;
#pragma unroll
        for (unsigned j = 0; j < 16; ++j) { const unsigned c = xb_ld(&bar[XB_XCNT(j)]); sum += c; cnt += (c > 0u) ? 1u : 0u; mine = (j == x) ? c : mine; }
        if (sum == G) break;
        __builtin_amdgcn_s_sleep(1);
        if ((++sp & 255u) == 0u) { if (xb_ld(&bar[XB_TMO])) break; if (sp > XB_SPIN_CAP) { atomicAdd(&bar[XB_TMO], 1u); break; } }
    }
    nloc = mine > 0u ? mine : 1u; nx = cnt > 0u ? cnt : 1u;
}

__device__ __forceinline__ void xcd_barrier(const XcdBarrier& b) {
    asm volatile("s_waitcnt vmcnt(0)" ::: "memory");
    __syncthreads();
    if (threadIdx.x == 0) {
        unsigned* bar = b.bar;
        __builtin_amdgcn_s_waitcnt(0);
        unsigned nloc = b.st[0], nx = b.st[1];
        if (nloc == 0u) { xcd_barrier_complete(bar, b.x, nloc, nx); b.st[0] = nloc; b.st[1] = nx; }
        const unsigned old = xb_add(&bar[XB_XSUB(b.x)], 1u);
        const unsigned gen = old / nloc;
        if (old + 1u == (gen + 1u) * nloc) {
            __builtin_amdgcn_fence(__ATOMIC_RELEASE, "agent");
            asm volatile("s_waitcnt vmcnt(0)" ::: "memory");
            const unsigned og = xb_add(&bar[XB_TOP], 1u);
            const unsigned tg = og / nx;
            if (og + 1u == (tg + 1u) * nx) xb_add(&bar[XB_TOPGEN], 1u);
            else XB_SPIN(xb_ld(&bar[XB_TOPGEN]) == tg, bar);
            __builtin_amdgcn_fence(__ATOMIC_ACQUIRE, "agent");
            xb_add(&bar[XB_XGEN(b.x)], 1u);
            asm volatile("s_waitcnt vmcnt(0)" ::: "memory");
        } else {
            XB_SPIN(xb_ld(&bar[XB_XGEN(b.x)]) == gen, bar);
            __builtin_amdgcn_fence(__ATOMIC_ACQUIRE, "agent");
            asm volatile("s_waitcnt vmcnt(0)" ::: "memory");
        }
    }
    __syncthreads();
}

using pg8::bf16_t;
typedef unsigned u32x2 __attribute__((ext_vector_type(2)));
__device__ __forceinline__ float bf2f(unsigned v) { return __uint_as_float(v << 16); }
__device__ __forceinline__ float bflo(unsigned w) { return __uint_as_float(w << 16); }
__device__ __forceinline__ float bfhi(unsigned w) { return __uint_as_float(w & 0xffff0000u); }
__device__ __forceinline__ float wave_sum(float v) {
#pragma unroll
    for (int o = 1; o < 64; o <<= 1) v += __shfl_xor(v, o);
    return v;
}
__device__ __forceinline__ float sigm(float x) { return 1.0f / (1.0f + expf(-x)); }
__device__ __forceinline__ float softplusf_(float x) { return fmaxf(x, 0.f) + log1pf(expf(-fabsf(x))); }
__device__ __forceinline__ float gelu_tanh(float x) { const float y = 0.7978845608028654f * (x + 0.044715f * x * x * x);
    return x * __builtin_amdgcn_rcpf(1.0f + __builtin_amdgcn_exp2f(-2.0f * 1.4426950408889634f * y)); }

__device__ __forceinline__ int gu_rowmap(int n) { const int a = n >> 1; return ((a >> 7) << 8) + (a & 127) + ((n & 1) << 7); }
struct TDesc { const float* W; bf16* WT; int ldw, K, k0, n0, gu; };
__device__ __forceinline__ void tload(const TDesc& d, f32x4 (&v)[16], int lane) {
#pragma unroll
    for (int i = 0; i < 16; ++i) v[i] = __builtin_nontemporal_load((const f32x4*)(d.W + (size_t)(d.k0 + 4 * i + (lane >> 4)) * d.ldw + d.n0 + 4 * (lane & 15)));
}
__device__ __forceinline__ void tstore(const TDesc& d, const f32x4 (&v)[16], LAS float* scr, int lane) {
#pragma unroll
    for (int i = 0; i < 16; ++i) { LAS float* p = scr + (4 * i + (lane >> 4)) * 65 + 4 * (lane & 15); p[0] = v[i][0]; p[1] = v[i][1]; p[2] = v[i][2]; p[3] = v[i][3]; }
    LDS_WAIT(); asm volatile("" ::: "memory");
    const int c = lane & 7;
#pragma unroll
    for (int j = 0; j < 8; ++j) { const int n = 8 * j + (lane >> 3); const LAS float* s = scr + (8 * c) * 65 + n;
        v4u o; o.x = pg8::cvt_pk_bf16(s[0], s[65]); o.y = pg8::cvt_pk_bf16(s[130], s[195]); o.z = pg8::cvt_pk_bf16(s[260], s[325]); o.w = pg8::cvt_pk_bf16(s[390], s[455]);
        const int nr = d.gu ? gu_rowmap(d.n0 + n) : (d.n0 + n);
        *(v4u*)(d.WT + (size_t)nr * d.K + d.k0 + 8 * c) = o; }
    LDS_WAIT(); asm volatile("" ::: "memory");
}
constexpr int IT_WIN = 16 * 52, IT_WOUT = 256, IT_GU = 512, IT_DN = 256;
constexpr int NIT_WIN = DEPTH * IT_WIN, NIT_WOUT = DEPTH * IT_WOUT, NIT_GU = DEPTH * NE * IT_GU, NIT_DN = DEPTH * NE * IT_DN, NITEMS = NIT_WIN + NIT_WOUT + NIT_GU + NIT_DN;

__device__ __forceinline__ void emit_xn_dt(const f32x4 (&v)[4], const float* g, const float* win_l, bf16* xn_row, float* dt_row, int lane) {
    float ss = 0.f;
#pragma unroll
    for (int j = 0; j < 4; ++j) ss += (v[j][0] * v[j][0] + v[j][1] * v[j][1]) + (v[j][2] * v[j][2] + v[j][3] * v[j][3]);
    ss = wave_sum(ss);
    const float rstd = 1.0f / sqrtf(ss * (1.0f / DM) + EPS);
    float d0 = 0.f, d1 = 0.f, d2 = 0.f, d3 = 0.f;
#pragma unroll
    for (int j = 0; j < 4; ++j) { const int col = 256 * j + 4 * lane; const f32x4 gg = *(const f32x4*)(g + col); const f32x4 u = v[j] * rstd * gg;
        u32x2 w; w.x = pk2(u[0], u[1]); w.y = pk2(u[2], u[3]); *(u32x2*)(xn_row + col) = w;
#pragma unroll
        for (int i = 0; i < 4; ++i) { const f32x4 ww = *(const f32x4*)(win_l + (size_t)(col + i) * DIN + C_DT); d0 += u[i] * ww[0]; d1 += u[i] * ww[1]; d2 += u[i] * ww[2]; d3 += u[i] * ww[3]; } }
    d0 = wave_sum(d0); d1 = wave_sum(d1); d2 = wave_sum(d2); d3 = wave_sum(d3);
    if (lane == 0) *(f32x4*)dt_row = (f32x4){d0, d1, d2, d3};
}

__device__ __forceinline__ void norm_row(const float* orow, const bf16* prow, bf16* mrow, const float* gA, const float* gB, const float* gC, const float* gD, int lane) {
    f32x4 v[4];
#pragma unroll
    for (int j = 0; j < 4; ++j) v[j] = *(const f32x4*)(orow + 256 * j + 4 * lane);
    float s[4];
#pragma unroll
    for (int j = 0; j < 4; ++j) s[j] = (v[j][0] * v[j][0] + v[j][1] * v[j][1]) + (v[j][2] * v[j][2] + v[j][3] * v[j][3]);
#pragma unroll
    for (int o = 1; o < 64; o <<= 1) { s[0] += __shfl_xor(s[0], o); s[1] += __shfl_xor(s[1], o); if (o < 16) s[2] += __shfl_xor(s[2], o); if (o < 32) s[3] += __shfl_xor(s[3], o); }
    const float r0 = 1.0f / sqrtf(s[0] * (1.0f / 256) + EPS), r1 = 1.0f / sqrtf(s[1] * (1.0f / 256) + EPS), r2 = 1.0f / sqrtf(s[2] * (1.0f / 64) + EPS), r3 = 1.0f / sqrtf(s[3] * (1.0f / 128) + EPS);
    const int c = 4 * lane;
    const f32x4 g0 = *(const f32x4*)(gA + c), g1 = *(const f32x4*)(gB + c), g2 = *(const f32x4*)(gC + c), g3 = *(const f32x4*)(gD + c);
    const u32x2 gw = *(const u32x2*)(prow + C_HGG + c);
    const float gi[4] = {bflo(gw.x), bfhi(gw.x), bflo(gw.y), bfhi(gw.y)};
    f32x4 o0 = v[0] * r0 * g0, o1 = v[1] * r1 * g1, o2 = v[2] * r2 * g2, o3 = v[3] * r3 * g3;
#pragma unroll
    for (int i = 0; i < 4; ++i) o2[i] *= gi[i] * sigm(gi[i]);
    u32x2 w;
    w.x = pk2(o0[0], o0[1]); w.y = pk2(o0[2], o0[3]); *(u32x2*)(mrow + c) = w;
    w.x = pk2(o1[0], o1[1]); w.y = pk2(o1[2], o1[3]); *(u32x2*)(mrow + 256 + c) = w;
    w.x = pk2(o2[0], o2[1]); w.y = pk2(o2[2], o2[3]); *(u32x2*)(mrow + 512 + c) = w;
    w.x = pk2(o3[0], o3[1]); w.y = pk2(o3[2], o3[3]); *(u32x2*)(mrow + 768 + c) = w;
}

__device__ __forceinline__ void build_tb(const int* tot, LAS int* tb, int tid) {
    if (tid == 0) { int run = 0; for (int e = 0; e < 32; ++e) { tb[e] = run; run += (tot[e] + 255) >> 8; } tb[32] = run; }
    __syncthreads();
}

typedef short s16x4 __attribute__((ext_vector_type(4)));
typedef short v4i16_t __attribute__((ext_vector_type(4)));
#define MFMA16(a, b, c) __builtin_amdgcn_mfma_f32_16x16x32_bf16((a), (b), (c), 0, 0, 0)
__device__ __forceinline__ bf16x8 frag_kc(const LAS bf16* M, int ld, int idx0, int k0, int lane) { return *(const LAS bf16x8*)(M + (idx0 + (lane & 15)) * ld + k0 + 8 * (lane >> 4)); }
__device__ __forceinline__ bf16x8 frag_ks(const LAS bf16* M, int ld, int idx0, int k0, int lane) {
    const LAS bf16* p = M + (k0 + 8 * (lane >> 4) + ((lane & 15) >> 2)) * ld + idx0 + 4 * (lane & 3);
    const s16x4 lo = __builtin_bit_cast(s16x4, __builtin_amdgcn_ds_read_tr16_b64_v4i16((LAS v4i16_t*)p));
    const s16x4 hi = __builtin_bit_cast(s16x4, __builtin_amdgcn_ds_read_tr16_b64_v4i16((LAS v4i16_t*)(p + 4 * ld)));
    return (bf16x8){lo[0], lo[1], lo[2], lo[3], hi[0], hi[1], hi[2], hi[3]};
}
__device__ __forceinline__ bf16x8 frag_g32(const float* M, int ld, int idx0, int k0, int lane) {
    const float* p = M + (size_t)(idx0 + (lane & 15)) * ld + k0 + 8 * (lane >> 4);
    const f32x4 a = *(const f32x4*)p, b = *(const f32x4*)(p + 4);
    v4u w; w.x = pk2(a[0], a[1]); w.y = pk2(a[2], a[3]); w.z = pk2(b[0], b[1]); w.w = pk2(b[2], b[3]);
    return __builtin_bit_cast(bf16x8, w);
}
__device__ __forceinline__ float fsigm(float x) { return __builtin_amdgcn_rcpf(1.0f + __builtin_amdgcn_exp2f(-1.4426950408889634f * x)); }
__device__ __forceinline__ float fexp(float x) { return __builtin_amdgcn_exp2f(1.4426950408889634f * x); }

constexpr int M2LD = 136, M2WLD = 72;
__device__ __forceinline__ void m2_conv_block(const bf16* proj, const float* cw, const float* cb, int b, int t0, int tq, int cc0, float (&o)[8][8]) {
    v4u x[11]; f32x4 w[4][2];
    const int ts0 = t0 + 8 * tq - 3;
#pragma unroll
    for (int r = 0; r < 11; ++r) { const int ts = ts0 + r; x[r] = (v4u){0u, 0u, 0u, 0u}; if (ts >= 0) x[r] = *(const v4u*)(proj + ((size_t)b * SEQ + ts) * DING + C_M2X + cc0); }
#pragma unroll
    for (int k = 0; k < 4; ++k) { w[k][0] = *(const f32x4*)(cw + k * 768 + cc0); w[k][1] = *(const f32x4*)(cw + k * 768 + cc0 + 4); }
    const f32x4 b0 = *(const f32x4*)(cb + cc0), b1 = *(const f32x4*)(cb + cc0 + 4);
#pragma unroll
    for (int j = 0; j < 8; ++j) { float a[8] = {b0[0], b0[1], b0[2], b0[3], b1[0], b1[1], b1[2], b1[3]};
#pragma unroll
        for (int k = 0; k < 4; ++k) { const v4u xv = x[j + k];
            a[0] += w[k][0][0] * bflo(xv[0]); a[1] += w[k][0][1] * bfhi(xv[0]); a[2] += w[k][0][2] * bflo(xv[1]); a[3] += w[k][0][3] * bfhi(xv[1]);
            a[4] += w[k][1][0] * bflo(xv[2]); a[5] += w[k][1][1] * bfhi(xv[2]); a[6] += w[k][1][2] * bflo(xv[3]); a[7] += w[k][1][3] * bfhi(xv[3]); }
#pragma unroll
        for (int i = 0; i < 8; ++i) o[j][i] = a[i] * fsigm(a[i]); }
}
__device__ __forceinline__ void m2_dt_scan(const float* dtraw, const float* dt_bias, const float* a_log, int b, int t0, int g, LAS float* dt_s, LAS float* acs_s, LAS float* w_s, float* dec_out, int tid) {
    if (tid >= 384) { const int hh = (tid - 384) >> 6, t = tid & 63, h = 2 * g + hh;
        const float dtv = softplusf_(dtraw[((size_t)b * SEQ + t0 + t) * 4 + h] + dt_bias[h]);
        float v = dtv * (-expf(a_log[h]));
#pragma unroll
        for (int o = 1; o < 64; o <<= 1) { const float nb = __shfl_up(v, o); if (t >= o) v += nb; }
        const float last = __shfl(v, 63);
        dt_s[hh * 64 + t] = dtv; acs_s[hh * 64 + t] = v; w_s[hh * 64 + t] = expf(last - v) * dtv;
        if (dec_out && t == 63) dec_out[h] = expf(last); }
}
__device__ __forceinline__ void m2_state_unit(const bf16* proj, const float* dtraw, float* sloc, float* dec, int b, int ch, int g, const float* cw, const float* cb, const float* dt_bias, const float* a_log, LAS unsigned char* lds, int tid) {
    LAS bf16* XS = (LAS bf16*)lds; LAS bf16* BS = XS + 64 * M2LD; LAS float* dt_s = (LAS float*)(BS + 64 * M2LD); LAS float* acs_s = dt_s + 128; LAS float* w_s = acs_s + 128;
    const int lane = tid & 63, w = tid >> 6, t0 = ch * 64;
    m2_dt_scan(dtraw, dt_bias, a_log, b, t0, g, dt_s, acs_s, w_s, dec + (size_t)(b * 32 + ch) * 4, tid);
    float o[8][8]; const int cg = tid & 31, tq = tid >> 5;
    if (tid < 256) m2_conv_block(proj, cw, cb, b, t0, tq, cg < 16 ? g * 128 + 8 * cg : 256 + g * 128 + 8 * (cg - 16), o);
    __syncthreads();
    if (tid < 256) {
#pragma unroll
        for (int j = 0; j < 8; ++j) { const int t = 8 * tq + j; const float sc = cg < 16 ? w_s[(cg >> 3) * 64 + t] : 1.0f;
            v4u q; q.x = pk2(o[j][0] * sc, o[j][1] * sc); q.y = pk2(o[j][2] * sc, o[j][3] * sc); q.z = pk2(o[j][4] * sc, o[j][5] * sc); q.w = pk2(o[j][6] * sc, o[j][7] * sc);
            *(LAS v4u*)((cg < 16 ? XS + 8 * cg : BS + 8 * (cg - 16)) + t * M2LD) = q; } }
    __syncthreads();
    { const int hh = w >> 2, mi = w & 3;
        const bf16x8 a0 = frag_ks(XS, M2LD, hh * 64 + mi * 16, 0, lane), a1 = frag_ks(XS, M2LD, hh * 64 + mi * 16, 32, lane);
        float* outp = sloc + ((size_t)((b * 32 + ch) * 4 + 2 * g + hh) * 64 + mi * 16 + 4 * (lane >> 4)) * 128 + (lane & 15);
#pragma unroll
        for (int ni = 0; ni < 8; ++ni) { const bf16x8 b0 = frag_ks(BS, M2LD, ni * 16, 0, lane), b1 = frag_ks(BS, M2LD, ni * 16, 32, lane);
            f32x4 acc = {0.f, 0.f, 0.f, 0.f}; acc = MFMA16(a0, b0, acc); acc = MFMA16(a1, b1, acc);
#pragma unroll
            for (int i = 0; i < 4; ++i) outp[i * 128 + ni * 16] = acc[i]; } }
    __syncthreads();
}
__device__ __forceinline__ void m2_out_unit(const bf16* proj, const float* dtraw, const bf16* prevb, float* oraw, int b, int ch, int g, const float* cw, const float* cb, const float* dt_bias, const float* a_log, const float* dskip, LAS unsigned char* lds, int tid) {
    LAS bf16* XS = (LAS bf16*)lds; LAS bf16* BS = XS + 64 * M2LD; LAS bf16* CS = BS + 64 * M2LD; LAS bf16* WS = CS + 64 * M2LD;
    LAS float* dt_s = (LAS float*)(WS + 2 * 64 * M2WLD); LAS float* acs_s = dt_s + 128; LAS float* w_s = acs_s + 128;
    const int lane = tid & 63, w = tid >> 6, t0 = ch * 64;
    bf16x8 pf[4][4];
    { const bf16* pv = prevb + (size_t)((b * 32 + ch) * 4 + 2 * g + (w >> 2)) * 64 * 128;
#pragma unroll
        for (int kk = 0; kk < 4; ++kk)
#pragma unroll
            for (int ni = 0; ni < 4; ++ni) pf[kk][ni] = *(const bf16x8*)(pv + (size_t)(ni * 16 + (lane & 15)) * 128 + 32 * kk + 8 * (lane >> 4)); }
    m2_dt_scan(dtraw, dt_bias, a_log, b, t0, g, dt_s, acs_s, w_s, nullptr, tid);
    if (tid < 384) { float o[8][8]; const int cg = tid % 48, tq = tid / 48;
        const int cc0 = cg < 16 ? g * 128 + 8 * cg : cg < 32 ? 256 + g * 128 + 8 * (cg - 16) : 512 + g * 128 + 8 * (cg - 32);
        m2_conv_block(proj, cw, cb, b, t0, tq, cc0, o);
        LAS bf16* dst = cg < 16 ? XS + 8 * cg : cg < 32 ? BS + 8 * (cg - 16) : CS + 8 * (cg - 32);
#pragma unroll
        for (int j = 0; j < 8; ++j) { v4u q; q.x = pk2(o[j][0], o[j][1]); q.y = pk2(o[j][2], o[j][3]); q.z = pk2(o[j][4], o[j][5]); q.w = pk2(o[j][6], o[j][7]); *(LAS v4u*)(dst + (8 * tq + j) * M2LD) = q; } }
    __syncthreads();
    { const int mi = w >> 1, ni0 = (w & 1) * 2;
        f32x4 acc[2] = {{0.f, 0.f, 0.f, 0.f}, {0.f, 0.f, 0.f, 0.f}};
#pragma unroll
        for (int kk = 0; kk < 4; ++kk) { const bf16x8 a = frag_kc(CS, M2LD, mi * 16, 32 * kk, lane);
#pragma unroll
            for (int q = 0; q < 2; ++q) { const bf16x8 bb = frag_kc(BS, M2LD, (ni0 + q) * 16, 32 * kk, lane); acc[q] = MFMA16(a, bb, acc[q]); } }
#pragma unroll
        for (int q = 0; q < 2; ++q) { const int s = (ni0 + q) * 16 + (lane & 15);
#pragma unroll
            for (int hh = 0; hh < 2; ++hh) { const float as = acs_s[hh * 64 + s], ds = dt_s[hh * 64 + s];
#pragma unroll
                for (int i = 0; i < 4; ++i) { const int l = mi * 16 + 4 * (lane >> 4) + i;
                    const float v = (s <= l) ? acc[q][i] * fexp(acs_s[hh * 64 + l] - as) * ds : 0.f;
                    WS[(hh * 64 + l) * M2WLD + s] = (bf16)f2bf(v); } } } }
    __syncthreads();
    { const int hh = w >> 2, mi = w & 3, h = 2 * g + hh;
        f32x4 yd[4], yo[4];
#pragma unroll
        for (int ni = 0; ni < 4; ++ni) { yd[ni] = (f32x4){0.f, 0.f, 0.f, 0.f}; yo[ni] = (f32x4){0.f, 0.f, 0.f, 0.f}; }
#pragma unroll
        for (int kk = 0; kk < 2; ++kk) { const bf16x8 a = frag_kc(WS + hh * 64 * M2WLD, M2WLD, mi * 16, 32 * kk, lane);
#pragma unroll
            for (int ni = 0; ni < 4; ++ni) { const bf16x8 bb = frag_ks(XS, M2LD, hh * 64 + ni * 16, 32 * kk, lane); yd[ni] = MFMA16(a, bb, yd[ni]); } }
#pragma unroll
        for (int kk = 0; kk < 4; ++kk) { const bf16x8 a = frag_kc(CS, M2LD, mi * 16, 32 * kk, lane);
#pragma unroll
            for (int ni = 0; ni < 4; ++ni) yo[ni] = MFMA16(a, pf[kk][ni], yo[ni]); }
        const float Dh = dskip[h];
#pragma unroll
        for (int i = 0; i < 4; ++i) { const int l = mi * 16 + 4 * (lane >> 4) + i; const float ea = fexp(acs_s[hh * 64 + l]); const size_t row = (size_t)b * SEQ + t0 + l;
#pragma unroll
            for (int ni = 0; ni < 4; ++ni) { const int p = ni * 16 + (lane & 15);
                const float xv = bf2f(XS[l * M2LD + hh * 64 + p]), zv = bf2f(proj[row * DING + C_M2Z + h * 64 + p]);
                const float y = yd[ni][i] + ea * yo[ni][i] + xv * Dh;
                oraw[row * DM + 768 + h * 64 + p] = y * (zv * fsigm(zv)); } } }
    __syncthreads();
}

constexpr int HGLD = 136, HGWLD = 72;
template <bool WITH_Q>
__device__ __forceinline__ void hg_prep(const bf16* proj, int b, int t0, int hp, const float* lb1, int layer, LAS float* bc_s, LAS bf16* QS, LAS bf16* KS, LAS bf16* VS, LAS bf16* Q2, int tid) {
    const int c0 = (tid & 15) * 8, ta = tid >> 4;
    float lb[8];
#pragma unroll
    for (int i = 0; i < 8; ++i) lb[i] = 0.f;
    if (layer == 1) { const f32x4 l0 = *(const f32x4*)(lb1 + hp * 128 + c0), l1 = *(const f32x4*)(lb1 + hp * 128 + c0 + 4); lb[0] = l0[0]; lb[1] = l0[1]; lb[2] = l0[2]; lb[3] = l0[3]; lb[4] = l1[0]; lb[5] = l1[1]; lb[6] = l1[2]; lb[7] = l1[3]; }
    v4u fw[2], iw[2], qw[2];
#pragma unroll
    for (int u = 0; u < 2; ++u) { const size_t row = (size_t)b * SEQ + t0 + ta + 32 * u;
        fw[u] = *(const v4u*)(proj + row * DING + C_HGF + hp * 128 + c0); iw[u] = *(const v4u*)(proj + row * DING + C_HGI + hp * 128 + c0);
        if (WITH_Q) qw[u] = *(const v4u*)(proj + row * DING + C_HGQ + hp * 128 + c0); }
    float key[2][8];
#pragma unroll
    for (int u = 0; u < 2; ++u) { const int t = ta + 32 * u;
        const float f[8] = {bflo(fw[u][0]), bfhi(fw[u][0]), bflo(fw[u][1]), bfhi(fw[u][1]), bflo(fw[u][2]), bfhi(fw[u][2]), bflo(fw[u][3]), bfhi(fw[u][3])};
        float lf[8];
#pragma unroll
        for (int i = 0; i < 8; ++i) { const float sg = fsigm(f[i]); lf[i] = __builtin_amdgcn_logf(lb[i] + (1.0f - lb[i]) * sg) * 0.6931471805599453f; key[u][i] = (1.0f - lb[i]) * (1.0f - sg); }
        *(LAS f32x4*)(bc_s + t * 128 + c0) = (f32x4){lf[0], lf[1], lf[2], lf[3]}; *(LAS f32x4*)(bc_s + t * 128 + c0 + 4) = (f32x4){lf[4], lf[5], lf[6], lf[7]};
        *(LAS v4u*)(VS + t * HGLD + c0) = iw[u]; }
    __syncthreads();
    if (tid < 128) { float run = 0.f;
#pragma unroll 8
        for (int t = 0; t < 64; ++t) { run += bc_s[t * 128 + tid]; bc_s[t * 128 + tid] = run; } }
    __syncthreads();
    const f32x4 m0 = *(const LAS f32x4*)(bc_s + 31 * 128 + c0), m1 = *(const LAS f32x4*)(bc_s + 31 * 128 + c0 + 4);
    const float b31[8] = {m0[0], m0[1], m0[2], m0[3], m1[0], m1[1], m1[2], m1[3]};
#pragma unroll
    for (int u = 0; u < 2; ++u) { const int t = ta + 32 * u;
        const f32x4 x0 = *(const LAS f32x4*)(bc_s + t * 128 + c0), x1 = *(const LAS f32x4*)(bc_s + t * 128 + c0 + 4);
        const float bc[8] = {x0[0], x0[1], x0[2], x0[3], x1[0], x1[1], x1[2], x1[3]};
        float kk[8], qq[8], q2[8];
#pragma unroll
        for (int i = 0; i < 8; ++i) { const float d = b31[i] - bc[i]; kk[i] = key[u][i] * fexp(fminf(d, 60.0f));
            if (WITH_Q) { const float qv = (i & 1) ? bfhi(qw[u][i >> 1]) : bflo(qw[u][i >> 1]); const float qs = qv * fsigm(qv); qq[i] = qs * fexp(fminf(-d, 60.0f)); q2[i] = qs * fexp(bc[i]); } }
        v4u o; o.x = pk2(kk[0], kk[1]); o.y = pk2(kk[2], kk[3]); o.z = pk2(kk[4], kk[5]); o.w = pk2(kk[6], kk[7]); *(LAS v4u*)(KS + t * HGLD + c0) = o;
        if (WITH_Q) { o.x = pk2(qq[0], qq[1]); o.y = pk2(qq[2], qq[3]); o.z = pk2(qq[4], qq[5]); o.w = pk2(qq[6], qq[7]); *(LAS v4u*)(QS + t * HGLD + c0) = o;
            o.x = pk2(q2[0], q2[1]); o.y = pk2(q2[2], q2[3]); o.z = pk2(q2[4], q2[5]); o.w = pk2(q2[6], q2[7]); *(LAS v4u*)(Q2 + t * HGLD + c0) = o; } }
    __syncthreads();
}
__device__ __forceinline__ void hg_state_unit(const bf16* proj, float* slt, float* decc, int b, int ch, int hp, const float* lbp, int layer, LAS unsigned char* lds, int tid) {
    LAS float* bc_s = (LAS float*)lds; LAS bf16* KS = (LAS bf16*)(lds + 32768); LAS bf16* VS = KS + 64 * HGLD;
    const int lane = tid & 63, w = tid >> 6;
    hg_prep<false>(proj, b, ch * 64, hp, lbp, layer, bc_s, nullptr, KS, VS, nullptr, tid);
    if (tid < 128) decc[(size_t)((b * 32 + ch) * 4 + 2 * hp) * 64 + tid] = fexp(bc_s[63 * 128 + tid]);
    { const int hh = w >> 2, mi = w & 3, h = 2 * hp + hh;
        const bf16x8 a0 = frag_ks(VS, HGLD, hh * 64 + mi * 16, 0, lane), a1 = frag_ks(VS, HGLD, hh * 64 + mi * 16, 32, lane);
        float* outp = slt + ((size_t)((b * 32 + ch) * 4 + h) * 64 + mi * 16 + 4 * (lane >> 4)) * 64 + (lane & 15);
#pragma unroll
        for (int ni = 0; ni < 4; ++ni) { const bf16x8 b0 = frag_ks(KS, HGLD, hh * 64 + ni * 16, 0, lane), b1 = frag_ks(KS, HGLD, hh * 64 + ni * 16, 32, lane);
            f32x4 acc = {0.f, 0.f, 0.f, 0.f}; acc = MFMA16(a0, b0, acc); acc = MFMA16(a1, b1, acc);
            const int c = hh * 64 + ni * 16 + (lane & 15); const float sc = fexp(bc_s[63 * 128 + c] - bc_s[31 * 128 + c]);
#pragma unroll
            for (int i = 0; i < 4; ++i) outp[i * 64 + ni * 16] = acc[i] * sc; } }
    __syncthreads();
}
__device__ __forceinline__ void hg_out_unit(const bf16* proj, const bf16* stb, float* oraw, int b, int ch, int hp, const float* lbp, int layer, LAS unsigned char* lds, int tid) {
    LAS float* bc_s = (LAS float*)lds; LAS bf16* KS = (LAS bf16*)(lds + 32768); LAS bf16* VS = KS + 64 * HGLD; LAS bf16* QS = VS + 64 * HGLD; LAS bf16* WS = QS + 64 * HGLD; LAS bf16* Q2 = WS + 2 * 64 * HGWLD;
    const int lane = tid & 63, w = tid >> 6, t0 = ch * 64;
    const int hh = w >> 2, mi = w & 3, h = 2 * hp + hh;
    bf16x8 sf[2][4];
    { const bf16* st = stb + (size_t)((b * 32 + ch) * 4 + h) * 64 * 64;
#pragma unroll
        for (int kk = 0; kk < 2; ++kk)
#pragma unroll
            for (int ni = 0; ni < 4; ++ni) sf[kk][ni] = *(const bf16x8*)(st + (size_t)(ni * 16 + (lane & 15)) * 64 + 32 * kk + 8 * (lane >> 4)); }
    hg_prep<true>(proj, b, t0, hp, lbp, layer, bc_s, QS, KS, VS, Q2, tid);
    { f32x4 sc[4];
#pragma unroll
        for (int ni = 0; ni < 4; ++ni) sc[ni] = (f32x4){0.f, 0.f, 0.f, 0.f};
#pragma unroll
        for (int kk = 0; kk < 2; ++kk) { const bf16x8 a = frag_kc(QS, HGLD, mi * 16, hh * 64 + 32 * kk, lane);
#pragma unroll
            for (int ni = 0; ni < 4; ++ni) { const bf16x8 bb = frag_kc(KS, HGLD, ni * 16, hh * 64 + 32 * kk, lane); sc[ni] = MFMA16(a, bb, sc[ni]); } }
#pragma unroll
        for (int ni = 0; ni < 4; ++ni) { const int s = ni * 16 + (lane & 15);
#pragma unroll
            for (int i = 0; i < 4; ++i) { const int t = mi * 16 + 4 * (lane >> 4) + i; WS[(hh * 64 + t) * HGWLD + s] = (bf16)f2bf(s <= t ? sc[ni][i] : 0.f); } } }
    __syncthreads();
    { f32x4 o[4];
#pragma unroll
        for (int ni = 0; ni < 4; ++ni) o[ni] = (f32x4){0.f, 0.f, 0.f, 0.f};
#pragma unroll
        for (int kk = 0; kk < 2; ++kk) { const bf16x8 a = frag_kc(WS + hh * 64 * HGWLD, HGWLD, mi * 16, 32 * kk, lane);
#pragma unroll
            for (int ni = 0; ni < 4; ++ni) { const bf16x8 bb = frag_ks(VS, HGLD, hh * 64 + ni * 16, 32 * kk, lane); o[ni] = MFMA16(a, bb, o[ni]); } }
#pragma unroll
        for (int kk = 0; kk < 2; ++kk) { const bf16x8 a = frag_kc(Q2, HGLD, mi * 16, hh * 64 + 32 * kk, lane);
#pragma unroll
            for (int ni = 0; ni < 4; ++ni) o[ni] = MFMA16(a, sf[kk][ni], o[ni]); }
#pragma unroll
        for (int i = 0; i < 4; ++i) { const size_t row = (size_t)b * SEQ + t0 + mi * 16 + 4 * (lane >> 4) + i;
#pragma unroll
            for (int ni = 0; ni < 4; ++ni) oraw[row * DM + 512 + h * 64 + ni * 16 + (lane & 15)] = o[ni][i]; } }
    __syncthreads();
}

constexpr int RGLD = 136;
__device__ __forceinline__ void rg_local_unit(const bf16* proj, float* hloc, float* pcum, float* rgs, int b, int ch, int half, const float* conv_w, const float* conv_b, const bf16* waT, const bf16* wxT,
                                              const float* ba, const float* bx, const float* lam, LAS unsigned char* lds, int tid) {
    LAS float* xc32 = (LAS float*)lds; LAS float* a_s = xc32 + 64 * 128; LAS bf16* xcb = (LAS bf16*)(a_s + 64 * 128); LAS float* par = (LAS float*)(xcb + 64 * RGLD);
    const int lane = tid & 63, w = tid >> 6, t0 = ch * 64, cg0 = half * 128;
    if (tid < 128) { par[tid] = ba[cg0 + tid]; par[128 + tid] = bx[cg0 + tid]; par[256 + tid] = softplusf_(-lam[cg0 + tid]); }
    { const int c0 = (tid & 15) * 8, cg = cg0 + c0, tp = tid >> 4;
        v4u x[5]; f32x4 wk[4][2];
#pragma unroll
        for (int r = 0; r < 5; ++r) { const int ts = t0 + 2 * tp - 3 + r; x[r] = (v4u){0u, 0u, 0u, 0u}; if (ts >= 0) x[r] = *(const v4u*)(proj + ((size_t)b * SEQ + ts) * DING + C_RGX + cg); }
#pragma unroll
        for (int k = 0; k < 4; ++k) { wk[k][0] = *(const f32x4*)(conv_w + k * 256 + cg); wk[k][1] = *(const f32x4*)(conv_w + k * 256 + cg + 4); }
        const f32x4 b0 = *(const f32x4*)(conv_b + cg), b1 = *(const f32x4*)(conv_b + cg + 4);
#pragma unroll
        for (int j = 0; j < 2; ++j) { const int t = 2 * tp + j; float o[8] = {b0[0], b0[1], b0[2], b0[3], b1[0], b1[1], b1[2], b1[3]};
#pragma unroll
            for (int k = 0; k < 4; ++k) { const v4u xv = x[j + k];
                o[0] += wk[k][0][0] * bflo(xv[0]); o[1] += wk[k][0][1] * bfhi(xv[0]); o[2] += wk[k][0][2] * bflo(xv[1]); o[3] += wk[k][0][3] * bfhi(xv[1]);
                o[4] += wk[k][1][0] * bflo(xv[2]); o[5] += wk[k][1][1] * bfhi(xv[2]); o[6] += wk[k][1][2] * bflo(xv[3]); o[7] += wk[k][1][3] * bfhi(xv[3]); }
            *(LAS f32x4*)(xc32 + t * 128 + c0) = (f32x4){o[0], o[1], o[2], o[3]}; *(LAS f32x4*)(xc32 + t * 128 + c0 + 4) = (f32x4){o[4], o[5], o[6], o[7]};
            v4u q; q.x = pk2(o[0], o[1]); q.y = pk2(o[2], o[3]); q.z = pk2(o[4], o[5]); q.w = pk2(o[6], o[7]); *(LAS v4u*)(xcb + t * RGLD + c0) = q; } }
    __syncthreads();
    { const int nb = w >> 2, mi = w & 3, n = 2 * half + nb;
        f32x4 ra[4], ga[4];
#pragma unroll
        for (int ni = 0; ni < 4; ++ni) { ra[ni] = (f32x4){0.f, 0.f, 0.f, 0.f}; ga[ni] = (f32x4){0.f, 0.f, 0.f, 0.f}; }
#pragma unroll
        for (int kk = 0; kk < 2; ++kk) { const bf16x8 a = frag_kc(xcb, RGLD, mi * 16, nb * 64 + 32 * kk, lane);
#pragma unroll
            for (int ni = 0; ni < 4; ++ni) { const size_t off = (size_t)(n * 64 + ni * 16 + (lane & 15)) * 64 + 32 * kk + 8 * (lane >> 4);
                ra[ni] = MFMA16(a, *(const bf16x8*)(waT + off), ra[ni]); ga[ni] = MFMA16(a, *(const bf16x8*)(wxT + off), ga[ni]); } }
#pragma unroll
        for (int ni = 0; ni < 4; ++ni) { const int c = nb * 64 + ni * 16 + (lane & 15); const float bav = par[c], bxv = par[128 + c], spl = par[256 + c];
#pragma unroll
            for (int i = 0; i < 4; ++i) { const int t = mi * 16 + 4 * (lane >> 4) + i;
                const float r = fsigm(ra[ni][i] + bav), ig = fsigm(ga[ni][i] + bxv), log_a = -8.0f * r * spl, x2 = 2.0f * log_a;
                const float em1 = x2 > -0.25f ? -x2 * (1.0f + x2 * (0.5f + x2 * (0.16666667f + x2 * (0.041666668f + x2 * 0.0083333338f)))) : 1.0f - fexp(x2);
                float mult = __builtin_amdgcn_sqrtf(em1); if (t0 + t == 0) mult = 1.0f;
                a_s[t * 128 + c] = fexp(log_a); xc32[t * 128 + c] = mult * ig * xc32[t * 128 + c]; } } }
    __syncthreads();
    if (tid < 128) { float h = 0.f, P = 1.f; const size_t base = ((size_t)b * SEQ + t0) * 256 + cg0 + tid;
#pragma unroll 8
        for (int t = 0; t < 64; ++t) { const float a = a_s[t * 128 + tid]; h = a * h + xc32[t * 128 + tid]; P *= a; hloc[base + (size_t)t * 256] = h; pcum[base + (size_t)t * 256] = P; }
        rgs[((size_t)(b * 32 + ch) * 256 + cg0 + tid) * 2] = P; rgs[((size_t)(b * 32 + ch) * 256 + cg0 + tid) * 2 + 1] = h; }
    __syncthreads();
}

typedef float f32x16 __attribute__((ext_vector_type(16)));
#define MFMA32(a, b, c) __builtin_amdgcn_mfma_f32_32x32x16_bf16((a), (b), (c), 0, 0, 0)
constexpr int AVLD = 72;
__device__ __forceinline__ bf16x8 pack8(const f32x16& x, int o) {
    v4u w; w.x = pg8::cvt_pk_bf16(x[o], x[o + 1]); w.y = pg8::cvt_pk_bf16(x[o + 2], x[o + 3]); w.z = pg8::cvt_pk_bf16(x[o + 4], x[o + 5]); w.w = pg8::cvt_pk_bf16(x[o + 6], x[o + 7]);
    return __builtin_bit_cast(bf16x8, w);
}
__device__ __forceinline__ float lk2(float z) { return -(fmaxf(z, 0.f) + __builtin_amdgcn_logf(1.0f + __builtin_amdgcn_exp2f(-fabsf(z)))); }
__device__ __forceinline__ void attn_unit(const bf16* proj, float* oraw, int b, int h, int qb, LAS bf16* VL, int lane) {
    const int q = lane & 31, h2 = lane >> 5, qw = qb * 32; const size_t rowb = (size_t)b * SEQ;
    bf16x8 qf[4];
    { const bf16* qp = proj + (rowb + qw + q) * DING + C_SBQ + h * 64 + 8 * h2; const float C2 = 0.125f * 1.4426950408889634f;
#pragma unroll
        for (int kk = 0; kk < 4; ++kk) { const v4u w = *(const v4u*)(qp + 16 * kk); v4u o;
            o.x = pg8::cvt_pk_bf16(bflo(w.x) * C2, bfhi(w.x) * C2); o.y = pg8::cvt_pk_bf16(bflo(w.y) * C2, bfhi(w.y) * C2); o.z = pg8::cvt_pk_bf16(bflo(w.z) * C2, bfhi(w.z) * C2); o.w = pg8::cvt_pk_bf16(bflo(w.w) * C2, bfhi(w.w) * C2);
            qf[kk] = __builtin_bit_cast(bf16x8, o); } }
    bf16x8 m0[2], ones;
#pragma unroll
    for (int s = 0; s < 2; ++s) {
#pragma unroll
        for (int jj = 0; jj < 8; ++jj) { const int j = 16 * s + 8 * (jj >> 2) + 4 * h2 + (jj & 3); m0[s][jj] = (short)(j >= q ? 0x3F80 : 0); } }
#pragma unroll
    for (int jj = 0; jj < 8; ++jj) ones[jj] = (short)0x3F80;
    f32x16 o0, o1;
#pragma unroll
    for (int r = 0; r < 16; ++r) { o0[r] = 0.f; o1[r] = 0.f; }
    float R = 0.f;
    const int sd = (qw >> 6) << 6;
    bf16x8 kf[2][4];
    { const bf16* kp = proj + (rowb + sd + q) * DING + C_SBK + h * 64 + 8 * h2;
#pragma unroll
        for (int hf = 0; hf < 2; ++hf)
#pragma unroll
            for (int kk = 0; kk < 4; ++kk) kf[hf][kk] = *(const bf16x8*)(kp + (size_t)hf * 32 * DING + 16 * kk); }
    for (int s0 = sd; s0 >= 0; s0 -= 64) {
        bf16x8 kn[2][4];
        { const int sn = s0 >= 64 ? s0 - 64 : s0; const bf16* kp = proj + (rowb + sn + q) * DING + C_SBK + h * 64 + 8 * h2;
#pragma unroll
            for (int hf = 0; hf < 2; ++hf)
#pragma unroll
                for (int kk = 0; kk < 4; ++kk) kn[hf][kk] = *(const bf16x8*)(kp + (size_t)hf * 32 * DING + 16 * kk); }
#pragma unroll
        for (int i = 0; i < 8; ++i) { const int row = (lane >> 3) + 8 * i; const v4u w = *(const v4u*)(proj + (rowb + s0 + row) * DING + C_SBV + h * 64 + 8 * (lane & 7)); *(LAS v4u*)(VL + row * AVLD + 8 * (lane & 7)) = w; }
        f32x16 z0, z1;
#pragma unroll
        for (int r = 0; r < 16; ++r) { z0[r] = 0.f; z1[r] = 0.f; }
#pragma unroll
        for (int kk = 0; kk < 4; ++kk) { z0 = MFMA32(kf[0][kk], qf[kk], z0); z1 = MFMA32(kf[1][kk], qf[kk], z1); }
        const int lim = (s0 == sd) ? (qw - sd) + q : 64;
        f32x16 l0, l1;
#pragma unroll
        for (int r = 0; r < 16; ++r) { const int key = (r & 3) + 8 * (r >> 2) + 4 * h2; l0[r] = key < lim ? lk2(z0[r]) : 0.f; l1[r] = key + 32 < lim ? lk2(z1[r]) : 0.f; }
        const bf16x8 bl0 = pack8(l0, 0), bl1 = pack8(l0, 8), bh0 = pack8(l1, 0), bh1 = pack8(l1, 8);
        f32x16 i0 = z0, i1 = z1;
        i0 = MFMA32(m0[0], bl0, i0); i0 = MFMA32(m0[1], bl1, i0); i0 = MFMA32(ones, bh0, i0); i0 = MFMA32(ones, bh1, i0);
        i1 = MFMA32(m0[0], bh0, i1); i1 = MFMA32(m0[1], bh1, i1);
        float tot = h2 == 0 ? i0[0] - z0[0] : 0.f; tot += __shfl_xor(tot, 32);
#pragma unroll
        for (int r = 0; r < 16; ++r) { const int key = (r & 3) + 8 * (r >> 2) + 4 * h2; l0[r] = key < lim ? __builtin_amdgcn_exp2f(i0[r] + R) : 0.f; l1[r] = key + 32 < lim ? __builtin_amdgcn_exp2f(i1[r] + R) : 0.f; }
        R += tot;
        const bf16x8 pa0 = pack8(l0, 0), pa1 = pack8(l0, 8), pa2 = pack8(l1, 0), pa3 = pack8(l1, 8);
        const LAS bf16* vb = VL + (4 * h2 + ((lane & 15) >> 2)) * AVLD + 16 * ((lane >> 4) & 1) + 4 * (lane & 3);
#define VFRAG(kb, db) ({ const s16x4 lo_ = __builtin_bit_cast(s16x4, __builtin_amdgcn_ds_read_tr16_b64_v4i16((LAS v4i16_t*)(vb + (kb) * AVLD + (db) * 32))); \
                         const s16x4 hi_ = __builtin_bit_cast(s16x4, __builtin_amdgcn_ds_read_tr16_b64_v4i16((LAS v4i16_t*)(vb + ((kb) + 8) * AVLD + (db) * 32))); \
                         (bf16x8){lo_[0], lo_[1], lo_[2], lo_[3], hi_[0], hi_[1], hi_[2], hi_[3]}; })
        o0 = MFMA32(pa0, VFRAG(0, 0), o0); o1 = MFMA32(pa0, VFRAG(0, 1), o1);
        o0 = MFMA32(pa1, VFRAG(16, 0), o0); o1 = MFMA32(pa1, VFRAG(16, 1), o1);
        o0 = MFMA32(pa2, VFRAG(32, 0), o0); o1 = MFMA32(pa2, VFRAG(32, 1), o1);
        o0 = MFMA32(pa3, VFRAG(48, 0), o0); o1 = MFMA32(pa3, VFRAG(48, 1), o1);
#undef VFRAG
#pragma unroll
        for (int hf = 0; hf < 2; ++hf)
#pragma unroll
            for (int kk = 0; kk < 4; ++kk) kf[hf][kk] = kn[hf][kk];
        if (__all(R < -127.0f)) break;
    }
    float* op = oraw + (rowb + qw) * DM + h * 64 + q;
#pragma unroll
    for (int r = 0; r < 16; ++r) { const int qq = (r & 3) + 8 * (r >> 2) + 4 * h2; op[(size_t)qq * DM] = o0[r]; op[(size_t)qq * DM + 32] = o1[r]; }
}


constexpr int NPL = 11, NPHASE = 1 + NPL * DEPTH;
struct Args { const float* in[29]; float* out; unsigned char* ws; int ph_lo, ph_hi, use_bar, pad; };

typedef const __attribute__((address_space(4))) Args* KArgP;
__device__ __forceinline__ KArgP kargs() { KArgP p = (KArgP)__builtin_amdgcn_kernarg_segment_ptr(); asm volatile("" : "+s"(p)); return p; }
#define WSP(type, off) ((type*)(kargs()->ws + (off)))
#define INP(i) (kargs()->in[i])

constexpr int CV_MOE = NE * IT_GU + NE * IT_DN;
constexpr int CV_TAILQ = 5, CV_TAILW = (256 - 64) * NWAVES;
constexpr int CV_TAIL = CV_TAILQ * CV_TAILW;
constexpr int CV_SMALL = NIT_WIN + NIT_WOUT;
constexpr int CV_GHQ = 3;
constexpr int CV_P0_ITEMS = CV_SMALL + (CV_MOE - CV_TAIL);
__device__ __forceinline__ TDesc cv_moe(int l, int r) { TDesc d;
    if (r < NE * IT_GU) { const int le = l * NE + r / IT_GU, q = r % IT_GU; d.W = INP(24) + (size_t)le * DM * 2048; d.ldw = 2048; d.WT = WSP(bf16, WS_WGU) + (size_t)le * 2048 * DM; d.K = DM; d.k0 = 64 * (q / 32); d.n0 = 64 * (q % 32); d.gu = 1; return d; }
    r -= NE * IT_GU;
    { const int le = l * NE + r / IT_DN, q = r % IT_DN; d.W = INP(26) + (size_t)le * DFF * DM; d.ldw = DM; d.WT = WSP(bf16, WS_WDN) + (size_t)le * DM * DFF; d.K = DFF; d.k0 = 64 * (q / 16); d.n0 = 64 * (q % 16); d.gu = 0; return d; } }
__device__ __forceinline__ TDesc cv_p0(int r) { TDesc d;
    if (r < NIT_WIN) { const int l = r / IT_WIN, q = r % IT_WIN; d.W = INP(2) + (size_t)l * DM * DIN; d.ldw = DIN; d.WT = WSP(bf16, WS_WIN) + (size_t)l * DING * DM; d.K = DM; d.k0 = 64 * (q / 52); d.n0 = 64 * (q % 52); d.gu = 0; return d; }
    r -= NIT_WIN;
    if (r < NIT_WOUT) { const int l = r / IT_WOUT, q = r % IT_WOUT; d.W = INP(20) + (size_t)l * DM * DM; d.ldw = DM; d.WT = WSP(bf16, WS_WOUT) + (size_t)l * DM * DM; d.K = DM; d.k0 = 64 * (q / 16); d.n0 = 64 * (q % 16); d.gu = 0; return d; }
    r -= NIT_WOUT;
    return cv_moe(0, CV_TAIL + r); }
__device__ __forceinline__ void convert_items(int n, int first, int stride, int tail_layer_p1, LAS float* scr, int lane) {
    int it = first; TDesc dc, dn; f32x4 va[16], vb[16];
    if (it < n) { dc = tail_layer_p1 ? cv_moe(tail_layer_p1 - 1, it) : cv_p0(it); tload(dc, va, lane); }
    while (it < n) { const int nx = it + stride; const bool hn = nx < n;
        if (hn) { dn = tail_layer_p1 ? cv_moe(tail_layer_p1 - 1, nx) : cv_p0(nx); tload(dn, vb, lane); }
        tstore(dc, va, scr, lane);
        if (hn) { dc = dn;
#pragma unroll
            for (int i = 0; i < 16; ++i) va[i] = vb[i]; }
        it = nx; }
}

__global__ void __launch_bounds__(NTHR, 2) fwd_kernel(Args args_unused) {
    extern __shared__ __attribute__((aligned(16))) unsigned char lds_raw[];
    LAS unsigned char* lds = (LAS unsigned char*)lds_raw;
    LAS float* ldsf = (LAS float*)lds_raw;
    volatile LAS unsigned* MISC = (volatile LAS unsigned*)(lds + MISC_OFF);
    LAS int* tb = (LAS int*)(lds + TB_OFF);
    const int tid0 = threadIdx.x;
#define PH_IDS int tid = threadIdx.x; asm volatile("" : "+v"(tid)); const int lane = tid & 63, wave = __builtin_amdgcn_readfirstlane(tid >> 6); const int gw = vcu * NWAVES + wave; (void)lane; (void)gw;
    const int G = gridDim.x, bx = blockIdx.x;
    const int vcu = (G % 8 == 0) ? (bx % 8) * (G / 8) + bx / 8 : bx;
    const int NGW = G * NWAVES;
    gu32* ctl = (gu32*)WSP(unsigned char, WS_CTL);

    for (int u = tid0; u < (LDS_BYTES - LDSCTL_OFF) / 4; u += NTHR) ((LAS unsigned*)(lds + LDSCTL_OFF))[u] = 0u;
    __syncthreads();
    XcdBarrier bar; bar.bar = (unsigned*)(ctl + CW_BAR); bar.x = 0; bar.st = nullptr;
    if (kargs()->use_bar) bar = xcd_barrier_post((unsigned*)(ctl + CW_BAR), MISC + 8);
    const int lo = kargs()->ph_lo, hi = kargs()->ph_hi;
#ifndef PH_MASK
#define PH_MASK 0xfff
#endif
#ifndef REP_MASK
#define REP_MASK 0
#endif
#define IN(k) (lo <= (k) && (k) < hi)
#define EN(ty) ((PH_MASK >> (ty)) & 1)
#define REPS(ty) (1 + ((REP_MASK >> (ty)) & 1))
#ifndef REP2_MASK
#define REP2_MASK 0
#endif
#define SUB(bit) _Pragma("unroll 1") for (int rep2_ = 0; rep2_ < 1 + ((REP2_MASK >> (bit)) & 1); ++rep2_)
#define SEAM(k) do { if (IN(k) && IN((k) + 1)) xcd_barrier(bar); } while (0)
#define PHASE(ty, k) if (EN(ty) && IN(k)) _Pragma("unroll 1") for (int rep_ = 0; rep_ < REPS(ty); ++rep_)

    PHASE(11, 0) { PH_IDS
        LAS float* scr = ldsf + wave * (64 * 65);
        convert_items(CV_P0_ITEMS, gw, NGW, 0, scr, lane);
        for (int idx = gw * 64 + lane; idx < DEPTH * 4 * 4096; idx += NGW * 64) { const int i = idx & 63, j = (idx >> 6) & 63, ln = idx >> 12;
            WSP(bf16, WS_WAT)[idx] = (bf16)f2bf(INP(6)[(size_t)ln * 4096 + i * 64 + j]); WSP(bf16, WS_WAT + 512 * 1024)[idx] = (bf16)f2bf(INP(8)[(size_t)ln * 4096 + i * 64 + j]); }
        for (int idx = gw * 64 + lane; idx < DEPTH * NE * DM; idx += NGW * 64) { const int k = idx & 1023, e = (idx >> 10) & 31, ll = idx >> 15;
            const float w = INP(21)[ll * DM + k] * INP(22)[((size_t)ll * DM + k) * NE + e]; const unsigned hi = f2bf(w); const float lo = w - __uint_as_float(hi << 16);
            bf16* dst = WSP(bf16, WS_RWB) + (size_t)ll * 2 * NE * DM + e * DM + k; dst[0] = (bf16)hi; dst[NE * DM] = (bf16)f2bf(lo); }
        if (gw == 0) for (int c = lane; c < 256; c += 64) { const float x0 = INP(12)[c], x1 = INP(12)[256 + c], mx = fmaxf(x0, x1), e0 = expf(x0 - mx), e1 = expf(x1 - mx); WSP(float, WS_LB1)[c] = e1 / (e0 + e1); }
        for (int m = gw; m < T; m += NGW) { f32x4 v[4];
#pragma unroll
            for (int j = 0; j < 4; ++j) v[j] = *(const f32x4*)(INP(0) + (size_t)m * DM + 256 * j + 4 * lane);
            emit_xn_dt(v, INP(1), INP(2), WSP(bf16, WS_XN) + (size_t)m * DM, WSP(float, WS_DT) + (size_t)m * 4, lane); }
    }
    SEAM(0);

#pragma unroll 1
    for (int l = 0; l < DEPTH; ++l) {
        const int P = 1 + NPL * l;
        PHASE(0, P) { PH_IDS
            pg8::Gemm g{WSP(bf16, WS_XN), WSP(bf16, WS_WIN) + (size_t)l * DING * DM, T, DING, DM}; pg8::StaticOrder S; S.init(T, DING, G, bx);
            pg8::EpiBf16 E{WSP(bf16, WS_PROJ), DING, nullptr, 0};
            pg8::gemm_phase<pg8::EpiBf16, pg8::StaticOrder, true, true>(lds, g, S, E);
            if (G == 256 && bx >= 64) convert_items(CV_TAIL, (bx - 64) * NWAVES + wave, CV_TAILW, l + 1, ldsf + wave * (64 * 65), lane);
            else if (G != 256) convert_items(CV_TAIL, gw, NGW, l + 1, ldsf + wave * (64 * 65), lane);
            __syncthreads();
        }
        SEAM(P);
#define LAUNDER_TID int tidu = threadIdx.x; asm volatile("" : "+v"(tidu));
        PHASE(1, P + 1) { PH_IDS
            { const int v = vcu, b = v >> 5, ch = v & 31;
                SUB(0)
#pragma unroll 1
                for (int g = 0; g < 2; ++g) { LAUNDER_TID m2_state_unit(WSP(bf16, WS_PROJ), WSP(float, WS_DT), WSP(float, WS_SLOC), WSP(float, WS_DEC), b, ch, g, INP(14) + l * 3072, INP(15) + l * 768, INP(16) + l * 4, INP(17) + l * 4, lds, tidu); }
                SUB(1)
#pragma unroll 1
                for (int g = 0; g < 2; ++g) { LAUNDER_TID hg_state_unit(WSP(bf16, WS_PROJ), WSP(float, WS_SLT), WSP(float, WS_DECC), b, ch, g, WSP(float, WS_LB1), l, lds, tidu); }
                SUB(2)
#pragma unroll 1
                for (int g = 0; g < 2; ++g) { LAUNDER_TID rg_local_unit(WSP(bf16, WS_PROJ), WSP(float, WS_HLOC), WSP(float, WS_PCUM), WSP(float, WS_RGS), b, ch, g, INP(4) + l * 1024, INP(5) + l * 256, WSP(bf16, WS_WAT) + l * 16384, WSP(bf16, WS_WAT + 512 * 1024) + l * 16384, INP(7) + l * 256, INP(9) + l * 256, INP(10) + l * 256, lds, tidu); }
            }
            SUB(3) { __syncthreads();
            for (int u = gw; u < 2048; u += NGW) { const int qb = 63 - (u >> 5), bh = u & 31; attn_unit(WSP(bf16, WS_PROJ), WSP(float, WS_ORAW), bh >> 2, bh & 3, qb, (LAS bf16*)(lds + wave * (64 * AVLD * 2)), lane); }
            __syncthreads(); }
        }
        SEAM(P + 1);
        PHASE(2, P + 2) { PH_IDS
            { float* sl = WSP(float, WS_SLOC); const float* dc = WSP(float, WS_DEC); bf16* pb = WSP(bf16, WS_PREVB);
                const int e = (vcu * NTHR + tid) * 2, n = e & 127, p = (e >> 7) & 63, h = (e >> 13) & 3, b = e >> 15;
                if (b < NB) { float r0 = 0.f, r1 = 0.f;
#pragma unroll 8
                    for (int c = 0; c < 32; ++c) { float* a = sl + ((size_t)((b * 32 + c) * 4 + h) * 64 + p) * 128 + n; const float d = dc[(b * 32 + c) * 4 + h];
                        const float s0 = a[0], s1 = a[1]; *(unsigned*)(pb + (a - sl)) = pk2(r0, r1); r0 = d * r0 + s0; r1 = d * r1 + s1; } } }
            { float* sl = WSP(float, WS_SLT); const float* dc = WSP(float, WS_DECC); bf16* pb = WSP(bf16, WS_STB);
                const int e = vcu * NTHR + tid, c = e & 63, v = (e >> 6) & 63, h = (e >> 12) & 3, b = e >> 14;
                if (b < NB) { float r = 0.f;
#pragma unroll 8
                    for (int k = 0; k < 32; ++k) { float* a = sl + ((size_t)((b * 32 + k) * 4 + h) * 64 + v) * 64 + c; const float d = dc[(size_t)((b * 32 + k) * 4 + h) * 64 + c];
                        const float s0 = a[0]; pb[a - sl] = (bf16)f2bf(r); r = d * r + s0; } } }
            { const int e = vcu * NTHR + tid;
                if (e < NB * 256) { const int b = e >> 8, c = e & 255; const float* rs = WSP(float, WS_RGS); float* cy = WSP(float, WS_CARRY); float r = 0.f;
#pragma unroll 8
                    for (int k = 0; k < 32; ++k) { const size_t o = (size_t)(b * 32 + k) * 256 + c; cy[o] = r; r = rs[2 * o] * r + rs[2 * o + 1]; } } }
        }
        SEAM(P + 2);
        PHASE(3, P + 3) { PH_IDS
            { const int v = vcu, b = v >> 5, ch = v & 31;
                SUB(4)
#pragma unroll 1
                for (int g = 0; g < 2; ++g) { LAUNDER_TID m2_out_unit(WSP(bf16, WS_PROJ), WSP(float, WS_DT), WSP(bf16, WS_PREVB), WSP(float, WS_ORAW), b, ch, g, INP(14) + l * 3072, INP(15) + l * 768, INP(16) + l * 4, INP(17) + l * 4, INP(18) + l * 4, lds, tidu); }
                SUB(5)
#pragma unroll 1
                for (int g = 0; g < 2; ++g) { LAUNDER_TID hg_out_unit(WSP(bf16, WS_PROJ), WSP(bf16, WS_STB), WSP(float, WS_ORAW), b, ch, g, WSP(float, WS_LB1), l, lds, tidu); }
                SUB(6)
                {
                    const float* hl = WSP(float, WS_HLOC); const float* pc = WSP(float, WS_PCUM); const float* cy = WSP(float, WS_CARRY); const bf16* pj = WSP(bf16, WS_PROJ); float* orw = WSP(float, WS_ORAW);
                    _Pragma("unroll 1") for (int r = 0; r < 8; ++r) { const int m = v * 64 + wave * 8 + r, c = 4 * lane; const size_t cb = (size_t)v * 256 + c;
                        const f32x4 hv = *(const f32x4*)(hl + (size_t)m * 256 + c), pv = *(const f32x4*)(pc + (size_t)m * 256 + c), cv = *(const f32x4*)(cy + cb);
                        const u32x2 gwd = *(const u32x2*)(pj + (size_t)m * DING + C_RGG + c);
                        f32x4 o = hv + pv * cv; o[0] *= gelu_tanh(bflo(gwd.x)); o[1] *= gelu_tanh(bfhi(gwd.x)); o[2] *= gelu_tanh(bflo(gwd.y)); o[3] *= gelu_tanh(bfhi(gwd.y));
                        *(f32x4*)(orw + (size_t)m * DM + 256 + c) = o; }
                    __syncthreads();
                }
                _Pragma("unroll 1") for (int r = 0; r < 8; ++r) { const int m = v * 64 + wave * 8 + r;
                    norm_row(WSP(float, WS_ORAW) + (size_t)m * DM, WSP(bf16, WS_PROJ) + (size_t)m * DING, WSP(bf16, WS_MIX) + (size_t)m * DM, INP(3) + l * 256, INP(11) + l * 256, INP(13) + l * 256, INP(19) + l * 256, lane); }
            }
        }
        SEAM(P + 3);
        PHASE(5, P + 5) { PH_IDS
            pg8::Gemm g{WSP(bf16, WS_MIX), WSP(bf16, WS_WOUT) + (size_t)l * DM * DM, T, DM, DM}; pg8::StaticOrder S; S.init(T, DM, G, bx);
            if (l == 0) { pg8::EpiResBf16<true> E{INP(0), WSP(bf16, WS_H1), DM}; pg8::gemm_phase<pg8::EpiResBf16<true>, pg8::StaticOrder, true, true>(lds, g, S, E); }
            else { pg8::EpiResBf16<false> E{WSP(bf16, WS_HB), WSP(bf16, WS_H1), DM}; pg8::gemm_phase<pg8::EpiResBf16<false>, pg8::StaticOrder, true, true>(lds, g, S, E); }
        }
        SEAM(P + 5);
        PHASE(6, P + 6) { PH_IDS
            constexpr int WLD = 1032;
            LAS bf16* WB = (LAS bf16*)lds; LAS float* LG = (LAS float*)(lds + 2 * 32 * WLD * 2); LAS float* SS = LG + 64 * 33; LAS float* RS = SS + 64;
            { const bf16* src = WSP(bf16, WS_RWB) + (size_t)l * 2 * 32 * 1024; v4u wv[16];
#pragma unroll
                for (int i = 0; i < 16; ++i) wv[i] = *(const v4u*)(src + (size_t)(tid + NTHR * i) * 8);
#pragma unroll
                for (int i = 0; i < 16; ++i) { const int c = tid + NTHR * i; *(LAS v4u*)(WB + (c >> 7) * WLD + (c & 127) * 8) = wv[i]; } }
            __syncthreads();
            const bf16* h1 = WSP(bf16, WS_H1);
            { const int rt = wave >> 1, et = wave & 1; const bf16* hp = h1 + (size_t)(vcu * 64 + rt * 16 + (lane & 15)) * DM + 8 * (lane >> 4);
                f32x4 acc = {0.f, 0.f, 0.f, 0.f}; float ssum = 0.f;
#pragma unroll 8
                for (int ks = 0; ks < 32; ++ks) { const bf16x8 a = *(const bf16x8*)(hp + 32 * ks);
                    acc = MFMA16(a, frag_kc(WB, WLD, et * 16, 32 * ks, lane), acc); acc = MFMA16(a, frag_kc(WB + 32 * WLD, WLD, et * 16, 32 * ks, lane), acc);
                    const v4u aw = __builtin_bit_cast(v4u, a);
#pragma unroll
                    for (int i = 0; i < 4; ++i) { const float x0 = bflo(aw[i]), x1 = bfhi(aw[i]); ssum += x0 * x0 + x1 * x1; } }
                ssum += __shfl_xor(ssum, 16); ssum += __shfl_xor(ssum, 32);
                if (et == 0 && lane < 16) SS[rt * 16 + lane] = ssum;
#pragma unroll
                for (int i = 0; i < 4; ++i) LG[(rt * 16 + 4 * (lane >> 4) + i) * 33 + et * 16 + (lane & 15)] = acc[i]; }
            __syncthreads();
            if (wave == 0) { const int row = lane; const float rstd = 1.0f / sqrtf(SS[row] * (1.0f / DM) + EPS); RS[row] = rstd;
                const float* rb = INP(23) + l * NE;
                float lg[32];
#pragma unroll
                for (int e = 0; e < 32; ++e) lg[e] = rstd * LG[row * 33 + e] + rb[e];
                int be[4]; float bl[4];
#pragma unroll
                for (int r = 0; r < 4; ++r) { float best = -INFINITY; int bi = 0;
#pragma unroll
                    for (int e = 0; e < 32; ++e) if (lg[e] > best) { best = lg[e]; bi = e; }
#pragma unroll
                    for (int e = 0; e < 32; ++e) if (e == bi) lg[e] = -INFINITY;
                    be[r] = bi; bl[r] = best; }
                const float e1 = expf(bl[1] - bl[0]), e2 = expf(bl[2] - bl[0]), e3 = expf(bl[3] - bl[0]), inv = 1.0f / (1.0f + e1 + e2 + e3);
                int rk0 = 0, rk1 = 0, rk2 = 0, rk3 = 0, hist = 0; const unsigned long long lt = (1ull << lane) - 1ull;
#pragma unroll
                for (int e = 0; e < 32; ++e) { const bool h0 = be[0] == e, h1b = be[1] == e, h2 = be[2] == e, h3 = be[3] == e; const unsigned long long m = __ballot(h0 | h1b | h2 | h3);
                    const int below = __popcll(m & lt); rk0 = h0 ? below : rk0; rk1 = h1b ? below : rk1; rk2 = h2 ? below : rk2; rk3 = h3 ? below : rk3; if (lane == e) hist = __popcll(m); }
                if (lane < 32) WSP(int, WS_HIST)[(size_t)vcu * 32 + lane] = hist;
                const int a = (vcu * 64 + row) * 4;
                *(int4*)(WSP(int, WS_ASGE) + a) = make_int4(be[0], be[1], be[2], be[3]); *(int4*)(WSP(int, WS_ASGP) + a) = make_int4(rk0, rk1, rk2, rk3);
                *(f32x4*)(WSP(float, WS_GATE) + a) = (f32x4){inv, e1 * inv, e2 * inv, e3 * inv}; }
            __syncthreads();
            { const float* g = INP(21) + l * DM; bf16* xn = WSP(bf16, WS_XN);
#pragma unroll
                for (int r = 0; r < 8; ++r) { const int row = wave * 8 + r; const size_t m = (size_t)vcu * 64 + row; const float rstd = RS[row];
#pragma unroll
                    for (int j = 0; j < 2; ++j) { const int col = 512 * j + 8 * lane; const v4u w = *(const v4u*)(h1 + m * DM + col); const f32x4 g0 = *(const f32x4*)(g + col), g1 = *(const f32x4*)(g + col + 4);
                        v4u o; o.x = pk2(bflo(w.x) * rstd * g0[0], bfhi(w.x) * rstd * g0[1]); o.y = pk2(bflo(w.y) * rstd * g0[2], bfhi(w.y) * rstd * g0[3]);
                        o.z = pk2(bflo(w.z) * rstd * g1[0], bfhi(w.z) * rstd * g1[1]); o.w = pk2(bflo(w.w) * rstd * g1[2], bfhi(w.w) * rstd * g1[3]);
                        *(v4u*)(xn + m * DM + col) = o; } } }
        }
        SEAM(P + 6);
        PHASE(7, P + 7) { PH_IDS
            LAS int* bs = (LAS int*)(lds + 131072);
            if (tid < 32) { const int* hs = WSP(int, WS_HIST); int base = 0, tot = 0;
#pragma unroll 8
                for (int w = 0; w < G; ++w) { const int c = hs[w * 32 + tid]; tot += c; if (w < vcu) base += c; }
                bs[tid] = base; bs[32 + tid] = tot; if (vcu == 0) WSP(int, WS_TOT)[tid] = tot; }
            __syncthreads();
            if (tid == 0) { int run = 0; for (int e = 0; e < 32; ++e) { tb[e] = run; run += (bs[32 + e] + 255) >> 8; } tb[32] = run; }
            __syncthreads();
            const int* asge = WSP(int, WS_ASGE); const int* asgp = WSP(int, WS_ASGP); int* slotp = WSP(int, WS_SLOT); int* toks = (int*)(kargs()->ws + WS_CTL + CTL_TOKS) + (size_t)l * MAXSLOT;
            if (tid < 256) { const int a = vcu * 256 + tid; const int e = asge[a], slot = tb[e] * 256 + bs[e] + asgp[a]; slotp[a] = slot; toks[slot] = a >> 2; }
        }
        SEAM(P + 7);
        PHASE(8, P + 8) { PH_IDS
            build_tb(WSP(int, WS_TOT), tb, tid);
            LAS int* tokl = (LAS int*)(lds + 131072);
            pg8::MoeOrder S{(const LAS int*)tb, 8, G, bx, (const LAS int*)tokl};
            { const int* toks = (const int*)(kargs()->ws + WS_CTL + CTL_TOKS) + (size_t)l * MAXSLOT; pg8::Unit u;
                for (int i = 0; i < 15 && S.next(i, u); ++i) if (tid < 256) tokl[i * 256 + tid] = toks[u.pm * 256 + tid];
                __syncthreads(); }
            pg8::Gemm g{WSP(bf16, WS_XN), WSP(bf16, WS_WGU) + (size_t)l * NE * 2048 * DM, T, 2048, DM};
            pg8::EpiSwiglu E{WSP(bf16, WS_ACT), INP(25) + (size_t)l * NE * 2048};
            pg8::gemm_phase<pg8::EpiSwiglu, pg8::MoeOrder, true, true>(lds, g, S, E);
            if (l + 1 < DEPTH) { const int rem = (tb[32] * 8) % G;
                if (rem != 0 && bx >= rem) { const int nw = (G - rem) * NWAVES; convert_items(CV_TAIL + nw * CV_GHQ, CV_TAIL + (bx - rem) * NWAVES + wave, nw, l + 2, ldsf + wave * (64 * 65), lane); } }
        }
        SEAM(P + 8);
        PHASE(9, P + 9) { PH_IDS
            build_tb(WSP(int, WS_TOT), tb, tid);
            pg8::Gemm g{WSP(bf16, WS_ACT), WSP(bf16, WS_WDN) + (size_t)l * NE * DM * DFF, MAXSLOT, DM, DFF}; pg8::MoeOrder S{(const LAS int*)tb, 4, G, bx};
            pg8::EpiBf16 E{WSP(bf16, WS_Y), DM, INP(27) + (size_t)l * NE * DM, DM};
            pg8::gemm_phase<pg8::EpiBf16, pg8::MoeOrder, true, true>(lds, g, S, E);
            if (l + 1 < DEPTH) { const int remg = (tb[32] * 8) % G, remh = (tb[32] * 4) % G; const int offh = CV_TAIL + (remg ? (G - remg) * NWAVES * CV_GHQ : 0);
                if (remh != 0 && bx >= remh) { const int nw = (G - remh) * NWAVES; convert_items(offh + nw * CV_GHQ, offh + (bx - remh) * NWAVES + wave, nw, l + 2, ldsf + wave * (64 * 65), lane); } }
        }
        SEAM(P + 9);
        PHASE(10, P + 10) { PH_IDS
            if (l + 1 < DEPTH) { build_tb(WSP(int, WS_TOT), tb, tid);
                const int remg = (tb[32] * 8) % G, remh = (tb[32] * 4) % G; const int offc = CV_TAIL + (remg ? (G - remg) * NWAVES * CV_GHQ : 0) + (remh ? (G - remh) * NWAVES * CV_GHQ : 0);
                convert_items(CV_MOE, offc + gw, NGW, l + 2, ldsf + wave * (64 * 65), lane); }
            const bf16* h1 = WSP(bf16, WS_H1); const int* slotp = WSP(int, WS_SLOT); const float* gatep = WSP(float, WS_GATE); const bf16* yb = WSP(bf16, WS_Y);
            for (int m = gw; m < T; m += NGW) { f32x4 v[4];
#pragma unroll
                for (int j = 0; j < 4; ++j) { const u32x2 w = *(const u32x2*)(h1 + (size_t)m * DM + 256 * j + 4 * lane); v[j] = (f32x4){bflo(w.x), bfhi(w.x), bflo(w.y), bfhi(w.y)}; }
#pragma unroll
                for (int r = 0; r < 4; ++r) { const int slot = slotp[m * 4 + r]; const float gg = gatep[m * 4 + r]; const bf16* yr = yb + (size_t)slot * DM;
#pragma unroll
                    for (int j = 0; j < 4; ++j) { const u32x2 w = *(const u32x2*)(yr + 256 * j + 4 * lane); v[j][0] += gg * bflo(w.x); v[j][1] += gg * bfhi(w.x); v[j][2] += gg * bflo(w.y); v[j][3] += gg * bfhi(w.y); } }
                if (l + 1 < DEPTH) {
#pragma unroll
                    for (int j = 0; j < 4; ++j) { u32x2 w; w.x = pk2(v[j][0], v[j][1]); w.y = pk2(v[j][2], v[j][3]); *(u32x2*)(WSP(bf16, WS_HB) + (size_t)m * DM + 256 * j + 4 * lane) = w; }
                    emit_xn_dt(v, INP(1) + (l + 1) * DM, INP(2) + (size_t)(l + 1) * DM * DIN, WSP(bf16, WS_XN) + (size_t)m * DM, WSP(float, WS_DT) + (size_t)m * 4, lane);
                } else { float ss = 0.f;
#pragma unroll
                    for (int j = 0; j < 4; ++j) ss += (v[j][0] * v[j][0] + v[j][1] * v[j][1]) + (v[j][2] * v[j][2] + v[j][3] * v[j][3]);
                    ss = wave_sum(ss); const float rstd = 1.0f / sqrtf(ss * (1.0f / DM) + EPS);
#pragma unroll
                    for (int j = 0; j < 4; ++j) *(f32x4*)(kargs()->out + (size_t)m * DM + 256 * j + 4 * lane) = v[j] * rstd * *(const f32x4*)(INP(28) + 256 * j + 4 * lane); }
            }
        }
        if (l + 1 < DEPTH) SEAM(P + 10);
    }
#undef IN
#undef SEAM
}

extern "C" void kernel_launch(void* const* d_in, const int* in_sizes, int n_in, void* d_out, int out_size, void* d_ws, size_t ws_size, hipStream_t stream) {
    static int grid = 0;
    if (grid == 0) {
        if (n_in != 29 || in_sizes[0] != T * DM || out_size != T * DM || ws_size < WS_END) { fprintf(stderr, "kernel_launch: unexpected shapes (n_in %d, in0 %d, out %d, ws %zu); nothing launched\n", n_in, n_in > 0 ? in_sizes[0] : -1, out_size, ws_size); grid = -1; return; }
        int dev = 0, cus = 0, per_cu = 0;
        if (hipGetDevice(&dev) != hipSuccess || hipDeviceGetAttribute(&cus, hipDeviceAttributeMultiprocessorCount, dev) != hipSuccess) { grid = -1; return; }
        if (hipFuncSetAttribute((const void*)fwd_kernel, hipFuncAttributeMaxDynamicSharedMemorySize, LDS_BYTES) != hipSuccess) { fprintf(stderr, "kernel_launch: hipFuncSetAttribute failed\n"); grid = -1; return; }
        if (hipOccupancyMaxActiveBlocksPerMultiprocessor(&per_cu, (const void*)fwd_kernel, NTHR, LDS_BYTES) != hipSuccess || per_cu < 1) fprintf(stderr, "kernel_launch: occupancy query reports %d\n", per_cu);
        (void)hipGetLastError();
        if (cus != 256) { fprintf(stderr, "kernel_launch: built for a 256-CU device (one workgroup per CU, work lists sized for 256 workgroups); found %d CUs; nothing launched\n", cus); grid = -1; return; }
        grid = cus;
    }
    if (grid < 0) return;
    if (hipMemsetAsync((char*)d_ws + WS_CTL, 0, CTL_ZERO_BYTES, stream) != hipSuccess) { fprintf(stderr, "kernel_launch: memset failed\n"); return; }
    Args a{};
    for (int i = 0; i < 29; ++i) a.in[i] = (const float*)d_in[i];
    a.out = (float*)d_out; a.ws = (unsigned char*)d_ws;
#if MK_N_LAUNCHES == 1
    a.ph_lo = 0; a.ph_hi = NPHASE; a.use_bar = 1;
    hipLaunchKernelGGL(fwd_kernel, dim3(grid), dim3(NTHR), LDS_BYTES, stream, a);
#else
    for (int p = 0; p < NPHASE; ++p) { a.ph_lo = p; a.ph_hi = p + 1; a.use_bar = 0; hipLaunchKernelGGL(fwd_kernel, dim3(grid), dim3(NTHR), LDS_BYTES, stream, a); }
#endif
}
```

```cpp
#include <hip/hip_runtime.h>
#include <cstdio>
#include <cstdint>

#ifndef MK_N_LAUNCHES
#define MK_N_LAUNCHES 1
#endif

constexpr int NB = 8, SEQ = 2048, DM = 1024, T = NB * SEQ, DEPTH = 2;
constexpr int DIN = 3332, DING = 3328;
constexpr int NE = 32, TOPK = 4, DFF = 1024;
constexpr int NASG = T * TOPK;
constexpr int MAXSLOT = NASG + NE * 256;
constexpr float EPS = 1e-6f;
constexpr int C_SBQ = 0, C_SBK = 256, C_SBV = 512, C_RGX = 768, C_RGG = 1024, C_HGQ = 1280, C_HGF = 1536, C_HGI = 1792, C_HGG = 2048,
              C_M2Z = 2304, C_M2X = 2560, C_DT = 3328;
constexpr int NWAVES = 8, NTHR = 512;

constexpr size_t MiB = 1u << 20;
constexpr size_t WS_CTL = 0, CTL_ZERO_BYTES = 1 * MiB;
constexpr size_t WS_WIN = 2 * MiB;
constexpr size_t WS_WOUT = 16 * MiB;
constexpr size_t WS_WGU = 32 * MiB;
constexpr size_t WS_WDN = 288 * MiB;
constexpr size_t WS_XN = 416 * MiB;
constexpr size_t WS_PROJ = 448 * MiB;
constexpr size_t WS_ORAW = 552 * MiB;
constexpr size_t WS_MIX = 616 * MiB;
constexpr size_t WS_H1 = 648 * MiB;
constexpr size_t WS_HB = 712 * MiB;
constexpr size_t WS_XS = 776 * MiB;
constexpr size_t WS_ACT = 920 * MiB;
constexpr size_t WS_Y = 1064 * MiB;
constexpr size_t WS_DT = 1208 * MiB;
constexpr size_t WS_ASGE = 1209 * MiB;
constexpr size_t WS_ASGP = 1210 * MiB;
constexpr size_t WS_GATE = 1211 * MiB;
constexpr size_t WS_SLOT = 1212 * MiB;
constexpr size_t WS_SLOC = 1216 * MiB;
constexpr size_t WS_DEC = 1248 * MiB;
constexpr size_t WS_SLT = 1250 * MiB;
constexpr size_t WS_DECC = 1266 * MiB;
constexpr size_t WS_HLOC = 1268 * MiB;
constexpr size_t WS_PCUM = 1284 * MiB;
constexpr size_t WS_RGS = 1300 * MiB;
constexpr size_t WS_CARRY = 1301 * MiB;
constexpr size_t WS_WAT = 1302 * MiB;
constexpr size_t WS_HIST = 1303 * MiB;
constexpr size_t WS_TOT = WS_HIST + 512 * 1024;
constexpr size_t WS_LB1 = WS_HIST + 768 * 1024;
constexpr size_t WS_PREVB = 1304 * MiB;
constexpr size_t WS_STB = 1320 * MiB;
constexpr size_t WS_RWB = 1328 * MiB;
constexpr size_t WS_END = 1329 * MiB;
constexpr int CW_TMO = 0, CW_CODE = 1;
constexpr int CW_CNT = 256;
constexpr int CW_BAR = 4096;
constexpr size_t CTL_TOKS = 256 * 1024;

constexpr int LDS_BYTES = 147456;
constexpr int LDSCTL_OFF = LDS_BYTES - 1024;
constexpr int MISC_OFF = LDSCTL_OFF;
constexpr int TB_OFF = LDSCTL_OFF + 256;

namespace pg8 {
#define PG8_LAS __attribute__((address_space(3)))
typedef unsigned short bf16_t;
typedef short bf16x8 __attribute__((ext_vector_type(8)));
typedef float f32x4 __attribute__((ext_vector_type(4)));
typedef unsigned u32x4 __attribute__((ext_vector_type(4)));
constexpr int BM = 256, BK = 64, HALF = 128, HTB = HALF * BK * 2  , STAGE_BYTES = 8 * HTB, NXCD = 8, WGM = 8;

__host__ __device__ __forceinline__ int lds_byte(int r, int c) { const int st = (r >> 4) * 2 + (c >> 5), rr = r & 15, cc = c & 31, ob = rr * 64 + cc * 2; return st * 1024 + (ob ^ (((ob >> 9) & 1) << 5)); }
__host__ __device__ __forceinline__ void stage_rc(int b, int& R, int& C) { const int st = b / 1024, sb = b % 1024, swz = sb ^ (((sb >> 9) & 1) << 5); R = (st >> 1) * 16 + swz / 64; C = (st & 1) * 32 + (swz % 64) / 2; }
__host__ __device__ __forceinline__ int perm32(int rho) { const int n = rho >> 4, i = rho & 15; return 8 * (i >> 2) + 4 * n + (i & 3); }

struct Unit { int pm, pn, pb, e, ui; };
struct Gemm { const bf16_t* A; const bf16_t* Bt; int M, N, K; int sw = 0x7f7f7f7f, sx = 0x7f7f7f7f; };

__host__ __device__ __forceinline__ int xcd_remap(int wgid, int nwg) { const int q = nwg / NXCD, r = nwg % NXCD, xcd = wgid % NXCD, off = wgid / NXCD; return (xcd < r ? xcd * (q + 1) : r * (q + 1) + (xcd - r) * q) + off; }

struct StaticOrder {
    int nM, nN, nwg, G, c;
    __host__ __device__ void init(int M, int N, int G_, int c_) { nM = M / BM; nN = N / BM; nwg = nM * nN; G = G_; c = c_; }
    __host__ __device__ bool next(int i, Unit& u) const {
        const long L = (long)i * G + c; if (L >= nwg) return false;
        const int wgid = xcd_remap((int)L, nwg);
        const int nig = WGM * nN, gid = wgid / nig, fm = gid * WGM, gsz = (nM - fm) < WGM ? (nM - fm) : WGM;
        u.pm = fm + ((wgid % nig) % gsz); u.pn = (wgid % nig) / gsz; u.pb = u.pn; u.e = 0; u.ui = i; return true;
    }
    __device__ __forceinline__ void a_ready(const Unit&) const {}
    __device__ __forceinline__ void done(const Unit&) const {}
    __device__ __forceinline__ size_t a_base(const Unit& u, size_t tstep) const { return (size_t)u.pm * tstep; }
    __device__ __forceinline__ unsigned a_off(const Unit&, int r, int K) const { return (unsigned)(r * K) * 2u; }
};
struct MoeOrder {
    const PG8_LAS int* tb; int NP, G, c; const PG8_LAS int* tokl;
    __device__ __forceinline__ bool next(int i, Unit& u) const {
        const int ntot = tb[32], nunits = ntot * NP;
        const long L = (long)i * G + c; if (L >= nunits) return false;
        const int id = xcd_remap((int)L, nunits);
        int e = 0;
        for (int j = 1; j < 32; ++j) if (id >= tb[j] * NP) e = j;
        e = __builtin_amdgcn_readfirstlane(e);
        const int t0 = tb[e], nt = tb[e + 1] - t0, rem = id - t0 * NP;
        u.pm = __builtin_amdgcn_readfirstlane(t0 + rem % nt); u.pn = __builtin_amdgcn_readfirstlane(rem / nt); u.pb = e * NP + u.pn; u.e = e; u.ui = i; return true;
    }
    __device__ __forceinline__ void a_ready(const Unit&) const {}
    __device__ __forceinline__ void done(const Unit&) const {}
    __device__ __forceinline__ size_t a_base(const Unit& u, size_t tstep) const { return tokl ? (size_t)0 : (size_t)u.pm * tstep; }
    __device__ __forceinline__ unsigned a_off(const Unit& u, int r, int K) const { return tokl ? (unsigned)(tokl[u.ui * 256 + r] * K) * 2u : (unsigned)(r * K) * 2u; }
};

__device__ __forceinline__ unsigned cvt_pk_bf16(float lo, float hi) { unsigned r; asm volatile("v_cvt_pk_bf16_f32 %0, %1, %2" : "=v"(r) : "v"(lo), "v"(hi)); return r; }

struct EpiBf16 {
    static constexpr bool PERM = true, AFTER_DRAIN = false;
    bf16_t* O; int ldc; const float* bias; int bias_estride;
    __device__ __forceinline__ void operator()(const f32x4 (&acc)[2][2][4][2], const Unit& u, int wr, int wc, int fr, int fq) const {
        const int row0 = u.pm * BM + wr * 64 + fr; const int col0 = u.pn * BM + wc * 32 + 8 * fq;
        f32x4 bv[2][2];
#pragma unroll
        for (int bj = 0; bj < 2; ++bj)
#pragma unroll
            for (int n = 0; n < 2; ++n) bv[bj][n] = bias ? *(const f32x4*)(bias + (size_t)u.e * bias_estride + col0 + bj * HALF + 4 * n) : (f32x4){0.f, 0.f, 0.f, 0.f};
#pragma unroll
        for (int ai = 0; ai < 2; ++ai)
#pragma unroll
            for (int m = 0; m < 4; ++m) { bf16_t* rowp = O + (size_t)(row0 + ai * HALF + m * 16) * ldc + col0;
#pragma unroll
                for (int bj = 0; bj < 2; ++bj) { const f32x4 v0 = acc[ai][bj][m][0] + bv[bj][0], v1 = acc[ai][bj][m][1] + bv[bj][1];
                    u32x4 w; w.x = cvt_pk_bf16(v0[0], v0[1]); w.y = cvt_pk_bf16(v0[2], v0[3]); w.z = cvt_pk_bf16(v1[0], v1[1]); w.w = cvt_pk_bf16(v1[2], v1[3]);
                    *(u32x4*)(rowp + bj * HALF) = w; } }
    }
};
template <bool BASE_F32> struct EpiResBf16 {
    static constexpr bool PERM = true, AFTER_DRAIN = false;
    const void* base; bf16_t* out; int ldc;
    __device__ __forceinline__ void operator()(const f32x4 (&acc)[2][2][4][2], const Unit& u, int wr, int wc, int fr, int fq) const {
        const int row0 = u.pm * BM + wr * 64 + fr, col0 = u.pn * BM + wc * 32 + 8 * fq;
#pragma unroll
        for (int ai = 0; ai < 2; ++ai)
#pragma unroll
            for (int m = 0; m < 4; ++m) { const size_t off = (size_t)(row0 + ai * HALF + m * 16) * ldc + col0;
#pragma unroll
                for (int bj = 0; bj < 2; ++bj) { f32x4 b0, b1;
                    if (BASE_F32) { const float* bp = (const float*)base + off + bj * HALF; b0 = *(const f32x4*)bp; b1 = *(const f32x4*)(bp + 4); }
                    else { const u32x4 w = *(const u32x4*)((const bf16_t*)base + off + bj * HALF);
                        b0 = (f32x4){__uint_as_float(w.x << 16), __uint_as_float(w.x & 0xffff0000u), __uint_as_float(w.y << 16), __uint_as_float(w.y & 0xffff0000u)};
                        b1 = (f32x4){__uint_as_float(w.z << 16), __uint_as_float(w.z & 0xffff0000u), __uint_as_float(w.w << 16), __uint_as_float(w.w & 0xffff0000u)}; }
                    const f32x4 v0 = b0 + acc[ai][bj][m][0], v1 = b1 + acc[ai][bj][m][1];
                    u32x4 o; o.x = cvt_pk_bf16(v0[0], v0[1]); o.y = cvt_pk_bf16(v0[2], v0[3]); o.z = cvt_pk_bf16(v1[0], v1[1]); o.w = cvt_pk_bf16(v1[2], v1[3]);
                    *(u32x4*)(out + off + bj * HALF) = o; } }
    }
};
struct EpiSwiglu8 {
    static constexpr bool PERM = true, AFTER_DRAIN = false;
    unsigned char* O; const float* bias;
    __device__ __forceinline__ void operator()(const f32x4 (&acc)[2][2][4][2], const Unit& u, int wr, int wc, int fr, int fq) const {
        const int row0 = u.pm * BM + wr * 64 + fr; const int a0 = u.pn * HALF + wc * 32 + 8 * fq;
        const float* bp = bias + (size_t)u.e * 2048 + 2 * a0;
        f32x4 b4[4];
#pragma unroll
        for (int j = 0; j < 4; ++j) b4[j] = *(const f32x4*)(bp + 4 * j);
#pragma unroll
        for (int ai = 0; ai < 2; ++ai)
#pragma unroll
            for (int m = 0; m < 4; ++m) { unsigned char* rowp = O + (size_t)(row0 + ai * HALF + m * 16) * 1024 + a0;
                float a[8];
#pragma unroll
                for (int n = 0; n < 2; ++n)
#pragma unroll
                    for (int i = 0; i < 4; ++i) { const int k = 4 * n + i;
                        float g = acc[ai][0][m][n][i] + b4[k >> 1][2 * (k & 1)], l = acc[ai][1][m][n][i] + b4[k >> 1][2 * (k & 1) + 1];
                        g = fminf(g, 7.0f); l = fminf(fmaxf(l, -7.0f), 7.0f);
                        const float sg = __builtin_amdgcn_rcpf(1.0f + __builtin_amdgcn_exp2f(-1.702f * 1.4426950408889634f * g));
                        a[k] = g * sg * (l + 1.0f); }
                int w0 = 0, w1 = 0;
                w0 = __builtin_amdgcn_cvt_pk_fp8_f32(a[0], a[1], w0, false); w0 = __builtin_amdgcn_cvt_pk_fp8_f32(a[2], a[3], w0, true);
                w1 = __builtin_amdgcn_cvt_pk_fp8_f32(a[4], a[5], w1, false); w1 = __builtin_amdgcn_cvt_pk_fp8_f32(a[6], a[7], w1, true);
                typedef int i32x2_ __attribute__((ext_vector_type(2)));
                *(i32x2_*)rowp = (i32x2_){w0, w1}; }
    }
};
struct EpiSwiglu {
    static constexpr bool PERM = true, AFTER_DRAIN = false;
    bf16_t* O; const float* bias;
    __device__ __forceinline__ void operator()(const f32x4 (&acc)[2][2][4][2], const Unit& u, int wr, int wc, int fr, int fq) const {
        const int row0 = u.pm * BM + wr * 64 + fr; const int a0 = u.pn * HALF + wc * 32 + 8 * fq;
        const float* bp = bias + (size_t)u.e * 2048 + 2 * a0;
        f32x4 b4[4];
#pragma unroll
        for (int j = 0; j < 4; ++j) b4[j] = *(const f32x4*)(bp + 4 * j);
#pragma unroll
        for (int ai = 0; ai < 2; ++ai)
#pragma unroll
            for (int m = 0; m < 4; ++m) { bf16_t* rowp = O + (size_t)(row0 + ai * HALF + m * 16) * 1024 + a0;
                float a[8];
#pragma unroll
                for (int n = 0; n < 2; ++n)
#pragma unroll
                    for (int i = 0; i < 4; ++i) { const int k = 4 * n + i;
                        float g = acc[ai][0][m][n][i] + b4[k >> 1][2 * (k & 1)], l = acc[ai][1][m][n][i] + b4[k >> 1][2 * (k & 1) + 1];
                        g = fminf(g, 7.0f); l = fminf(fmaxf(l, -7.0f), 7.0f);
                        const float sg = __builtin_amdgcn_rcpf(1.0f + __builtin_amdgcn_exp2f(-1.702f * 1.4426950408889634f * g));
                        a[k] = g * sg * (l + 1.0f); }
                u32x4 w; w.x = cvt_pk_bf16(a[0], a[1]); w.y = cvt_pk_bf16(a[2], a[3]); w.z = cvt_pk_bf16(a[4], a[5]); w.w = cvt_pk_bf16(a[6], a[7]);
                *(u32x4*)rowp = w; }
    }
};

template <class Epi, class Sched, bool ALIGN_EPI = false, bool SP2 = false, bool F8 = false>
__device__ __forceinline__ void gemm_phase(PG8_LAS unsigned char* lds, const Gemm g, const Sched& S, const Epi& E) {
    int tid = threadIdx.x; asm volatile("" : "+v"(tid));
    const int wid = __builtin_amdgcn_readfirstlane(tid >> 6), lane = tid & 63, wr = wid >> 2, wc = wid & 3, fr = lane & 15, fq = lane >> 4;
    const int K = g.K, PITCH = F8 ? K : 2 * K  , KH = PITCH / 2, nt = PITCH / (2 * BK);
    unsigned vAc[2][2], vAn[2][2], voffB[2];
    int sR[2], sC[2];
#pragma unroll
    for (int i = 0; i < 2; ++i) { int R, C; stage_rc(tid * 16 + i * 8192, R, C); const int Rb = Epi::PERM ? ((R & ~31) + perm32(R & 31)) : R;
        sR[i] = R; sC[i] = C; voffB[i] = (unsigned)(Rb * KH + C) * 2u; }
    const size_t kstep = (size_t)(BK * 2);
    const size_t hstep = (size_t)HALF * PITCH;
    const size_t tstep = 2 * hstep;
    const unsigned ldsw = (unsigned)wid * 1024u;
    const int aoff = F8 ? lds_byte(wr * 64 + fr, 16 * (fq & 1)) + (fq >> 1) * 1024 : lds_byte(wr * 64 + fr, fq * 8), boff = F8 ? lds_byte(wc * 32 + fr, 16 * (fq & 1)) + (fq >> 1) * 1024 : lds_byte(wc * 32 + fr, fq * 8);
    typedef int v8i_ __attribute__((ext_vector_type(8))); typedef int v4i_ __attribute__((ext_vector_type(4)));
#define PG8_SA(b, h) (((b) * 2 + (h)) * HTB)
#define PG8_SB(b, h) ((4 + (b) * 2 + (h)) * HTB)
#define PG8_STAGE(bufoff, gbase, voff) do { _Pragma("unroll") for (int _i = 0; _i < 2; ++_i) \
        __builtin_amdgcn_global_load_lds((const unsigned*)((const char*)(gbase) + (voff)[_i]), (PG8_LAS unsigned*)(lds + (bufoff) + ldsw + _i * 8192), 16, 0, 0); } while (0)
#define PG8_LDA(dst, b, h) do { if constexpr (F8) { _Pragma("unroll") for (int m = 0; m < 4; ++m) { const v4i_ lo_ = *(const PG8_LAS v4i_*)(lds + PG8_SA(b, h) + aoff + m * 2048), hi_ = *(const PG8_LAS v4i_*)(lds + PG8_SA(b, h) + aoff + m * 2048 + 16); \
            dst##8[m] = __builtin_shufflevector(lo_, hi_, 0, 1, 2, 3, 4, 5, 6, 7); } } \
        else { _Pragma("unroll") for (int m = 0; m < 4; ++m) _Pragma("unroll") for (int k = 0; k < 2; ++k) dst[m][k] = *(const PG8_LAS bf16x8*)(lds + PG8_SA(b, h) + aoff + m * 2048 + k * 1024); } } while (0)
#define PG8_LDB(dst, b, h) do { if constexpr (F8) { _Pragma("unroll") for (int n = 0; n < 2; ++n) { const v4i_ lo_ = *(const PG8_LAS v4i_*)(lds + PG8_SB(b, h) + boff + n * 2048), hi_ = *(const PG8_LAS v4i_*)(lds + PG8_SB(b, h) + boff + n * 2048 + 16); \
            dst##8[n] = __builtin_shufflevector(lo_, hi_, 0, 1, 2, 3, 4, 5, 6, 7); } } \
        else { _Pragma("unroll") for (int n = 0; n < 2; ++n) _Pragma("unroll") for (int k = 0; k < 2; ++k) dst[n][k] = *(const PG8_LAS bf16x8*)(lds + PG8_SB(b, h) + boff + n * 2048 + k * 1024); } } while (0)
#define PG8_MMA(ai, bj, At, Bt) do { __builtin_amdgcn_s_setprio(1); if constexpr (F8) asm volatile("s_nop 3"); _Pragma("unroll") for (int m = 0; m < 4; ++m) _Pragma("unroll") for (int n = 0; n < 2; ++n) { \
        if constexpr (F8) asm volatile("v_mfma_scale_f32_16x16x128_f8f6f4 %0, %1, %2, %0, %3, %4 op_sel_hi:[0,0,0]" : "+v"(acc[ai][bj][m][n]) : "v"(Bt##8[n]), "v"(At##8[m]), "v"(swv), "v"(sxv)); \
        else { _Pragma("unroll") for (int k = 0; k < 2; ++k) acc[ai][bj][m][n] = __builtin_amdgcn_mfma_f32_16x16x32_bf16(Bt[n][k], At[m][k], acc[ai][bj][m][n], 0, 0, 0); } } \
        __builtin_amdgcn_s_setprio(0); } while (0)
#define PG8_WAIT_V(n) asm volatile("s_waitcnt vmcnt(" #n ")" ::: "memory")
#define PG8_WAIT_L(n) asm volatile("s_waitcnt lgkmcnt(" #n ")" ::: "memory")
#define PG8_BAR __builtin_amdgcn_s_barrier()
#define PG8_SCHED __builtin_amdgcn_sched_barrier(0)
    Unit cur, nxt; int ui = 0;
    if (!S.next(0, cur)) return;
    f32x4 acc[2][2][4][2];
#pragma unroll
    for (int a = 0; a < 2; ++a)
#pragma unroll
        for (int b = 0; b < 2; ++b)
#pragma unroll
            for (int m = 0; m < 4; ++m)
#pragma unroll
                for (int n = 0; n < 2; ++n) acc[a][b][m][n] = (f32x4){0.f, 0.f, 0.f, 0.f};
    int swv = g.sw, sxv = g.sx;
    bf16x8 At[4][2], B0[2][2], B1[2][2]; v8i_ At8[4], B08[2], B18[2];
    const char* cA = (const char*)g.A + S.a_base(cur, tstep); const char* cB = (const char*)g.Bt + (size_t)cur.pb * tstep;
#pragma unroll
    for (int h = 0; h < 2; ++h)
#pragma unroll
        for (int i = 0; i < 2; ++i) { vAc[h][i] = S.a_off(cur, h * HALF + sR[i], KH) + (unsigned)sC[i] * 2u; vAn[h][i] = vAc[h][i]; }
    S.a_ready(cur);
    if constexpr (SP2) {
        PG8_STAGE(PG8_SB(0, 0), cB, voffB); PG8_STAGE(PG8_SB(0, 1), cB + hstep, voffB); PG8_STAGE(PG8_SA(0, 0), cA, vAc[0]); PG8_STAGE(PG8_SA(0, 1), cA, vAc[1]);
        if (wr == 1) PG8_BAR;
        PG8_WAIT_V(2); PG8_BAR;
        PG8_STAGE(PG8_SB(1, 0), cB + kstep, voffB); PG8_STAGE(PG8_SA(1, 0), cA + kstep, vAc[0]); PG8_STAGE(PG8_SB(1, 1), cB + hstep + kstep, voffB);
        PG8_WAIT_V(6); PG8_BAR;
    } else {
        PG8_STAGE(PG8_SB(0, 0), cB, voffB); PG8_STAGE(PG8_SA(0, 0), cA, vAc[0]); PG8_STAGE(PG8_SB(0, 1), cB + hstep, voffB); PG8_STAGE(PG8_SA(0, 1), cA, vAc[1]);
        if (wr == 1) PG8_BAR;
        PG8_WAIT_V(4); PG8_BAR;
        PG8_STAGE(PG8_SB(1, 0), cB + kstep, voffB); PG8_STAGE(PG8_SA(1, 0), cA + kstep, vAc[0]); PG8_STAGE(PG8_SB(1, 1), cB + hstep + kstep, voffB);
        PG8_WAIT_V(6); PG8_BAR;
    }
    for (;;) {
        const bool has_next = S.next(ui + 1, nxt);
        const char* nA = has_next ? (const char*)g.A + S.a_base(nxt, tstep) : cA;
        if (has_next) {
#pragma unroll
            for (int h = 0; h < 2; ++h)
#pragma unroll
                for (int i = 0; i < 2; ++i) vAn[h][i] = S.a_off(nxt, h * HALF + sR[i], KH) + (unsigned)sC[i] * 2u; } const char* nB = has_next ? (const char*)g.Bt + (size_t)nxt.pb * tstep : cB;
        for (int t = 0; t < nt; t += 2) {
            const bool last = (t == nt - 2);
            const char* a1 = cA + (size_t)(t + 1) * kstep;
            const char* a2 = last ? nA : cA + (size_t)(t + 2) * kstep; const char* b2 = last ? nB : cB + (size_t)(t + 2) * kstep;
            const char* a3 = a2 + kstep; const char* b3 = b2 + kstep;
            unsigned v2[2][2];
#pragma unroll
            for (int h = 0; h < 2; ++h)
#pragma unroll
                for (int i = 0; i < 2; ++i) v2[h][i] = last ? vAn[h][i] : vAc[h][i];
            if (last && has_next) S.a_ready(nxt);
            if constexpr (SP2) {
            PG8_LDB(B0, 0, 0); PG8_LDB(B1, 0, 1); PG8_SCHED; PG8_LDA(At, 0, 0); PG8_STAGE(PG8_SA(1, 1), a1, vAc[1]);
            PG8_WAIT_V(8); PG8_WAIT_L(0); PG8_BAR; PG8_MMA(0, 0, At, B0); PG8_MMA(0, 1, At, B1); PG8_BAR; PG8_SCHED;
            PG8_LDA(At, 0, 1); PG8_STAGE(PG8_SB(0, 0), b2, voffB); PG8_STAGE(PG8_SB(0, 1), b2 + hstep, voffB); PG8_STAGE(PG8_SA(0, 0), a2, v2[0]);
            PG8_WAIT_V(8); PG8_WAIT_L(0); PG8_BAR; PG8_MMA(1, 0, At, B0); PG8_MMA(1, 1, At, B1); PG8_BAR; PG8_SCHED;
            PG8_LDB(B0, 1, 0); PG8_LDB(B1, 1, 1); PG8_SCHED; PG8_LDA(At, 1, 0); PG8_STAGE(PG8_SA(0, 1), a2, v2[1]);
            PG8_WAIT_V(8); PG8_WAIT_L(0); PG8_BAR; PG8_MMA(0, 0, At, B0); PG8_MMA(0, 1, At, B1); PG8_BAR; PG8_SCHED;
            PG8_LDA(At, 1, 1); PG8_STAGE(PG8_SB(1, 0), b3, voffB); PG8_STAGE(PG8_SB(1, 1), b3 + hstep, voffB); PG8_STAGE(PG8_SA(1, 0), a3, v2[0]);
            PG8_WAIT_V(8); PG8_WAIT_L(0); PG8_BAR; PG8_MMA(1, 0, At, B0); PG8_MMA(1, 1, At, B1); PG8_BAR; PG8_SCHED;
            } else {
            PG8_LDB(B0, 0, 0); PG8_SCHED; PG8_LDA(At, 0, 0); PG8_STAGE(PG8_SA(1, 1), a1, vAc[1]);
            PG8_WAIT_L(8); PG8_BAR; PG8_WAIT_L(0); PG8_MMA(0, 0, At, B0); PG8_BAR; PG8_SCHED;
            PG8_LDB(B1, 0, 1); PG8_STAGE(PG8_SB(0, 0), b2, voffB);
            PG8_BAR; PG8_WAIT_L(0); PG8_MMA(0, 1, At, B1); PG8_BAR;
            PG8_LDA(At, 0, 1); PG8_STAGE(PG8_SA(0, 0), a2, v2[0]);
            PG8_BAR; PG8_WAIT_L(0); PG8_MMA(1, 0, At, B0); PG8_BAR; PG8_SCHED;
            PG8_STAGE(PG8_SB(0, 1), b2 + hstep, voffB);
            PG8_WAIT_V(6); PG8_BAR; PG8_MMA(1, 1, At, B1); PG8_BAR;
            PG8_LDB(B0, 1, 0); PG8_SCHED; PG8_LDA(At, 1, 0); PG8_STAGE(PG8_SA(0, 1), a2, v2[1]);
            PG8_WAIT_L(8); PG8_BAR; PG8_WAIT_L(0); PG8_MMA(0, 0, At, B0); PG8_BAR; PG8_SCHED;
            PG8_LDB(B1, 1, 1); PG8_STAGE(PG8_SB(1, 0), b3, voffB);
            PG8_BAR; PG8_WAIT_L(0); PG8_MMA(0, 1, At, B1); PG8_BAR;
            PG8_LDA(At, 1, 1); PG8_STAGE(PG8_SA(1, 0), a3, v2[0]);
            PG8_BAR; PG8_WAIT_L(0); PG8_MMA(1, 0, At, B0); PG8_BAR; PG8_SCHED;
            PG8_STAGE(PG8_SB(1, 1), b3 + hstep, voffB);
            PG8_WAIT_V(6); PG8_BAR; PG8_MMA(1, 1, At, B1); PG8_BAR;
            }
        }
        if constexpr (F8) {
#pragma unroll
            for (int a = 0; a < 2; ++a)
#pragma unroll
                for (int b = 0; b < 2; ++b) asm volatile("s_nop 15\n\ts_nop 7" : "+v"(acc[a][b][0][0]), "+v"(acc[a][b][0][1]), "+v"(acc[a][b][1][0]), "+v"(acc[a][b][1][1]), "+v"(acc[a][b][2][0]), "+v"(acc[a][b][2][1]), "+v"(acc[a][b][3][0]), "+v"(acc[a][b][3][1])); }
        if constexpr (ALIGN_EPI) { if (wr == 0) PG8_BAR; }
        if constexpr (!Epi::AFTER_DRAIN) { E(acc, cur, wr, wc, fr, fq); S.done(cur); }
        if (!has_next) break;
#pragma unroll
        for (int a = 0; a < 2; ++a)
#pragma unroll
            for (int b = 0; b < 2; ++b)
#pragma unroll
                for (int m = 0; m < 4; ++m)
#pragma unroll
                    for (int n = 0; n < 2; ++n) acc[a][b][m][n] = (f32x4){0.f, 0.f, 0.f, 0.f};
        cur = nxt; cA = nA; cB = nB; ++ui;
#pragma unroll
        for (int h = 0; h < 2; ++h)
#pragma unroll
            for (int i = 0; i < 2; ++i) vAc[h][i] = vAn[h][i];
        if constexpr (ALIGN_EPI) { if (wr == 1) PG8_BAR; }
    }
    PG8_WAIT_V(0);
    if constexpr (!ALIGN_EPI) { if (wr == 0) PG8_BAR; }
    PG8_BAR;
    if constexpr (Epi::AFTER_DRAIN) { E.fused(acc, cur, wr, wc, fr, fq, lds, wid, lane); S.done(cur); }
#undef PG8_SA
#undef PG8_SB
#undef PG8_STAGE
#undef PG8_LDA
#undef PG8_LDB
#undef PG8_MMA
#undef PG8_WAIT_V
#undef PG8_WAIT_L
#undef PG8_BAR
#undef PG8_SCHED
}
}
#define GAS __attribute__((address_space(1)))
#define LAS __attribute__((address_space(3)))
typedef unsigned short bf16;
typedef unsigned v4u __attribute__((ext_vector_type(4)));
typedef float f32x4 __attribute__((ext_vector_type(4)));
typedef short bf16x8 __attribute__((ext_vector_type(8)));
typedef GAS unsigned gu32;
typedef GAS unsigned long long gu64;
#define RLX_AGENT __ATOMIC_RELAXED, __HIP_MEMORY_SCOPE_AGENT
#define LDS_WAIT() asm volatile("s_waitcnt lgkmcnt(0)" ::: "memory")
#define VM_WAIT() asm volatile("s_waitcnt vmcnt(0)" ::: "memory")
__device__ __forceinline__ unsigned long long rt() { return __builtin_amdgcn_s_memrealtime(); }
__device__ __forceinline__ unsigned f2bf(float f) { unsigned u = __builtin_bit_cast(unsigned, f); return (u + 0x7fffu + ((u >> 16) & 1u)) >> 16; }
__device__ __forceinline__ unsigned pk2(float lo, float hi) { return f2bf(lo) | (f2bf(hi) << 16); }

#define XB_TMO      128
#define XB_XCNT(j)  (256  + 64 * (j))
#define XB_XSUB(j)  (1280 + 64 * (j))
#define XB_XGEN(j)  (2304 + 64 * (j))
#define XB_TOP      3328
#define XB_TOPGEN   3392
#define XCD_BAR_WORDS 3456
#define XB_SPIN_CAP (1u << 18)

__device__ __forceinline__ unsigned xb_ld(unsigned* p)              { return __hip_atomic_load(p, __ATOMIC_RELAXED, __HIP_MEMORY_SCOPE_AGENT); }
__device__ __forceinline__ unsigned xb_add(unsigned* p, unsigned v) { return __hip_atomic_fetch_add(p, v, __ATOMIC_RELAXED, __HIP_MEMORY_SCOPE_AGENT); }
__device__ __forceinline__ unsigned xb_xcc_id() { return (unsigned)__builtin_amdgcn_s_getreg((3 << 11) | 20) & 0xFu; }
#define XB_SPIN(cond, bar) do { unsigned _sp = 0; while (cond) { __builtin_amdgcn_s_sleep(1); \
    if ((++_sp & 255u) == 0u) { if (xb_ld(&(bar)[XB_TMO])) break; if (_sp > XB_SPIN_CAP) { atomicAdd(&(bar)[XB_TMO], 1u); break; } } } } while (0)

struct XcdBarrier {
    unsigned* bar; unsigned x;
    volatile LAS unsigned* st;
};

__device__ __forceinline__ XcdBarrier xcd_barrier_post(unsigned* bar, volatile LAS unsigned* st) {
    XcdBarrier b; b.bar = bar; b.x = xb_xcc_id(); b.st = st;
    if (threadIdx.x == 0) (void)xb_add(&bar[XB_XCNT(b.x)], 1u);
    return b;
}
__device__ __forceinline__ void xcd_barrier_complete(unsigned* bar, unsigned x, unsigned& nloc, unsigned& nx) {
    const unsigned G = gridDim.x * gridDim.y * gridDim.z;
    unsigned sum, cnt, mine, sp = 0u;
    for (;;) {
        sum = 0u; cnt = 0u; mine = 0u;
#pragma unroll
        for (unsigned j = 0; j < 16; ++j) { const unsigned c = xb_ld(&bar[XB_XCNT(j)]); sum += c; cnt += (c > 0u) ? 1u : 0u; mine = (j == x) ? c : mine; }
        if (sum == G) break;
        __builtin_amdgcn_s_sleep(1);
        if ((++sp & 255u) == 0u) { if (xb_ld(&bar[XB_TMO])) break; if (sp > XB_SPIN_CAP) { atomicAdd(&bar[XB_TMO], 1u); break; } }
    }
    nloc = mine > 0u ? mine : 1u; nx = cnt > 0u ? cnt : 1u;
}

__device__ __forceinline__ void xcd_barrier(const XcdBarrier& b) {
    asm volatile("s_waitcnt vmcnt(0)" ::: "memory");
    __syncthreads();
    if (threadIdx.x == 0) {
        unsigned* bar = b.bar;
        __builtin_amdgcn_s_waitcnt(0);
        unsigned nloc = b.st[0], nx = b.st[1];
        if (nloc == 0u) { xcd_barrier_complete(bar, b.x, nloc, nx); b.st[0] = nloc; b.st[1] = nx; }
        const unsigned old = xb_add(&bar[XB_XSUB(b.x)], 1u);
        const unsigned gen = old / nloc;
        if (old + 1u == (gen + 1u) * nloc) {
            __builtin_amdgcn_fence(__ATOMIC_RELEASE, "agent");
            asm volatile("s_waitcnt vmcnt(0)" ::: "memory");
            const unsigned og = xb_add(&bar[XB_TOP], 1u);
            const unsigned tg = og / nx;
            if (og + 1u == (tg + 1u) * nx) xb_add(&bar[XB_TOPGEN], 1u);
            else XB_SPIN(xb_ld(&bar[XB_TOPGEN]) == tg, bar);
            __builtin_amdgcn_fence(__ATOMIC_ACQUIRE, "agent");
            xb_add(&bar[XB_XGEN(b.x)], 1u);
            asm volatile("s_waitcnt vmcnt(0)" ::: "memory");
        } else {
            XB_SPIN(xb_ld(&bar[XB_XGEN(b.x)]) == gen, bar);
            __builtin_amdgcn_fence(__ATOMIC_ACQUIRE, "agent");
            asm volatile("s_waitcnt vmcnt(0)" ::: "memory");
        }
    }
    __syncthreads();
}

using pg8::bf16_t;
typedef unsigned u32x2 __attribute__((ext_vector_type(2)));
__device__ __forceinline__ float bf2f(unsigned v) { return __uint_as_float(v << 16); }
__device__ __forceinline__ float bflo(unsigned w) { return __uint_as_float(w << 16); }
__device__ __forceinline__ float bfhi(unsigned w) { return __uint_as_float(w & 0xffff0000u); }
__device__ __forceinline__ float wave_sum(float v) {
#pragma unroll
    for (int o = 1; o < 64; o <<= 1) v += __shfl_xor(v, o);
    return v;
}
__device__ __forceinline__ float sigm(float x) { return 1.0f / (1.0f + expf(-x)); }
__device__ __forceinline__ float softplusf_(float x) { return fmaxf(x, 0.f) + log1pf(expf(-fabsf(x))); }
__device__ __forceinline__ float gelu_tanh(float x) { const float y = 0.7978845608028654f * (x + 0.044715f * x * x * x);
    return x * __builtin_amdgcn_rcpf(1.0f + __builtin_amdgcn_exp2f(-2.0f * 1.4426950408889634f * y)); }

__device__ __forceinline__ int gu_rowmap(int n) { const int a = n >> 1; return ((a >> 7) << 8) + (a & 127) + ((n & 1) << 7); }
struct TDesc { const float* W; bf16* WT; int ldw, K, k0, n0, gu; float f8s; };
__device__ __forceinline__ void tload(const TDesc& d, f32x4 (&v)[16], int lane) {
#pragma unroll
    for (int i = 0; i < 16; ++i) v[i] = __builtin_nontemporal_load((const f32x4*)(d.W + (size_t)(d.k0 + 4 * i + (lane >> 4)) * d.ldw + d.n0 + 4 * (lane & 15)));
}
__device__ __forceinline__ void tstore(const TDesc& d, const f32x4 (&v)[16], LAS float* scr, int lane) {
#pragma unroll
    for (int i = 0; i < 16; ++i) { LAS float* p = scr + (4 * i + (lane >> 4)) * 65 + 4 * (lane & 15); p[0] = v[i][0]; p[1] = v[i][1]; p[2] = v[i][2]; p[3] = v[i][3]; }
    LDS_WAIT(); asm volatile("" ::: "memory");
    const int c = lane & 7;
#pragma unroll
    for (int j = 0; j < 8; ++j) { const int n = 8 * j + (lane >> 3); const LAS float* s = scr + (8 * c) * 65 + n;
        const int nr = d.gu ? gu_rowmap(d.n0 + n) : (d.n0 + n);
        if (d.f8s != 0.f) { const float f = d.f8s; int w0 = 0, w1 = 0;
            w0 = __builtin_amdgcn_cvt_pk_fp8_f32(s[0] * f, s[65] * f, w0, false); w0 = __builtin_amdgcn_cvt_pk_fp8_f32(s[130] * f, s[195] * f, w0, true);
            w1 = __builtin_amdgcn_cvt_pk_fp8_f32(s[260] * f, s[325] * f, w1, false); w1 = __builtin_amdgcn_cvt_pk_fp8_f32(s[390] * f, s[455] * f, w1, true);
            u32x2 o; o.x = (unsigned)w0; o.y = (unsigned)w1; *(u32x2*)((unsigned char*)d.WT + (size_t)nr * d.K + d.k0 + 8 * c) = o; }
        else { v4u o; o.x = pg8::cvt_pk_bf16(s[0], s[65]); o.y = pg8::cvt_pk_bf16(s[130], s[195]); o.z = pg8::cvt_pk_bf16(s[260], s[325]); o.w = pg8::cvt_pk_bf16(s[390], s[455]);
            *(v4u*)(d.WT + (size_t)nr * d.K + d.k0 + 8 * c) = o; } }
    LDS_WAIT(); asm volatile("" ::: "memory");
}
constexpr int IT_WIN = 16 * 52, IT_WOUT = 256, IT_GU = 512, IT_DN = 256;
constexpr int NIT_WIN = DEPTH * IT_WIN, NIT_WOUT = DEPTH * IT_WOUT, NIT_GU = DEPTH * NE * IT_GU, NIT_DN = DEPTH * NE * IT_DN, NITEMS = NIT_WIN + NIT_WOUT + NIT_GU + NIT_DN;

__device__ __forceinline__ void emit_xn_dt(const f32x4 (&v)[4], const float* g, const float* win_l, bf16* xn_row, float* dt_row, int lane) {
    float ss = 0.f;
#pragma unroll
    for (int j = 0; j < 4; ++j) ss += (v[j][0] * v[j][0] + v[j][1] * v[j][1]) + (v[j][2] * v[j][2] + v[j][3] * v[j][3]);
    ss = wave_sum(ss);
    const float rstd = 1.0f / sqrtf(ss * (1.0f / DM) + EPS);
    float d0 = 0.f, d1 = 0.f, d2 = 0.f, d3 = 0.f;
#pragma unroll
    for (int j = 0; j < 4; ++j) { const int col = 256 * j + 4 * lane; const f32x4 gg = *(const f32x4*)(g + col); const f32x4 u = v[j] * rstd * gg;
        u32x2 w; w.x = pk2(u[0], u[1]); w.y = pk2(u[2], u[3]); *(u32x2*)(xn_row + col) = w;
#pragma unroll
        for (int i = 0; i < 4; ++i) { const f32x4 ww = *(const f32x4*)(win_l + (size_t)(col + i) * DIN + C_DT); d0 += u[i] * ww[0]; d1 += u[i] * ww[1]; d2 += u[i] * ww[2]; d3 += u[i] * ww[3]; } }
    d0 = wave_sum(d0); d1 = wave_sum(d1); d2 = wave_sum(d2); d3 = wave_sum(d3);
    if (lane == 0) *(f32x4*)dt_row = (f32x4){d0, d1, d2, d3};
}

__device__ __forceinline__ void norm_row(const float* orow, const bf16* prow, bf16* mrow, const float* gA, const float* gB, const float* gC, const float* gD, int lane) {
    f32x4 v[4];
#pragma unroll
    for (int j = 0; j < 4; ++j) v[j] = *(const f32x4*)(orow + 256 * j + 4 * lane);
    float s[4];
#pragma unroll
    for (int j = 0; j < 4; ++j) s[j] = (v[j][0] * v[j][0] + v[j][1] * v[j][1]) + (v[j][2] * v[j][2] + v[j][3] * v[j][3]);
#pragma unroll
    for (int o = 1; o < 64; o <<= 1) { s[0] += __shfl_xor(s[0], o); s[1] += __shfl_xor(s[1], o); if (o < 16) s[2] += __shfl_xor(s[2], o); if (o < 32) s[3] += __shfl_xor(s[3], o); }
    const float r0 = 1.0f / sqrtf(s[0] * (1.0f / 256) + EPS), r1 = 1.0f / sqrtf(s[1] * (1.0f / 256) + EPS), r2 = 1.0f / sqrtf(s[2] * (1.0f / 64) + EPS), r3 = 1.0f / sqrtf(s[3] * (1.0f / 128) + EPS);
    const int c = 4 * lane;
    const f32x4 g0 = *(const f32x4*)(gA + c), g1 = *(const f32x4*)(gB + c), g2 = *(const f32x4*)(gC + c), g3 = *(const f32x4*)(gD + c);
    const u32x2 gw = *(const u32x2*)(prow + C_HGG + c);
    const float gi[4] = {bflo(gw.x), bfhi(gw.x), bflo(gw.y), bfhi(gw.y)};
    f32x4 o0 = v[0] * r0 * g0, o1 = v[1] * r1 * g1, o2 = v[2] * r2 * g2, o3 = v[3] * r3 * g3;
#pragma unroll
    for (int i = 0; i < 4; ++i) o2[i] *= gi[i] * sigm(gi[i]);
    u32x2 w;
    w.x = pk2(o0[0], o0[1]); w.y = pk2(o0[2], o0[3]); *(u32x2*)(mrow + c) = w;
    w.x = pk2(o1[0], o1[1]); w.y = pk2(o1[2], o1[3]); *(u32x2*)(mrow + 256 + c) = w;
    w.x = pk2(o2[0], o2[1]); w.y = pk2(o2[2], o2[3]); *(u32x2*)(mrow + 512 + c) = w;
    w.x = pk2(o3[0], o3[1]); w.y = pk2(o3[2], o3[3]); *(u32x2*)(mrow + 768 + c) = w;
}

__device__ __forceinline__ void build_tb(const int* tot, LAS int* tb, int tid) {
    if (tid == 0) { int run = 0; for (int e = 0; e < 32; ++e) { tb[e] = run; run += (tot[e] + 255) >> 8; } tb[32] = run; }
    __syncthreads();
}

typedef short s16x4 __attribute__((ext_vector_type(4)));
typedef short v4i16_t __attribute__((ext_vector_type(4)));
#define MFMA16(a, b, c) __builtin_amdgcn_mfma_f32_16x16x32_bf16((a), (b), (c), 0, 0, 0)
__device__ __forceinline__ bf16x8 frag_kc(const LAS bf16* M, int ld, int idx0, int k0, int lane) { return *(const LAS bf16x8*)(M + (idx0 + (lane & 15)) * ld + k0 + 8 * (lane >> 4)); }
__device__ __forceinline__ bf16x8 frag_ks(const LAS bf16* M, int ld, int idx0, int k0, int lane) {
    const LAS bf16* p = M + (k0 + 8 * (lane >> 4) + ((lane & 15) >> 2)) * ld + idx0 + 4 * (lane & 3);
    const s16x4 lo = __builtin_bit_cast(s16x4, __builtin_amdgcn_ds_read_tr16_b64_v4i16((LAS v4i16_t*)p));
    const s16x4 hi = __builtin_bit_cast(s16x4, __builtin_amdgcn_ds_read_tr16_b64_v4i16((LAS v4i16_t*)(p + 4 * ld)));
    return (bf16x8){lo[0], lo[1], lo[2], lo[3], hi[0], hi[1], hi[2], hi[3]};
}
__device__ __forceinline__ bf16x8 frag_g32(const float* M, int ld, int idx0, int k0, int lane) {
    const float* p = M + (size_t)(idx0 + (lane & 15)) * ld + k0 + 8 * (lane >> 4);
    const f32x4 a = *(const f32x4*)p, b = *(const f32x4*)(p + 4);
    v4u w; w.x = pk2(a[0], a[1]); w.y = pk2(a[2], a[3]); w.z = pk2(b[0], b[1]); w.w = pk2(b[2], b[3]);
    return __builtin_bit_cast(bf16x8, w);
}
__device__ __forceinline__ float fsigm(float x) { return __builtin_amdgcn_rcpf(1.0f + __builtin_amdgcn_exp2f(-1.4426950408889634f * x)); }
__device__ __forceinline__ float fexp(float x) { return __builtin_amdgcn_exp2f(1.4426950408889634f * x); }

constexpr int M2LD = 136, M2WLD = 72;
__device__ __forceinline__ void m2_conv_block(const bf16* proj, const float* cw, const float* cb, int b, int t0, int tq, int cc0, float (&o)[8][8]) {
    v4u x[11]; f32x4 w[4][2];
    const int ts0 = t0 + 8 * tq - 3;
#pragma unroll
    for (int r = 0; r < 11; ++r) { const int ts = ts0 + r; x[r] = (v4u){0u, 0u, 0u, 0u}; if (ts >= 0) x[r] = *(const v4u*)(proj + ((size_t)b * SEQ + ts) * DING + C_M2X + cc0); }
#pragma unroll
    for (int k = 0; k < 4; ++k) { w[k][0] = *(const f32x4*)(cw + k * 768 + cc0); w[k][1] = *(const f32x4*)(cw + k * 768 + cc0 + 4); }
    const f32x4 b0 = *(const f32x4*)(cb + cc0), b1 = *(const f32x4*)(cb + cc0 + 4);
#pragma unroll
    for (int j = 0; j < 8; ++j) { float a[8] = {b0[0], b0[1], b0[2], b0[3], b1[0], b1[1], b1[2], b1[3]};
#pragma unroll
        for (int k = 0; k < 4; ++k) { const v4u xv = x[j + k];
            a[0] += w[k][0][0] * bflo(xv[0]); a[1] += w[k][0][1] * bfhi(xv[0]); a[2] += w[k][0][2] * bflo(xv[1]); a[3] += w[k][0][3] * bfhi(xv[1]);
            a[4] += w[k][1][0] * bflo(xv[2]); a[5] += w[k][1][1] * bfhi(xv[2]); a[6] += w[k][1][2] * bflo(xv[3]); a[7] += w[k][1][3] * bfhi(xv[3]); }
#pragma unroll
        for (int i = 0; i < 8; ++i) o[j][i] = a[i] * fsigm(a[i]); }
}
__device__ __forceinline__ void m2_dt_scan(const float* dtraw, const float* dt_bias, const float* a_log, int b, int t0, int g, LAS float* dt_s, LAS float* acs_s, LAS float* w_s, float* dec_out, int tid) {
    if (tid >= 384) { const int hh = (tid - 384) >> 6, t = tid & 63, h = 2 * g + hh;
        const float dtv = softplusf_(dtraw[((size_t)b * SEQ + t0 + t) * 4 + h] + dt_bias[h]);
        float v = dtv * (-expf(a_log[h]));
#pragma unroll
        for (int o = 1; o < 64; o <<= 1) { const float nb = __shfl_up(v, o); if (t >= o) v += nb; }
        const float last = __shfl(v, 63);
        dt_s[hh * 64 + t] = dtv; acs_s[hh * 64 + t] = v; w_s[hh * 64 + t] = expf(last - v) * dtv;
        if (dec_out && t == 63) dec_out[h] = expf(last); }
}
__device__ __forceinline__ void m2_state_unit(const bf16* proj, const float* dtraw, float* sloc, float* dec, int b, int ch, int g, const float* cw, const float* cb, const float* dt_bias, const float* a_log, LAS unsigned char* lds, int tid) {
    LAS bf16* XS = (LAS bf16*)lds; LAS bf16* BS = XS + 64 * M2LD; LAS float* dt_s = (LAS float*)(BS + 64 * M2LD); LAS float* acs_s = dt_s + 128; LAS float* w_s = acs_s + 128;
    const int lane = tid & 63, w = tid >> 6, t0 = ch * 64;
    m2_dt_scan(dtraw, dt_bias, a_log, b, t0, g, dt_s, acs_s, w_s, dec + (size_t)(b * 32 + ch) * 4, tid);
    float o[8][8]; const int cg = tid & 31, tq = tid >> 5;
    if (tid < 256) m2_conv_block(proj, cw, cb, b, t0, tq, cg < 16 ? g * 128 + 8 * cg : 256 + g * 128 + 8 * (cg - 16), o);
    __syncthreads();
    if (tid < 256) {
#pragma unroll
        for (int j = 0; j < 8; ++j) { const int t = 8 * tq + j; const float sc = cg < 16 ? w_s[(cg >> 3) * 64 + t] : 1.0f;
            v4u q; q.x = pk2(o[j][0] * sc, o[j][1] * sc); q.y = pk2(o[j][2] * sc, o[j][3] * sc); q.z = pk2(o[j][4] * sc, o[j][5] * sc); q.w = pk2(o[j][6] * sc, o[j][7] * sc);
            *(LAS v4u*)((cg < 16 ? XS + 8 * cg : BS + 8 * (cg - 16)) + t * M2LD) = q; } }
    __syncthreads();
    { const int hh = w >> 2, mi = w & 3;
        const bf16x8 a0 = frag_ks(XS, M2LD, hh * 64 + mi * 16, 0, lane), a1 = frag_ks(XS, M2LD, hh * 64 + mi * 16, 32, lane);
        float* outp = sloc + ((size_t)((b * 32 + ch) * 4 + 2 * g + hh) * 64 + mi * 16 + 4 * (lane >> 4)) * 128 + (lane & 15);
#pragma unroll
        for (int ni = 0; ni < 8; ++ni) { const bf16x8 b0 = frag_ks(BS, M2LD, ni * 16, 0, lane), b1 = frag_ks(BS, M2LD, ni * 16, 32, lane);
            f32x4 acc = {0.f, 0.f, 0.f, 0.f}; acc = MFMA16(a0, b0, acc); acc = MFMA16(a1, b1, acc);
#pragma unroll
            for (int i = 0; i < 4; ++i) outp[i * 128 + ni * 16] = acc[i]; } }
    __syncthreads();
}
__device__ __forceinline__ void m2_out_unit(const bf16* proj, const float* dtraw, const bf16* prevb, float* oraw, int b, int ch, int g, const float* cw, const float* cb, const float* dt_bias, const float* a_log, const float* dskip, LAS unsigned char* lds, int tid) {
    LAS bf16* XS = (LAS bf16*)lds; LAS bf16* BS = XS + 64 * M2LD; LAS bf16* CS = BS + 64 * M2LD; LAS bf16* WS = CS + 64 * M2LD;
    LAS float* dt_s = (LAS float*)(WS + 2 * 64 * M2WLD); LAS float* acs_s = dt_s + 128; LAS float* w_s = acs_s + 128;
    const int lane = tid & 63, w = tid >> 6, t0 = ch * 64;
    bf16x8 pf[4][4];
    { const bf16* pv = prevb + (size_t)((b * 32 + ch) * 4 + 2 * g + (w >> 2)) * 64 * 128;
#pragma unroll
        for (int kk = 0; kk < 4; ++kk)
#pragma unroll
            for (int ni = 0; ni < 4; ++ni) pf[kk][ni] = *(const bf16x8*)(pv + (size_t)(ni * 16 + (lane & 15)) * 128 + 32 * kk + 8 * (lane >> 4)); }
    m2_dt_scan(dtraw, dt_bias, a_log, b, t0, g, dt_s, acs_s, w_s, nullptr, tid);
    if (tid < 384) { float o[8][8]; const int cg = tid % 48, tq = tid / 48;
        const int cc0 = cg < 16 ? g * 128 + 8 * cg : cg < 32 ? 256 + g * 128 + 8 * (cg - 16) : 512 + g * 128 + 8 * (cg - 32);
        m2_conv_block(proj, cw, cb, b, t0, tq, cc0, o);
        LAS bf16* dst = cg < 16 ? XS + 8 * cg : cg < 32 ? BS + 8 * (cg - 16) : CS + 8 * (cg - 32);
#pragma unroll
        for (int j = 0; j < 8; ++j) { v4u q; q.x = pk2(o[j][0], o[j][1]); q.y = pk2(o[j][2], o[j][3]); q.z = pk2(o[j][4], o[j][5]); q.w = pk2(o[j][6], o[j][7]); *(LAS v4u*)(dst + (8 * tq + j) * M2LD) = q; } }
    __syncthreads();
    { const int mi = w >> 1, ni0 = (w & 1) * 2;
        f32x4 acc[2] = {{0.f, 0.f, 0.f, 0.f}, {0.f, 0.f, 0.f, 0.f}};
#pragma unroll
        for (int kk = 0; kk < 4; ++kk) { const bf16x8 a = frag_kc(CS, M2LD, mi * 16, 32 * kk, lane);
#pragma unroll
            for (int q = 0; q < 2; ++q) { const bf16x8 bb = frag_kc(BS, M2LD, (ni0 + q) * 16, 32 * kk, lane); acc[q] = MFMA16(a, bb, acc[q]); } }
#pragma unroll
        for (int q = 0; q < 2; ++q) { const int s = (ni0 + q) * 16 + (lane & 15);
#pragma unroll
            for (int hh = 0; hh < 2; ++hh) { const float as = acs_s[hh * 64 + s], ds = dt_s[hh * 64 + s];
#pragma unroll
                for (int i = 0; i < 4; ++i) { const int l = mi * 16 + 4 * (lane >> 4) + i;
                    const float v = (s <= l) ? acc[q][i] * fexp(acs_s[hh * 64 + l] - as) * ds : 0.f;
                    WS[(hh * 64 + l) * M2WLD + s] = (bf16)f2bf(v); } } } }
    __syncthreads();
    { const int hh = w >> 2, mi = w & 3, h = 2 * g + hh;
        f32x4 yd[4], yo[4];
#pragma unroll
        for (int ni = 0; ni < 4; ++ni) { yd[ni] = (f32x4){0.f, 0.f, 0.f, 0.f}; yo[ni] = (f32x4){0.f, 0.f, 0.f, 0.f}; }
#pragma unroll
        for (int kk = 0; kk < 2; ++kk) { const bf16x8 a = frag_kc(WS + hh * 64 * M2WLD, M2WLD, mi * 16, 32 * kk, lane);
#pragma unroll
            for (int ni = 0; ni < 4; ++ni) { const bf16x8 bb = frag_ks(XS, M2LD, hh * 64 + ni * 16, 32 * kk, lane); yd[ni] = MFMA16(a, bb, yd[ni]); } }
#pragma unroll
        for (int kk = 0; kk < 4; ++kk) { const bf16x8 a = frag_kc(CS, M2LD, mi * 16, 32 * kk, lane);
#pragma unroll
            for (int ni = 0; ni < 4; ++ni) yo[ni] = MFMA16(a, pf[kk][ni], yo[ni]); }
        const float Dh = dskip[h];
#pragma unroll
        for (int i = 0; i < 4; ++i) { const int l = mi * 16 + 4 * (lane >> 4) + i; const float ea = fexp(acs_s[hh * 64 + l]); const size_t row = (size_t)b * SEQ + t0 + l;
#pragma unroll
            for (int ni = 0; ni < 4; ++ni) { const int p = ni * 16 + (lane & 15);
                const float xv = bf2f(XS[l * M2LD + hh * 64 + p]), zv = bf2f(proj[row * DING + C_M2Z + h * 64 + p]);
                const float y = yd[ni][i] + ea * yo[ni][i] + xv * Dh;
                oraw[row * DM + 768 + h * 64 + p] = y * (zv * fsigm(zv)); } } }
    __syncthreads();
}

constexpr int HGLD = 136, HGWLD = 72;
template <bool WITH_Q>
__device__ __forceinline__ void hg_prep(const bf16* proj, int b, int t0, int hp, const float* lb1, int layer, LAS float* bc_s, LAS bf16* QS, LAS bf16* KS, LAS bf16* VS, LAS bf16* Q2, int tid) {
    const int c0 = (tid & 15) * 8, ta = tid >> 4;
    float lb[8];
#pragma unroll
    for (int i = 0; i < 8; ++i) lb[i] = 0.f;
    if (layer == 1) { const f32x4 l0 = *(const f32x4*)(lb1 + hp * 128 + c0), l1 = *(const f32x4*)(lb1 + hp * 128 + c0 + 4); lb[0] = l0[0]; lb[1] = l0[1]; lb[2] = l0[2]; lb[3] = l0[3]; lb[4] = l1[0]; lb[5] = l1[1]; lb[6] = l1[2]; lb[7] = l1[3]; }
    v4u fw[2], iw[2], qw[2];
#pragma unroll
    for (int u = 0; u < 2; ++u) { const size_t row = (size_t)b * SEQ + t0 + ta + 32 * u;
        fw[u] = *(const v4u*)(proj + row * DING + C_HGF + hp * 128 + c0); iw[u] = *(const v4u*)(proj + row * DING + C_HGI + hp * 128 + c0);
        if (WITH_Q) qw[u] = *(const v4u*)(proj + row * DING + C_HGQ + hp * 128 + c0); }
    float key[2][8];
#pragma unroll
    for (int u = 0; u < 2; ++u) { const int t = ta + 32 * u;
        const float f[8] = {bflo(fw[u][0]), bfhi(fw[u][0]), bflo(fw[u][1]), bfhi(fw[u][1]), bflo(fw[u][2]), bfhi(fw[u][2]), bflo(fw[u][3]), bfhi(fw[u][3])};
        float lf[8];
#pragma unroll
        for (int i = 0; i < 8; ++i) { const float sg = fsigm(f[i]); lf[i] = __builtin_amdgcn_logf(lb[i] + (1.0f - lb[i]) * sg) * 0.6931471805599453f; key[u][i] = (1.0f - lb[i]) * (1.0f - sg); }
        *(LAS f32x4*)(bc_s + t * 128 + c0) = (f32x4){lf[0], lf[1], lf[2], lf[3]}; *(LAS f32x4*)(bc_s + t * 128 + c0 + 4) = (f32x4){lf[4], lf[5], lf[6], lf[7]};
        *(LAS v4u*)(VS + t * HGLD + c0) = iw[u]; }
    __syncthreads();
    if (tid < 128) { float run = 0.f;
#pragma unroll 8
        for (int t = 0; t < 64; ++t) { run += bc_s[t * 128 + tid]; bc_s[t * 128 + tid] = run; } }
    __syncthreads();
    const f32x4 m0 = *(const LAS f32x4*)(bc_s + 31 * 128 + c0), m1 = *(const LAS f32x4*)(bc_s + 31 * 128 + c0 + 4);
    const float b31[8] = {m0[0], m0[1], m0[2], m0[3], m1[0], m1[1], m1[2], m1[3]};
#pragma unroll
    for (int u = 0; u < 2; ++u) { const int t = ta + 32 * u;
        const f32x4 x0 = *(const LAS f32x4*)(bc_s + t * 128 + c0), x1 = *(const LAS f32x4*)(bc_s + t * 128 + c0 + 4);
        const float bc[8] = {x0[0], x0[1], x0[2], x0[3], x1[0], x1[1], x1[2], x1[3]};
        float kk[8], qq[8], q2[8];
#pragma unroll
        for (int i = 0; i < 8; ++i) { const float d = b31[i] - bc[i]; kk[i] = key[u][i] * fexp(fminf(d, 60.0f));
            if (WITH_Q) { const float qv = (i & 1) ? bfhi(qw[u][i >> 1]) : bflo(qw[u][i >> 1]); const float qs = qv * fsigm(qv); qq[i] = qs * fexp(fminf(-d, 60.0f)); q2[i] = qs * fexp(bc[i]); } }
        v4u o; o.x = pk2(kk[0], kk[1]); o.y = pk2(kk[2], kk[3]); o.z = pk2(kk[4], kk[5]); o.w = pk2(kk[6], kk[7]); *(LAS v4u*)(KS + t * HGLD + c0) = o;
        if (WITH_Q) { o.x = pk2(qq[0], qq[1]); o.y = pk2(qq[2], qq[3]); o.z = pk2(qq[4], qq[5]); o.w = pk2(qq[6], qq[7]); *(LAS v4u*)(QS + t * HGLD + c0) = o;
            o.x = pk2(q2[0], q2[1]); o.y = pk2(q2[2], q2[3]); o.z = pk2(q2[4], q2[5]); o.w = pk2(q2[6], q2[7]); *(LAS v4u*)(Q2 + t * HGLD + c0) = o; } }
    __syncthreads();
}
__device__ __forceinline__ void hg_state_unit(const bf16* proj, float* slt, float* decc, int b, int ch, int hp, const float* lbp, int layer, LAS unsigned char* lds, int tid) {
    LAS float* bc_s = (LAS float*)lds; LAS bf16* KS = (LAS bf16*)(lds + 32768); LAS bf16* VS = KS + 64 * HGLD;
    const int lane = tid & 63, w = tid >> 6;
    hg_prep<false>(proj, b, ch * 64, hp, lbp, layer, bc_s, nullptr, KS, VS, nullptr, tid);
    if (tid < 128) decc[(size_t)((b * 32 + ch) * 4 + 2 * hp) * 64 + tid] = fexp(bc_s[63 * 128 + tid]);
    { const int hh = w >> 2, mi = w & 3, h = 2 * hp + hh;
        const bf16x8 a0 = frag_ks(VS, HGLD, hh * 64 + mi * 16, 0, lane), a1 = frag_ks(VS, HGLD, hh * 64 + mi * 16, 32, lane);
        float* outp = slt + ((size_t)((b * 32 + ch) * 4 + h) * 64 + mi * 16 + 4 * (lane >> 4)) * 64 + (lane & 15);
#pragma unroll
        for (int ni = 0; ni < 4; ++ni) { const bf16x8 b0 = frag_ks(KS, HGLD, hh * 64 + ni * 16, 0, lane), b1 = frag_ks(KS, HGLD, hh * 64 + ni * 16, 32, lane);
            f32x4 acc = {0.f, 0.f, 0.f, 0.f}; acc = MFMA16(a0, b0, acc); acc = MFMA16(a1, b1, acc);
            const int c = hh * 64 + ni * 16 + (lane & 15); const float sc = fexp(bc_s[63 * 128 + c] - bc_s[31 * 128 + c]);
#pragma unroll
            for (int i = 0; i < 4; ++i) outp[i * 64 + ni * 16] = acc[i] * sc; } }
    __syncthreads();
}
__device__ __forceinline__ void hg_out_unit(const bf16* proj, const bf16* stb, float* oraw, int b, int ch, int hp, const float* lbp, int layer, LAS unsigned char* lds, int tid) {
    LAS float* bc_s = (LAS float*)lds; LAS bf16* KS = (LAS bf16*)(lds + 32768); LAS bf16* VS = KS + 64 * HGLD; LAS bf16* QS = VS + 64 * HGLD; LAS bf16* WS = QS + 64 * HGLD; LAS bf16* Q2 = WS + 2 * 64 * HGWLD;
    const int lane = tid & 63, w = tid >> 6, t0 = ch * 64;
    const int hh = w >> 2, mi = w & 3, h = 2 * hp + hh;
    bf16x8 sf[2][4];
    { const bf16* st = stb + (size_t)((b * 32 + ch) * 4 + h) * 64 * 64;
#pragma unroll
        for (int kk = 0; kk < 2; ++kk)
#pragma unroll
            for (int ni = 0; ni < 4; ++ni) sf[kk][ni] = *(const bf16x8*)(st + (size_t)(ni * 16 + (lane & 15)) * 64 + 32 * kk + 8 * (lane >> 4)); }
    hg_prep<true>(proj, b, t0, hp, lbp, layer, bc_s, QS, KS, VS, Q2, tid);
    { f32x4 sc[4];
#pragma unroll
        for (int ni = 0; ni < 4; ++ni) sc[ni] = (f32x4){0.f, 0.f, 0.f, 0.f};
#pragma unroll
        for (int kk = 0; kk < 2; ++kk) { const bf16x8 a = frag_kc(QS, HGLD, mi * 16, hh * 64 + 32 * kk, lane);
#pragma unroll
            for (int ni = 0; ni < 4; ++ni) { const bf16x8 bb = frag_kc(KS, HGLD, ni * 16, hh * 64 + 32 * kk, lane); sc[ni] = MFMA16(a, bb, sc[ni]); } }
#pragma unroll
        for (int ni = 0; ni < 4; ++ni) { const int s = ni * 16 + (lane & 15);
#pragma unroll
            for (int i = 0; i < 4; ++i) { const int t = mi * 16 + 4 * (lane >> 4) + i; WS[(hh * 64 + t) * HGWLD + s] = (bf16)f2bf(s <= t ? sc[ni][i] : 0.f); } } }
    __syncthreads();
    { f32x4 o[4];
#pragma unroll
        for (int ni = 0; ni < 4; ++ni) o[ni] = (f32x4){0.f, 0.f, 0.f, 0.f};
#pragma unroll
        for (int kk = 0; kk < 2; ++kk) { const bf16x8 a = frag_kc(WS + hh * 64 * HGWLD, HGWLD, mi * 16, 32 * kk, lane);
#pragma unroll
            for (int ni = 0; ni < 4; ++ni) { const bf16x8 bb = frag_ks(VS, HGLD, hh * 64 + ni * 16, 32 * kk, lane); o[ni] = MFMA16(a, bb, o[ni]); } }
#pragma unroll
        for (int kk = 0; kk < 2; ++kk) { const bf16x8 a = frag_kc(Q2, HGLD, mi * 16, hh * 64 + 32 * kk, lane);
#pragma unroll
            for (int ni = 0; ni < 4; ++ni) o[ni] = MFMA16(a, sf[kk][ni], o[ni]); }
#pragma unroll
        for (int i = 0; i < 4; ++i) { const size_t row = (size_t)b * SEQ + t0 + mi * 16 + 4 * (lane >> 4) + i;
#pragma unroll
            for (int ni = 0; ni < 4; ++ni) oraw[row * DM + 512 + h * 64 + ni * 16 + (lane & 15)] = o[ni][i]; } }
    __syncthreads();
}

constexpr int RGLD = 136;
__device__ __forceinline__ void rg_local_unit(const bf16* proj, float* hloc, float* pcum, float* rgs, int b, int ch, int half, const float* conv_w, const float* conv_b, const bf16* waT, const bf16* wxT,
                                              const float* ba, const float* bx, const float* lam, LAS unsigned char* lds, int tid) {
    LAS float* xc32 = (LAS float*)lds; LAS float* a_s = xc32 + 64 * 128; LAS bf16* xcb = (LAS bf16*)(a_s + 64 * 128); LAS float* par = (LAS float*)(xcb + 64 * RGLD);
    const int lane = tid & 63, w = tid >> 6, t0 = ch * 64, cg0 = half * 128;
    if (tid < 128) { par[tid] = ba[cg0 + tid]; par[128 + tid] = bx[cg0 + tid]; par[256 + tid] = softplusf_(-lam[cg0 + tid]); }
    { const int c0 = (tid & 15) * 8, cg = cg0 + c0, tp = tid >> 4;
        v4u x[5]; f32x4 wk[4][2];
#pragma unroll
        for (int r = 0; r < 5; ++r) { const int ts = t0 + 2 * tp - 3 + r; x[r] = (v4u){0u, 0u, 0u, 0u}; if (ts >= 0) x[r] = *(const v4u*)(proj + ((size_t)b * SEQ + ts) * DING + C_RGX + cg); }
#pragma unroll
        for (int k = 0; k < 4; ++k) { wk[k][0] = *(const f32x4*)(conv_w + k * 256 + cg); wk[k][1] = *(const f32x4*)(conv_w + k * 256 + cg + 4); }
        const f32x4 b0 = *(const f32x4*)(conv_b + cg), b1 = *(const f32x4*)(conv_b + cg + 4);
#pragma unroll
        for (int j = 0; j < 2; ++j) { const int t = 2 * tp + j; float o[8] = {b0[0], b0[1], b0[2], b0[3], b1[0], b1[1], b1[2], b1[3]};
#pragma unroll
            for (int k = 0; k < 4; ++k) { const v4u xv = x[j + k];
                o[0] += wk[k][0][0] * bflo(xv[0]); o[1] += wk[k][0][1] * bfhi(xv[0]); o[2] += wk[k][0][2] * bflo(xv[1]); o[3] += wk[k][0][3] * bfhi(xv[1]);
                o[4] += wk[k][1][0] * bflo(xv[2]); o[5] += wk[k][1][1] * bfhi(xv[2]); o[6] += wk[k][1][2] * bflo(xv[3]); o[7] += wk[k][1][3] * bfhi(xv[3]); }
            *(LAS f32x4*)(xc32 + t * 128 + c0) = (f32x4){o[0], o[1], o[2], o[3]}; *(LAS f32x4*)(xc32 + t * 128 + c0 + 4) = (f32x4){o[4], o[5], o[6], o[7]};
            v4u q; q.x = pk2(o[0], o[1]); q.y = pk2(o[2], o[3]); q.z = pk2(o[4], o[5]); q.w = pk2(o[6], o[7]); *(LAS v4u*)(xcb + t * RGLD + c0) = q; } }
    __syncthreads();
    { const int nb = w >> 2, mi = w & 3, n = 2 * half + nb;
        f32x4 ra[4], ga[4];
#pragma unroll
        for (int ni = 0; ni < 4; ++ni) { ra[ni] = (f32x4){0.f, 0.f, 0.f, 0.f}; ga[ni] = (f32x4){0.f, 0.f, 0.f, 0.f}; }
#pragma unroll
        for (int kk = 0; kk < 2; ++kk) { const bf16x8 a = frag_kc(xcb, RGLD, mi * 16, nb * 64 + 32 * kk, lane);
#pragma unroll
            for (int ni = 0; ni < 4; ++ni) { const size_t off = (size_t)(n * 64 + ni * 16 + (lane & 15)) * 64 + 32 * kk + 8 * (lane >> 4);
                ra[ni] = MFMA16(a, *(const bf16x8*)(waT + off), ra[ni]); ga[ni] = MFMA16(a, *(const bf16x8*)(wxT + off), ga[ni]); } }
#pragma unroll
        for (int ni = 0; ni < 4; ++ni) { const int c = nb * 64 + ni * 16 + (lane & 15); const float bav = par[c], bxv = par[128 + c], spl = par[256 + c];
#pragma unroll
            for (int i = 0; i < 4; ++i) { const int t = mi * 16 + 4 * (lane >> 4) + i;
                const float r = fsigm(ra[ni][i] + bav), ig = fsigm(ga[ni][i] + bxv), log_a = -8.0f * r * spl, x2 = 2.0f * log_a;
                const float em1 = x2 > -0.25f ? -x2 * (1.0f + x2 * (0.5f + x2 * (0.16666667f + x2 * (0.041666668f + x2 * 0.0083333338f)))) : 1.0f - fexp(x2);
                float mult = __builtin_amdgcn_sqrtf(em1); if (t0 + t == 0) mult = 1.0f;
                a_s[t * 128 + c] = fexp(log_a); xc32[t * 128 + c] = mult * ig * xc32[t * 128 + c]; } } }
    __syncthreads();
    if (tid < 128) { float h = 0.f, P = 1.f; const size_t base = ((size_t)b * SEQ + t0) * 256 + cg0 + tid;
#pragma unroll 8
        for (int t = 0; t < 64; ++t) { const float a = a_s[t * 128 + tid]; h = a * h + xc32[t * 128 + tid]; P *= a; hloc[base + (size_t)t * 256] = h; pcum[base + (size_t)t * 256] = P; }
        rgs[((size_t)(b * 32 + ch) * 256 + cg0 + tid) * 2] = P; rgs[((size_t)(b * 32 + ch) * 256 + cg0 + tid) * 2 + 1] = h; }
    __syncthreads();
}

typedef float f32x16 __attribute__((ext_vector_type(16)));
#define MFMA32(a, b, c) __builtin_amdgcn_mfma_f32_32x32x16_bf16((a), (b), (c), 0, 0, 0)
constexpr int AVLD = 72;
__device__ __forceinline__ bf16x8 pack8(const f32x16& x, int o) {
    v4u w; w.x = pg8::cvt_pk_bf16(x[o], x[o + 1]); w.y = pg8::cvt_pk_bf16(x[o + 2], x[o + 3]); w.z = pg8::cvt_pk_bf16(x[o + 4], x[o + 5]); w.w = pg8::cvt_pk_bf16(x[o + 6], x[o + 7]);
    return __builtin_bit_cast(bf16x8, w);
}
__device__ __forceinline__ float lk2(float z) { return -(fmaxf(z, 0.f) + __builtin_amdgcn_logf(1.0f + __builtin_amdgcn_exp2f(-fabsf(z)))); }
__device__ __forceinline__ void attn_unit(const bf16* proj, float* oraw, int b, int h, int qb, LAS bf16* VL, int lane) {
    const int q = lane & 31, h2 = lane >> 5, qw = qb * 32; const size_t rowb = (size_t)b * SEQ;
    bf16x8 qf[4];
    { const bf16* qp = proj + (rowb + qw + q) * DING + C_SBQ + h * 64 + 8 * h2; const float C2 = 0.125f * 1.4426950408889634f;
#pragma unroll
        for (int kk = 0; kk < 4; ++kk) { const v4u w = *(const v4u*)(qp + 16 * kk); v4u o;
            o.x = pg8::cvt_pk_bf16(bflo(w.x) * C2, bfhi(w.x) * C2); o.y = pg8::cvt_pk_bf16(bflo(w.y) * C2, bfhi(w.y) * C2); o.z = pg8::cvt_pk_bf16(bflo(w.z) * C2, bfhi(w.z) * C2); o.w = pg8::cvt_pk_bf16(bflo(w.w) * C2, bfhi(w.w) * C2);
            qf[kk] = __builtin_bit_cast(bf16x8, o); } }
    bf16x8 m0[2], ones;
#pragma unroll
    for (int s = 0; s < 2; ++s) {
#pragma unroll
        for (int jj = 0; jj < 8; ++jj) { const int j = 16 * s + 8 * (jj >> 2) + 4 * h2 + (jj & 3); m0[s][jj] = (short)(j >= q ? 0x3F80 : 0); } }
#pragma unroll
    for (int jj = 0; jj < 8; ++jj) ones[jj] = (short)0x3F80;
    f32x16 o0, o1;
#pragma unroll
    for (int r = 0; r < 16; ++r) { o0[r] = 0.f; o1[r] = 0.f; }
    float R = 0.f;
    const int sd = (qw >> 6) << 6;
    bf16x8 kf[2][4];
    { const bf16* kp = proj + (rowb + sd + q) * DING + C_SBK + h * 64 + 8 * h2;
#pragma unroll
        for (int hf = 0; hf < 2; ++hf)
#pragma unroll
            for (int kk = 0; kk < 4; ++kk) kf[hf][kk] = *(const bf16x8*)(kp + (size_t)hf * 32 * DING + 16 * kk); }
    for (int s0 = sd; s0 >= 0; s0 -= 64) {
        bf16x8 kn[2][4];
        { const int sn = s0 >= 64 ? s0 - 64 : s0; const bf16* kp = proj + (rowb + sn + q) * DING + C_SBK + h * 64 + 8 * h2;
#pragma unroll
            for (int hf = 0; hf < 2; ++hf)
#pragma unroll
                for (int kk = 0; kk < 4; ++kk) kn[hf][kk] = *(const bf16x8*)(kp + (size_t)hf * 32 * DING + 16 * kk); }
#pragma unroll
        for (int i = 0; i < 8; ++i) { const int row = (lane >> 3) + 8 * i; const v4u w = *(const v4u*)(proj + (rowb + s0 + row) * DING + C_SBV + h * 64 + 8 * (lane & 7)); *(LAS v4u*)(VL + row * AVLD + 8 * (lane & 7)) = w; }
        f32x16 z0, z1;
#pragma unroll
        for (int r = 0; r < 16; ++r) { z0[r] = 0.f; z1[r] = 0.f; }
#pragma unroll
        for (int kk = 0; kk < 4; ++kk) { z0 = MFMA32(kf[0][kk], qf[kk], z0); z1 = MFMA32(kf[1][kk], qf[kk], z1); }
        const int lim = (s0 == sd) ? (qw - sd) + q : 64;
        f32x16 l0, l1;
#pragma unroll
        for (int r = 0; r < 16; ++r) { const int key = (r & 3) + 8 * (r >> 2) + 4 * h2; l0[r] = key < lim ? lk2(z0[r]) : 0.f; l1[r] = key + 32 < lim ? lk2(z1[r]) : 0.f; }
        const bf16x8 bl0 = pack8(l0, 0), bl1 = pack8(l0, 8), bh0 = pack8(l1, 0), bh1 = pack8(l1, 8);
        f32x16 i0 = z0, i1 = z1;
        i0 = MFMA32(m0[0], bl0, i0); i0 = MFMA32(m0[1], bl1, i0); i0 = MFMA32(ones, bh0, i0); i0 = MFMA32(ones, bh1, i0);
        i1 = MFMA32(m0[0], bh0, i1); i1 = MFMA32(m0[1], bh1, i1);
        float tot = h2 == 0 ? i0[0] - z0[0] : 0.f; tot += __shfl_xor(tot, 32);
#pragma unroll
        for (int r = 0; r < 16; ++r) { const int key = (r & 3) + 8 * (r >> 2) + 4 * h2; l0[r] = key < lim ? __builtin_amdgcn_exp2f(i0[r] + R) : 0.f; l1[r] = key + 32 < lim ? __builtin_amdgcn_exp2f(i1[r] + R) : 0.f; }
        R += tot;
        const bf16x8 pa0 = pack8(l0, 0), pa1 = pack8(l0, 8), pa2 = pack8(l1, 0), pa3 = pack8(l1, 8);
        const LAS bf16* vb = VL + (4 * h2 + ((lane & 15) >> 2)) * AVLD + 16 * ((lane >> 4) & 1) + 4 * (lane & 3);
#define VFRAG(kb, db) ({ const s16x4 lo_ = __builtin_bit_cast(s16x4, __builtin_amdgcn_ds_read_tr16_b64_v4i16((LAS v4i16_t*)(vb + (kb) * AVLD + (db) * 32))); \
                         const s16x4 hi_ = __builtin_bit_cast(s16x4, __builtin_amdgcn_ds_read_tr16_b64_v4i16((LAS v4i16_t*)(vb + ((kb) + 8) * AVLD + (db) * 32))); \
                         (bf16x8){lo_[0], lo_[1], lo_[2], lo_[3], hi_[0], hi_[1], hi_[2], hi_[3]}; })
        o0 = MFMA32(pa0, VFRAG(0, 0), o0); o1 = MFMA32(pa0, VFRAG(0, 1), o1);
        o0 = MFMA32(pa1, VFRAG(16, 0), o0); o1 = MFMA32(pa1, VFRAG(16, 1), o1);
        o0 = MFMA32(pa2, VFRAG(32, 0), o0); o1 = MFMA32(pa2, VFRAG(32, 1), o1);
        o0 = MFMA32(pa3, VFRAG(48, 0), o0); o1 = MFMA32(pa3, VFRAG(48, 1), o1);
#undef VFRAG
#pragma unroll
        for (int hf = 0; hf < 2; ++hf)
#pragma unroll
            for (int kk = 0; kk < 4; ++kk) kf[hf][kk] = kn[hf][kk];
        if (__all(R < -127.0f)) break;
    }
    float* op = oraw + (rowb + qw) * DM + h * 64 + q;
#pragma unroll
    for (int r = 0; r < 16; ++r) { const int qq = (r & 3) + 8 * (r >> 2) + 4 * h2; op[(size_t)qq * DM] = o0[r]; op[(size_t)qq * DM + 32] = o1[r]; }
}


constexpr int NPL = 11, NPHASE = 1 + NPL * DEPTH;
struct Args { const float* in[29]; float* out; unsigned char* ws; int ph_lo, ph_hi, use_bar, pad; };

typedef const __attribute__((address_space(4))) Args* KArgP;
__device__ __forceinline__ KArgP kargs() { KArgP p = (KArgP)__builtin_amdgcn_kernarg_segment_ptr(); asm volatile("" : "+s"(p)); return p; }
#define WSP(type, off) ((type*)(kargs()->ws + (off)))
#define INP(i) (kargs()->in[i])

constexpr int CV_MOE = NE * IT_GU + NE * IT_DN;
constexpr int CV_TAILQ = 5, CV_TAILW = (256 - 64) * NWAVES;
constexpr int CV_TAIL = CV_TAILQ * CV_TAILW;
constexpr int CV_SMALL = NIT_WIN + NIT_WOUT;
constexpr int CV_GQ = 6, CV_HQ = 5;
constexpr int CV_P0_ITEMS = CV_SMALL + (CV_MOE - CV_TAIL);
constexpr float F8_WGU_SCALE = 32.0f, F8_WDN_SCALE = 64.0f;
__device__ __forceinline__ TDesc cv_moe(int l, int r) { TDesc d;
    if (r < NE * IT_GU) { const int le = l * NE + r / IT_GU, q = r % IT_GU; d.W = INP(24) + (size_t)le * DM * 2048; d.ldw = 2048; d.WT = (bf16*)(WSP(unsigned char, WS_WGU) + (size_t)le * 2048 * DM); d.K = DM; d.k0 = 64 * (q / 32); d.n0 = 64 * (q % 32); d.gu = 1; d.f8s = F8_WGU_SCALE; return d; }
    r -= NE * IT_GU;
    { const int le = l * NE + r / IT_DN, q = r % IT_DN; d.W = INP(26) + (size_t)le * DFF * DM; d.ldw = DM; d.WT = (bf16*)(WSP(unsigned char, WS_WDN) + (size_t)le * DM * DFF); d.K = DFF; d.k0 = 64 * (q / 16); d.n0 = 64 * (q % 16); d.gu = 0; d.f8s = F8_WDN_SCALE; return d; } }
__device__ __forceinline__ TDesc cv_p0(int r) { TDesc d;
    if (r < NIT_WIN) { const int l = r / IT_WIN, q = r % IT_WIN; d.W = INP(2) + (size_t)l * DM * DIN; d.ldw = DIN; d.WT = WSP(bf16, WS_WIN) + (size_t)l * DING * DM; d.K = DM; d.k0 = 64 * (q / 52); d.n0 = 64 * (q % 52); d.gu = 0; d.f8s = 0.f; return d; }
    r -= NIT_WIN;
    if (r < NIT_WOUT) { const int l = r / IT_WOUT, q = r % IT_WOUT; d.W = INP(20) + (size_t)l * DM * DM; d.ldw = DM; d.WT = WSP(bf16, WS_WOUT) + (size_t)l * DM * DM; d.K = DM; d.k0 = 64 * (q / 16); d.n0 = 64 * (q % 16); d.gu = 0; d.f8s = 0.f; return d; }
    r -= NIT_WOUT;
    return cv_moe(0, CV_TAIL + r); }
__device__ __forceinline__ void convert_items(int n, int first, int stride, int tail_layer_p1, LAS float* scr, int lane) {
    int it = first; TDesc dc, dn; f32x4 va[16], vb[16];
    if (it < n) { dc = tail_layer_p1 ? cv_moe(tail_layer_p1 - 1, it) : cv_p0(it); tload(dc, va, lane); }
    while (it < n) { const int nx = it + stride; const bool hn = nx < n;
        if (hn) { dn = tail_layer_p1 ? cv_moe(tail_layer_p1 - 1, nx) : cv_p0(nx); tload(dn, vb, lane); }
        tstore(dc, va, scr, lane);
        if (hn) { dc = dn;
#pragma unroll
            for (int i = 0; i < 16; ++i) va[i] = vb[i]; }
        it = nx; }
}

__global__ void __launch_bounds__(NTHR, 2) fwd_kernel(Args args_unused) {
    extern __shared__ __attribute__((aligned(16))) unsigned char lds_raw[];
    LAS unsigned char* lds = (LAS unsigned char*)lds_raw;
    LAS float* ldsf = (LAS float*)lds_raw;
    volatile LAS unsigned* MISC = (volatile LAS unsigned*)(lds + MISC_OFF);
    LAS int* tb = (LAS int*)(lds + TB_OFF);
    const int tid0 = threadIdx.x;
#define PH_IDS int tid = threadIdx.x; asm volatile("" : "+v"(tid)); const int lane = tid & 63, wave = __builtin_amdgcn_readfirstlane(tid >> 6); const int gw = vcu * NWAVES + wave; (void)lane; (void)gw;
    const int G = gridDim.x, bx = blockIdx.x;
    const int vcu = (G % 8 == 0) ? (bx % 8) * (G / 8) + bx / 8 : bx;
    const int NGW = G * NWAVES;
    gu32* ctl = (gu32*)WSP(unsigned char, WS_CTL);

    for (int u = tid0; u < (LDS_BYTES - LDSCTL_OFF) / 4; u += NTHR) ((LAS unsigned*)(lds + LDSCTL_OFF))[u] = 0u;
    __syncthreads();
    XcdBarrier bar; bar.bar = (unsigned*)(ctl + CW_BAR); bar.x = 0; bar.st = nullptr;
    if (kargs()->use_bar) bar = xcd_barrier_post((unsigned*)(ctl + CW_BAR), MISC + 8);
    const int lo = kargs()->ph_lo, hi = kargs()->ph_hi;
#ifndef PH_MASK
#define PH_MASK 0xfff
#endif
#ifndef REP_MASK
#define REP_MASK 0
#endif
#define IN(k) (lo <= (k) && (k) < hi)
#define EN(ty) ((PH_MASK >> (ty)) & 1)
#define REPS(ty) (1 + ((REP_MASK >> (ty)) & 1))
#ifndef REP2_MASK
#define REP2_MASK 0
#endif
#define SUB(bit) _Pragma("unroll 1") for (int rep2_ = 0; rep2_ < 1 + ((REP2_MASK >> (bit)) & 1); ++rep2_)
#define SEAM(k) do { if (IN(k) && IN((k) + 1)) xcd_barrier(bar); } while (0)
#define PHASE(ty, k) if (EN(ty) && IN(k)) _Pragma("unroll 1") for (int rep_ = 0; rep_ < REPS(ty); ++rep_)

    PHASE(11, 0) { PH_IDS
        LAS float* scr = ldsf + wave * (64 * 65);
        convert_items(CV_P0_ITEMS, gw, NGW, 0, scr, lane);
        for (int idx = gw * 64 + lane; idx < DEPTH * 4 * 4096; idx += NGW * 64) { const int i = idx & 63, j = (idx >> 6) & 63, ln = idx >> 12;
            WSP(bf16, WS_WAT)[idx] = (bf16)f2bf(INP(6)[(size_t)ln * 4096 + i * 64 + j]); WSP(bf16, WS_WAT + 512 * 1024)[idx] = (bf16)f2bf(INP(8)[(size_t)ln * 4096 + i * 64 + j]); }
        for (int idx = gw * 64 + lane; idx < DEPTH * NE * DM; idx += NGW * 64) { const int k = idx & 1023, e = (idx >> 10) & 31, ll = idx >> 15;
            const float w = INP(21)[ll * DM + k] * INP(22)[((size_t)ll * DM + k) * NE + e]; const unsigned hi = f2bf(w); const float lo = w - __uint_as_float(hi << 16);
            bf16* dst = WSP(bf16, WS_RWB) + (size_t)ll * 2 * NE * DM + e * DM + k; dst[0] = (bf16)hi; dst[NE * DM] = (bf16)f2bf(lo); }
        if (gw == 0) for (int c = lane; c < 256; c += 64) { const float x0 = INP(12)[c], x1 = INP(12)[256 + c], mx = fmaxf(x0, x1), e0 = expf(x0 - mx), e1 = expf(x1 - mx); WSP(float, WS_LB1)[c] = e1 / (e0 + e1); }
        for (int m = gw; m < T; m += NGW) { f32x4 v[4];
#pragma unroll
            for (int j = 0; j < 4; ++j) v[j] = *(const f32x4*)(INP(0) + (size_t)m * DM + 256 * j + 4 * lane);
            emit_xn_dt(v, INP(1), INP(2), WSP(bf16, WS_XN) + (size_t)m * DM, WSP(float, WS_DT) + (size_t)m * 4, lane); }
    }
    SEAM(0);

#pragma unroll 1
    for (int l = 0; l < DEPTH; ++l) {
        const int P = 1 + NPL * l;
        PHASE(0, P) { PH_IDS
            pg8::Gemm g{WSP(bf16, WS_XN), WSP(bf16, WS_WIN) + (size_t)l * DING * DM, T, DING, DM}; pg8::StaticOrder S; S.init(T, DING, G, bx);
            pg8::EpiBf16 E{WSP(bf16, WS_PROJ), DING, nullptr, 0};
            pg8::gemm_phase<pg8::EpiBf16, pg8::StaticOrder, true, true>(lds, g, S, E);
            if (G == 256 && bx >= 64) convert_items(CV_TAIL, (bx - 64) * NWAVES + wave, CV_TAILW, l + 1, ldsf + wave * (64 * 65), lane);
            else if (G != 256) convert_items(CV_TAIL, gw, NGW, l + 1, ldsf + wave * (64 * 65), lane);
            __syncthreads();
        }
        SEAM(P);
#define LAUNDER_TID int tidu = threadIdx.x; asm volatile("" : "+v"(tidu));
        PHASE(1, P + 1) { PH_IDS
            { const int v = vcu, b = v >> 5, ch = v & 31;
                SUB(0)
#pragma unroll 1
                for (int g = 0; g < 2; ++g) { LAUNDER_TID m2_state_unit(WSP(bf16, WS_PROJ), WSP(float, WS_DT), WSP(float, WS_SLOC), WSP(float, WS_DEC), b, ch, g, INP(14) + l * 3072, INP(15) + l * 768, INP(16) + l * 4, INP(17) + l * 4, lds, tidu); }
                SUB(1)
#pragma unroll 1
                for (int g = 0; g < 2; ++g) { LAUNDER_TID hg_state_unit(WSP(bf16, WS_PROJ), WSP(float, WS_SLT), WSP(float, WS_DECC), b, ch, g, WSP(float, WS_LB1), l, lds, tidu); }
                SUB(2)
#pragma unroll 1
                for (int g = 0; g < 2; ++g) { LAUNDER_TID rg_local_unit(WSP(bf16, WS_PROJ), WSP(float, WS_HLOC), WSP(float, WS_PCUM), WSP(float, WS_RGS), b, ch, g, INP(4) + l * 1024, INP(5) + l * 256, WSP(bf16, WS_WAT) + l * 16384, WSP(bf16, WS_WAT + 512 * 1024) + l * 16384, INP(7) + l * 256, INP(9) + l * 256, INP(10) + l * 256, lds, tidu); }
            }
            SUB(3) { __syncthreads();
            for (int u = gw; u < 2048; u += NGW) { const int qb = 63 - (u >> 5), bh = u & 31; attn_unit(WSP(bf16, WS_PROJ), WSP(float, WS_ORAW), bh >> 2, bh & 3, qb, (LAS bf16*)(lds + wave * (64 * AVLD * 2)), lane); }
            __syncthreads(); }
        }
        SEAM(P + 1);
        PHASE(2, P + 2) { PH_IDS
            { float* sl = WSP(float, WS_SLOC); const float* dc = WSP(float, WS_DEC); bf16* pb = WSP(bf16, WS_PREVB);
                const int e = (vcu * NTHR + tid) * 2, n = e & 127, p = (e >> 7) & 63, h = (e >> 13) & 3, b = e >> 15;
                if (b < NB) { float r0 = 0.f, r1 = 0.f;
#pragma unroll 8
                    for (int c = 0; c < 32; ++c) { float* a = sl + ((size_t)((b * 32 + c) * 4 + h) * 64 + p) * 128 + n; const float d = dc[(b * 32 + c) * 4 + h];
                        const float s0 = a[0], s1 = a[1]; *(unsigned*)(pb + (a - sl)) = pk2(r0, r1); r0 = d * r0 + s0; r1 = d * r1 + s1; } } }
            { float* sl = WSP(float, WS_SLT); const float* dc = WSP(float, WS_DECC); bf16* pb = WSP(bf16, WS_STB);
                const int e = vcu * NTHR + tid, c = e & 63, v = (e >> 6) & 63, h = (e >> 12) & 3, b = e >> 14;
                if (b < NB) { float r = 0.f;
#pragma unroll 8
                    for (int k = 0; k < 32; ++k) { float* a = sl + ((size_t)((b * 32 + k) * 4 + h) * 64 + v) * 64 + c; const float d = dc[(size_t)((b * 32 + k) * 4 + h) * 64 + c];
                        const float s0 = a[0]; pb[a - sl] = (bf16)f2bf(r); r = d * r + s0; } } }
            { const int e = vcu * NTHR + tid;
                if (e < NB * 256) { const int b = e >> 8, c = e & 255; const float* rs = WSP(float, WS_RGS); float* cy = WSP(float, WS_CARRY); float r = 0.f;
#pragma unroll 8
                    for (int k = 0; k < 32; ++k) { const size_t o = (size_t)(b * 32 + k) * 256 + c; cy[o] = r; r = rs[2 * o] * r + rs[2 * o + 1]; } } }
        }
        SEAM(P + 2);
        PHASE(3, P + 3) { PH_IDS
            { const int v = vcu, b = v >> 5, ch = v & 31;
                SUB(4)
#pragma unroll 1
                for (int g = 0; g < 2; ++g) { LAUNDER_TID m2_out_unit(WSP(bf16, WS_PROJ), WSP(float, WS_DT), WSP(bf16, WS_PREVB), WSP(float, WS_ORAW), b, ch, g, INP(14) + l * 3072, INP(15) + l * 768, INP(16) + l * 4, INP(17) + l * 4, INP(18) + l * 4, lds, tidu); }
                SUB(5)
#pragma unroll 1
                for (int g = 0; g < 2; ++g) { LAUNDER_TID hg_out_unit(WSP(bf16, WS_PROJ), WSP(bf16, WS_STB), WSP(float, WS_ORAW), b, ch, g, WSP(float, WS_LB1), l, lds, tidu); }
                SUB(6)
                {
                    const float* hl = WSP(float, WS_HLOC); const float* pc = WSP(float, WS_PCUM); const float* cy = WSP(float, WS_CARRY); const bf16* pj = WSP(bf16, WS_PROJ); float* orw = WSP(float, WS_ORAW);
                    _Pragma("unroll 1") for (int r = 0; r < 8; ++r) { const int m = v * 64 + wave * 8 + r, c = 4 * lane; const size_t cb = (size_t)v * 256 + c;
                        const f32x4 hv = *(const f32x4*)(hl + (size_t)m * 256 + c), pv = *(const f32x4*)(pc + (size_t)m * 256 + c), cv = *(const f32x4*)(cy + cb);
                        const u32x2 gwd = *(const u32x2*)(pj + (size_t)m * DING + C_RGG + c);
                        f32x4 o = hv + pv * cv; o[0] *= gelu_tanh(bflo(gwd.x)); o[1] *= gelu_tanh(bfhi(gwd.x)); o[2] *= gelu_tanh(bflo(gwd.y)); o[3] *= gelu_tanh(bfhi(gwd.y));
                        *(f32x4*)(orw + (size_t)m * DM + 256 + c) = o; }
                    __syncthreads();
                }
                _Pragma("unroll 1") for (int r = 0; r < 8; ++r) { const int m = v * 64 + wave * 8 + r;
                    norm_row(WSP(float, WS_ORAW) + (size_t)m * DM, WSP(bf16, WS_PROJ) + (size_t)m * DING, WSP(bf16, WS_MIX) + (size_t)m * DM, INP(3) + l * 256, INP(11) + l * 256, INP(13) + l * 256, INP(19) + l * 256, lane); }
            }
        }
        SEAM(P + 3);
        PHASE(5, P + 5) { PH_IDS
            pg8::Gemm g{WSP(bf16, WS_MIX), WSP(bf16, WS_WOUT) + (size_t)l * DM * DM, T, DM, DM}; pg8::StaticOrder S; S.init(T, DM, G, bx);
            if (l == 0) { pg8::EpiResBf16<true> E{INP(0), WSP(bf16, WS_H1), DM}; pg8::gemm_phase<pg8::EpiResBf16<true>, pg8::StaticOrder, true, true>(lds, g, S, E); }
            else { pg8::EpiResBf16<false> E{WSP(bf16, WS_HB), WSP(bf16, WS_H1), DM}; pg8::gemm_phase<pg8::EpiResBf16<false>, pg8::StaticOrder, true, true>(lds, g, S, E); }
        }
        SEAM(P + 5);
        PHASE(6, P + 6) { PH_IDS
            constexpr int WLD = 1032;
            LAS bf16* WB = (LAS bf16*)lds; LAS float* LG = (LAS float*)(lds + 2 * 32 * WLD * 2); LAS float* SS = LG + 64 * 33; LAS float* RS = SS + 64;
            { const bf16* src = WSP(bf16, WS_RWB) + (size_t)l * 2 * 32 * 1024; v4u wv[16];
#pragma unroll
                for (int i = 0; i < 16; ++i) wv[i] = *(const v4u*)(src + (size_t)(tid + NTHR * i) * 8);
#pragma unroll
                for (int i = 0; i < 16; ++i) { const int c = tid + NTHR * i; *(LAS v4u*)(WB + (c >> 7) * WLD + (c & 127) * 8) = wv[i]; } }
            __syncthreads();
            const bf16* h1 = WSP(bf16, WS_H1);
            { const int rt = wave >> 1, et = wave & 1; const bf16* hp = h1 + (size_t)(vcu * 64 + rt * 16 + (lane & 15)) * DM + 8 * (lane >> 4);
                f32x4 acc = {0.f, 0.f, 0.f, 0.f}; float ssum = 0.f;
#pragma unroll 8
                for (int ks = 0; ks < 32; ++ks) { const bf16x8 a = *(const bf16x8*)(hp + 32 * ks);
                    acc = MFMA16(a, frag_kc(WB, WLD, et * 16, 32 * ks, lane), acc); acc = MFMA16(a, frag_kc(WB + 32 * WLD, WLD, et * 16, 32 * ks, lane), acc);
                    const v4u aw = __builtin_bit_cast(v4u, a);
#pragma unroll
                    for (int i = 0; i < 4; ++i) { const float x0 = bflo(aw[i]), x1 = bfhi(aw[i]); ssum += x0 * x0 + x1 * x1; } }
                ssum += __shfl_xor(ssum, 16); ssum += __shfl_xor(ssum, 32);
                if (et == 0 && lane < 16) SS[rt * 16 + lane] = ssum;
#pragma unroll
                for (int i = 0; i < 4; ++i) LG[(rt * 16 + 4 * (lane >> 4) + i) * 33 + et * 16 + (lane & 15)] = acc[i]; }
            __syncthreads();
            if (wave == 0) { const int row = lane; const float rstd = 1.0f / sqrtf(SS[row] * (1.0f / DM) + EPS); RS[row] = rstd;
                const float* rb = INP(23) + l * NE;
                float lg[32];
#pragma unroll
                for (int e = 0; e < 32; ++e) lg[e] = rstd * LG[row * 33 + e] + rb[e];
                int be[4]; float bl[4];
#pragma unroll
                for (int r = 0; r < 4; ++r) { float best = -INFINITY; int bi = 0;
#pragma unroll
                    for (int e = 0; e < 32; ++e) if (lg[e] > best) { best = lg[e]; bi = e; }
#pragma unroll
                    for (int e = 0; e < 32; ++e) if (e == bi) lg[e] = -INFINITY;
                    be[r] = bi; bl[r] = best; }
                const float e1 = expf(bl[1] - bl[0]), e2 = expf(bl[2] - bl[0]), e3 = expf(bl[3] - bl[0]), inv = 1.0f / (1.0f + e1 + e2 + e3);
                int rk0 = 0, rk1 = 0, rk2 = 0, rk3 = 0, hist = 0; const unsigned long long lt = (1ull << lane) - 1ull;
#pragma unroll
                for (int e = 0; e < 32; ++e) { const bool h0 = be[0] == e, h1b = be[1] == e, h2 = be[2] == e, h3 = be[3] == e; const unsigned long long m = __ballot(h0 | h1b | h2 | h3);
                    const int below = __popcll(m & lt); rk0 = h0 ? below : rk0; rk1 = h1b ? below : rk1; rk2 = h2 ? below : rk2; rk3 = h3 ? below : rk3; if (lane == e) hist = __popcll(m); }
                if (lane < 32) WSP(int, WS_HIST)[(size_t)vcu * 32 + lane] = hist;
                const int a = (vcu * 64 + row) * 4;
                *(int4*)(WSP(int, WS_ASGE) + a) = make_int4(be[0], be[1], be[2], be[3]); *(int4*)(WSP(int, WS_ASGP) + a) = make_int4(rk0, rk1, rk2, rk3);
                *(f32x4*)(WSP(float, WS_GATE) + a) = (f32x4){inv, e1 * inv, e2 * inv, e3 * inv}; }
            __syncthreads();
            { const float* g = INP(21) + l * DM; unsigned char* xn8 = WSP(unsigned char, WS_XN);
#pragma unroll
                for (int r = 0; r < 8; ++r) { const int row = wave * 8 + r; const size_t m = (size_t)vcu * 64 + row; const float rstd = RS[row];
#pragma unroll
                    for (int j = 0; j < 2; ++j) { const int col = 512 * j + 8 * lane; const v4u w = *(const v4u*)(h1 + m * DM + col); const f32x4 g0 = *(const f32x4*)(g + col), g1 = *(const f32x4*)(g + col + 4);
                        int w0 = 0, w1 = 0;
                        w0 = __builtin_amdgcn_cvt_pk_fp8_f32(bflo(w.x) * rstd * g0[0], bfhi(w.x) * rstd * g0[1], w0, false); w0 = __builtin_amdgcn_cvt_pk_fp8_f32(bflo(w.y) * rstd * g0[2], bfhi(w.y) * rstd * g0[3], w0, true);
                        w1 = __builtin_amdgcn_cvt_pk_fp8_f32(bflo(w.z) * rstd * g1[0], bfhi(w.z) * rstd * g1[1], w1, false); w1 = __builtin_amdgcn_cvt_pk_fp8_f32(bflo(w.w) * rstd * g1[2], bfhi(w.w) * rstd * g1[3], w1, true);
                        u32x2 o; o.x = (unsigned)w0; o.y = (unsigned)w1; *(u32x2*)(xn8 + m * DM + col) = o; } } }
        }
        SEAM(P + 6);
        PHASE(7, P + 7) { PH_IDS
            LAS int* bs = (LAS int*)(lds + 131072);
            if (tid < 32) { const int* hs = WSP(int, WS_HIST); int base = 0, tot = 0;
#pragma unroll 8
                for (int w = 0; w < G; ++w) { const int c = hs[w * 32 + tid]; tot += c; if (w < vcu) base += c; }
                bs[tid] = base; bs[32 + tid] = tot; if (vcu == 0) WSP(int, WS_TOT)[tid] = tot; }
            __syncthreads();
            if (tid == 0) { int run = 0; for (int e = 0; e < 32; ++e) { tb[e] = run; run += (bs[32 + e] + 255) >> 8; } tb[32] = run; }
            __syncthreads();
            const int* asge = WSP(int, WS_ASGE); const int* asgp = WSP(int, WS_ASGP); int* slotp = WSP(int, WS_SLOT); int* toks = (int*)(kargs()->ws + WS_CTL + CTL_TOKS) + (size_t)l * MAXSLOT;
            if (tid < 256) { const int a = vcu * 256 + tid; const int e = asge[a], slot = tb[e] * 256 + bs[e] + asgp[a]; slotp[a] = slot; toks[slot] = a >> 2; }
        }
        SEAM(P + 7);
        PHASE(8, P + 8) { PH_IDS
            build_tb(WSP(int, WS_TOT), tb, tid);
            LAS int* tokl = (LAS int*)(lds + 131072);
            pg8::MoeOrder S{(const LAS int*)tb, 8, G, bx, (const LAS int*)tokl};
            { const int* toks = (const int*)(kargs()->ws + WS_CTL + CTL_TOKS) + (size_t)l * MAXSLOT; pg8::Unit u;
                for (int i = 0; i < 15 && S.next(i, u); ++i) if (tid < 256) tokl[i * 256 + tid] = toks[u.pm * 256 + tid];
                __syncthreads(); }
            pg8::Gemm g{WSP(bf16, WS_XN), (const bf16*)(WSP(unsigned char, WS_WGU) + (size_t)l * NE * 2048 * DM), T, 2048, DM, 0x7a7a7a7a, 0x7f7f7f7f};
            pg8::EpiSwiglu8 E{WSP(unsigned char, WS_ACT), INP(25) + (size_t)l * NE * 2048};
            pg8::gemm_phase<pg8::EpiSwiglu8, pg8::MoeOrder, true, true, true>(lds, g, S, E);
            if (l + 1 < DEPTH) { const int rem = (tb[32] * 8) % G;
                if (rem != 0 && bx >= rem) { const int nw = (G - rem) * NWAVES; convert_items(min(CV_TAIL + nw * CV_GQ, CV_MOE), CV_TAIL + (bx - rem) * NWAVES + wave, nw, l + 2, ldsf + wave * (64 * 65), lane); } }
        }
        SEAM(P + 8);
        PHASE(9, P + 9) { PH_IDS
            build_tb(WSP(int, WS_TOT), tb, tid);
            pg8::Gemm g{WSP(bf16, WS_ACT), (const bf16*)(WSP(unsigned char, WS_WDN) + (size_t)l * NE * DM * DFF), MAXSLOT, DM, DFF, 0x79797979, 0x7f7f7f7f}; pg8::MoeOrder S{(const LAS int*)tb, 4, G, bx};
            pg8::EpiBf16 E{WSP(bf16, WS_Y), DM, INP(27) + (size_t)l * NE * DM, DM};
            pg8::gemm_phase<pg8::EpiBf16, pg8::MoeOrder, true, true, true>(lds, g, S, E);
            if (l + 1 < DEPTH) { const int remg = (tb[32] * 8) % G, remh = (tb[32] * 4) % G; const int offh = min(CV_TAIL + (remg ? (G - remg) * NWAVES * CV_GQ : 0), CV_MOE);
                if (remh != 0 && bx >= remh) { const int nw = (G - remh) * NWAVES; convert_items(min(offh + nw * CV_HQ, CV_MOE), offh + (bx - remh) * NWAVES + wave, nw, l + 2, ldsf + wave * (64 * 65), lane); } }
        }
        SEAM(P + 9);
        PHASE(10, P + 10) { PH_IDS
            if (l + 1 < DEPTH) { build_tb(WSP(int, WS_TOT), tb, tid);
                const int remg = (tb[32] * 8) % G, remh = (tb[32] * 4) % G; const int offc = min(min(CV_TAIL + (remg ? (G - remg) * NWAVES * CV_GQ : 0), CV_MOE) + (remh ? (G - remh) * NWAVES * CV_HQ : 0), CV_MOE);
                convert_items(CV_MOE, offc + gw, NGW, l + 2, ldsf + wave * (64 * 65), lane); }
            const bf16* h1 = WSP(bf16, WS_H1); const int* slotp = WSP(int, WS_SLOT); const float* gatep = WSP(float, WS_GATE); const bf16* yb = WSP(bf16, WS_Y);
            for (int m = gw; m < T; m += NGW) { f32x4 v[4];
#pragma unroll
                for (int j = 0; j < 4; ++j) { const u32x2 w = *(const u32x2*)(h1 + (size_t)m * DM + 256 * j + 4 * lane); v[j] = (f32x4){bflo(w.x), bfhi(w.x), bflo(w.y), bfhi(w.y)}; }
#pragma unroll
                for (int r = 0; r < 4; ++r) { const int slot = slotp[m * 4 + r]; const float gg = gatep[m * 4 + r]; const bf16* yr = yb + (size_t)slot * DM;
#pragma unroll
                    for (int j = 0; j < 4; ++j) { const u32x2 w = *(const u32x2*)(yr + 256 * j + 4 * lane); v[j][0] += gg * bflo(w.x); v[j][1] += gg * bfhi(w.x); v[j][2] += gg * bflo(w.y); v[j][3] += gg * bfhi(w.y); } }
                if (l + 1 < DEPTH) {
#pragma unroll
                    for (int j = 0; j < 4; ++j) { u32x2 w; w.x = pk2(v[j][0], v[j][1]); w.y = pk2(v[j][2], v[j][3]); *(u32x2*)(WSP(bf16, WS_HB) + (size_t)m * DM + 256 * j + 4 * lane) = w; }
                    emit_xn_dt(v, INP(1) + (l + 1) * DM, INP(2) + (size_t)(l + 1) * DM * DIN, WSP(bf16, WS_XN) + (size_t)m * DM, WSP(float, WS_DT) + (size_t)m * 4, lane);
                } else { float ss = 0.f;
#pragma unroll
                    for (int j = 0; j < 4; ++j) ss += (v[j][0] * v[j][0] + v[j][1] * v[j][1]) + (v[j][2] * v[j][2] + v[j][3] * v[j][3]);
                    ss = wave_sum(ss); const float rstd = 1.0f / sqrtf(ss * (1.0f / DM) + EPS);
#pragma unroll
                    for (int j = 0; j < 4; ++j) *(f32x4*)(kargs()->out + (size_t)m * DM + 256 * j + 4 * lane) = v[j] * rstd * *(const f32x4*)(INP(28) + 256 * j + 4 * lane); }
            }
        }
        if (l + 1 < DEPTH) SEAM(P + 10);
    }
#undef IN
#undef SEAM
}

extern "C" void kernel_launch(void* const* d_in, const int* in_sizes, int n_in, void* d_out, int out_size, void* d_ws, size_t ws_size, hipStream_t stream) {
    static int grid = 0;
    if (grid == 0) {
        if (n_in != 29 || in_sizes[0] != T * DM || out_size != T * DM || ws_size < WS_END) { fprintf(stderr, "kernel_launch: unexpected shapes (n_in %d, in0 %d, out %d, ws %zu); nothing launched\n", n_in, n_in > 0 ? in_sizes[0] : -1, out_size, ws_size); grid = -1; return; }
        int dev = 0, cus = 0, per_cu = 0;
        if (hipGetDevice(&dev) != hipSuccess || hipDeviceGetAttribute(&cus, hipDeviceAttributeMultiprocessorCount, dev) != hipSuccess) { grid = -1; return; }
        if (hipFuncSetAttribute((const void*)fwd_kernel, hipFuncAttributeMaxDynamicSharedMemorySize, LDS_BYTES) != hipSuccess) { fprintf(stderr, "kernel_launch: hipFuncSetAttribute failed\n"); grid = -1; return; }
        if (hipOccupancyMaxActiveBlocksPerMultiprocessor(&per_cu, (const void*)fwd_kernel, NTHR, LDS_BYTES) != hipSuccess || per_cu < 1) fprintf(stderr, "kernel_launch: occupancy query reports %d\n", per_cu);
        (void)hipGetLastError();
        if (cus != 256) { fprintf(stderr, "kernel_launch: built for a 256-CU device (one workgroup per CU, work lists sized for 256 workgroups); found %d CUs; nothing launched\n", cus); grid = -1; return; }
        grid = cus;
    }
    if (grid < 0) return;
    if (hipMemsetAsync((char*)d_ws + WS_CTL, 0, CTL_ZERO_BYTES, stream) != hipSuccess) { fprintf(stderr, "kernel_launch: memset failed\n"); return; }
    Args a{};
    for (int i = 0; i < 29; ++i) a.in[i] = (const float*)d_in[i];
    a.out = (float*)d_out; a.ws = (unsigned char*)d_ws;
#if MK_N_LAUNCHES == 1
    a.ph_lo = 0; a.ph_hi = NPHASE; a.use_bar = 1;
    hipLaunchKernelGGL(fwd_kernel, dim3(grid), dim3(NTHR), LDS_BYTES, stream, a);
#else
    for (int p = 0; p < NPHASE; ++p) { a.ph_lo = p; a.ph_hi = p + 1; a.use_bar = 0; hipLaunchKernelGGL(fwd_kernel, dim3(grid), dim3(NTHR), LDS_BYTES, stream, a); }
#endif
}
```

```cpp
#include <hip/hip_runtime.h>
#include <cstdio>
#include <cstdint>

#ifndef MK_N_LAUNCHES
#define MK_N_LAUNCHES 1
#endif

constexpr int NB = 8, SEQ = 2048, DM = 1024, T = NB * SEQ, DEPTH = 2;
constexpr int DIN = 3332, DING = 3328;
constexpr int NE = 32, TOPK = 4, DFF = 1024;
constexpr int NASG = T * TOPK;
constexpr int MAXSLOT = NASG + NE * 256;
constexpr float EPS = 1e-6f;
constexpr int C_SBQ = 0, C_SBK = 256, C_SBV = 512, C_RGX = 768, C_RGG = 1024, C_HGQ = 1280, C_HGF = 1536, C_HGI = 1792, C_HGG = 2048,
              C_M2Z = 2304, C_M2X = 2560, C_DT = 3328;
constexpr int NWAVES = 8, NTHR = 512;

constexpr size_t MiB = 1u << 20;
constexpr size_t WS_CTL = 0, CTL_ZERO_BYTES = 1 * MiB;
constexpr size_t WS_WIN = 2 * MiB;
constexpr size_t WS_WOUT = 16 * MiB;
constexpr size_t WS_WGU = 32 * MiB;
constexpr size_t WS_WDN = 288 * MiB;
constexpr size_t WS_XN = 416 * MiB;
constexpr size_t WS_PROJ = 448 * MiB;
constexpr size_t WS_ORAW = 552 * MiB;
constexpr size_t WS_MIX = 616 * MiB;
constexpr size_t WS_H1 = 648 * MiB;
constexpr size_t WS_HB = 712 * MiB;
constexpr size_t WS_XS = 776 * MiB;
constexpr size_t WS_ACT = 920 * MiB;
constexpr size_t WS_Y = 1064 * MiB;
constexpr size_t WS_DT = 1208 * MiB;
constexpr size_t WS_ASGE = 1209 * MiB;
constexpr size_t WS_ASGP = 1210 * MiB;
constexpr size_t WS_GATE = 1211 * MiB;
constexpr size_t WS_SLOT = 1212 * MiB;
constexpr size_t WS_SLOC = 1216 * MiB;
constexpr size_t WS_DEC = 1248 * MiB;
constexpr size_t WS_SLT = 1250 * MiB;
constexpr size_t WS_DECC = 1266 * MiB;
constexpr size_t WS_HLOC = 1268 * MiB;
constexpr size_t WS_PCUM = 1284 * MiB;
constexpr size_t WS_RGS = 1300 * MiB;
constexpr size_t WS_CARRY = 1301 * MiB;
constexpr size_t WS_WAT = 1302 * MiB;
constexpr size_t WS_HIST = 1303 * MiB;
constexpr size_t WS_TOT = WS_HIST + 512 * 1024;
constexpr size_t WS_LB1 = WS_HIST + 768 * 1024;
constexpr size_t WS_PREVB = 1304 * MiB;
constexpr size_t WS_STB = 1320 * MiB;
constexpr size_t WS_RWB = 1328 * MiB;
constexpr size_t WS_END = 1329 * MiB;
constexpr int CW_TMO = 0, CW_CODE = 1;
constexpr int CW_CNT = 256;
constexpr int CW_BAR = 4096;
constexpr size_t CTL_TOKS = 256 * 1024;

constexpr int LDS_BYTES = 147456;
constexpr int LDSCTL_OFF = LDS_BYTES - 1024;
constexpr int MISC_OFF = LDSCTL_OFF;
constexpr int TB_OFF = LDSCTL_OFF + 256;

namespace pg8 {
#define PG8_LAS __attribute__((address_space(3)))
typedef unsigned short bf16_t;
typedef short bf16x8 __attribute__((ext_vector_type(8)));
typedef float f32x4 __attribute__((ext_vector_type(4)));
typedef unsigned u32x4 __attribute__((ext_vector_type(4)));
constexpr int BM = 256, BK = 64, HALF = 128, HTB = HALF * BK * 2  , STAGE_BYTES = 8 * HTB, NXCD = 8, WGM = 8;

__host__ __device__ __forceinline__ int lds_byte(int r, int c) { const int st = (r >> 4) * 2 + (c >> 5), rr = r & 15, cc = c & 31, ob = rr * 64 + cc * 2; return st * 1024 + (ob ^ (((ob >> 9) & 1) << 5)); }
__host__ __device__ __forceinline__ void stage_rc(int b, int& R, int& C) { const int st = b / 1024, sb = b % 1024, swz = sb ^ (((sb >> 9) & 1) << 5); R = (st >> 1) * 16 + swz / 64; C = (st & 1) * 32 + (swz % 64) / 2; }
__host__ __device__ __forceinline__ int perm32(int rho) { const int n = rho >> 4, i = rho & 15; return 8 * (i >> 2) + 4 * n + (i & 3); }

struct Unit { int pm, pn, pb, e, ui; };
struct Gemm { const bf16_t* A; const bf16_t* Bt; int M, N, K; int sw = 0x7f7f7f7f, sx = 0x7f7f7f7f; };

__host__ __device__ __forceinline__ int xcd_remap(int wgid, int nwg) { const int q = nwg / NXCD, r = nwg % NXCD, xcd = wgid % NXCD, off = wgid / NXCD; return (xcd < r ? xcd * (q + 1) : r * (q + 1) + (xcd - r) * q) + off; }

struct StaticOrder {
    int nM, nN, nwg, G, c;
    __host__ __device__ void init(int M, int N, int G_, int c_) { nM = M / BM; nN = N / BM; nwg = nM * nN; G = G_; c = c_; }
    __host__ __device__ bool next(int i, Unit& u) const {
        const long L = (long)i * G + c; if (L >= nwg) return false;
        const int wgid = xcd_remap((int)L, nwg);
        const int nig = WGM * nN, gid = wgid / nig, fm = gid * WGM, gsz = (nM - fm) < WGM ? (nM - fm) : WGM;
        u.pm = fm + ((wgid % nig) % gsz); u.pn = (wgid % nig) / gsz; u.pb = u.pn; u.e = 0; u.ui = i; return true;
    }
    __device__ __forceinline__ void a_ready(const Unit&) const {}
    __device__ __forceinline__ void done(const Unit&) const {}
    __device__ __forceinline__ size_t a_base(const Unit& u, size_t tstep) const { return (size_t)u.pm * tstep; }
    __device__ __forceinline__ unsigned a_off(const Unit&, int r, int K) const { return (unsigned)(r * K) * 2u; }
};
struct MoeOrder {
    const PG8_LAS int* tb; int NP, G, c; const PG8_LAS int* tokl;
    __device__ __forceinline__ bool next(int i, Unit& u) const {
        const int ntot = tb[32], nunits = ntot * NP;
        const long L = (long)i * G + c; if (L >= nunits) return false;
        const int id = xcd_remap((int)L, nunits);
        int e = 0;
        for (int j = 1; j < 32; ++j) if (id >= tb[j] * NP) e = j;
        e = __builtin_amdgcn_readfirstlane(e);
        const int t0 = tb[e], nt = tb[e + 1] - t0, rem = id - t0 * NP;
        u.pm = __builtin_amdgcn_readfirstlane(t0 + rem % nt); u.pn = __builtin_amdgcn_readfirstlane(rem / nt); u.pb = e * NP + u.pn; u.e = e; u.ui = i; return true;
    }
    __device__ __forceinline__ void a_ready(const Unit&) const {}
    __device__ __forceinline__ void done(const Unit&) const {}
    __device__ __forceinline__ size_t a_base(const Unit& u, size_t tstep) const { return tokl ? (size_t)0 : (size_t)u.pm * tstep; }
    __device__ __forceinline__ unsigned a_off(const Unit& u, int r, int K) const { return tokl ? (unsigned)(tokl[u.ui * 256 + r] * K) * 2u : (unsigned)(r * K) * 2u; }
};

__device__ __forceinline__ float f8clamp(float x) { return __builtin_amdgcn_fmed3f(x, -448.0f, 448.0f); }
__device__ __forceinline__ unsigned cvt_pk_bf16(float lo, float hi) { unsigned r; asm volatile("v_cvt_pk_bf16_f32 %0, %1, %2" : "=v"(r) : "v"(lo), "v"(hi)); return r; }

struct EpiBf16 {
    static constexpr bool PERM = true, AFTER_DRAIN = false;
    bf16_t* O; int ldc; const float* bias; int bias_estride;
    __device__ __forceinline__ void operator()(const f32x4 (&acc)[2][2][4][2], const Unit& u, int wr, int wc, int fr, int fq) const {
        const int row0 = u.pm * BM + wr * 64 + fr; const int col0 = u.pn * BM + wc * 32 + 8 * fq;
        f32x4 bv[2][2];
#pragma unroll
        for (int bj = 0; bj < 2; ++bj)
#pragma unroll
            for (int n = 0; n < 2; ++n) bv[bj][n] = bias ? *(const f32x4*)(bias + (size_t)u.e * bias_estride + col0 + bj * HALF + 4 * n) : (f32x4){0.f, 0.f, 0.f, 0.f};
#pragma unroll
        for (int ai = 0; ai < 2; ++ai)
#pragma unroll
            for (int m = 0; m < 4; ++m) { bf16_t* rowp = O + (size_t)(row0 + ai * HALF + m * 16) * ldc + col0;
#pragma unroll
                for (int bj = 0; bj < 2; ++bj) { const f32x4 v0 = acc[ai][bj][m][0] + bv[bj][0], v1 = acc[ai][bj][m][1] + bv[bj][1];
                    u32x4 w; w.x = cvt_pk_bf16(v0[0], v0[1]); w.y = cvt_pk_bf16(v0[2], v0[3]); w.z = cvt_pk_bf16(v1[0], v1[1]); w.w = cvt_pk_bf16(v1[2], v1[3]);
                    *(u32x4*)(rowp + bj * HALF) = w; } }
    }
};
template <bool BASE_F32> struct EpiResBf16 {
    static constexpr bool PERM = true, AFTER_DRAIN = false;
    const void* base; bf16_t* out; int ldc;
    __device__ __forceinline__ void operator()(const f32x4 (&acc)[2][2][4][2], const Unit& u, int wr, int wc, int fr, int fq) const {
        const int row0 = u.pm * BM + wr * 64 + fr, col0 = u.pn * BM + wc * 32 + 8 * fq;
#pragma unroll
        for (int ai = 0; ai < 2; ++ai)
#pragma unroll
            for (int m = 0; m < 4; ++m) { const size_t off = (size_t)(row0 + ai * HALF + m * 16) * ldc + col0;
#pragma unroll
                for (int bj = 0; bj < 2; ++bj) { f32x4 b0, b1;
                    if (BASE_F32) { const float* bp = (const float*)base + off + bj * HALF; b0 = *(const f32x4*)bp; b1 = *(const f32x4*)(bp + 4); }
                    else { const u32x4 w = *(const u32x4*)((const bf16_t*)base + off + bj * HALF);
                        b0 = (f32x4){__uint_as_float(w.x << 16), __uint_as_float(w.x & 0xffff0000u), __uint_as_float(w.y << 16), __uint_as_float(w.y & 0xffff0000u)};
                        b1 = (f32x4){__uint_as_float(w.z << 16), __uint_as_float(w.z & 0xffff0000u), __uint_as_float(w.w << 16), __uint_as_float(w.w & 0xffff0000u)}; }
                    const f32x4 v0 = b0 + acc[ai][bj][m][0], v1 = b1 + acc[ai][bj][m][1];
                    u32x4 o; o.x = cvt_pk_bf16(v0[0], v0[1]); o.y = cvt_pk_bf16(v0[2], v0[3]); o.z = cvt_pk_bf16(v1[0], v1[1]); o.w = cvt_pk_bf16(v1[2], v1[3]);
                    *(u32x4*)(out + off + bj * HALF) = o; } }
    }
};
struct EpiSwiglu8 {
    static constexpr bool PERM = true, AFTER_DRAIN = false;
    unsigned char* O; const float* bias;
    __device__ __forceinline__ void operator()(const f32x4 (&acc)[2][2][4][2], const Unit& u, int wr, int wc, int fr, int fq) const {
        const int row0 = u.pm * BM + wr * 64 + fr; const int a0 = u.pn * HALF + wc * 32 + 8 * fq;
        const float* bp = bias + (size_t)u.e * 2048 + 2 * a0;
        f32x4 b4[4];
#pragma unroll
        for (int j = 0; j < 4; ++j) b4[j] = *(const f32x4*)(bp + 4 * j);
#pragma unroll
        for (int ai = 0; ai < 2; ++ai)
#pragma unroll
            for (int m = 0; m < 4; ++m) { unsigned char* rowp = O + (size_t)(row0 + ai * HALF + m * 16) * 1024 + a0;
                float a[8];
#pragma unroll
                for (int n = 0; n < 2; ++n)
#pragma unroll
                    for (int i = 0; i < 4; ++i) { const int k = 4 * n + i;
                        float g = acc[ai][0][m][n][i] + b4[k >> 1][2 * (k & 1)], l = acc[ai][1][m][n][i] + b4[k >> 1][2 * (k & 1) + 1];
                        g = fminf(g, 7.0f); l = fminf(fmaxf(l, -7.0f), 7.0f);
                        const float sg = __builtin_amdgcn_rcpf(1.0f + __builtin_amdgcn_exp2f(-1.702f * 1.4426950408889634f * g));
                        a[k] = g * sg * (l + 1.0f); }
                int w0 = 0, w1 = 0;
                w0 = __builtin_amdgcn_cvt_pk_fp8_f32(f8clamp(a[0]), f8clamp(a[1]), w0, false); w0 = __builtin_amdgcn_cvt_pk_fp8_f32(f8clamp(a[2]), f8clamp(a[3]), w0, true);
                w1 = __builtin_amdgcn_cvt_pk_fp8_f32(f8clamp(a[4]), f8clamp(a[5]), w1, false); w1 = __builtin_amdgcn_cvt_pk_fp8_f32(f8clamp(a[6]), f8clamp(a[7]), w1, true);
                typedef int i32x2_ __attribute__((ext_vector_type(2)));
                *(i32x2_*)rowp = (i32x2_){w0, w1}; }
    }
};
struct EpiSwiglu {
    static constexpr bool PERM = true, AFTER_DRAIN = false;
    bf16_t* O; const float* bias;
    __device__ __forceinline__ void operator()(const f32x4 (&acc)[2][2][4][2], const Unit& u, int wr, int wc, int fr, int fq) const {
        const int row0 = u.pm * BM + wr * 64 + fr; const int a0 = u.pn * HALF + wc * 32 + 8 * fq;
        const float* bp = bias + (size_t)u.e * 2048 + 2 * a0;
        f32x4 b4[4];
#pragma unroll
        for (int j = 0; j < 4; ++j) b4[j] = *(const f32x4*)(bp + 4 * j);
#pragma unroll
        for (int ai = 0; ai < 2; ++ai)
#pragma unroll
            for (int m = 0; m < 4; ++m) { bf16_t* rowp = O + (size_t)(row0 + ai * HALF + m * 16) * 1024 + a0;
                float a[8];
#pragma unroll
                for (int n = 0; n < 2; ++n)
#pragma unroll
                    for (int i = 0; i < 4; ++i) { const int k = 4 * n + i;
                        float g = acc[ai][0][m][n][i] + b4[k >> 1][2 * (k & 1)], l = acc[ai][1][m][n][i] + b4[k >> 1][2 * (k & 1) + 1];
                        g = fminf(g, 7.0f); l = fminf(fmaxf(l, -7.0f), 7.0f);
                        const float sg = __builtin_amdgcn_rcpf(1.0f + __builtin_amdgcn_exp2f(-1.702f * 1.4426950408889634f * g));
                        a[k] = g * sg * (l + 1.0f); }
                u32x4 w; w.x = cvt_pk_bf16(a[0], a[1]); w.y = cvt_pk_bf16(a[2], a[3]); w.z = cvt_pk_bf16(a[4], a[5]); w.w = cvt_pk_bf16(a[6], a[7]);
                *(u32x4*)rowp = w; }
    }
};

template <class Epi, class Sched, bool ALIGN_EPI = false, bool SP2 = false, bool F8 = false>
__device__ __forceinline__ void gemm_phase(PG8_LAS unsigned char* lds, const Gemm g, const Sched& S, const Epi& E) {
    int tid = threadIdx.x; asm volatile("" : "+v"(tid));
    const int wid = __builtin_amdgcn_readfirstlane(tid >> 6), lane = tid & 63, wr = wid >> 2, wc = wid & 3, fr = lane & 15, fq = lane >> 4;
    const int K = g.K, PITCH = F8 ? K : 2 * K  , KH = PITCH / 2, nt = PITCH / (2 * BK);
    unsigned vAc[2][2], vAn[2][2], voffB[2];
    int sR[2], sC[2];
#pragma unroll
    for (int i = 0; i < 2; ++i) { int R, C; stage_rc(tid * 16 + i * 8192, R, C); const int Rb = Epi::PERM ? ((R & ~31) + perm32(R & 31)) : R;
        sR[i] = R; sC[i] = C; voffB[i] = (unsigned)(Rb * KH + C) * 2u; }
    const size_t kstep = (size_t)(BK * 2);
    const size_t hstep = (size_t)HALF * PITCH;
    const size_t tstep = 2 * hstep;
    const unsigned ldsw = (unsigned)wid * 1024u;
    const int aoff = F8 ? lds_byte(wr * 64 + fr, 16 * (fq & 1)) + (fq >> 1) * 1024 : lds_byte(wr * 64 + fr, fq * 8), boff = F8 ? lds_byte(wc * 32 + fr, 16 * (fq & 1)) + (fq >> 1) * 1024 : lds_byte(wc * 32 + fr, fq * 8);
    typedef int v8i_ __attribute__((ext_vector_type(8))); typedef int v4i_ __attribute__((ext_vector_type(4)));
#define PG8_SA(b, h) (((b) * 2 + (h)) * HTB)
#define PG8_SB(b, h) ((4 + (b) * 2 + (h)) * HTB)
#define PG8_STAGE(bufoff, gbase, voff) do { _Pragma("unroll") for (int _i = 0; _i < 2; ++_i) \
        __builtin_amdgcn_global_load_lds((const unsigned*)((const char*)(gbase) + (voff)[_i]), (PG8_LAS unsigned*)(lds + (bufoff) + ldsw + _i * 8192), 16, 0, 0); } while (0)
#define PG8_LDA(dst, b, h) do { if constexpr (F8) { _Pragma("unroll") for (int m = 0; m < 4; ++m) { const v4i_ lo_ = *(const PG8_LAS v4i_*)(lds + PG8_SA(b, h) + aoff + m * 2048), hi_ = *(const PG8_LAS v4i_*)(lds + PG8_SA(b, h) + aoff + m * 2048 + 16); \
            dst##8[m] = __builtin_shufflevector(lo_, hi_, 0, 1, 2, 3, 4, 5, 6, 7); } } \
        else { _Pragma("unroll") for (int m = 0; m < 4; ++m) _Pragma("unroll") for (int k = 0; k < 2; ++k) dst[m][k] = *(const PG8_LAS bf16x8*)(lds + PG8_SA(b, h) + aoff + m * 2048 + k * 1024); } } while (0)
#define PG8_LDB(dst, b, h) do { if constexpr (F8) { _Pragma("unroll") for (int n = 0; n < 2; ++n) { const v4i_ lo_ = *(const PG8_LAS v4i_*)(lds + PG8_SB(b, h) + boff + n * 2048), hi_ = *(const PG8_LAS v4i_*)(lds + PG8_SB(b, h) + boff + n * 2048 + 16); \
            dst##8[n] = __builtin_shufflevector(lo_, hi_, 0, 1, 2, 3, 4, 5, 6, 7); } } \
        else { _Pragma("unroll") for (int n = 0; n < 2; ++n) _Pragma("unroll") for (int k = 0; k < 2; ++k) dst[n][k] = *(const PG8_LAS bf16x8*)(lds + PG8_SB(b, h) + boff + n * 2048 + k * 1024); } } while (0)
#define PG8_MMA(ai, bj, At, Bt) do { __builtin_amdgcn_s_setprio(1); if constexpr (F8) asm volatile("s_nop 3"); _Pragma("unroll") for (int m = 0; m < 4; ++m) _Pragma("unroll") for (int n = 0; n < 2; ++n) { \
        if constexpr (F8) asm volatile("v_mfma_scale_f32_16x16x128_f8f6f4 %0, %1, %2, %0, %3, %4 op_sel_hi:[0,0,0]" : "+v"(acc[ai][bj][m][n]) : "v"(Bt##8[n]), "v"(At##8[m]), "v"(swv), "v"(sxv)); \
        else { _Pragma("unroll") for (int k = 0; k < 2; ++k) acc[ai][bj][m][n] = __builtin_amdgcn_mfma_f32_16x16x32_bf16(Bt[n][k], At[m][k], acc[ai][bj][m][n], 0, 0, 0); } } \
        __builtin_amdgcn_s_setprio(0); } while (0)
#define PG8_WAIT_V(n) asm volatile("s_waitcnt vmcnt(" #n ")" ::: "memory")
#define PG8_WAIT_L(n) asm volatile("s_waitcnt lgkmcnt(" #n ")" ::: "memory")
#define PG8_BAR __builtin_amdgcn_s_barrier()
#define PG8_SCHED __builtin_amdgcn_sched_barrier(0)
    Unit cur, nxt; int ui = 0;
    if (!S.next(0, cur)) return;
    f32x4 acc[2][2][4][2];
#pragma unroll
    for (int a = 0; a < 2; ++a)
#pragma unroll
        for (int b = 0; b < 2; ++b)
#pragma unroll
            for (int m = 0; m < 4; ++m)
#pragma unroll
                for (int n = 0; n < 2; ++n) acc[a][b][m][n] = (f32x4){0.f, 0.f, 0.f, 0.f};
    int swv = g.sw, sxv = g.sx;
    bf16x8 At[4][2], B0[2][2], B1[2][2]; v8i_ At8[4], B08[2], B18[2];
    const char* cA = (const char*)g.A + S.a_base(cur, tstep); const char* cB = (const char*)g.Bt + (size_t)cur.pb * tstep;
#pragma unroll
    for (int h = 0; h < 2; ++h)
#pragma unroll
        for (int i = 0; i < 2; ++i) { vAc[h][i] = S.a_off(cur, h * HALF + sR[i], KH) + (unsigned)sC[i] * 2u; vAn[h][i] = vAc[h][i]; }
    S.a_ready(cur);
    if constexpr (SP2) {
        PG8_STAGE(PG8_SB(0, 0), cB, voffB); PG8_STAGE(PG8_SB(0, 1), cB + hstep, voffB); PG8_STAGE(PG8_SA(0, 0), cA, vAc[0]); PG8_STAGE(PG8_SA(0, 1), cA, vAc[1]);
        if (wr == 1) PG8_BAR;
        PG8_WAIT_V(2); PG8_BAR;
        PG8_STAGE(PG8_SB(1, 0), cB + kstep, voffB); PG8_STAGE(PG8_SA(1, 0), cA + kstep, vAc[0]); PG8_STAGE(PG8_SB(1, 1), cB + hstep + kstep, voffB);
        PG8_WAIT_V(6); PG8_BAR;
    } else {
        PG8_STAGE(PG8_SB(0, 0), cB, voffB); PG8_STAGE(PG8_SA(0, 0), cA, vAc[0]); PG8_STAGE(PG8_SB(0, 1), cB + hstep, voffB); PG8_STAGE(PG8_SA(0, 1), cA, vAc[1]);
        if (wr == 1) PG8_BAR;
        PG8_WAIT_V(4); PG8_BAR;
        PG8_STAGE(PG8_SB(1, 0), cB + kstep, voffB); PG8_STAGE(PG8_SA(1, 0), cA + kstep, vAc[0]); PG8_STAGE(PG8_SB(1, 1), cB + hstep + kstep, voffB);
        PG8_WAIT_V(6); PG8_BAR;
    }
    for (;;) {
        const bool has_next = S.next(ui + 1, nxt);
        const char* nA = has_next ? (const char*)g.A + S.a_base(nxt, tstep) : cA;
        if (has_next) {
#pragma unroll
            for (int h = 0; h < 2; ++h)
#pragma unroll
                for (int i = 0; i < 2; ++i) vAn[h][i] = S.a_off(nxt, h * HALF + sR[i], KH) + (unsigned)sC[i] * 2u; } const char* nB = has_next ? (const char*)g.Bt + (size_t)nxt.pb * tstep : cB;
        for (int t = 0; t < nt; t += 2) {
            const bool last = (t == nt - 2);
            const char* a1 = cA + (size_t)(t + 1) * kstep;
            const char* a2 = last ? nA : cA + (size_t)(t + 2) * kstep; const char* b2 = last ? nB : cB + (size_t)(t + 2) * kstep;
            const char* a3 = a2 + kstep; const char* b3 = b2 + kstep;
            unsigned v2[2][2];
#pragma unroll
            for (int h = 0; h < 2; ++h)
#pragma unroll
                for (int i = 0; i < 2; ++i) v2[h][i] = last ? vAn[h][i] : vAc[h][i];
            if (last && has_next) S.a_ready(nxt);
            if constexpr (SP2) {
            PG8_LDB(B0, 0, 0); PG8_LDB(B1, 0, 1); PG8_SCHED; PG8_LDA(At, 0, 0); PG8_STAGE(PG8_SA(1, 1), a1, vAc[1]);
            PG8_WAIT_V(8); PG8_WAIT_L(0); PG8_BAR; PG8_MMA(0, 0, At, B0); PG8_MMA(0, 1, At, B1); PG8_BAR; PG8_SCHED;
            PG8_LDA(At, 0, 1); PG8_STAGE(PG8_SB(0, 0), b2, voffB); PG8_STAGE(PG8_SB(0, 1), b2 + hstep, voffB); PG8_STAGE(PG8_SA(0, 0), a2, v2[0]);
            PG8_WAIT_V(8); PG8_WAIT_L(0); PG8_BAR; PG8_MMA(1, 0, At, B0); PG8_MMA(1, 1, At, B1); PG8_BAR; PG8_SCHED;
            PG8_LDB(B0, 1, 0); PG8_LDB(B1, 1, 1); PG8_SCHED; PG8_LDA(At, 1, 0); PG8_STAGE(PG8_SA(0, 1), a2, v2[1]);
            PG8_WAIT_V(8); PG8_WAIT_L(0); PG8_BAR; PG8_MMA(0, 0, At, B0); PG8_MMA(0, 1, At, B1); PG8_BAR; PG8_SCHED;
            PG8_LDA(At, 1, 1); PG8_STAGE(PG8_SB(1, 0), b3, voffB); PG8_STAGE(PG8_SB(1, 1), b3 + hstep, voffB); PG8_STAGE(PG8_SA(1, 0), a3, v2[0]);
            PG8_WAIT_V(8); PG8_WAIT_L(0); PG8_BAR; PG8_MMA(1, 0, At, B0); PG8_MMA(1, 1, At, B1); PG8_BAR; PG8_SCHED;
            } else {
            PG8_LDB(B0, 0, 0); PG8_SCHED; PG8_LDA(At, 0, 0); PG8_STAGE(PG8_SA(1, 1), a1, vAc[1]);
            PG8_WAIT_L(8); PG8_BAR; PG8_WAIT_L(0); PG8_MMA(0, 0, At, B0); PG8_BAR; PG8_SCHED;
            PG8_LDB(B1, 0, 1); PG8_STAGE(PG8_SB(0, 0), b2, voffB);
            PG8_BAR; PG8_WAIT_L(0); PG8_MMA(0, 1, At, B1); PG8_BAR;
            PG8_LDA(At, 0, 1); PG8_STAGE(PG8_SA(0, 0), a2, v2[0]);
            PG8_BAR; PG8_WAIT_L(0); PG8_MMA(1, 0, At, B0); PG8_BAR; PG8_SCHED;
            PG8_STAGE(PG8_SB(0, 1), b2 + hstep, voffB);
            PG8_WAIT_V(6); PG8_BAR; PG8_MMA(1, 1, At, B1); PG8_BAR;
            PG8_LDB(B0, 1, 0); PG8_SCHED; PG8_LDA(At, 1, 0); PG8_STAGE(PG8_SA(0, 1), a2, v2[1]);
            PG8_WAIT_L(8); PG8_BAR; PG8_WAIT_L(0); PG8_MMA(0, 0, At, B0); PG8_BAR; PG8_SCHED;
            PG8_LDB(B1, 1, 1); PG8_STAGE(PG8_SB(1, 0), b3, voffB);
            PG8_BAR; PG8_WAIT_L(0); PG8_MMA(0, 1, At, B1); PG8_BAR;
            PG8_LDA(At, 1, 1); PG8_STAGE(PG8_SA(1, 0), a3, v2[0]);
            PG8_BAR; PG8_WAIT_L(0); PG8_MMA(1, 0, At, B0); PG8_BAR; PG8_SCHED;
            PG8_STAGE(PG8_SB(1, 1), b3 + hstep, voffB);
            PG8_WAIT_V(6); PG8_BAR; PG8_MMA(1, 1, At, B1); PG8_BAR;
            }
        }
        if constexpr (F8) {
#pragma unroll
            for (int a = 0; a < 2; ++a)
#pragma unroll
                for (int b = 0; b < 2; ++b) asm volatile("s_nop 15\n\ts_nop 7" : "+v"(acc[a][b][0][0]), "+v"(acc[a][b][0][1]), "+v"(acc[a][b][1][0]), "+v"(acc[a][b][1][1]), "+v"(acc[a][b][2][0]), "+v"(acc[a][b][2][1]), "+v"(acc[a][b][3][0]), "+v"(acc[a][b][3][1])); }
        if constexpr (ALIGN_EPI) { if (wr == 0) PG8_BAR; }
        if constexpr (!Epi::AFTER_DRAIN) { E(acc, cur, wr, wc, fr, fq); S.done(cur); }
        if (!has_next) break;
#pragma unroll
        for (int a = 0; a < 2; ++a)
#pragma unroll
            for (int b = 0; b < 2; ++b)
#pragma unroll
                for (int m = 0; m < 4; ++m)
#pragma unroll
                    for (int n = 0; n < 2; ++n) acc[a][b][m][n] = (f32x4){0.f, 0.f, 0.f, 0.f};
        cur = nxt; cA = nA; cB = nB; ++ui;
#pragma unroll
        for (int h = 0; h < 2; ++h)
#pragma unroll
            for (int i = 0; i < 2; ++i) vAc[h][i] = vAn[h][i];
        if constexpr (ALIGN_EPI) { if (wr == 1) PG8_BAR; }
    }
    PG8_WAIT_V(0);
    if constexpr (!ALIGN_EPI) { if (wr == 0) PG8_BAR; }
    PG8_BAR;
    if constexpr (Epi::AFTER_DRAIN) { E.fused(acc, cur, wr, wc, fr, fq, lds, wid, lane); S.done(cur); }
#undef PG8_SA
#undef PG8_SB
#undef PG8_STAGE
#undef PG8_LDA
#undef PG8_LDB
#undef PG8_MMA
#undef PG8_WAIT_V
#undef PG8_WAIT_L
#undef PG8_BAR
#undef PG8_SCHED
}
}
#define GAS __attribute__((address_space(1)))
#define LAS __attribute__((address_space(3)))
typedef unsigned short bf16;
typedef unsigned v4u __attribute__((ext_vector_type(4)));
typedef float f32x4 __attribute__((ext_vector_type(4)));
typedef short bf16x8 __attribute__((ext_vector_type(8)));
typedef GAS unsigned gu32;
typedef GAS unsigned long long gu64;
#define RLX_AGENT __ATOMIC_RELAXED, __HIP_MEMORY_SCOPE_AGENT
#define LDS_WAIT() asm volatile("s_waitcnt lgkmcnt(0)" ::: "memory")
#define VM_WAIT() asm volatile("s_waitcnt vmcnt(0)" ::: "memory")
__device__ __forceinline__ unsigned long long rt() { return __builtin_amdgcn_s_memrealtime(); }
__device__ __forceinline__ unsigned f2bf(float f) { unsigned u = __builtin_bit_cast(unsigned, f); return (u + 0x7fffu + ((u >> 16) & 1u)) >> 16; }
__device__ __forceinline__ unsigned pk2(float lo, float hi) { return f2bf(lo) | (f2bf(hi) << 16); }

#define XB_TMO      128
#define XB_XCNT(j)  (256  + 64 * (j))
#define XB_XSUB(j)  (1280 + 64 * (j))
#define XB_XGEN(j)  (2304 + 64 * (j))
#define XB_TOP      3328
#define XB_TOPGEN   3392
#define XCD_BAR_WORDS 3456
#define XB_SPIN_CAP (1u << 18)

__device__ __forceinline__ unsigned xb_ld(unsigned* p)              { return __hip_atomic_load(p, __ATOMIC_RELAXED, __HIP_MEMORY_SCOPE_AGENT); }
__device__ __forceinline__ unsigned xb_add(unsigned* p, unsigned v) { return __hip_atomic_fetch_add(p, v, __ATOMIC_RELAXED, __HIP_MEMORY_SCOPE_AGENT); }
__device__ __forceinline__ unsigned xb_xcc_id() { return (unsigned)__builtin_amdgcn_s_getreg((3 << 11) | 20) & 0xFu; }
#define XB_SPIN(cond, bar) do { unsigned _sp = 0; while (cond) { __builtin_amdgcn_s_sleep(1); \
    if ((++_sp & 255u) == 0u) { if (xb_ld(&(bar)[XB_TMO])) break; if (_sp > XB_SPIN_CAP) { atomicAdd(&(bar)[XB_TMO], 1u); break; } } } } while (0)

struct XcdBarrier {
    unsigned* bar; unsigned x;
    volatile LAS unsigned* st;
};

__device__ __forceinline__ XcdBarrier xcd_barrier_post(unsigned* bar, volatile LAS unsigned* st) {
    XcdBarrier b; b.bar = bar; b.x = xb_xcc_id(); b.st = st;
    if (threadIdx.x == 0) (void)xb_add(&bar[XB_XCNT(b.x)], 1u);
    return b;
}
__device__ __forceinline__ void xcd_barrier_complete(unsigned* bar, unsigned x, unsigned& nloc, unsigned& nx) {
    const unsigned G = gridDim.x * gridDim.y * gridDim.z;
    unsigned sum, cnt, mine, sp = 0u;
    for (;;) {
        sum = 0u; cnt = 0u; mine = 0u;
#pragma unroll
        for (unsigned j = 0; j < 16; ++j) { const unsigned c = xb_ld(&bar[XB_XCNT(j)]); sum += c; cnt += (c > 0u) ? 1u : 0u; mine = (j == x) ? c : mine; }
        if (sum == G) break;
        __builtin_amdgcn_s_sleep(1);
        if ((++sp & 255u) == 0u) { if (xb_ld(&bar[XB_TMO])) break; if (sp > XB_SPIN_CAP) { atomicAdd(&bar[XB_TMO], 1u); break; } }
    }
    nloc = mine > 0u ? mine : 1u; nx = cnt > 0u ? cnt : 1u;
}

__device__ __forceinline__ void xcd_barrier(const XcdBarrier& b) {
    asm volatile("s_waitcnt vmcnt(0)" ::: "memory");
    __syncthreads();
    if (threadIdx.x == 0) {
        unsigned* bar = b.bar;
        __builtin_amdgcn_s_waitcnt(0);
        unsigned nloc = b.st[0], nx = b.st[1];
        if (nloc == 0u) { xcd_barrier_complete(bar, b.x, nloc, nx); b.st[0] = nloc; b.st[1] = nx; }
        const unsigned old = xb_add(&bar[XB_XSUB(b.x)], 1u);
        const unsigned gen = old / nloc;
        if (old + 1u == (gen + 1u) * nloc) {
            __builtin_amdgcn_fence(__ATOMIC_RELEASE, "agent");
            asm volatile("s_waitcnt vmcnt(0)" ::: "memory");
            const unsigned og = xb_add(&bar[XB_TOP], 1u);
            const unsigned tg = og / nx;
            if (og + 1u == (tg + 1u) * nx) xb_add(&bar[XB_TOPGEN], 1u);
            else XB_SPIN(xb_ld(&bar[XB_TOPGEN]) == tg, bar);
            __builtin_amdgcn_fence(__ATOMIC_ACQUIRE, "agent");
            xb_add(&bar[XB_XGEN(b.x)], 1u);
            asm volatile("s_waitcnt vmcnt(0)" ::: "memory");
        } else {
            XB_SPIN(xb_ld(&bar[XB_XGEN(b.x)]) == gen, bar);
            __builtin_amdgcn_fence(__ATOMIC_ACQUIRE, "agent");
            asm volatile("s_waitcnt vmcnt(0)" ::: "memory");
        }
    }
    __syncthreads();
}

using pg8::bf16_t;
typedef unsigned u32x2 __attribute__((ext_vector_type(2)));
__device__ __forceinline__ float bf2f(unsigned v) { return __uint_as_float(v << 16); }
__device__ __forceinline__ float bflo(unsigned w) { return __uint_as_float(w << 16); }
__device__ __forceinline__ float bfhi(unsigned w) { return __uint_as_float(w & 0xffff0000u); }
__device__ __forceinline__ float wave_sum(float v) {
#pragma unroll
    for (int o = 1; o < 64; o <<= 1) v += __shfl_xor(v, o);
    return v;
}
__device__ __forceinline__ float sigm(float x) { return 1.0f / (1.0f + expf(-x)); }
__device__ __forceinline__ float softplusf_(float x) { return fmaxf(x, 0.f) + log1pf(expf(-fabsf(x))); }
__device__ __forceinline__ float gelu_tanh(float x) { const float y = 0.7978845608028654f * (x + 0.044715f * x * x * x);
    return x * __builtin_amdgcn_rcpf(1.0f + __builtin_amdgcn_exp2f(-2.0f * 1.4426950408889634f * y)); }

__device__ __forceinline__ int gu_rowmap(int n) { const int a = n >> 1; return ((a >> 7) << 8) + (a & 127) + ((n & 1) << 7); }
struct TDesc { const float* W; bf16* WT; int ldw, K, k0, n0, gu; float f8s; };
__device__ __forceinline__ void tload(const TDesc& d, f32x4 (&v)[16], int lane) {
#pragma unroll
    for (int i = 0; i < 16; ++i) v[i] = __builtin_nontemporal_load((const f32x4*)(d.W + (size_t)(d.k0 + 4 * i + (lane >> 4)) * d.ldw + d.n0 + 4 * (lane & 15)));
}
__device__ __forceinline__ void tstore(const TDesc& d, const f32x4 (&v)[16], LAS float* scr, int lane) {
#pragma unroll
    for (int i = 0; i < 16; ++i) { LAS float* p = scr + (4 * i + (lane >> 4)) * 65 + 4 * (lane & 15); p[0] = v[i][0]; p[1] = v[i][1]; p[2] = v[i][2]; p[3] = v[i][3]; }
    LDS_WAIT(); asm volatile("" ::: "memory");
    const int c = lane & 7;
#pragma unroll
    for (int j = 0; j < 8; ++j) { const int n = 8 * j + (lane >> 3); const LAS float* s = scr + (8 * c) * 65 + n;
        const int nr = d.gu ? gu_rowmap(d.n0 + n) : (d.n0 + n);
        if (d.f8s != 0.f) { const float f = d.f8s; int w0 = 0, w1 = 0;
            w0 = __builtin_amdgcn_cvt_pk_fp8_f32(pg8::f8clamp(s[0] * f), pg8::f8clamp(s[65] * f), w0, false); w0 = __builtin_amdgcn_cvt_pk_fp8_f32(pg8::f8clamp(s[130] * f), pg8::f8clamp(s[195] * f), w0, true);
            w1 = __builtin_amdgcn_cvt_pk_fp8_f32(pg8::f8clamp(s[260] * f), pg8::f8clamp(s[325] * f), w1, false); w1 = __builtin_amdgcn_cvt_pk_fp8_f32(pg8::f8clamp(s[390] * f), pg8::f8clamp(s[455] * f), w1, true);
            u32x2 o; o.x = (unsigned)w0; o.y = (unsigned)w1; *(u32x2*)((unsigned char*)d.WT + (size_t)nr * d.K + d.k0 + 8 * c) = o; }
        else { v4u o; o.x = pg8::cvt_pk_bf16(s[0], s[65]); o.y = pg8::cvt_pk_bf16(s[130], s[195]); o.z = pg8::cvt_pk_bf16(s[260], s[325]); o.w = pg8::cvt_pk_bf16(s[390], s[455]);
            *(v4u*)(d.WT + (size_t)nr * d.K + d.k0 + 8 * c) = o; } }
    LDS_WAIT(); asm volatile("" ::: "memory");
}
constexpr int IT_WIN = 16 * 52, IT_WOUT = 256, IT_GU = 512, IT_DN = 256;
constexpr int NIT_WIN = DEPTH * IT_WIN, NIT_WOUT = DEPTH * IT_WOUT, NIT_GU = DEPTH * NE * IT_GU, NIT_DN = DEPTH * NE * IT_DN, NITEMS = NIT_WIN + NIT_WOUT + NIT_GU + NIT_DN;

__device__ __forceinline__ void stage_dtw(const float* win_l, LAS float* dtw, int tid) {
    for (int k = tid; k < DM; k += NTHR) *(LAS f32x4*)(dtw + 4 * k) = *(const f32x4*)(win_l + (size_t)k * DIN + C_DT);
    __syncthreads();
}
__device__ __forceinline__ void emit_xn_dt(const f32x4 (&v)[4], const float* g, const LAS float* dtw, bf16* xn_row, float* dt_row, int lane) {
    float ss = 0.f;
#pragma unroll
    for (int j = 0; j < 4; ++j) ss += (v[j][0] * v[j][0] + v[j][1] * v[j][1]) + (v[j][2] * v[j][2] + v[j][3] * v[j][3]);
    ss = wave_sum(ss);
    const float rstd = 1.0f / sqrtf(ss * (1.0f / DM) + EPS);
    float d0 = 0.f, d1 = 0.f, d2 = 0.f, d3 = 0.f;
#pragma unroll
    for (int j = 0; j < 4; ++j) { const int col = 256 * j + 4 * lane; const f32x4 gg = *(const f32x4*)(g + col); const f32x4 u = v[j] * rstd * gg;
        u32x2 w; w.x = pk2(u[0], u[1]); w.y = pk2(u[2], u[3]); *(u32x2*)(xn_row + col) = w;
#pragma unroll
        for (int i = 0; i < 4; ++i) { const f32x4 ww = *(const LAS f32x4*)(dtw + 4 * (col + i)); d0 += u[i] * ww[0]; d1 += u[i] * ww[1]; d2 += u[i] * ww[2]; d3 += u[i] * ww[3]; } }
    d0 = wave_sum(d0); d1 = wave_sum(d1); d2 = wave_sum(d2); d3 = wave_sum(d3);
    if (lane == 0) *(f32x4*)dt_row = (f32x4){d0, d1, d2, d3};
}

__device__ __forceinline__ void norm_rows4(const float* orow, const bf16* prow, bf16* mrow, const float* gA, const float* gB, const float* gC, const float* gD, int lane) {
    const int c = 4 * lane;
    f32x4 v[4][4]; u32x2 gw[4];
#pragma unroll
    for (int r = 0; r < 4; ++r) {
#pragma unroll
        for (int j = 0; j < 4; ++j) v[r][j] = *(const f32x4*)(orow + (size_t)r * DM + 256 * j + c);
        gw[r] = *(const u32x2*)(prow + (size_t)r * DING + C_HGG + c); }
    const f32x4 g0 = *(const f32x4*)(gA + c), g1 = *(const f32x4*)(gB + c), g2 = *(const f32x4*)(gC + c), g3 = *(const f32x4*)(gD + c);
#pragma unroll
    for (int r = 0; r < 4; ++r) {
        float s[4];
#pragma unroll
        for (int j = 0; j < 4; ++j) s[j] = (v[r][j][0] * v[r][j][0] + v[r][j][1] * v[r][j][1]) + (v[r][j][2] * v[r][j][2] + v[r][j][3] * v[r][j][3]);
#pragma unroll
        for (int o = 1; o < 64; o <<= 1) { s[0] += __shfl_xor(s[0], o); s[1] += __shfl_xor(s[1], o); if (o < 16) s[2] += __shfl_xor(s[2], o); if (o < 32) s[3] += __shfl_xor(s[3], o); }
        const float r0 = 1.0f / sqrtf(s[0] * (1.0f / 256) + EPS), r1 = 1.0f / sqrtf(s[1] * (1.0f / 256) + EPS), r2 = 1.0f / sqrtf(s[2] * (1.0f / 64) + EPS), r3 = 1.0f / sqrtf(s[3] * (1.0f / 128) + EPS);
        const float gi[4] = {bflo(gw[r].x), bfhi(gw[r].x), bflo(gw[r].y), bfhi(gw[r].y)};
        f32x4 o0 = v[r][0] * r0 * g0, o1 = v[r][1] * r1 * g1, o2 = v[r][2] * r2 * g2, o3 = v[r][3] * r3 * g3;
#pragma unroll
        for (int i = 0; i < 4; ++i) o2[i] *= gi[i] * sigm(gi[i]);
        bf16* mr = mrow + (size_t)r * DM; u32x2 w;
        w.x = pk2(o0[0], o0[1]); w.y = pk2(o0[2], o0[3]); *(u32x2*)(mr + c) = w;
        w.x = pk2(o1[0], o1[1]); w.y = pk2(o1[2], o1[3]); *(u32x2*)(mr + 256 + c) = w;
        w.x = pk2(o2[0], o2[1]); w.y = pk2(o2[2], o2[3]); *(u32x2*)(mr + 512 + c) = w;
        w.x = pk2(o3[0], o3[1]); w.y = pk2(o3[2], o3[3]); *(u32x2*)(mr + 768 + c) = w; }
}

__device__ __forceinline__ void build_tb(const int* tot, LAS int* tb, int tid) {
    if (tid == 0) { int run = 0; for (int e = 0; e < 32; ++e) { tb[e] = run; run += (tot[e] + 255) >> 8; } tb[32] = run; }
    __syncthreads();
}

typedef short s16x4 __attribute__((ext_vector_type(4)));
typedef short v4i16_t __attribute__((ext_vector_type(4)));
#define MFMA16(a, b, c) __builtin_amdgcn_mfma_f32_16x16x32_bf16((a), (b), (c), 0, 0, 0)
__device__ __forceinline__ bf16x8 frag_kc(const LAS bf16* M, int ld, int idx0, int k0, int lane) { return *(const LAS bf16x8*)(M + (idx0 + (lane & 15)) * ld + k0 + 8 * (lane >> 4)); }
__device__ __forceinline__ bf16x8 frag_ks(const LAS bf16* M, int ld, int idx0, int k0, int lane) {
    const LAS bf16* p = M + (k0 + 8 * (lane >> 4) + ((lane & 15) >> 2)) * ld + idx0 + 4 * (lane & 3);
    const s16x4 lo = __builtin_bit_cast(s16x4, __builtin_amdgcn_ds_read_tr16_b64_v4i16((LAS v4i16_t*)p));
    const s16x4 hi = __builtin_bit_cast(s16x4, __builtin_amdgcn_ds_read_tr16_b64_v4i16((LAS v4i16_t*)(p + 4 * ld)));
    return (bf16x8){lo[0], lo[1], lo[2], lo[3], hi[0], hi[1], hi[2], hi[3]};
}
__device__ __forceinline__ bf16x8 frag_g32(const float* M, int ld, int idx0, int k0, int lane) {
    const float* p = M + (size_t)(idx0 + (lane & 15)) * ld + k0 + 8 * (lane >> 4);
    const f32x4 a = *(const f32x4*)p, b = *(const f32x4*)(p + 4);
    v4u w; w.x = pk2(a[0], a[1]); w.y = pk2(a[2], a[3]); w.z = pk2(b[0], b[1]); w.w = pk2(b[2], b[3]);
    return __builtin_bit_cast(bf16x8, w);
}
__device__ __forceinline__ float fsigm(float x) { return __builtin_amdgcn_rcpf(1.0f + __builtin_amdgcn_exp2f(-1.4426950408889634f * x)); }
__device__ __forceinline__ float fexp(float x) { return __builtin_amdgcn_exp2f(1.4426950408889634f * x); }

constexpr int M2LD = 136, M2WLD = 72;
__device__ __forceinline__ void m2_conv_block(const bf16* proj, const float* cw, const float* cb, int b, int t0, int tq, int cc0, float (&o)[8][8]) {
    v4u x[11]; f32x4 w[4][2];
    const int ts0 = t0 + 8 * tq - 3;
#pragma unroll
    for (int r = 0; r < 11; ++r) { const int ts = ts0 + r; x[r] = (v4u){0u, 0u, 0u, 0u}; if (ts >= 0) x[r] = *(const v4u*)(proj + ((size_t)b * SEQ + ts) * DING + C_M2X + cc0); }
#pragma unroll
    for (int k = 0; k < 4; ++k) { w[k][0] = *(const f32x4*)(cw + k * 768 + cc0); w[k][1] = *(const f32x4*)(cw + k * 768 + cc0 + 4); }
    const f32x4 b0 = *(const f32x4*)(cb + cc0), b1 = *(const f32x4*)(cb + cc0 + 4);
#pragma unroll
    for (int j = 0; j < 8; ++j) { float a[8] = {b0[0], b0[1], b0[2], b0[3], b1[0], b1[1], b1[2], b1[3]};
#pragma unroll
        for (int k = 0; k < 4; ++k) { const v4u xv = x[j + k];
            a[0] += w[k][0][0] * bflo(xv[0]); a[1] += w[k][0][1] * bfhi(xv[0]); a[2] += w[k][0][2] * bflo(xv[1]); a[3] += w[k][0][3] * bfhi(xv[1]);
            a[4] += w[k][1][0] * bflo(xv[2]); a[5] += w[k][1][1] * bfhi(xv[2]); a[6] += w[k][1][2] * bflo(xv[3]); a[7] += w[k][1][3] * bfhi(xv[3]); }
#pragma unroll
        for (int i = 0; i < 8; ++i) o[j][i] = a[i] * fsigm(a[i]); }
}
__device__ __forceinline__ void m2_dt_scan(const float* dtraw, const float* dt_bias, const float* a_log, int b, int t0, int g, LAS float* dt_s, LAS float* acs_s, LAS float* w_s, float* dec_out, int tid) {
    if (tid >= 384) { const int hh = (tid - 384) >> 6, t = tid & 63, h = 2 * g + hh;
        const float dtv = softplusf_(dtraw[((size_t)b * SEQ + t0 + t) * 4 + h] + dt_bias[h]);
        float v = dtv * (-expf(a_log[h]));
#pragma unroll
        for (int o = 1; o < 64; o <<= 1) { const float nb = __shfl_up(v, o); if (t >= o) v += nb; }
        const float last = __shfl(v, 63);
        dt_s[hh * 64 + t] = dtv; acs_s[hh * 64 + t] = v; w_s[hh * 64 + t] = expf(last - v) * dtv;
        if (dec_out && t == 63) dec_out[h] = expf(last); }
}
__device__ __forceinline__ void m2_state_unit(const bf16* proj, const float* dtraw, float* sloc, float* dec, int b, int ch, int g, const float* cw, const float* cb, const float* dt_bias, const float* a_log, LAS unsigned char* lds, int tid) {
    LAS bf16* XS = (LAS bf16*)lds; LAS bf16* BS = XS + 64 * M2LD; LAS float* dt_s = (LAS float*)(BS + 64 * M2LD); LAS float* acs_s = dt_s + 128; LAS float* w_s = acs_s + 128;
    const int lane = tid & 63, w = tid >> 6, t0 = ch * 64;
    m2_dt_scan(dtraw, dt_bias, a_log, b, t0, g, dt_s, acs_s, w_s, dec + (size_t)(b * 32 + ch) * 4, tid);
    float o[8][8]; const int cg = tid & 31, tq = tid >> 5;
    if (tid < 256) m2_conv_block(proj, cw, cb, b, t0, tq, cg < 16 ? g * 128 + 8 * cg : 256 + g * 128 + 8 * (cg - 16), o);
    __syncthreads();
    if (tid < 256) {
#pragma unroll
        for (int j = 0; j < 8; ++j) { const int t = 8 * tq + j; const float sc = cg < 16 ? w_s[(cg >> 3) * 64 + t] : 1.0f;
            v4u q; q.x = pk2(o[j][0] * sc, o[j][1] * sc); q.y = pk2(o[j][2] * sc, o[j][3] * sc); q.z = pk2(o[j][4] * sc, o[j][5] * sc); q.w = pk2(o[j][6] * sc, o[j][7] * sc);
            *(LAS v4u*)((cg < 16 ? XS + 8 * cg : BS + 8 * (cg - 16)) + t * M2LD) = q; } }
    __syncthreads();
    { const int hh = w >> 2, mi = w & 3;
        const bf16x8 a0 = frag_ks(XS, M2LD, hh * 64 + mi * 16, 0, lane), a1 = frag_ks(XS, M2LD, hh * 64 + mi * 16, 32, lane);
        float* outp = sloc + ((size_t)((b * 32 + ch) * 4 + 2 * g + hh) * 64 + mi * 16 + 4 * (lane >> 4)) * 128 + (lane & 15);
#pragma unroll
        for (int ni = 0; ni < 8; ++ni) { const bf16x8 b0 = frag_ks(BS, M2LD, ni * 16, 0, lane), b1 = frag_ks(BS, M2LD, ni * 16, 32, lane);
            f32x4 acc = {0.f, 0.f, 0.f, 0.f}; acc = MFMA16(a0, b0, acc); acc = MFMA16(a1, b1, acc);
#pragma unroll
            for (int i = 0; i < 4; ++i) outp[i * 128 + ni * 16] = acc[i]; } }
    __syncthreads();
}
__device__ __forceinline__ void m2_out_unit(const bf16* proj, const float* dtraw, const bf16* prevb, float* oraw, int b, int ch, int g, const float* cw, const float* cb, const float* dt_bias, const float* a_log, const float* dskip, LAS unsigned char* lds, int tid) {
    LAS bf16* XS = (LAS bf16*)lds; LAS bf16* BS = XS + 64 * M2LD; LAS bf16* CS = BS + 64 * M2LD; LAS bf16* WS = CS + 64 * M2LD;
    LAS float* dt_s = (LAS float*)(WS + 2 * 64 * M2WLD); LAS float* acs_s = dt_s + 128; LAS float* w_s = acs_s + 128;
    const int lane = tid & 63, w = tid >> 6, t0 = ch * 64;
    bf16x8 pf[4][4];
    { const bf16* pv = prevb + (size_t)((b * 32 + ch) * 4 + 2 * g + (w >> 2)) * 64 * 128;
#pragma unroll
        for (int kk = 0; kk < 4; ++kk)
#pragma unroll
            for (int ni = 0; ni < 4; ++ni) pf[kk][ni] = *(const bf16x8*)(pv + (size_t)(ni * 16 + (lane & 15)) * 128 + 32 * kk + 8 * (lane >> 4)); }
    m2_dt_scan(dtraw, dt_bias, a_log, b, t0, g, dt_s, acs_s, w_s, nullptr, tid);
    if (tid < 384) { float o[8][8]; const int cg = tid % 48, tq = tid / 48;
        const int cc0 = cg < 16 ? g * 128 + 8 * cg : cg < 32 ? 256 + g * 128 + 8 * (cg - 16) : 512 + g * 128 + 8 * (cg - 32);
        m2_conv_block(proj, cw, cb, b, t0, tq, cc0, o);
        LAS bf16* dst = cg < 16 ? XS + 8 * cg : cg < 32 ? BS + 8 * (cg - 16) : CS + 8 * (cg - 32);
#pragma unroll
        for (int j = 0; j < 8; ++j) { v4u q; q.x = pk2(o[j][0], o[j][1]); q.y = pk2(o[j][2], o[j][3]); q.z = pk2(o[j][4], o[j][5]); q.w = pk2(o[j][6], o[j][7]); *(LAS v4u*)(dst + (8 * tq + j) * M2LD) = q; } }
    __syncthreads();
    { const int mi = w >> 1, ni0 = (w & 1) * 2;
        f32x4 acc[2] = {{0.f, 0.f, 0.f, 0.f}, {0.f, 0.f, 0.f, 0.f}};
#pragma unroll
        for (int kk = 0; kk < 4; ++kk) { const bf16x8 a = frag_kc(CS, M2LD, mi * 16, 32 * kk, lane);
#pragma unroll
            for (int q = 0; q < 2; ++q) { const bf16x8 bb = frag_kc(BS, M2LD, (ni0 + q) * 16, 32 * kk, lane); acc[q] = MFMA16(a, bb, acc[q]); } }
#pragma unroll
        for (int q = 0; q < 2; ++q) { const int s = (ni0 + q) * 16 + (lane & 15);
#pragma unroll
            for (int hh = 0; hh < 2; ++hh) { const float as = acs_s[hh * 64 + s], ds = dt_s[hh * 64 + s];
#pragma unroll
                for (int i = 0; i < 4; ++i) { const int l = mi * 16 + 4 * (lane >> 4) + i;
                    const float v = (s <= l) ? acc[q][i] * fexp(acs_s[hh * 64 + l] - as) * ds : 0.f;
                    WS[(hh * 64 + l) * M2WLD + s] = (bf16)f2bf(v); } } } }
    __syncthreads();
    { const int hh = w >> 2, mi = w & 3, h = 2 * g + hh;
        f32x4 yd[4], yo[4];
#pragma unroll
        for (int ni = 0; ni < 4; ++ni) { yd[ni] = (f32x4){0.f, 0.f, 0.f, 0.f}; yo[ni] = (f32x4){0.f, 0.f, 0.f, 0.f}; }
#pragma unroll
        for (int kk = 0; kk < 2; ++kk) { const bf16x8 a = frag_kc(WS + hh * 64 * M2WLD, M2WLD, mi * 16, 32 * kk, lane);
#pragma unroll
            for (int ni = 0; ni < 4; ++ni) { const bf16x8 bb = frag_ks(XS, M2LD, hh * 64 + ni * 16, 32 * kk, lane); yd[ni] = MFMA16(a, bb, yd[ni]); } }
#pragma unroll
        for (int kk = 0; kk < 4; ++kk) { const bf16x8 a = frag_kc(CS, M2LD, mi * 16, 32 * kk, lane);
#pragma unroll
            for (int ni = 0; ni < 4; ++ni) yo[ni] = MFMA16(a, pf[kk][ni], yo[ni]); }
        const float Dh = dskip[h];
#pragma unroll
        for (int i = 0; i < 4; ++i) { const int l = mi * 16 + 4 * (lane >> 4) + i; const float ea = fexp(acs_s[hh * 64 + l]); const size_t row = (size_t)b * SEQ + t0 + l;
#pragma unroll
            for (int ni = 0; ni < 4; ++ni) { const int p = ni * 16 + (lane & 15);
                const float xv = bf2f(XS[l * M2LD + hh * 64 + p]), zv = bf2f(proj[row * DING + C_M2Z + h * 64 + p]);
                const float y = yd[ni][i] + ea * yo[ni][i] + xv * Dh;
                oraw[row * DM + 768 + h * 64 + p] = y * (zv * fsigm(zv)); } } }
    __syncthreads();
}

constexpr int HGLD = 136, HGWLD = 72;
template <bool WITH_Q>
__device__ __forceinline__ void hg_prep(const bf16* proj, int b, int t0, int hp, const float* lb1, int layer, LAS float* bc_s, LAS bf16* QS, LAS bf16* KS, LAS bf16* VS, LAS bf16* Q2, int tid) {
    const int c0 = (tid & 15) * 8, ta = tid >> 4;
    float lb[8];
#pragma unroll
    for (int i = 0; i < 8; ++i) lb[i] = 0.f;
    if (layer == 1) { const f32x4 l0 = *(const f32x4*)(lb1 + hp * 128 + c0), l1 = *(const f32x4*)(lb1 + hp * 128 + c0 + 4); lb[0] = l0[0]; lb[1] = l0[1]; lb[2] = l0[2]; lb[3] = l0[3]; lb[4] = l1[0]; lb[5] = l1[1]; lb[6] = l1[2]; lb[7] = l1[3]; }
    v4u fw[2], iw[2], qw[2];
#pragma unroll
    for (int u = 0; u < 2; ++u) { const size_t row = (size_t)b * SEQ + t0 + ta + 32 * u;
        fw[u] = *(const v4u*)(proj + row * DING + C_HGF + hp * 128 + c0); iw[u] = *(const v4u*)(proj + row * DING + C_HGI + hp * 128 + c0);
        if (WITH_Q) qw[u] = *(const v4u*)(proj + row * DING + C_HGQ + hp * 128 + c0); }
    float key[2][8];
#pragma unroll
    for (int u = 0; u < 2; ++u) { const int t = ta + 32 * u;
        const float f[8] = {bflo(fw[u][0]), bfhi(fw[u][0]), bflo(fw[u][1]), bfhi(fw[u][1]), bflo(fw[u][2]), bfhi(fw[u][2]), bflo(fw[u][3]), bfhi(fw[u][3])};
        float lf[8];
#pragma unroll
        for (int i = 0; i < 8; ++i) { const float sg = fsigm(f[i]); lf[i] = __builtin_amdgcn_logf(lb[i] + (1.0f - lb[i]) * sg) * 0.6931471805599453f; key[u][i] = (1.0f - lb[i]) * (1.0f - sg); }
        *(LAS f32x4*)(bc_s + t * 128 + c0) = (f32x4){lf[0], lf[1], lf[2], lf[3]}; *(LAS f32x4*)(bc_s + t * 128 + c0 + 4) = (f32x4){lf[4], lf[5], lf[6], lf[7]};
        *(LAS v4u*)(VS + t * HGLD + c0) = iw[u]; }
    __syncthreads();
    if (tid < 128) { float run = 0.f;
#pragma unroll 8
        for (int t = 0; t < 64; ++t) { run += bc_s[t * 128 + tid]; bc_s[t * 128 + tid] = run; } }
    __syncthreads();
    const f32x4 m0 = *(const LAS f32x4*)(bc_s + 31 * 128 + c0), m1 = *(const LAS f32x4*)(bc_s + 31 * 128 + c0 + 4);
    const float b31[8] = {m0[0], m0[1], m0[2], m0[3], m1[0], m1[1], m1[2], m1[3]};
#pragma unroll
    for (int u = 0; u < 2; ++u) { const int t = ta + 32 * u;
        const f32x4 x0 = *(const LAS f32x4*)(bc_s + t * 128 + c0), x1 = *(const LAS f32x4*)(bc_s + t * 128 + c0 + 4);
        const float bc[8] = {x0[0], x0[1], x0[2], x0[3], x1[0], x1[1], x1[2], x1[3]};
        float kk[8], qq[8], q2[8];
#pragma unroll
        for (int i = 0; i < 8; ++i) { const float d = b31[i] - bc[i]; kk[i] = key[u][i] * fexp(fminf(d, 60.0f));
            if (WITH_Q) { const float qv = (i & 1) ? bfhi(qw[u][i >> 1]) : bflo(qw[u][i >> 1]); const float qs = qv * fsigm(qv); qq[i] = qs * fexp(fminf(-d, 60.0f)); q2[i] = qs * fexp(bc[i]); } }
        v4u o; o.x = pk2(kk[0], kk[1]); o.y = pk2(kk[2], kk[3]); o.z = pk2(kk[4], kk[5]); o.w = pk2(kk[6], kk[7]); *(LAS v4u*)(KS + t * HGLD + c0) = o;
        if (WITH_Q) { o.x = pk2(qq[0], qq[1]); o.y = pk2(qq[2], qq[3]); o.z = pk2(qq[4], qq[5]); o.w = pk2(qq[6], qq[7]); *(LAS v4u*)(QS + t * HGLD + c0) = o;
            o.x = pk2(q2[0], q2[1]); o.y = pk2(q2[2], q2[3]); o.z = pk2(q2[4], q2[5]); o.w = pk2(q2[6], q2[7]); *(LAS v4u*)(Q2 + t * HGLD + c0) = o; } }
    __syncthreads();
}
__device__ __forceinline__ void hg_state_unit(const bf16* proj, float* slt, float* decc, int b, int ch, int hp, const float* lbp, int layer, LAS unsigned char* lds, int tid) {
    LAS float* bc_s = (LAS float*)lds; LAS bf16* KS = (LAS bf16*)(lds + 32768); LAS bf16* VS = KS + 64 * HGLD;
    const int lane = tid & 63, w = tid >> 6;
    hg_prep<false>(proj, b, ch * 64, hp, lbp, layer, bc_s, nullptr, KS, VS, nullptr, tid);
    if (tid < 128) decc[(size_t)((b * 32 + ch) * 4 + 2 * hp) * 64 + tid] = fexp(bc_s[63 * 128 + tid]);
    { const int hh = w >> 2, mi = w & 3, h = 2 * hp + hh;
        const bf16x8 a0 = frag_ks(VS, HGLD, hh * 64 + mi * 16, 0, lane), a1 = frag_ks(VS, HGLD, hh * 64 + mi * 16, 32, lane);
        float* outp = slt + ((size_t)((b * 32 + ch) * 4 + h) * 64 + mi * 16 + 4 * (lane >> 4)) * 64 + (lane & 15);
#pragma unroll
        for (int ni = 0; ni < 4; ++ni) { const bf16x8 b0 = frag_ks(KS, HGLD, hh * 64 + ni * 16, 0, lane), b1 = frag_ks(KS, HGLD, hh * 64 + ni * 16, 32, lane);
            f32x4 acc = {0.f, 0.f, 0.f, 0.f}; acc = MFMA16(a0, b0, acc); acc = MFMA16(a1, b1, acc);
            const int c = hh * 64 + ni * 16 + (lane & 15); const float sc = fexp(bc_s[63 * 128 + c] - bc_s[31 * 128 + c]);
#pragma unroll
            for (int i = 0; i < 4; ++i) outp[i * 64 + ni * 16] = acc[i] * sc; } }
    __syncthreads();
}
__device__ __forceinline__ void hg_out_unit(const bf16* proj, const bf16* stb, float* oraw, int b, int ch, int hp, const float* lbp, int layer, LAS unsigned char* lds, int tid) {
    LAS float* bc_s = (LAS float*)lds; LAS bf16* KS = (LAS bf16*)(lds + 32768); LAS bf16* VS = KS + 64 * HGLD; LAS bf16* QS = VS + 64 * HGLD; LAS bf16* WS = QS + 64 * HGLD; LAS bf16* Q2 = WS + 2 * 64 * HGWLD;
    const int lane = tid & 63, w = tid >> 6, t0 = ch * 64;
    const int hh = w >> 2, mi = w & 3, h = 2 * hp + hh;
    bf16x8 sf[2][4];
    { const bf16* st = stb + (size_t)((b * 32 + ch) * 4 + h) * 64 * 64;
#pragma unroll
        for (int kk = 0; kk < 2; ++kk)
#pragma unroll
            for (int ni = 0; ni < 4; ++ni) sf[kk][ni] = *(const bf16x8*)(st + (size_t)(ni * 16 + (lane & 15)) * 64 + 32 * kk + 8 * (lane >> 4)); }
    hg_prep<true>(proj, b, t0, hp, lbp, layer, bc_s, QS, KS, VS, Q2, tid);
    { f32x4 sc[4];
#pragma unroll
        for (int ni = 0; ni < 4; ++ni) sc[ni] = (f32x4){0.f, 0.f, 0.f, 0.f};
#pragma unroll
        for (int kk = 0; kk < 2; ++kk) { const bf16x8 a = frag_kc(QS, HGLD, mi * 16, hh * 64 + 32 * kk, lane);
#pragma unroll
            for (int ni = 0; ni < 4; ++ni) { const bf16x8 bb = frag_kc(KS, HGLD, ni * 16, hh * 64 + 32 * kk, lane); sc[ni] = MFMA16(a, bb, sc[ni]); } }
#pragma unroll
        for (int ni = 0; ni < 4; ++ni) { const int s = ni * 16 + (lane & 15);
#pragma unroll
            for (int i = 0; i < 4; ++i) { const int t = mi * 16 + 4 * (lane >> 4) + i; WS[(hh * 64 + t) * HGWLD + s] = (bf16)f2bf(s <= t ? sc[ni][i] : 0.f); } } }
    __syncthreads();
    { f32x4 o[4];
#pragma unroll
        for (int ni = 0; ni < 4; ++ni) o[ni] = (f32x4){0.f, 0.f, 0.f, 0.f};
#pragma unroll
        for (int kk = 0; kk < 2; ++kk) { const bf16x8 a = frag_kc(WS + hh * 64 * HGWLD, HGWLD, mi * 16, 32 * kk, lane);
#pragma unroll
            for (int ni = 0; ni < 4; ++ni) { const bf16x8 bb = frag_ks(VS, HGLD, hh * 64 + ni * 16, 32 * kk, lane); o[ni] = MFMA16(a, bb, o[ni]); } }
#pragma unroll
        for (int kk = 0; kk < 2; ++kk) { const bf16x8 a = frag_kc(Q2, HGLD, mi * 16, hh * 64 + 32 * kk, lane);
#pragma unroll
            for (int ni = 0; ni < 4; ++ni) o[ni] = MFMA16(a, sf[kk][ni], o[ni]); }
#pragma unroll
        for (int i = 0; i < 4; ++i) { const size_t row = (size_t)b * SEQ + t0 + mi * 16 + 4 * (lane >> 4) + i;
#pragma unroll
            for (int ni = 0; ni < 4; ++ni) oraw[row * DM + 512 + h * 64 + ni * 16 + (lane & 15)] = o[ni][i]; } }
    __syncthreads();
}

constexpr int RGLD = 136;
__device__ __forceinline__ void rg_local_unit(const bf16* proj, float* hloc, float* pcum, float* rgs, int b, int ch, int half, const float* conv_w, const float* conv_b, const bf16* waT, const bf16* wxT,
                                              const float* ba, const float* bx, const float* lam, LAS unsigned char* lds, int tid) {
    LAS float* xc32 = (LAS float*)lds; LAS float* a_s = xc32 + 64 * 128; LAS bf16* xcb = (LAS bf16*)(a_s + 64 * 128); LAS float* par = (LAS float*)(xcb + 64 * RGLD);
    const int lane = tid & 63, w = tid >> 6, t0 = ch * 64, cg0 = half * 128;
    if (tid < 128) { par[tid] = ba[cg0 + tid]; par[128 + tid] = bx[cg0 + tid]; par[256 + tid] = softplusf_(-lam[cg0 + tid]); }
    { const int c0 = (tid & 15) * 8, cg = cg0 + c0, tp = tid >> 4;
        v4u x[5]; f32x4 wk[4][2];
#pragma unroll
        for (int r = 0; r < 5; ++r) { const int ts = t0 + 2 * tp - 3 + r; x[r] = (v4u){0u, 0u, 0u, 0u}; if (ts >= 0) x[r] = *(const v4u*)(proj + ((size_t)b * SEQ + ts) * DING + C_RGX + cg); }
#pragma unroll
        for (int k = 0; k < 4; ++k) { wk[k][0] = *(const f32x4*)(conv_w + k * 256 + cg); wk[k][1] = *(const f32x4*)(conv_w + k * 256 + cg + 4); }
        const f32x4 b0 = *(const f32x4*)(conv_b + cg), b1 = *(const f32x4*)(conv_b + cg + 4);
#pragma unroll
        for (int j = 0; j < 2; ++j) { const int t = 2 * tp + j; float o[8] = {b0[0], b0[1], b0[2], b0[3], b1[0], b1[1], b1[2], b1[3]};
#pragma unroll
            for (int k = 0; k < 4; ++k) { const v4u xv = x[j + k];
                o[0] += wk[k][0][0] * bflo(xv[0]); o[1] += wk[k][0][1] * bfhi(xv[0]); o[2] += wk[k][0][2] * bflo(xv[1]); o[3] += wk[k][0][3] * bfhi(xv[1]);
                o[4] += wk[k][1][0] * bflo(xv[2]); o[5] += wk[k][1][1] * bfhi(xv[2]); o[6] += wk[k][1][2] * bflo(xv[3]); o[7] += wk[k][1][3] * bfhi(xv[3]); }
            *(LAS f32x4*)(xc32 + t * 128 + c0) = (f32x4){o[0], o[1], o[2], o[3]}; *(LAS f32x4*)(xc32 + t * 128 + c0 + 4) = (f32x4){o[4], o[5], o[6], o[7]};
            v4u q; q.x = pk2(o[0], o[1]); q.y = pk2(o[2], o[3]); q.z = pk2(o[4], o[5]); q.w = pk2(o[6], o[7]); *(LAS v4u*)(xcb + t * RGLD + c0) = q; } }
    __syncthreads();
    { const int nb = w >> 2, mi = w & 3, n = 2 * half + nb;
        f32x4 ra[4], ga[4];
#pragma unroll
        for (int ni = 0; ni < 4; ++ni) { ra[ni] = (f32x4){0.f, 0.f, 0.f, 0.f}; ga[ni] = (f32x4){0.f, 0.f, 0.f, 0.f}; }
#pragma unroll
        for (int kk = 0; kk < 2; ++kk) { const bf16x8 a = frag_kc(xcb, RGLD, mi * 16, nb * 64 + 32 * kk, lane);
#pragma unroll
            for (int ni = 0; ni < 4; ++ni) { const size_t off = (size_t)(n * 64 + ni * 16 + (lane & 15)) * 64 + 32 * kk + 8 * (lane >> 4);
                ra[ni] = MFMA16(a, *(const bf16x8*)(waT + off), ra[ni]); ga[ni] = MFMA16(a, *(const bf16x8*)(wxT + off), ga[ni]); } }
#pragma unroll
        for (int ni = 0; ni < 4; ++ni) { const int c = nb * 64 + ni * 16 + (lane & 15); const float bav = par[c], bxv = par[128 + c], spl = par[256 + c];
#pragma unroll
            for (int i = 0; i < 4; ++i) { const int t = mi * 16 + 4 * (lane >> 4) + i;
                const float r = fsigm(ra[ni][i] + bav), ig = fsigm(ga[ni][i] + bxv), log_a = -8.0f * r * spl, x2 = 2.0f * log_a;
                const float em1 = x2 > -0.25f ? -x2 * (1.0f + x2 * (0.5f + x2 * (0.16666667f + x2 * (0.041666668f + x2 * 0.0083333338f)))) : 1.0f - fexp(x2);
                float mult = __builtin_amdgcn_sqrtf(em1); if (t0 + t == 0) mult = 1.0f;
                a_s[t * 128 + c] = fexp(log_a); xc32[t * 128 + c] = mult * ig * xc32[t * 128 + c]; } } }
    __syncthreads();
    if (tid < 128) { float h = 0.f, P = 1.f; const size_t base = ((size_t)b * SEQ + t0) * 256 + cg0 + tid;
#pragma unroll 8
        for (int t = 0; t < 64; ++t) { const float a = a_s[t * 128 + tid]; h = a * h + xc32[t * 128 + tid]; P *= a; hloc[base + (size_t)t * 256] = h; pcum[base + (size_t)t * 256] = P; }
        rgs[((size_t)(b * 32 + ch) * 256 + cg0 + tid) * 2] = P; rgs[((size_t)(b * 32 + ch) * 256 + cg0 + tid) * 2 + 1] = h; }
    __syncthreads();
}

typedef float f32x16 __attribute__((ext_vector_type(16)));
#define MFMA32(a, b, c) __builtin_amdgcn_mfma_f32_32x32x16_bf16((a), (b), (c), 0, 0, 0)
constexpr int AVLD = 72;
__device__ __forceinline__ bf16x8 pack8(const f32x16& x, int o) {
    v4u w; w.x = pg8::cvt_pk_bf16(x[o], x[o + 1]); w.y = pg8::cvt_pk_bf16(x[o + 2], x[o + 3]); w.z = pg8::cvt_pk_bf16(x[o + 4], x[o + 5]); w.w = pg8::cvt_pk_bf16(x[o + 6], x[o + 7]);
    return __builtin_bit_cast(bf16x8, w);
}
__device__ __forceinline__ float lk2(float z) { return -(fmaxf(z, 0.f) + __builtin_amdgcn_logf(1.0f + __builtin_amdgcn_exp2f(-fabsf(z)))); }
__device__ __forceinline__ void attn_unit(const bf16* proj, float* oraw, int b, int h, int qb, LAS bf16* KL, LAS bf16* VL, int lane) {
    const int q = lane & 31, h2 = lane >> 5, qw = qb * 32; const size_t rowb = (size_t)b * SEQ;
    bf16x8 qf[4];
    { const bf16* qp = proj + (rowb + qw + q) * DING + C_SBQ + h * 64 + 8 * h2; const float C2 = 0.125f * 1.4426950408889634f;
#pragma unroll
        for (int kk = 0; kk < 4; ++kk) { const v4u w = *(const v4u*)(qp + 16 * kk); v4u o;
            o.x = pg8::cvt_pk_bf16(bflo(w.x) * C2, bfhi(w.x) * C2); o.y = pg8::cvt_pk_bf16(bflo(w.y) * C2, bfhi(w.y) * C2); o.z = pg8::cvt_pk_bf16(bflo(w.z) * C2, bfhi(w.z) * C2); o.w = pg8::cvt_pk_bf16(bflo(w.w) * C2, bfhi(w.w) * C2);
            qf[kk] = __builtin_bit_cast(bf16x8, o); } }
    bf16x8 m0[2], ones;
#pragma unroll
    for (int s = 0; s < 2; ++s) {
#pragma unroll
        for (int jj = 0; jj < 8; ++jj) { const int j = 16 * s + 8 * (jj >> 2) + 4 * h2 + (jj & 3); m0[s][jj] = (short)(j >= q ? 0x3F80 : 0); } }
#pragma unroll
    for (int jj = 0; jj < 8; ++jj) ones[jj] = (short)0x3F80;
    f32x16 o0, o1;
#pragma unroll
    for (int r = 0; r < 16; ++r) { o0[r] = 0.f; o1[r] = 0.f; }
    float R = 0.f;
    const int sd = (qw >> 6) << 6;
    v4u kr[8];
#pragma unroll
    for (int i = 0; i < 8; ++i) kr[i] = *(const v4u*)(proj + (rowb + sd + (lane >> 3) + 8 * i) * DING + C_SBK + h * 64 + 8 * (lane & 7));
    for (int s0 = sd; s0 >= 0; s0 -= 64) {
#pragma unroll
        for (int i = 0; i < 8; ++i) { const int row = (lane >> 3) + 8 * i; *(LAS v4u*)(KL + row * 64 + 8 * ((lane & 7) ^ (row & 7))) = kr[i]; }
        { const int sn = s0 >= 64 ? s0 - 64 : s0;
#pragma unroll
            for (int i = 0; i < 8; ++i) kr[i] = *(const v4u*)(proj + (rowb + sn + (lane >> 3) + 8 * i) * DING + C_SBK + h * 64 + 8 * (lane & 7)); }
        bf16x8 kf[2][4];
#pragma unroll
        for (int hf = 0; hf < 2; ++hf)
#pragma unroll
            for (int kk = 0; kk < 4; ++kk) { const int key = 32 * hf + q; kf[hf][kk] = *(const LAS bf16x8*)(KL + key * 64 + 8 * ((2 * kk + h2) ^ (key & 7))); }
#pragma unroll
        for (int i = 0; i < 8; ++i) { const int row = (lane >> 3) + 8 * i; const v4u w = *(const v4u*)(proj + (rowb + s0 + row) * DING + C_SBV + h * 64 + 8 * (lane & 7)); *(LAS v4u*)(VL + row * AVLD + 8 * (lane & 7)) = w; }
        f32x16 z0, z1;
#pragma unroll
        for (int r = 0; r < 16; ++r) { z0[r] = 0.f; z1[r] = 0.f; }
#pragma unroll
        for (int kk = 0; kk < 4; ++kk) { z0 = MFMA32(kf[0][kk], qf[kk], z0); z1 = MFMA32(kf[1][kk], qf[kk], z1); }
        const int lim = (s0 == sd) ? (qw - sd) + q : 64;
        f32x16 l0, l1;
#pragma unroll
        for (int r = 0; r < 16; ++r) { const int key = (r & 3) + 8 * (r >> 2) + 4 * h2; l0[r] = key < lim ? lk2(z0[r]) : 0.f; l1[r] = key + 32 < lim ? lk2(z1[r]) : 0.f; }
        const bf16x8 bl0 = pack8(l0, 0), bl1 = pack8(l0, 8), bh0 = pack8(l1, 0), bh1 = pack8(l1, 8);
        f32x16 i0 = z0, i1 = z1;
        i0 = MFMA32(m0[0], bl0, i0); i0 = MFMA32(m0[1], bl1, i0); i0 = MFMA32(ones, bh0, i0); i0 = MFMA32(ones, bh1, i0);
        i1 = MFMA32(m0[0], bh0, i1); i1 = MFMA32(m0[1], bh1, i1);
        float tot = h2 == 0 ? i0[0] - z0[0] : 0.f; tot += __shfl_xor(tot, 32);
#pragma unroll
        for (int r = 0; r < 16; ++r) { const int key = (r & 3) + 8 * (r >> 2) + 4 * h2; l0[r] = key < lim ? __builtin_amdgcn_exp2f(i0[r] + R) : 0.f; l1[r] = key + 32 < lim ? __builtin_amdgcn_exp2f(i1[r] + R) : 0.f; }
        R += tot;
        const bf16x8 pa0 = pack8(l0, 0), pa1 = pack8(l0, 8), pa2 = pack8(l1, 0), pa3 = pack8(l1, 8);
        const LAS bf16* vb = VL + (4 * h2 + ((lane & 15) >> 2)) * AVLD + 16 * ((lane >> 4) & 1) + 4 * (lane & 3);
#define VFRAG(kb, db) ({ const s16x4 lo_ = __builtin_bit_cast(s16x4, __builtin_amdgcn_ds_read_tr16_b64_v4i16((LAS v4i16_t*)(vb + (kb) * AVLD + (db) * 32))); \
                         const s16x4 hi_ = __builtin_bit_cast(s16x4, __builtin_amdgcn_ds_read_tr16_b64_v4i16((LAS v4i16_t*)(vb + ((kb) + 8) * AVLD + (db) * 32))); \
                         (bf16x8){lo_[0], lo_[1], lo_[2], lo_[3], hi_[0], hi_[1], hi_[2], hi_[3]}; })
        o0 = MFMA32(pa0, VFRAG(0, 0), o0); o1 = MFMA32(pa0, VFRAG(0, 1), o1);
        o0 = MFMA32(pa1, VFRAG(16, 0), o0); o1 = MFMA32(pa1, VFRAG(16, 1), o1);
        o0 = MFMA32(pa2, VFRAG(32, 0), o0); o1 = MFMA32(pa2, VFRAG(32, 1), o1);
        o0 = MFMA32(pa3, VFRAG(48, 0), o0); o1 = MFMA32(pa3, VFRAG(48, 1), o1);
#undef VFRAG
        if (__all(R < -127.0f)) break;
    }
    float* op = oraw + (rowb + qw) * DM + h * 64 + q;
#pragma unroll
    for (int r = 0; r < 16; ++r) { const int qq = (r & 3) + 8 * (r >> 2) + 4 * h2; op[(size_t)qq * DM] = o0[r]; op[(size_t)qq * DM + 32] = o1[r]; }
}


constexpr int NPL = 11, NPHASE = 1 + NPL * DEPTH;
struct Args { const float* in[29]; float* out; unsigned char* ws; int ph_lo, ph_hi, use_bar, pad; };

typedef const __attribute__((address_space(4))) Args* KArgP;
__device__ __forceinline__ KArgP kargs() { KArgP p = (KArgP)__builtin_amdgcn_kernarg_segment_ptr(); asm volatile("" : "+s"(p)); return p; }
#define WSP(type, off) ((type*)(kargs()->ws + (off)))
#define INP(i) (kargs()->in[i])

constexpr int CV_MOE = NE * IT_GU + NE * IT_DN;
constexpr int CV_TAILQ = 5, CV_TAILW = (256 - 64) * NWAVES;
constexpr int CV_TAIL = CV_TAILQ * CV_TAILW;
constexpr int CV_SMALL = NIT_WIN + NIT_WOUT;
constexpr int CV_GQ = 6, CV_HQ = 5;
constexpr int CV_P0_ITEMS = CV_SMALL + (CV_MOE - CV_TAIL);
constexpr float F8_WGU_SCALE = 32.0f, F8_WDN_SCALE = 64.0f;
__device__ __forceinline__ TDesc cv_moe(int l, int r) { TDesc d;
    if (r < NE * IT_GU) { const int le = l * NE + r / IT_GU, q = r % IT_GU; d.W = INP(24) + (size_t)le * DM * 2048; d.ldw = 2048; d.WT = (bf16*)(WSP(unsigned char, WS_WGU) + (size_t)le * 2048 * DM); d.K = DM; d.k0 = 64 * (q / 32); d.n0 = 64 * (q % 32); d.gu = 1; d.f8s = F8_WGU_SCALE; return d; }
    r -= NE * IT_GU;
    { const int le = l * NE + r / IT_DN, q = r % IT_DN; d.W = INP(26) + (size_t)le * DFF * DM; d.ldw = DM; d.WT = (bf16*)(WSP(unsigned char, WS_WDN) + (size_t)le * DM * DFF); d.K = DFF; d.k0 = 64 * (q / 16); d.n0 = 64 * (q % 16); d.gu = 0; d.f8s = F8_WDN_SCALE; return d; } }
__device__ __forceinline__ TDesc cv_p0(int r) { TDesc d;
    if (r < NIT_WIN) { const int l = r / IT_WIN, q = r % IT_WIN; d.W = INP(2) + (size_t)l * DM * DIN; d.ldw = DIN; d.WT = WSP(bf16, WS_WIN) + (size_t)l * DING * DM; d.K = DM; d.k0 = 64 * (q / 52); d.n0 = 64 * (q % 52); d.gu = 0; d.f8s = 0.f; return d; }
    r -= NIT_WIN;
    if (r < NIT_WOUT) { const int l = r / IT_WOUT, q = r % IT_WOUT; d.W = INP(20) + (size_t)l * DM * DM; d.ldw = DM; d.WT = WSP(bf16, WS_WOUT) + (size_t)l * DM * DM; d.K = DM; d.k0 = 64 * (q / 16); d.n0 = 64 * (q % 16); d.gu = 0; d.f8s = 0.f; return d; }
    r -= NIT_WOUT;
    return cv_moe(0, CV_TAIL + r); }
__device__ __forceinline__ void convert_items(int n, int first, int stride, int tail_layer_p1, LAS float* scr, int lane) {
    int it = first; TDesc dc, dn; f32x4 va[16], vb[16];
    if (it < n) { dc = tail_layer_p1 ? cv_moe(tail_layer_p1 - 1, it) : cv_p0(it); tload(dc, va, lane); }
    while (it < n) { const int nx = it + stride; const bool hn = nx < n;
        if (hn) { dn = tail_layer_p1 ? cv_moe(tail_layer_p1 - 1, nx) : cv_p0(nx); tload(dn, vb, lane); }
        tstore(dc, va, scr, lane);
        if (hn) { dc = dn;
#pragma unroll
            for (int i = 0; i < 16; ++i) va[i] = vb[i]; }
        it = nx; }
}

__global__ void __launch_bounds__(NTHR, 2) fwd_kernel(Args args_unused) {
    extern __shared__ __attribute__((aligned(16))) unsigned char lds_raw[];
    LAS unsigned char* lds = (LAS unsigned char*)lds_raw;
    LAS float* ldsf = (LAS float*)lds_raw;
    volatile LAS unsigned* MISC = (volatile LAS unsigned*)(lds + MISC_OFF);
    LAS int* tb = (LAS int*)(lds + TB_OFF);
    const int tid0 = threadIdx.x;
#define PH_IDS int tid = threadIdx.x; asm volatile("" : "+v"(tid)); const int lane = tid & 63, wave = __builtin_amdgcn_readfirstlane(tid >> 6); const int gw = vcu * NWAVES + wave; (void)lane; (void)gw;
    const int G = gridDim.x, bx = blockIdx.x;
    const int vcu = (G % 8 == 0) ? (bx % 8) * (G / 8) + bx / 8 : bx;
    const int NGW = G * NWAVES;
    gu32* ctl = (gu32*)WSP(unsigned char, WS_CTL);

    for (int u = tid0; u < (LDS_BYTES - LDSCTL_OFF) / 4; u += NTHR) ((LAS unsigned*)(lds + LDSCTL_OFF))[u] = 0u;
    __syncthreads();
    XcdBarrier bar; bar.bar = (unsigned*)(ctl + CW_BAR); bar.x = 0; bar.st = nullptr;
    if (kargs()->use_bar) bar = xcd_barrier_post((unsigned*)(ctl + CW_BAR), MISC + 8);
    const int lo = kargs()->ph_lo, hi = kargs()->ph_hi;
#ifndef PH_MASK
#define PH_MASK 0xfff
#endif
#ifndef REP_MASK
#define REP_MASK 0
#endif
#define IN(k) (lo <= (k) && (k) < hi)
#define EN(ty) ((PH_MASK >> (ty)) & 1)
#define REPS(ty) (1 + ((REP_MASK >> (ty)) & 1))
#ifndef REP2_MASK
#define REP2_MASK 0
#endif
#define SUB(bit) _Pragma("unroll 1") for (int rep2_ = 0; rep2_ < 1 + ((REP2_MASK >> (bit)) & 1); ++rep2_)
#define SEAM(k) do { if (IN(k) && IN((k) + 1)) xcd_barrier(bar); } while (0)
#define PHASE(ty, k) if (EN(ty) && IN(k)) _Pragma("unroll 1") for (int rep_ = 0; rep_ < REPS(ty); ++rep_)

    PHASE(11, 0) { PH_IDS
        LAS float* scr = ldsf + wave * (64 * 65);
        convert_items(CV_P0_ITEMS, gw, NGW, 0, scr, lane);
        for (int idx = gw * 64 + lane; idx < DEPTH * 4 * 4096; idx += NGW * 64) { const int i = idx & 63, j = (idx >> 6) & 63, ln = idx >> 12;
            WSP(bf16, WS_WAT)[idx] = (bf16)f2bf(INP(6)[(size_t)ln * 4096 + i * 64 + j]); WSP(bf16, WS_WAT + 512 * 1024)[idx] = (bf16)f2bf(INP(8)[(size_t)ln * 4096 + i * 64 + j]); }
        for (int idx = gw * 64 + lane; idx < DEPTH * NE * DM; idx += NGW * 64) { const int k = idx & 1023, e = (idx >> 10) & 31, ll = idx >> 15;
            const float w = INP(21)[ll * DM + k] * INP(22)[((size_t)ll * DM + k) * NE + e]; const unsigned hi = f2bf(w); const float lo = w - __uint_as_float(hi << 16);
            bf16* dst = WSP(bf16, WS_RWB) + (size_t)ll * 2 * NE * DM + e * DM + k; dst[0] = (bf16)hi; dst[NE * DM] = (bf16)f2bf(lo); }
        if (gw == 0) for (int c = lane; c < 256; c += 64) { const float x0 = INP(12)[c], x1 = INP(12)[256 + c], mx = fmaxf(x0, x1), e0 = expf(x0 - mx), e1 = expf(x1 - mx); WSP(float, WS_LB1)[c] = e1 / (e0 + e1); }
        __syncthreads();
        stage_dtw(INP(2), ldsf, tid);
        _Pragma("unroll 1") for (int m = gw; m < T; m += 2 * NGW) { const int m1 = m + NGW; const bool two = m1 < T; f32x4 va[4], vb[4];
#pragma unroll
            for (int j = 0; j < 4; ++j) { va[j] = *(const f32x4*)(INP(0) + (size_t)m * DM + 256 * j + 4 * lane); vb[j] = *(const f32x4*)(INP(0) + (size_t)(two ? m1 : m) * DM + 256 * j + 4 * lane); }
            emit_xn_dt(va, INP(1), ldsf, WSP(bf16, WS_XN) + (size_t)m * DM, WSP(float, WS_DT) + (size_t)m * 4, lane);
            if (two) emit_xn_dt(vb, INP(1), ldsf, WSP(bf16, WS_XN) + (size_t)m1 * DM, WSP(float, WS_DT) + (size_t)m1 * 4, lane); }
    }
    SEAM(0);

#pragma unroll 1
    for (int l = 0; l < DEPTH; ++l) {
        const int P = 1 + NPL * l;
        PHASE(0, P) { PH_IDS
            pg8::Gemm g{WSP(bf16, WS_XN), WSP(bf16, WS_WIN) + (size_t)l * DING * DM, T, DING, DM}; pg8::StaticOrder S; S.init(T, DING, G, bx);
            pg8::EpiBf16 E{WSP(bf16, WS_PROJ), DING, nullptr, 0};
            pg8::gemm_phase<pg8::EpiBf16, pg8::StaticOrder, true, true>(lds, g, S, E);
            if (G == 256 && bx >= 64) convert_items(CV_TAIL, (bx - 64) * NWAVES + wave, CV_TAILW, l + 1, ldsf + wave * (64 * 65), lane);
            else if (G != 256) convert_items(CV_TAIL, gw, NGW, l + 1, ldsf + wave * (64 * 65), lane);
            __syncthreads();
        }
        SEAM(P);
#define LAUNDER_TID int tidu = threadIdx.x; asm volatile("" : "+v"(tidu));
        PHASE(1, P + 1) { PH_IDS
            { const int v = vcu, b = v >> 5, ch = v & 31;
                SUB(0)
#pragma unroll 1
                for (int g = 0; g < 2; ++g) { LAUNDER_TID m2_state_unit(WSP(bf16, WS_PROJ), WSP(float, WS_DT), WSP(float, WS_SLOC), WSP(float, WS_DEC), b, ch, g, INP(14) + l * 3072, INP(15) + l * 768, INP(16) + l * 4, INP(17) + l * 4, lds, tidu); }
                SUB(1)
#pragma unroll 1
                for (int g = 0; g < 2; ++g) { LAUNDER_TID hg_state_unit(WSP(bf16, WS_PROJ), WSP(float, WS_SLT), WSP(float, WS_DECC), b, ch, g, WSP(float, WS_LB1), l, lds, tidu); }
                SUB(2)
#pragma unroll 1
                for (int g = 0; g < 2; ++g) { LAUNDER_TID rg_local_unit(WSP(bf16, WS_PROJ), WSP(float, WS_HLOC), WSP(float, WS_PCUM), WSP(float, WS_RGS), b, ch, g, INP(4) + l * 1024, INP(5) + l * 256, WSP(bf16, WS_WAT) + l * 16384, WSP(bf16, WS_WAT + 512 * 1024) + l * 16384, INP(7) + l * 256, INP(9) + l * 256, INP(10) + l * 256, lds, tidu); }
            }
            SUB(3) { __syncthreads();
            for (int u = gw; u < 2048; u += NGW) { const int qb = 63 - (u >> 5), bh = u & 31; attn_unit(WSP(bf16, WS_PROJ), WSP(float, WS_ORAW), bh >> 2, bh & 3, qb, (LAS bf16*)(lds + wave * 17408), (LAS bf16*)(lds + wave * 17408 + 8192), lane); }
            __syncthreads(); }
        }
        SEAM(P + 1);
        PHASE(2, P + 2) { PH_IDS
            { float* sl = WSP(float, WS_SLOC); const float* dc = WSP(float, WS_DEC); bf16* pb = WSP(bf16, WS_PREVB);
                const int e = (vcu * NTHR + tid) * 2, n = e & 127, p = (e >> 7) & 63, h = (e >> 13) & 3, b = e >> 15;
                if (b < NB) { float r0 = 0.f, r1 = 0.f;
#pragma unroll 8
                    for (int c = 0; c < 32; ++c) { float* a = sl + ((size_t)((b * 32 + c) * 4 + h) * 64 + p) * 128 + n; const float d = dc[(b * 32 + c) * 4 + h];
                        const float s0 = a[0], s1 = a[1]; *(unsigned*)(pb + (a - sl)) = pk2(r0, r1); r0 = d * r0 + s0; r1 = d * r1 + s1; } } }
            { float* sl = WSP(float, WS_SLT); const float* dc = WSP(float, WS_DECC); bf16* pb = WSP(bf16, WS_STB);
                const int e = vcu * NTHR + tid, c = e & 63, v = (e >> 6) & 63, h = (e >> 12) & 3, b = e >> 14;
                if (b < NB) { float r = 0.f;
#pragma unroll 8
                    for (int k = 0; k < 32; ++k) { float* a = sl + ((size_t)((b * 32 + k) * 4 + h) * 64 + v) * 64 + c; const float d = dc[(size_t)((b * 32 + k) * 4 + h) * 64 + c];
                        const float s0 = a[0]; pb[a - sl] = (bf16)f2bf(r); r = d * r + s0; } } }
            { const int e = vcu * NTHR + tid;
                if (e < NB * 256) { const int b = e >> 8, c = e & 255; const float* rs = WSP(float, WS_RGS); float* cy = WSP(float, WS_CARRY); float r = 0.f;
#pragma unroll 8
                    for (int k = 0; k < 32; ++k) { const size_t o = (size_t)(b * 32 + k) * 256 + c; cy[o] = r; r = rs[2 * o] * r + rs[2 * o + 1]; } } }
        }
        SEAM(P + 2);
        PHASE(3, P + 3) { PH_IDS
            { const int v = vcu, b = v >> 5, ch = v & 31;
                SUB(4)
#pragma unroll 1
                for (int g = 0; g < 2; ++g) { LAUNDER_TID m2_out_unit(WSP(bf16, WS_PROJ), WSP(float, WS_DT), WSP(bf16, WS_PREVB), WSP(float, WS_ORAW), b, ch, g, INP(14) + l * 3072, INP(15) + l * 768, INP(16) + l * 4, INP(17) + l * 4, INP(18) + l * 4, lds, tidu); }
                SUB(5)
#pragma unroll 1
                for (int g = 0; g < 2; ++g) { LAUNDER_TID hg_out_unit(WSP(bf16, WS_PROJ), WSP(bf16, WS_STB), WSP(float, WS_ORAW), b, ch, g, WSP(float, WS_LB1), l, lds, tidu); }
                SUB(6)
                {
                    const float* hl = WSP(float, WS_HLOC); const float* pc = WSP(float, WS_PCUM); const float* cy = WSP(float, WS_CARRY); const bf16* pj = WSP(bf16, WS_PROJ); float* orw = WSP(float, WS_ORAW);
                    { const int c = 4 * lane; const f32x4 cv = *(const f32x4*)(cy + (size_t)v * 256 + c);
                        _Pragma("unroll 1") for (int r0 = 0; r0 < 8; r0 += 4) { f32x4 hv[4], pv[4]; u32x2 gwd[4];
#pragma unroll
                            for (int r = 0; r < 4; ++r) { const size_t m = (size_t)v * 64 + wave * 8 + r0 + r; hv[r] = *(const f32x4*)(hl + m * 256 + c); pv[r] = *(const f32x4*)(pc + m * 256 + c); gwd[r] = *(const u32x2*)(pj + m * DING + C_RGG + c); }
#pragma unroll
                            for (int r = 0; r < 4; ++r) { const size_t m = (size_t)v * 64 + wave * 8 + r0 + r;
                                f32x4 o = hv[r] + pv[r] * cv; o[0] *= gelu_tanh(bflo(gwd[r].x)); o[1] *= gelu_tanh(bfhi(gwd[r].x)); o[2] *= gelu_tanh(bflo(gwd[r].y)); o[3] *= gelu_tanh(bfhi(gwd[r].y));
                                *(f32x4*)(orw + m * DM + 256 + c) = o; } } }
                    __syncthreads();
                }
                _Pragma("unroll 1") for (int r0 = 0; r0 < 8; r0 += 4) { const size_t m0 = (size_t)v * 64 + wave * 8 + r0;
                    norm_rows4(WSP(float, WS_ORAW) + m0 * DM, WSP(bf16, WS_PROJ) + m0 * DING, WSP(bf16, WS_MIX) + m0 * DM, INP(3) + l * 256, INP(11) + l * 256, INP(13) + l * 256, INP(19) + l * 256, lane); }
            }
        }
        SEAM(P + 3);
        PHASE(5, P + 5) { PH_IDS
            pg8::Gemm g{WSP(bf16, WS_MIX), WSP(bf16, WS_WOUT) + (size_t)l * DM * DM, T, DM, DM}; pg8::StaticOrder S; S.init(T, DM, G, bx);
            if (l == 0) { pg8::EpiResBf16<true> E{INP(0), WSP(bf16, WS_H1), DM}; pg8::gemm_phase<pg8::EpiResBf16<true>, pg8::StaticOrder, true, true>(lds, g, S, E); }
            else { pg8::EpiResBf16<false> E{WSP(bf16, WS_HB), WSP(bf16, WS_H1), DM}; pg8::gemm_phase<pg8::EpiResBf16<false>, pg8::StaticOrder, true, true>(lds, g, S, E); }
        }
        SEAM(P + 5);
        PHASE(6, P + 6) { PH_IDS
            constexpr int WLD = 1032;
            LAS bf16* WB = (LAS bf16*)lds; LAS float* LG = (LAS float*)(lds + 2 * 32 * WLD * 2); LAS float* SS = LG + 64 * 33; LAS float* RS = SS + 64;
            { const bf16* src = WSP(bf16, WS_RWB) + (size_t)l * 2 * 32 * 1024; v4u wv[16];
#pragma unroll
                for (int i = 0; i < 16; ++i) wv[i] = *(const v4u*)(src + (size_t)(tid + NTHR * i) * 8);
#pragma unroll
                for (int i = 0; i < 16; ++i) { const int c = tid + NTHR * i; *(LAS v4u*)(WB + (c >> 7) * WLD + (c & 127) * 8) = wv[i]; } }
            __syncthreads();
            const bf16* h1 = WSP(bf16, WS_H1);
            { const int rt = wave >> 1, et = wave & 1; const bf16* hp = h1 + (size_t)(vcu * 64 + rt * 16 + (lane & 15)) * DM + 8 * (lane >> 4);
                f32x4 acc = {0.f, 0.f, 0.f, 0.f}; float ssum = 0.f;
#pragma unroll 8
                for (int ks = 0; ks < 32; ++ks) { const bf16x8 a = *(const bf16x8*)(hp + 32 * ks);
                    acc = MFMA16(a, frag_kc(WB, WLD, et * 16, 32 * ks, lane), acc); acc = MFMA16(a, frag_kc(WB + 32 * WLD, WLD, et * 16, 32 * ks, lane), acc);
                    const v4u aw = __builtin_bit_cast(v4u, a);
#pragma unroll
                    for (int i = 0; i < 4; ++i) { const float x0 = bflo(aw[i]), x1 = bfhi(aw[i]); ssum += x0 * x0 + x1 * x1; } }
                ssum += __shfl_xor(ssum, 16); ssum += __shfl_xor(ssum, 32);
                if (et == 0 && lane < 16) SS[rt * 16 + lane] = ssum;
#pragma unroll
                for (int i = 0; i < 4; ++i) LG[(rt * 16 + 4 * (lane >> 4) + i) * 33 + et * 16 + (lane & 15)] = acc[i]; }
            __syncthreads();
            if (wave == 0) { const int row = lane; const float rstd = 1.0f / sqrtf(SS[row] * (1.0f / DM) + EPS); RS[row] = rstd;
                const float* rb = INP(23) + l * NE;
                float lg[32];
#pragma unroll
                for (int e = 0; e < 32; ++e) lg[e] = rstd * LG[row * 33 + e] + rb[e];
                int be[4]; float bl[4];
#pragma unroll
                for (int r = 0; r < 4; ++r) { float best = -INFINITY; int bi = 0;
#pragma unroll
                    for (int e = 0; e < 32; ++e) if (lg[e] > best) { best = lg[e]; bi = e; }
#pragma unroll
                    for (int e = 0; e < 32; ++e) if (e == bi) lg[e] = -INFINITY;
                    be[r] = bi; bl[r] = best; }
                const float e1 = expf(bl[1] - bl[0]), e2 = expf(bl[2] - bl[0]), e3 = expf(bl[3] - bl[0]), inv = 1.0f / (1.0f + e1 + e2 + e3);
                int rk0 = 0, rk1 = 0, rk2 = 0, rk3 = 0, hist = 0; const unsigned long long lt = (1ull << lane) - 1ull;
#pragma unroll
                for (int e = 0; e < 32; ++e) { const bool h0 = be[0] == e, h1b = be[1] == e, h2 = be[2] == e, h3 = be[3] == e; const unsigned long long m = __ballot(h0 | h1b | h2 | h3);
                    const int below = __popcll(m & lt); rk0 = h0 ? below : rk0; rk1 = h1b ? below : rk1; rk2 = h2 ? below : rk2; rk3 = h3 ? below : rk3; if (lane == e) hist = __popcll(m); }
                if (lane < 32) WSP(int, WS_HIST)[(size_t)vcu * 32 + lane] = hist;
                const int a = (vcu * 64 + row) * 4;
                *(int4*)(WSP(int, WS_ASGE) + a) = make_int4(be[0], be[1], be[2], be[3]); *(int4*)(WSP(int, WS_ASGP) + a) = make_int4(rk0, rk1, rk2, rk3);
                *(f32x4*)(WSP(float, WS_GATE) + a) = (f32x4){inv, e1 * inv, e2 * inv, e3 * inv}; }
            __syncthreads();
            { const float* g = INP(21) + l * DM; unsigned char* xn8 = WSP(unsigned char, WS_XN);
                _Pragma("unroll 1") for (int r0 = 0; r0 < 8; r0 += 4) { v4u w[4][2];
#pragma unroll
                    for (int r = 0; r < 4; ++r)
#pragma unroll
                        for (int j = 0; j < 2; ++j) w[r][j] = *(const v4u*)(h1 + ((size_t)vcu * 64 + wave * 8 + r0 + r) * DM + 512 * j + 8 * lane);
#pragma unroll
                    for (int r = 0; r < 4; ++r) { const int row = wave * 8 + r0 + r; const size_t m = (size_t)vcu * 64 + row; const float rstd = RS[row];
#pragma unroll
                        for (int j = 0; j < 2; ++j) { const int col = 512 * j + 8 * lane; const v4u ww = w[r][j]; const f32x4 g0 = *(const f32x4*)(g + col), g1 = *(const f32x4*)(g + col + 4);
                            int w0 = 0, w1 = 0;
                            w0 = __builtin_amdgcn_cvt_pk_fp8_f32(pg8::f8clamp(bflo(ww.x) * rstd * g0[0]), pg8::f8clamp(bfhi(ww.x) * rstd * g0[1]), w0, false); w0 = __builtin_amdgcn_cvt_pk_fp8_f32(pg8::f8clamp(bflo(ww.y) * rstd * g0[2]), pg8::f8clamp(bfhi(ww.y) * rstd * g0[3]), w0, true);
                            w1 = __builtin_amdgcn_cvt_pk_fp8_f32(pg8::f8clamp(bflo(ww.z) * rstd * g1[0]), pg8::f8clamp(bfhi(ww.z) * rstd * g1[1]), w1, false); w1 = __builtin_amdgcn_cvt_pk_fp8_f32(pg8::f8clamp(bflo(ww.w) * rstd * g1[2]), pg8::f8clamp(bfhi(ww.w) * rstd * g1[3]), w1, true);
                            u32x2 o; o.x = (unsigned)w0; o.y = (unsigned)w1; *(u32x2*)(xn8 + m * DM + col) = o; } } } }
        }
        SEAM(P + 6);
        PHASE(7, P + 7) { PH_IDS
            LAS int* bs = (LAS int*)(lds + 131072);
            if (tid < 32) { const int* hs = WSP(int, WS_HIST); int base = 0, tot = 0;
#pragma unroll 8
                for (int w = 0; w < G; ++w) { const int c = hs[w * 32 + tid]; tot += c; if (w < vcu) base += c; }
                bs[tid] = base; bs[32 + tid] = tot; if (vcu == 0) WSP(int, WS_TOT)[tid] = tot; }
            __syncthreads();
            if (tid == 0) { int run = 0; for (int e = 0; e < 32; ++e) { tb[e] = run; run += (bs[32 + e] + 255) >> 8; } tb[32] = run; }
            __syncthreads();
            const int* asge = WSP(int, WS_ASGE); const int* asgp = WSP(int, WS_ASGP); int* slotp = WSP(int, WS_SLOT); int* toks = (int*)(kargs()->ws + WS_CTL + CTL_TOKS) + (size_t)l * MAXSLOT;
            if (tid < 256) { const int a = vcu * 256 + tid; const int e = asge[a], slot = tb[e] * 256 + bs[e] + asgp[a]; slotp[a] = slot; toks[slot] = a >> 2; }
        }
        SEAM(P + 7);
        PHASE(8, P + 8) { PH_IDS
            build_tb(WSP(int, WS_TOT), tb, tid);
            LAS int* tokl = (LAS int*)(lds + 131072);
            pg8::MoeOrder S{(const LAS int*)tb, 8, G, bx, (const LAS int*)tokl};
            { const int* toks = (const int*)(kargs()->ws + WS_CTL + CTL_TOKS) + (size_t)l * MAXSLOT; pg8::Unit u;
                for (int i = 0; i < 15 && S.next(i, u); ++i) if (tid < 256) tokl[i * 256 + tid] = toks[u.pm * 256 + tid];
                __syncthreads(); }
            pg8::Gemm g{WSP(bf16, WS_XN), (const bf16*)(WSP(unsigned char, WS_WGU) + (size_t)l * NE * 2048 * DM), T, 2048, DM, 0x7a7a7a7a, 0x7f7f7f7f};
            pg8::EpiSwiglu8 E{WSP(unsigned char, WS_ACT), INP(25) + (size_t)l * NE * 2048};
            pg8::gemm_phase<pg8::EpiSwiglu8, pg8::MoeOrder, true, true, true>(lds, g, S, E);
            if (l + 1 < DEPTH) { const int rem = (tb[32] * 8) % G;
                if (rem != 0 && bx >= rem) { const int nw = (G - rem) * NWAVES; convert_items(min(CV_TAIL + nw * CV_GQ, CV_MOE), CV_TAIL + (bx - rem) * NWAVES + wave, nw, l + 2, ldsf + wave * (64 * 65), lane); } }
        }
        SEAM(P + 8);
        PHASE(9, P + 9) { PH_IDS
            build_tb(WSP(int, WS_TOT), tb, tid);
            pg8::Gemm g{WSP(bf16, WS_ACT), (const bf16*)(WSP(unsigned char, WS_WDN) + (size_t)l * NE * DM * DFF), MAXSLOT, DM, DFF, 0x79797979, 0x7f7f7f7f}; pg8::MoeOrder S{(const LAS int*)tb, 4, G, bx};
            pg8::EpiBf16 E{WSP(bf16, WS_Y), DM, INP(27) + (size_t)l * NE * DM, DM};
            pg8::gemm_phase<pg8::EpiBf16, pg8::MoeOrder, true, true, true>(lds, g, S, E);
            if (l + 1 < DEPTH) { const int remg = (tb[32] * 8) % G, remh = (tb[32] * 4) % G; const int offh = min(CV_TAIL + (remg ? (G - remg) * NWAVES * CV_GQ : 0), CV_MOE);
                if (remh != 0 && bx >= remh) { const int nw = (G - remh) * NWAVES; convert_items(min(offh + nw * CV_HQ, CV_MOE), offh + (bx - remh) * NWAVES + wave, nw, l + 2, ldsf + wave * (64 * 65), lane); } }
        }
        SEAM(P + 9);
        PHASE(10, P + 10) { PH_IDS
            if (l + 1 < DEPTH) { build_tb(WSP(int, WS_TOT), tb, tid);
                const int remg = (tb[32] * 8) % G, remh = (tb[32] * 4) % G; const int offc = min(min(CV_TAIL + (remg ? (G - remg) * NWAVES * CV_GQ : 0), CV_MOE) + (remh ? (G - remh) * NWAVES * CV_HQ : 0), CV_MOE);
                convert_items(CV_MOE, offc + gw, NGW, l + 2, ldsf + wave * (64 * 65), lane); }
            if (l + 1 < DEPTH) { __syncthreads(); stage_dtw(INP(2) + (size_t)(l + 1) * DM * DIN, ldsf, tid); }
            const bf16* h1 = WSP(bf16, WS_H1); const int* slotp = WSP(int, WS_SLOT); const float* gatep = WSP(float, WS_GATE); const bf16* yb = WSP(bf16, WS_Y);
            { const int nrow = (T - gw + NGW - 1) / NGW;
                _Pragma("unroll 1") for (int i = 0; i < nrow; i += 2) { const int m0 = gw + i * NGW, m1 = (i + 1 < nrow) ? m0 + NGW : m0; const bool two = i + 1 < nrow;
                    const int4 s0 = *(const int4*)(slotp + (size_t)m0 * 4), s1 = *(const int4*)(slotp + (size_t)m1 * 4); const f32x4 g0 = *(const f32x4*)(gatep + (size_t)m0 * 4), g1 = *(const f32x4*)(gatep + (size_t)m1 * 4);
                    const int sl0[4] = {s0.x, s0.y, s0.z, s0.w}, sl1[4] = {s1.x, s1.y, s1.z, s1.w};
                    u32x2 h0[4], h1r[4], y0[4][4], y1[4][4];
#pragma unroll
                    for (int j = 0; j < 4; ++j) { h0[j] = *(const u32x2*)(h1 + (size_t)m0 * DM + 256 * j + 4 * lane); h1r[j] = *(const u32x2*)(h1 + (size_t)m1 * DM + 256 * j + 4 * lane); }
#pragma unroll
                    for (int r = 0; r < 4; ++r)
#pragma unroll
                        for (int j = 0; j < 4; ++j) { y0[r][j] = *(const u32x2*)(yb + (size_t)sl0[r] * DM + 256 * j + 4 * lane); y1[r][j] = *(const u32x2*)(yb + (size_t)sl1[r] * DM + 256 * j + 4 * lane); }
#pragma unroll
                    for (int rr = 0; rr < 2; ++rr) { if (rr == 1 && !two) break; const int m = rr ? m1 : m0;
                        f32x4 v[4];
#pragma unroll
                        for (int j = 0; j < 4; ++j) { const u32x2 w = rr ? h1r[j] : h0[j]; v[j] = (f32x4){bflo(w.x), bfhi(w.x), bflo(w.y), bfhi(w.y)}; }
#pragma unroll
                        for (int r = 0; r < 4; ++r)
#pragma unroll
                            for (int j = 0; j < 4; ++j) { const float gg = rr ? g1[r] : g0[r]; const u32x2 w = rr ? y1[r][j] : y0[r][j]; v[j][0] += gg * bflo(w.x); v[j][1] += gg * bfhi(w.x); v[j][2] += gg * bflo(w.y); v[j][3] += gg * bfhi(w.y); }
                        if (l + 1 < DEPTH) {
#pragma unroll
                            for (int j = 0; j < 4; ++j) { u32x2 w; w.x = pk2(v[j][0], v[j][1]); w.y = pk2(v[j][2], v[j][3]); *(u32x2*)(WSP(bf16, WS_HB) + (size_t)m * DM + 256 * j + 4 * lane) = w; }
                            emit_xn_dt(v, INP(1) + (l + 1) * DM, ldsf, WSP(bf16, WS_XN) + (size_t)m * DM, WSP(float, WS_DT) + (size_t)m * 4, lane);
                        } else { float ss = 0.f;
#pragma unroll
                            for (int j = 0; j < 4; ++j) ss += (v[j][0] * v[j][0] + v[j][1] * v[j][1]) + (v[j][2] * v[j][2] + v[j][3] * v[j][3]);
                            ss = wave_sum(ss); const float rstd = 1.0f / sqrtf(ss * (1.0f / DM) + EPS);
#pragma unroll
                            for (int j = 0; j < 4; ++j) *(f32x4*)(kargs()->out + (size_t)m * DM + 256 * j + 4 * lane) = v[j] * rstd * *(const f32x4*)(INP(28) + 256 * j + 4 * lane); } }
                }
            }
        }
        if (l + 1 < DEPTH) SEAM(P + 10);
    }
#undef IN
#undef SEAM
}

extern "C" void kernel_launch(void* const* d_in, const int* in_sizes, int n_in, void* d_out, int out_size, void* d_ws, size_t ws_size, hipStream_t stream) {
    static int grid = 0;
    if (grid == 0) {
        if (n_in != 29 || in_sizes[0] != T * DM || out_size != T * DM || ws_size < WS_END) { fprintf(stderr, "kernel_launch: unexpected shapes (n_in %d, in0 %d, out %d, ws %zu); nothing launched\n", n_in, n_in > 0 ? in_sizes[0] : -1, out_size, ws_size); grid = -1; return; }
        int dev = 0, cus = 0, per_cu = 0;
        if (hipGetDevice(&dev) != hipSuccess || hipDeviceGetAttribute(&cus, hipDeviceAttributeMultiprocessorCount, dev) != hipSuccess) { grid = -1; return; }
        if (hipFuncSetAttribute((const void*)fwd_kernel, hipFuncAttributeMaxDynamicSharedMemorySize, LDS_BYTES) != hipSuccess) { fprintf(stderr, "kernel_launch: hipFuncSetAttribute failed\n"); grid = -1; return; }
        if (hipOccupancyMaxActiveBlocksPerMultiprocessor(&per_cu, (const void*)fwd_kernel, NTHR, LDS_BYTES) != hipSuccess || per_cu < 1) fprintf(stderr, "kernel_launch: occupancy query reports %d\n", per_cu);
        (void)hipGetLastError();
        if (cus != 256) { fprintf(stderr, "kernel_launch: built for a 256-CU device (one workgroup per CU, work lists sized for 256 workgroups); found %d CUs; nothing launched\n", cus); grid = -1; return; }
        grid = cus;
    }
    if (grid < 0) return;
    if (hipMemsetAsync((char*)d_ws + WS_CTL, 0, CTL_ZERO_BYTES, stream) != hipSuccess) { fprintf(stderr, "kernel_launch: memset failed\n"); return; }
    Args a{};
    for (int i = 0; i < 29; ++i) a.in[i] = (const float*)d_in[i];
    a.out = (float*)d_out; a.ws = (unsigned char*)d_ws;
#if MK_N_LAUNCHES == 1
    a.ph_lo = 0; a.ph_hi = NPHASE; a.use_bar = 1;
    hipLaunchKernelGGL(fwd_kernel, dim3(grid), dim3(NTHR), LDS_BYTES, stream, a);
#else
    for (int p = 0; p < NPHASE; ++p) { a.ph_lo = p; a.ph_hi = p + 1; a.use_bar = 0; hipLaunchKernelGGL(fwd_kernel, dim3(grid), dim3(NTHR), LDS_BYTES, stream, a); }
#endif
}
```

```cpp
#include <hip/hip_runtime.h>
#include <cstdio>
#include <cstdint>

#ifndef PROBE_T
#define PROBE_T 0
#endif
#ifndef PROBE_CLK
#define PROBE_CLK 0
#endif
#ifndef PROBE_PH
#define PROBE_PH 8
#endif
#ifndef PROBE_WG
#define PROBE_WG 0
#endif
#ifndef MK_N_LAUNCHES
#define MK_N_LAUNCHES 1
#endif

constexpr int NB = 8, SEQ = 2048, DM = 1024, T = NB * SEQ, DEPTH = 2;
constexpr int DIN = 3332, DING = 3328;
constexpr int NE = 32, TOPK = 4, DFF = 1024;
constexpr int NASG = T * TOPK;
constexpr int MAXSLOT = NASG + NE * 256;
constexpr float EPS = 1e-6f;
constexpr int C_SBQ = 0, C_SBK = 256, C_SBV = 512, C_RGX = 768, C_RGG = 1024, C_HGQ = 1280, C_HGF = 1536, C_HGI = 1792, C_HGG = 2048,
              C_M2Z = 2304, C_M2X = 2560, C_DT = 3328;
constexpr int NWAVES = 8, NTHR = 512;

constexpr size_t MiB = 1u << 20;
constexpr size_t WS_CTL = 0, CTL_ZERO_BYTES = 1 * MiB;
constexpr size_t WS_WIN = 2 * MiB;
constexpr size_t WS_WOUT = 16 * MiB;
constexpr size_t WS_WGU = 32 * MiB;
constexpr size_t WS_WDN = 288 * MiB;
constexpr size_t WS_XN = 416 * MiB;
constexpr size_t WS_PROJ = 448 * MiB;
constexpr size_t WS_ORAW = 552 * MiB;
constexpr size_t WS_MIX = 616 * MiB;
constexpr size_t WS_H1 = 648 * MiB;
constexpr size_t WS_HB = 712 * MiB;
constexpr size_t WS_XS = 776 * MiB;
constexpr size_t WS_ACT = 920 * MiB;
constexpr size_t WS_Y = 1064 * MiB;
constexpr size_t WS_DT = 1208 * MiB;
constexpr size_t WS_ASGE = 1209 * MiB;
constexpr size_t WS_ASGP = 1210 * MiB;
constexpr size_t WS_GATE = 1211 * MiB;
constexpr size_t WS_SLOT = 1212 * MiB;
constexpr size_t WS_SLOC = 1216 * MiB;
constexpr size_t WS_DEC = 1248 * MiB;
constexpr size_t WS_SLT = 1250 * MiB;
constexpr size_t WS_DECC = 1266 * MiB;
constexpr size_t WS_HLOC = 1268 * MiB;
constexpr size_t WS_PCUM = 1284 * MiB;
constexpr size_t WS_RGS = 1300 * MiB;
constexpr size_t WS_CARRY = 1301 * MiB;
constexpr size_t WS_WAT = 1302 * MiB;
constexpr size_t WS_HIST = 1303 * MiB;
constexpr size_t WS_TOT = WS_HIST + 512 * 1024;
constexpr size_t WS_LB1 = WS_HIST + 768 * 1024;
constexpr size_t WS_PREVB = 1304 * MiB;
constexpr size_t WS_STB = 1320 * MiB;
constexpr size_t WS_RWB = 1328 * MiB;
constexpr size_t WS_END = 1329 * MiB;
constexpr int CW_TMO = 0, CW_CODE = 1;
constexpr int CW_CNT = 256;
constexpr int CW_BAR = 4096;
constexpr size_t CTL_TOKS = 256 * 1024;

constexpr int LDS_BYTES = 147456;
constexpr int LDSCTL_OFF = LDS_BYTES - 1024;
constexpr int MISC_OFF = LDSCTL_OFF;
constexpr int TB_OFF = LDSCTL_OFF + 256;
constexpr int UL_OFF = LDSCTL_OFF + 512;

namespace pg8 {
#define PG8_LAS __attribute__((address_space(3)))
typedef unsigned short bf16_t;
typedef short bf16x8 __attribute__((ext_vector_type(8)));
typedef float f32x4 __attribute__((ext_vector_type(4)));
typedef unsigned u32x4 __attribute__((ext_vector_type(4)));
constexpr int BM = 256, BK = 64, HALF = 128, HTB = HALF * BK * 2  , STAGE_BYTES = 8 * HTB, NXCD = 8, WGM = 8;
constexpr int PF_JUNK_OFF = 131072 + 10 * 1024;

__host__ __device__ __forceinline__ int lds_byte(int r, int c) { const int st = (r >> 4) * 2 + (c >> 5), rr = r & 15, cc = c & 31, ob = rr * 64 + cc * 2; return st * 1024 + (ob ^ (((ob >> 9) & 1) << 5)); }
__host__ __device__ __forceinline__ void stage_rc(int b, int& R, int& C) { const int st = b / 1024, sb = b % 1024, swz = sb ^ (((sb >> 9) & 1) << 5); R = (st >> 1) * 16 + swz / 64; C = (st & 1) * 32 + (swz % 64) / 2; }
__host__ __device__ __forceinline__ int perm32(int rho) { const int n = rho >> 4, i = rho & 15; return 8 * (i >> 2) + 4 * n + (i & 3); }

struct Unit { int pm, pn, pb, e, ui; };
struct Gemm { const bf16_t* A; const bf16_t* Bt; int M, N, K; int sw = 0x7f7f7f7f, sx = 0x7f7f7f7f; int ktn = 0; };

__host__ __device__ __forceinline__ int xcd_remap(int wgid, int nwg) { const int q = nwg / NXCD, r = nwg % NXCD, xcd = wgid % NXCD, off = wgid / NXCD; return (xcd < r ? xcd * (q + 1) : r * (q + 1) + (xcd - r) * q) + off; }

struct StaticOrder {
    int nM, nN, nwg, G, c;
    __host__ __device__ void init(int M, int N, int G_, int c_) { nM = M / BM; nN = N / BM; nwg = nM * nN; G = G_; c = c_; }
    __host__ __device__ bool next(int i, Unit& u) const {
        const long L = (long)i * G + c; if (L >= nwg) return false;
        const int wgid = xcd_remap((int)L, nwg);
        const int nig = WGM * nN, gid = wgid / nig, fm = gid * WGM, gsz = (nM - fm) < WGM ? (nM - fm) : WGM;
        u.pm = fm + ((wgid % nig) % gsz); u.pn = (wgid % nig) / gsz; u.pb = u.pn; u.e = 0; u.ui = i; return true;
    }
    __device__ __forceinline__ void a_ready(const Unit&) const {}
    __device__ __forceinline__ void done(const Unit&) const {}
    __device__ __forceinline__ size_t a_base(const Unit& u, size_t tstep) const { return (size_t)u.pm * tstep; }
    __device__ __forceinline__ unsigned a_off(const Unit&, int r, int K) const { return (unsigned)(r * K) * 2u; }
};
struct MoeOrder {
    const PG8_LAS int* ul; const PG8_LAS int* tokl = nullptr; int same = 0;
    static constexpr int MAXU = 12;
    static __device__ __forceinline__ void build(const PG8_LAS int* tb, int NP, int G, int c, PG8_LAS int* ulw, int tid) {
        if (tid < 64) { bool ok = false; Unit u{0, 0, 0, 0, 0};
            if (tid < MAXU) { const int ntot = tb[32], nunits = ntot * NP; const long L = (long)tid * G + c;
                if (L < nunits) { ok = true; const int id = xcd_remap((int)L, nunits); int e = 0;
                    for (int j = 1; j < 32; ++j) if (id >= tb[j] * NP) e = j;
                    const int t0 = tb[e], nt = tb[e + 1] - t0, rem = id - t0 * NP;
                    u.pm = t0 + rem % nt; u.pn = rem / nt; u.pb = e * NP + u.pn; u.e = e; } }
            if (ok) { ulw[4 + 4 * tid] = u.pm; ulw[5 + 4 * tid] = u.pn; ulw[6 + 4 * tid] = u.pb; ulw[7 + 4 * tid] = u.e; }
            const unsigned long long m = __ballot(ok); if (tid == 0) ulw[0] = __popcll(m); }
        __syncthreads();
    }
    __device__ __forceinline__ bool next(int i, Unit& u) const {
        if (i >= ul[0]) return false;
        u.pm = __builtin_amdgcn_readfirstlane(ul[4 + 4 * i]); u.pn = __builtin_amdgcn_readfirstlane(ul[5 + 4 * i]); u.pb = __builtin_amdgcn_readfirstlane(ul[6 + 4 * i]); u.e = __builtin_amdgcn_readfirstlane(ul[7 + 4 * i]); u.ui = i;
        if (same) { u.pm = 0; u.pb = 0; } return true;
    }
    __device__ __forceinline__ void a_ready(const Unit&) const {}
    __device__ __forceinline__ void done(const Unit&) const {}
    __device__ __forceinline__ size_t a_base(const Unit& u, size_t tstep) const { return tokl ? (size_t)0 : (size_t)u.pm * tstep; }
    __device__ __forceinline__ unsigned a_off(const Unit& u, int r, int K) const { return tokl ? (unsigned)(tokl[u.ui * 256 + r] * K) * 2u : (unsigned)(r * K) * 2u; }
};

__device__ __forceinline__ float f8clamp(float x) { return __builtin_amdgcn_fmed3f(x, -448.0f, 448.0f); }
__device__ __forceinline__ unsigned cvt_pk_bf16(float lo, float hi) { unsigned r; asm volatile("v_cvt_pk_bf16_f32 %0, %1, %2" : "=v"(r) : "v"(lo), "v"(hi)); return r; }

struct EpiBf16 {
    static constexpr bool PERM = true, AFTER_DRAIN = false;
    bf16_t* O; int ldc; const float* bias; int bias_estride; int skip = 0;
    template <class PF> __device__ __forceinline__ void operator()(const f32x4 (&acc)[2][2][4][2], const Unit& u, int wr, int wc, int fr, int fq, const PF& pf) const {
        if (skip) return;
        const int row0 = u.pm * BM + wr * 64 + fr; const int col0 = u.pn * BM + wc * 32 + 8 * fq;
        f32x4 bv[2][2];
#pragma unroll
        for (int bj = 0; bj < 2; ++bj)
#pragma unroll
            for (int n = 0; n < 2; ++n) bv[bj][n] = bias ? *(const f32x4*)(bias + (size_t)u.e * bias_estride + col0 + bj * HALF + 4 * n) : (f32x4){0.f, 0.f, 0.f, 0.f};
        pf();
#pragma unroll
        for (int ai = 0; ai < 2; ++ai)
#pragma unroll
            for (int m = 0; m < 4; ++m) { bf16_t* rowp = O + (size_t)(row0 + ai * HALF + m * 16) * ldc + col0;
#pragma unroll
                for (int bj = 0; bj < 2; ++bj) { const f32x4 v0 = acc[ai][bj][m][0] + bv[bj][0], v1 = acc[ai][bj][m][1] + bv[bj][1];
                    u32x4 w; w.x = cvt_pk_bf16(v0[0], v0[1]); w.y = cvt_pk_bf16(v0[2], v0[3]); w.z = cvt_pk_bf16(v1[0], v1[1]); w.w = cvt_pk_bf16(v1[2], v1[3]);
                    *(u32x4*)(rowp + bj * HALF) = w; } }
    }
};
template <bool BASE_F32> struct EpiResBf16 {
    static constexpr bool PERM = true, AFTER_DRAIN = false;
    const void* base; bf16_t* out; int ldc;
    template <class PF> __device__ __forceinline__ void operator()(const f32x4 (&acc)[2][2][4][2], const Unit& u, int wr, int wc, int fr, int fq, const PF& pf) const {
        const int row0 = u.pm * BM + wr * 64 + fr, col0 = u.pn * BM + wc * 32 + 8 * fq;
        pf();
#pragma unroll
        for (int ai = 0; ai < 2; ++ai) {
            f32x4 b0[4][2], b1[4][2];
#pragma unroll
            for (int m = 0; m < 4; ++m)
#pragma unroll
                for (int bj = 0; bj < 2; ++bj) { const size_t off = (size_t)(row0 + ai * HALF + m * 16) * ldc + col0 + bj * HALF;
                    if (BASE_F32) { const float* bp = (const float*)base + off; b0[m][bj] = *(const f32x4*)bp; b1[m][bj] = *(const f32x4*)(bp + 4); }
                    else { const u32x4 w = *(const u32x4*)((const bf16_t*)base + off);
                        b0[m][bj] = (f32x4){__uint_as_float(w.x << 16), __uint_as_float(w.x & 0xffff0000u), __uint_as_float(w.y << 16), __uint_as_float(w.y & 0xffff0000u)};
                        b1[m][bj] = (f32x4){__uint_as_float(w.z << 16), __uint_as_float(w.z & 0xffff0000u), __uint_as_float(w.w << 16), __uint_as_float(w.w & 0xffff0000u)}; } }
#pragma unroll
            for (int m = 0; m < 4; ++m)
#pragma unroll
                for (int bj = 0; bj < 2; ++bj) { const size_t off = (size_t)(row0 + ai * HALF + m * 16) * ldc + col0 + bj * HALF;
                    const f32x4 v0 = b0[m][bj] + acc[ai][bj][m][0], v1 = b1[m][bj] + acc[ai][bj][m][1];
                    u32x4 o; o.x = cvt_pk_bf16(v0[0], v0[1]); o.y = cvt_pk_bf16(v0[2], v0[3]); o.z = cvt_pk_bf16(v1[0], v1[1]); o.w = cvt_pk_bf16(v1[2], v1[3]);
                    *(u32x4*)(out + off) = o; } }
    }
};
struct EpiSwiglu8 {
    static constexpr bool PERM = true, AFTER_DRAIN = false;
    unsigned char* O; const float* bias; int skip = 0;
    template <class PF> __device__ __forceinline__ void operator()(const f32x4 (&acc)[2][2][4][2], const Unit& u, int wr, int wc, int fr, int fq, const PF& pf) const {
        if (skip) return;
        const int row0 = u.pm * BM + wr * 64 + fr; const int a0 = u.pn * HALF + wc * 32 + 8 * fq;
        const float* bp = bias + (size_t)u.e * 2048 + 2 * a0;
        f32x4 b4[4];
#pragma unroll
        for (int j = 0; j < 4; ++j) b4[j] = *(const f32x4*)(bp + 4 * j);
        pf();
        typedef float f32x2_ __attribute__((ext_vector_type(2)));
        f32x2_ bg[4], bl[4];
#pragma unroll
        for (int j = 0; j < 4; ++j) { bg[j] = (f32x2_){b4[j][0], b4[j][2]}; bl[j] = (f32x2_){b4[j][1] + 1.0f, b4[j][3] + 1.0f}; }
        const f32x2_ kexp = {-1.702f * 1.4426950408889634f, -1.702f * 1.4426950408889634f}, one2 = {1.0f, 1.0f};
#pragma unroll
        for (int ai = 0; ai < 2; ++ai)
#pragma unroll
            for (int m = 0; m < 4; ++m) { unsigned char* rowp = O + (size_t)(row0 + ai * HALF + m * 16) * 1024 + a0;
                int w[2] = {0, 0};
#pragma unroll
                for (int n = 0; n < 2; ++n)
#pragma unroll
                    for (int i2 = 0; i2 < 2; ++i2) { const int j = 2 * n + i2;
                        f32x2_ g = (f32x2_){acc[ai][0][m][n][2 * i2], acc[ai][0][m][n][2 * i2 + 1]} + bg[j], l = (f32x2_){acc[ai][1][m][n][2 * i2], acc[ai][1][m][n][2 * i2 + 1]} + bl[j];
                        g.x = fminf(g.x, 7.0f); g.y = fminf(g.y, 7.0f); l.x = __builtin_amdgcn_fmed3f(l.x, -6.0f, 8.0f); l.y = __builtin_amdgcn_fmed3f(l.y, -6.0f, 8.0f);
                        f32x2_ d = g * kexp; d.x = __builtin_amdgcn_exp2f(d.x); d.y = __builtin_amdgcn_exp2f(d.y); d = d + one2;
                        f32x2_ r; r.x = __builtin_amdgcn_rcpf(d.x); r.y = __builtin_amdgcn_rcpf(d.y);
                        const f32x2_ o = (g * r) * l;
                        w[n] = i2 ? __builtin_amdgcn_cvt_pk_fp8_f32(o.x, o.y, w[n], true) : __builtin_amdgcn_cvt_pk_fp8_f32(o.x, o.y, w[n], false); }
                typedef int i32x2_ __attribute__((ext_vector_type(2)));
                *(i32x2_*)rowp = (i32x2_){w[0], w[1]}; }
    }
};
struct EpiSwiglu {
    static constexpr bool PERM = true, AFTER_DRAIN = false;
    bf16_t* O; const float* bias;
    template <class PF> __device__ __forceinline__ void operator()(const f32x4 (&acc)[2][2][4][2], const Unit& u, int wr, int wc, int fr, int fq, const PF& pf) const {
        pf();
        const int row0 = u.pm * BM + wr * 64 + fr; const int a0 = u.pn * HALF + wc * 32 + 8 * fq;
        const float* bp = bias + (size_t)u.e * 2048 + 2 * a0;
        f32x4 b4[4];
#pragma unroll
        for (int j = 0; j < 4; ++j) b4[j] = *(const f32x4*)(bp + 4 * j);
#pragma unroll
        for (int ai = 0; ai < 2; ++ai)
#pragma unroll
            for (int m = 0; m < 4; ++m) { bf16_t* rowp = O + (size_t)(row0 + ai * HALF + m * 16) * 1024 + a0;
                float a[8];
#pragma unroll
                for (int n = 0; n < 2; ++n)
#pragma unroll
                    for (int i = 0; i < 4; ++i) { const int k = 4 * n + i;
                        float g = acc[ai][0][m][n][i] + b4[k >> 1][2 * (k & 1)], l = acc[ai][1][m][n][i] + b4[k >> 1][2 * (k & 1) + 1];
                        g = fminf(g, 7.0f); l = fminf(fmaxf(l, -7.0f), 7.0f);
                        const float sg = __builtin_amdgcn_rcpf(1.0f + __builtin_amdgcn_exp2f(-1.702f * 1.4426950408889634f * g));
                        a[k] = g * sg * (l + 1.0f); }
                u32x4 w; w.x = cvt_pk_bf16(a[0], a[1]); w.y = cvt_pk_bf16(a[2], a[3]); w.z = cvt_pk_bf16(a[4], a[5]); w.w = cvt_pk_bf16(a[6], a[7]);
                *(u32x4*)rowp = w; }
    }
};

template <class Epi, class Sched, bool ALIGN_EPI = false, bool SP2 = false, bool F8 = false, int PFN = 0>
__device__ __forceinline__ void gemm_phase(PG8_LAS unsigned char* lds, const Gemm g, const Sched& S, const Epi& E) {
    int tid = threadIdx.x; asm volatile("" : "+v"(tid));
    const int wid = __builtin_amdgcn_readfirstlane(tid >> 6), lane = tid & 63, wr = wid >> 2, wc = wid & 3, fr = lane & 15, fq = lane >> 4;
    const int K = g.K, PITCH = F8 ? K : 2 * K  , KH = PITCH / 2, nt = g.ktn ? g.ktn : PITCH / (2 * BK);
    unsigned vAc[2][2], vAn[2][2], voffB[2];
    int sR[2], sC[2];
#pragma unroll
    for (int i = 0; i < 2; ++i) { int R, C; stage_rc(tid * 16 + i * 8192, R, C); const int Rb = Epi::PERM ? ((R & ~31) + perm32(R & 31)) : R;
        sR[i] = R; sC[i] = C; voffB[i] = (unsigned)(Rb * KH + C) * 2u; }
    const size_t kstep = (size_t)(BK * 2);
    const size_t hstep = (size_t)HALF * PITCH;
    const size_t tstep = 2 * hstep;
    const unsigned ldsw = (unsigned)wid * 1024u;
    const int aoff = lds_byte(wr * 64 + fr, fq * 8), boff = lds_byte(wc * 32 + fr, fq * 8);
    typedef int v8i_ __attribute__((ext_vector_type(8))); typedef int v4i_ __attribute__((ext_vector_type(4)));
#define PG8_SA(b, h) (((b) * 2 + (h)) * HTB)
#define PG8_SB(b, h) ((4 + (b) * 2 + (h)) * HTB)
#define PG8_STAGE(bufoff, gbase, voff) do { _Pragma("unroll") for (int _i = 0; _i < 2; ++_i) \
        __builtin_amdgcn_global_load_lds((const unsigned*)((const char*)(gbase) + (voff)[_i]), (PG8_LAS unsigned*)(lds + (bufoff) + ldsw + _i * 8192), 16, 0, 0); } while (0)
#define PG8_LDA(dst, b, h) do { if constexpr (F8) { _Pragma("unroll") for (int m = 0; m < 4; ++m) { const v4i_ lo_ = *(const PG8_LAS v4i_*)(lds + PG8_SA(b, h) + aoff + m * 2048), hi_ = *(const PG8_LAS v4i_*)(lds + PG8_SA(b, h) + aoff + m * 2048 + 1024); \
            dst##8[m] = __builtin_shufflevector(lo_, hi_, 0, 1, 2, 3, 4, 5, 6, 7); } } \
        else { _Pragma("unroll") for (int m = 0; m < 4; ++m) _Pragma("unroll") for (int k = 0; k < 2; ++k) dst[m][k] = *(const PG8_LAS bf16x8*)(lds + PG8_SA(b, h) + aoff + m * 2048 + k * 1024); } } while (0)
#define PG8_LDB(dst, b, h) do { if constexpr (F8) { _Pragma("unroll") for (int n = 0; n < 2; ++n) { const v4i_ lo_ = *(const PG8_LAS v4i_*)(lds + PG8_SB(b, h) + boff + n * 2048), hi_ = *(const PG8_LAS v4i_*)(lds + PG8_SB(b, h) + boff + n * 2048 + 1024); \
            dst##8[n] = __builtin_shufflevector(lo_, hi_, 0, 1, 2, 3, 4, 5, 6, 7); } } \
        else { _Pragma("unroll") for (int n = 0; n < 2; ++n) _Pragma("unroll") for (int k = 0; k < 2; ++k) dst[n][k] = *(const PG8_LAS bf16x8*)(lds + PG8_SB(b, h) + boff + n * 2048 + k * 1024); } } while (0)
#define PG8_MMA(ai, bj, At, Bt) do { __builtin_amdgcn_s_setprio(1); if constexpr (F8) asm volatile("s_nop 3"); _Pragma("unroll") for (int m = 0; m < 4; ++m) _Pragma("unroll") for (int n = 0; n < 2; ++n) { \
        if constexpr (F8) asm volatile("v_mfma_scale_f32_16x16x128_f8f6f4 %0, %1, %2, %0, %3, %4 op_sel_hi:[0,0,0]" : "+v"(acc[ai][bj][m][n]) : "v"(Bt##8[n]), "v"(At##8[m]), "v"(swv), "v"(sxv)); \
        else { _Pragma("unroll") for (int k = 0; k < 2; ++k) acc[ai][bj][m][n] = __builtin_amdgcn_mfma_f32_16x16x32_bf16(Bt[n][k], At[m][k], acc[ai][bj][m][n], 0, 0, 0); } } \
        __builtin_amdgcn_s_setprio(0); } while (0)
#define PG8_WAIT_V(n) asm volatile("s_waitcnt vmcnt(" #n ")" ::: "memory")
#define PG8_WAIT_L(n) asm volatile("s_waitcnt lgkmcnt(" #n ")" ::: "memory")
#define PG8_BAR __builtin_amdgcn_s_barrier()
#define PG8_SCHED __builtin_amdgcn_sched_barrier(0)
    Unit cur, nxt; int ui = 0;
    if (!S.next(0, cur)) return;
    f32x4 acc[2][2][4][2];
#pragma unroll
    for (int a = 0; a < 2; ++a)
#pragma unroll
        for (int b = 0; b < 2; ++b)
#pragma unroll
            for (int m = 0; m < 4; ++m)
#pragma unroll
                for (int n = 0; n < 2; ++n) acc[a][b][m][n] = (f32x4){0.f, 0.f, 0.f, 0.f};
    int swv = g.sw, sxv = g.sx;
    bf16x8 At[4][2], B0[2][2], B1[2][2]; v8i_ At8[4], B08[2], B18[2];
    const char* cA = (const char*)g.A + S.a_base(cur, tstep); const char* cB = (const char*)g.Bt + (size_t)cur.pb * tstep;
#pragma unroll
    for (int h = 0; h < 2; ++h)
#pragma unroll
        for (int i = 0; i < 2; ++i) { vAc[h][i] = S.a_off(cur, h * HALF + sR[i], KH) + (unsigned)sC[i] * 2u; vAn[h][i] = vAc[h][i]; }
    S.a_ready(cur);
    if constexpr (SP2) {
        PG8_STAGE(PG8_SB(0, 0), cB, voffB); PG8_STAGE(PG8_SB(0, 1), cB + hstep, voffB); PG8_STAGE(PG8_SA(0, 0), cA, vAc[0]); PG8_STAGE(PG8_SA(0, 1), cA, vAc[1]);
        if (wr == 1) PG8_BAR;
        PG8_WAIT_V(2); PG8_BAR;
        PG8_STAGE(PG8_SB(1, 0), cB + kstep, voffB); PG8_STAGE(PG8_SA(1, 0), cA + kstep, vAc[0]); PG8_STAGE(PG8_SB(1, 1), cB + hstep + kstep, voffB);
        PG8_WAIT_V(6); PG8_BAR;
    } else {
        PG8_STAGE(PG8_SB(0, 0), cB, voffB); PG8_STAGE(PG8_SA(0, 0), cA, vAc[0]); PG8_STAGE(PG8_SB(0, 1), cB + hstep, voffB); PG8_STAGE(PG8_SA(0, 1), cA, vAc[1]);
        if (wr == 1) PG8_BAR;
        PG8_WAIT_V(4); PG8_BAR;
        PG8_STAGE(PG8_SB(1, 0), cB + kstep, voffB); PG8_STAGE(PG8_SA(1, 0), cA + kstep, vAc[0]); PG8_STAGE(PG8_SB(1, 1), cB + hstep + kstep, voffB);
        PG8_WAIT_V(6); PG8_BAR;
    }
#if PROBE_T
#define PT_MARK(k) do { const unsigned long long now_ = PROBE_CLK ? __builtin_amdgcn_s_memtime() : __builtin_amdgcn_s_memrealtime(); if (F8 && tid == 0) { PG8_LAS unsigned* pt_ = (PG8_LAS unsigned*)(lds + 147456 - 1024 + 128); if (pt_[7]) pt_[k] += (unsigned)(now_ - ptl); } ptl = now_; } while (0)
    unsigned long long ptl = PROBE_CLK ? __builtin_amdgcn_s_memtime() : __builtin_amdgcn_s_memrealtime();
#else
#define PT_MARK(k) do {} while (0)
#endif
    for (;;) {
        const bool has_next = S.next(ui + 1, nxt);
        const char* nA = has_next ? (const char*)g.A + S.a_base(nxt, tstep) : cA;
        if (has_next) {
#pragma unroll
            for (int h = 0; h < 2; ++h)
#pragma unroll
                for (int i = 0; i < 2; ++i) vAn[h][i] = S.a_off(nxt, h * HALF + sR[i], KH) + (unsigned)sC[i] * 2u; } const char* nB = has_next ? (const char*)g.Bt + (size_t)nxt.pb * tstep : cB;
        PT_MARK(0);
        for (int t = 0; t < nt; t += 2) {
            const bool last = (t == nt - 2);
            const char* a1 = cA + (size_t)(t + 1) * kstep;
            const char* a2 = last ? nA : cA + (size_t)(t + 2) * kstep; const char* b2 = last ? nB : cB + (size_t)(t + 2) * kstep;
            const char* a3 = a2 + kstep; const char* b3 = b2 + kstep;
            unsigned v2[2][2];
#pragma unroll
            for (int h = 0; h < 2; ++h)
#pragma unroll
                for (int i = 0; i < 2; ++i) v2[h][i] = last ? vAn[h][i] : vAc[h][i];
            if (last && has_next) S.a_ready(nxt);
            if constexpr (SP2) {
            PG8_LDB(B0, 0, 0); PG8_LDB(B1, 0, 1); PG8_SCHED; PG8_LDA(At, 0, 0); PG8_STAGE(PG8_SA(1, 1), a1, vAc[1]);
            PG8_WAIT_V(8); PG8_WAIT_L(0); PG8_BAR; PG8_MMA(0, 0, At, B0); PG8_MMA(0, 1, At, B1); PG8_BAR; PG8_SCHED;
            PG8_LDA(At, 0, 1); PG8_STAGE(PG8_SB(0, 0), b2, voffB); PG8_STAGE(PG8_SB(0, 1), b2 + hstep, voffB); PG8_STAGE(PG8_SA(0, 0), a2, v2[0]);
            PG8_WAIT_V(8); PG8_WAIT_L(0); PG8_BAR; PG8_MMA(1, 0, At, B0); PG8_MMA(1, 1, At, B1); PG8_BAR; PG8_SCHED;
            PG8_LDB(B0, 1, 0); PG8_LDB(B1, 1, 1); PG8_SCHED; PG8_LDA(At, 1, 0); PG8_STAGE(PG8_SA(0, 1), a2, v2[1]);
            PG8_WAIT_V(8); PG8_WAIT_L(0); PG8_BAR; PG8_MMA(0, 0, At, B0); PG8_MMA(0, 1, At, B1); PG8_BAR; PG8_SCHED;
            PG8_LDA(At, 1, 1); PG8_STAGE(PG8_SB(1, 0), b3, voffB); PG8_STAGE(PG8_SB(1, 1), b3 + hstep, voffB); PG8_STAGE(PG8_SA(1, 0), a3, v2[0]);
            PG8_WAIT_V(8); PG8_WAIT_L(0); PG8_BAR; PG8_MMA(1, 0, At, B0); PG8_MMA(1, 1, At, B1); PG8_BAR; PG8_SCHED;
            } else {
            PG8_LDB(B0, 0, 0); PG8_SCHED; PG8_LDA(At, 0, 0); PG8_STAGE(PG8_SA(1, 1), a1, vAc[1]);
            PG8_WAIT_L(8); PG8_BAR; PG8_WAIT_L(0); PG8_MMA(0, 0, At, B0); PG8_BAR; PG8_SCHED;
            PG8_LDB(B1, 0, 1); PG8_STAGE(PG8_SB(0, 0), b2, voffB);
            PG8_BAR; PG8_WAIT_L(0); PG8_MMA(0, 1, At, B1); PG8_BAR;
            PG8_LDA(At, 0, 1); PG8_STAGE(PG8_SA(0, 0), a2, v2[0]);
            PG8_BAR; PG8_WAIT_L(0); PG8_MMA(1, 0, At, B0); PG8_BAR; PG8_SCHED;
            PG8_STAGE(PG8_SB(0, 1), b2 + hstep, voffB);
            PG8_WAIT_V(6); PG8_BAR; PG8_MMA(1, 1, At, B1); PG8_BAR;
            PG8_LDB(B0, 1, 0); PG8_SCHED; PG8_LDA(At, 1, 0); PG8_STAGE(PG8_SA(0, 1), a2, v2[1]);
            PG8_WAIT_L(8); PG8_BAR; PG8_WAIT_L(0); PG8_MMA(0, 0, At, B0); PG8_BAR; PG8_SCHED;
            PG8_LDB(B1, 1, 1); PG8_STAGE(PG8_SB(1, 0), b3, voffB);
            PG8_BAR; PG8_WAIT_L(0); PG8_MMA(0, 1, At, B1); PG8_BAR;
            PG8_LDA(At, 1, 1); PG8_STAGE(PG8_SA(1, 0), a3, v2[0]);
            PG8_BAR; PG8_WAIT_L(0); PG8_MMA(1, 0, At, B0); PG8_BAR; PG8_SCHED;
            PG8_STAGE(PG8_SB(1, 1), b3 + hstep, voffB);
            PG8_WAIT_V(6); PG8_BAR; PG8_MMA(1, 1, At, B1); PG8_BAR;
            }
        }
        PT_MARK(1);
        if constexpr (F8) {
#pragma unroll
            for (int a = 0; a < 2; ++a)
#pragma unroll
                for (int b = 0; b < 2; ++b) asm volatile("s_nop 15\n\ts_nop 7" : "+v"(acc[a][b][0][0]), "+v"(acc[a][b][0][1]), "+v"(acc[a][b][1][0]), "+v"(acc[a][b][1][1]), "+v"(acc[a][b][2][0]), "+v"(acc[a][b][2][1]), "+v"(acc[a][b][3][0]), "+v"(acc[a][b][3][1])); }
        if constexpr (ALIGN_EPI) { if (wr == 0) PG8_BAR; }
        auto pfl = [&]() { if constexpr (PFN > 0) { if (has_next) { const int kq = (tid & 3) + 4 * ((tid >> 6) & 1);
#pragma unroll
            for (int rp = 0; rp < (PFN + 7) / 8; ++rp) { const int kt = 2 + kq + 8 * rp;
                if (kt < 2 + PFN && kt < nt) { const size_t ko = (size_t)kt * kstep; PG8_LAS unsigned* junk = (PG8_LAS unsigned*)(lds + PF_JUNK_OFF + wid * 256);
#pragma unroll
                    for (int h = 0; h < 2; ++h)
#pragma unroll
                        for (int i = 0; i < 2; ++i) { __builtin_amdgcn_global_load_lds((const unsigned*)(nA + vAn[h][i] + ko), junk, 4, 0, 0); __builtin_amdgcn_global_load_lds((const unsigned*)(nB + h * hstep + voffB[i] + ko), junk, 4, 0, 0); } } } } } };
        if constexpr (!Epi::AFTER_DRAIN) { E(acc, cur, wr, wc, fr, fq, pfl); S.done(cur); }   PT_MARK(2);
        if (!has_next) break;
#pragma unroll
        for (int a = 0; a < 2; ++a)
#pragma unroll
            for (int b = 0; b < 2; ++b)
#pragma unroll
                for (int m = 0; m < 4; ++m)
#pragma unroll
                    for (int n = 0; n < 2; ++n) acc[a][b][m][n] = (f32x4){0.f, 0.f, 0.f, 0.f};
        cur = nxt; cA = nA; cB = nB; ++ui;
#pragma unroll
        for (int h = 0; h < 2; ++h)
#pragma unroll
            for (int i = 0; i < 2; ++i) vAc[h][i] = vAn[h][i];
        if constexpr (ALIGN_EPI) { if (wr == 1) PG8_BAR; }
    }
    PG8_WAIT_V(0);
    if constexpr (!ALIGN_EPI) { if (wr == 0) PG8_BAR; }
    PG8_BAR;
    if constexpr (Epi::AFTER_DRAIN) { E.fused(acc, cur, wr, wc, fr, fq, lds, wid, lane); S.done(cur); }
#undef PT_MARK
#undef PG8_SA
#undef PG8_SB
#undef PG8_STAGE
#undef PG8_LDA
#undef PG8_LDB
#undef PG8_MMA
#undef PG8_WAIT_V
#undef PG8_WAIT_L
#undef PG8_BAR
#undef PG8_SCHED
}
}
#define GAS __attribute__((address_space(1)))
#define LAS __attribute__((address_space(3)))
typedef unsigned short bf16;
typedef unsigned v4u __attribute__((ext_vector_type(4)));
typedef float f32x4 __attribute__((ext_vector_type(4)));
typedef short bf16x8 __attribute__((ext_vector_type(8)));
typedef GAS unsigned gu32;
typedef GAS unsigned long long gu64;
#define RLX_AGENT __ATOMIC_RELAXED, __HIP_MEMORY_SCOPE_AGENT
#define LDS_WAIT() asm volatile("s_waitcnt lgkmcnt(0)" ::: "memory")
#define VM_WAIT() asm volatile("s_waitcnt vmcnt(0)" ::: "memory")
__device__ __forceinline__ unsigned long long rt() { return __builtin_amdgcn_s_memrealtime(); }
__device__ __forceinline__ unsigned f2bf(float f) { unsigned u = __builtin_bit_cast(unsigned, f); return (u + 0x7fffu + ((u >> 16) & 1u)) >> 16; }
__device__ __forceinline__ unsigned pk2s(float lo, float hi) { return f2bf(lo) | (f2bf(hi) << 16); }
__device__ __forceinline__ unsigned f2bfh(float f);
__device__ __forceinline__ unsigned pk2(float lo, float hi) { unsigned r; asm("v_cvt_pk_bf16_f32 %0, %1, %2" : "=v"(r) : "v"(lo), "v"(hi)); return r; }
__device__ __forceinline__ unsigned f2bfh(float f) { return pk2(f, f) & 0xffffu; }

#define XB_TMO      128
#define XB_XCNT(j)  (256  + 64 * (j))
#define XB_XSUB(j)  (1280 + 64 * (j))
#define XB_XGEN(j)  (2304 + 64 * (j))
#define XB_TOP      3328
#define XB_TOPGEN   3392
#define XCD_BAR_WORDS 3456
#define XB_SPIN_CAP (1u << 18)

__device__ __forceinline__ unsigned xb_ld(unsigned* p)              { return __hip_atomic_load(p, __ATOMIC_RELAXED, __HIP_MEMORY_SCOPE_AGENT); }
__device__ __forceinline__ unsigned xb_add(unsigned* p, unsigned v) { return __hip_atomic_fetch_add(p, v, __ATOMIC_RELAXED, __HIP_MEMORY_SCOPE_AGENT); }
__device__ __forceinline__ unsigned xb_xcc_id() { return (unsigned)__builtin_amdgcn_s_getreg((3 << 11) | 20) & 0xFu; }
#define XB_SPIN(cond, bar) do { unsigned _sp = 0; while (cond) { __builtin_amdgcn_s_sleep(1); \
    if ((++_sp & 255u) == 0u) { if (xb_ld(&(bar)[XB_TMO])) break; if (_sp > XB_SPIN_CAP) { atomicAdd(&(bar)[XB_TMO], 1u); break; } } } } while (0)

struct XcdBarrier {
    unsigned* bar; unsigned x;
    volatile LAS unsigned* st;
};

__device__ __forceinline__ XcdBarrier xcd_barrier_post(unsigned* bar, volatile LAS unsigned* st) {
    XcdBarrier b; b.bar = bar; b.x = xb_xcc_id(); b.st = st;
    if (threadIdx.x == 0) (void)xb_add(&bar[XB_XCNT(b.x)], 1u);
    return b;
}
__device__ __forceinline__ void xcd_barrier_complete(unsigned* bar, unsigned x, unsigned& nloc, unsigned& nx) {
    const unsigned G = gridDim.x * gridDim.y * gridDim.z;
    unsigned sum, cnt, mine, sp = 0u;
    for (;;) {
        sum = 0u; cnt = 0u; mine = 0u;
#pragma unroll
        for (unsigned j = 0; j < 16; ++j) { const unsigned c = xb_ld(&bar[XB_XCNT(j)]); sum += c; cnt += (c > 0u) ? 1u : 0u; mine = (j == x) ? c : mine; }
        if (sum == G) break;
        __builtin_amdgcn_s_sleep(1);
        if ((++sp & 255u) == 0u) { if (xb_ld(&bar[XB_TMO])) break; if (sp > XB_SPIN_CAP) { atomicAdd(&bar[XB_TMO], 1u); break; } }
    }
    nloc = mine > 0u ? mine : 1u; nx = cnt > 0u ? cnt : 1u;
}

__device__ __forceinline__ void xcd_barrier(const XcdBarrier& b) {
    asm volatile("s_waitcnt vmcnt(0)" ::: "memory");
    __syncthreads();
    if (threadIdx.x == 0) {
        unsigned* bar = b.bar;
        __builtin_amdgcn_s_waitcnt(0);
        unsigned nloc = b.st[0], nx = b.st[1];
        if (nloc == 0u) { xcd_barrier_complete(bar, b.x, nloc, nx); b.st[0] = nloc; b.st[1] = nx; }
        const unsigned old = xb_add(&bar[XB_XSUB(b.x)], 1u);
        const unsigned gen = old / nloc;
        if (old + 1u == (gen + 1u) * nloc) {
            __builtin_amdgcn_fence(__ATOMIC_RELEASE, "agent");
            asm volatile("s_waitcnt vmcnt(0)" ::: "memory");
            const unsigned og = xb_add(&bar[XB_TOP], 1u);
            const unsigned tg = og / nx;
            if (og + 1u == (tg + 1u) * nx) xb_add(&bar[XB_TOPGEN], 1u);
            else XB_SPIN(xb_ld(&bar[XB_TOPGEN]) == tg, bar);
            __builtin_amdgcn_fence(__ATOMIC_ACQUIRE, "agent");
            xb_add(&bar[XB_XGEN(b.x)], 1u);
            asm volatile("s_waitcnt vmcnt(0)" ::: "memory");
        } else {
            XB_SPIN(xb_ld(&bar[XB_XGEN(b.x)]) == gen, bar);
            __builtin_amdgcn_fence(__ATOMIC_ACQUIRE, "agent");
            asm volatile("s_waitcnt vmcnt(0)" ::: "memory");
        }
    }
    __syncthreads();
}

using pg8::bf16_t;
typedef unsigned u32x2 __attribute__((ext_vector_type(2)));
__device__ __forceinline__ float bf2f(unsigned v) { return __uint_as_float(v << 16); }
__device__ __forceinline__ float bflo(unsigned w) { return __uint_as_float(w << 16); }
__device__ __forceinline__ float bfhi(unsigned w) { return __uint_as_float(w & 0xffff0000u); }
__device__ __forceinline__ float wave_sum(float v) {
#pragma unroll
    for (int o = 1; o < 64; o <<= 1) v += __shfl_xor(v, o);
    return v;
}
__device__ __forceinline__ float sigm(float x) { return __builtin_amdgcn_rcpf(1.0f + __builtin_amdgcn_exp2f(-1.4426950408889634f * x)); }
__device__ __forceinline__ float rsq(float x) { return __builtin_amdgcn_rsqf(x); }
__device__ __forceinline__ float softplusf_(float x) { return fmaxf(x, 0.f) + log1pf(expf(-fabsf(x))); }
__device__ __forceinline__ float gelu_tanh(float x) { const float y = 0.7978845608028654f * (x + 0.044715f * x * x * x);
    return x * __builtin_amdgcn_rcpf(1.0f + __builtin_amdgcn_exp2f(-2.0f * 1.4426950408889634f * y)); }

__device__ __forceinline__ int gu_rowmap(int n) { const int a = n >> 1; return ((a >> 7) << 8) + (a & 127) + ((n & 1) << 7); }
struct TDesc { const float* W; bf16* WT; int ldw, K, k0, n0, gu; float f8s; };
__device__ __forceinline__ void tload(const TDesc& d, f32x4 (&v)[16], int lane) {
#pragma unroll
    for (int i = 0; i < 16; ++i) v[i] = __builtin_nontemporal_load((const f32x4*)(d.W + (size_t)(d.k0 + 4 * i + (lane >> 4)) * d.ldw + d.n0 + 4 * (lane & 15)));
}
__device__ __forceinline__ void tstore(const TDesc& d, const f32x4 (&v)[16], LAS float* scr, int lane) {
#pragma unroll
    for (int i = 0; i < 16; ++i) { LAS float* p = scr + (4 * i + (lane >> 4)) * 65 + 4 * (lane & 15); p[0] = v[i][0]; p[1] = v[i][1]; p[2] = v[i][2]; p[3] = v[i][3]; }
    LDS_WAIT(); asm volatile("" ::: "memory");
    const int c = lane & 7;
#pragma unroll
    for (int j = 0; j < 8; ++j) { const int n = 8 * j + (lane >> 3); const LAS float* s = scr + (8 * c) * 65 + n;
        const int nr = d.gu ? gu_rowmap(d.n0 + n) : (d.n0 + n);
        if (d.f8s != 0.f) { const float f = d.f8s; int w0 = 0, w1 = 0;
            w0 = __builtin_amdgcn_cvt_pk_fp8_f32(pg8::f8clamp(s[0] * f), pg8::f8clamp(s[65] * f), w0, false); w0 = __builtin_amdgcn_cvt_pk_fp8_f32(pg8::f8clamp(s[130] * f), pg8::f8clamp(s[195] * f), w0, true);
            w1 = __builtin_amdgcn_cvt_pk_fp8_f32(pg8::f8clamp(s[260] * f), pg8::f8clamp(s[325] * f), w1, false); w1 = __builtin_amdgcn_cvt_pk_fp8_f32(pg8::f8clamp(s[390] * f), pg8::f8clamp(s[455] * f), w1, true);
            u32x2 o; o.x = (unsigned)w0; o.y = (unsigned)w1; __builtin_nontemporal_store(o, (u32x2*)((unsigned char*)d.WT + (size_t)nr * d.K + d.k0 + 8 * c)); }
        else { v4u o; o.x = pg8::cvt_pk_bf16(s[0], s[65]); o.y = pg8::cvt_pk_bf16(s[130], s[195]); o.z = pg8::cvt_pk_bf16(s[260], s[325]); o.w = pg8::cvt_pk_bf16(s[390], s[455]);
            __builtin_nontemporal_store(o, (v4u*)(d.WT + (size_t)nr * d.K + d.k0 + 8 * c)); } }
    LDS_WAIT(); asm volatile("" ::: "memory");
}
constexpr int IT_WIN = 16 * 52, IT_WOUT = 256, IT_GU = 512, IT_DN = 256;
constexpr int NIT_WIN = DEPTH * IT_WIN, NIT_WOUT = DEPTH * IT_WOUT, NIT_GU = DEPTH * NE * IT_GU, NIT_DN = DEPTH * NE * IT_DN, NITEMS = NIT_WIN + NIT_WOUT + NIT_GU + NIT_DN;

__device__ __forceinline__ void stage_dtw(const float* win_l, LAS float* dtw, int tid) {
    for (int k = tid; k < DM; k += NTHR) *(LAS f32x4*)(dtw + 4 * k) = *(const f32x4*)(win_l + (size_t)k * DIN + C_DT);
    __syncthreads();
}
__device__ __forceinline__ void emit_xn_dt(const f32x4 (&v)[4], const float* g, const LAS float* dtw, bf16* xn_row, float* dt_row, int lane) {
    float ss = 0.f;
#pragma unroll
    for (int j = 0; j < 4; ++j) ss += (v[j][0] * v[j][0] + v[j][1] * v[j][1]) + (v[j][2] * v[j][2] + v[j][3] * v[j][3]);
    ss = wave_sum(ss);
    const float rstd = rsq(ss * (1.0f / DM) + EPS);
    float d0 = 0.f, d1 = 0.f, d2 = 0.f, d3 = 0.f;
#pragma unroll
    for (int j = 0; j < 4; ++j) { const int col = 256 * j + 4 * lane; const f32x4 gg = *(const f32x4*)(g + col); const f32x4 u = v[j] * rstd * gg;
        u32x2 w; w.x = pk2(u[0], u[1]); w.y = pk2(u[2], u[3]); *(u32x2*)(xn_row + col) = w;
#pragma unroll
        for (int i = 0; i < 4; ++i) { const f32x4 ww = *(const LAS f32x4*)(dtw + 4 * (col + i)); d0 += u[i] * ww[0]; d1 += u[i] * ww[1]; d2 += u[i] * ww[2]; d3 += u[i] * ww[3]; } }
    d0 = wave_sum(d0); d1 = wave_sum(d1); d2 = wave_sum(d2); d3 = wave_sum(d3);
    if (lane == 0) *(f32x4*)dt_row = (f32x4){d0, d1, d2, d3};
}

__device__ __forceinline__ void norm_rows4(const bf16* orow, const bf16* prow, bf16* mrow, const float* gA, const float* gB, const float* gC, const float* gD, int lane) {
    const int c = 4 * lane;
    f32x4 v[4][4]; u32x2 gw[4];
#pragma unroll
    for (int r = 0; r < 4; ++r) {
#pragma unroll
        for (int j = 0; j < 4; ++j) { const u32x2 w = *(const u32x2*)(orow + (size_t)r * DM + 256 * j + c); v[r][j] = (f32x4){bflo(w.x), bfhi(w.x), bflo(w.y), bfhi(w.y)}; }
        gw[r] = *(const u32x2*)(prow + (size_t)r * DING + C_HGG + c); }
    const f32x4 g0 = *(const f32x4*)(gA + c), g1 = *(const f32x4*)(gB + c), g2 = *(const f32x4*)(gC + c), g3 = *(const f32x4*)(gD + c);
#pragma unroll
    for (int r = 0; r < 4; ++r) {
        float s[4];
#pragma unroll
        for (int j = 0; j < 4; ++j) s[j] = (v[r][j][0] * v[r][j][0] + v[r][j][1] * v[r][j][1]) + (v[r][j][2] * v[r][j][2] + v[r][j][3] * v[r][j][3]);
#pragma unroll
        for (int o = 1; o < 64; o <<= 1) { s[0] += __shfl_xor(s[0], o); s[1] += __shfl_xor(s[1], o); if (o < 16) s[2] += __shfl_xor(s[2], o); if (o < 32) s[3] += __shfl_xor(s[3], o); }
        const float r0 = rsq(s[0] * (1.0f / 256) + EPS), r1 = rsq(s[1] * (1.0f / 256) + EPS), r2 = rsq(s[2] * (1.0f / 64) + EPS), r3 = rsq(s[3] * (1.0f / 128) + EPS);
        const float gi[4] = {bflo(gw[r].x), bfhi(gw[r].x), bflo(gw[r].y), bfhi(gw[r].y)};
        f32x4 o0 = v[r][0] * r0 * g0, o1 = v[r][1] * r1 * g1, o2 = v[r][2] * r2 * g2, o3 = v[r][3] * r3 * g3;
#pragma unroll
        for (int i = 0; i < 4; ++i) o2[i] *= gi[i] * sigm(gi[i]);
        bf16* mr = mrow + (size_t)r * DM; u32x2 w;
        w.x = pk2(o0[0], o0[1]); w.y = pk2(o0[2], o0[3]); *(u32x2*)(mr + c) = w;
        w.x = pk2(o1[0], o1[1]); w.y = pk2(o1[2], o1[3]); *(u32x2*)(mr + 256 + c) = w;
        w.x = pk2(o2[0], o2[1]); w.y = pk2(o2[2], o2[3]); *(u32x2*)(mr + 512 + c) = w;
        w.x = pk2(o3[0], o3[1]); w.y = pk2(o3[2], o3[3]); *(u32x2*)(mr + 768 + c) = w; }
}

__device__ __forceinline__ void build_tb(const int* tot, LAS int* tb, int tid) {
    if (tid < 64) { const int t = tid < 32 ? (tot[tid] + 255) >> 8 : 0; int incl = t;
#pragma unroll
        for (int o = 1; o < 32; o <<= 1) { const int nb = __shfl_up(incl, o); if ((tid & 63) >= o) incl += nb; }
        if (tid < 32) tb[tid] = incl - t;
        if (tid == 31) tb[32] = incl; }
    __syncthreads();
}

typedef short s16x4 __attribute__((ext_vector_type(4)));
typedef short v4i16_t __attribute__((ext_vector_type(4)));
#define MFMA16(a, b, c) __builtin_amdgcn_mfma_f32_16x16x32_bf16((a), (b), (c), 0, 0, 0)
__device__ __forceinline__ bf16x8 frag_kc(const LAS bf16* M, int ld, int idx0, int k0, int lane) { return *(const LAS bf16x8*)(M + (idx0 + (lane & 15)) * ld + k0 + 8 * (lane >> 4)); }
__device__ __forceinline__ bf16x8 frag_ks(const LAS bf16* M, int ld, int idx0, int k0, int lane) {
    const LAS bf16* p = M + (k0 + 8 * (lane >> 4) + ((lane & 15) >> 2)) * ld + idx0 + 4 * (lane & 3);
    const s16x4 lo = __builtin_bit_cast(s16x4, __builtin_amdgcn_ds_read_tr16_b64_v4i16((LAS v4i16_t*)p));
    const s16x4 hi = __builtin_bit_cast(s16x4, __builtin_amdgcn_ds_read_tr16_b64_v4i16((LAS v4i16_t*)(p + 4 * ld)));
    return (bf16x8){lo[0], lo[1], lo[2], lo[3], hi[0], hi[1], hi[2], hi[3]};
}
__device__ __forceinline__ bf16x8 frag_g32(const float* M, int ld, int idx0, int k0, int lane) {
    const float* p = M + (size_t)(idx0 + (lane & 15)) * ld + k0 + 8 * (lane >> 4);
    const f32x4 a = *(const f32x4*)p, b = *(const f32x4*)(p + 4);
    v4u w; w.x = pk2(a[0], a[1]); w.y = pk2(a[2], a[3]); w.z = pk2(b[0], b[1]); w.w = pk2(b[2], b[3]);
    return __builtin_bit_cast(bf16x8, w);
}
__device__ __forceinline__ float fsigm(float x) { return __builtin_amdgcn_rcpf(1.0f + __builtin_amdgcn_exp2f(-1.4426950408889634f * x)); }
__device__ __forceinline__ float fexp(float x) { return __builtin_amdgcn_exp2f(1.4426950408889634f * x); }

constexpr int M2LD = 136, M2WLD = 72;
__device__ __forceinline__ void m2_conv_block(const bf16* proj, const float* cw, const float* cb, int b, int t0, int tq, int cc0, float (&o)[8][8]) {
    v4u x[11]; f32x4 w[4][2];
    const int ts0 = t0 + 8 * tq - 3;
#pragma unroll
    for (int r = 0; r < 11; ++r) { const int ts = ts0 + r; x[r] = (v4u){0u, 0u, 0u, 0u}; if (ts >= 0) x[r] = __builtin_nontemporal_load((const v4u*)(proj + ((size_t)b * SEQ + ts) * DING + C_M2X + cc0)); }
#pragma unroll
    for (int k = 0; k < 4; ++k) { w[k][0] = *(const f32x4*)(cw + k * 768 + cc0); w[k][1] = *(const f32x4*)(cw + k * 768 + cc0 + 4); }
    const f32x4 b0 = *(const f32x4*)(cb + cc0), b1 = *(const f32x4*)(cb + cc0 + 4);
#pragma unroll
    for (int j = 0; j < 8; ++j) { float a[8] = {b0[0], b0[1], b0[2], b0[3], b1[0], b1[1], b1[2], b1[3]};
#pragma unroll
        for (int k = 0; k < 4; ++k) { const v4u xv = x[j + k];
            a[0] += w[k][0][0] * bflo(xv[0]); a[1] += w[k][0][1] * bfhi(xv[0]); a[2] += w[k][0][2] * bflo(xv[1]); a[3] += w[k][0][3] * bfhi(xv[1]);
            a[4] += w[k][1][0] * bflo(xv[2]); a[5] += w[k][1][1] * bfhi(xv[2]); a[6] += w[k][1][2] * bflo(xv[3]); a[7] += w[k][1][3] * bfhi(xv[3]); }
#pragma unroll
        for (int i = 0; i < 8; ++i) o[j][i] = a[i] * fsigm(a[i]); }
}
__device__ __forceinline__ void m2_dt_scan(const float* dtraw, const float* dt_bias, const float* a_log, int b, int t0, int g, LAS float* dt_s, LAS float* acs_s, LAS float* w_s, float* dec_out, int tid) {
    if (tid >= 384) { const int hh = (tid - 384) >> 6, t = tid & 63, h = 2 * g + hh;
        const float dtv = softplusf_(dtraw[((size_t)b * SEQ + t0 + t) * 4 + h] + dt_bias[h]);
        float v = dtv * (-expf(a_log[h]));
#pragma unroll
        for (int o = 1; o < 64; o <<= 1) { const float nb = __shfl_up(v, o); if (t >= o) v += nb; }
        const float last = __shfl(v, 63);
        dt_s[hh * 64 + t] = dtv; acs_s[hh * 64 + t] = v; w_s[hh * 64 + t] = expf(last - v) * dtv;
        if (dec_out && t == 63) dec_out[h] = expf(last); }
}
__device__ __forceinline__ void m2_state_unit(const bf16* proj, const float* dtraw, float* sloc, float* dec, int b, int ch, int g, const float* cw, const float* cb, const float* dt_bias, const float* a_log, LAS unsigned char* lds, int tid) {
    LAS bf16* XS = (LAS bf16*)lds; LAS bf16* BS = XS + 64 * M2LD; LAS float* dt_s = (LAS float*)(BS + 64 * M2LD); LAS float* acs_s = dt_s + 128; LAS float* w_s = acs_s + 128;
    const int lane = tid & 63, w = tid >> 6, t0 = ch * 64;
    m2_dt_scan(dtraw, dt_bias, a_log, b, t0, g, dt_s, acs_s, w_s, dec + (size_t)(b * 32 + ch) * 4, tid);
    float o[8][8]; const int cg = tid & 31, tq = tid >> 5;
    if (tid < 256) m2_conv_block(proj, cw, cb, b, t0, tq, cg < 16 ? g * 128 + 8 * cg : 256 + g * 128 + 8 * (cg - 16), o);
    __syncthreads();
    if (tid < 256) {
#pragma unroll
        for (int j = 0; j < 8; ++j) { const int t = 8 * tq + j; const float sc = cg < 16 ? w_s[(cg >> 3) * 64 + t] : 1.0f;
            v4u q; q.x = pk2(o[j][0] * sc, o[j][1] * sc); q.y = pk2(o[j][2] * sc, o[j][3] * sc); q.z = pk2(o[j][4] * sc, o[j][5] * sc); q.w = pk2(o[j][6] * sc, o[j][7] * sc);
            *(LAS v4u*)((cg < 16 ? XS + 8 * cg : BS + 8 * (cg - 16)) + t * M2LD) = q; } }
    __syncthreads();
    { const int hh = w >> 2, mi = w & 3;
        const bf16x8 a0 = frag_ks(XS, M2LD, hh * 64 + mi * 16, 0, lane), a1 = frag_ks(XS, M2LD, hh * 64 + mi * 16, 32, lane);
        bf16* outp = (bf16*)sloc + ((size_t)((b * 32 + ch) * 4 + 2 * g + hh) * 64 + mi * 16 + (lane & 15)) * 128 + 4 * (lane >> 4);
#pragma unroll
        for (int ni = 0; ni < 8; ++ni) { const bf16x8 b0 = frag_ks(BS, M2LD, ni * 16, 0, lane), b1 = frag_ks(BS, M2LD, ni * 16, 32, lane);
            f32x4 acc = {0.f, 0.f, 0.f, 0.f}; acc = MFMA16(b0, a0, acc); acc = MFMA16(b1, a1, acc);
            u32x2 o; o.x = pk2s(acc[0], acc[1]); o.y = pk2s(acc[2], acc[3]); *(u32x2*)(outp + ni * 16) = o; } }
    __syncthreads();
}
#if PROBE_T
#define M2PT_DECL unsigned long long m2t_ = __builtin_amdgcn_s_memrealtime()
#define M2PT(k) do { const unsigned long long n_ = __builtin_amdgcn_s_memrealtime(); if (PROBE_PH == 33 && tid == 0) ((LAS unsigned*)(lds + 147456 - 1024 + 128))[k] += (unsigned)(n_ - m2t_); m2t_ = n_; } while (0)
#else
#define M2PT_DECL
#define M2PT(k) do {} while (0)
#endif
__device__ __forceinline__ void m2_out_unit(const bf16* proj, const float* dtraw, const bf16* prevb, bf16* oraw, int b, int ch, int g, const float* cw, const float* cb, const float* dt_bias, const float* a_log, const float* dskip, LAS unsigned char* lds, int tid) {
    LAS bf16* XS = (LAS bf16*)lds; LAS bf16* BS = XS + 64 * M2LD; LAS bf16* CS = BS + 64 * M2LD; LAS bf16* WS = CS + 64 * M2LD;
    LAS float* dt_s = (LAS float*)(WS + 2 * 64 * M2WLD); LAS float* acs_s = dt_s + 128; LAS float* w_s = acs_s + 128; LAS bf16* ZS = (LAS bf16*)(w_s + 128);
    const int lane = tid & 63, w = tid >> 6, t0 = ch * 64;
    M2PT_DECL;
    bf16x8 pf[4][4];
    { const bf16* pv = prevb + (size_t)((b * 32 + ch) * 4 + 2 * g + (w >> 2)) * 64 * 128;
#pragma unroll
        for (int kk = 0; kk < 4; ++kk)
#pragma unroll
            for (int ni = 0; ni < 4; ++ni) pf[kk][ni] = __builtin_nontemporal_load((const bf16x8*)(pv + (size_t)(ni * 16 + (lane & 15)) * 128 + 32 * kk + 8 * (lane >> 4))); }
    v4u zr[8];
    if (tid >= 384) {
#pragma unroll
        for (int j = 0; j < 8; ++j) { const int c = (tid - 384) + 128 * j; zr[j] = __builtin_nontemporal_load((const v4u*)(proj + ((size_t)b * SEQ + t0 + (c >> 4)) * DING + C_M2Z + g * 128 + 8 * (c & 15))); } }
    m2_dt_scan(dtraw, dt_bias, a_log, b, t0, g, dt_s, acs_s, w_s, nullptr, tid);
    if (tid >= 384) {
#pragma unroll
        for (int j = 0; j < 8; ++j) { const int c = (tid - 384) + 128 * j; *(LAS v4u*)(ZS + (c >> 4) * M2LD + 8 * (c & 15)) = zr[j]; } }
    if (tid < 384) { float o[8][8]; const int cg = tid % 48, tq = tid / 48;
        const int cc0 = cg < 16 ? g * 128 + 8 * cg : cg < 32 ? 256 + g * 128 + 8 * (cg - 16) : 512 + g * 128 + 8 * (cg - 32);
        m2_conv_block(proj, cw, cb, b, t0, tq, cc0, o);
        LAS bf16* dst = cg < 16 ? XS + 8 * cg : cg < 32 ? BS + 8 * (cg - 16) : CS + 8 * (cg - 32);
#pragma unroll
        for (int j = 0; j < 8; ++j) { v4u q; q.x = pk2(o[j][0], o[j][1]); q.y = pk2(o[j][2], o[j][3]); q.z = pk2(o[j][4], o[j][5]); q.w = pk2(o[j][6], o[j][7]); *(LAS v4u*)(dst + (8 * tq + j) * M2LD) = q; } }
    __syncthreads(); M2PT(0);
    { const int mi = w >> 1, ni0 = (w & 1) * 2;
        f32x4 acc[2] = {{0.f, 0.f, 0.f, 0.f}, {0.f, 0.f, 0.f, 0.f}};
#pragma unroll
        for (int kk = 0; kk < 4; ++kk) { const bf16x8 a = frag_kc(CS, M2LD, mi * 16, 32 * kk, lane);
#pragma unroll
            for (int q = 0; q < 2; ++q) { const bf16x8 bb = frag_kc(BS, M2LD, (ni0 + q) * 16, 32 * kk, lane); acc[q] = MFMA16(a, bb, acc[q]); } }
#pragma unroll
        for (int q = 0; q < 2; ++q) { const int s = (ni0 + q) * 16 + (lane & 15);
#pragma unroll
            for (int hh = 0; hh < 2; ++hh) { const float as = acs_s[hh * 64 + s], ds = dt_s[hh * 64 + s];
#pragma unroll
                for (int i = 0; i < 4; ++i) { const int l = mi * 16 + 4 * (lane >> 4) + i;
                    const float v = (s <= l) ? acc[q][i] * fexp(acs_s[hh * 64 + l] - as) * ds : 0.f;
                    WS[(hh * 64 + l) * M2WLD + s] = (bf16)f2bfh(v); } } } }
    __syncthreads(); M2PT(1);
    { const int hh = w >> 2, mi = w & 3, h = 2 * g + hh;
        f32x4 yd[4], yo[4];
#pragma unroll
        for (int ni = 0; ni < 4; ++ni) { yd[ni] = (f32x4){0.f, 0.f, 0.f, 0.f}; yo[ni] = (f32x4){0.f, 0.f, 0.f, 0.f}; }
#pragma unroll
        for (int kk = 0; kk < 2; ++kk) { const bf16x8 a = frag_kc(WS + hh * 64 * M2WLD, M2WLD, mi * 16, 32 * kk, lane);
#pragma unroll
            for (int ni = 0; ni < 4; ++ni) { const bf16x8 bb = frag_ks(XS, M2LD, hh * 64 + ni * 16, 32 * kk, lane); yd[ni] = MFMA16(a, bb, yd[ni]); } }
#pragma unroll
        for (int kk = 0; kk < 4; ++kk) { const bf16x8 a = frag_kc(CS, M2LD, mi * 16, 32 * kk, lane);
#pragma unroll
            for (int ni = 0; ni < 4; ++ni) yo[ni] = MFMA16(a, pf[kk][ni], yo[ni]); }
        const float Dh = dskip[h];
#pragma unroll
        for (int i = 0; i < 4; ++i) { const int l = mi * 16 + 4 * (lane >> 4) + i; const float ea = fexp(acs_s[hh * 64 + l]); const size_t row = (size_t)b * SEQ + t0 + l;
#pragma unroll
            for (int ni = 0; ni < 4; ++ni) { const int p = ni * 16 + (lane & 15);
                const float xv = bf2f(XS[l * M2LD + hh * 64 + p]), zv = bf2f(ZS[l * M2LD + hh * 64 + p]);
                const float y = yd[ni][i] + ea * yo[ni][i] + xv * Dh;
                oraw[row * DM + 768 + h * 64 + p] = (bf16)f2bfh(y * (zv * fsigm(zv))); } } }
    __syncthreads(); M2PT(2);
}

constexpr int HGLD = 136, HGWLD = 72;
template <bool WITH_Q>
__device__ __forceinline__ void hg_prep(const bf16* proj, int b, int t0, int hp, const float* lb1, int layer, LAS float* bc_s, LAS bf16* QS, LAS bf16* KS, LAS bf16* VS, LAS bf16* Q2, int tid) {
    const int c0 = (tid & 15) * 8, ta = tid >> 4;
    float lb[8];
#pragma unroll
    for (int i = 0; i < 8; ++i) lb[i] = 0.f;
    if (layer == 1) { const f32x4 l0 = *(const f32x4*)(lb1 + hp * 128 + c0), l1 = *(const f32x4*)(lb1 + hp * 128 + c0 + 4); lb[0] = l0[0]; lb[1] = l0[1]; lb[2] = l0[2]; lb[3] = l0[3]; lb[4] = l1[0]; lb[5] = l1[1]; lb[6] = l1[2]; lb[7] = l1[3]; }
    v4u fw[2], iw[2], qw[2];
#pragma unroll
    for (int u = 0; u < 2; ++u) { const size_t row = (size_t)b * SEQ + t0 + ta + 32 * u;
        fw[u] = __builtin_nontemporal_load((const v4u*)(proj + row * DING + C_HGF + hp * 128 + c0)); iw[u] = __builtin_nontemporal_load((const v4u*)(proj + row * DING + C_HGI + hp * 128 + c0));
        if (WITH_Q) qw[u] = __builtin_nontemporal_load((const v4u*)(proj + row * DING + C_HGQ + hp * 128 + c0)); }
    float key[2][8];
#pragma unroll
    for (int u = 0; u < 2; ++u) { const int t = ta + 32 * u;
        const float f[8] = {bflo(fw[u][0]), bfhi(fw[u][0]), bflo(fw[u][1]), bfhi(fw[u][1]), bflo(fw[u][2]), bfhi(fw[u][2]), bflo(fw[u][3]), bfhi(fw[u][3])};
        float lf[8];
#pragma unroll
        for (int i = 0; i < 8; ++i) { const float sg = fsigm(f[i]); lf[i] = __builtin_amdgcn_logf(lb[i] + (1.0f - lb[i]) * sg) * 0.6931471805599453f; key[u][i] = (1.0f - lb[i]) * (1.0f - sg); }
        *(LAS f32x4*)(bc_s + t * 128 + c0) = (f32x4){lf[0], lf[1], lf[2], lf[3]}; *(LAS f32x4*)(bc_s + t * 128 + c0 + 4) = (f32x4){lf[4], lf[5], lf[6], lf[7]};
        *(LAS v4u*)(VS + t * HGLD + c0) = iw[u]; }
    __syncthreads();
    if (tid < 128) { float run = 0.f;
#pragma unroll 8
        for (int t = 0; t < 64; ++t) { run += bc_s[t * 128 + tid]; bc_s[t * 128 + tid] = run; } }
    __syncthreads();
    const f32x4 m0 = *(const LAS f32x4*)(bc_s + 31 * 128 + c0), m1 = *(const LAS f32x4*)(bc_s + 31 * 128 + c0 + 4);
    const float b31[8] = {m0[0], m0[1], m0[2], m0[3], m1[0], m1[1], m1[2], m1[3]};
#pragma unroll
    for (int u = 0; u < 2; ++u) { const int t = ta + 32 * u;
        const f32x4 x0 = *(const LAS f32x4*)(bc_s + t * 128 + c0), x1 = *(const LAS f32x4*)(bc_s + t * 128 + c0 + 4);
        const float bc[8] = {x0[0], x0[1], x0[2], x0[3], x1[0], x1[1], x1[2], x1[3]};
        float kk[8], qq[8], q2[8];
#pragma unroll
        for (int i = 0; i < 8; ++i) { const float d = b31[i] - bc[i]; kk[i] = key[u][i] * fexp(fminf(d, 60.0f));
            if (WITH_Q) { const float qv = (i & 1) ? bfhi(qw[u][i >> 1]) : bflo(qw[u][i >> 1]); const float qs = qv * fsigm(qv); qq[i] = qs * fexp(fminf(-d, 60.0f)); q2[i] = qs * fexp(bc[i]); } }
        v4u o; o.x = pk2(kk[0], kk[1]); o.y = pk2(kk[2], kk[3]); o.z = pk2(kk[4], kk[5]); o.w = pk2(kk[6], kk[7]); *(LAS v4u*)(KS + t * HGLD + c0) = o;
        if (WITH_Q) { o.x = pk2(qq[0], qq[1]); o.y = pk2(qq[2], qq[3]); o.z = pk2(qq[4], qq[5]); o.w = pk2(qq[6], qq[7]); *(LAS v4u*)(QS + t * HGLD + c0) = o;
            o.x = pk2(q2[0], q2[1]); o.y = pk2(q2[2], q2[3]); o.z = pk2(q2[4], q2[5]); o.w = pk2(q2[6], q2[7]); *(LAS v4u*)(Q2 + t * HGLD + c0) = o; } }
    __syncthreads();
}
__device__ __forceinline__ void hg_state_unit(const bf16* proj, float* slt, float* decc, int b, int ch, int hp, const float* lbp, int layer, LAS unsigned char* lds, int tid) {
    LAS float* bc_s = (LAS float*)lds; LAS bf16* KS = (LAS bf16*)(lds + 32768); LAS bf16* VS = KS + 64 * HGLD;
    const int lane = tid & 63, w = tid >> 6;
    hg_prep<false>(proj, b, ch * 64, hp, lbp, layer, bc_s, nullptr, KS, VS, nullptr, tid);
    if (tid < 128) decc[(size_t)((b * 32 + ch) * 4 + 2 * hp) * 64 + tid] = fexp(bc_s[63 * 128 + tid]);
    { const int hh = w >> 2, mi = w & 3, h = 2 * hp + hh;
        const bf16x8 a0 = frag_ks(VS, HGLD, hh * 64 + mi * 16, 0, lane), a1 = frag_ks(VS, HGLD, hh * 64 + mi * 16, 32, lane);
        bf16* outp = (bf16*)slt + ((size_t)((b * 32 + ch) * 4 + h) * 64 + mi * 16 + (lane & 15)) * 64 + 4 * (lane >> 4);
#pragma unroll
        for (int ni = 0; ni < 4; ++ni) { const bf16x8 b0 = frag_ks(KS, HGLD, hh * 64 + ni * 16, 0, lane), b1 = frag_ks(KS, HGLD, hh * 64 + ni * 16, 32, lane);
            f32x4 acc = {0.f, 0.f, 0.f, 0.f}; acc = MFMA16(b0, a0, acc); acc = MFMA16(b1, a1, acc);
            const int c0 = hh * 64 + ni * 16 + 4 * (lane >> 4);
            const f32x4 e63 = *(const LAS f32x4*)(bc_s + 63 * 128 + c0), e31 = *(const LAS f32x4*)(bc_s + 31 * 128 + c0);
            u32x2 o; o.x = pk2(acc[0] * fexp(e63[0] - e31[0]), acc[1] * fexp(e63[1] - e31[1])); o.y = pk2(acc[2] * fexp(e63[2] - e31[2]), acc[3] * fexp(e63[3] - e31[3]));
            *(u32x2*)(outp + ni * 16) = o; } }
    __syncthreads();
}
__device__ __forceinline__ void hg_out_unit(const bf16* proj, const bf16* stb, bf16* oraw, int b, int ch, int hp, const float* lbp, int layer, LAS unsigned char* lds, int tid) {
    LAS float* bc_s = (LAS float*)lds; LAS bf16* KS = (LAS bf16*)(lds + 32768); LAS bf16* VS = KS + 64 * HGLD; LAS bf16* QS = VS + 64 * HGLD; LAS bf16* WS = QS + 64 * HGLD; LAS bf16* Q2 = WS + 2 * 64 * HGWLD;
    const int lane = tid & 63, w = tid >> 6, t0 = ch * 64;
    const int hh = w >> 2, mi = w & 3, h = 2 * hp + hh;
    bf16x8 sf[2][4];
    { const bf16* st = stb + (size_t)((b * 32 + ch) * 4 + h) * 64 * 64;
#pragma unroll
        for (int kk = 0; kk < 2; ++kk)
#pragma unroll
            for (int ni = 0; ni < 4; ++ni) sf[kk][ni] = __builtin_nontemporal_load((const bf16x8*)(st + (size_t)(ni * 16 + (lane & 15)) * 64 + 32 * kk + 8 * (lane >> 4))); }
    hg_prep<true>(proj, b, t0, hp, lbp, layer, bc_s, QS, KS, VS, Q2, tid);
    { f32x4 sc[4];
#pragma unroll
        for (int ni = 0; ni < 4; ++ni) sc[ni] = (f32x4){0.f, 0.f, 0.f, 0.f};
#pragma unroll
        for (int kk = 0; kk < 2; ++kk) { const bf16x8 a = frag_kc(QS, HGLD, mi * 16, hh * 64 + 32 * kk, lane);
#pragma unroll
            for (int ni = 0; ni < 4; ++ni) { const bf16x8 bb = frag_kc(KS, HGLD, ni * 16, hh * 64 + 32 * kk, lane); sc[ni] = MFMA16(a, bb, sc[ni]); } }
#pragma unroll
        for (int ni = 0; ni < 4; ++ni) { const int s = ni * 16 + (lane & 15);
#pragma unroll
            for (int i = 0; i < 4; ++i) { const int t = mi * 16 + 4 * (lane >> 4) + i; WS[(hh * 64 + t) * HGWLD + s] = (bf16)f2bfh(s <= t ? sc[ni][i] : 0.f); } } }
    __syncthreads();
    { f32x4 o[4];
#pragma unroll
        for (int ni = 0; ni < 4; ++ni) o[ni] = (f32x4){0.f, 0.f, 0.f, 0.f};
#pragma unroll
        for (int kk = 0; kk < 2; ++kk) { const bf16x8 a = frag_kc(WS + hh * 64 * HGWLD, HGWLD, mi * 16, 32 * kk, lane);
#pragma unroll
            for (int ni = 0; ni < 4; ++ni) { const bf16x8 bb = frag_ks(VS, HGLD, hh * 64 + ni * 16, 32 * kk, lane); o[ni] = MFMA16(a, bb, o[ni]); } }
#pragma unroll
        for (int kk = 0; kk < 2; ++kk) { const bf16x8 a = frag_kc(Q2, HGLD, mi * 16, hh * 64 + 32 * kk, lane);
#pragma unroll
            for (int ni = 0; ni < 4; ++ni) o[ni] = MFMA16(a, sf[kk][ni], o[ni]); }
#pragma unroll
        for (int i = 0; i < 4; ++i) { const size_t row = (size_t)b * SEQ + t0 + mi * 16 + 4 * (lane >> 4) + i;
#pragma unroll
            for (int ni = 0; ni < 4; ++ni) oraw[row * DM + 512 + h * 64 + ni * 16 + (lane & 15)] = (bf16)f2bf(o[ni][i]); } }
    __syncthreads();
}

constexpr int RGLD = 136;
__device__ __forceinline__ void rg_local_unit(const bf16* proj, float* hloc, float* pcum, float* rgs, int b, int ch, int half, const float* conv_w, const float* conv_b, const bf16* waT, const bf16* wxT,
                                              const float* ba, const float* bx, const float* lam, LAS unsigned char* lds, int tid) {
    LAS float* xc32 = (LAS float*)lds; LAS float* a_s = xc32 + 64 * 128; LAS bf16* xcb = (LAS bf16*)(a_s + 64 * 128); LAS float* par = (LAS float*)(xcb + 64 * RGLD);
    const int lane = tid & 63, w = tid >> 6, t0 = ch * 64, cg0 = half * 128;
    if (tid < 128) { par[tid] = ba[cg0 + tid]; par[128 + tid] = bx[cg0 + tid]; par[256 + tid] = softplusf_(-lam[cg0 + tid]); }
    { const int c0 = (tid & 15) * 8, cg = cg0 + c0, tp = tid >> 4;
        v4u x[5]; f32x4 wk[4][2];
#pragma unroll
        for (int r = 0; r < 5; ++r) { const int ts = t0 + 2 * tp - 3 + r; x[r] = (v4u){0u, 0u, 0u, 0u}; if (ts >= 0) x[r] = __builtin_nontemporal_load((const v4u*)(proj + ((size_t)b * SEQ + ts) * DING + C_RGX + cg)); }
#pragma unroll
        for (int k = 0; k < 4; ++k) { wk[k][0] = *(const f32x4*)(conv_w + k * 256 + cg); wk[k][1] = *(const f32x4*)(conv_w + k * 256 + cg + 4); }
        const f32x4 b0 = *(const f32x4*)(conv_b + cg), b1 = *(const f32x4*)(conv_b + cg + 4);
#pragma unroll
        for (int j = 0; j < 2; ++j) { const int t = 2 * tp + j; float o[8] = {b0[0], b0[1], b0[2], b0[3], b1[0], b1[1], b1[2], b1[3]};
#pragma unroll
            for (int k = 0; k < 4; ++k) { const v4u xv = x[j + k];
                o[0] += wk[k][0][0] * bflo(xv[0]); o[1] += wk[k][0][1] * bfhi(xv[0]); o[2] += wk[k][0][2] * bflo(xv[1]); o[3] += wk[k][0][3] * bfhi(xv[1]);
                o[4] += wk[k][1][0] * bflo(xv[2]); o[5] += wk[k][1][1] * bfhi(xv[2]); o[6] += wk[k][1][2] * bflo(xv[3]); o[7] += wk[k][1][3] * bfhi(xv[3]); }
            *(LAS f32x4*)(xc32 + t * 128 + c0) = (f32x4){o[0], o[1], o[2], o[3]}; *(LAS f32x4*)(xc32 + t * 128 + c0 + 4) = (f32x4){o[4], o[5], o[6], o[7]};
            v4u q; q.x = pk2(o[0], o[1]); q.y = pk2(o[2], o[3]); q.z = pk2(o[4], o[5]); q.w = pk2(o[6], o[7]); *(LAS v4u*)(xcb + t * RGLD + c0) = q; } }
    __syncthreads();
    { const int nb = w >> 2, mi = w & 3, n = 2 * half + nb;
        f32x4 ra[4], ga[4];
#pragma unroll
        for (int ni = 0; ni < 4; ++ni) { ra[ni] = (f32x4){0.f, 0.f, 0.f, 0.f}; ga[ni] = (f32x4){0.f, 0.f, 0.f, 0.f}; }
#pragma unroll
        for (int kk = 0; kk < 2; ++kk) { const bf16x8 a = frag_kc(xcb, RGLD, mi * 16, nb * 64 + 32 * kk, lane);
#pragma unroll
            for (int ni = 0; ni < 4; ++ni) { const size_t off = (size_t)(n * 64 + ni * 16 + (lane & 15)) * 64 + 32 * kk + 8 * (lane >> 4);
                ra[ni] = MFMA16(a, *(const bf16x8*)(waT + off), ra[ni]); ga[ni] = MFMA16(a, *(const bf16x8*)(wxT + off), ga[ni]); } }
#pragma unroll
        for (int ni = 0; ni < 4; ++ni) { const int c = nb * 64 + ni * 16 + (lane & 15); const float bav = par[c], bxv = par[128 + c], spl = par[256 + c];
#pragma unroll
            for (int i = 0; i < 4; ++i) { const int t = mi * 16 + 4 * (lane >> 4) + i;
                const float r = fsigm(ra[ni][i] + bav), ig = fsigm(ga[ni][i] + bxv), log_a = -8.0f * r * spl, x2 = 2.0f * log_a;
                const float em1 = x2 > -0.25f ? -x2 * (1.0f + x2 * (0.5f + x2 * (0.16666667f + x2 * (0.041666668f + x2 * 0.0083333338f)))) : 1.0f - fexp(x2);
                float mult = __builtin_amdgcn_sqrtf(em1); if (t0 + t == 0) mult = 1.0f;
                a_s[t * 128 + c] = fexp(log_a); xc32[t * 128 + c] = mult * ig * xc32[t * 128 + c]; } } }
    __syncthreads();
    if (tid < 128) { float h = 0.f, P = 1.f; const size_t base = ((size_t)b * SEQ + t0) * 256 + cg0 + tid;
#pragma unroll 8
        for (int t = 0; t < 64; ++t) { const float a = a_s[t * 128 + tid]; h = a * h + xc32[t * 128 + tid]; P *= a; ((unsigned*)hloc)[base + (size_t)t * 256] = pk2(h, P); }
        rgs[((size_t)(b * 32 + ch) * 256 + cg0 + tid) * 2] = P; rgs[((size_t)(b * 32 + ch) * 256 + cg0 + tid) * 2 + 1] = h; }
    __syncthreads();
}

typedef float f32x16 __attribute__((ext_vector_type(16)));
#define MFMA32(a, b, c) __builtin_amdgcn_mfma_f32_32x32x16_bf16((a), (b), (c), 0, 0, 0)
constexpr int AVLD = 72;
__device__ __forceinline__ bf16x8 pack8(const f32x16& x, int o) {
    v4u w; w.x = pg8::cvt_pk_bf16(x[o], x[o + 1]); w.y = pg8::cvt_pk_bf16(x[o + 2], x[o + 3]); w.z = pg8::cvt_pk_bf16(x[o + 4], x[o + 5]); w.w = pg8::cvt_pk_bf16(x[o + 6], x[o + 7]);
    return __builtin_bit_cast(bf16x8, w);
}
__device__ __forceinline__ float lk2(float z) { return -(fmaxf(z, 0.f) + __builtin_amdgcn_logf(1.0f + __builtin_amdgcn_exp2f(-fabsf(z)))); }
__device__ __forceinline__ void attn_unit(const bf16* proj, bf16* oraw, int b, int h, int qb, LAS bf16* KL, LAS bf16* VL, int lane) {
    const int q = lane & 31, h2 = lane >> 5, qw = qb * 32; const size_t rowb = (size_t)b * SEQ;
    bf16x8 qf[4];
    { const bf16* qp = proj + (rowb + qw + q) * DING + C_SBQ + h * 64 + 8 * h2; const float C2 = 0.125f * 1.4426950408889634f;
#pragma unroll
        for (int kk = 0; kk < 4; ++kk) { const v4u w = *(const v4u*)(qp + 16 * kk); v4u o;
            o.x = pg8::cvt_pk_bf16(bflo(w.x) * C2, bfhi(w.x) * C2); o.y = pg8::cvt_pk_bf16(bflo(w.y) * C2, bfhi(w.y) * C2); o.z = pg8::cvt_pk_bf16(bflo(w.z) * C2, bfhi(w.z) * C2); o.w = pg8::cvt_pk_bf16(bflo(w.w) * C2, bfhi(w.w) * C2);
            qf[kk] = __builtin_bit_cast(bf16x8, o); } }
    bf16x8 m0[2], ones;
#pragma unroll
    for (int s = 0; s < 2; ++s) {
#pragma unroll
        for (int jj = 0; jj < 8; ++jj) { const int j = 16 * s + 8 * (jj >> 2) + 4 * h2 + (jj & 3); m0[s][jj] = (short)(j >= q ? 0x3F80 : 0); } }
#pragma unroll
    for (int jj = 0; jj < 8; ++jj) ones[jj] = (short)0x3F80;
    f32x16 o0, o1;
#pragma unroll
    for (int r = 0; r < 16; ++r) { o0[r] = 0.f; o1[r] = 0.f; }
    float R = 0.f;
    const int sd = (qw >> 6) << 6;
    v4u kr[8];
#pragma unroll
    for (int i = 0; i < 8; ++i) kr[i] = *(const v4u*)(proj + (rowb + sd + (lane >> 3) + 8 * i) * DING + C_SBK + h * 64 + 8 * (lane & 7));
    for (int s0 = sd; s0 >= 0; s0 -= 64) {
#pragma unroll
        for (int i = 0; i < 8; ++i) { const int row = (lane >> 3) + 8 * i; *(LAS v4u*)(KL + row * 64 + 8 * ((lane & 7) ^ (row & 7))) = kr[i]; }
        { const int sn = s0 >= 64 ? s0 - 64 : s0;
#pragma unroll
            for (int i = 0; i < 8; ++i) kr[i] = *(const v4u*)(proj + (rowb + sn + (lane >> 3) + 8 * i) * DING + C_SBK + h * 64 + 8 * (lane & 7)); }
        bf16x8 kf[2][4];
#pragma unroll
        for (int hf = 0; hf < 2; ++hf)
#pragma unroll
            for (int kk = 0; kk < 4; ++kk) { const int key = 32 * hf + q; kf[hf][kk] = *(const LAS bf16x8*)(KL + key * 64 + 8 * ((2 * kk + h2) ^ (key & 7))); }
#pragma unroll
        for (int i = 0; i < 8; ++i) { const int row = (lane >> 3) + 8 * i; const v4u w = *(const v4u*)(proj + (rowb + s0 + row) * DING + C_SBV + h * 64 + 8 * (lane & 7)); *(LAS v4u*)(VL + row * AVLD + 8 * (lane & 7)) = w; }
        f32x16 z0, z1;
#pragma unroll
        for (int r = 0; r < 16; ++r) { z0[r] = 0.f; z1[r] = 0.f; }
#pragma unroll
        for (int kk = 0; kk < 4; ++kk) { z0 = MFMA32(kf[0][kk], qf[kk], z0); z1 = MFMA32(kf[1][kk], qf[kk], z1); }
        const int lim = (s0 == sd) ? (qw - sd) + q : 64;
        f32x16 l0, l1;
#pragma unroll
        for (int r = 0; r < 16; ++r) { const int key = (r & 3) + 8 * (r >> 2) + 4 * h2; l0[r] = key < lim ? lk2(z0[r]) : 0.f; l1[r] = key + 32 < lim ? lk2(z1[r]) : 0.f; }
        const bf16x8 bl0 = pack8(l0, 0), bl1 = pack8(l0, 8), bh0 = pack8(l1, 0), bh1 = pack8(l1, 8);
        f32x16 i0 = z0, i1 = z1;
        i0 = MFMA32(m0[0], bl0, i0); i0 = MFMA32(m0[1], bl1, i0); i0 = MFMA32(ones, bh0, i0); i0 = MFMA32(ones, bh1, i0);
        i1 = MFMA32(m0[0], bh0, i1); i1 = MFMA32(m0[1], bh1, i1);
        float tot = h2 == 0 ? i0[0] - z0[0] : 0.f; tot += __shfl_xor(tot, 32);
#pragma unroll
        for (int r = 0; r < 16; ++r) { const int key = (r & 3) + 8 * (r >> 2) + 4 * h2; l0[r] = key < lim ? __builtin_amdgcn_exp2f(i0[r] + R) : 0.f; l1[r] = key + 32 < lim ? __builtin_amdgcn_exp2f(i1[r] + R) : 0.f; }
        R += tot;
        const bf16x8 pa0 = pack8(l0, 0), pa1 = pack8(l0, 8), pa2 = pack8(l1, 0), pa3 = pack8(l1, 8);
        const LAS bf16* vb = VL + (4 * h2 + ((lane & 15) >> 2)) * AVLD + 16 * ((lane >> 4) & 1) + 4 * (lane & 3);
#define VFRAG(kb, db) ({ const s16x4 lo_ = __builtin_bit_cast(s16x4, __builtin_amdgcn_ds_read_tr16_b64_v4i16((LAS v4i16_t*)(vb + (kb) * AVLD + (db) * 32))); \
                         const s16x4 hi_ = __builtin_bit_cast(s16x4, __builtin_amdgcn_ds_read_tr16_b64_v4i16((LAS v4i16_t*)(vb + ((kb) + 8) * AVLD + (db) * 32))); \
                         (bf16x8){lo_[0], lo_[1], lo_[2], lo_[3], hi_[0], hi_[1], hi_[2], hi_[3]}; })
        o0 = MFMA32(pa0, VFRAG(0, 0), o0); o1 = MFMA32(pa0, VFRAG(0, 1), o1);
        o0 = MFMA32(pa1, VFRAG(16, 0), o0); o1 = MFMA32(pa1, VFRAG(16, 1), o1);
        o0 = MFMA32(pa2, VFRAG(32, 0), o0); o1 = MFMA32(pa2, VFRAG(32, 1), o1);
        o0 = MFMA32(pa3, VFRAG(48, 0), o0); o1 = MFMA32(pa3, VFRAG(48, 1), o1);
#undef VFRAG
        if (__all(R < -127.0f)) break;
    }
    bf16* op = oraw + (rowb + qw) * DM + h * 64 + q;
#pragma unroll
    for (int r = 0; r < 16; ++r) { const int qq = (r & 3) + 8 * (r >> 2) + 4 * h2; op[(size_t)qq * DM] = (bf16)f2bf(o0[r]); op[(size_t)qq * DM + 32] = (bf16)f2bf(o1[r]); }
}


constexpr int NPL = 11, NPHASE = 1 + NPL * DEPTH;
struct Args { const float* in[29]; float* out; unsigned char* ws; int ph_lo, ph_hi, use_bar, pad; };

typedef const __attribute__((address_space(4))) Args* KArgP;
__device__ __forceinline__ KArgP kargs() { KArgP p = (KArgP)__builtin_amdgcn_kernarg_segment_ptr(); asm volatile("" : "+s"(p)); return p; }
#define WSP(type, off) ((type*)(kargs()->ws + (off)))
#define INP(i) (kargs()->in[i])

constexpr int CV_MOE = NE * IT_GU + NE * IT_DN;
constexpr int CV_TAILQ = 7, CV_TAILW = (256 - 64) * NWAVES;
constexpr int CV_TAIL = CV_TAILQ * CV_TAILW;
#ifndef CV_TAILQ1
#define CV_TAILQ1 8
#endif
constexpr int CV_TAIL1 = CV_TAILQ1 * CV_TAILW;
constexpr int CV_SMALL = NIT_WIN + NIT_WOUT;
constexpr int CV_GQ = 5, CV_HQ = 5;
constexpr int CV_P0_ITEMS = CV_SMALL + (CV_MOE - CV_TAIL);
constexpr float F8_WGU_SCALE = 32.0f, F8_WDN_SCALE = 64.0f;
__device__ __forceinline__ TDesc cv_moe(int l, int r) { TDesc d;
    if (r < NE * IT_GU) { const int le = l * NE + r / IT_GU, q = r % IT_GU; d.W = INP(24) + (size_t)le * DM * 2048; d.ldw = 2048; d.WT = (bf16*)(WSP(unsigned char, WS_WGU) + (size_t)le * 2048 * DM); d.K = DM; d.k0 = 64 * (q / 32); d.n0 = 64 * (q % 32); d.gu = 1; d.f8s = F8_WGU_SCALE; return d; }
    r -= NE * IT_GU;
    { const int le = l * NE + r / IT_DN, q = r % IT_DN; d.W = INP(26) + (size_t)le * DFF * DM; d.ldw = DM; d.WT = (bf16*)(WSP(unsigned char, WS_WDN) + (size_t)le * DM * DFF); d.K = DFF; d.k0 = 64 * (q / 16); d.n0 = 64 * (q % 16); d.gu = 0; d.f8s = F8_WDN_SCALE; return d; } }
__device__ __forceinline__ TDesc cv_p0(int r) { TDesc d;
    if (r < NIT_WIN) { const int l = r / IT_WIN, q = r % IT_WIN; d.W = INP(2) + (size_t)l * DM * DIN; d.ldw = DIN; d.WT = WSP(bf16, WS_WIN) + (size_t)l * DING * DM; d.K = DM; d.k0 = 64 * (q / 52); d.n0 = 64 * (q % 52); d.gu = 0; d.f8s = 0.f; return d; }
    r -= NIT_WIN;
    if (r < NIT_WOUT) { const int l = r / IT_WOUT, q = r % IT_WOUT; d.W = INP(20) + (size_t)l * DM * DM; d.ldw = DM; d.WT = WSP(bf16, WS_WOUT) + (size_t)l * DM * DM; d.K = DM; d.k0 = 64 * (q / 16); d.n0 = 64 * (q % 16); d.gu = 0; d.f8s = 0.f; return d; }
    r -= NIT_WOUT;
    return cv_moe(0, CV_TAIL + r); }
__device__ __forceinline__ void convert_items(int n, int first, int stride, int tail_layer_p1, LAS float* scr, int lane) {
    int it = first; TDesc dc, dn; f32x4 va[16], vb[16];
    if (it < n) { dc = tail_layer_p1 ? cv_moe(tail_layer_p1 - 1, it) : cv_p0(it); tload(dc, va, lane); }
    while (it < n) { const int nx = it + stride; const bool hn = nx < n;
        if (hn) { dn = tail_layer_p1 ? cv_moe(tail_layer_p1 - 1, nx) : cv_p0(nx); tload(dn, vb, lane); }
        tstore(dc, va, scr, lane);
        if (hn) { dc = dn;
#pragma unroll
            for (int i = 0; i < 16; ++i) va[i] = vb[i]; }
        it = nx; }
}

__global__ void __launch_bounds__(NTHR, 2) fwd_kernel(Args args_unused) {
    extern __shared__ __attribute__((aligned(16))) unsigned char lds_raw[];
    LAS unsigned char* lds = (LAS unsigned char*)lds_raw;
    LAS float* ldsf = (LAS float*)lds_raw;
    volatile LAS unsigned* MISC = (volatile LAS unsigned*)(lds + MISC_OFF);
    LAS int* tb = (LAS int*)(lds + TB_OFF);
    const int tid0 = threadIdx.x;
#define PH_IDS int tid = threadIdx.x; asm volatile("" : "+v"(tid)); const int lane = tid & 63, wave = __builtin_amdgcn_readfirstlane(tid >> 6); const int gw = vcu * NWAVES + wave; (void)lane; (void)gw;
    const int G = gridDim.x, bx = blockIdx.x;
    const int vcu = (G % 8 == 0) ? (bx % 8) * (G / 8) + bx / 8 : bx;
    const int NGW = G * NWAVES;
    gu32* ctl = (gu32*)WSP(unsigned char, WS_CTL);

    for (int u = tid0; u < (LDS_BYTES - LDSCTL_OFF) / 4; u += NTHR) ((LAS unsigned*)(lds + LDSCTL_OFF))[u] = 0u;
    __syncthreads();
#if PROBE_T
    unsigned long long tprev_ = __builtin_amdgcn_s_memrealtime();
#endif
    XcdBarrier bar; bar.bar = (unsigned*)(ctl + CW_BAR); bar.x = 0; bar.st = nullptr;
    if (kargs()->use_bar) bar = xcd_barrier_post((unsigned*)(ctl + CW_BAR), MISC + 8);
    const int lo = kargs()->ph_lo, hi = kargs()->ph_hi;
#ifndef PH_MASK
#define PH_MASK 0xfff
#endif
#ifndef REP_MASK
#define REP_MASK 0
#endif
#define IN(k) (lo <= (k) && (k) < hi)
#define EN(ty) ((PH_MASK >> (ty)) & 1)
#define REPS(ty) (1 + ((REP_MASK >> (ty)) & 1))
#ifndef REP2_MASK
#define REP2_MASK 0
#endif
#ifndef PF_G
#define PF_G 0
#endif
#ifndef PF_H
#define PF_H 0
#endif
#ifndef PF_A
#define PF_A 0
#endif
#ifndef PROBE_SAME
#define PROBE_SAME 0
#endif
#ifndef SP2_F8
#define SP2_F8 true
#endif
#ifndef PROBE_SEAM
#define PROBE_SEAM -1
#endif
#ifndef PROBE_KT
#define PROBE_KT 0
#endif
#ifndef PROBE_SEL
#define PROBE_SEL 0
#endif

#define SUB(bit) _Pragma("unroll 1") for (int rep2_ = 0; rep2_ < 1 + ((REP2_MASK >> (bit)) & 1); ++rep2_)
#if PROBE_T
#define SEAM(k) do { if (IN(k) && IN((k) + 1)) { const unsigned long long tb0_ = __builtin_amdgcn_s_memrealtime(); if (threadIdx.x == 0 && PROBE_SEAM == (k)) ((LAS unsigned*)(lds + LDSCTL_OFF + 128))[3] += (unsigned)(tb0_ - tprev_); xcd_barrier(bar); tprev_ = __builtin_amdgcn_s_memrealtime(); if (threadIdx.x == 0 && (PROBE_SEAM < 0 || PROBE_SEAM == (k))) ((LAS unsigned*)(lds + LDSCTL_OFF + 128))[6] += (unsigned)(__builtin_amdgcn_s_memrealtime() - tb0_); } } while (0)
#else
#define SEAM(k) do { if (IN(k) && IN((k) + 1)) xcd_barrier(bar); } while (0)
#endif
#define PHASE(ty, k) if (EN(ty) && IN(k)) _Pragma("unroll 1") for (int rep_ = 0; rep_ < REPS(ty); ++rep_)

    PHASE(11, 0) { PH_IDS
        LAS float* scr = ldsf + wave * (64 * 65);
        convert_items(CV_P0_ITEMS, gw, NGW, 0, scr, lane);
        for (int idx = gw * 64 + lane; idx < DEPTH * 4 * 4096; idx += NGW * 64) { const int i = idx & 63, j = (idx >> 6) & 63, ln = idx >> 12;
            WSP(bf16, WS_WAT)[idx] = (bf16)f2bf(INP(6)[(size_t)ln * 4096 + i * 64 + j]); WSP(bf16, WS_WAT + 512 * 1024)[idx] = (bf16)f2bf(INP(8)[(size_t)ln * 4096 + i * 64 + j]); }
        for (int idx = gw * 64 + lane; idx < DEPTH * NE * DM; idx += NGW * 64) { const int k = idx & 1023, e = (idx >> 10) & 31, ll = idx >> 15;
            const float w = INP(21)[ll * DM + k] * INP(22)[((size_t)ll * DM + k) * NE + e]; const unsigned hi = f2bf(w); const float lo = w - __uint_as_float(hi << 16);
            bf16* dst = WSP(bf16, WS_RWB) + (size_t)ll * 2 * NE * DM + e * DM + k; dst[0] = (bf16)hi; dst[NE * DM] = (bf16)f2bf(lo); }
        if (gw == 0) for (int c = lane; c < 256; c += 64) { const float x0 = INP(12)[c], x1 = INP(12)[256 + c], mx = fmaxf(x0, x1), e0 = expf(x0 - mx), e1 = expf(x1 - mx); WSP(float, WS_LB1)[c] = e1 / (e0 + e1); }
        __syncthreads();
        stage_dtw(INP(2), ldsf, tid);
        _Pragma("unroll 1") for (int m = gw; m < T; m += 2 * NGW) { const int m1 = m + NGW; const bool two = m1 < T; f32x4 va[4], vb[4];
#pragma unroll
            for (int j = 0; j < 4; ++j) { va[j] = *(const f32x4*)(INP(0) + (size_t)m * DM + 256 * j + 4 * lane); vb[j] = *(const f32x4*)(INP(0) + (size_t)(two ? m1 : m) * DM + 256 * j + 4 * lane); }
            emit_xn_dt(va, INP(1), ldsf, WSP(bf16, WS_XN) + (size_t)m * DM, WSP(float, WS_DT) + (size_t)m * 4, lane);
            if (two) emit_xn_dt(vb, INP(1), ldsf, WSP(bf16, WS_XN) + (size_t)m1 * DM, WSP(float, WS_DT) + (size_t)m1 * 4, lane); }
    }
    SEAM(0);

#pragma unroll 1
    for (int l = 0; l < DEPTH; ++l) {
        const int P = 1 + NPL * l;
        PHASE(0, P) { PH_IDS
            pg8::Gemm g{WSP(bf16, WS_XN), WSP(bf16, WS_WIN) + (size_t)l * DING * DM, T, DING, DM}; pg8::StaticOrder S; S.init(T, DING, G, bx);
            pg8::EpiBf16 E{WSP(bf16, WS_PROJ), DING, nullptr, 0};
            if (G == 256 && bx >= 64) convert_items(l ? CV_TAIL1 : CV_TAIL, (bx - 64) * NWAVES + wave, CV_TAILW, l + 1, ldsf + wave * (64 * 65), lane);
            else if (G != 256) convert_items(l ? CV_TAIL1 : CV_TAIL, gw, NGW, l + 1, ldsf + wave * (64 * 65), lane);
            __syncthreads();
            pg8::gemm_phase<pg8::EpiBf16, pg8::StaticOrder, true, true, false, PF_A>(lds, g, S, E);
            __syncthreads();
        }
        SEAM(P);
#define LAUNDER_TID int tidu = threadIdx.x; asm volatile("" : "+v"(tidu));
        PHASE(1, P + 1) { PH_IDS
#if PROBE_T
            unsigned long long ptb_ = __builtin_amdgcn_s_memrealtime();
#define PTB(ph, k) do { __syncthreads(); const unsigned long long n_ = __builtin_amdgcn_s_memrealtime(); if (PROBE_PH == (ph) && l == 1 && tid == 0) ((LAS unsigned*)(lds + LDSCTL_OFF + 128))[k] += (unsigned)(n_ - ptb_); ptb_ = n_; } while (0)
#else
#define PTB(ph, k) do {} while (0)
#endif
            { const int v = vcu, b = v >> 5, ch = v & 31;
                SUB(0)
#pragma unroll 1
                for (int g = 0; g < 2; ++g) { LAUNDER_TID m2_state_unit(WSP(bf16, WS_PROJ), WSP(float, WS_DT), WSP(float, WS_SLOC), WSP(float, WS_DEC), b, ch, g, INP(14) + l * 3072, INP(15) + l * 768, INP(16) + l * 4, INP(17) + l * 4, lds, tidu); }
                PTB(1, 0);
                SUB(1)
#pragma unroll 1
                for (int g = 0; g < 2; ++g) { LAUNDER_TID hg_state_unit(WSP(bf16, WS_PROJ), WSP(float, WS_SLT), WSP(float, WS_DECC), b, ch, g, WSP(float, WS_LB1), l, lds, tidu); }
                PTB(1, 1);
                SUB(2)
#pragma unroll 1
                for (int g = 0; g < 2; ++g) { LAUNDER_TID rg_local_unit(WSP(bf16, WS_PROJ), WSP(float, WS_HLOC), WSP(float, WS_PCUM), WSP(float, WS_RGS), b, ch, g, INP(4) + l * 1024, INP(5) + l * 256, WSP(bf16, WS_WAT) + l * 16384, WSP(bf16, WS_WAT + 512 * 1024) + l * 16384, INP(7) + l * 256, INP(9) + l * 256, INP(10) + l * 256, lds, tidu); }
            }
            PTB(1, 2);
            SUB(3) { __syncthreads();
            for (int u = gw; u < 2048; u += NGW) { const int qb = 63 - (u >> 5), bh = u & 31; attn_unit(WSP(bf16, WS_PROJ), WSP(bf16, WS_ORAW), bh >> 2, bh & 3, qb, (LAS bf16*)(lds + wave * 17408), (LAS bf16*)(lds + wave * 17408 + 8192), lane); }
            __syncthreads(); }
            PTB(1, 3);
        }
        SEAM(P + 1);
        PHASE(2, P + 2) { PH_IDS
            { const float* sl = WSP(float, WS_SLOC); const float* dc = WSP(float, WS_DEC); bf16* pb = WSP(bf16, WS_PREVB);
                const int e = (vcu * NTHR + tid) * 2, n = e & 127, p = (e >> 7) & 63, h = (e >> 13) & 3, b = e >> 15;
                if (b < NB) { typedef float f32x2_ __attribute__((ext_vector_type(2))); f32x2_ sv[32]; float dv[32];
#pragma unroll
                    for (int c = 0; c < 32; ++c) { { const unsigned w = *(const unsigned*)((const bf16*)sl + ((size_t)((b * 32 + c) * 4 + h) * 64 + p) * 128 + n); sv[c] = (f32x2_){bflo(w), bfhi(w)}; } dv[c] = dc[(b * 32 + c) * 4 + h]; }
                    float r0 = 0.f, r1 = 0.f;
#pragma unroll
                    for (int c = 0; c < 32; ++c) { *(unsigned*)(pb + ((size_t)((b * 32 + c) * 4 + h) * 64 + p) * 128 + n) = pk2(r0, r1); r0 = dv[c] * r0 + sv[c][0]; r1 = dv[c] * r1 + sv[c][1]; } } }
            { const float* sl = WSP(float, WS_SLT); const float* dc = WSP(float, WS_DECC); bf16* pb = WSP(bf16, WS_STB);
                const int e = vcu * NTHR + tid, c = e & 63, v = (e >> 6) & 63, h = (e >> 12) & 3, b = e >> 14;
                if (b < NB) { float sv[32], dv[32];
#pragma unroll
                    for (int k = 0; k < 32; ++k) { sv[k] = bf2f(((const bf16*)sl)[((size_t)((b * 32 + k) * 4 + h) * 64 + v) * 64 + c]); dv[k] = dc[(size_t)((b * 32 + k) * 4 + h) * 64 + c]; }
                    float r = 0.f;
#pragma unroll
                    for (int k = 0; k < 32; ++k) { pb[((size_t)((b * 32 + k) * 4 + h) * 64 + v) * 64 + c] = (bf16)f2bf(r); r = dv[k] * r + sv[k]; } } }
            { const int e = vcu * NTHR + tid;
                if (e < NB * 256) { const int b = e >> 8, c = e & 255; const float* rs = WSP(float, WS_RGS); float* cy = WSP(float, WS_CARRY); typedef float f32x2_ __attribute__((ext_vector_type(2))); f32x2_ pv[32];
#pragma unroll
                    for (int k = 0; k < 32; ++k) pv[k] = *(const f32x2_*)(rs + 2 * ((size_t)(b * 32 + k) * 256 + c));
                    float r = 0.f;
#pragma unroll
                    for (int k = 0; k < 32; ++k) { cy[(size_t)(b * 32 + k) * 256 + c] = r; r = pv[k][0] * r + pv[k][1]; } } }
        }
        SEAM(P + 2);
        PHASE(3, P + 3) { PH_IDS
#if PROBE_T
            unsigned long long ptb_ = __builtin_amdgcn_s_memrealtime();
#endif
            { const int v = vcu, b = v >> 5, ch = v & 31;
                SUB(4)
#pragma unroll 1
                for (int g = 0; g < 2; ++g) { LAUNDER_TID m2_out_unit(WSP(bf16, WS_PROJ), WSP(float, WS_DT), WSP(bf16, WS_PREVB), WSP(bf16, WS_ORAW), b, ch, g, INP(14) + l * 3072, INP(15) + l * 768, INP(16) + l * 4, INP(17) + l * 4, INP(18) + l * 4, lds, tidu); }
                PTB(3, 0);
                SUB(5)
#pragma unroll 1
                for (int g = 0; g < 2; ++g) { LAUNDER_TID hg_out_unit(WSP(bf16, WS_PROJ), WSP(bf16, WS_STB), WSP(bf16, WS_ORAW), b, ch, g, WSP(float, WS_LB1), l, lds, tidu); }
                PTB(3, 1);
                SUB(6)
                {
                    const float* hl = WSP(float, WS_HLOC); const float* cy = WSP(float, WS_CARRY); const bf16* pj = WSP(bf16, WS_PROJ); bf16* orw = WSP(bf16, WS_ORAW);
                    { const int c = 4 * lane; const f32x4 cv = *(const f32x4*)(cy + (size_t)v * 256 + c);
                        _Pragma("unroll 1") for (int r0 = 0; r0 < 8; r0 += 4) { v4u hpv[4]; u32x2 gwd[4];
#pragma unroll
                            for (int r = 0; r < 4; ++r) { const size_t m = (size_t)v * 64 + wave * 8 + r0 + r; hpv[r] = __builtin_nontemporal_load((const v4u*)((const unsigned*)hl + m * 256 + c)); gwd[r] = __builtin_nontemporal_load((const u32x2*)(pj + m * DING + C_RGG + c)); }
#pragma unroll
                            for (int r = 0; r < 4; ++r) { const size_t m = (size_t)v * 64 + wave * 8 + r0 + r;
                                f32x4 o = (f32x4){bflo(hpv[r].x), bflo(hpv[r].y), bflo(hpv[r].z), bflo(hpv[r].w)} + (f32x4){bfhi(hpv[r].x), bfhi(hpv[r].y), bfhi(hpv[r].z), bfhi(hpv[r].w)} * cv; o[0] *= gelu_tanh(bflo(gwd[r].x)); o[1] *= gelu_tanh(bfhi(gwd[r].x)); o[2] *= gelu_tanh(bflo(gwd[r].y)); o[3] *= gelu_tanh(bfhi(gwd[r].y));
                                u32x2 ow; ow.x = pk2(o[0], o[1]); ow.y = pk2(o[2], o[3]); *(u32x2*)(orw + m * DM + 256 + c) = ow; } } }
                    __syncthreads();
                }
                PTB(3, 2);
                _Pragma("unroll 1") for (int r0 = 0; r0 < 8; r0 += 4) { const size_t m0 = (size_t)v * 64 + wave * 8 + r0;
                    norm_rows4(WSP(bf16, WS_ORAW) + m0 * DM, WSP(bf16, WS_PROJ) + m0 * DING, WSP(bf16, WS_MIX) + m0 * DM, INP(3) + l * 256, INP(11) + l * 256, INP(13) + l * 256, INP(19) + l * 256, lane); }
                PTB(3, 3);
            }
        }
        SEAM(P + 3);
        PHASE(5, P + 5) { PH_IDS
            pg8::Gemm g{WSP(bf16, WS_MIX), WSP(bf16, WS_WOUT) + (size_t)l * DM * DM, T, DM, DM}; pg8::StaticOrder S; S.init(T, DM, G, bx);
            if (l == 0) { pg8::EpiResBf16<true> E{INP(0), WSP(bf16, WS_H1), DM}; pg8::gemm_phase<pg8::EpiResBf16<true>, pg8::StaticOrder, true, true>(lds, g, S, E); }
            else { pg8::EpiResBf16<false> E{WSP(bf16, WS_HB), WSP(bf16, WS_H1), DM}; pg8::gemm_phase<pg8::EpiResBf16<false>, pg8::StaticOrder, true, true>(lds, g, S, E); }
        }
        SEAM(P + 5);
        PHASE(6, P + 6) { PH_IDS
#if PROBE_T
            unsigned long long ept_ = __builtin_amdgcn_s_memrealtime();
#define EPT(k) do { const unsigned long long n_ = __builtin_amdgcn_s_memrealtime(); if (PROBE_PH == 36 && tid == 0) ((LAS unsigned*)(lds + LDSCTL_OFF + 128))[k] += (unsigned)(n_ - ept_); ept_ = n_; } while (0)
#else
#define EPT(k) do {} while (0)
#endif
            constexpr int WLD = 1032;
            LAS bf16* WB = (LAS bf16*)lds; LAS float* LG = (LAS float*)(lds + 2 * 32 * WLD * 2); LAS float* SS = LG + 64 * 33; LAS float* RS = SS + 64;
            const bf16* h1 = WSP(bf16, WS_H1);
            const int rt = wave >> 1, et = wave & 1;
            bf16x8 av[32];
            { const bf16* hp = h1 + (size_t)(vcu * 64 + rt * 16 + (lane & 15)) * DM + 8 * (lane >> 4);
#pragma unroll
                for (int ks = 0; ks < 32; ++ks) av[ks] = *(const bf16x8*)(hp + 32 * ks); }
            { const bf16* src = WSP(bf16, WS_RWB) + (size_t)l * 2 * 32 * 1024; v4u wv[16];
#pragma unroll
                for (int i = 0; i < 16; ++i) wv[i] = *(const v4u*)(src + (size_t)(tid + NTHR * i) * 8);
#pragma unroll
                for (int i = 0; i < 16; ++i) { const int c = tid + NTHR * i; *(LAS v4u*)(WB + (c >> 7) * WLD + (c & 127) * 8) = wv[i]; } }
            __syncthreads();
            { f32x4 acc = {0.f, 0.f, 0.f, 0.f}; float ssum = 0.f;
#pragma unroll
                for (int ks = 0; ks < 32; ++ks) { const bf16x8 a = av[ks];
                    acc = MFMA16(a, frag_kc(WB, WLD, et * 16, 32 * ks, lane), acc); acc = MFMA16(a, frag_kc(WB + 32 * WLD, WLD, et * 16, 32 * ks, lane), acc);
                    const v4u aw = __builtin_bit_cast(v4u, a);
#pragma unroll
                    for (int i = 0; i < 4; ++i) { const float x0 = bflo(aw[i]), x1 = bfhi(aw[i]); ssum += x0 * x0 + x1 * x1; } }
                ssum += __shfl_xor(ssum, 16); ssum += __shfl_xor(ssum, 32);
                if (et == 0 && lane < 16) SS[rt * 16 + lane] = ssum;
#pragma unroll
                for (int i = 0; i < 4; ++i) LG[(rt * 16 + 4 * (lane >> 4) + i) * 33 + et * 16 + (lane & 15)] = acc[i]; }
            __syncthreads();
            EPT(0);
            if (wave == 0) { const int row = lane; const float rstd = rsq(SS[row] * (1.0f / DM) + EPS);
                const float* rb = INP(23) + l * NE;
                float lg[32];
#pragma unroll
                for (int e = 0; e < 32; ++e) lg[e] = rstd * LG[row * 33 + e] + rb[e];
                int be[4]; float bl[4];
#pragma unroll
                for (int r = 0; r < 4; ++r) { float best = -INFINITY; int bi = 0;
#pragma unroll
                    for (int e = 0; e < 32; ++e) if (lg[e] > best) { best = lg[e]; bi = e; }
#pragma unroll
                    for (int e = 0; e < 32; ++e) if (e == bi) lg[e] = -INFINITY;
                    be[r] = bi; bl[r] = best; }
                const float e1 = expf(bl[1] - bl[0]), e2 = expf(bl[2] - bl[0]), e3 = expf(bl[3] - bl[0]), inv = 1.0f / (1.0f + e1 + e2 + e3);
                int rk0 = 0, rk1 = 0, rk2 = 0, rk3 = 0, hist = 0; const unsigned long long lt = (1ull << lane) - 1ull;
#pragma unroll
                for (int e = 0; e < 32; ++e) { const bool h0 = be[0] == e, h1b = be[1] == e, h2 = be[2] == e, h3 = be[3] == e; const unsigned long long m = __ballot(h0 | h1b | h2 | h3);
                    const int below = __popcll(m & lt); rk0 = h0 ? below : rk0; rk1 = h1b ? below : rk1; rk2 = h2 ? below : rk2; rk3 = h3 ? below : rk3; if (lane == e) hist = __popcll(m); }
                if (lane < 32) WSP(int, WS_HIST)[(size_t)vcu * 32 + lane] = hist;
                const int a = (vcu * 64 + row) * 4;
                *(int4*)(WSP(int, WS_ASGE) + a) = make_int4(be[0], be[1], be[2], be[3]); *(int4*)(WSP(int, WS_ASGP) + a) = make_int4(rk0, rk1, rk2, rk3);
                *(f32x4*)(WSP(float, WS_GATE) + a) = (f32x4){inv, e1 * inv, e2 * inv, e3 * inv}; }
            else { const float* g = INP(21) + l * DM; unsigned char* xn8 = WSP(unsigned char, WS_XN);
                f32x4 gg[2][2];
#pragma unroll
                for (int j = 0; j < 2; ++j) { gg[j][0] = *(const f32x4*)(g + 512 * j + 8 * lane); gg[j][1] = *(const f32x4*)(g + 512 * j + 8 * lane + 4); }
                _Pragma("unroll 1") for (int i0 = 0; i0 < 12; i0 += 4) { v4u w[4][2];
#pragma unroll
                    for (int r = 0; r < 4; ++r) { const int row = min((wave - 1) + 7 * (i0 + r), 63);
#pragma unroll
                        for (int j = 0; j < 2; ++j) w[r][j] = *(const v4u*)(h1 + ((size_t)vcu * 64 + row) * DM + 512 * j + 8 * lane); }
#pragma unroll
                    for (int r = 0; r < 4; ++r) { const int row = (wave - 1) + 7 * (i0 + r);
                        if (row < 64) { const size_t m = (size_t)vcu * 64 + row; const float rstd = rsq(SS[row] * (1.0f / DM) + EPS);
#pragma unroll
                            for (int j = 0; j < 2; ++j) { const int col = 512 * j + 8 * lane; const v4u ww = w[r][j]; const f32x4 g0 = gg[j][0] * rstd, g1 = gg[j][1] * rstd;
                                int w0 = 0, w1 = 0;
                                w0 = __builtin_amdgcn_cvt_pk_fp8_f32(pg8::f8clamp(bflo(ww.x) * g0[0]), pg8::f8clamp(bfhi(ww.x) * g0[1]), w0, false); w0 = __builtin_amdgcn_cvt_pk_fp8_f32(pg8::f8clamp(bflo(ww.y) * g0[2]), pg8::f8clamp(bfhi(ww.y) * g0[3]), w0, true);
                                w1 = __builtin_amdgcn_cvt_pk_fp8_f32(pg8::f8clamp(bflo(ww.z) * g1[0]), pg8::f8clamp(bfhi(ww.z) * g1[1]), w1, false); w1 = __builtin_amdgcn_cvt_pk_fp8_f32(pg8::f8clamp(bflo(ww.w) * g1[2]), pg8::f8clamp(bfhi(ww.w) * g1[3]), w1, true);
                                u32x2 o; o.x = (unsigned)w0; o.y = (unsigned)w1; *(u32x2*)(xn8 + m * DM + col) = o; } } } } }
            EPT(2);
        }
        SEAM(P + 6);
#undef EPT
        PHASE(7, P + 7) { PH_IDS
            LAS int* bs = (LAS int*)(lds + 131072);
            { const int* hs = WSP(int, WS_HIST); LAS int* part = bs + 256; const int e = tid & 31, ws = tid >> 5;
                int cv[16];
#pragma unroll
                for (int k = 0; k < 16; ++k) cv[k] = hs[(ws + 16 * k) * 32 + e];
                int base = 0, tot = 0;
#pragma unroll
                for (int k = 0; k < 16; ++k) { tot += cv[k]; if (ws + 16 * k < vcu) base += cv[k]; }
                base += __shfl_xor(base, 32); tot += __shfl_xor(tot, 32);
                if (lane < 32) { part[wave * 64 + lane] = base; part[wave * 64 + 32 + lane] = tot; }
                __syncthreads();
                if (tid < 32) { int b2 = 0, t2 = 0;
#pragma unroll
                    for (int w = 0; w < 8; ++w) { b2 += part[w * 64 + tid]; t2 += part[w * 64 + 32 + tid]; }
                    bs[tid] = b2; bs[32 + tid] = t2; if (vcu == 0) WSP(int, WS_TOT)[tid] = t2; } }
            __syncthreads();
            if (tid < 64) { const int t = tid < 32 ? (bs[32 + tid] + 255) >> 8 : 0; int incl = t;
#pragma unroll
                for (int o = 1; o < 32; o <<= 1) { const int nb = __shfl_up(incl, o); if (lane >= o) incl += nb; }
                if (tid < 32) tb[tid] = incl - t;
                if (tid == 31) tb[32] = incl; }
            __syncthreads();
            const int* asge = WSP(int, WS_ASGE); const int* asgp = WSP(int, WS_ASGP); int* slotp = WSP(int, WS_SLOT); int* toks = (int*)(kargs()->ws + WS_CTL + CTL_TOKS) + (size_t)l * MAXSLOT;
            if (tid < 256) { const int a = vcu * 256 + tid; const int e = asge[a], slot = tb[e] * 256 + bs[e] + asgp[a]; slotp[a] = slot; toks[slot] = a >> 2; }
        }
        SEAM(P + 7);
        PHASE(8, P + 8) { PH_IDS
            build_tb(WSP(int, WS_TOT), tb, tid);
            LAS int* tokl = (LAS int*)(lds + 131072);
            pg8::MoeOrder::build((const LAS int*)tb, 8, G, bx, (LAS int*)(lds + UL_OFF), tid); pg8::MoeOrder S{(const LAS int*)(lds + UL_OFF), (const LAS int*)tokl};
            if (l + 1 < DEPTH) { const int rem = (tb[32] * 8) % G;
                if (rem != 0 && bx >= rem) { const int nw = (G - rem) * NWAVES; convert_items(min(CV_TAIL1 + nw * CV_GQ, CV_MOE), CV_TAIL1 + (bx - rem) * NWAVES + wave, nw, l + 2, ldsf + wave * (64 * 65), lane); } }
            __syncthreads();
            { const int* toks = (const int*)(kargs()->ws + WS_CTL + CTL_TOKS) + (size_t)l * MAXSLOT;
                const int nu = min(S.ul[0], 10); int tk[5];
#pragma unroll
                for (int j = 0; j < 5; ++j) { const int i = 2 * j + (tid >> 8); tk[j] = i < nu ? toks[S.ul[4 + 4 * i] * 256 + (tid & 255)] : 0; }
#pragma unroll
                for (int j = 0; j < 5; ++j) { const int i = 2 * j + (tid >> 8); if (i < nu) tokl[i * 256 + (tid & 255)] = tk[j]; }
                __syncthreads(); }
            pg8::Gemm g{WSP(bf16, WS_XN), (const bf16*)(WSP(unsigned char, WS_WGU) + (size_t)l * NE * 2048 * DM), T, 2048, DM, 0x7a7a7a7a, 0x7f7f7f7f, (REP_MASK && rep_) ? PROBE_KT : 0};
            pg8::EpiSwiglu8 E{WSP(unsigned char, WS_ACT), INP(25) + (size_t)l * NE * 2048, REP_MASK ? rep_ : 0};
#if PROBE_T
            if (PROBE_PH == 8 && l == 1 && tid == 0) ((LAS unsigned*)(lds + LDSCTL_OFF + 128))[7] = 1u; __syncthreads();
#endif
            pg8::gemm_phase<pg8::EpiSwiglu8, pg8::MoeOrder, true, SP2_F8, true, PF_G>(lds, g, S, E);
#if PROBE_T
            __syncthreads(); if (tid == 0) ((LAS unsigned*)(lds + LDSCTL_OFF + 128))[7] = 0u;
#endif
        }
        SEAM(P + 8);
        PHASE(9, P + 9) { PH_IDS
            build_tb(WSP(int, WS_TOT), tb, tid);
            pg8::Gemm g{WSP(bf16, WS_ACT), (const bf16*)(WSP(unsigned char, WS_WDN) + (size_t)l * NE * DM * DFF), MAXSLOT, DM, DFF, 0x79797979, 0x7f7f7f7f}; pg8::MoeOrder::build((const LAS int*)tb, 4, G, bx, (LAS int*)(lds + UL_OFF), tid); pg8::MoeOrder S{(const LAS int*)(lds + UL_OFF), nullptr, (REP_MASK && rep_) ? PROBE_SAME : 0};
            if (l + 1 < DEPTH) { const int remg = (tb[32] * 8) % G, remh = (tb[32] * 4) % G; const int offh = min(CV_TAIL1 + (remg ? (G - remg) * NWAVES * CV_GQ : 0), CV_MOE);
                if (remh != 0 && bx >= remh) { const int nw = (G - remh) * NWAVES; convert_items(min(offh + nw * CV_HQ, CV_MOE), offh + (bx - remh) * NWAVES + wave, nw, l + 2, ldsf + wave * (64 * 65), lane); } }
            __syncthreads();
            pg8::EpiBf16 E{WSP(bf16, WS_Y), DM, INP(27) + (size_t)l * NE * DM, DM, (REP_MASK && rep_) ? 1 : 0};
#if PROBE_T
            if (PROBE_PH == 9 && l == 1 && tid == 0) ((LAS unsigned*)(lds + LDSCTL_OFF + 128))[7] = 1u; __syncthreads();
#endif
            pg8::gemm_phase<pg8::EpiBf16, pg8::MoeOrder, true, SP2_F8, true, PF_H>(lds, g, S, E);
#if PROBE_T
            __syncthreads(); if (tid == 0) ((LAS unsigned*)(lds + LDSCTL_OFF + 128))[7] = 0u;
#endif
        }
        SEAM(P + 9);
        PHASE(10, P + 10) { PH_IDS
            if (l + 1 < DEPTH) { build_tb(WSP(int, WS_TOT), tb, tid);
                const int remg = (tb[32] * 8) % G, remh = (tb[32] * 4) % G; const int offc = min(min(CV_TAIL1 + (remg ? (G - remg) * NWAVES * CV_GQ : 0), CV_MOE) + (remh ? (G - remh) * NWAVES * CV_HQ : 0), CV_MOE);
                convert_items(CV_MOE, offc + gw, NGW, l + 2, ldsf + wave * (64 * 65), lane); }
            if (l + 1 < DEPTH) { __syncthreads(); stage_dtw(INP(2) + (size_t)(l + 1) * DM * DIN, ldsf, tid); }
            const bf16* h1 = WSP(bf16, WS_H1); const int* slotp = WSP(int, WS_SLOT); const float* gatep = WSP(float, WS_GATE); const bf16* yb = WSP(bf16, WS_Y);
            { const int nrow = (T - gw + NGW - 1) / NGW;
                int4 s0, s1; f32x4 g0, g1;
                { const int ma = gw, mb = nrow > 1 ? gw + NGW : gw; s0 = *(const int4*)(slotp + (size_t)ma * 4); s1 = *(const int4*)(slotp + (size_t)mb * 4); g0 = *(const f32x4*)(gatep + (size_t)ma * 4); g1 = *(const f32x4*)(gatep + (size_t)mb * 4); }
                _Pragma("unroll 1") for (int i = 0; i < nrow; i += 2) { const int m0 = gw + i * NGW, m1 = (i + 1 < nrow) ? m0 + NGW : m0; const bool two = i + 1 < nrow;
                    const int na = i + 2 < nrow ? gw + (i + 2) * NGW : m0, nb = i + 3 < nrow ? gw + (i + 3) * NGW : na;
                    const int4 s0n = *(const int4*)(slotp + (size_t)na * 4), s1n = *(const int4*)(slotp + (size_t)nb * 4); const f32x4 g0n = *(const f32x4*)(gatep + (size_t)na * 4), g1n = *(const f32x4*)(gatep + (size_t)nb * 4);
                    const int sl0[4] = {s0.x, s0.y, s0.z, s0.w}, sl1[4] = {s1.x, s1.y, s1.z, s1.w};
                    u32x2 h0[4], h1r[4], y0[4][4], y1[4][4];
#pragma unroll
                    for (int j = 0; j < 4; ++j) { h0[j] = *(const u32x2*)(h1 + (size_t)m0 * DM + 256 * j + 4 * lane); h1r[j] = *(const u32x2*)(h1 + (size_t)m1 * DM + 256 * j + 4 * lane); }
#pragma unroll
                    for (int r = 0; r < 4; ++r)
#pragma unroll
                        for (int j = 0; j < 4; ++j) { y0[r][j] = *(const u32x2*)(yb + (size_t)sl0[r] * DM + 256 * j + 4 * lane); y1[r][j] = *(const u32x2*)(yb + (size_t)sl1[r] * DM + 256 * j + 4 * lane); }
#pragma unroll
                    for (int rr = 0; rr < 2; ++rr) { if (rr == 1 && !two) break; const int m = rr ? m1 : m0;
                        f32x4 v[4];
#pragma unroll
                        for (int j = 0; j < 4; ++j) { const u32x2 w = rr ? h1r[j] : h0[j]; v[j] = (f32x4){bflo(w.x), bfhi(w.x), bflo(w.y), bfhi(w.y)}; }
#pragma unroll
                        for (int r = 0; r < 4; ++r)
#pragma unroll
                            for (int j = 0; j < 4; ++j) { const float gg = rr ? g1[r] : g0[r]; const u32x2 w = rr ? y1[r][j] : y0[r][j]; v[j][0] += gg * bflo(w.x); v[j][1] += gg * bfhi(w.x); v[j][2] += gg * bflo(w.y); v[j][3] += gg * bfhi(w.y); }
                        if (l + 1 < DEPTH) {
#pragma unroll
                            for (int j = 0; j < 4; ++j) { u32x2 w; w.x = pk2(v[j][0], v[j][1]); w.y = pk2(v[j][2], v[j][3]); *(u32x2*)(WSP(bf16, WS_HB) + (size_t)m * DM + 256 * j + 4 * lane) = w; }
                            emit_xn_dt(v, INP(1) + (l + 1) * DM, ldsf, WSP(bf16, WS_XN) + (size_t)m * DM, WSP(float, WS_DT) + (size_t)m * 4, lane);
                        } else { float ss = 0.f;
#pragma unroll
                            for (int j = 0; j < 4; ++j) ss += (v[j][0] * v[j][0] + v[j][1] * v[j][1]) + (v[j][2] * v[j][2] + v[j][3] * v[j][3]);
                            ss = wave_sum(ss); const float rstd = rsq(ss * (1.0f / DM) + EPS);
#pragma unroll
                            for (int j = 0; j < 4; ++j) __builtin_nontemporal_store(v[j] * rstd * *(const f32x4*)(INP(28) + 256 * j + 4 * lane), (f32x4*)(kargs()->out + (size_t)m * DM + 256 * j + 4 * lane)); } }
                    s0 = s0n; s1 = s1n; g0 = g0n; g1 = g1n;
                }
            }
        }
        if (l + 1 < DEPTH) SEAM(P + 10);
    }
#if PROBE_T
    if (bx == PROBE_WG && tid0 == 0) { const unsigned ticks = ((LAS unsigned*)(lds + LDSCTL_OFF + 128))[PROBE_SEL] * 4u / (PROBE_CLK ? 32u : 1u); const unsigned long long t0 = __builtin_amdgcn_s_memrealtime();
        while ((unsigned)(__builtin_amdgcn_s_memrealtime() - t0) < ticks) __builtin_amdgcn_s_sleep(8); }
#endif
#undef IN
#undef SEAM
}

extern "C" void kernel_launch(void* const* d_in, const int* in_sizes, int n_in, void* d_out, int out_size, void* d_ws, size_t ws_size, hipStream_t stream) {
    static int grid = 0;
    if (grid == 0) {
        if (n_in != 29 || in_sizes[0] != T * DM || out_size != T * DM || ws_size < WS_END) { fprintf(stderr, "kernel_launch: unexpected shapes (n_in %d, in0 %d, out %d, ws %zu); nothing launched\n", n_in, n_in > 0 ? in_sizes[0] : -1, out_size, ws_size); grid = -1; return; }
        int dev = 0, cus = 0, per_cu = 0;
        if (hipGetDevice(&dev) != hipSuccess || hipDeviceGetAttribute(&cus, hipDeviceAttributeMultiprocessorCount, dev) != hipSuccess) { grid = -1; return; }
        if (hipFuncSetAttribute((const void*)fwd_kernel, hipFuncAttributeMaxDynamicSharedMemorySize, LDS_BYTES) != hipSuccess) { fprintf(stderr, "kernel_launch: hipFuncSetAttribute failed\n"); grid = -1; return; }
        if (hipOccupancyMaxActiveBlocksPerMultiprocessor(&per_cu, (const void*)fwd_kernel, NTHR, LDS_BYTES) != hipSuccess || per_cu < 1) fprintf(stderr, "kernel_launch: occupancy query reports %d\n", per_cu);
        (void)hipGetLastError();
        if (cus != 256) { fprintf(stderr, "kernel_launch: built for a 256-CU device (one workgroup per CU, work lists sized for 256 workgroups); found %d CUs; nothing launched\n", cus); grid = -1; return; }
        grid = cus;
    }
    if (grid < 0) return;
    if (hipMemsetAsync((char*)d_ws + WS_CTL, 0, CTL_ZERO_BYTES, stream) != hipSuccess) { fprintf(stderr, "kernel_launch: memset failed\n"); return; }
    Args a{};
    for (int i = 0; i < 29; ++i) a.in[i] = (const float*)d_in[i];
    a.out = (float*)d_out; a.ws = (unsigned char*)d_ws;
#if MK_N_LAUNCHES == 1
    a.ph_lo = 0; a.ph_hi = NPHASE; a.use_bar = 1;
    hipLaunchKernelGGL(fwd_kernel, dim3(grid), dim3(NTHR), LDS_BYTES, stream, a);
#else
    for (int p = 0; p < NPHASE; ++p) { a.ph_lo = p; a.ph_hi = p + 1; a.use_bar = 0; hipLaunchKernelGGL(fwd_kernel, dim3(grid), dim3(NTHR), LDS_BYTES, stream, a); }
#endif
}
```
